# Optimizing an MI355X kernel written in HIP

```python
import math
import jax, jax.numpy as jnp
from jax import lax
import numpy as np

D_MODEL = 2048
BATCH = 16
SEQ = 2048
DEPTH = 1

N_META = 16
D_MIX = D_MODEL
ATTN_WIDTH = D_MIX // 2
MLSTM_WIDTH = D_MIX - ATTN_WIDTH
ATTN_HEAD_DIM = 64
ATTN_HEADS = ATTN_WIDTH // (2 * ATTN_HEAD_DIM)
ATTN_V_DIM = 2 * ATTN_HEAD_DIM
ROPE_THETA = 10000.0
Q_BLOCK = 128
PAD_LEN = Q_BLOCK - N_META
MLSTM_HEADS = 4
MLSTM_V_DIM = MLSTM_WIDTH // MLSTM_HEADS
MLSTM_QK_DIM = MLSTM_V_DIM // 2
MLSTM_CHUNK = 64
CONV_WIDTH = 4
FORGET_BIAS_INIT = 3.0
PEER_HEADS = 8
PEER_N_KEYS = 128
PEER_N_EXPERTS = PEER_N_KEYS * PEER_N_KEYS
PEER_SUB_DIM = 128
PEER_KEY_DIM = 2 * PEER_SUB_DIM
PEER_TOPK = 16
PEER_TOK_BLOCK = 128
EPS = 1e-6
NEG = -1e30

IN_SIZES = (
    ATTN_HEADS * 2 * ATTN_HEAD_DIM,
    ATTN_HEADS * 2 * ATTN_HEAD_DIM,
    ATTN_HEADS * ATTN_V_DIM,
    MLSTM_HEADS * MLSTM_QK_DIM,
    MLSTM_HEADS * MLSTM_QK_DIM,
    MLSTM_HEADS * MLSTM_V_DIM,
    MLSTM_HEADS * MLSTM_V_DIM,
    MLSTM_HEADS,
    MLSTM_HEADS,
)
IN_COLS = sum(IN_SIZES)

kernel_name = 'hybrid_diffattn_mlstm_peer'


def _split_points():
    pts, acc = [], 0
    for s in IN_SIZES[:-1]:
        acc += s
        pts.append(acc)
    return pts


def rmsnorm(x, w):
    xf = x.astype(jnp.float32)
    y = xf * lax.rsqrt(jnp.mean(xf * xf, axis=-1, keepdims=True) + EPS)
    return (y * w.astype(jnp.float32)).astype(x.dtype)


def rope_tables(pos, dim):
    inv_freq = ROPE_THETA ** (-jnp.arange(0, dim, 2, dtype=jnp.float32) / dim)
    ang = pos.astype(jnp.float32)[:, None] * inv_freq[None, :]
    ang = jnp.concatenate([ang, ang], axis=-1)
    return jnp.cos(ang), jnp.sin(ang)


def apply_rope(x, cos, sin):
    c = cos.astype(x.dtype)[None, :, None, None, :]
    s = sin.astype(x.dtype)[None, :, None, None, :]
    x1, x2 = jnp.split(x, 2, axis=-1)
    return x * c + jnp.concatenate([-x2, x1], axis=-1) * s


def causal_conv(x, w, b):
    c = x.shape[-1]
    y = lax.conv_general_dilated(x, w[:, None, :], window_strides=(1,),
                                 padding=[(CONV_WIDTH - 1, 0)],
                                 dimension_numbers=('NWC', 'WIO', 'NWC'),
                                 feature_group_count=c)
    return y + b


def diff_attention(q, k, v, lam_qk, subln_w, lambda_init):
    B, P = q.shape[0], q.shape[1]
    nb = P // Q_BLOCK
    pos = jnp.maximum(jnp.arange(P) - PAD_LEN, 0)
    cos, sin = rope_tables(pos, ATTN_HEAD_DIM)
    q = apply_rope(q, cos, sin) * (ATTN_HEAD_DIM ** -0.5)
    k = apply_rope(k, cos, sin)
    lq = lam_qk.astype(jnp.float32)
    lam = jnp.exp(jnp.sum(lq[0] * lq[1])) - jnp.exp(jnp.sum(lq[2] * lq[3])) + lambda_init
    q_blocks = q.reshape(B, nb, Q_BLOCK, ATTN_HEADS, 2, ATTN_HEAD_DIM).transpose(1, 0, 2, 3, 4, 5)
    key_idx = jnp.arange(P)

    def block(args):
        qb, bi = args
        q_idx = bi * Q_BLOCK + jnp.arange(Q_BLOCK)
        s = jnp.einsum('bqhcd,bkhcd->bhcqk', qb, k).astype(jnp.float32)
        mask = (key_idx[None, :] <= q_idx[:, None]) & (key_idx[None, :] >= PAD_LEN)
        s = jnp.where(mask[None, None, None], s, NEG)
        p = jax.nn.softmax(s, axis=-1)
        a = p[:, :, 0] - lam * p[:, :, 1]
        return jnp.einsum('bhqk,bkhe->bqhe', a.astype(v.dtype), v)

    out = lax.map(block, (q_blocks, jnp.arange(nb)))
    out = out.transpose(1, 0, 2, 3, 4).reshape(B, P, ATTN_HEADS, ATTN_V_DIM)
    out = rmsnorm(out, subln_w) * (1.0 - lambda_init)
    return out.reshape(B, P, ATTN_HEADS * ATTN_V_DIM)


def mlstm_chunkwise(q, k, v, log_i, log_f):
    B, P = q.shape[0], q.shape[1]
    H, CL = MLSTM_HEADS, MLSTM_CHUNK
    nc = P // CL

    def to_chunks(t):
        return t.astype(jnp.float32).reshape(B, nc, CL, H, -1).transpose(0, 3, 1, 2, 4)

    qc = to_chunks(q) * (MLSTM_QK_DIM ** -0.5)
    kc, vc = to_chunks(k), to_chunks(v)
    li = log_i.reshape(B, nc, CL, H).transpose(0, 3, 1, 2)
    lf = log_f.reshape(B, nc, CL, H).transpose(0, 3, 1, 2)
    b = jnp.cumsum(lf, axis=-1)
    g = b[..., -1]
    a = g[..., None] - b + li

    def step(carry, xs):
        C, n, m = carry
        k_s, v_s, a_s, g_s = xs
        m_new = jnp.maximum(g_s + m, jnp.max(a_s, axis=-1))
        w = jnp.exp(a_s - m_new[..., None])
        decay = jnp.exp(g_s + m - m_new)
        C_new = decay[..., None, None] * C + jnp.einsum('bhs,bhsk,bhsv->bhkv', w, k_s, v_s)
        n_new = decay[..., None] * n + jnp.einsum('bhs,bhsk->bhk', w, k_s)
        return (C_new, n_new, m_new), (C, n, m)

    init = (jnp.zeros((B, H, MLSTM_QK_DIM, MLSTM_V_DIM), jnp.float32),
            jnp.zeros((B, H, MLSTM_QK_DIM), jnp.float32),
            jnp.full((B, H), NEG, jnp.float32))
    xs = (kc.transpose(2, 0, 1, 3, 4), vc.transpose(2, 0, 1, 3, 4),
          a.transpose(2, 0, 1, 3), g.transpose(2, 0, 1))
    _, (C_prev, n_prev, m_prev) = lax.scan(step, init, xs)
    C_prev = C_prev.transpose(1, 2, 0, 3, 4)
    n_prev = n_prev.transpose(1, 2, 0, 3)
    m_prev = m_prev.transpose(1, 2, 0)

    causal = jnp.tril(jnp.ones((CL, CL), dtype=bool))
    D = jnp.where(causal, b[..., :, None] - b[..., None, :] + li[..., None, :], NEG)
    m_inter = b + m_prev[..., None]
    m_t = jnp.maximum(jnp.max(D, axis=-1), m_inter)
    S = jnp.einsum('bhctd,bhcsd->bhcts', qc, kc) * jnp.exp(D - m_t[..., None])
    inter_w = jnp.exp(m_inter - m_t)
    num = jnp.einsum('bhcts,bhcsv->bhctv', S, vc) + \
        inter_w[..., None] * jnp.einsum('bhctk,bhckv->bhctv', qc, C_prev)
    nq = jnp.sum(S, axis=-1) + inter_w * jnp.einsum('bhctk,bhck->bhct', qc, n_prev)
    h = num / jnp.maximum(jnp.abs(nq), jnp.exp(-m_t))[..., None]
    return h.transpose(0, 2, 3, 1, 4).reshape(B, P, H, MLSTM_V_DIM)


def peer_ffn(h, w_q, sub_keys, u, v):
    B, L, D = h.shape
    T = B * L
    ht = h.reshape(T, D)
    q = (ht @ w_q).reshape(T, PEER_HEADS, 2, PEER_SUB_DIM)
    s = jnp.einsum('thpd,hpnd->thpn', q, sub_keys).astype(jnp.float32)
    s1, i1 = lax.top_k(s[:, :, 0], PEER_TOPK)
    s2, i2 = lax.top_k(s[:, :, 1], PEER_TOPK)
    cand_s = (s1[..., :, None] + s2[..., None, :]).reshape(T, PEER_HEADS, PEER_TOPK * PEER_TOPK)
    cand_i = (i1[..., :, None] * PEER_N_KEYS + i2[..., None, :]).reshape(T, PEER_HEADS, PEER_TOPK * PEER_TOPK)
    best_s, best_pos = lax.top_k(cand_s, PEER_TOPK)
    idx = jnp.take_along_axis(cand_i, best_pos, axis=-1).reshape(T, PEER_HEADS * PEER_TOPK)
    gate = jax.nn.softmax(best_s, axis=-1).reshape(T, PEER_HEADS * PEER_TOPK).astype(h.dtype)
    nblk = -(-T // PEER_TOK_BLOCK)
    pad = nblk * PEER_TOK_BLOCK - T
    ht_b = jnp.pad(ht, ((0, pad), (0, 0))).reshape(nblk, PEER_TOK_BLOCK, D)
    idx_b = jnp.pad(idx, ((0, pad), (0, 0))).reshape(nblk, PEER_TOK_BLOCK, -1)
    g_b = jnp.pad(gate, ((0, pad), (0, 0))).reshape(nblk, PEER_TOK_BLOCK, -1)

    def block(args):
        hb, ib, gb = args
        ub = jnp.take(u, ib, axis=0)
        act = jax.nn.gelu(jnp.einsum('td,tkd->tk', hb, ub), approximate=False)
        return jnp.einsum('tk,tkd->td', gb * act, jnp.take(v, ib, axis=0))

    y = lax.map(block, (ht_b, idx_b, g_b)).reshape(nblk * PEER_TOK_BLOCK, D)[:T]
    return y.reshape(B, L, D)


def hybrid_layer(x, norm_mix_w, w_in, attn_lambda_qk, attn_subln_w, conv_w, conv_b,
                 i_b, f_b, mlstm_norm_w, w_out, norm_ffn_w, peer_w_q, peer_sub_keys,
                 peer_u, peer_v, lambda_init):
    B, L, _ = x.shape
    P = L + PAD_LEN
    h = rmsnorm(x, norm_mix_w)
    z = jnp.einsum('bld,dc->blc', h, w_in)
    z = jnp.pad(z, ((0, 0), (PAD_LEN, 0), (0, 0)))
    aq, ak, av, mq, mk, mv, mo, mi, mf = jnp.split(z, _split_points(), axis=-1)
    valid = (jnp.arange(P) >= PAD_LEN)[None, :, None]

    attn_out = diff_attention(aq.reshape(B, P, ATTN_HEADS, 2, ATTN_HEAD_DIM),
                              ak.reshape(B, P, ATTN_HEADS, 2, ATTN_HEAD_DIM),
                              av.reshape(B, P, ATTN_HEADS, ATTN_V_DIM),
                              attn_lambda_qk, attn_subln_w, lambda_init)

    qk = jax.nn.silu(causal_conv(jnp.concatenate([mq, mk], axis=-1), conv_w, conv_b))
    mq, mk = jnp.split(qk, 2, axis=-1)
    log_i = jnp.where(valid, mi.astype(jnp.float32) + i_b.astype(jnp.float32), NEG)
    log_f = jnp.where(valid, jax.nn.log_sigmoid(mf.astype(jnp.float32) + f_b.astype(jnp.float32)), 0.0)
    hm = mlstm_chunkwise(mq.reshape(B, P, MLSTM_HEADS, MLSTM_QK_DIM),
                         mk.reshape(B, P, MLSTM_HEADS, MLSTM_QK_DIM),
                         mv.reshape(B, P, MLSTM_HEADS, MLSTM_V_DIM), log_i, log_f)
    hm = rmsnorm(hm, mlstm_norm_w.reshape(MLSTM_HEADS, MLSTM_V_DIM)).astype(x.dtype)
    mlstm_out = (hm * jax.nn.sigmoid(mo.reshape(B, P, MLSTM_HEADS, MLSTM_V_DIM))).reshape(B, P, MLSTM_WIDTH)

    mix = jnp.concatenate([attn_out, mlstm_out], axis=-1)[:, PAD_LEN:]
    x = x + jnp.einsum('blc,cd->bld', mix, w_out)
    x = x + peer_ffn(rmsnorm(x, norm_ffn_w), peer_w_q, peer_sub_keys, peer_u, peer_v)
    return x


def setup_inputs(seed: int = 0) -> dict:
    key = jax.random.key(seed)
    ks = jax.random.split(key, 18)
    f32 = jnp.float32
    nrm = lambda k, shape, scale: scale * jax.random.normal(k, shape, f32)
    return {
        'x': nrm(ks[0], (BATCH, SEQ, D_MODEL), 1.0),
        'meta_tokens': nrm(ks[1], (N_META, D_MODEL), 1.0),
        'norm_mix_w': 1.0 + nrm(ks[2], (DEPTH, D_MODEL), 0.02),
        'w_in': nrm(ks[3], (DEPTH, D_MODEL, IN_COLS), D_MODEL ** -0.5),
        'attn_lambda_qk': nrm(ks[4], (DEPTH, 4, ATTN_HEAD_DIM), 0.1),
        'attn_subln_w': 1.0 + nrm(ks[5], (DEPTH, ATTN_V_DIM), 0.02),
        'mlstm_conv_w': nrm(ks[6], (DEPTH, CONV_WIDTH, 2 * MLSTM_HEADS * MLSTM_QK_DIM), CONV_WIDTH ** -0.5),
        'mlstm_conv_b': nrm(ks[7], (DEPTH, 2 * MLSTM_HEADS * MLSTM_QK_DIM), 0.02),
        'mlstm_i_b': nrm(ks[8], (DEPTH, MLSTM_HEADS), 0.1),
        'mlstm_f_b': FORGET_BIAS_INIT + nrm(ks[9], (DEPTH, MLSTM_HEADS), 0.5),
        'mlstm_norm_w': 1.0 + nrm(ks[10], (DEPTH, MLSTM_WIDTH), 0.02),
        'w_out': nrm(ks[11], (DEPTH, D_MIX, D_MODEL), D_MIX ** -0.5),
        'norm_ffn_w': 1.0 + nrm(ks[12], (DEPTH, D_MODEL), 0.02),
        'peer_w_q': nrm(ks[13], (DEPTH, D_MODEL, PEER_HEADS * PEER_KEY_DIM), D_MODEL ** -0.5),
        'peer_sub_keys': nrm(ks[14], (DEPTH, PEER_HEADS, 2, PEER_N_KEYS, PEER_SUB_DIM), PEER_SUB_DIM ** -0.5),
        'peer_u': nrm(ks[15], (DEPTH, PEER_N_EXPERTS, D_MODEL), D_MODEL ** -0.5),
        'peer_v': nrm(ks[16], (DEPTH, PEER_N_EXPERTS, D_MODEL), D_MODEL ** -0.5),
        'norm_final_w': 1.0 + nrm(ks[17], (D_MODEL,), 0.02),
    }


def reference(x, meta_tokens, norm_mix_w, w_in, attn_lambda_qk, attn_subln_w, mlstm_conv_w,
              mlstm_conv_b, mlstm_i_b, mlstm_f_b, mlstm_norm_w, w_out, norm_ffn_w, peer_w_q,
              peer_sub_keys, peer_u, peer_v, norm_final_w):
    B = x.shape[0]
    meta = jnp.broadcast_to(meta_tokens[None].astype(x.dtype), (B, N_META, D_MODEL))
    h = jnp.concatenate([meta, x], axis=1)
    for layer in range(DEPTH):
        lambda_init = 0.8 - 0.6 * math.exp(-0.3 * layer)
        h = hybrid_layer(h, norm_mix_w[layer], w_in[layer], attn_lambda_qk[layer],
                         attn_subln_w[layer], mlstm_conv_w[layer], mlstm_conv_b[layer],
                         mlstm_i_b[layer], mlstm_f_b[layer], mlstm_norm_w[layer], w_out[layer],
                         norm_ffn_w[layer], peer_w_q[layer], peer_sub_keys[layer],
                         peer_u[layer], peer_v[layer], lambda_init)
    h = rmsnorm(h, norm_final_w)
    return h[:, N_META:]
```

```cpp
#include <hip/hip_runtime.h>
#include <hip/hip_bf16.h>
#include <cstdio>
#include <cstdint>
#include <cmath>
namespace pg8 {
#define PG8_LAS __attribute__((address_space(3)))
typedef unsigned short bf16_t;
typedef short bf16x8 __attribute__((ext_vector_type(8)));
typedef float f32x4 __attribute__((ext_vector_type(4)));
typedef unsigned u32x4 __attribute__((ext_vector_type(4)));
constexpr int BM = 256, BK = 64, HALF = 128, HTB = HALF * BK * 2  , STAGE_BYTES = 8 * HTB, NXCD = 8, WGM = 8;

__host__ __device__ __forceinline__ int lds_byte(int r, int c) { const int st = (r >> 4) * 2 + (c >> 5), rr = r & 15, cc = c & 31, ob = rr * 64 + cc * 2; return st * 1024 + (ob ^ (((ob >> 9) & 1) << 5)); }
__host__ __device__ __forceinline__ void stage_rc(int b, int& R, int& C) { const int st = b / 1024, sb = b % 1024, swz = sb ^ (((sb >> 9) & 1) << 5); R = (st >> 1) * 16 + swz / 64; C = (st & 1) * 32 + (swz % 64) / 2; }
__host__ __device__ __forceinline__ int perm32(int rho) { const int n = rho >> 4, i = rho & 15; return 8 * (i >> 2) + 4 * n + (i & 3); }

struct Unit { int pm, pn; };
struct Gemm { const bf16_t* A; const bf16_t* Bt; int M, N, K; };

struct StaticOrder {
    int nM, nN, nwg, G, c;
    __host__ __device__ void init(int M, int N, int G_, int c_) { nM = M / BM; nN = N / BM; nwg = nM * nN; G = G_; c = c_; }
    __host__ __device__ bool next(int i, Unit& u) const {
        const long L = (long)i * G + c; if (L >= nwg) return false;
        int wgid = (int)L; { const int q = nwg / NXCD, r = nwg % NXCD, xcd = wgid % NXCD, off = wgid / NXCD; wgid = (xcd < r ? xcd * (q + 1) : r * (q + 1) + (xcd - r) * q) + off; }
        const int nig = WGM * nN, gid = wgid / nig, fm = gid * WGM, gsz = (nM - fm) < WGM ? (nM - fm) : WGM;
        u.pm = fm + ((wgid % nig) % gsz); u.pn = (wgid % nig) / gsz; return true;
    }
    __device__ __forceinline__ void a_ready(const Unit&) const {}
    __device__ __forceinline__ void done(const Unit&) const {}
};

__device__ __forceinline__ unsigned cvt_pk_bf16(float lo, float hi) { unsigned r; asm volatile("v_cvt_pk_bf16_f32 %0, %1, %2" : "=v"(r) : "v"(lo), "v"(hi)); return r; }
typedef float f32x2 __attribute__((ext_vector_type(2)));
__device__ __forceinline__ f32x2 gelu_pk(f32x2 v) {
    const f32x2 av = __builtin_elementwise_abs(v), d = av * 0.2316418882f + 1.0f;
    f32x2 t; t.x = __builtin_amdgcn_rcpf(d.x); t.y = __builtin_amdgcn_rcpf(d.y);
    f32x2 q = t * 0.5307027145f + (-0.7265760135f); q = q * t + 0.7107068705f; q = q * t + (-0.142248368f); q = q * t + 0.127414796f; q = q * t;
    const f32x2 s = (v * v) * (-0.72134752044f);
    f32x2 e; e.x = __builtin_amdgcn_exp2f(s.x); e.y = __builtin_amdgcn_exp2f(s.y);
    const f32x2 m = v * (q * e), r = v - m;
    f32x2 o; o.x = v.x < 0.f ? m.x : r.x; o.y = v.y < 0.f ? m.y : r.y; return o;
}

template <int ACT  > struct EpiBf16 {
    static constexpr bool PERM = true, AFTER_DRAIN = false; static_assert(ACT == 0 || ACT == 1, "EpiBf16: ACT is 0 (none) or 1 (gelu_pk)");
    bf16_t* O; int ldc; const float* bias; int split_cols; size_t split_stride; float scale0;
    __device__ __forceinline__ void operator()(const f32x4 (&acc)[2][2][4][2], const Unit& u, int wr, int wc, int fr, int fq) const {
        const int row0 = u.pm * BM + wr * 64 + fr; int colt = u.pn * BM; bf16_t* base = O;
        float sc = 1.f; if (split_cols) { const int t = colt / split_cols; base += (size_t)t * split_stride; colt -= t * split_cols; if (t == 0) sc = scale0; }
        const int col0 = colt + wc * 32 + 8 * fq, bcol0 = u.pn * BM + wc * 32 + 8 * fq;
        f32x4 bv[2][2];
#pragma unroll
        for (int bj = 0; bj < 2; ++bj)
#pragma unroll
            for (int n = 0; n < 2; ++n) bv[bj][n] = bias ? *(const f32x4*)(bias + bcol0 + bj * HALF + 4 * n) : (f32x4){0.f, 0.f, 0.f, 0.f};
#pragma unroll
        for (int ai = 0; ai < 2; ++ai)
#pragma unroll
            for (int m = 0; m < 4; ++m) { bf16_t* rowp = base + (size_t)(row0 + ai * HALF + m * 16) * ldc + col0;
#pragma unroll
                for (int bj = 0; bj < 2; ++bj) { f32x4 v0 = acc[ai][bj][m][0] + bv[bj][0], v1 = acc[ai][bj][m][1] + bv[bj][1];
                    if (ACT == 1) { f32x2 a = gelu_pk((f32x2){v0[0], v0[1]}), b = gelu_pk((f32x2){v0[2], v0[3]}), c = gelu_pk((f32x2){v1[0], v1[1]}), d = gelu_pk((f32x2){v1[2], v1[3]});
                        v0 = (f32x4){a.x, a.y, b.x, b.y}; v1 = (f32x4){c.x, c.y, d.x, d.y}; }
                    v0 = v0 * sc; v1 = v1 * sc; u32x4 w; w.x = cvt_pk_bf16(v0[0], v0[1]); w.y = cvt_pk_bf16(v0[2], v0[3]); w.z = cvt_pk_bf16(v1[0], v1[1]); w.w = cvt_pk_bf16(v1[2], v1[3]);
                    *(u32x4*)(rowp + bj * HALF) = w; } }
    }
};
template <class Epi, class Sched, bool ALIGN_EPI = false, bool SP2 = false>
__device__ __forceinline__ void gemm_phase(PG8_LAS unsigned char* lds, const Gemm g, const Sched& S, const Epi& E) {
    const int tid = threadIdx.x, wid = __builtin_amdgcn_readfirstlane(tid >> 6), lane = tid & 63, wr = wid >> 2, wc = wid & 3, fr = lane & 15, fq = lane >> 4;
    const int K = g.K, nt = K / BK;
    unsigned voffA[2], voffB[2];
#pragma unroll
    for (int i = 0; i < 2; ++i) { int R, C; stage_rc(tid * 16 + i * 8192, R, C); const int Rb = Epi::PERM ? ((R & ~31) + perm32(R & 31)) : R;
        voffA[i] = (unsigned)(R * K + C) * 2u; voffB[i] = (unsigned)(Rb * K + C) * 2u; }
    const size_t kstep = (size_t)(BK * 2);
    const size_t hstep = (size_t)HALF * K * 2;
    const size_t tstep = 2 * hstep;
    const unsigned ldsw = (unsigned)wid * 1024u;
    const int aoff = lds_byte(wr * 64 + fr, fq * 8), boff = lds_byte(wc * 32 + fr, fq * 8);
#define PG8_SA(b, h) (((b) * 2 + (h)) * HTB)
#define PG8_SB(b, h) ((4 + (b) * 2 + (h)) * HTB)
#define PG8_STAGE(bufoff, gbase, voff) do { _Pragma("unroll") for (int _i = 0; _i < 2; ++_i) \
        __builtin_amdgcn_global_load_lds((const unsigned*)((const char*)(gbase) + (voff)[_i]), (PG8_LAS unsigned*)(lds + (bufoff) + ldsw + _i * 8192), 16, 0, 0); } while (0)
#define PG8_LDA(dst, b, h) do { _Pragma("unroll") for (int m = 0; m < 4; ++m) _Pragma("unroll") for (int k = 0; k < 2; ++k) dst[m][k] = *(const PG8_LAS bf16x8*)(lds + PG8_SA(b, h) + aoff + m * 2048 + k * 1024); } while (0)
#define PG8_LDB(dst, b, h) do { _Pragma("unroll") for (int n = 0; n < 2; ++n) _Pragma("unroll") for (int k = 0; k < 2; ++k) dst[n][k] = *(const PG8_LAS bf16x8*)(lds + PG8_SB(b, h) + boff + n * 2048 + k * 1024); } while (0)
#define PG8_MMA(ai, bj, At, Bt) do { __builtin_amdgcn_s_setprio(1); _Pragma("unroll") for (int m = 0; m < 4; ++m) _Pragma("unroll") for (int n = 0; n < 2; ++n) _Pragma("unroll") for (int k = 0; k < 2; ++k) \
        acc[ai][bj][m][n] = __builtin_amdgcn_mfma_f32_16x16x32_bf16(Bt[n][k], At[m][k], acc[ai][bj][m][n], 0, 0, 0); __builtin_amdgcn_s_setprio(0); } while (0)
#define PG8_WAIT_V(n) asm volatile("s_waitcnt vmcnt(" #n ")" ::: "memory")
#define PG8_WAIT_L(n) asm volatile("s_waitcnt lgkmcnt(" #n ")" ::: "memory")
#define PG8_BAR __builtin_amdgcn_s_barrier()
#define PG8_SCHED __builtin_amdgcn_sched_barrier(0)
    Unit cur, nxt; int ui = 0;
    if (!S.next(0, cur)) return;
    f32x4 acc[2][2][4][2];
#pragma unroll
    for (int a = 0; a < 2; ++a)
#pragma unroll
        for (int b = 0; b < 2; ++b)
#pragma unroll
            for (int m = 0; m < 4; ++m)
#pragma unroll
                for (int n = 0; n < 2; ++n) acc[a][b][m][n] = (f32x4){0.f, 0.f, 0.f, 0.f};
    bf16x8 At[4][2], B0[2][2], B1[2][2];
    const char* cA = (const char*)g.A + (size_t)cur.pm * tstep; const char* cB = (const char*)g.Bt + (size_t)cur.pn * tstep;
    S.a_ready(cur);
    if constexpr (SP2) {
        PG8_STAGE(PG8_SB(0, 0), cB, voffB); PG8_STAGE(PG8_SB(0, 1), cB + hstep, voffB); PG8_STAGE(PG8_SA(0, 0), cA, voffA); PG8_STAGE(PG8_SA(0, 1), cA + hstep, voffA);
        if (wr == 1) PG8_BAR;
        PG8_WAIT_V(2); PG8_BAR;
        PG8_STAGE(PG8_SB(1, 0), cB + kstep, voffB); PG8_STAGE(PG8_SA(1, 0), cA + kstep, voffA); PG8_STAGE(PG8_SB(1, 1), cB + hstep + kstep, voffB);
        PG8_WAIT_V(6); PG8_BAR;
    } else {
        PG8_STAGE(PG8_SB(0, 0), cB, voffB); PG8_STAGE(PG8_SA(0, 0), cA, voffA); PG8_STAGE(PG8_SB(0, 1), cB + hstep, voffB); PG8_STAGE(PG8_SA(0, 1), cA + hstep, voffA);
        if (wr == 1) PG8_BAR;
        PG8_WAIT_V(4); PG8_BAR;
        PG8_STAGE(PG8_SB(1, 0), cB + kstep, voffB); PG8_STAGE(PG8_SA(1, 0), cA + kstep, voffA); PG8_STAGE(PG8_SB(1, 1), cB + hstep + kstep, voffB);
        PG8_WAIT_V(6); PG8_BAR;
    }
    for (;;) {
        const bool has_next = S.next(ui + 1, nxt);
        const char* nA = has_next ? (const char*)g.A + (size_t)nxt.pm * tstep : cA; const char* nB = has_next ? (const char*)g.Bt + (size_t)nxt.pn * tstep : cB;
        for (int t = 0; t < nt; t += 2) {
            const bool last = (t == nt - 2);
            const char* a1 = cA + (size_t)(t + 1) * kstep;
            const char* a2 = last ? nA : cA + (size_t)(t + 2) * kstep; const char* b2 = last ? nB : cB + (size_t)(t + 2) * kstep;
            const char* a3 = a2 + kstep; const char* b3 = b2 + kstep;
            if (last && has_next) S.a_ready(nxt);
            if constexpr (SP2) {
            PG8_LDB(B0, 0, 0); PG8_LDB(B1, 0, 1); PG8_SCHED; PG8_LDA(At, 0, 0); PG8_STAGE(PG8_SA(1, 1), a1 + hstep, voffA);
            PG8_WAIT_V(8); PG8_WAIT_L(0); PG8_BAR; PG8_MMA(0, 0, At, B0); PG8_MMA(0, 1, At, B1); PG8_BAR; PG8_SCHED;
            PG8_LDA(At, 0, 1); PG8_STAGE(PG8_SB(0, 0), b2, voffB); PG8_STAGE(PG8_SB(0, 1), b2 + hstep, voffB); PG8_STAGE(PG8_SA(0, 0), a2, voffA);
            PG8_WAIT_V(8); PG8_WAIT_L(0); PG8_BAR; PG8_MMA(1, 0, At, B0); PG8_MMA(1, 1, At, B1); PG8_BAR; PG8_SCHED;
            PG8_LDB(B0, 1, 0); PG8_LDB(B1, 1, 1); PG8_SCHED; PG8_LDA(At, 1, 0); PG8_STAGE(PG8_SA(0, 1), a2 + hstep, voffA);
            PG8_WAIT_V(8); PG8_WAIT_L(0); PG8_BAR; PG8_MMA(0, 0, At, B0); PG8_MMA(0, 1, At, B1); PG8_BAR; PG8_SCHED;
            PG8_LDA(At, 1, 1); PG8_STAGE(PG8_SB(1, 0), b3, voffB); PG8_STAGE(PG8_SB(1, 1), b3 + hstep, voffB); PG8_STAGE(PG8_SA(1, 0), a3, voffA);
            PG8_WAIT_V(8); PG8_WAIT_L(0); PG8_BAR; PG8_MMA(1, 0, At, B0); PG8_MMA(1, 1, At, B1); PG8_BAR; PG8_SCHED;
            } else {
            PG8_LDB(B0, 0, 0); PG8_SCHED; PG8_LDA(At, 0, 0); PG8_STAGE(PG8_SA(1, 1), a1 + hstep, voffA);
            PG8_WAIT_L(8); PG8_BAR; PG8_WAIT_L(0); PG8_MMA(0, 0, At, B0); PG8_BAR; PG8_SCHED;
            PG8_LDB(B1, 0, 1); PG8_STAGE(PG8_SB(0, 0), b2, voffB);
            PG8_BAR; PG8_WAIT_L(0); PG8_MMA(0, 1, At, B1); PG8_BAR;
            PG8_LDA(At, 0, 1); PG8_STAGE(PG8_SA(0, 0), a2, voffA);
            PG8_BAR; PG8_WAIT_L(0); PG8_MMA(1, 0, At, B0); PG8_BAR; PG8_SCHED;
            PG8_STAGE(PG8_SB(0, 1), b2 + hstep, voffB);
            PG8_WAIT_V(6); PG8_BAR; PG8_MMA(1, 1, At, B1); PG8_BAR;
            PG8_LDB(B0, 1, 0); PG8_SCHED; PG8_LDA(At, 1, 0); PG8_STAGE(PG8_SA(0, 1), a2 + hstep, voffA);
            PG8_WAIT_L(8); PG8_BAR; PG8_WAIT_L(0); PG8_MMA(0, 0, At, B0); PG8_BAR; PG8_SCHED;
            PG8_LDB(B1, 1, 1); PG8_STAGE(PG8_SB(1, 0), b3, voffB);
            PG8_BAR; PG8_WAIT_L(0); PG8_MMA(0, 1, At, B1); PG8_BAR;
            PG8_LDA(At, 1, 1); PG8_STAGE(PG8_SA(1, 0), a3, voffA);
            PG8_BAR; PG8_WAIT_L(0); PG8_MMA(1, 0, At, B0); PG8_BAR; PG8_SCHED;
            PG8_STAGE(PG8_SB(1, 1), b3 + hstep, voffB);
            PG8_WAIT_V(6); PG8_BAR; PG8_MMA(1, 1, At, B1); PG8_BAR;
            }
        }
        if constexpr (ALIGN_EPI) { if (wr == 0) PG8_BAR; }
        if constexpr (!Epi::AFTER_DRAIN) { E(acc, cur, wr, wc, fr, fq); S.done(cur); }
        if (!has_next) break;
#pragma unroll
        for (int a = 0; a < 2; ++a)
#pragma unroll
            for (int b = 0; b < 2; ++b)
#pragma unroll
                for (int m = 0; m < 4; ++m)
#pragma unroll
                    for (int n = 0; n < 2; ++n) acc[a][b][m][n] = (f32x4){0.f, 0.f, 0.f, 0.f};
        cur = nxt; cA = nA; cB = nB; ++ui;
        if constexpr (ALIGN_EPI) { if (wr == 1) PG8_BAR; }
    }
    PG8_WAIT_V(0);
    if constexpr (!ALIGN_EPI) { if (wr == 0) PG8_BAR; }
    PG8_BAR;
    if constexpr (Epi::AFTER_DRAIN) { E.fused(acc, cur, wr, wc, fr, fq, lds, wid, lane); S.done(cur); }
#undef PG8_SA
#undef PG8_SB
#undef PG8_STAGE
#undef PG8_LDA
#undef PG8_LDB
#undef PG8_MMA
#undef PG8_WAIT_V
#undef PG8_WAIT_L
#undef PG8_BAR
#undef PG8_SCHED
}
}

constexpr int BATCH = 16, SEQ = 2048, DM = 2048, NMETA = 16;
constexpr int TREAL = BATCH * SEQ;
constexpr int MROWS = 33024;
constexpr int META_TILE0 = 32768;
constexpr int META_ROW0 = 32816;
constexpr int NZ = 6144;
constexpr int ZQ = 0, ZK = 1024, ZV = 2048, ZMQ = 3072, ZMK = 3584, ZMV = 4096, ZMO = 5120;
constexpr int INCOLS = 6152;
constexpr float EPS = 1e-6f;
constexpr float QSCALE = 0.125f * 1.4426950408889634f;
constexpr float LAMBDA_INIT = 0.2f;

typedef unsigned short bf16_t;
typedef float f32x4 __attribute__((ext_vector_type(4)));
typedef __bf16 bf16x2_t __attribute__((ext_vector_type(2)));

constexpr size_t MiB = 1u << 20;
constexpr size_t WS_CTL = 0;
constexpr size_t WS_WIN = 1 * MiB;
constexpr size_t WS_WOUT = 25 * MiB;
constexpr size_t WS_WQ = 33 * MiB;
constexpr size_t WS_ROPE = 41 * MiB;
constexpr size_t WS_GATES = 42 * MiB;
constexpr size_t WS_SSQ = 44 * MiB;
constexpr size_t WS_IDX = 48 * MiB;
constexpr size_t WS_GATE = 64 * MiB;
constexpr size_t WS_U = 80 * MiB;
constexpr size_t WS_V = 144 * MiB;
constexpr size_t WS_HN = 208 * MiB;
constexpr size_t WS_MIX = 338 * MiB;
constexpr size_t WS_Z = 466 * MiB;
constexpr size_t WS_END = 854 * MiB;

__device__ __forceinline__ float bf_lo(unsigned w) { return __uint_as_float(w << 16); }
__device__ __forceinline__ float bf_hi(unsigned w) { return __uint_as_float(w & 0xffff0000u); }
__device__ __forceinline__ float bf2f(bf16_t v) { return __uint_as_float(((unsigned)v) << 16); }
__device__ __forceinline__ unsigned f2bf(float f) { unsigned u = __float_as_uint(f); return (u + 0x7fffu + ((u >> 16) & 1u)) >> 16; }
__device__ __forceinline__ unsigned pk2(float lo, float hi) { return f2bf(lo) | (f2bf(hi) << 16); }
__device__ __forceinline__ float dot2(unsigned a, unsigned b, float acc) { return __builtin_amdgcn_fdot2_f32_bf16(__builtin_bit_cast(bf16x2_t, a), __builtin_bit_cast(bf16x2_t, b), acc, false); }
__device__ __forceinline__ float wave_sum(float v) {
#pragma unroll
    for (int o = 1; o < 64; o <<= 1) v += __shfl_xor(v, o);
    return v;
}
__device__ __forceinline__ float wave_max(float v) {
#pragma unroll
    for (int o = 1; o < 64; o <<= 1) v = fmaxf(v, __shfl_xor(v, o));
    return v;
}
__device__ __forceinline__ int zrow_of(int b, int l) { return l < NMETA ? META_ROW0 + l : b * SEQ + (l - NMETA); }

struct EpiZ {
    static constexpr bool PERM = true, AFTER_DRAIN = false;
    bf16_t* Z; const float* rope;
    __device__ __forceinline__ void operator()(const pg8::f32x4 (&acc)[2][2][4][2], const pg8::Unit& u, int wr, int wc, int fr, int fq) const {
        const int row0 = u.pm * 256 + wr * 64 + fr, col0 = u.pn * 256 + wc * 32 + 8 * fq;
        const bool isq = u.pn < 4, isrope = u.pn < 8;
        const int j0 = 16 * (wc & 1) + 4 * fq;
#pragma unroll
        for (int ai = 0; ai < 2; ++ai)
#pragma unroll
            for (int m = 0; m < 4; ++m) {
                const int row = row0 + ai * 128 + m * 16;
                pg8::f32x4 c0 = {1.f, 0.f, 1.f, 0.f}, c1 = {1.f, 0.f, 1.f, 0.f};
                if (isrope) {
                    const int pos = row < TREAL ? (row & (SEQ - 1)) + NMETA : ((row >= META_ROW0 && row < META_ROW0 + NMETA) ? row - META_ROW0 : 0);
                    const pg8::f32x4* tp = (const pg8::f32x4*)(rope + ((size_t)pos * 32 + j0) * 2);
                    c0 = tp[0]; c1 = tp[1];
                }
                bf16_t* rowp = Z + (size_t)row * NZ + col0;
#pragma unroll
                for (int bj = 0; bj < 2; ++bj) {
                    pg8::f32x4 v0 = acc[ai][bj][m][0], v1 = acc[ai][bj][m][1];
                    if (isrope) {
                        pg8::f32x4 o0, o1;
                        o0[0] = v0[0] * c0[0] - v0[1] * c0[1]; o0[1] = v0[1] * c0[0] + v0[0] * c0[1];
                        o0[2] = v0[2] * c0[2] - v0[3] * c0[3]; o0[3] = v0[3] * c0[2] + v0[2] * c0[3];
                        o1[0] = v1[0] * c1[0] - v1[1] * c1[1]; o1[1] = v1[1] * c1[0] + v1[0] * c1[1];
                        o1[2] = v1[2] * c1[2] - v1[3] * c1[3]; o1[3] = v1[3] * c1[2] + v1[2] * c1[3];
                        v0 = o0; v1 = o1;
                        if (isq) { v0 = v0 * QSCALE; v1 = v1 * QSCALE; }
                    }
                    pg8::u32x4 w; w.x = pg8::cvt_pk_bf16(v0[0], v0[1]); w.y = pg8::cvt_pk_bf16(v0[2], v0[3]); w.z = pg8::cvt_pk_bf16(v1[0], v1[1]); w.w = pg8::cvt_pk_bf16(v1[2], v1[3]);
                    *(pg8::u32x4*)(rowp + bj * 128) = w;
                }
            }
    }
};
struct EpiX1 {
    static constexpr bool PERM = true, AFTER_DRAIN = false;
    const float* x; float* x1; bf16_t* x1w; const float* wf; float* ssq;
    __device__ __forceinline__ void operator()(const pg8::f32x4 (&acc)[2][2][4][2], const pg8::Unit& u, int wr, int wc, int fr, int fq) const {
        const int row0 = u.pm * 256 + wr * 64 + fr, col0 = u.pn * 256 + wc * 32 + 8 * fq;
        pg8::f32x4 wv[2][2];
#pragma unroll
        for (int bj = 0; bj < 2; ++bj) { wv[bj][0] = *(const pg8::f32x4*)(wf + col0 + bj * 128); wv[bj][1] = *(const pg8::f32x4*)(wf + col0 + bj * 128 + 4); }
#pragma unroll
        for (int ai = 0; ai < 2; ++ai)
#pragma unroll
            for (int m = 0; m < 4; ++m) {
                const int row = row0 + ai * 128 + m * 16; float ss = 0.f;
#pragma unroll
                for (int bj = 0; bj < 2; ++bj) {
                    const size_t off = (size_t)row * DM + col0 + bj * 128;
                    const pg8::f32x4 xa = *(const pg8::f32x4*)(x + off), xb = *(const pg8::f32x4*)(x + off + 4);
                    const pg8::f32x4 v0 = acc[ai][bj][m][0] + xa, v1 = acc[ai][bj][m][1] + xb;
                    *(pg8::f32x4*)(x1 + off) = v0; *(pg8::f32x4*)(x1 + off + 4) = v1;
                    ss += (v0[0] * v0[0] + v0[1] * v0[1]) + (v0[2] * v0[2] + v0[3] * v0[3]) + (v1[0] * v1[0] + v1[1] * v1[1]) + (v1[2] * v1[2] + v1[3] * v1[3]);
                    const pg8::f32x4 a = v0 * wv[bj][0], b = v1 * wv[bj][1];
                    pg8::u32x4 w; w.x = pg8::cvt_pk_bf16(a[0], a[1]); w.y = pg8::cvt_pk_bf16(a[2], a[3]); w.z = pg8::cvt_pk_bf16(b[0], b[1]); w.w = pg8::cvt_pk_bf16(b[2], b[3]);
                    *(pg8::u32x4*)(x1w + off) = w;
                }
                ss += __shfl_xor(ss, 16); ss += __shfl_xor(ss, 32);
                if (fq == 0) ssq[(size_t)row * 32 + u.pn * 4 + wc] = ss;
            }
    }
};

__global__ void __launch_bounds__(512, 2) k_gemm1(const bf16_t* A, const bf16_t* Bt, bf16_t* Z, const float* rope) {
    extern __shared__ __attribute__((aligned(16))) unsigned char lds[];
    pg8::Gemm g{A, Bt, MROWS, NZ, DM}; EpiZ E{Z, rope};
    pg8::StaticOrder S; S.init(g.M, g.N, (int)gridDim.x, (int)blockIdx.x);
    pg8::gemm_phase<EpiZ, pg8::StaticOrder, true, true>((PG8_LAS unsigned char*)lds, g, S, E);
}
__global__ void __launch_bounds__(512, 2) k_gemm2(const bf16_t* A, const bf16_t* Bt, const float* x, float* x1, bf16_t* x1w, const float* wf, float* ssq) {
    extern __shared__ __attribute__((aligned(16))) unsigned char lds[];
    pg8::Gemm g{A, Bt, TREAL, DM, DM}; EpiX1 E{x, x1, x1w, wf, ssq};
    pg8::StaticOrder S; S.init(g.M, g.N, (int)gridDim.x, (int)blockIdx.x);
    pg8::gemm_phase<EpiX1, pg8::StaticOrder, true, true>((PG8_LAS unsigned char*)lds, g, S, E);
}
__global__ void __launch_bounds__(512, 2) k_gemm3(const bf16_t* A, const bf16_t* Bt, bf16_t* QP) {
    extern __shared__ __attribute__((aligned(16))) unsigned char lds[];
    pg8::Gemm g{A, Bt, TREAL, DM, DM}; pg8::EpiBf16<0> E{QP, DM, nullptr, 0, 0, 1.f};
    pg8::StaticOrder S; S.init(g.M, g.N, (int)gridDim.x, (int)blockIdx.x);
    pg8::gemm_phase<pg8::EpiBf16<0>, pg8::StaticOrder, true, true>((PG8_LAS unsigned char*)lds, g, S, E);
}

__device__ __forceinline__ void transpose_item(const float* W, int ldw, int K, int N, bf16_t* WT, bool ropeperm, float* scr, int item, int lane) {
    const int nblk = N / 32, kb = item / nblk, nb = item % nblk, k0 = 64 * kb, n0 = 32 * nb;
#pragma unroll 8
    for (int i = 0; i < 32; ++i) { const int kk = 2 * i + (lane >> 5); scr[kk * 33 + (lane & 31)] = W[(size_t)(k0 + kk) * ldw + n0 + (lane & 31)]; }
    __builtin_amdgcn_s_waitcnt(0xC07F); asm volatile("" ::: "memory");
    const int c = lane & 7;
#pragma unroll
    for (int j = 0; j < 4; ++j) {
        const int n = (lane >> 3) + 8 * j; const float* s = scr + (8 * c) * 33 + n;
        uint4 o; o.x = pk2(s[0 * 33], s[1 * 33]); o.y = pk2(s[2 * 33], s[3 * 33]); o.z = pk2(s[4 * 33], s[5 * 33]); o.w = pk2(s[6 * 33], s[7 * 33]);
        int orow = n0 + n;
        if (ropeperm && n0 < 2048) orow = (n0 & ~63) + 2 * n + ((n0 >> 5) & 1);
        *(uint4*)(WT + (size_t)orow * K + k0 + 8 * c) = o;
    }
    __builtin_amdgcn_s_waitcnt(0xC07F); asm volatile("" ::: "memory");
}

struct PrepArgs {
    const float *x, *meta, *nmw, *w_in, *w_out, *w_q, *u, *v;
    bf16_t *WinT, *WoutT, *WqT, *U, *V, *HN; float *G, *rope;
};
__global__ void __launch_bounds__(512) k_prep(PrepArgs a) {
    extern __shared__ __attribute__((aligned(16))) unsigned char lds[];
    const int tid = threadIdx.x, lane = tid & 63, wave = tid >> 6;
    const int gw = blockIdx.x * 8 + wave, NGW = gridDim.x * 8;
    float* scr = (float*)lds + wave * (64 * 33);
    float* WG = (float*)(lds + 8 * 64 * 33 * 4);
    for (int i = tid; i < 8 * 2048; i += 512) { const int k = i >> 3, g = i & 7; WG[g * 2048 + k] = a.w_in[(size_t)k * INCOLS + 6144 + g]; }
    __syncthreads();
    constexpr int I_IN = 32 * 192, I_OUT = 32 * 64, I_Q = 32 * 64;
    for (int it = gw; it < I_IN + I_OUT + I_Q; it += NGW) {
        int r = it;
        if (r < I_IN) { transpose_item(a.w_in, INCOLS, 2048, 6144, a.WinT, true, scr, r, lane); continue; } r -= I_IN;
        if (r < I_OUT) { transpose_item(a.w_out, 2048, 2048, 2048, a.WoutT, false, scr, r, lane); continue; } r -= I_OUT;
        transpose_item(a.w_q, 2048, 2048, 2048, a.WqT, false, scr, r, lane);
    }
    {
        const size_t n8 = (size_t)16384 * 2048 / 8;
        for (size_t i = (size_t)blockIdx.x * 512 + tid; i < 2 * n8; i += (size_t)gridDim.x * 512) {
            const bool isu = i < n8; const size_t j = isu ? i : i - n8;
            const float4* src = (const float4*)((isu ? a.u : a.v) + j * 8);
            const float4 p = src[0], q = src[1];
            uint4 o; o.x = pk2(p.x, p.y); o.y = pk2(p.z, p.w); o.z = pk2(q.x, q.y); o.w = pk2(q.z, q.w);
            *(uint4*)((isu ? a.U : a.V) + j * 8) = o;
        }
    }
    for (int r = gw; r < MROWS; r += NGW) {
        const float* src = nullptr;
        if (r < TREAL) src = a.x + (size_t)r * DM;
        else if (r >= META_ROW0 && r < META_ROW0 + NMETA) src = a.meta + (size_t)(r - META_ROW0) * DM;
        unsigned long long* o8 = (unsigned long long*)(a.HN + (size_t)r * DM) + lane;
        if (!src) {
#pragma unroll
            for (int j = 0; j < 8; ++j) o8[64 * j] = 0ull;
            if (lane < 8) a.G[(size_t)r * 8 + lane] = 0.f;
            continue;
        }
        const float4* xr = (const float4*)src + lane;
        float4 v[8]; float ss = 0.f;
#pragma unroll
        for (int j = 0; j < 8; ++j) { v[j] = xr[64 * j]; ss += (v[j].x * v[j].x + v[j].y * v[j].y) + (v[j].z * v[j].z + v[j].w * v[j].w); }
        const float rstd = rsqrtf(wave_sum(ss) * (1.f / DM) + EPS);
        float g[8];
#pragma unroll
        for (int q = 0; q < 8; ++q) g[q] = 0.f;
#pragma unroll
        for (int j = 0; j < 8; ++j) {
            const float4 w = ((const float4*)a.nmw)[64 * j + lane];
            float4 y; y.x = v[j].x * rstd * w.x; y.y = v[j].y * rstd * w.y; y.z = v[j].z * rstd * w.z; y.w = v[j].w * rstd * w.w;
            o8[64 * j] = (unsigned long long)pk2(y.x, y.y) | ((unsigned long long)pk2(y.z, y.w) << 32);
#pragma unroll
            for (int q = 0; q < 8; ++q) { const float4 wg = ((const float4*)(WG + q * 2048))[64 * j + lane]; g[q] += (y.x * wg.x + y.y * wg.y) + (y.z * wg.z + y.w * wg.w); }
        }
#pragma unroll
        for (int q = 0; q < 8; ++q) g[q] = wave_sum(g[q]);
        if (lane == 0) {
#pragma unroll
            for (int q = 0; q < 8; ++q) a.G[(size_t)r * 8 + q] = g[q];
        }
    }
    for (int i = blockIdx.x * 512 + tid; i < (SEQ + NMETA) * 32; i += gridDim.x * 512) {
        const int pos = i >> 5, j = i & 31;
        const float inv = (float)pow(10000.0, -(double)j / 32.0);
        const float ang = (float)pos * inv;
        a.rope[2 * i] = (float)cos((double)ang); a.rope[2 * i + 1] = (float)sin((double)ang);
    }
}

__global__ void __launch_bounds__(256) k_attn_simple(const bf16_t* Z, const float* lamqk, const float* subln, bf16_t* MIX) {
    __shared__ float sc[4][2080];
    const int wave = threadIdx.x >> 6, lane = threadIdx.x & 63;
    const int gw = blockIdx.x * 4 + wave;
    const int t = gw & 2047, h = (gw >> 11) & 7, b = gw >> 14;
    const float l1 = wave_sum(lamqk[lane] * lamqk[64 + lane]), l2 = wave_sum(lamqk[128 + lane] * lamqk[192 + lane]);
    const float lam = expf(l1) - expf(l2) + LAMBDA_INIT;
    const int qrow = b * SEQ + t, nk = NMETA + t + 1;
    float oc[2][2];
    for (int c = 0; c < 2; ++c) {
        uint4 qv[8];
        const uint4* qp = (const uint4*)(Z + (size_t)qrow * NZ + ZQ + h * 128 + c * 64);
#pragma unroll
        for (int i = 0; i < 8; ++i) qv[i] = qp[i];
        float mx = -1e30f;
        for (int kk = lane; kk < nk; kk += 64) {
            const int krow = zrow_of(b, kk);
            const uint4* kp = (const uint4*)(Z + (size_t)krow * NZ + ZK + h * 128 + c * 64);
            float s = 0.f;
#pragma unroll
            for (int i = 0; i < 8; ++i) { const uint4 kv = kp[i]; s = dot2(kv.x, qv[i].x, s); s = dot2(kv.y, qv[i].y, s); s = dot2(kv.z, qv[i].z, s); s = dot2(kv.w, qv[i].w, s); }
            sc[wave][kk] = s; mx = fmaxf(mx, s);
        }
        mx = wave_max(mx);
        float l = 0.f;
        for (int kk = lane; kk < nk; kk += 64) { const float p = exp2f(sc[wave][kk] - mx); sc[wave][kk] = p; l += p; }
        l = wave_sum(l);
        __syncthreads();
        float a0 = 0.f, a1 = 0.f;
        for (int kk = 0; kk < nk; ++kk) {
            const float p = sc[wave][kk]; const int krow = zrow_of(b, kk);
            const unsigned vv = *(const unsigned*)(Z + (size_t)krow * NZ + ZV + h * 128 + 2 * lane);
            a0 += p * bf_lo(vv); a1 += p * bf_hi(vv);
        }
        oc[c][0] = a0 / l; oc[c][1] = a1 / l;
        __syncthreads();
    }
    const float o0 = oc[0][0] - lam * oc[1][0], o1 = oc[0][1] - lam * oc[1][1];
    const float r = rsqrtf(wave_sum(o0 * o0 + o1 * o1) * (1.f / 128.f) + EPS) * (1.f - LAMBDA_INIT);
    *(unsigned*)(MIX + (size_t)qrow * DM + h * 128 + 2 * lane) = pk2(o0 * r * subln[2 * lane], o1 * r * subln[2 * lane + 1]);
}

__global__ void __launch_bounds__(1024) k_mlstm_simple(const bf16_t* Z, const float* G, const float* convw, const float* convb, const float* ib, const float* fb, const float* normw, bf16_t* MIX) {
    __shared__ float qs[128], ks[128], red[4][256], qn[128], hsq[4];
    const int bh = blockIdx.x, b = bh >> 2, h = bh & 3, tid = threadIdx.x, e = tid & 255, kq = tid >> 8;
    float C[32];
#pragma unroll
    for (int i = 0; i < 32; ++i) C[i] = 0.f;
    float nn = 0.f, m = -1e30f;
    const float ibh = ib[h], fbh = fb[h];
    for (int l = 0; l < NMETA + SEQ; ++l) {
        const int row = zrow_of(b, l);
        if (tid < 256) {
            const int ch = tid < 128 ? (h * 128 + tid) : (512 + h * 128 + (tid - 128));
            float acc = convb[ch];
#pragma unroll
            for (int j = 0; j < 4; ++j) { const int ll = l - 3 + j; if (ll >= 0) acc += convw[j * 1024 + ch] * bf2f(Z[(size_t)zrow_of(b, ll) * NZ + ZMQ + ch]); }
            const float sv = acc / (1.f + expf(-acc));
            if (tid < 128) qs[tid] = sv * 0.08838834764831845f; else ks[tid - 128] = sv;
        }
        const float li = G[(size_t)row * 8 + h] + ibh; const float xf = G[(size_t)row * 8 + 4 + h] + fbh;
        const float lf = fminf(xf, 0.f) - log1pf(expf(-fabsf(xf)));
        const float mn = fmaxf(lf + m, li); const float fd = expf(lf + m - mn), iw = expf(li - mn); m = mn;
        const float v = bf2f(Z[(size_t)row * NZ + ZMV + h * 256 + e]);
        __syncthreads();
        float part = 0.f;
#pragma unroll
        for (int i = 0; i < 32; ++i) { const int k = kq * 32 + i; C[i] = fd * C[i] + iw * ks[k] * v; part += qs[k] * C[i]; }
        red[kq][e] = part;
        if (tid < 128) { nn = fd * nn + iw * ks[tid]; qn[tid] = qs[tid] * nn; }
        __syncthreads();
        float hv = 0.f;
        if (tid < 256) {
            const float num = (red[0][e] + red[1][e]) + (red[2][e] + red[3][e]);
            float nq = 0.f;
            for (int k = 0; k < 128; ++k) nq += qn[k];
            hv = num / fmaxf(fabsf(nq), expf(-m));
            const float s2 = wave_sum(hv * hv);
            if ((tid & 63) == 0) hsq[tid >> 6] = s2;
        }
        __syncthreads();
        if (tid < 256 && l >= NMETA) {
            const float r = rsqrtf(((hsq[0] + hsq[1]) + (hsq[2] + hsq[3])) * (1.f / 256.f) + EPS);
            const float zo = bf2f(Z[(size_t)row * NZ + ZMO + h * 256 + e]);
            const float outv = hv * r * normw[h * 256 + e] / (1.f + expf(-zo));
            MIX[(size_t)row * DM + 1024 + h * 256 + e] = (bf16_t)f2bf(outv);
        }
    }
}

__global__ void __launch_bounds__(256) k_route_simple(const bf16_t* QP, const float* subkeys, const float* SSQ, int* IDX, float* GATE) {
    __shared__ float qsh[4][256];
    const int wave = threadIdx.x >> 6, lane = threadIdx.x & 63;
    const int gw = blockIdx.x * 4 + wave, row = gw >> 3, h = gw & 7;
    const float NEGV = -3.0e38f;
    float ssv = lane < 32 ? SSQ[(size_t)row * 32 + lane] : 0.f; ssv = wave_sum(ssv);
    const float rstd = rsqrtf(ssv * (1.f / DM) + EPS);
    {
        const uint2 qq = *(const uint2*)(QP + (size_t)row * DM + h * 256 + 4 * lane);
        qsh[wave][4 * lane + 0] = bf_lo(qq.x) * rstd; qsh[wave][4 * lane + 1] = bf_hi(qq.x) * rstd;
        qsh[wave][4 * lane + 2] = bf_lo(qq.y) * rstd; qsh[wave][4 * lane + 3] = bf_hi(qq.y) * rstd;
    }
    __syncthreads();
    float sv[2][2];
#pragma unroll
    for (int p = 0; p < 2; ++p)
#pragma unroll
        for (int nn = 0; nn < 2; ++nn) {
            const int n = lane + 64 * nn;
            const float4* kp = (const float4*)(subkeys + ((size_t)((h * 2 + p) * 128 + n)) * 128);
            const float4* qp = (const float4*)(&qsh[wave][p * 128]);
            float s = 0.f;
#pragma unroll 8
            for (int d = 0; d < 32; ++d) { const float4 kv = kp[d], qv = qp[d]; s += (kv.x * qv.x + kv.y * qv.y) + (kv.z * qv.z + kv.w * qv.w); }
            sv[p][nn] = s;
        }
    float s12[2]; int i12[2];
#pragma unroll
    for (int p = 0; p < 2; ++p) {
        float a0 = sv[p][0], a1 = sv[p][1]; float sp = NEGV; int ip = 0;
        for (int j = 0; j < 16; ++j) {
            float bv; int bi; if (a0 >= a1) { bv = a0; bi = lane; } else { bv = a1; bi = lane + 64; }
#pragma unroll
            for (int off = 32; off >= 1; off >>= 1) { const float ov = __shfl_xor(bv, off); const int oi = __shfl_xor(bi, off); if (ov > bv || (ov == bv && oi < bi)) { bv = ov; bi = oi; } }
            if (lane == j) { sp = bv; ip = bi; }
            if (bi == lane) a0 = NEGV; else if (bi == lane + 64) a1 = NEGV;
        }
        s12[p] = sp; i12[p] = ip;
    }
    float cv[4];
#pragma unroll
    for (int q = 0; q < 4; ++q) { const int cidx = lane * 4 + q; cv[q] = __shfl(s12[0], cidx >> 4) + __shfl(s12[1], cidx & 15); }
    float bs = NEGV; int bc = 0;
    for (int j = 0; j < 16; ++j) {
        float bv = cv[0]; int bi = lane * 4;
#pragma unroll
        for (int q = 1; q < 4; ++q) if (cv[q] > bv) { bv = cv[q]; bi = lane * 4 + q; }
#pragma unroll
        for (int off = 32; off >= 1; off >>= 1) { const float ov = __shfl_xor(bv, off); const int oi = __shfl_xor(bi, off); if (ov > bv || (ov == bv && oi < bi)) { bv = ov; bi = oi; } }
        if (lane == j) { bs = bv; bc = bi; }
        if ((bi >> 2) == lane) {
#pragma unroll
            for (int q = 0; q < 4; ++q) if ((bi & 3) == q) cv[q] = NEGV;
        }
    }
    const int e1 = __shfl(i12[0], bc >> 4), e2 = __shfl(i12[1], bc & 15);
    const int idx = e1 * 128 + e2;
    const float mx = __shfl(bs, 0);
    const float ex = lane < 16 ? expf(bs - mx) : 0.f;
    const float sum = wave_sum(ex);
    if (lane < 16) { IDX[(size_t)row * 128 + h * 16 + lane] = idx; GATE[(size_t)row * 128 + h * 16 + lane] = ex / sum; }
}

__global__ void __launch_bounds__(256) k_peer(const bf16_t* X1W, const float* SSQ, const int* IDX, const float* GATE, const bf16_t* U, const bf16_t* V, float* OUT, const float* nfw) {
    const int wave = threadIdx.x >> 6, lane = threadIdx.x & 63;
    const int gw = blockIdx.x * 4 + wave, NGW = gridDim.x * 4;
    for (int row = gw; row < TREAL; row += NGW) {
        float ssv = lane < 32 ? SSQ[(size_t)row * 32 + lane] : 0.f; ssv = wave_sum(ssv);
        const float rstd = rsqrtf(ssv * (1.f / DM) + EPS);
        uint4 hx[4];
#pragma unroll
        for (int jj = 0; jj < 4; ++jj) hx[jj] = *(const uint4*)(X1W + (size_t)row * DM + 8 * lane + 512 * jj);
        float y[32];
#pragma unroll
        for (int i = 0; i < 32; ++i) y[i] = 0.f;
#pragma unroll 1
        for (int h = 0; h < 8; ++h) {
            const int myidx = IDX[(size_t)row * 128 + h * 16 + (lane >> 2)];
            const float mygate = GATE[(size_t)row * 128 + h * 16 + (lane >> 2)];
            float part[16];
#pragma unroll
            for (int j = 0; j < 16; ++j) {
                const int e = __builtin_amdgcn_readfirstlane(__shfl(myidx, 4 * j));
                const uint4* up = (const uint4*)(U + (size_t)e * DM + 8 * lane);
                float a = 0.f;
#pragma unroll
                for (int jj = 0; jj < 4; ++jj) { const uint4 w = up[64 * jj]; a = dot2(w.x, hx[jj].x, a); a = dot2(w.y, hx[jj].y, a); a = dot2(w.z, hx[jj].z, a); a = dot2(w.w, hx[jj].w, a); }
                part[j] = a;
                if ((j & 3) == 3) asm volatile("" ::: "memory");
            }
            float r8[8], r4[4], r2[2], r1;
            { const bool hi = (lane & 32) != 0;
#pragma unroll
              for (int i = 0; i < 8; ++i) { const float send = hi ? part[i] : part[i + 8]; const float recv = __shfl_xor(send, 32); r8[i] = (hi ? part[i + 8] : part[i]) + recv; } }
            { const bool hi = (lane & 16) != 0;
#pragma unroll
              for (int i = 0; i < 4; ++i) { const float send = hi ? r8[i] : r8[i + 4]; const float recv = __shfl_xor(send, 16); r4[i] = (hi ? r8[i + 4] : r8[i]) + recv; } }
            { const bool hi = (lane & 8) != 0;
#pragma unroll
              for (int i = 0; i < 2; ++i) { const float send = hi ? r4[i] : r4[i + 2]; const float recv = __shfl_xor(send, 8); r2[i] = (hi ? r4[i + 2] : r4[i]) + recv; } }
            { const bool hi = (lane & 4) != 0; const float send = hi ? r2[0] : r2[1]; const float recv = __shfl_xor(send, 4); r1 = (hi ? r2[1] : r2[0]) + recv; }
            r1 += __shfl_xor(r1, 2); r1 += __shfl_xor(r1, 1);
            const float pre = r1 * rstd;
            const float act = 0.5f * pre * (1.f + erff(pre * 0.7071067811865476f));
            const float wgt = mygate * act;
#pragma unroll
            for (int j = 0; j < 16; ++j) {
                const int e = __builtin_amdgcn_readfirstlane(__shfl(myidx, 4 * j));
                const float wj = __shfl(wgt, 4 * j);
                const uint4* vp = (const uint4*)(V + (size_t)e * DM + 8 * lane);
#pragma unroll
                for (int jj = 0; jj < 4; ++jj) {
                    const uint4 w = vp[64 * jj];
                    y[8 * jj + 0] += wj * bf_lo(w.x); y[8 * jj + 1] += wj * bf_hi(w.x); y[8 * jj + 2] += wj * bf_lo(w.y); y[8 * jj + 3] += wj * bf_hi(w.y);
                    y[8 * jj + 4] += wj * bf_lo(w.z); y[8 * jj + 5] += wj * bf_hi(w.z); y[8 * jj + 6] += wj * bf_lo(w.w); y[8 * jj + 7] += wj * bf_hi(w.w);
                }
                if ((j & 3) == 3) asm volatile("" ::: "memory");
            }
        }
        float ss = 0.f;
#pragma unroll
        for (int jj = 0; jj < 4; ++jj) {
            const float4* p = (const float4*)(OUT + (size_t)row * DM + 8 * lane + 512 * jj);
            const float4 a = p[0], b = p[1];
            y[8 * jj + 0] += a.x; y[8 * jj + 1] += a.y; y[8 * jj + 2] += a.z; y[8 * jj + 3] += a.w;
            y[8 * jj + 4] += b.x; y[8 * jj + 5] += b.y; y[8 * jj + 6] += b.z; y[8 * jj + 7] += b.w;
#pragma unroll
            for (int i = 0; i < 8; ++i) ss += y[8 * jj + i] * y[8 * jj + i];
        }
        const float r = rsqrtf(wave_sum(ss) * (1.f / DM) + EPS);
#pragma unroll
        for (int jj = 0; jj < 4; ++jj) {
            const float4* wp = (const float4*)(nfw + 8 * lane + 512 * jj);
            const float4 wa = wp[0], wb = wp[1];
            float4 oa, ob;
            oa.x = y[8 * jj + 0] * r * wa.x; oa.y = y[8 * jj + 1] * r * wa.y; oa.z = y[8 * jj + 2] * r * wa.z; oa.w = y[8 * jj + 3] * r * wa.w;
            ob.x = y[8 * jj + 4] * r * wb.x; ob.y = y[8 * jj + 5] * r * wb.y; ob.z = y[8 * jj + 6] * r * wb.z; ob.w = y[8 * jj + 7] * r * wb.w;
            float4* q = (float4*)(OUT + (size_t)row * DM + 8 * lane + 512 * jj);
            q[0] = oa; q[1] = ob;
        }
    }
}

extern "C" void kernel_launch(void* const* d_in, const int* in_sizes, int n_in, void* d_out, int out_size, void* d_ws, size_t ws_size, hipStream_t stream) {
    if (n_in != 18 || out_size != TREAL * DM || ws_size < WS_END) { fprintf(stderr, "kernel_launch: unexpected shapes n_in %d out %d ws %zu (need %zu)\n", n_in, out_size, ws_size, (size_t)WS_END); return; }
    const float* x = (const float*)d_in[0]; const float* meta = (const float*)d_in[1]; const float* nmw = (const float*)d_in[2]; const float* w_in = (const float*)d_in[3];
    const float* lamqk = (const float*)d_in[4]; const float* subln = (const float*)d_in[5]; const float* convw = (const float*)d_in[6]; const float* convb = (const float*)d_in[7];
    const float* ib = (const float*)d_in[8]; const float* fb = (const float*)d_in[9]; const float* mnw = (const float*)d_in[10]; const float* w_out = (const float*)d_in[11];
    const float* nfw_ffn = (const float*)d_in[12]; const float* w_q = (const float*)d_in[13]; const float* subkeys = (const float*)d_in[14]; const float* pu = (const float*)d_in[15];
    const float* pv = (const float*)d_in[16]; const float* nfinal = (const float*)d_in[17];
    unsigned char* ws = (unsigned char*)d_ws; float* out = (float*)d_out;
    bf16_t* WinT = (bf16_t*)(ws + WS_WIN); bf16_t* WoutT = (bf16_t*)(ws + WS_WOUT); bf16_t* WqT = (bf16_t*)(ws + WS_WQ);
    float* rope = (float*)(ws + WS_ROPE); float* G = (float*)(ws + WS_GATES); float* SSQ = (float*)(ws + WS_SSQ);
    int* IDX = (int*)(ws + WS_IDX); float* GATE = (float*)(ws + WS_GATE);
    bf16_t* U = (bf16_t*)(ws + WS_U); bf16_t* V = (bf16_t*)(ws + WS_V); bf16_t* HN = (bf16_t*)(ws + WS_HN); bf16_t* MIX = (bf16_t*)(ws + WS_MIX); bf16_t* Z = (bf16_t*)(ws + WS_Z);
    bf16_t* X1W = HN; bf16_t* QP = MIX;
    static bool attr_done = false;
    if (!attr_done) {
        (void)hipFuncSetAttribute((const void*)k_prep, hipFuncAttributeMaxDynamicSharedMemorySize, 8 * 64 * 33 * 4 + 65536);
        (void)hipFuncSetAttribute((const void*)k_gemm1, hipFuncAttributeMaxDynamicSharedMemorySize, pg8::STAGE_BYTES);
        (void)hipFuncSetAttribute((const void*)k_gemm2, hipFuncAttributeMaxDynamicSharedMemorySize, pg8::STAGE_BYTES);
        (void)hipFuncSetAttribute((const void*)k_gemm3, hipFuncAttributeMaxDynamicSharedMemorySize, pg8::STAGE_BYTES);
        attr_done = true;
    }
    PrepArgs pa{x, meta, nmw, w_in, w_out, w_q, pu, pv, WinT, WoutT, WqT, U, V, HN, G, rope};
    hipLaunchKernelGGL(k_prep, dim3(256), dim3(512), 8 * 64 * 33 * 4 + 65536, stream, pa);
    hipLaunchKernelGGL(k_gemm1, dim3(256), dim3(512), pg8::STAGE_BYTES, stream, (const bf16_t*)HN, (const bf16_t*)WinT, Z, (const float*)rope);
    hipLaunchKernelGGL(k_attn_simple, dim3(BATCH * 8 * SEQ / 4), dim3(256), 0, stream, (const bf16_t*)Z, lamqk, subln, MIX);
    hipLaunchKernelGGL(k_mlstm_simple, dim3(BATCH * 4), dim3(1024), 0, stream, (const bf16_t*)Z, (const float*)G, convw, convb, ib, fb, mnw, MIX);
    hipLaunchKernelGGL(k_gemm2, dim3(256), dim3(512), pg8::STAGE_BYTES, stream, (const bf16_t*)MIX, (const bf16_t*)WoutT, x, out, X1W, nfw_ffn, SSQ);
    hipLaunchKernelGGL(k_gemm3, dim3(256), dim3(512), pg8::STAGE_BYTES, stream, (const bf16_t*)X1W, (const bf16_t*)WqT, QP);
    hipLaunchKernelGGL(k_route_simple, dim3(TREAL * 8 / 4), dim3(256), 0, stream, (const bf16_t*)QP, subkeys, (const float*)SSQ, IDX, GATE);
    hipLaunchKernelGGL(k_peer, dim3(2048), dim3(256), 0, stream, (const bf16_t*)X1W, (const float*)SSQ, (const int*)IDX, (const float*)GATE, (const bf16_t*)U, (const bf16_t*)V, out, nfinal);
    const hipError_t le = hipPeekAtLastError();
    if (le != hipSuccess) fprintf(stderr, "kernel_launch: launch failed: %s\n", hipGetErrorName(le));
}
```

```cpp
#include <hip/hip_runtime.h>
#include <hip/hip_bf16.h>
#include <cstdio>
#include <cstdint>
#include <cmath>
namespace pg8 {
#define PG8_LAS __attribute__((address_space(3)))
typedef unsigned short bf16_t;
typedef short bf16x8 __attribute__((ext_vector_type(8)));
typedef float f32x4 __attribute__((ext_vector_type(4)));
typedef unsigned u32x4 __attribute__((ext_vector_type(4)));
constexpr int BM = 256, BK = 64, HALF = 128, HTB = HALF * BK * 2  , STAGE_BYTES = 8 * HTB, NXCD = 8, WGM = 8;

__host__ __device__ __forceinline__ int lds_byte(int r, int c) { const int st = (r >> 4) * 2 + (c >> 5), rr = r & 15, cc = c & 31, ob = rr * 64 + cc * 2; return st * 1024 + (ob ^ (((ob >> 9) & 1) << 5)); }
__host__ __device__ __forceinline__ void stage_rc(int b, int& R, int& C) { const int st = b / 1024, sb = b % 1024, swz = sb ^ (((sb >> 9) & 1) << 5); R = (st >> 1) * 16 + swz / 64; C = (st & 1) * 32 + (swz % 64) / 2; }
__host__ __device__ __forceinline__ int perm32(int rho) { const int n = rho >> 4, i = rho & 15; return 8 * (i >> 2) + 4 * n + (i & 3); }

struct Unit { int pm, pn; };
struct Gemm { const bf16_t* A; const bf16_t* Bt; int M, N, K; };

struct StaticOrder {
    int nM, nN, nwg, G, c;
    __host__ __device__ void init(int M, int N, int G_, int c_) { nM = M / BM; nN = N / BM; nwg = nM * nN; G = G_; c = c_; }
    __host__ __device__ bool next(int i, Unit& u) const {
        const long L = (long)i * G + c; if (L >= nwg) return false;
        int wgid = (int)L; { const int q = nwg / NXCD, r = nwg % NXCD, xcd = wgid % NXCD, off = wgid / NXCD; wgid = (xcd < r ? xcd * (q + 1) : r * (q + 1) + (xcd - r) * q) + off; }
        const int nig = WGM * nN, gid = wgid / nig, fm = gid * WGM, gsz = (nM - fm) < WGM ? (nM - fm) : WGM;
        u.pm = fm + ((wgid % nig) % gsz); u.pn = (wgid % nig) / gsz; return true;
    }
    __device__ __forceinline__ void a_ready(const Unit&) const {}
    __device__ __forceinline__ void done(const Unit&) const {}
};

__device__ __forceinline__ unsigned cvt_pk_bf16(float lo, float hi) { unsigned r; asm volatile("v_cvt_pk_bf16_f32 %0, %1, %2" : "=v"(r) : "v"(lo), "v"(hi)); return r; }
typedef float f32x2 __attribute__((ext_vector_type(2)));
__device__ __forceinline__ f32x2 gelu_pk(f32x2 v) {
    const f32x2 av = __builtin_elementwise_abs(v), d = av * 0.2316418882f + 1.0f;
    f32x2 t; t.x = __builtin_amdgcn_rcpf(d.x); t.y = __builtin_amdgcn_rcpf(d.y);
    f32x2 q = t * 0.5307027145f + (-0.7265760135f); q = q * t + 0.7107068705f; q = q * t + (-0.142248368f); q = q * t + 0.127414796f; q = q * t;
    const f32x2 s = (v * v) * (-0.72134752044f);
    f32x2 e; e.x = __builtin_amdgcn_exp2f(s.x); e.y = __builtin_amdgcn_exp2f(s.y);
    const f32x2 m = v * (q * e), r = v - m;
    f32x2 o; o.x = v.x < 0.f ? m.x : r.x; o.y = v.y < 0.f ? m.y : r.y; return o;
}

template <int ACT  > struct EpiBf16 {
    static constexpr bool PERM = true, AFTER_DRAIN = false; static_assert(ACT == 0 || ACT == 1, "EpiBf16: ACT is 0 (none) or 1 (gelu_pk)");
    bf16_t* O; int ldc; const float* bias; int split_cols; size_t split_stride; float scale0;
    __device__ __forceinline__ void operator()(const f32x4 (&acc)[2][2][4][2], const Unit& u, int wr, int wc, int fr, int fq) const {
        const int row0 = u.pm * BM + wr * 64 + fr; int colt = u.pn * BM; bf16_t* base = O;
        float sc = 1.f; if (split_cols) { const int t = colt / split_cols; base += (size_t)t * split_stride; colt -= t * split_cols; if (t == 0) sc = scale0; }
        const int col0 = colt + wc * 32 + 8 * fq, bcol0 = u.pn * BM + wc * 32 + 8 * fq;
        f32x4 bv[2][2];
#pragma unroll
        for (int bj = 0; bj < 2; ++bj)
#pragma unroll
            for (int n = 0; n < 2; ++n) bv[bj][n] = bias ? *(const f32x4*)(bias + bcol0 + bj * HALF + 4 * n) : (f32x4){0.f, 0.f, 0.f, 0.f};
#pragma unroll
        for (int ai = 0; ai < 2; ++ai)
#pragma unroll
            for (int m = 0; m < 4; ++m) { bf16_t* rowp = base + (size_t)(row0 + ai * HALF + m * 16) * ldc + col0;
#pragma unroll
                for (int bj = 0; bj < 2; ++bj) { f32x4 v0 = acc[ai][bj][m][0] + bv[bj][0], v1 = acc[ai][bj][m][1] + bv[bj][1];
                    if (ACT == 1) { f32x2 a = gelu_pk((f32x2){v0[0], v0[1]}), b = gelu_pk((f32x2){v0[2], v0[3]}), c = gelu_pk((f32x2){v1[0], v1[1]}), d = gelu_pk((f32x2){v1[2], v1[3]});
                        v0 = (f32x4){a.x, a.y, b.x, b.y}; v1 = (f32x4){c.x, c.y, d.x, d.y}; }
                    v0 = v0 * sc; v1 = v1 * sc; u32x4 w; w.x = cvt_pk_bf16(v0[0], v0[1]); w.y = cvt_pk_bf16(v0[2], v0[3]); w.z = cvt_pk_bf16(v1[0], v1[1]); w.w = cvt_pk_bf16(v1[2], v1[3]);
                    *(u32x4*)(rowp + bj * HALF) = w; } }
    }
};
template <class Epi, class Sched, bool ALIGN_EPI = false, bool SP2 = false>
__device__ __forceinline__ void gemm_phase(PG8_LAS unsigned char* lds, const Gemm g, const Sched& S, const Epi& E) {
    int tid_ = threadIdx.x; asm volatile("" : "+v"(tid_));
    const int tid = tid_, wid = __builtin_amdgcn_readfirstlane(tid >> 6), lane = tid & 63, wr = wid >> 2, wc = wid & 3, fr = lane & 15, fq = lane >> 4;
    const int K = g.K, nt = K / BK;
    unsigned voffA[2], voffB[2];
#pragma unroll
    for (int i = 0; i < 2; ++i) { int R, C; stage_rc(tid * 16 + i * 8192, R, C); const int Rb = Epi::PERM ? ((R & ~31) + perm32(R & 31)) : R;
        voffA[i] = (unsigned)(R * K + C) * 2u; voffB[i] = (unsigned)(Rb * K + C) * 2u; }
    const size_t kstep = (size_t)(BK * 2);
    const size_t hstep = (size_t)HALF * K * 2;
    const size_t tstep = 2 * hstep;
    const unsigned ldsw = (unsigned)wid * 1024u;
    const int aoff = lds_byte(wr * 64 + fr, fq * 8), boff = lds_byte(wc * 32 + fr, fq * 8);
#define PG8_SA(b, h) (((b) * 2 + (h)) * HTB)
#define PG8_SB(b, h) ((4 + (b) * 2 + (h)) * HTB)
#define PG8_STAGE(bufoff, gbase, voff) do { _Pragma("unroll") for (int _i = 0; _i < 2; ++_i) \
        __builtin_amdgcn_global_load_lds((const unsigned*)((const char*)(gbase) + (voff)[_i]), (PG8_LAS unsigned*)(lds + (bufoff) + ldsw + _i * 8192), 16, 0, 0); } while (0)
#define PG8_LDA(dst, b, h) do { _Pragma("unroll") for (int m = 0; m < 4; ++m) _Pragma("unroll") for (int k = 0; k < 2; ++k) dst[m][k] = *(const PG8_LAS bf16x8*)(lds + PG8_SA(b, h) + aoff + m * 2048 + k * 1024); } while (0)
#define PG8_LDB(dst, b, h) do { _Pragma("unroll") for (int n = 0; n < 2; ++n) _Pragma("unroll") for (int k = 0; k < 2; ++k) dst[n][k] = *(const PG8_LAS bf16x8*)(lds + PG8_SB(b, h) + boff + n * 2048 + k * 1024); } while (0)
#define PG8_MMA(ai, bj, At, Bt) do { __builtin_amdgcn_s_setprio(1); _Pragma("unroll") for (int m = 0; m < 4; ++m) _Pragma("unroll") for (int n = 0; n < 2; ++n) _Pragma("unroll") for (int k = 0; k < 2; ++k) \
        acc[ai][bj][m][n] = __builtin_amdgcn_mfma_f32_16x16x32_bf16(Bt[n][k], At[m][k], acc[ai][bj][m][n], 0, 0, 0); __builtin_amdgcn_s_setprio(0); } while (0)
#define PG8_WAIT_V(n) asm volatile("s_waitcnt vmcnt(" #n ")" ::: "memory")
#define PG8_WAIT_L(n) asm volatile("s_waitcnt lgkmcnt(" #n ")" ::: "memory")
#define PG8_BAR __builtin_amdgcn_s_barrier()
#define PG8_SCHED __builtin_amdgcn_sched_barrier(0)
    Unit cur, nxt; int ui = 0;
    if (!S.next(0, cur)) return;
    f32x4 acc[2][2][4][2];
#pragma unroll
    for (int a = 0; a < 2; ++a)
#pragma unroll
        for (int b = 0; b < 2; ++b)
#pragma unroll
            for (int m = 0; m < 4; ++m)
#pragma unroll
                for (int n = 0; n < 2; ++n) acc[a][b][m][n] = (f32x4){0.f, 0.f, 0.f, 0.f};
    bf16x8 At[4][2], B0[2][2], B1[2][2];
    const char* cA = (const char*)g.A + (size_t)cur.pm * tstep; const char* cB = (const char*)g.Bt + (size_t)cur.pn * tstep;
    S.a_ready(cur);
    if constexpr (SP2) {
        PG8_STAGE(PG8_SB(0, 0), cB, voffB); PG8_STAGE(PG8_SB(0, 1), cB + hstep, voffB); PG8_STAGE(PG8_SA(0, 0), cA, voffA); PG8_STAGE(PG8_SA(0, 1), cA + hstep, voffA);
        if (wr == 1) PG8_BAR;
        PG8_WAIT_V(2); PG8_BAR;
        PG8_STAGE(PG8_SB(1, 0), cB + kstep, voffB); PG8_STAGE(PG8_SA(1, 0), cA + kstep, voffA); PG8_STAGE(PG8_SB(1, 1), cB + hstep + kstep, voffB);
        PG8_WAIT_V(6); PG8_BAR;
    } else {
        PG8_STAGE(PG8_SB(0, 0), cB, voffB); PG8_STAGE(PG8_SA(0, 0), cA, voffA); PG8_STAGE(PG8_SB(0, 1), cB + hstep, voffB); PG8_STAGE(PG8_SA(0, 1), cA + hstep, voffA);
        if (wr == 1) PG8_BAR;
        PG8_WAIT_V(4); PG8_BAR;
        PG8_STAGE(PG8_SB(1, 0), cB + kstep, voffB); PG8_STAGE(PG8_SA(1, 0), cA + kstep, voffA); PG8_STAGE(PG8_SB(1, 1), cB + hstep + kstep, voffB);
        PG8_WAIT_V(6); PG8_BAR;
    }
    for (;;) {
        const bool has_next = S.next(ui + 1, nxt);
        const char* nA = has_next ? (const char*)g.A + (size_t)nxt.pm * tstep : cA; const char* nB = has_next ? (const char*)g.Bt + (size_t)nxt.pn * tstep : cB;
        for (int t = 0; t < nt; t += 2) {
            const bool last = (t == nt - 2);
            const char* a1 = cA + (size_t)(t + 1) * kstep;
            const char* a2 = last ? nA : cA + (size_t)(t + 2) * kstep; const char* b2 = last ? nB : cB + (size_t)(t + 2) * kstep;
            const char* a3 = a2 + kstep; const char* b3 = b2 + kstep;
            if (last && has_next) S.a_ready(nxt);
            if constexpr (SP2) {
            PG8_LDB(B0, 0, 0); PG8_LDB(B1, 0, 1); PG8_SCHED; PG8_LDA(At, 0, 0); PG8_STAGE(PG8_SA(1, 1), a1 + hstep, voffA);
            PG8_WAIT_V(8); PG8_WAIT_L(0); PG8_BAR; PG8_MMA(0, 0, At, B0); PG8_MMA(0, 1, At, B1); PG8_BAR; PG8_SCHED;
            PG8_LDA(At, 0, 1); PG8_STAGE(PG8_SB(0, 0), b2, voffB); PG8_STAGE(PG8_SB(0, 1), b2 + hstep, voffB); PG8_STAGE(PG8_SA(0, 0), a2, voffA);
            PG8_WAIT_V(8); PG8_WAIT_L(0); PG8_BAR; PG8_MMA(1, 0, At, B0); PG8_MMA(1, 1, At, B1); PG8_BAR; PG8_SCHED;
            PG8_LDB(B0, 1, 0); PG8_LDB(B1, 1, 1); PG8_SCHED; PG8_LDA(At, 1, 0); PG8_STAGE(PG8_SA(0, 1), a2 + hstep, voffA);
            PG8_WAIT_V(8); PG8_WAIT_L(0); PG8_BAR; PG8_MMA(0, 0, At, B0); PG8_MMA(0, 1, At, B1); PG8_BAR; PG8_SCHED;
            PG8_LDA(At, 1, 1); PG8_STAGE(PG8_SB(1, 0), b3, voffB); PG8_STAGE(PG8_SB(1, 1), b3 + hstep, voffB); PG8_STAGE(PG8_SA(1, 0), a3, voffA);
            PG8_WAIT_V(8); PG8_WAIT_L(0); PG8_BAR; PG8_MMA(1, 0, At, B0); PG8_MMA(1, 1, At, B1); PG8_BAR; PG8_SCHED;
            } else {
            PG8_LDB(B0, 0, 0); PG8_SCHED; PG8_LDA(At, 0, 0); PG8_STAGE(PG8_SA(1, 1), a1 + hstep, voffA);
            PG8_WAIT_L(8); PG8_BAR; PG8_WAIT_L(0); PG8_MMA(0, 0, At, B0); PG8_BAR; PG8_SCHED;
            PG8_LDB(B1, 0, 1); PG8_STAGE(PG8_SB(0, 0), b2, voffB);
            PG8_BAR; PG8_WAIT_L(0); PG8_MMA(0, 1, At, B1); PG8_BAR;
            PG8_LDA(At, 0, 1); PG8_STAGE(PG8_SA(0, 0), a2, voffA);
            PG8_BAR; PG8_WAIT_L(0); PG8_MMA(1, 0, At, B0); PG8_BAR; PG8_SCHED;
            PG8_STAGE(PG8_SB(0, 1), b2 + hstep, voffB);
            PG8_WAIT_V(6); PG8_BAR; PG8_MMA(1, 1, At, B1); PG8_BAR;
            PG8_LDB(B0, 1, 0); PG8_SCHED; PG8_LDA(At, 1, 0); PG8_STAGE(PG8_SA(0, 1), a2 + hstep, voffA);
            PG8_WAIT_L(8); PG8_BAR; PG8_WAIT_L(0); PG8_MMA(0, 0, At, B0); PG8_BAR; PG8_SCHED;
            PG8_LDB(B1, 1, 1); PG8_STAGE(PG8_SB(1, 0), b3, voffB);
            PG8_BAR; PG8_WAIT_L(0); PG8_MMA(0, 1, At, B1); PG8_BAR;
            PG8_LDA(At, 1, 1); PG8_STAGE(PG8_SA(1, 0), a3, voffA);
            PG8_BAR; PG8_WAIT_L(0); PG8_MMA(1, 0, At, B0); PG8_BAR; PG8_SCHED;
            PG8_STAGE(PG8_SB(1, 1), b3 + hstep, voffB);
            PG8_WAIT_V(6); PG8_BAR; PG8_MMA(1, 1, At, B1); PG8_BAR;
            }
        }
        if constexpr (ALIGN_EPI) { if (wr == 0) PG8_BAR; }
        if constexpr (!Epi::AFTER_DRAIN) { E(acc, cur, wr, wc, fr, fq); S.done(cur); }
        if (!has_next) break;
#pragma unroll
        for (int a = 0; a < 2; ++a)
#pragma unroll
            for (int b = 0; b < 2; ++b)
#pragma unroll
                for (int m = 0; m < 4; ++m)
#pragma unroll
                    for (int n = 0; n < 2; ++n) acc[a][b][m][n] = (f32x4){0.f, 0.f, 0.f, 0.f};
        cur = nxt; cA = nA; cB = nB; ++ui;
        if constexpr (ALIGN_EPI) { if (wr == 1) PG8_BAR; }
    }
    PG8_WAIT_V(0);
    if constexpr (!ALIGN_EPI) { if (wr == 0) PG8_BAR; }
    PG8_BAR;
    if constexpr (Epi::AFTER_DRAIN) { E.fused(acc, cur, wr, wc, fr, fq, lds, wid, lane); S.done(cur); }
#undef PG8_SA
#undef PG8_SB
#undef PG8_STAGE
#undef PG8_LDA
#undef PG8_LDB
#undef PG8_MMA
#undef PG8_WAIT_V
#undef PG8_WAIT_L
#undef PG8_BAR
#undef PG8_SCHED
}
}

constexpr int BATCH = 16, SEQ = 2048, DM = 2048, NMETA = 16;
constexpr int TREAL = BATCH * SEQ;
constexpr int MROWS = 33024;
constexpr int META_TILE0 = 32768;
constexpr int META_ROW0 = 32816;
constexpr int NZ = 6144;
constexpr int ZQ = 0, ZK = 1024, ZV = 2048, ZMQ = 3072, ZMK = 3584, ZMV = 4096, ZMO = 5120;
constexpr int INCOLS = 6152;
constexpr float EPS = 1e-6f;
constexpr float QSCALE = 0.125f * 1.4426950408889634f;
constexpr float LAMBDA_INIT = 0.2f;

typedef unsigned short bf16_t;
typedef float f32x4 __attribute__((ext_vector_type(4)));
typedef __bf16 bf16x2_t __attribute__((ext_vector_type(2)));

constexpr size_t MiB = 1u << 20;
constexpr size_t WS_CTL = 0;
constexpr size_t WS_ISC = 655360;
constexpr size_t WS_SKB = 65536;
constexpr size_t WS_WIN = 1 * MiB;
constexpr size_t WS_WOUT = 25 * MiB;
constexpr size_t WS_WQ = 33 * MiB;
constexpr size_t WS_ROPE = 41 * MiB;
constexpr size_t WS_GATES = 42 * MiB;
constexpr size_t WS_SSQ = 44 * MiB;
constexpr size_t WS_IDX = 48 * MiB;
constexpr size_t WS_GATE = 64 * MiB;
constexpr size_t WS_U = 80 * MiB;
constexpr size_t WS_V = 144 * MiB;
constexpr size_t WS_HN = 208 * MiB;
constexpr size_t WS_MIX = 338 * MiB;
constexpr size_t WS_Z = 466 * MiB;
constexpr size_t WS_END = 854 * MiB;

__device__ __forceinline__ float bf_lo(unsigned w) { return __uint_as_float(w << 16); }
__device__ __forceinline__ float bf_hi(unsigned w) { return __uint_as_float(w & 0xffff0000u); }
__device__ __forceinline__ float bf2f(bf16_t v) { return __uint_as_float(((unsigned)v) << 16); }
__device__ __forceinline__ unsigned f2bf(float f) { unsigned r; asm("v_cvt_pk_bf16_f32 %0, %1, 0" : "=v"(r) : "v"(f)); return r; }
__device__ __forceinline__ unsigned pk2(float lo, float hi) { unsigned r; asm("v_cvt_pk_bf16_f32 %0, %1, %2" : "=v"(r) : "v"(lo), "v"(hi)); return r; }
__device__ __forceinline__ float dot2(unsigned a, unsigned b, float acc) { return __builtin_amdgcn_fdot2_f32_bf16(__builtin_bit_cast(bf16x2_t, a), __builtin_bit_cast(bf16x2_t, b), acc, false); }
__device__ __forceinline__ float wave_sum(float v) {
#pragma unroll
    for (int o = 1; o < 64; o <<= 1) v += __shfl_xor(v, o);
    return v;
}
__device__ __forceinline__ float wave_max(float v) {
#pragma unroll
    for (int o = 1; o < 64; o <<= 1) v = fmaxf(v, __shfl_xor(v, o));
    return v;
}
__device__ __forceinline__ int zrow_of(int b, int l) { return l < NMETA ? META_ROW0 + l : b * SEQ + (l - NMETA); }

struct EpiZ {
    static constexpr bool PERM = true, AFTER_DRAIN = false;
    bf16_t* Z; const float* rope;
    __device__ __forceinline__ void operator()(const pg8::f32x4 (&acc)[2][2][4][2], const pg8::Unit& u, int wr, int wc, int fr, int fq) const {
        const int row0 = u.pm * 256 + wr * 64 + fr, col0 = u.pn * 256 + wc * 32 + 8 * fq;
        const bool isq = u.pn < 4, isrope = u.pn < 8;
        const int j0 = 16 * (wc & 1) + 4 * fq;
#pragma unroll
        for (int ai = 0; ai < 2; ++ai)
#pragma unroll
            for (int m = 0; m < 4; ++m) {
                const int row = row0 + ai * 128 + m * 16;
                pg8::f32x4 c0 = {1.f, 0.f, 1.f, 0.f}, c1 = {1.f, 0.f, 1.f, 0.f};
                if (isrope) {
                    const int pos = row < TREAL ? (row & (SEQ - 1)) + NMETA : ((row >= META_ROW0 && row < META_ROW0 + NMETA) ? row - META_ROW0 : 0);
                    const pg8::f32x4* tp = (const pg8::f32x4*)(rope + ((size_t)pos * 32 + j0) * 2);
                    c0 = tp[0]; c1 = tp[1];
                }
                bf16_t* rowp = Z + (size_t)row * NZ + col0;
#pragma unroll
                for (int bj = 0; bj < 2; ++bj) {
                    pg8::f32x4 v0 = acc[ai][bj][m][0], v1 = acc[ai][bj][m][1];
                    if (isrope) {
                        pg8::f32x4 o0, o1;
                        o0[0] = v0[0] * c0[0] - v0[1] * c0[1]; o0[1] = v0[1] * c0[0] + v0[0] * c0[1];
                        o0[2] = v0[2] * c0[2] - v0[3] * c0[3]; o0[3] = v0[3] * c0[2] + v0[2] * c0[3];
                        o1[0] = v1[0] * c1[0] - v1[1] * c1[1]; o1[1] = v1[1] * c1[0] + v1[0] * c1[1];
                        o1[2] = v1[2] * c1[2] - v1[3] * c1[3]; o1[3] = v1[3] * c1[2] + v1[2] * c1[3];
                        v0 = o0; v1 = o1;
                        if (isq) { v0 = v0 * QSCALE; v1 = v1 * QSCALE; }
                    }
                    pg8::u32x4 w; w.x = pg8::cvt_pk_bf16(v0[0], v0[1]); w.y = pg8::cvt_pk_bf16(v0[2], v0[3]); w.z = pg8::cvt_pk_bf16(v1[0], v1[1]); w.w = pg8::cvt_pk_bf16(v1[2], v1[3]);
                    *(pg8::u32x4*)(rowp + bj * 128) = w;
                }
            }
    }
};
struct EpiX1 {
    static constexpr bool PERM = true, AFTER_DRAIN = false;
    const float* x; bf16_t* x1b; float* ssq;
    __device__ __forceinline__ void loadr(pg8::f32x4 (&xb)[2][2], int row0, int col0, int i) const {
#pragma unroll
        for (int bj = 0; bj < 2; ++bj) {
            const size_t off = (size_t)(row0 + (i >> 2) * 128 + (i & 3) * 16) * DM + col0 + bj * 128;
            xb[bj][0] = *(const pg8::f32x4*)(x + off); xb[bj][1] = *(const pg8::f32x4*)(x + off + 4);
        }
    }
    __device__ __forceinline__ void procr(const pg8::f32x4 (&acc)[2][2][4][2], const pg8::f32x4 (&xb)[2][2], int row0, int col0, int i, int pn, int wc, int fq) const {
        const int ai = i >> 2, m = i & 3;
        const int row = row0 + ai * 128 + m * 16; float ss = 0.f;
#pragma unroll
        for (int bj = 0; bj < 2; ++bj) {
            const size_t off = (size_t)row * DM + col0 + bj * 128;
            const pg8::f32x4 v0 = acc[ai][bj][m][0] + xb[bj][0], v1 = acc[ai][bj][m][1] + xb[bj][1];
            ss += (v0[0] * v0[0] + v0[1] * v0[1]) + (v0[2] * v0[2] + v0[3] * v0[3]) + (v1[0] * v1[0] + v1[1] * v1[1]) + (v1[2] * v1[2] + v1[3] * v1[3]);
            pg8::u32x4 w; w.x = pg8::cvt_pk_bf16(v0[0], v0[1]); w.y = pg8::cvt_pk_bf16(v0[2], v0[3]); w.z = pg8::cvt_pk_bf16(v1[0], v1[1]); w.w = pg8::cvt_pk_bf16(v1[2], v1[3]);
            *(pg8::u32x4*)(x1b + off) = w;
        }
        ss += __shfl_xor(ss, 16); ss += __shfl_xor(ss, 32);
        if (fq == 0) ssq[(size_t)row * 32 + pn * 4 + wc] = ss;
    }
    __device__ __forceinline__ void operator()(const pg8::f32x4 (&acc)[2][2][4][2], const pg8::Unit& u, int wr, int wc, int fr, int fq) const {
        const int row0 = u.pm * 256 + wr * 64 + fr, col0 = u.pn * 256 + wc * 32 + 8 * fq;
        pg8::f32x4 b0[2][2], b1[2][2], b2[2][2];
        loadr(b0, row0, col0, 0); loadr(b1, row0, col0, 1); loadr(b2, row0, col0, 2);
        procr(acc, b0, row0, col0, 0, u.pn, wc, fq); loadr(b0, row0, col0, 3);
        procr(acc, b1, row0, col0, 1, u.pn, wc, fq); loadr(b1, row0, col0, 4);
        procr(acc, b2, row0, col0, 2, u.pn, wc, fq); loadr(b2, row0, col0, 5);
        procr(acc, b0, row0, col0, 3, u.pn, wc, fq); loadr(b0, row0, col0, 6);
        procr(acc, b1, row0, col0, 4, u.pn, wc, fq); loadr(b1, row0, col0, 7);
        procr(acc, b2, row0, col0, 5, u.pn, wc, fq);
        procr(acc, b0, row0, col0, 6, u.pn, wc, fq);
        procr(acc, b1, row0, col0, 7, u.pn, wc, fq);
    }
};


#include <hip/hip_cooperative_groups.h>
namespace cg = cooperative_groups;

constexpr int NWAVES = 8, NTHREADS = 512;
constexpr size_t WS_X1Q = WS_Z + 300 * MiB, WS_XSC = WS_Z + 370 * MiB;
__device__ __forceinline__ int opaque_tid() { int t = threadIdx.x; asm volatile("" : "+v"(t)); return t; }
constexpr int LDS_BYTES = 163840;

struct Args {
    const float *x, *meta, *nmw, *w_in, *lamqk, *subln, *convw, *convb, *ib, *fb, *mnw, *w_out, *nfw_ffn, *w_q, *subkeys, *pu, *pv, *nfinal;
    float* out; unsigned char* ws;
};

#define LAS __attribute__((address_space(3)))
#define XB_TMO      128
#define XB_XCNT(j)  (256  + 64 * (j))
#define XB_XSUB(j)  (1280 + 64 * (j))
#define XB_XGEN(j)  (2304 + 64 * (j))
#define XB_TOP      3328
#define XB_TOPGEN   3392
#define XCD_BAR_WORDS 3456
#define XB_SPIN_CAP (1u << 18)

__device__ __forceinline__ unsigned xb_ld(unsigned* p)              { return __hip_atomic_load(p, __ATOMIC_RELAXED, __HIP_MEMORY_SCOPE_AGENT); }
__device__ __forceinline__ unsigned xb_add(unsigned* p, unsigned v) { return __hip_atomic_fetch_add(p, v, __ATOMIC_RELAXED, __HIP_MEMORY_SCOPE_AGENT); }
__device__ __forceinline__ unsigned xb_xcc_id() { return (unsigned)__builtin_amdgcn_s_getreg((3 << 11) | 20) & 0xFu; }
#define XB_SPIN(cond, bar) do { unsigned _sp = 0; while (cond) { __builtin_amdgcn_s_sleep(1); \
    if ((++_sp & 255u) == 0u) { if (xb_ld(&(bar)[XB_TMO])) break; if (_sp > XB_SPIN_CAP) { atomicAdd(&(bar)[XB_TMO], 1u); break; } } } } while (0)

struct XcdBarrier {
    unsigned* bar; unsigned x;
    volatile LAS unsigned* st;
};

__device__ __forceinline__ XcdBarrier xcd_barrier_post(unsigned* bar, volatile LAS unsigned* st) {
    XcdBarrier b; b.bar = bar; b.x = xb_xcc_id(); b.st = st;
    if (threadIdx.x == 0) (void)xb_add(&bar[XB_XCNT(b.x)], 1u);
    return b;
}
__device__ __forceinline__ void xcd_barrier_complete(unsigned* bar, unsigned x, unsigned& nloc, unsigned& nx) {
    const unsigned G = gridDim.x * gridDim.y * gridDim.z;
    unsigned sum, cnt, mine, sp = 0u;
    for (;;) {
        sum = 0u; cnt = 0u; mine = 0u;
#pragma unroll
        for (unsigned j = 0; j < 16; ++j) { const unsigned c = xb_ld(&bar[XB_XCNT(j)]); sum += c; cnt += (c > 0u) ? 1u : 0u; mine = (j == x) ? c : mine; }
        if (sum == G) break;
        __builtin_amdgcn_s_sleep(1);
        if ((++sp & 255u) == 0u) { if (xb_ld(&bar[XB_TMO])) break; if (sp > XB_SPIN_CAP) { atomicAdd(&bar[XB_TMO], 1u); break; } }
    }
    nloc = mine > 0u ? mine : 1u; nx = cnt > 0u ? cnt : 1u;
}

__device__ __forceinline__ void xcd_barrier(const XcdBarrier& b) {
    asm volatile("s_waitcnt vmcnt(0)" ::: "memory");
    __syncthreads();
    if (threadIdx.x == 0) {
        unsigned* bar = b.bar;
        __builtin_amdgcn_s_waitcnt(0);
        unsigned nloc = b.st[0], nx = b.st[1];
        if (nloc == 0u) { xcd_barrier_complete(bar, b.x, nloc, nx); b.st[0] = nloc; b.st[1] = nx; }
        const unsigned old = xb_add(&bar[XB_XSUB(b.x)], 1u);
        const unsigned gen = old / nloc;
        if (old + 1u == (gen + 1u) * nloc) {
            __builtin_amdgcn_fence(__ATOMIC_RELEASE, "agent");
            asm volatile("s_waitcnt vmcnt(0)" ::: "memory");
            const unsigned og = xb_add(&bar[XB_TOP], 1u);
            const unsigned tg = og / nx;
            if (og + 1u == (tg + 1u) * nx) xb_add(&bar[XB_TOPGEN], 1u);
            else XB_SPIN(xb_ld(&bar[XB_TOPGEN]) == tg, bar);
            __builtin_amdgcn_fence(__ATOMIC_ACQUIRE, "agent");
            xb_add(&bar[XB_XGEN(b.x)], 1u);
            asm volatile("s_waitcnt vmcnt(0)" ::: "memory");
        } else {
            XB_SPIN(xb_ld(&bar[XB_XGEN(b.x)]) == gen, bar);
            __builtin_amdgcn_fence(__ATOMIC_ACQUIRE, "agent");
            asm volatile("s_waitcnt vmcnt(0)" ::: "memory");
        }
    }
    __syncthreads();
}

constexpr int CW_BAR = 0, CW_QUEUE = 4096;
constexpr int LDS_MISC = LDS_BYTES - 256;
__device__ __forceinline__ int next_item(unsigned* ctr, volatile LAS unsigned* slot) {
    __syncthreads();
    if (threadIdx.x == 0) *slot = __hip_atomic_fetch_add(ctr, 1u, __ATOMIC_RELAXED, __HIP_MEMORY_SCOPE_AGENT);
    __syncthreads();
    return (int)*slot;
}

__device__ __forceinline__ void transpose_item(const float* W, int ldw, int K, int N, bf16_t* WT, bool ropeperm, float* scr, int item, int lane, const float* kscale = nullptr) {
    const int nblk = N / 32, kb = item / nblk, nb = item % nblk, k0 = 64 * kb, n0 = 32 * nb;
#pragma unroll 8
    for (int i = 0; i < 32; ++i) { const int kk = 2 * i + (lane >> 5); scr[kk * 33 + (lane & 31)] = W[(size_t)(k0 + kk) * ldw + n0 + (lane & 31)] * (kscale ? kscale[k0 + kk] : 1.f); }
    __builtin_amdgcn_s_waitcnt(0xC07F); asm volatile("" ::: "memory");
    const int c = lane & 7;
#pragma unroll
    for (int j = 0; j < 4; ++j) {
        const int n = (lane >> 3) + 8 * j; const float* s = scr + (8 * c) * 33 + n;
        uint4 o; o.x = pk2(s[0 * 33], s[1 * 33]); o.y = pk2(s[2 * 33], s[3 * 33]); o.z = pk2(s[4 * 33], s[5 * 33]); o.w = pk2(s[6 * 33], s[7 * 33]);
        int orow = n0 + n;
        if (ropeperm && n0 < 2048) orow = (n0 & ~63) + 2 * n + ((n0 >> 5) & 1);
        *(uint4*)(WT + (size_t)orow * K + k0 + 8 * c) = o;
    }
    __builtin_amdgcn_s_waitcnt(0xC07F); asm volatile("" ::: "memory");
}

__device__ __forceinline__ void hn_row(const Args& a, bf16_t* HN, float* G, const float* WG, int r, const f32x4 (&v)[8], int lane) {
    float ss = 0.f;
#pragma unroll
    for (int j = 0; j < 8; ++j) ss += (v[j][0] * v[j][0] + v[j][1] * v[j][1]) + (v[j][2] * v[j][2] + v[j][3] * v[j][3]);
    const float rstd = rsqrtf(wave_sum(ss) * (1.f / DM) + EPS);
    float g[8];
#pragma unroll
    for (int k = 0; k < 8; ++k) g[k] = 0.f;
    unsigned long long* o8 = (unsigned long long*)(HN + (size_t)r * DM) + lane;
#pragma unroll
    for (int j = 0; j < 8; ++j) {
        const f32x4 w = ((const f32x4*)a.nmw)[64 * j + lane];
        const f32x4 y = v[j] * rstd * w;
        o8[64 * j] = (unsigned long long)pk2(y[0], y[1]) | ((unsigned long long)pk2(y[2], y[3]) << 32);
#pragma unroll
        for (int k = 0; k < 8; ++k) { const f32x4 wg = ((const f32x4*)(WG + k * 2048))[64 * j + lane]; g[k] += (y[0] * wg[0] + y[1] * wg[1]) + (y[2] * wg[2] + y[3] * wg[3]); }
        __builtin_amdgcn_sched_barrier(0);
    }
    float r4[4], r2[2], r1;
    { const bool hb = (lane & 32) != 0;
#pragma unroll
      for (int i = 0; i < 4; ++i) { const float send = hb ? g[i] : g[i + 4]; const float recv = __shfl_xor(send, 32); r4[i] = (hb ? g[i + 4] : g[i]) + recv; } }
    { const bool hb = (lane & 16) != 0;
#pragma unroll
      for (int i = 0; i < 2; ++i) { const float send = hb ? r4[i] : r4[i + 2]; const float recv = __shfl_xor(send, 16); r2[i] = (hb ? r4[i + 2] : r4[i]) + recv; } }
    { const bool hb = (lane & 8) != 0; const float send = hb ? r2[0] : r2[1]; const float recv = __shfl_xor(send, 8); r1 = (hb ? r2[1] : r2[0]) + recv; }
    r1 += __shfl_xor(r1, 4); r1 += __shfl_xor(r1, 2); r1 += __shfl_xor(r1, 1);
    if ((lane & 7) == 0) G[(size_t)r * 8 + ((lane >> 5) & 1) * 4 + ((lane >> 4) & 1) * 2 + ((lane >> 3) & 1)] = r1;
}

__device__ __forceinline__ void phase_prep(const Args& a, unsigned char* lds, int bid, int nb) {
    const int tid = opaque_tid(), lane = tid & 63, wave = tid >> 6;
    const int gw = bid * NWAVES + wave, NGW = nb * NWAVES;
    unsigned char* ws = a.ws;
    bf16_t* WinT = (bf16_t*)(ws + WS_WIN); bf16_t* WoutT = (bf16_t*)(ws + WS_WOUT); bf16_t* WqT = (bf16_t*)(ws + WS_WQ);
    bf16_t* U = (bf16_t*)(ws + WS_U); bf16_t* V = (bf16_t*)(ws + WS_V); bf16_t* HN = (bf16_t*)(ws + WS_HN);
    float* G = (float*)(ws + WS_GATES); float* rope = (float*)(ws + WS_ROPE);
    float* scr = (float*)lds + wave * (64 * 33);
    float* WG = (float*)(lds + 8 * 64 * 33 * 4);
    for (int i = tid; i < 8 * 2048; i += NTHREADS) { const int k = i >> 3, g = i & 7; WG[g * 2048 + k] = a.w_in[(size_t)k * INCOLS + 6144 + g]; }
    __syncthreads();
    constexpr int I_IN = 32 * 192, I_OUT = 32 * 64, I_Q = 32 * 64;
    for (int it = gw; it < I_IN + I_OUT + I_Q; it += NGW) {
        int r = it;
        if (r < I_IN) { transpose_item(a.w_in, INCOLS, 2048, 6144, WinT, true, scr, r, lane); continue; } r -= I_IN;
        if (r < I_OUT) { transpose_item(a.w_out, 2048, 2048, 2048, WoutT, false, scr, r, lane); continue; } r -= I_OUT;
        transpose_item(a.w_q, 2048, 2048, 2048, WqT, false, scr, r, lane, a.nfw_ffn);
    }
    {
        f32x4 vc[8], vn[8];
#pragma unroll
        for (int j = 0; j < 8; ++j) vc[j] = ((const f32x4*)(a.x + (size_t)gw * DM))[64 * j + lane];
        for (int r = gw; r < TREAL; r += NGW) {
            const int rn = r + NGW < TREAL ? r + NGW : r;
#pragma unroll
            for (int j = 0; j < 8; ++j) vn[j] = ((const f32x4*)(a.x + (size_t)rn * DM))[64 * j + lane];
            hn_row(a, HN, G, WG, r, vc, lane);
#pragma unroll
            for (int j = 0; j < 8; ++j) vc[j] = vn[j];
        }
    }
    for (int r = TREAL + gw; r < MROWS; r += NGW) {
        if (r >= META_ROW0 && r < META_ROW0 + NMETA) {
            f32x4 vm[8];
#pragma unroll
            for (int j = 0; j < 8; ++j) vm[j] = ((const f32x4*)(a.meta + (size_t)(r - META_ROW0) * DM))[64 * j + lane];
            hn_row(a, HN, G, WG, r, vm, lane);
        } else {
            unsigned long long* o8 = (unsigned long long*)(HN + (size_t)r * DM) + lane;
#pragma unroll
            for (int j = 0; j < 8; ++j) o8[64 * j] = 0ull;
            if (lane < 8) G[(size_t)r * 8 + lane] = 0.f;
        }
    }
    { bf16_t* SKB = (bf16_t*)(ws + WS_SKB);
      for (int i = bid * NTHREADS + tid; i < 8 * 2 * 128 * 128 / 2; i += nb * NTHREADS) { const float2 v = ((const float2*)a.subkeys)[i]; ((unsigned*)SKB)[i] = pk2(v.x, v.y); } }
    for (int i = bid * NTHREADS + tid; i < (SEQ + NMETA) * 32; i += nb * NTHREADS) {
        const int pos = i >> 5, j = i & 31;
        const float inv = (float)pow(10000.0, -(double)j / 32.0);
        const float ang = (float)pos * inv;
        rope[2 * i] = (float)cos((double)ang); rope[2 * i + 1] = (float)sin((double)ang);
    }
}


constexpr int CW_QTAB = 4096 + 1024, TAB_ITEMS = 2 * 16384 / 16;
__device__ __forceinline__ void phase_tables(const Args& a, unsigned char* lds, unsigned* ctl) {
    const int tid = opaque_tid(), lane = tid & 63, wave = __builtin_amdgcn_readfirstlane(tid >> 6);
    unsigned char* ws = a.ws;
    volatile LAS unsigned* slot = (volatile LAS unsigned*)((LAS unsigned char*)lds + LDS_MISC) + 2;
    for (;;) {
        const int item = next_item(ctl + CW_QTAB, slot);
        if (item >= TAB_ITEMS) break;
        const int rr = item * 16 + wave;
    {
        unsigned* U8 = (unsigned*)(ws + WS_U); unsigned* V8 = (unsigned*)(ws + WS_V); float* ISC = (float*)(ws + WS_ISC);
        {
            f32x4 v[2][8]; float am[2];
#pragma unroll
            for (int q = 0; q < 2; ++q) {
                const int r = rr + q * 8; const bool isu = r < 16384; const int e = r & 16383;
                const f32x4* xr = (const f32x4*)((isu ? a.pu : a.pv) + (size_t)e * DM) + lane;
#pragma unroll
                for (int j = 0; j < 8; ++j) v[q][j] = xr[64 * j];
            }
#pragma unroll
            for (int q = 0; q < 2; ++q) if (rr + q * 8 < 16384) {
#pragma unroll
                for (int j = 0; j < 8; ++j) v[q][j] = v[q][j] * ((const f32x4*)a.nfw_ffn)[64 * j + lane]; }
#pragma unroll
            for (int q = 0; q < 2; ++q) { float t = 0.f;
#pragma unroll
                for (int j = 0; j < 8; ++j) t = fmaxf(t, fmaxf(fmaxf(fabsf(v[q][j][0]), fabsf(v[q][j][1])), fmaxf(fabsf(v[q][j][2]), fabsf(v[q][j][3]))));
                am[q] = t; }
#pragma unroll
            for (int o = 1; o < 64; o <<= 1) { am[0] = fmaxf(am[0], __shfl_xor(am[0], o)); am[1] = fmaxf(am[1], __shfl_xor(am[1], o)); }
#pragma unroll
            for (int q = 0; q < 2; ++q) {
                const int r = rr + q * 8; const bool isu = r < 16384; const int e = r & 16383;
                const float top = isu ? 127.f : 256.f;
                const float sc = am[q] > 0.f ? top / am[q] : 0.f;
                unsigned* o8 = isu ? U8 : V8;
#pragma unroll
                for (int j = 0; j < 8; ++j) { int w;
                    if (isu) { const int q0 = (int)rintf(v[q][j][0] * sc), q1 = (int)rintf(v[q][j][1] * sc), q2 = (int)rintf(v[q][j][2] * sc), q3 = (int)rintf(v[q][j][3] * sc);
                        w = (int)((unsigned)(q0 & 255) | ((unsigned)(q1 & 255) << 8) | ((unsigned)(q2 & 255) << 16) | ((unsigned)q3 << 24)); }
                    else { w = __builtin_amdgcn_cvt_pk_fp8_f32(v[q][j][0] * sc, v[q][j][1] * sc, 0, false); w = __builtin_amdgcn_cvt_pk_fp8_f32(v[q][j][2] * sc, v[q][j][3] * sc, w, true); }
                    o8[((size_t)j * 16384 + e) * 64 + lane] = (unsigned)w; }
                if (lane == 0) ISC[(isu ? 0 : 16384) + e] = am[q] / top;
            }
        }
    }
    }
}

namespace att {
using bf16x8 = __attribute__((ext_vector_type(8))) short;
using s16x4 = __attribute__((ext_vector_type(4))) short;
using f32x16 = __attribute__((ext_vector_type(16))) float;
using u32x4 = __attribute__((ext_vector_type(4))) unsigned;
constexpr int SHM_V = 16384, SHM_K = 16384;
constexpr int L_V = 0, L_K = 2 * SHM_V, L_WS = L_K + 2 * SHM_K, L_P = L_WS + 8 * 64 * 4, L_END = L_P + 4 * 4096;
#define KSWZ(row, colB) ((row) * 256 + ((colB) ^ (((row) & 7) << 4)))
#define SBAR() __builtin_amdgcn_sched_barrier(0)
__device__ __forceinline__ int crow(int r, int hi) { return (r & 3) + 8 * (r >> 2) + 4 * hi; }
__device__ __forceinline__ unsigned cvtpk(float lo, float hi) { unsigned r; asm volatile("v_cvt_pk_bf16_f32 %0, %1, %2" : "=v"(r) : "v"(lo), "v"(hi)); return r; }
__device__ __forceinline__ int v_st(int k, int c) { const int kk = (k & ~0xC) | ((k & 4) << 1) | ((k & 8) >> 1); return ((kk >> 3) * 4 + (c >> 5)) * 512 + ((kk & 7) * 32 + (c & 31)) * 2; }
__device__ __forceinline__ int v_rd_base(int lane) { return ((lane & 3) << 3) | (((lane >> 2) & 3) << 6) | (((lane >> 4) & 1) << 5) | (((lane >> 5) & 1) << 8); }
constexpr int v_rd_off(int d0, int ks, int half) { return d0 * 512 + ks * 4096 + half * 2048; }
template <int OFF> __device__ __forceinline__ s16x4 tr_read(int vb) { s16x4 r; asm volatile("ds_read_b64_tr_b16 %0, %1 offset:%2" : "=&v"(r) : "v"(vb), "i"(OFF) : "memory"); return r; }
template <int D0> __device__ __forceinline__ void pv_one(f32x16& od, int vb, bf16x8 pa0, bf16x8 pa1, bf16x8 pa2, bf16x8 pa3) {
    const s16x4 l0 = tr_read<v_rd_off(D0, 0, 0)>(vb), h0 = tr_read<v_rd_off(D0, 0, 1)>(vb), l1 = tr_read<v_rd_off(D0, 1, 0)>(vb), h1 = tr_read<v_rd_off(D0, 1, 1)>(vb);
    const s16x4 l2 = tr_read<v_rd_off(D0, 2, 0)>(vb), h2 = tr_read<v_rd_off(D0, 2, 1)>(vb), l3 = tr_read<v_rd_off(D0, 3, 0)>(vb), h3 = tr_read<v_rd_off(D0, 3, 1)>(vb);
    asm volatile("s_waitcnt lgkmcnt(0)" ::: "memory"); SBAR();
#define PK(L, H) (bf16x8){L[0], L[1], L[2], L[3], H[0], H[1], H[2], H[3]}
    od = __builtin_amdgcn_mfma_f32_32x32x16_bf16(pa0, PK(l0, h0), od, 0, 0, 0);
    od = __builtin_amdgcn_mfma_f32_32x32x16_bf16(pa1, PK(l1, h1), od, 0, 0, 0);
    od = __builtin_amdgcn_mfma_f32_32x32x16_bf16(pa2, PK(l2, h2), od, 0, 0, 0);
    od = __builtin_amdgcn_mfma_f32_32x32x16_bf16(pa3, PK(l3, h3), od, 0, 0, 0);
#undef PK
}
__device__ __forceinline__ void qkt(f32x16& p0, f32x16& p1, const char* Ks, const bf16x8* qr, int r32, int hi, int comp) {
    p0 = f32x16{}; p1 = f32x16{};
#pragma unroll
    for (int d0 = 0; d0 < 4; ++d0) {
        const int cb = (comp * 64 + d0 * 16 + hi * 8) * 2;
        const bf16x8 b0 = *reinterpret_cast<const bf16x8*>(Ks + KSWZ(r32, cb));
        const bf16x8 b1 = *reinterpret_cast<const bf16x8*>(Ks + KSWZ(32 + r32, cb));
        p0 = __builtin_amdgcn_mfma_f32_32x32x16_bf16(b0, qr[d0], p0, 0, 0, 0);
        p1 = __builtin_amdgcn_mfma_f32_32x32x16_bf16(b1, qr[d0], p1, 0, 0, 0);
    }
}

__device__ __forceinline__ void attn_unit(int b, int h, int qb, const bf16_t* Z, bf16_t* MIX, float lam, const float* subln, char* lds) {
    const int tid = opaque_tid(), wid = __builtin_amdgcn_readfirstlane(tid >> 6), lane = tid & 63, r32 = lane & 31, hi = lane >> 5;
    const int comp = wid >> 2, rg = wid & 3;
    char* V_lds = lds + L_V; char* K_lds = lds + L_K;
    float* wsf = (float*)(lds + L_WS) + wid * 64;
    const int q0 = b * SEQ + qb * 128;
    const float NEGV = -1e30f;
    bf16x8 qr[4];
    {
        const bf16_t* Qw = Z + (size_t)(q0 + rg * 32 + r32) * NZ + ZQ + h * 128 + comp * 64 + hi * 8;
#pragma unroll
        for (int d0 = 0; d0 < 4; ++d0) qr[d0] = *reinterpret_cast<const bf16x8*>(Qw + d0 * 16);
    }
    const int NT = 2 * qb + 3;
    const int sr = tid >> 4, sc = (tid & 15) * 8;
    const int vst0 = v_st(sr, sc), vst1 = v_st(32 + sr, sc), kst0 = KSWZ(sr, sc * 2), kst1 = KSWZ(32 + sr, sc * 2);
    const int vb0 = (int)(uintptr_t)V_lds + v_rd_base(lane);
#define PK4(P, BASE, OUT) do { unsigned a0 = cvtpk(P[BASE + 0], P[BASE + 1]), a1 = cvtpk(P[BASE + 2], P[BASE + 3]); \
        unsigned b0 = cvtpk(P[BASE + 4], P[BASE + 5]), b1 = cvtpk(P[BASE + 6], P[BASE + 7]); \
        auto r0 = __builtin_amdgcn_permlane32_swap(a0, b0, false, false); auto r1 = __builtin_amdgcn_permlane32_swap(a1, b1, false, false); \
        u32x4 w = {r0[0], r1[0], r0[1], r1[1]}; OUT = *reinterpret_cast<bf16x8*>(&w); } while (0)
    bf16x8 vsA0, vsA1, ksA0, ksA1, vsB0, vsB1, ksB0, ksB1;
#define SLOAD(j, S) do { const size_t r0_ = (size_t)((j) == 0 ? META_TILE0 : b * SEQ + ((j) - 1) * 64) + sr; const bf16_t* zp_ = Z + r0_ * NZ + h * 128 + sc; \
        vs##S##0 = *reinterpret_cast<const bf16x8*>(zp_ + ZV); vs##S##1 = *reinterpret_cast<const bf16x8*>(zp_ + ZV + (size_t)32 * NZ); \
        ks##S##0 = *reinterpret_cast<const bf16x8*>(zp_ + ZK); ks##S##1 = *reinterpret_cast<const bf16x8*>(zp_ + ZK + (size_t)32 * NZ); } while (0)
#define SWRITE(bi, S) do { *reinterpret_cast<bf16x8*>(V_lds + (bi) * SHM_V + vst0) = vs##S##0; *reinterpret_cast<bf16x8*>(V_lds + (bi) * SHM_V + vst1) = vs##S##1; \
        *reinterpret_cast<bf16x8*>(K_lds + (bi) * SHM_K + kst0) = ks##S##0; *reinterpret_cast<bf16x8*>(K_lds + (bi) * SHM_K + kst1) = ks##S##1; } while (0)
    f32x16 o[4] = {}; float m_reg = NEGV, l_reg = 0.f;
    SLOAD(0, A); SWRITE(0, A); SLOAD(1, B); __syncthreads();
    const int qrel = rg * 32 + r32;
#define ATT_TILE(j, L_, W_) do { \
        const int cur = j & 1; \
        if (j + 2 < NT) SLOAD(j + 2, L_); \
        f32x16 p0, p1; \
        qkt(p0, p1, K_lds + cur * SHM_K, qr, r32, hi, comp); \
        if (j == 0) { \
    _Pragma("unroll") \
            for (int r = 0; r < 16; ++r) { p0[r] = NEGV; if (r < 8) p1[r] = NEGV; } \
        } else if (j >= NT - 2) { \
            const int kb0 = (j - (NT - 2)) * 64; \
    _Pragma("unroll") \
            for (int r = 0; r < 16; ++r) { const int kl = kb0 + crow(r, hi); if (kl > qrel) p0[r] = NEGV; if (kl + 32 > qrel) p1[r] = NEGV; } \
        } \
        float pmax = p0[0]; \
    _Pragma("unroll") \
        for (int r = 1; r < 16; ++r) pmax = fmaxf(pmax, p0[r]); \
    _Pragma("unroll") \
        for (int r = 0; r < 16; ++r) pmax = fmaxf(pmax, p1[r]); \
        { auto rr = __builtin_amdgcn_permlane32_swap(__float_as_uint(pmax), __float_as_uint(pmax), false, false); pmax = fmaxf(__uint_as_float(rr[0]), __uint_as_float(rr[1])); } \
        const float mn = fmaxf(m_reg, pmax); const float alpha = __builtin_amdgcn_exp2f(m_reg - mn); m_reg = mn; \
        float ps = 0.f; \
    _Pragma("unroll") \
        for (int r = 0; r < 16; ++r) { p0[r] = __builtin_amdgcn_exp2f(p0[r] - mn); ps += p0[r]; } \
    _Pragma("unroll") \
        for (int r = 0; r < 16; ++r) { p1[r] = __builtin_amdgcn_exp2f(p1[r] - mn); ps += p1[r]; } \
        { auto rr = __builtin_amdgcn_permlane32_swap(__float_as_uint(ps), __float_as_uint(ps), false, false); ps = __uint_as_float(rr[0]) + __uint_as_float(rr[1]); } \
        l_reg = l_reg * alpha + ps; \
        if (__any(alpha < 1.f)) { \
            if (hi == 0) wsf[r32] = alpha; \
            asm volatile("s_waitcnt lgkmcnt(0)" ::: "memory"); \
            float al[16]; \
    _Pragma("unroll") \
            for (int r = 0; r < 16; ++r) al[r] = wsf[crow(r, hi)]; \
    _Pragma("unroll") \
            for (int d = 0; d < 4; ++d) \
    _Pragma("unroll") \
                for (int r = 0; r < 16; ++r) o[d][r] *= al[r]; \
            asm volatile("s_waitcnt lgkmcnt(0)" ::: "memory"); \
        } \
        bf16x8 pa0, pa1, pa2, pa3; \
        PK4(p0, 0, pa0); PK4(p0, 8, pa1); PK4(p1, 0, pa2); PK4(p1, 8, pa3); \
        SBAR(); \
        { const int vb = vb0 + cur * SHM_V; \
          pv_one<0>(o[0], vb, pa0, pa1, pa2, pa3); pv_one<1>(o[1], vb, pa0, pa1, pa2, pa3); pv_one<2>(o[2], vb, pa0, pa1, pa2, pa3); pv_one<3>(o[3], vb, pa0, pa1, pa2, pa3); } \
        if (j + 1 < NT) SWRITE(cur ^ 1, W_); \
        __syncthreads(); \
    } while (0)
    for (int j = 0; j < NT; j += 2) { ATT_TILE(j, A, B); if (j + 1 < NT) ATT_TILE(j + 1, B, A); }
#undef ATT_TILE
#undef SLOAD
#undef SWRITE
#undef PK4
    if (hi == 0) wsf[r32] = l_reg;
    asm volatile("s_waitcnt lgkmcnt(0)" ::: "memory");
    float rli[16];
#pragma unroll
    for (int r = 0; r < 16; ++r) rli[r] = __builtin_amdgcn_rcpf(wsf[crow(r, hi)]);
    float* X = (float*)lds + rg * 4096;
    if (comp == 1) {
#pragma unroll
        for (int d0 = 0; d0 < 4; ++d0)
#pragma unroll
            for (int r = 0; r < 16; ++r) X[(d0 * 16 + r) * 64 + lane] = o[d0][r] * rli[r] * lam;
    }
    __syncthreads();
    if (comp == 0) {
        float ssr[16];
#pragma unroll
        for (int r = 0; r < 16; ++r) ssr[r] = 0.f;
#pragma unroll
        for (int d0 = 0; d0 < 4; ++d0)
#pragma unroll
            for (int r = 0; r < 16; ++r) { const float v = o[d0][r] * rli[r] - X[(d0 * 16 + r) * 64 + lane]; o[d0][r] = v; ssr[r] += v * v; }
        float* P = (float*)(lds + L_P) + rg * 1024;
#pragma unroll
        for (int r = 0; r < 16; ++r) P[r * 64 + lane] = ssr[r];
        asm volatile("s_waitcnt lgkmcnt(0)" ::: "memory");
        {
            const int rho = lane & 31, hh = (rho >> 2) & 1, rr = (rho & 3) + 4 * (rho >> 3);
            const float4* pp = (const float4*)(P + rr * 64 + hh * 32 + (lane >> 5) * 16);
            const float4 a0 = pp[0], a1 = pp[1], a2 = pp[2], a3 = pp[3];
            float s = ((a0.x + a0.y) + (a0.z + a0.w)) + ((a1.x + a1.y) + (a1.z + a1.w)) + ((a2.x + a2.y) + (a2.z + a2.w)) + ((a3.x + a3.y) + (a3.z + a3.w));
            auto sw = __builtin_amdgcn_permlane32_swap(__float_as_uint(s), __float_as_uint(s), false, false); s = __uint_as_float(sw[0]) + __uint_as_float(sw[1]);
            if (lane < 32) wsf[32 + rho] = rsqrtf(s * (1.f / 128.f) + EPS) * (1.f - LAMBDA_INIT);
        }
        asm volatile("s_waitcnt lgkmcnt(0)" ::: "memory");
        float sw4[4];
#pragma unroll
        for (int d0 = 0; d0 < 4; ++d0) sw4[d0] = subln[d0 * 32 + r32];
        bf16_t* Ow = MIX + (size_t)(q0 + rg * 32) * DM + h * 128 + r32;
#pragma unroll
        for (int r = 0; r < 16; ++r) {
            const int orow = crow(r, hi); const float rs = wsf[32 + orow];
#pragma unroll
            for (int d0 = 0; d0 < 4; ++d0) Ow[(size_t)orow * DM + d0 * 32] = (bf16_t)f2bf(o[d0][r] * rs * sw4[d0]);
        }
    }
    __syncthreads();
}
#undef KSWZ
#undef SBAR
}

__device__ __forceinline__ float attn_lambda(const Args& a) {
    const int lane = opaque_tid() & 63;
    const float l1 = wave_sum(a.lamqk[lane] * a.lamqk[64 + lane]), l2 = wave_sum(a.lamqk[128 + lane] * a.lamqk[192 + lane]);
    return expf(l1) - expf(l2) + LAMBDA_INIT;
}
namespace mls {
using bf16x8 = __attribute__((ext_vector_type(8))) short;
using bf16x4 = __attribute__((ext_vector_type(4))) short;
using s16x4 = __attribute__((ext_vector_type(4))) short;
using f32x16 = __attribute__((ext_vector_type(16))) float;
using f32x4v = __attribute__((ext_vector_type(4))) float;
using u32x4v = __attribute__((ext_vector_type(4))) unsigned;
using u32x2v = __attribute__((ext_vector_type(2))) unsigned;
constexpr int L_QS = 0, L_QP = 16384, L_KS = 32768, L_KW = 49152, L_VT = 65536, L_PT = 98304, L_HT = 106496, HT_STRIDE = 528;
constexpr int L_MISC = L_HT + 64 * HT_STRIDE;
constexpr int L_RS = L_MISC, L_QN = L_RS + 2 * 64 * 4, L_NV = L_QN + 64 * 4, L_NP = L_NV + 128 * 4, L_CW = L_NP + 8 * 128 * 4, L_RD = L_CW + 5 * 256 * 4, L_NW = L_RD + 8 * 64 * 4, L_END = L_NW + 8 * 36 * 4;
#define KSWZ(row, colB) ((row) * 256 + ((colB) ^ (((row) & 7) << 4)))
#define PSWZ(row, colB) ((row) * 128 + ((colB) ^ ((((row) >> 1) & 7) << 4)))
__device__ __forceinline__ int crow(int r, int hi) { return (r & 3) + 8 * (r >> 2) + 4 * hi; }
__device__ __forceinline__ unsigned cvtpk(float lo, float hi) { unsigned r; asm volatile("v_cvt_pk_bf16_f32 %0, %1, %2" : "=v"(r) : "v"(lo), "v"(hi)); return r; }
__device__ __forceinline__ int v_st(int k, int c) { const int kk = (k & ~0xC) | ((k & 4) << 1) | ((k & 8) >> 1); return ((kk >> 3) * 4 + (c >> 5)) * 512 + ((kk & 7) * 32 + (c & 31)) * 2; }
__device__ __forceinline__ int v_rd_base(int lane) { return ((lane & 3) << 3) | (((lane >> 2) & 3) << 6) | (((lane >> 4) & 1) << 5) | (((lane >> 5) & 1) << 8); }
__device__ __forceinline__ s16x4 tr_read_dyn(int addr) { s16x4 r; asm volatile("ds_read_b64_tr_b16 %0, %1" : "=&v"(r) : "v"(addr) : "memory"); return r; }
__device__ __forceinline__ bf16x8 tr_frag(int img_plus_base, int d0, int ks) {
    const s16x4 lo = tr_read_dyn(img_plus_base + d0 * 512 + ks * 4096), hi = tr_read_dyn(img_plus_base + d0 * 512 + ks * 4096 + 2048);
    return (bf16x8){lo[0], lo[1], lo[2], lo[3], hi[0], hi[1], hi[2], hi[3]};
}
template <int CTRL, int RMASK> __device__ __forceinline__ float dppf(float old, float v) { return __builtin_bit_cast(float, __builtin_amdgcn_update_dpp(__builtin_bit_cast(int, old), __builtin_bit_cast(int, v), CTRL, RMASK, 0xf, false)); }
__device__ __forceinline__ float scan_add(float v) {
    v += dppf<0x111, 0xf>(0.f, v); v += dppf<0x112, 0xf>(0.f, v); v += dppf<0x114, 0xf>(0.f, v); v += dppf<0x118, 0xf>(0.f, v);
    v += dppf<0x142, 0xa>(0.f, v); v += dppf<0x143, 0xc>(0.f, v); return v;
}
__device__ __forceinline__ float scan_max(float v) {
    const float NI = -3.0e38f;
    v = fmaxf(v, dppf<0x111, 0xf>(NI, v)); v = fmaxf(v, dppf<0x112, 0xf>(NI, v)); v = fmaxf(v, dppf<0x114, 0xf>(NI, v)); v = fmaxf(v, dppf<0x118, 0xf>(NI, v));
    v = fmaxf(v, dppf<0x142, 0xa>(NI, v)); v = fmaxf(v, dppf<0x143, 0xc>(NI, v)); return v;
}
__device__ __forceinline__ float rlane(float v, int l) { return __uint_as_float(__builtin_amdgcn_readlane(__float_as_uint(v), l)); }
__device__ __forceinline__ float silu(float x) { return x * __builtin_amdgcn_rcpf(1.f + __expf(-x)); }
__device__ __forceinline__ void fmac_v(float& y, float a, float b) { asm("v_fmac_f32 %0, %1, %2" : "+v"(y) : "v"(a), "v"(b)); }
__device__ __forceinline__ float mul_v(float a, float b) { float r; asm("v_mul_f32 %0, %1, %2" : "=v"(r) : "v"(a), "v"(b)); return r; }

__device__ __forceinline__ void mlstm_item(int b, int h, const Args& a, char* lds) {
    const int tid0 = opaque_tid(), wid = __builtin_amdgcn_readfirstlane(tid0 >> 6);
    const bf16_t* Z = (const bf16_t*)(a.ws + WS_Z); const float* G = (const float*)(a.ws + WS_GATES); bf16_t* MIX = (bf16_t*)(a.ws + WS_MIX);
    const int ldsb = (int)(uintptr_t)lds;
    float* RS = (float*)(lds + L_RS); float* QN = (float*)(lds + L_QN); float* NV = (float*)(lds + L_NV); float* NP = (float*)(lds + L_NP); float* CW = (float*)(lds + L_CW);
    for (int i = tid0; i < 5 * 256; i += NTHREADS) { const int j = i >> 8, c = i & 255; const int cc = c < 128 ? h * 128 + c : 512 + h * 128 + (c - 128); CW[i] = j < 4 ? a.convw[j * 1024 + cc] : a.convb[cc]; }
    if (tid0 < 128) NV[tid0] = 0.f;
    if (tid0 < 256) ((float*)(lds + L_NW))[(tid0 >> 5) * 36 + (tid0 & 31)] = a.mnw[h * 256 + tid0];
    const float ibh = a.ib[h], fbh = a.fb[h];
    float cw[4][4], cb[4];
    __syncthreads();
    { const int c4 = 4 * (tid0 & 63);
#pragma unroll
    for (int j = 0; j < 4; ++j)
#pragma unroll
        for (int q = 0; q < 4; ++q) cw[j][q] = CW[j * 256 + c4 + q];
#pragma unroll
    for (int q = 0; q < 4; ++q) cb[q] = CW[4 * 256 + c4 + q]; }
    f32x16 C[4] = {};
    float m_prev = -1e30f;
    u32x2v rq[11]; u32x4v rv[4]; float gi, gf;
    auto chunk_row0 = [&](int c) -> int { return c == 0 ? META_TILE0 : b * SEQ + (c - 1) * 64; };
#define LOAD_RAW(c) do { int tq_ = tid0; asm volatile("" : "+v"(tq_)); const int ln_ = tq_ & 63, c4_ = 4 * ln_, zc_qk = (c4_ < 128 ? ZMQ + h * 128 + c4_ : ZMK + h * 128 + (c4_ - 128)), erow = tq_ >> 3, eseg = tq_ & 7; const int r0_ = chunk_row0(c); \
        _Pragma("unroll") for (int i_ = 0; i_ < 11; ++i_) { const int t_ = 8 * wid - 3 + i_; int row_; bool ok_ = true; \
            if (t_ >= 0) row_ = r0_ + t_; else if ((c) == 0) { row_ = 0; ok_ = false; } else if ((c) == 1) row_ = META_TILE0 + 64 + t_; else row_ = r0_ + t_; \
            rq[i_] = ok_ ? *(const u32x2v*)(Z + (size_t)row_ * NZ + zc_qk) : (u32x2v){0u, 0u}; } \
        _Pragma("unroll") for (int i_ = 0; i_ < 4; ++i_) rv[i_] = *(const u32x4v*)(Z + (size_t)(r0_ + erow) * NZ + ZMV + h * 256 + eseg * 32 + 8 * i_); \
        { const int rowg_ = r0_ + ln_; gi = G[(size_t)rowg_ * 8 + h]; gf = G[(size_t)rowg_ * 8 + 4 + h]; } } while (0)
    LOAD_RAW(0);
    const int NCH = 33;
    for (int c = 0; c < NCH; ++c) {
        int tid = tid0; asm volatile("" : "+v"(tid));
        const int lane = tid & 63, r32 = lane & 31, hi = lane >> 5, cq = lane, c4 = 4 * cq, erow = tid >> 3, eseg = tid & 7;
        float* RD = (float*)(lds + L_RD) + wid * 64;
        float li = gi + ibh; float lf; { const float xf = gf + fbh; lf = fminf(xf, 0.f) - __logf(1.f + __expf(-fabsf(xf))); }
        if (c == 0 && lane < 48) { li = -1e30f; lf = 0.f; }
        const float bsum = scan_add(lf);
        const float u = li - bsum;
        const float cm = scan_max(u);
        const float Mrow = fmaxf(cm, m_prev);
        const float iw = __expf(m_prev - Mrow);
        const float Mend = rlane(Mrow, 63), gtot = rlane(bsum, 63);
        const float wrow = __expf(u - Mend);
        const float dec = __expf(m_prev - Mend);
        const float dexp = __expf(-(bsum + Mrow));
        {
            float qn_part[8], ksum[4] = {0.f, 0.f, 0.f, 0.f};
            float nvv[4];
#pragma unroll
            for (int q = 0; q < 4; ++q) nvv[q] = (cq < 32) ? NV[c4 + q] : 0.f;
#pragma unroll
            for (int i = 0; i < 8; ++i) {
                const int t = 8 * wid + i;
                float xo[4];
#pragma unroll
                for (int q = 0; q < 4; ++q) xo[q] = cb[q];
#pragma unroll
                for (int j = 0; j < 4; ++j) {
                    const u32x2v rr = rq[i + j];
                    fmac_v(xo[0], cw[j][0], bf_lo(rr.x)); fmac_v(xo[1], cw[j][1], bf_hi(rr.x)); fmac_v(xo[2], cw[j][2], bf_lo(rr.y)); fmac_v(xo[3], cw[j][3], bf_hi(rr.y));
                }
#pragma unroll
                for (int q = 0; q < 4; ++q) xo[q] = silu(xo[q]);
                const float iw_t = rlane(iw, t), w_t = rlane(wrow, t);
                if (cq < 32) {
#pragma unroll
                    for (int q = 0; q < 4; ++q) xo[q] = mul_v(xo[q], 0.08838834764831845f);
                    *(uint2*)(lds + L_QS + KSWZ(t, c4 * 2)) = make_uint2(cvtpk(xo[0], xo[1]), cvtpk(xo[2], xo[3]));
                    float qd = 0.f;
#pragma unroll
                    for (int q = 0; q < 4; ++q) { fmac_v(qd, xo[q], nvv[q]); xo[q] = mul_v(xo[q], iw_t); }
                    *(uint2*)(lds + L_QP + KSWZ(t, c4 * 2)) = make_uint2(cvtpk(xo[0], xo[1]), cvtpk(xo[2], xo[3]));
                    qn_part[i] = iw_t * qd;
                } else {
                    const int kc = c4 - 128;
                    *(uint2*)(lds + L_KS + KSWZ(t, kc * 2)) = make_uint2(cvtpk(xo[0], xo[1]), cvtpk(xo[2], xo[3]));
#pragma unroll
                    for (int q = 0; q < 4; ++q) { xo[q] = mul_v(xo[q], w_t); ksum[q] += xo[q]; }
                    *(uint2*)(lds + L_KW + v_st(t, kc)) = make_uint2(cvtpk(xo[0], xo[1]), cvtpk(xo[2], xo[3]));
                    qn_part[i] = 0.f;
                }
                __builtin_amdgcn_sched_barrier(0);
            }
            {
                float r4[4], r2[2], r1;
                { const bool hb = (lane & 16) != 0;
#pragma unroll
                  for (int i = 0; i < 4; ++i) { const float send = hb ? qn_part[i] : qn_part[i + 4]; const float recv = __shfl_xor(send, 16); r4[i] = (hb ? qn_part[i + 4] : qn_part[i]) + recv; } }
                { const bool hb = (lane & 8) != 0;
#pragma unroll
                  for (int i = 0; i < 2; ++i) { const float send = hb ? r4[i] : r4[i + 2]; const float recv = __shfl_xor(send, 8); r2[i] = (hb ? r4[i + 2] : r4[i]) + recv; } }
                { const bool hb = (lane & 4) != 0; const float send = hb ? r2[0] : r2[1]; const float recv = __shfl_xor(send, 4); r1 = (hb ? r2[1] : r2[0]) + recv; }
                r1 += __shfl_xor(r1, 2); r1 += __shfl_xor(r1, 1);
                if (lane < 32 && (lane & 3) == 0) QN[8 * wid + ((lane >> 4) & 1) * 4 + ((lane >> 3) & 1) * 2 + ((lane >> 2) & 1)] = r1;
            }
            if (cq >= 32) {
#pragma unroll
                for (int q = 0; q < 4; ++q) NP[wid * 128 + (c4 - 128) + q] = ksum[q];
            }
#pragma unroll
            for (int i = 0; i < 4; ++i) *(u32x4v*)(lds + L_VT + (eseg >> 2) * 16384 + v_st(erow, (eseg & 3) * 32 + 8 * i)) = rv[i];
        }
        u32x4v zo[4];
        {
            const int r0 = chunk_row0(c);
#pragma unroll
            for (int i = 0; i < 4; ++i) zo[i] = *(const u32x4v*)(Z + (size_t)(r0 + erow) * NZ + ZMO + h * 256 + eseg * 32 + 8 * i);
        }
        if (c + 1 < NCH) LOAD_RAW(c + 1);
        __syncthreads();
        {
            const int tb = wid >> 1, half = wid & 1;
            float rsum[4] = {0.f, 0.f, 0.f, 0.f};
            const int fr = lane & 15, fq = lane >> 4;
            float Mt[4];
#pragma unroll
            for (int i = 0; i < 4; ++i) Mt[i] = __shfl(Mrow, 16 * tb + 4 * fq + i);
#pragma unroll
            for (int sj = 0; sj < 2; ++sj) {
                const int sb = 2 * half + sj;
                unsigned short pw[4] = {0, 0, 0, 0};
                if (sb <= tb) {
                    f32x4v acc = {0.f, 0.f, 0.f, 0.f};
#pragma unroll
                    for (int ks = 0; ks < 4; ++ks) {
                        const bf16x8 af = *(const bf16x8*)(lds + L_QS + KSWZ(16 * tb + fr, (32 * ks + 8 * fq) * 2));
                        const bf16x8 bfr = *(const bf16x8*)(lds + L_KS + KSWZ(16 * sb + fr, (32 * ks + 8 * fq) * 2));
                        acc = __builtin_amdgcn_mfma_f32_16x16x32_bf16(af, bfr, acc, 0, 0, 0);
                    }
                    const int s = 16 * sb + fr; const float us = __shfl(u, s);
#pragma unroll
                    for (int i = 0; i < 4; ++i) {
                        const int t = 16 * tb + 4 * fq + i;
                        const float p = (s <= t) ? acc[i] * __expf(us - Mt[i]) : 0.f;
                        rsum[i] += p; pw[i] = (unsigned short)f2bf(p);
                    }
                }
#pragma unroll
                for (int i = 0; i < 4; ++i) *(unsigned short*)(lds + L_PT + PSWZ(16 * tb + 4 * fq + i, (16 * sb + fr) * 2)) = pw[i];
            }
#pragma unroll
            for (int i = 0; i < 4; ++i) {
                float v = rsum[i];
                v += __shfl_xor(v, 1); v += __shfl_xor(v, 2); v += __shfl_xor(v, 4); v += __shfl_xor(v, 8);
                if (fr == 0) RS[half * 64 + 16 * tb + 4 * fq + i] = v;
            }
        }
        __syncthreads();
        {
            const float nq = RS[lane] + RS[64 + lane] + QN[lane];
            RD[lane] = __builtin_amdgcn_rcpf(fmaxf(fabsf(nq), dexp));
            bf16x8 vf[4];
            const int vimg = ldsb + L_VT + (wid >> 2) * 16384 + v_rd_base(lane);
#pragma unroll
            for (int ks = 0; ks < 4; ++ks) vf[ks] = tr_frag(vimg, wid & 3, ks);
            asm volatile("s_waitcnt lgkmcnt(0)" ::: "memory"); __builtin_amdgcn_sched_barrier(0);
            f32x16 acc[2] = {};
#pragma unroll
            for (int rb = 0; rb < 2; ++rb) {
                const int row = 32 * rb + r32;
#pragma unroll
                for (int ks = 0; ks < 4; ++ks) {
                    if (rb == 0 && ks >= 2) continue;
                    const bf16x8 pf = *(const bf16x8*)(lds + L_PT + PSWZ(row, (16 * ks + 8 * hi) * 2));
                    acc[rb] = __builtin_amdgcn_mfma_f32_32x32x16_bf16(pf, vf[ks], acc[rb], 0, 0, 0);
                }
            }
#pragma unroll
            for (int kb = 0; kb < 4; ++kb)
#pragma unroll
                for (int sp = 0; sp < 2; ++sp) {
                    bf16x8 cf; { unsigned w0 = cvtpk(C[kb][8 * sp + 0], C[kb][8 * sp + 1]), w1 = cvtpk(C[kb][8 * sp + 2], C[kb][8 * sp + 3]), w2 = cvtpk(C[kb][8 * sp + 4], C[kb][8 * sp + 5]), w3 = cvtpk(C[kb][8 * sp + 6], C[kb][8 * sp + 7]);
                        typedef unsigned u32x4_ __attribute__((ext_vector_type(4))); u32x4_ ww = {w0, w1, w2, w3}; cf = __builtin_bit_cast(bf16x8, ww); }
                    const int base = 32 * kb + 16 * sp;
#pragma unroll
                    for (int rb = 0; rb < 2; ++rb) {
                        const int row = 32 * rb + r32;
                        const bf16x4 q0 = *(const bf16x4*)(lds + L_QP + KSWZ(row, (base + 4 * hi) * 2));
                        const bf16x4 q1 = *(const bf16x4*)(lds + L_QP + KSWZ(row, (base + 8 + 4 * hi) * 2));
                        const bf16x8 qf = {q0[0], q0[1], q0[2], q0[3], q1[0], q1[1], q1[2], q1[3]};
                        acc[rb] = __builtin_amdgcn_mfma_f32_32x32x16_bf16(qf, cf, acc[rb], 0, 0, 0);
                    }
                }
            asm volatile("s_waitcnt lgkmcnt(0)" ::: "memory");
#pragma unroll
            for (int rb = 0; rb < 2; ++rb)
#pragma unroll
                for (int r = 0; r < 16; ++r) {
                    const int row = 32 * rb + crow(r, hi);
                    *(unsigned short*)(lds + L_HT + row * HT_STRIDE + (32 * wid + r32) * 2) = (unsigned short)f2bf(acc[rb][r] * RD[row]);
                }
#pragma unroll
            for (int kb = 0; kb < 4; ++kb) {
#pragma unroll
                for (int r = 0; r < 16; ++r) C[kb][r] *= dec;
                const int kimg = ldsb + L_KW + v_rd_base(lane);
                bf16x8 kf[4];
#pragma unroll
                for (int ks = 0; ks < 4; ++ks) kf[ks] = tr_frag(kimg, kb, ks);
                asm volatile("s_waitcnt lgkmcnt(0)" ::: "memory"); __builtin_amdgcn_sched_barrier(0);
#pragma unroll
                for (int ks = 0; ks < 4; ++ks) C[kb] = __builtin_amdgcn_mfma_f32_32x32x16_bf16(kf[ks], vf[ks], C[kb], 0, 0, 0);
            }
            if (tid < 128) { float s = NV[tid] * dec;
#pragma unroll
                for (int w8 = 0; w8 < 8; ++w8) s += NP[w8 * 128 + tid];
                NV[tid] = s; }
        }
        m_prev = gtot + Mend;
        __syncthreads();
        if (c > 0) {
            float hv[32]; float ss = 0.f;
#pragma unroll
            for (int i = 0; i < 4; ++i) {
                const uint4 w = *(const uint4*)(lds + L_HT + erow * HT_STRIDE + eseg * 64 + 16 * i);
                hv[8 * i + 0] = bf_lo(w.x); hv[8 * i + 1] = bf_hi(w.x); hv[8 * i + 2] = bf_lo(w.y); hv[8 * i + 3] = bf_hi(w.y);
                hv[8 * i + 4] = bf_lo(w.z); hv[8 * i + 5] = bf_hi(w.z); hv[8 * i + 6] = bf_lo(w.w); hv[8 * i + 7] = bf_hi(w.w);
            }
#pragma unroll
            for (int i = 0; i < 32; ++i) ss += hv[i] * hv[i];
            ss += __shfl_xor(ss, 1); ss += __shfl_xor(ss, 2); ss += __shfl_xor(ss, 4);
            const float rstd = rsqrtf(ss * (1.f / 256.f) + EPS);
            const float* nw = (const float*)(lds + L_NW) + eseg * 36;
            bf16_t* op = MIX + (size_t)(chunk_row0(c) + erow) * DM + 1024 + h * 256 + eseg * 32;
#pragma unroll
            for (int i = 0; i < 4; ++i) {
                const unsigned zz[4] = {zo[i].x, zo[i].y, zo[i].z, zo[i].w};
                unsigned ow[4];
#pragma unroll
                for (int q = 0; q < 4; ++q) {
                    const float z0 = bf_lo(zz[q]), z1 = bf_hi(zz[q]);
                    const float o0 = hv[8 * i + 2 * q] * rstd * nw[8 * i + 2 * q] * __builtin_amdgcn_rcpf(1.f + __expf(-z0));
                    const float o1 = hv[8 * i + 2 * q + 1] * rstd * nw[8 * i + 2 * q + 1] * __builtin_amdgcn_rcpf(1.f + __expf(-z1));
                    ow[q] = pk2(o0, o1);
                }
                *(uint4*)(op + 8 * i) = make_uint4(ow[0], ow[1], ow[2], ow[3]);
            }
        }
    }
#undef LOAD_RAW
    __syncthreads();
}
#undef KSWZ
#undef PSWZ
}

namespace rt {
using bf16x8 = __attribute__((ext_vector_type(8))) short;
using f32x16 = __attribute__((ext_vector_type(16))) float;
__device__ __forceinline__ unsigned fmaxu(unsigned a, unsigned b) { unsigned r; asm("v_max_f32 %0, %1, %2" : "=v"(r) : "v"(a), "v"(b)); return r; }
__device__ __forceinline__ unsigned fminu(unsigned a, unsigned b) { unsigned r; asm("v_min_f32 %0, %1, %2" : "=v"(r) : "v"(a), "v"(b)); return r; }
#define CE(a, b) do { const unsigned x_ = (a), y_ = (b); (a) = fmaxu(x_, y_); (b) = fminu(x_, y_); } while (0)
#define SORT16_DESC(V) do { CE(V[0], V[1]); CE(V[2], V[3]); CE(V[0], V[2]); CE(V[1], V[3]); CE(V[1], V[2]); CE(V[4], V[5]); CE(V[6], V[7]); CE(V[4], V[6]); CE(V[5], V[7]); CE(V[5], V[6]); CE(V[0], V[4]); CE(V[2], V[6]); CE(V[2], V[4]); CE(V[1], V[5]); CE(V[3], V[7]); CE(V[3], V[5]); CE(V[1], V[2]); CE(V[3], V[4]); CE(V[5], V[6]); CE(V[8], V[9]); CE(V[10], V[11]); CE(V[8], V[10]); CE(V[9], V[11]); CE(V[9], V[10]); CE(V[12], V[13]); CE(V[14], V[15]); CE(V[12], V[14]); CE(V[13], V[15]); CE(V[13], V[14]); CE(V[8], V[12]); CE(V[10], V[14]); CE(V[10], V[12]); CE(V[9], V[13]); CE(V[11], V[15]); CE(V[11], V[13]); CE(V[9], V[10]); CE(V[11], V[12]); CE(V[13], V[14]); CE(V[0], V[8]); CE(V[4], V[12]); CE(V[4], V[8]); CE(V[2], V[10]); CE(V[6], V[14]); CE(V[6], V[10]); CE(V[2], V[4]); CE(V[6], V[8]); CE(V[10], V[12]); CE(V[1], V[9]); CE(V[5], V[13]); CE(V[5], V[9]); CE(V[3], V[11]); CE(V[7], V[15]); CE(V[7], V[11]); CE(V[3], V[5]); CE(V[7], V[9]); CE(V[11], V[13]); CE(V[1], V[2]); CE(V[3], V[4]); CE(V[5], V[6]); CE(V[7], V[8]); CE(V[9], V[10]); CE(V[11], V[12]); CE(V[13], V[14]); } while (0)
#define BMERGE16_DESC(V) do { CE(V[0], V[8]); CE(V[1], V[9]); CE(V[2], V[10]); CE(V[3], V[11]); CE(V[4], V[12]); CE(V[5], V[13]); CE(V[6], V[14]); CE(V[7], V[15]); CE(V[0], V[4]); CE(V[1], V[5]); CE(V[2], V[6]); CE(V[3], V[7]); CE(V[8], V[12]); CE(V[9], V[13]); CE(V[10], V[14]); CE(V[11], V[15]); CE(V[0], V[2]); CE(V[1], V[3]); CE(V[4], V[6]); CE(V[5], V[7]); CE(V[8], V[10]); CE(V[9], V[11]); CE(V[12], V[14]); CE(V[13], V[15]); CE(V[0], V[1]); CE(V[2], V[3]); CE(V[4], V[5]); CE(V[6], V[7]); CE(V[8], V[9]); CE(V[10], V[11]); CE(V[12], V[13]); CE(V[14], V[15]); } while (0)

#define TOP16(A, B) do { _Pragma("unroll") for (int i_ = 0; i_ < 16; ++i_) { A[i_] = fmaxu(A[i_], B[15 - i_]); } BMERGE16_DESC(A); } while (0)
__device__ __forceinline__ unsigned ord_key(float f) { return __float_as_uint(f); }
__device__ __forceinline__ float ord_val(unsigned k) { return __uint_as_float(k); }
__device__ __forceinline__ int crow(int r, int hi) { return (r & 3) + 8 * (r >> 2) + 4 * hi; }

__device__ __forceinline__ void route_item(int tb, int h, const bf16_t* QP, const bf16_t* SKB, const float* SSQ, int* IDX, float* GATE, int* scr, int lane_in) {
    int lane = lane_in; asm volatile("" : "+v"(lane));
    const int tok = lane & 31, hi = lane >> 5;
    const int row = tb * 32 + tok;
    float rstd;
    { const float4* sp = (const float4*)(SSQ + (size_t)row * 32); float s = 0.f;
#pragma unroll
      for (int i = 0; i < 8; ++i) { const float4 v = sp[i]; s += (v.x + v.y) + (v.z + v.w); }
      rstd = rsqrtf(s * (1.f / DM) + EPS); }
    unsigned top[2][16];
    bf16x8 qf[8], af[2][8];
    unsigned T[16];
#define RT_LOADQ(p_) do { const bf16_t* qp_ = QP + (size_t)row * DM + h * 256 + (p_) * 128 + hi * 8; \
        _Pragma("unroll") for (int ks = 0; ks < 8; ++ks) qf[ks] = *reinterpret_cast<const bf16x8*>(qp_ + ks * 16); } while (0)
#define RT_LOADK(b_, i_) do { const bf16_t* kp_ = SKB + ((size_t)((h * 2 + ((i_) >> 2)) * 128 + ((i_) & 3) * 32 + tok)) * 128 + hi * 8; \
        _Pragma("unroll") for (int ks = 0; ks < 8; ++ks) af[b_][ks] = *reinterpret_cast<const bf16x8*>(kp_ + ks * 16); } while (0)
    RT_LOADQ(0); RT_LOADK(0, 0);
#pragma unroll
    for (int i = 0; i < 8; ++i) {
        const int p = i >> 2, kb = i & 3;
        if (i + 1 < 8) RT_LOADK((i + 1) & 1, i + 1);
        f32x16 acc = {};
#pragma unroll
        for (int ks = 0; ks < 8; ++ks) acc = __builtin_amdgcn_mfma_f32_32x32x16_bf16(af[i & 1][ks], qf[ks], acc, 0, 0, 0);
        unsigned K[16];
#pragma unroll
        for (int r = 0; r < 16; ++r) { const int low = 127 - (32 * kb + (r & 3) + 8 * (r >> 2)) - 4 * hi; K[r] = (ord_key(acc[r]) & ~127u) | (unsigned)low; }
        if (i == 3) RT_LOADQ(1);
        SORT16_DESC(K);
        if (kb == 0) {
#pragma unroll
            for (int j = 0; j < 16; ++j) T[j] = K[j];
        } else { TOP16(T, K); }
        if (kb == 3) {
            unsigned O[16];
#pragma unroll
            for (int j = 0; j < 16; ++j) { auto rr = __builtin_amdgcn_permlane32_swap(T[j], T[j], false, false); O[j] = hi ? rr[0] : rr[1]; }
            TOP16(T, O);
#pragma unroll
            for (int j = 0; j < 16; ++j) top[p][j] = T[j];
        }
        __builtin_amdgcn_sched_barrier(0);
    }
#undef RT_LOADQ
#undef RT_LOADK
    float s1[16], s2[16];
#pragma unroll
    for (int i = 0; i < 16; ++i) {
        s1[i] = ord_val(top[0][i] & ~127u) * rstd; s2[i] = ord_val(top[1][i] & ~127u) * rstd;
        scr[i * 64 + lane] = 127 - (int)(top[0][i] & 127u); scr[(16 + i) * 64 + lane] = 127 - (int)(top[1][i] & 127u);
    }
#define CKEY(a_, b_) ((ord_key(s1[a_] + s2[b_]) & ~255u) | (unsigned)(255 - (16 * (a_) + (b_))))
    unsigned A[16], B[16], Cg[16];
#pragma unroll
    for (int b_ = 0; b_ < 16; ++b_) A[b_] = CKEY(0, b_);
#pragma unroll
    for (int b_ = 0; b_ < 8; ++b_) { B[b_] = CKEY(1, b_); B[8 + b_] = CKEY(15 - b_, 0); }
    BMERGE16_DESC(B);
    Cg[0] = CKEY(2, 0); Cg[1] = CKEY(2, 1); Cg[2] = CKEY(2, 2); Cg[3] = CKEY(2, 3); Cg[4] = CKEY(2, 4);
    Cg[5] = CKEY(3, 0); Cg[6] = CKEY(3, 1); Cg[7] = CKEY(3, 2); Cg[8] = CKEY(3, 3);
    Cg[9] = CKEY(4, 0); Cg[10] = CKEY(4, 1); Cg[11] = CKEY(4, 2);
    Cg[12] = CKEY(5, 0); Cg[13] = CKEY(5, 1); Cg[14] = CKEY(6, 0); Cg[15] = CKEY(6, 1);
    SORT16_DESC(Cg);
    { const unsigned d0 = CKEY(7, 0), d1 = CKEY(7, 1); Cg[15] = fmaxu(Cg[15], d0); Cg[14] = fmaxu(Cg[14], d1); BMERGE16_DESC(Cg); }
    TOP16(A, B); TOP16(A, Cg);
#undef CKEY
    asm volatile("s_waitcnt lgkmcnt(0)" ::: "memory");
    float e[16]; float z = 0.f; const float mx = ord_val(A[0] & ~255u);
#pragma unroll
    for (int j = 0; j < 16; ++j) { e[j] = __expf(ord_val(A[j] & ~255u) - mx); z += e[j]; }
    const float rz = 1.f / z;
    int* ip = IDX + (size_t)row * 128 + h * 16 + hi * 8; float* gp = GATE + (size_t)row * 128 + h * 16 + hi * 8;
    int oi[8] = {0, 0, 0, 0, 0, 0, 0, 0}; float og[8] = {0.f, 0.f, 0.f, 0.f, 0.f, 0.f, 0.f, 0.f};
#pragma unroll
    for (int j = 0; j < 16; ++j) {
        const int flat = 255 - (int)(A[j] & 255u), a_ = flat >> 4, b_ = flat & 15;
        const int ex = scr[a_ * 64 + lane] * 128 + scr[(16 + b_) * 64 + lane];
        if (j < 8) { if (!hi) { oi[j] = ex; og[j] = e[j] * rz; } } else { if (hi) { oi[j - 8] = ex; og[j - 8] = e[j] * rz; } }
    }
    *(int4*)(ip) = make_int4(oi[0], oi[1], oi[2], oi[3]); *(int4*)(ip + 4) = make_int4(oi[4], oi[5], oi[6], oi[7]);
    *(float4*)(gp) = make_float4(og[0], og[1], og[2], og[3]); *(float4*)(gp + 4) = make_float4(og[4], og[5], og[6], og[7]);
    asm volatile("s_waitcnt lgkmcnt(0)" ::: "memory");
}
#undef CE
#undef TOP16
}

__device__ __forceinline__ void phase_route(const Args& a, unsigned char* lds, int bid, int nb) {
    const int tid = opaque_tid(), wave = __builtin_amdgcn_readfirstlane(tid >> 6), lane = tid & 63;
    const bf16_t* QP = (const bf16_t*)(a.ws + WS_MIX); const bf16_t* SKB = (const bf16_t*)(a.ws + WS_SKB); const float* SSQ = (const float*)(a.ws + WS_SSQ);
    int* IDX = (int*)(a.ws + WS_IDX); float* GATE = (float*)(a.ws + WS_GATE);
    int* scr = (int*)lds + wave * 2048;
    {
        const bf16_t* X1W = (const bf16_t*)(a.ws + WS_HN); signed char* X1Q = (signed char*)(a.ws + WS_X1Q); float* XSC = (float*)(a.ws + WS_XSC);
        for (int row = bid * NWAVES + wave; row < TREAL; row += nb * NWAVES) {
            uint4 xr[4]; float am = 0.f;
#pragma unroll
            for (int j = 0; j < 4; ++j) { xr[j] = *(const uint4*)(X1W + (size_t)row * DM + 8 * lane + 512 * j);
                am = fmaxf(am, fmaxf(fmaxf(fmaxf(fabsf(bf_lo(xr[j].x)), fabsf(bf_hi(xr[j].x))), fmaxf(fabsf(bf_lo(xr[j].y)), fabsf(bf_hi(xr[j].y)))), fmaxf(fmaxf(fabsf(bf_lo(xr[j].z)), fabsf(bf_hi(xr[j].z))), fmaxf(fabsf(bf_lo(xr[j].w)), fabsf(bf_hi(xr[j].w)))))); }
            am = wave_max(am);
            const float sc = am > 0.f ? 127.f / am : 0.f;
#pragma unroll
            for (int j = 0; j < 4; ++j) {
                const unsigned ww[4] = {xr[j].x, xr[j].y, xr[j].z, xr[j].w}; unsigned o[2] = {0u, 0u};
#pragma unroll
                for (int q = 0; q < 4; ++q) { const int q0 = (int)rintf(bf_lo(ww[q]) * sc), q1 = (int)rintf(bf_hi(ww[q]) * sc); o[q >> 1] |= ((unsigned)(q0 & 255) | ((unsigned)(q1 & 255) << 8)) << (16 * (q & 1)); }
                *(uint2*)(X1Q + (size_t)row * DM + 8 * lane + 512 * j) = make_uint2(o[0], o[1]);
            }
            if (lane == 0) XSC[row] = am * (1.f / 127.f);
        }
    }
    for (int item = bid * NWAVES + wave; item < (TREAL / 32) * 8; item += nb * NWAVES) rt::route_item(item >> 3, item & 7, QP, SKB, SSQ, IDX, GATE, scr, lane);
}

constexpr int CW_QPV = 8192, CW_QPU = 8192 + 8 * 64;
constexpr int PX_ITEMS = TREAL / 64;
constexpr size_t WS_W = WS_Z + 4 * MiB, WS_PART = WS_Z + 32 * MiB, WS_Y = WS_Z + 160 * MiB;


template <int CTRL, int RMASK> __device__ __forceinline__ float dppf(float old, float v) { return __builtin_bit_cast(float, __builtin_amdgcn_update_dpp(__builtin_bit_cast(int, old), __builtin_bit_cast(int, v), CTRL, RMASK, 0xf, false)); }
template <int CTRL> __device__ __forceinline__ int dppi(int v) { return __builtin_amdgcn_update_dpp(0, v, CTRL, 0xf, 0xf, false); }
namespace pu2 {
typedef float f32x2v __attribute__((ext_vector_type(2)));
typedef unsigned u32x4v __attribute__((ext_vector_type(4)));
#define SBP() __builtin_amdgcn_sched_barrier(0)
#define PU_CHUNK_LD(dst, r_, q_) dst = __builtin_amdgcn_raw_buffer_load_b128(RI, g128, (r_) * 512 + (q_) * 16, 0)
#define PU_ROW_LD(buf, e_) buf = __builtin_amdgcn_raw_buffer_load_b128(U, (int)(e_) * 256 + c16, 0, 0)
#define PU_CONSUME(buf, I_) do { int s_ = __builtin_amdgcn_sdot4((int)buf[0], hq0, 0, false); s_ = __builtin_amdgcn_sdot4((int)buf[1], hq1, s_, false); \
    s_ = __builtin_amdgcn_sdot4((int)buf[2], hq2, s_, false); s_ = __builtin_amdgcn_sdot4((int)buf[3], hq3, s_, false); \
    s_ += dppi<0x128>(s_); s_ += dppi<0x124>(s_); s_ += dppi<0x122>(s_); s_ += dppi<0x121>(s_); \
    if ((I_) < 16) keep0 = (c == ((I_) & 15)) ? s_ : keep0; else keep1 = (c == ((I_) & 15)) ? s_ : keep1; } while (0)
#define PU_TOKEN_BODY(row_, nrow_, has_next_) do { \
    PU_CHUNK_LD(C7, row_, 7); \
    SBP(); PU_CONSUME(B0, 0); \
    PU_ROW_LD(B0, C2.x); \
    SBP(); PU_CONSUME(B1, 1); \
    PU_ROW_LD(B1, C2.y); \
    SBP(); PU_CONSUME(B2, 2); \
    PU_ROW_LD(B2, C2.z); \
    SBP(); PU_CONSUME(B3, 3); \
    PU_ROW_LD(B3, C2.w); \
    if (has_next_) PU_CHUNK_LD(C0, nrow_, 0); \
    SBP(); PU_CONSUME(B4, 4); \
    PU_ROW_LD(B4, C3.x); \
    SBP(); PU_CONSUME(B5, 5); \
    PU_ROW_LD(B5, C3.y); \
    SBP(); PU_CONSUME(B6, 6); \
    PU_ROW_LD(B6, C3.z); \
    SBP(); PU_CONSUME(B7, 7); \
    PU_ROW_LD(B7, C3.w); \
    if (has_next_) PU_CHUNK_LD(C1, nrow_, 1); \
    SBP(); PU_CONSUME(B0, 8); \
    PU_ROW_LD(B0, C4.x); \
    SBP(); PU_CONSUME(B1, 9); \
    PU_ROW_LD(B1, C4.y); \
    SBP(); PU_CONSUME(B2, 10); \
    PU_ROW_LD(B2, C4.z); \
    SBP(); PU_CONSUME(B3, 11); \
    PU_ROW_LD(B3, C4.w); \
    if (has_next_) PU_CHUNK_LD(C2, nrow_, 2); \
    SBP(); PU_CONSUME(B4, 12); \
    PU_ROW_LD(B4, C5.x); \
    SBP(); PU_CONSUME(B5, 13); \
    PU_ROW_LD(B5, C5.y); \
    SBP(); PU_CONSUME(B6, 14); \
    PU_ROW_LD(B6, C5.z); \
    SBP(); PU_CONSUME(B7, 15); \
    PU_ROW_LD(B7, C5.w); \
    if (has_next_) PU_CHUNK_LD(C3, nrow_, 3); \
    SBP(); PU_CONSUME(B0, 16); \
    PU_ROW_LD(B0, C6.x); \
    SBP(); PU_CONSUME(B1, 17); \
    PU_ROW_LD(B1, C6.y); \
    SBP(); PU_CONSUME(B2, 18); \
    PU_ROW_LD(B2, C6.z); \
    SBP(); PU_CONSUME(B3, 19); \
    PU_ROW_LD(B3, C6.w); \
    if (has_next_) PU_CHUNK_LD(C4, nrow_, 4); \
    SBP(); PU_CONSUME(B4, 20); \
    PU_ROW_LD(B4, C7.x); \
    SBP(); PU_CONSUME(B5, 21); \
    PU_ROW_LD(B5, C7.y); \
    SBP(); PU_CONSUME(B6, 22); \
    PU_ROW_LD(B6, C7.z); \
    SBP(); PU_CONSUME(B7, 23); \
    PU_ROW_LD(B7, C7.w); \
    if (has_next_) PU_CHUNK_LD(C5, nrow_, 5); \
    SBP(); PU_CONSUME(B0, 24); \
    if (has_next_) PU_ROW_LD(B0, C0.x); \
    SBP(); PU_CONSUME(B1, 25); \
    if (has_next_) PU_ROW_LD(B1, C0.y); \
    SBP(); PU_CONSUME(B2, 26); \
    if (has_next_) PU_ROW_LD(B2, C0.z); \
    SBP(); PU_CONSUME(B3, 27); \
    if (has_next_) PU_ROW_LD(B3, C0.w); \
    if (has_next_) PU_CHUNK_LD(C6, nrow_, 6); \
    SBP(); PU_CONSUME(B4, 28); \
    if (has_next_) PU_ROW_LD(B4, C1.x); \
    SBP(); PU_CONSUME(B5, 29); \
    if (has_next_) PU_ROW_LD(B5, C1.y); \
    SBP(); PU_CONSUME(B6, 30); \
    if (has_next_) PU_ROW_LD(B6, C1.z); \
    SBP(); PU_CONSUME(B7, 31); \
    if (has_next_) PU_ROW_LD(B7, C1.w); \
    } while (0)
#undef SBP
}

__device__ __forceinline__ void phase_pu(const Args& a, unsigned char* lds, unsigned* ctl, int xcc) {
    using namespace pu2;
#define SBP() __builtin_amdgcn_sched_barrier(0)
    const int tid = opaque_tid(), wave = __builtin_amdgcn_readfirstlane(tid >> 6), lane = tid & 63;
    volatile LAS unsigned* slot = (volatile LAS unsigned*)((LAS unsigned char*)lds + LDS_MISC) + 2;
    const signed char* X1Q = (const signed char*)(a.ws + WS_X1Q); float* PART = (float*)(a.ws + WS_PART);
    const __amdgpu_buffer_rsrc_t RI = __builtin_amdgcn_make_buffer_rsrc((void*)(a.ws + WS_IDX), (short)0, TREAL * 512, 0x00020000);
    for (int ss = 0; ss < 8; ++ss) {
        const int s = (xcc + ss) & 7;
        const __amdgpu_buffer_rsrc_t U = __builtin_amdgcn_make_buffer_rsrc((void*)(a.ws + WS_U + (size_t)s * (16384 * 256)), (short)0, 16384 * 256, 0x00020000);
        for (;;) {
            const int item = next_item(ctl + CW_QPU + 64 * s, slot);
            if (item >= PX_ITEMS) break;
            int ln = lane; asm volatile("" : "+v"(ln));
            const int g = ln >> 4, c = ln & 15, c16 = c * 16, g128 = g * 128;
            const int r0 = item * 64 + wave * 8;
            u32x4v C0, C1, C2, C3, C4, C5, C6, C7, B0, B1, B2, B3, B4, B5, B6, B7;
            PU_CHUNK_LD(C0, r0, 0); PU_CHUNK_LD(C1, r0, 1); PU_CHUNK_LD(C2, r0, 2); PU_CHUNK_LD(C3, r0, 3); PU_CHUNK_LD(C4, r0, 4); PU_CHUNK_LD(C5, r0, 5); PU_CHUNK_LD(C6, r0, 6);
            uint4 nxq = *(const uint4*)(X1Q + (size_t)r0 * DM + 256 * s + 16 * c);
            PU_ROW_LD(B0, C0.x); PU_ROW_LD(B1, C0.y); PU_ROW_LD(B2, C0.z); PU_ROW_LD(B3, C0.w); PU_ROW_LD(B4, C1.x); PU_ROW_LD(B5, C1.y); PU_ROW_LD(B6, C1.z); PU_ROW_LD(B7, C1.w);
#pragma unroll 1
            for (int t = 0; t < 8; ++t) {
                const int row = r0 + t, nrow = row + 1; const bool has_next = t < 7;
                const int hq0 = (int)nxq.x, hq1 = (int)nxq.y, hq2 = (int)nxq.z, hq3 = (int)nxq.w;
                if (has_next) nxq = *(const uint4*)(X1Q + (size_t)nrow * DM + 256 * s + 16 * c);
                int keep0 = 0, keep1 = 0;
                PU_TOKEN_BODY(row, nrow, has_next);
                float* pp = PART + (size_t)row * 1024 + s * 128 + 32 * g + c;
                pp[0] = (float)keep0; pp[16] = (float)keep1;
            }
        }
    }
#undef SBP
}
__device__ __forceinline__ void phase_pc(const Args& a, int bid, int nb) {
    const int tid = opaque_tid(), wave = __builtin_amdgcn_readfirstlane(tid >> 6), lane = tid & 63;
    const float* SSQ = (const float*)(a.ws + WS_SSQ); const int* IDX = (const int*)(a.ws + WS_IDX); const float* GATE = (const float*)(a.ws + WS_GATE);
    const float* ISC = (const float*)(a.ws + WS_ISC); const float* PART = (const float*)(a.ws + WS_PART); float* W = (float*)(a.ws + WS_W);
    for (int row = bid * NWAVES + wave; row < TREAL; row += nb * NWAVES) {
        float ssv = lane < 32 ? SSQ[(size_t)row * 32 + lane] : 0.f; ssv = wave_sum(ssv);
        const float rstd = rsqrtf(ssv * (1.f / DM) + EPS);
        const float xsc = ((const float*)(a.ws + WS_XSC))[row];
#pragma unroll
        for (int k = 0; k < 2; ++k) {
            const int p = 64 * k + lane; float d = 0.f;
#pragma unroll
            for (int s = 0; s < 8; ++s) d += PART[(size_t)row * 1024 + s * 128 + p];
            const int e = IDX[(size_t)row * 128 + p];
            const float pre = d * rstd * ISC[e] * xsc;
            W[(size_t)row * 128 + p] = GATE[(size_t)row * 128 + p] * ISC[16384 + e] * (0.5f * pre * (1.f + erff(pre * 0.7071067811865476f)));
        }
    }
}
namespace pv2 {
typedef float f32x2v __attribute__((ext_vector_type(2)));
typedef unsigned u32x4v __attribute__((ext_vector_type(4))); typedef float f32x4v __attribute__((ext_vector_type(4)));
struct Chunk { u32x4v i; f32x4v w; };
#define SBP() __builtin_amdgcn_sched_barrier(0)
#define PV_CHUNK_LD(dst, r_, q_) do { dst.i = __builtin_bit_cast(u32x4v, __builtin_amdgcn_raw_buffer_load_b128(RI, g128, (r_) * 512 + (q_) * 16, 0)); dst.w = __builtin_bit_cast(f32x4v, __builtin_amdgcn_raw_buffer_load_b128(RW, g128, (r_) * 512 + (q_) * 16, 0)); } while (0)
#define PV_ROW_LD(buf, e_) buf = __builtin_amdgcn_raw_buffer_load_b128(V, (int)(e_) * 256 + c16, 0, 0)
#define PV_CONSUME(buf, w_) do { const f32x2v w2_ = {w_, w_}; const unsigned d_[4] = {buf[0], buf[1], buf[2], buf[3]}; \
    _Pragma("unroll") for (int k_ = 0; k_ < 4; ++k_) { const f32x2v lo_ = __builtin_amdgcn_cvt_pk_f32_fp8((int)d_[k_], false), hi_ = __builtin_amdgcn_cvt_pk_f32_fp8((int)d_[k_], true); \
        asm("v_pk_fma_f32 %0, %1, %2, %0" : "+v"(y2[2 * k_]) : "v"(lo_), "v"(w2_)); asm("v_pk_fma_f32 %0, %1, %2, %0" : "+v"(y2[2 * k_ + 1]) : "v"(hi_), "v"(w2_)); } } while (0)
#define PV_TOKEN_BODY(row_, nrow_, has_next_) do { \
    PV_CHUNK_LD(C7, row_, 7); \
    SBP(); PV_CONSUME(B0, C0.w.x); \
    PV_ROW_LD(B0, C2.i.x); \
    SBP(); PV_CONSUME(B1, C0.w.y); \
    PV_ROW_LD(B1, C2.i.y); \
    SBP(); PV_CONSUME(B2, C0.w.z); \
    PV_ROW_LD(B2, C2.i.z); \
    SBP(); PV_CONSUME(B3, C0.w.w); \
    PV_ROW_LD(B3, C2.i.w); \
    if (has_next_) PV_CHUNK_LD(C0, nrow_, 0); \
    SBP(); PV_CONSUME(B4, C1.w.x); \
    PV_ROW_LD(B4, C3.i.x); \
    SBP(); PV_CONSUME(B5, C1.w.y); \
    PV_ROW_LD(B5, C3.i.y); \
    SBP(); PV_CONSUME(B6, C1.w.z); \
    PV_ROW_LD(B6, C3.i.z); \
    SBP(); PV_CONSUME(B7, C1.w.w); \
    PV_ROW_LD(B7, C3.i.w); \
    if (has_next_) PV_CHUNK_LD(C1, nrow_, 1); \
    SBP(); PV_CONSUME(B0, C2.w.x); \
    PV_ROW_LD(B0, C4.i.x); \
    SBP(); PV_CONSUME(B1, C2.w.y); \
    PV_ROW_LD(B1, C4.i.y); \
    SBP(); PV_CONSUME(B2, C2.w.z); \
    PV_ROW_LD(B2, C4.i.z); \
    SBP(); PV_CONSUME(B3, C2.w.w); \
    PV_ROW_LD(B3, C4.i.w); \
    if (has_next_) PV_CHUNK_LD(C2, nrow_, 2); \
    SBP(); PV_CONSUME(B4, C3.w.x); \
    PV_ROW_LD(B4, C5.i.x); \
    SBP(); PV_CONSUME(B5, C3.w.y); \
    PV_ROW_LD(B5, C5.i.y); \
    SBP(); PV_CONSUME(B6, C3.w.z); \
    PV_ROW_LD(B6, C5.i.z); \
    SBP(); PV_CONSUME(B7, C3.w.w); \
    PV_ROW_LD(B7, C5.i.w); \
    if (has_next_) PV_CHUNK_LD(C3, nrow_, 3); \
    SBP(); PV_CONSUME(B0, C4.w.x); \
    PV_ROW_LD(B0, C6.i.x); \
    SBP(); PV_CONSUME(B1, C4.w.y); \
    PV_ROW_LD(B1, C6.i.y); \
    SBP(); PV_CONSUME(B2, C4.w.z); \
    PV_ROW_LD(B2, C6.i.z); \
    SBP(); PV_CONSUME(B3, C4.w.w); \
    PV_ROW_LD(B3, C6.i.w); \
    if (has_next_) PV_CHUNK_LD(C4, nrow_, 4); \
    SBP(); PV_CONSUME(B4, C5.w.x); \
    PV_ROW_LD(B4, C7.i.x); \
    SBP(); PV_CONSUME(B5, C5.w.y); \
    PV_ROW_LD(B5, C7.i.y); \
    SBP(); PV_CONSUME(B6, C5.w.z); \
    PV_ROW_LD(B6, C7.i.z); \
    SBP(); PV_CONSUME(B7, C5.w.w); \
    PV_ROW_LD(B7, C7.i.w); \
    if (has_next_) PV_CHUNK_LD(C5, nrow_, 5); \
    SBP(); PV_CONSUME(B0, C6.w.x); \
    if (has_next_) PV_ROW_LD(B0, C0.i.x); \
    SBP(); PV_CONSUME(B1, C6.w.y); \
    if (has_next_) PV_ROW_LD(B1, C0.i.y); \
    SBP(); PV_CONSUME(B2, C6.w.z); \
    if (has_next_) PV_ROW_LD(B2, C0.i.z); \
    SBP(); PV_CONSUME(B3, C6.w.w); \
    if (has_next_) PV_ROW_LD(B3, C0.i.w); \
    if (has_next_) PV_CHUNK_LD(C6, nrow_, 6); \
    SBP(); PV_CONSUME(B4, C7.w.x); \
    if (has_next_) PV_ROW_LD(B4, C1.i.x); \
    SBP(); PV_CONSUME(B5, C7.w.y); \
    if (has_next_) PV_ROW_LD(B5, C1.i.y); \
    SBP(); PV_CONSUME(B6, C7.w.z); \
    if (has_next_) PV_ROW_LD(B6, C1.i.z); \
    SBP(); PV_CONSUME(B7, C7.w.w); \
    if (has_next_) PV_ROW_LD(B7, C1.i.w); \
    } while (0)
}

__device__ __forceinline__ void phase_pv(const Args& a, unsigned char* lds, unsigned* ctl, int xcc) {
    using namespace pv2;
    const int tid = opaque_tid(), wave = __builtin_amdgcn_readfirstlane(tid >> 6), lane = tid & 63;
    volatile LAS unsigned* slot = (volatile LAS unsigned*)((LAS unsigned char*)lds + LDS_MISC) + 2;
    bf16_t* Y = (bf16_t*)(a.ws + WS_Y);
    const __amdgpu_buffer_rsrc_t RI = __builtin_amdgcn_make_buffer_rsrc((void*)(a.ws + WS_IDX), (short)0, TREAL * 512, 0x00020000);
    const __amdgpu_buffer_rsrc_t RW = __builtin_amdgcn_make_buffer_rsrc((void*)(a.ws + WS_W), (short)0, TREAL * 512, 0x00020000);
    float* ybuf = (float*)lds + wave * 1024;
    for (int ss = 0; ss < 8; ++ss) {
        const int s = (xcc + ss) & 7;
        const __amdgpu_buffer_rsrc_t V = __builtin_amdgcn_make_buffer_rsrc((void*)(a.ws + WS_V + (size_t)s * (16384 * 256)), (short)0, 16384 * 256, 0x00020000);
        for (;;) {
            const int item = next_item(ctl + CW_QPV + 64 * s, slot);
            if (item >= PX_ITEMS) break;
            int ln = lane; asm volatile("" : "+v"(ln));
            const int g = ln >> 4, c = ln & 15, c16 = c * 16, g128 = g * 128;
            const int r0 = item * 64 + wave * 8;
            Chunk C0, C1, C2, C3, C4, C5, C6, C7; u32x4v B0, B1, B2, B3, B4, B5, B6, B7;
            PV_CHUNK_LD(C0, r0, 0); PV_CHUNK_LD(C1, r0, 1); PV_CHUNK_LD(C2, r0, 2); PV_CHUNK_LD(C3, r0, 3); PV_CHUNK_LD(C4, r0, 4); PV_CHUNK_LD(C5, r0, 5); PV_CHUNK_LD(C6, r0, 6);
            PV_ROW_LD(B0, C0.i.x); PV_ROW_LD(B1, C0.i.y); PV_ROW_LD(B2, C0.i.z); PV_ROW_LD(B3, C0.i.w); PV_ROW_LD(B4, C1.i.x); PV_ROW_LD(B5, C1.i.y); PV_ROW_LD(B6, C1.i.z); PV_ROW_LD(B7, C1.i.w);
#pragma unroll 1
            for (int t = 0; t < 8; ++t) {
                const int row = r0 + t, nrow = row + 1; const bool has_next = t < 7;
                f32x2v y2[8];
#pragma unroll
                for (int k = 0; k < 8; ++k) y2[k] = (f32x2v){0.f, 0.f};
                PV_TOKEN_BODY(row, nrow, has_next);
                float4* yb = (float4*)(ybuf + ln * 16);
#pragma unroll
                for (int k = 0; k < 4; ++k) yb[k] = make_float4(y2[2 * k][0], y2[2 * k][1], y2[2 * k + 1][0], y2[2 * k + 1][1]);
                asm volatile("s_waitcnt lgkmcnt(0)" ::: "memory");
                if (g == 0) {
                    unsigned yo[8];
#pragma unroll
                    for (int k = 0; k < 4; ++k) {
                        const float4 y0 = yb[k], y1 = yb[64 + k], y2b = yb[128 + k], y3 = yb[192 + k];
                        yo[2 * k] = pk2((y0.x + y1.x) + (y2b.x + y3.x), (y0.y + y1.y) + (y2b.y + y3.y)); yo[2 * k + 1] = pk2((y0.z + y1.z) + (y2b.z + y3.z), (y0.w + y1.w) + (y2b.w + y3.w));
                    }
                    uint4* yp = (uint4*)(Y + (size_t)row * DM + 256 * s + 16 * c);
                    yp[0] = make_uint4(yo[0], yo[1], yo[2], yo[3]); yp[1] = make_uint4(yo[4], yo[5], yo[6], yo[7]);
                }
                asm volatile("s_waitcnt lgkmcnt(0)" ::: "memory");
            }
        }
    }
}
__device__ __forceinline__ void phase_pn(const Args& a, int bid, int nb) {
    const int tid = opaque_tid(), wave = __builtin_amdgcn_readfirstlane(tid >> 6), lane = tid & 63;
    const bf16_t* Y = (const bf16_t*)(a.ws + WS_Y); const bf16_t* X1 = (const bf16_t*)(a.ws + WS_HN);
    for (int row = bid * NWAVES + wave; row < TREAL; row += nb * NWAVES) {
        f32x4* p = (f32x4*)(a.out + (size_t)row * DM) + lane;
        const uint2* yp = (const uint2*)(Y + (size_t)row * DM) + lane; const uint2* xp = (const uint2*)(X1 + (size_t)row * DM) + lane;
        f32x4 v[8]; float ss = 0.f;
#pragma unroll
        for (int j = 0; j < 8; ++j) { const uint2 yy = yp[64 * j], xx = xp[64 * j];
            v[j][0] = bf_lo(xx.x) + bf_lo(yy.x); v[j][1] = bf_hi(xx.x) + bf_hi(yy.x); v[j][2] = bf_lo(xx.y) + bf_lo(yy.y); v[j][3] = bf_hi(xx.y) + bf_hi(yy.y);
            ss += (v[j][0] * v[j][0] + v[j][1] * v[j][1]) + (v[j][2] * v[j][2] + v[j][3] * v[j][3]); }
        const float r = rsqrtf(wave_sum(ss) * (1.f / DM) + EPS);
        const f32x4* wp = (const f32x4*)a.nfinal + lane;
#pragma unroll
        for (int j = 0; j < 8; ++j) p[64 * j] = v[j] * r * wp[64 * j];
    }
}

__device__ __forceinline__ void phase_mix(const Args& a, unsigned char* lds, unsigned* ctr) {
    const bf16_t* Z = (const bf16_t*)(a.ws + WS_Z); bf16_t* MIX = (bf16_t*)(a.ws + WS_MIX);
    volatile LAS unsigned* slot = (volatile LAS unsigned*)((LAS unsigned char*)lds + LDS_MISC) + 2;
    for (;;) {
        const int item = next_item(ctr, slot);
        if (item >= 64 + 2048) break;
        if (item < 64) mls::mlstm_item(item >> 2, item & 3, a, (char*)lds);
        else { const int k = item - 64, qb = 15 - (k >> 7), bh = k & 127; const float lam = attn_lambda(a); att::attn_unit(bh >> 3, bh & 7, qb, Z, MIX, lam, a.subln, (char*)lds); }
    }
}

__global__ void __launch_bounds__(NTHREADS, 2) mega(Args a) {
    extern __shared__ __attribute__((aligned(16))) unsigned char lds[];
    cg::grid_group grid = cg::this_grid();
    const int bid = blockIdx.x, nb = gridDim.x;
    unsigned char* ws = a.ws;
    bf16_t* WinT = (bf16_t*)(ws + WS_WIN); bf16_t* WoutT = (bf16_t*)(ws + WS_WOUT); bf16_t* WqT = (bf16_t*)(ws + WS_WQ);
    float* rope = (float*)(ws + WS_ROPE); float* SSQ = (float*)(ws + WS_SSQ);
    bf16_t* HN = (bf16_t*)(ws + WS_HN); bf16_t* MIX = (bf16_t*)(ws + WS_MIX); bf16_t* Z = (bf16_t*)(ws + WS_Z);

    volatile LAS unsigned* MISC = (volatile LAS unsigned*)((LAS unsigned char*)lds + LDS_MISC);
    if (threadIdx.x < 16) MISC[threadIdx.x] = 0u;
    __syncthreads();
    unsigned* ctl = (unsigned*)(ws + WS_CTL);
    XcdBarrier bar = xcd_barrier_post(ctl + CW_BAR, MISC);
    phase_prep(a, lds, bid, nb);
    grid.sync();
    { pg8::Gemm g{HN, WinT, MROWS, NZ, DM}; EpiZ E{Z, rope}; pg8::StaticOrder S; S.init(g.M, g.N, nb, bid);
      pg8::gemm_phase<EpiZ, pg8::StaticOrder, true, true>((PG8_LAS unsigned char*)lds, g, S, E); }
    phase_tables(a, lds, ctl);
    xcd_barrier(bar);
    phase_mix(a, lds, ctl + CW_QUEUE);
    xcd_barrier(bar);
    { pg8::Gemm g{MIX, WoutT, TREAL, DM, DM}; EpiX1 E{a.x, HN, SSQ}; pg8::StaticOrder S; S.init(g.M, g.N, nb, bid);
      pg8::gemm_phase<EpiX1, pg8::StaticOrder, true, true>((PG8_LAS unsigned char*)lds, g, S, E); }
    xcd_barrier(bar);
    { pg8::Gemm g{HN, WqT, TREAL, DM, DM}; pg8::EpiBf16<0> E{MIX, DM, nullptr, 0, 0, 1.f}; pg8::StaticOrder S; S.init(g.M, g.N, nb, bid);
      pg8::gemm_phase<pg8::EpiBf16<0>, pg8::StaticOrder, true, true>((PG8_LAS unsigned char*)lds, g, S, E); }
    xcd_barrier(bar);
    phase_route(a, lds, bid, nb);
    xcd_barrier(bar);
    { const int xcc = (int)(xb_xcc_id() & 7u);
      phase_pu(a, lds, ctl, xcc); xcd_barrier(bar);
      phase_pc(a, bid, nb); xcd_barrier(bar);
      phase_pv(a, lds, ctl, xcc); xcd_barrier(bar);
      phase_pn(a, bid, nb); }
}

extern "C" void kernel_launch(void* const* d_in, const int* in_sizes, int n_in, void* d_out, int out_size, void* d_ws, size_t ws_size, hipStream_t stream) {
    if (n_in != 18 || out_size != TREAL * DM || ws_size < WS_END) { fprintf(stderr, "kernel_launch: unexpected shapes n_in %d out %d ws %zu (need %zu)\n", n_in, out_size, ws_size, (size_t)WS_END); return; }
    static int grid_blocks = 0;
    if (!grid_blocks) {
        int dev = 0, cus = 0, per_cu = 0;
        (void)hipGetDevice(&dev);
        (void)hipDeviceGetAttribute(&cus, hipDeviceAttributeMultiprocessorCount, dev);
        (void)hipFuncSetAttribute((const void*)mega, hipFuncAttributeMaxDynamicSharedMemorySize, LDS_BYTES);
        (void)hipOccupancyMaxActiveBlocksPerMultiprocessor(&per_cu, (const void*)mega, NTHREADS, LDS_BYTES);
        if (per_cu < 1) { fprintf(stderr, "kernel_launch: occupancy query says %d blocks/CU\n", per_cu); per_cu = 1; }
        if (per_cu > 1) per_cu = 1;
        grid_blocks = cus * per_cu;
    }
    Args a{};
    a.x = (const float*)d_in[0]; a.meta = (const float*)d_in[1]; a.nmw = (const float*)d_in[2]; a.w_in = (const float*)d_in[3];
    a.lamqk = (const float*)d_in[4]; a.subln = (const float*)d_in[5]; a.convw = (const float*)d_in[6]; a.convb = (const float*)d_in[7];
    a.ib = (const float*)d_in[8]; a.fb = (const float*)d_in[9]; a.mnw = (const float*)d_in[10]; a.w_out = (const float*)d_in[11];
    a.nfw_ffn = (const float*)d_in[12]; a.w_q = (const float*)d_in[13]; a.subkeys = (const float*)d_in[14]; a.pu = (const float*)d_in[15];
    a.pv = (const float*)d_in[16]; a.nfinal = (const float*)d_in[17];
    a.out = (float*)d_out; a.ws = (unsigned char*)d_ws;
    (void)hipMemsetAsync((char*)d_ws + WS_CTL, 0, 65536, stream);
    void* kargs[] = {&a};
    const hipError_t e = hipLaunchCooperativeKernel((const void*)mega, dim3(grid_blocks), dim3(NTHREADS), kargs, LDS_BYTES, stream);
    if (e != hipSuccess) fprintf(stderr, "kernel_launch: cooperative launch failed: %s (grid %d)\n", hipGetErrorString(e), grid_blocks);
}
```

```cpp
#include <hip/hip_runtime.h>
#include <hip/hip_bf16.h>
#include <cstdio>
#include <cstdint>
#include <cmath>
namespace pg8 {
#define PG8_LAS __attribute__((address_space(3)))
typedef unsigned short bf16_t;
typedef short bf16x8 __attribute__((ext_vector_type(8)));
typedef float f32x4 __attribute__((ext_vector_type(4)));
typedef unsigned u32x4 __attribute__((ext_vector_type(4)));
constexpr int BM = 256, BK = 64, HALF = 128, HTB = HALF * BK * 2  , STAGE_BYTES = 8 * HTB, NXCD = 8, WGM = 8;

__host__ __device__ __forceinline__ int lds_byte(int r, int c) { const int st = (r >> 4) * 2 + (c >> 5), rr = r & 15, cc = c & 31, ob = rr * 64 + cc * 2; return st * 1024 + (ob ^ (((ob >> 9) & 1) << 5)); }
__host__ __device__ __forceinline__ void stage_rc(int b, int& R, int& C) { const int st = b / 1024, sb = b % 1024, swz = sb ^ (((sb >> 9) & 1) << 5); R = (st >> 1) * 16 + swz / 64; C = (st & 1) * 32 + (swz % 64) / 2; }
__host__ __device__ __forceinline__ int perm32(int rho) { const int n = rho >> 4, i = rho & 15; return 8 * (i >> 2) + 4 * n + (i & 3); }

struct Unit { int pm, pn; };
struct Gemm { const bf16_t* A; const bf16_t* Bt; int M, N, K; };

struct StaticOrder {
    int nM, nN, nwg, G, c;
    __host__ __device__ void init(int M, int N, int G_, int c_) { nM = M / BM; nN = N / BM; nwg = nM * nN; G = G_; c = c_; }
    __host__ __device__ bool next(int i, Unit& u) const {
        const long L = (long)i * G + c; if (L >= nwg) return false;
        int wgid = (int)L; { const int q = nwg / NXCD, r = nwg % NXCD, xcd = wgid % NXCD, off = wgid / NXCD; wgid = (xcd < r ? xcd * (q + 1) : r * (q + 1) + (xcd - r) * q) + off; }
        const int nig = WGM * nN, gid = wgid / nig, fm = gid * WGM, gsz = (nM - fm) < WGM ? (nM - fm) : WGM;
        u.pm = fm + ((wgid % nig) % gsz); u.pn = (wgid % nig) / gsz; return true;
    }
    __device__ __forceinline__ void a_ready(const Unit&) const {}
    __device__ __forceinline__ void done(const Unit&) const {}
};

__device__ __forceinline__ unsigned cvt_pk_bf16(float lo, float hi) { unsigned r; asm volatile("v_cvt_pk_bf16_f32 %0, %1, %2" : "=v"(r) : "v"(lo), "v"(hi)); return r; }
typedef float f32x2 __attribute__((ext_vector_type(2)));
__device__ __forceinline__ f32x2 gelu_pk(f32x2 v) {
    const f32x2 av = __builtin_elementwise_abs(v), d = av * 0.2316418882f + 1.0f;
    f32x2 t; t.x = __builtin_amdgcn_rcpf(d.x); t.y = __builtin_amdgcn_rcpf(d.y);
    f32x2 q = t * 0.5307027145f + (-0.7265760135f); q = q * t + 0.7107068705f; q = q * t + (-0.142248368f); q = q * t + 0.127414796f; q = q * t;
    const f32x2 s = (v * v) * (-0.72134752044f);
    f32x2 e; e.x = __builtin_amdgcn_exp2f(s.x); e.y = __builtin_amdgcn_exp2f(s.y);
    const f32x2 m = v * (q * e), r = v - m;
    f32x2 o; o.x = v.x < 0.f ? m.x : r.x; o.y = v.y < 0.f ? m.y : r.y; return o;
}

template <int ACT  > struct EpiBf16 {
    static constexpr bool PERM = true, AFTER_DRAIN = false; static_assert(ACT == 0 || ACT == 1, "EpiBf16: ACT is 0 (none) or 1 (gelu_pk)");
    bf16_t* O; int ldc; const float* bias; int split_cols; size_t split_stride; float scale0;
    __device__ __forceinline__ void operator()(const f32x4 (&acc)[2][2][4][2], const Unit& u, int wr, int wc, int fr, int fq) const {
        const int row0 = u.pm * BM + wr * 64 + fr; int colt = u.pn * BM; bf16_t* base = O;
        float sc = 1.f; if (split_cols) { const int t = colt / split_cols; base += (size_t)t * split_stride; colt -= t * split_cols; if (t == 0) sc = scale0; }
        const int col0 = colt + wc * 32 + 8 * fq, bcol0 = u.pn * BM + wc * 32 + 8 * fq;
        f32x4 bv[2][2];
#pragma unroll
        for (int bj = 0; bj < 2; ++bj)
#pragma unroll
            for (int n = 0; n < 2; ++n) bv[bj][n] = bias ? *(const f32x4*)(bias + bcol0 + bj * HALF + 4 * n) : (f32x4){0.f, 0.f, 0.f, 0.f};
#pragma unroll
        for (int ai = 0; ai < 2; ++ai)
#pragma unroll
            for (int m = 0; m < 4; ++m) { bf16_t* rowp = base + (size_t)(row0 + ai * HALF + m * 16) * ldc + col0;
#pragma unroll
                for (int bj = 0; bj < 2; ++bj) { f32x4 v0 = acc[ai][bj][m][0] + bv[bj][0], v1 = acc[ai][bj][m][1] + bv[bj][1];
                    if (ACT == 1) { f32x2 a = gelu_pk((f32x2){v0[0], v0[1]}), b = gelu_pk((f32x2){v0[2], v0[3]}), c = gelu_pk((f32x2){v1[0], v1[1]}), d = gelu_pk((f32x2){v1[2], v1[3]});
                        v0 = (f32x4){a.x, a.y, b.x, b.y}; v1 = (f32x4){c.x, c.y, d.x, d.y}; }
                    v0 = v0 * sc; v1 = v1 * sc; u32x4 w; w.x = cvt_pk_bf16(v0[0], v0[1]); w.y = cvt_pk_bf16(v0[2], v0[3]); w.z = cvt_pk_bf16(v1[0], v1[1]); w.w = cvt_pk_bf16(v1[2], v1[3]);
                    *(u32x4*)(rowp + bj * HALF) = w; } }
    }
};
template <class Epi, class Sched, bool ALIGN_EPI = false, bool SP2 = false>
__device__ __forceinline__ void gemm_phase(PG8_LAS unsigned char* lds, const Gemm g, const Sched& S, const Epi& E) {
    int tid_ = threadIdx.x; asm volatile("" : "+v"(tid_));
    const int tid = tid_, wid = __builtin_amdgcn_readfirstlane(tid >> 6), lane = tid & 63, wr = wid >> 2, wc = wid & 3, fr = lane & 15, fq = lane >> 4;
    const int K = g.K, nt = K / BK;
    unsigned voffA[2], voffB[2];
#pragma unroll
    for (int i = 0; i < 2; ++i) { int R, C; stage_rc(tid * 16 + i * 8192, R, C); const int Rb = Epi::PERM ? ((R & ~31) + perm32(R & 31)) : R;
        voffA[i] = (unsigned)(R * K + C) * 2u; voffB[i] = (unsigned)(Rb * K + C) * 2u; }
    const size_t kstep = (size_t)(BK * 2);
    const size_t hstep = (size_t)HALF * K * 2;
    const size_t tstep = 2 * hstep;
    const unsigned ldsw = (unsigned)wid * 1024u;
    const int aoff = lds_byte(wr * 64 + fr, fq * 8), boff = lds_byte(wc * 32 + fr, fq * 8);
#define PG8_SA(b, h) (((b) * 2 + (h)) * HTB)
#define PG8_SB(b, h) ((4 + (b) * 2 + (h)) * HTB)
#define PG8_STAGE(bufoff, gbase, voff) do { _Pragma("unroll") for (int _i = 0; _i < 2; ++_i) \
        __builtin_amdgcn_global_load_lds((const unsigned*)((const char*)(gbase) + (voff)[_i]), (PG8_LAS unsigned*)(lds + (bufoff) + ldsw + _i * 8192), 16, 0, 0); } while (0)
#define PG8_LDA(dst, b, h) do { _Pragma("unroll") for (int m = 0; m < 4; ++m) _Pragma("unroll") for (int k = 0; k < 2; ++k) dst[m][k] = *(const PG8_LAS bf16x8*)(lds + PG8_SA(b, h) + aoff + m * 2048 + k * 1024); } while (0)
#define PG8_LDB(dst, b, h) do { _Pragma("unroll") for (int n = 0; n < 2; ++n) _Pragma("unroll") for (int k = 0; k < 2; ++k) dst[n][k] = *(const PG8_LAS bf16x8*)(lds + PG8_SB(b, h) + boff + n * 2048 + k * 1024); } while (0)
#define PG8_MMA(ai, bj, At, Bt) do { __builtin_amdgcn_s_setprio(1); _Pragma("unroll") for (int m = 0; m < 4; ++m) _Pragma("unroll") for (int n = 0; n < 2; ++n) _Pragma("unroll") for (int k = 0; k < 2; ++k) \
        acc[ai][bj][m][n] = __builtin_amdgcn_mfma_f32_16x16x32_bf16(Bt[n][k], At[m][k], acc[ai][bj][m][n], 0, 0, 0); __builtin_amdgcn_s_setprio(0); } while (0)
#define PG8_WAIT_V(n) asm volatile("s_waitcnt vmcnt(" #n ")" ::: "memory")
#define PG8_WAIT_L(n) asm volatile("s_waitcnt lgkmcnt(" #n ")" ::: "memory")
#define PG8_BAR __builtin_amdgcn_s_barrier()
#define PG8_SCHED __builtin_amdgcn_sched_barrier(0)
    Unit cur, nxt; int ui = 0;
    if (!S.next(0, cur)) return;
    f32x4 acc[2][2][4][2];
#pragma unroll
    for (int a = 0; a < 2; ++a)
#pragma unroll
        for (int b = 0; b < 2; ++b)
#pragma unroll
            for (int m = 0; m < 4; ++m)
#pragma unroll
                for (int n = 0; n < 2; ++n) acc[a][b][m][n] = (f32x4){0.f, 0.f, 0.f, 0.f};
    bf16x8 At[4][2], B0[2][2], B1[2][2];
    const char* cA = (const char*)g.A + (size_t)cur.pm * tstep; const char* cB = (const char*)g.Bt + (size_t)cur.pn * tstep;
    S.a_ready(cur);
    if constexpr (SP2) {
        PG8_STAGE(PG8_SB(0, 0), cB, voffB); PG8_STAGE(PG8_SB(0, 1), cB + hstep, voffB); PG8_STAGE(PG8_SA(0, 0), cA, voffA); PG8_STAGE(PG8_SA(0, 1), cA + hstep, voffA);
        if (wr == 1) PG8_BAR;
        PG8_WAIT_V(2); PG8_BAR;
        PG8_STAGE(PG8_SB(1, 0), cB + kstep, voffB); PG8_STAGE(PG8_SA(1, 0), cA + kstep, voffA); PG8_STAGE(PG8_SB(1, 1), cB + hstep + kstep, voffB);
        PG8_WAIT_V(6); PG8_BAR;
    } else {
        PG8_STAGE(PG8_SB(0, 0), cB, voffB); PG8_STAGE(PG8_SA(0, 0), cA, voffA); PG8_STAGE(PG8_SB(0, 1), cB + hstep, voffB); PG8_STAGE(PG8_SA(0, 1), cA + hstep, voffA);
        if (wr == 1) PG8_BAR;
        PG8_WAIT_V(4); PG8_BAR;
        PG8_STAGE(PG8_SB(1, 0), cB + kstep, voffB); PG8_STAGE(PG8_SA(1, 0), cA + kstep, voffA); PG8_STAGE(PG8_SB(1, 1), cB + hstep + kstep, voffB);
        PG8_WAIT_V(6); PG8_BAR;
    }
    for (;;) {
        const bool has_next = S.next(ui + 1, nxt);
        const char* nA = has_next ? (const char*)g.A + (size_t)nxt.pm * tstep : cA; const char* nB = has_next ? (const char*)g.Bt + (size_t)nxt.pn * tstep : cB;
        for (int t = 0; t < nt; t += 2) {
            const bool last = (t == nt - 2);
            const char* a1 = cA + (size_t)(t + 1) * kstep;
            const char* a2 = last ? nA : cA + (size_t)(t + 2) * kstep; const char* b2 = last ? nB : cB + (size_t)(t + 2) * kstep;
            const char* a3 = a2 + kstep; const char* b3 = b2 + kstep;
            if (last && has_next) S.a_ready(nxt);
            if constexpr (SP2) {
            PG8_LDB(B0, 0, 0); PG8_LDB(B1, 0, 1); PG8_SCHED; PG8_LDA(At, 0, 0); PG8_STAGE(PG8_SA(1, 1), a1 + hstep, voffA);
            PG8_WAIT_V(8); PG8_WAIT_L(0); PG8_BAR; PG8_MMA(0, 0, At, B0); PG8_MMA(0, 1, At, B1); PG8_BAR; PG8_SCHED;
            PG8_LDA(At, 0, 1); PG8_STAGE(PG8_SB(0, 0), b2, voffB); PG8_STAGE(PG8_SB(0, 1), b2 + hstep, voffB); PG8_STAGE(PG8_SA(0, 0), a2, voffA);
            PG8_WAIT_V(8); PG8_WAIT_L(0); PG8_BAR; PG8_MMA(1, 0, At, B0); PG8_MMA(1, 1, At, B1); PG8_BAR; PG8_SCHED;
            PG8_LDB(B0, 1, 0); PG8_LDB(B1, 1, 1); PG8_SCHED; PG8_LDA(At, 1, 0); PG8_STAGE(PG8_SA(0, 1), a2 + hstep, voffA);
            PG8_WAIT_V(8); PG8_WAIT_L(0); PG8_BAR; PG8_MMA(0, 0, At, B0); PG8_MMA(0, 1, At, B1); PG8_BAR; PG8_SCHED;
            PG8_LDA(At, 1, 1); PG8_STAGE(PG8_SB(1, 0), b3, voffB); PG8_STAGE(PG8_SB(1, 1), b3 + hstep, voffB); PG8_STAGE(PG8_SA(1, 0), a3, voffA);
            PG8_WAIT_V(8); PG8_WAIT_L(0); PG8_BAR; PG8_MMA(1, 0, At, B0); PG8_MMA(1, 1, At, B1); PG8_BAR; PG8_SCHED;
            } else {
            PG8_LDB(B0, 0, 0); PG8_SCHED; PG8_LDA(At, 0, 0); PG8_STAGE(PG8_SA(1, 1), a1 + hstep, voffA);
            PG8_WAIT_L(8); PG8_BAR; PG8_WAIT_L(0); PG8_MMA(0, 0, At, B0); PG8_BAR; PG8_SCHED;
            PG8_LDB(B1, 0, 1); PG8_STAGE(PG8_SB(0, 0), b2, voffB);
            PG8_BAR; PG8_WAIT_L(0); PG8_MMA(0, 1, At, B1); PG8_BAR;
            PG8_LDA(At, 0, 1); PG8_STAGE(PG8_SA(0, 0), a2, voffA);
            PG8_BAR; PG8_WAIT_L(0); PG8_MMA(1, 0, At, B0); PG8_BAR; PG8_SCHED;
            PG8_STAGE(PG8_SB(0, 1), b2 + hstep, voffB);
            PG8_WAIT_V(6); PG8_BAR; PG8_MMA(1, 1, At, B1); PG8_BAR;
            PG8_LDB(B0, 1, 0); PG8_SCHED; PG8_LDA(At, 1, 0); PG8_STAGE(PG8_SA(0, 1), a2 + hstep, voffA);
            PG8_WAIT_L(8); PG8_BAR; PG8_WAIT_L(0); PG8_MMA(0, 0, At, B0); PG8_BAR; PG8_SCHED;
            PG8_LDB(B1, 1, 1); PG8_STAGE(PG8_SB(1, 0), b3, voffB);
            PG8_BAR; PG8_WAIT_L(0); PG8_MMA(0, 1, At, B1); PG8_BAR;
            PG8_LDA(At, 1, 1); PG8_STAGE(PG8_SA(1, 0), a3, voffA);
            PG8_BAR; PG8_WAIT_L(0); PG8_MMA(1, 0, At, B0); PG8_BAR; PG8_SCHED;
            PG8_STAGE(PG8_SB(1, 1), b3 + hstep, voffB);
            PG8_WAIT_V(6); PG8_BAR; PG8_MMA(1, 1, At, B1); PG8_BAR;
            }
        }
        if constexpr (ALIGN_EPI) { if (wr == 0) PG8_BAR; }
        if constexpr (!Epi::AFTER_DRAIN) { E(acc, cur, wr, wc, fr, fq); S.done(cur); }
        if (!has_next) break;
#pragma unroll
        for (int a = 0; a < 2; ++a)
#pragma unroll
            for (int b = 0; b < 2; ++b)
#pragma unroll
                for (int m = 0; m < 4; ++m)
#pragma unroll
                    for (int n = 0; n < 2; ++n) acc[a][b][m][n] = (f32x4){0.f, 0.f, 0.f, 0.f};
        cur = nxt; cA = nA; cB = nB; ++ui;
        if constexpr (ALIGN_EPI) { if (wr == 1) PG8_BAR; }
    }
    PG8_WAIT_V(0);
    if constexpr (!ALIGN_EPI) { if (wr == 0) PG8_BAR; }
    PG8_BAR;
    if constexpr (Epi::AFTER_DRAIN) { E.fused(acc, cur, wr, wc, fr, fq, lds, wid, lane); S.done(cur); }
#undef PG8_SA
#undef PG8_SB
#undef PG8_STAGE
#undef PG8_LDA
#undef PG8_LDB
#undef PG8_MMA
#undef PG8_WAIT_V
#undef PG8_WAIT_L
#undef PG8_BAR
#undef PG8_SCHED
}
}

constexpr int BATCH = 16, SEQ = 2048, DM = 2048, NMETA = 16;
constexpr int TREAL = BATCH * SEQ;
constexpr int MROWS = 33024;
constexpr int META_TILE0 = 32768;
constexpr int META_ROW0 = 32816;
constexpr int NZ = 6144;
constexpr int ZQ = 0, ZK = 1024, ZV = 2048, ZMQ = 3072, ZMK = 3584, ZMV = 4096, ZMO = 5120;
constexpr int INCOLS = 6152;
constexpr float EPS = 1e-6f;
constexpr float QSCALE = 0.125f * 1.4426950408889634f;
constexpr float LAMBDA_INIT = 0.2f;

typedef unsigned short bf16_t;
typedef float f32x4 __attribute__((ext_vector_type(4)));
typedef __bf16 bf16x2_t __attribute__((ext_vector_type(2)));

constexpr size_t MiB = 1u << 20;
constexpr size_t WS_CTL = 0;
constexpr size_t WS_ISC = 655360;
constexpr size_t WS_SKB = 65536;
constexpr size_t WS_WIN = 1 * MiB;
constexpr size_t WS_WOUT = 25 * MiB;
constexpr size_t WS_WQ = 33 * MiB;
constexpr size_t WS_ROPE = 41 * MiB;
constexpr size_t WS_GATES = 42 * MiB;
constexpr size_t WS_SSQ = 44 * MiB;
constexpr size_t WS_IDX = 48 * MiB;
constexpr size_t WS_GATE = 64 * MiB;
constexpr size_t WS_U = 80 * MiB;
constexpr size_t WS_V = 144 * MiB;
constexpr size_t WS_HN = 208 * MiB;
constexpr size_t WS_MIX = 338 * MiB;
constexpr size_t WS_Z = 466 * MiB;
constexpr size_t WS_END = 854 * MiB;

__device__ __forceinline__ float bf_lo(unsigned w) { return __uint_as_float(w << 16); }
__device__ __forceinline__ float bf_hi(unsigned w) { return __uint_as_float(w & 0xffff0000u); }
__device__ __forceinline__ float bf2f(bf16_t v) { return __uint_as_float(((unsigned)v) << 16); }
__device__ __forceinline__ unsigned f2bf(float f) { unsigned r; asm("v_cvt_pk_bf16_f32 %0, %1, 0" : "=v"(r) : "v"(f)); return r; }
__device__ __forceinline__ unsigned pk2(float lo, float hi) { unsigned r; asm("v_cvt_pk_bf16_f32 %0, %1, %2" : "=v"(r) : "v"(lo), "v"(hi)); return r; }
__device__ __forceinline__ float dot2(unsigned a, unsigned b, float acc) { return __builtin_amdgcn_fdot2_f32_bf16(__builtin_bit_cast(bf16x2_t, a), __builtin_bit_cast(bf16x2_t, b), acc, false); }
__device__ __forceinline__ float wave_sum(float v) {
#pragma unroll
    for (int o = 1; o < 64; o <<= 1) v += __shfl_xor(v, o);
    return v;
}
__device__ __forceinline__ float wave_max(float v) {
#pragma unroll
    for (int o = 1; o < 64; o <<= 1) v = fmaxf(v, __shfl_xor(v, o));
    return v;
}
__device__ __forceinline__ int zrow_of(int b, int l) { return l < NMETA ? META_ROW0 + l : b * SEQ + (l - NMETA); }

struct EpiZ {
    static constexpr bool PERM = true, AFTER_DRAIN = false;
    bf16_t* Z; const float* rope;
    __device__ __forceinline__ void operator()(const pg8::f32x4 (&acc)[2][2][4][2], const pg8::Unit& u, int wr, int wc, int fr, int fq) const {
        const int row0 = u.pm * 256 + wr * 64 + fr, col0 = u.pn * 256 + wc * 32 + 8 * fq;
        const bool isq = u.pn < 4, isrope = u.pn < 8;
        const int j0 = 16 * (wc & 1) + 4 * fq;
#pragma unroll
        for (int ai = 0; ai < 2; ++ai)
#pragma unroll
            for (int m = 0; m < 4; ++m) {
                const int row = row0 + ai * 128 + m * 16;
                pg8::f32x4 c0 = {1.f, 0.f, 1.f, 0.f}, c1 = {1.f, 0.f, 1.f, 0.f};
                if (isrope) {
                    const int pos = row < TREAL ? (row & (SEQ - 1)) + NMETA : ((row >= META_ROW0 && row < META_ROW0 + NMETA) ? row - META_ROW0 : 0);
                    const pg8::f32x4* tp = (const pg8::f32x4*)(rope + ((size_t)pos * 32 + j0) * 2);
                    c0 = tp[0]; c1 = tp[1];
                }
                bf16_t* rowp = Z + (size_t)row * NZ + col0;
#pragma unroll
                for (int bj = 0; bj < 2; ++bj) {
                    pg8::f32x4 v0 = acc[ai][bj][m][0], v1 = acc[ai][bj][m][1];
                    if (isrope) {
                        pg8::f32x4 o0, o1;
                        o0[0] = v0[0] * c0[0] - v0[1] * c0[1]; o0[1] = v0[1] * c0[0] + v0[0] * c0[1];
                        o0[2] = v0[2] * c0[2] - v0[3] * c0[3]; o0[3] = v0[3] * c0[2] + v0[2] * c0[3];
                        o1[0] = v1[0] * c1[0] - v1[1] * c1[1]; o1[1] = v1[1] * c1[0] + v1[0] * c1[1];
                        o1[2] = v1[2] * c1[2] - v1[3] * c1[3]; o1[3] = v1[3] * c1[2] + v1[2] * c1[3];
                        v0 = o0; v1 = o1;
                        if (isq) { v0 = v0 * QSCALE; v1 = v1 * QSCALE; }
                    }
                    pg8::u32x4 w; w.x = pg8::cvt_pk_bf16(v0[0], v0[1]); w.y = pg8::cvt_pk_bf16(v0[2], v0[3]); w.z = pg8::cvt_pk_bf16(v1[0], v1[1]); w.w = pg8::cvt_pk_bf16(v1[2], v1[3]);
                    *(pg8::u32x4*)(rowp + bj * 128) = w;
                }
            }
    }
};
struct EpiX1 {
    static constexpr bool PERM = true, AFTER_DRAIN = false;
    const float* x; bf16_t* x1b; float* ssq;
    __device__ __forceinline__ void loadr(pg8::f32x4 (&xb)[2][2], int row0, int col0, int i) const {
#pragma unroll
        for (int bj = 0; bj < 2; ++bj) {
            const size_t off = (size_t)(row0 + (i >> 2) * 128 + (i & 3) * 16) * DM + col0 + bj * 128;
            xb[bj][0] = *(const pg8::f32x4*)(x + off); xb[bj][1] = *(const pg8::f32x4*)(x + off + 4);
        }
    }
    __device__ __forceinline__ void procr(const pg8::f32x4 (&acc)[2][2][4][2], const pg8::f32x4 (&xb)[2][2], int row0, int col0, int i, int pn, int wc, int fq) const {
        const int ai = i >> 2, m = i & 3;
        const int row = row0 + ai * 128 + m * 16; float ss = 0.f;
#pragma unroll
        for (int bj = 0; bj < 2; ++bj) {
            const size_t off = (size_t)row * DM + col0 + bj * 128;
            const pg8::f32x4 v0 = acc[ai][bj][m][0] + xb[bj][0], v1 = acc[ai][bj][m][1] + xb[bj][1];
            ss += (v0[0] * v0[0] + v0[1] * v0[1]) + (v0[2] * v0[2] + v0[3] * v0[3]) + (v1[0] * v1[0] + v1[1] * v1[1]) + (v1[2] * v1[2] + v1[3] * v1[3]);
            pg8::u32x4 w; w.x = pg8::cvt_pk_bf16(v0[0], v0[1]); w.y = pg8::cvt_pk_bf16(v0[2], v0[3]); w.z = pg8::cvt_pk_bf16(v1[0], v1[1]); w.w = pg8::cvt_pk_bf16(v1[2], v1[3]);
            *(pg8::u32x4*)(x1b + off) = w;
        }
        ss += __shfl_xor(ss, 16); ss += __shfl_xor(ss, 32);
        if (fq == 0) ssq[(size_t)row * 32 + pn * 4 + wc] = ss;
    }
    __device__ __forceinline__ void operator()(const pg8::f32x4 (&acc)[2][2][4][2], const pg8::Unit& u, int wr, int wc, int fr, int fq) const {
        const int row0 = u.pm * 256 + wr * 64 + fr, col0 = u.pn * 256 + wc * 32 + 8 * fq;
        pg8::f32x4 b0[2][2], b1[2][2], b2[2][2];
        loadr(b0, row0, col0, 0); loadr(b1, row0, col0, 1); loadr(b2, row0, col0, 2);
        procr(acc, b0, row0, col0, 0, u.pn, wc, fq); loadr(b0, row0, col0, 3);
        procr(acc, b1, row0, col0, 1, u.pn, wc, fq); loadr(b1, row0, col0, 4);
        procr(acc, b2, row0, col0, 2, u.pn, wc, fq); loadr(b2, row0, col0, 5);
        procr(acc, b0, row0, col0, 3, u.pn, wc, fq); loadr(b0, row0, col0, 6);
        procr(acc, b1, row0, col0, 4, u.pn, wc, fq); loadr(b1, row0, col0, 7);
        procr(acc, b2, row0, col0, 5, u.pn, wc, fq);
        procr(acc, b0, row0, col0, 6, u.pn, wc, fq);
        procr(acc, b1, row0, col0, 7, u.pn, wc, fq);
    }
};


#include <hip/hip_cooperative_groups.h>
namespace cg = cooperative_groups;

constexpr int NWAVES = 8, NTHREADS = 512;
constexpr size_t WS_X1Q = WS_Z + 300 * MiB, WS_XSC = WS_Z + 370 * MiB;
__device__ __forceinline__ int opaque_tid() { int t = threadIdx.x; asm volatile("" : "+v"(t)); return t; }
constexpr int LDS_BYTES = 163840;

struct Args {
    const float *x, *meta, *nmw, *w_in, *lamqk, *subln, *convw, *convb, *ib, *fb, *mnw, *w_out, *nfw_ffn, *w_q, *subkeys, *pu, *pv, *nfinal;
    float* out; unsigned char* ws;
};

#define LAS __attribute__((address_space(3)))
#define XB_TMO      128
#define XB_XCNT(j)  (256  + 64 * (j))
#define XB_XSUB(j)  (1280 + 64 * (j))
#define XB_XGEN(j)  (2304 + 64 * (j))
#define XB_TOP      3328
#define XB_TOPGEN   3392
#define XCD_BAR_WORDS 3456
#define XB_SPIN_CAP (1u << 18)

__device__ __forceinline__ unsigned xb_ld(unsigned* p)              { return __hip_atomic_load(p, __ATOMIC_RELAXED, __HIP_MEMORY_SCOPE_AGENT); }
__device__ __forceinline__ unsigned xb_add(unsigned* p, unsigned v) { return __hip_atomic_fetch_add(p, v, __ATOMIC_RELAXED, __HIP_MEMORY_SCOPE_AGENT); }
__device__ __forceinline__ unsigned xb_xcc_id() { return (unsigned)__builtin_amdgcn_s_getreg((3 << 11) | 20) & 0xFu; }
#define XB_SPIN(cond, bar) do { unsigned _sp = 0; while (cond) { __builtin_amdgcn_s_sleep(1); \
    if ((++_sp & 255u) == 0u) { if (xb_ld(&(bar)[XB_TMO])) break; if (_sp > XB_SPIN_CAP) { atomicAdd(&(bar)[XB_TMO], 1u); break; } } } } while (0)

struct XcdBarrier {
    unsigned* bar; unsigned x;
    volatile LAS unsigned* st;
};

__device__ __forceinline__ XcdBarrier xcd_barrier_post(unsigned* bar, volatile LAS unsigned* st) {
    XcdBarrier b; b.bar = bar; b.x = xb_xcc_id(); b.st = st;
    if (threadIdx.x == 0) (void)xb_add(&bar[XB_XCNT(b.x)], 1u);
    return b;
}
__device__ __forceinline__ void xcd_barrier_complete(unsigned* bar, unsigned x, unsigned& nloc, unsigned& nx) {
    const unsigned G = gridDim.x * gridDim.y * gridDim.z;
    unsigned sum, cnt, mine, sp = 0u;
    for (;;) {
        sum = 0u; cnt = 0u; mine = 0u;
#pragma unroll
        for (unsigned j = 0; j < 16; ++j) { const unsigned c = xb_ld(&bar[XB_XCNT(j)]); sum += c; cnt += (c > 0u) ? 1u : 0u; mine = (j == x) ? c : mine; }
        if (sum == G) break;
        __builtin_amdgcn_s_sleep(1);
        if ((++sp & 255u) == 0u) { if (xb_ld(&bar[XB_TMO])) break; if (sp > XB_SPIN_CAP) { atomicAdd(&bar[XB_TMO], 1u); break; } }
    }
    nloc = mine > 0u ? mine : 1u; nx = cnt > 0u ? cnt : 1u;
}

__device__ __forceinline__ void xcd_barrier(const XcdBarrier& b) {
    asm volatile("s_waitcnt vmcnt(0)" ::: "memory");
    __syncthreads();
    if (threadIdx.x == 0) {
        unsigned* bar = b.bar;
        __builtin_amdgcn_s_waitcnt(0);
        unsigned nloc = b.st[0], nx = b.st[1];
        if (nloc == 0u) { xcd_barrier_complete(bar, b.x, nloc, nx); b.st[0] = nloc; b.st[1] = nx; }
        const unsigned old = xb_add(&bar[XB_XSUB(b.x)], 1u);
        const unsigned gen = old / nloc;
        if (old + 1u == (gen + 1u) * nloc) {
            __builtin_amdgcn_fence(__ATOMIC_RELEASE, "agent");
            asm volatile("s_waitcnt vmcnt(0)" ::: "memory");
            const unsigned og = xb_add(&bar[XB_TOP], 1u);
            const unsigned tg = og / nx;
            if (og + 1u == (tg + 1u) * nx) xb_add(&bar[XB_TOPGEN], 1u);
            else XB_SPIN(xb_ld(&bar[XB_TOPGEN]) == tg, bar);
            __builtin_amdgcn_fence(__ATOMIC_ACQUIRE, "agent");
            xb_add(&bar[XB_XGEN(b.x)], 1u);
            asm volatile("s_waitcnt vmcnt(0)" ::: "memory");
        } else {
            XB_SPIN(xb_ld(&bar[XB_XGEN(b.x)]) == gen, bar);
            __builtin_amdgcn_fence(__ATOMIC_ACQUIRE, "agent");
            asm volatile("s_waitcnt vmcnt(0)" ::: "memory");
        }
    }
    __syncthreads();
}

constexpr int CW_BAR = 0, CW_QUEUE = 4096;
constexpr int LDS_MISC = LDS_BYTES - 256;
__device__ __forceinline__ int next_item(unsigned* ctr, volatile LAS unsigned* slot) {
    __syncthreads();
    if (threadIdx.x == 0) *slot = __hip_atomic_fetch_add(ctr, 1u, __ATOMIC_RELAXED, __HIP_MEMORY_SCOPE_AGENT);
    __syncthreads();
    return (int)*slot;
}

__device__ __forceinline__ void transpose_item(const float* W, int ldw, int K, int N, bf16_t* WT, bool ropeperm, float* scr, int item, int lane, const float* kscale = nullptr) {
    const int nblk = N / 32, kb = item / nblk, nb = item % nblk, k0 = 64 * kb, n0 = 32 * nb;
#pragma unroll 8
    for (int i = 0; i < 32; ++i) { const int kk = 2 * i + (lane >> 5); scr[kk * 33 + (lane & 31)] = W[(size_t)(k0 + kk) * ldw + n0 + (lane & 31)] * (kscale ? kscale[k0 + kk] : 1.f); }
    __builtin_amdgcn_s_waitcnt(0xC07F); asm volatile("" ::: "memory");
    const int c = lane & 7;
#pragma unroll
    for (int j = 0; j < 4; ++j) {
        const int n = (lane >> 3) + 8 * j; const float* s = scr + (8 * c) * 33 + n;
        uint4 o; o.x = pk2(s[0 * 33], s[1 * 33]); o.y = pk2(s[2 * 33], s[3 * 33]); o.z = pk2(s[4 * 33], s[5 * 33]); o.w = pk2(s[6 * 33], s[7 * 33]);
        int orow = n0 + n;
        if (ropeperm && n0 < 2048) orow = (n0 & ~63) + 2 * n + ((n0 >> 5) & 1);
        *(uint4*)(WT + (size_t)orow * K + k0 + 8 * c) = o;
    }
    __builtin_amdgcn_s_waitcnt(0xC07F); asm volatile("" ::: "memory");
}

__device__ __forceinline__ void hn_row(const Args& a, bf16_t* HN, float* G, const float* WG, int r, const f32x4 (&v)[8], int lane) {
    float ss = 0.f;
#pragma unroll
    for (int j = 0; j < 8; ++j) ss += (v[j][0] * v[j][0] + v[j][1] * v[j][1]) + (v[j][2] * v[j][2] + v[j][3] * v[j][3]);
    const float rstd = rsqrtf(wave_sum(ss) * (1.f / DM) + EPS);
    float g[8];
#pragma unroll
    for (int k = 0; k < 8; ++k) g[k] = 0.f;
    unsigned long long* o8 = (unsigned long long*)(HN + (size_t)r * DM) + lane;
#pragma unroll
    for (int j = 0; j < 8; ++j) {
        const f32x4 w = ((const f32x4*)a.nmw)[64 * j + lane];
        const f32x4 y = v[j] * rstd * w;
        o8[64 * j] = (unsigned long long)pk2(y[0], y[1]) | ((unsigned long long)pk2(y[2], y[3]) << 32);
#pragma unroll
        for (int k = 0; k < 8; ++k) { const f32x4 wg = ((const f32x4*)(WG + k * 2048))[64 * j + lane]; g[k] += (y[0] * wg[0] + y[1] * wg[1]) + (y[2] * wg[2] + y[3] * wg[3]); }
        __builtin_amdgcn_sched_barrier(0);
    }
    float r4[4], r2[2], r1;
    { const bool hb = (lane & 32) != 0;
#pragma unroll
      for (int i = 0; i < 4; ++i) { const float send = hb ? g[i] : g[i + 4]; const float recv = __shfl_xor(send, 32); r4[i] = (hb ? g[i + 4] : g[i]) + recv; } }
    { const bool hb = (lane & 16) != 0;
#pragma unroll
      for (int i = 0; i < 2; ++i) { const float send = hb ? r4[i] : r4[i + 2]; const float recv = __shfl_xor(send, 16); r2[i] = (hb ? r4[i + 2] : r4[i]) + recv; } }
    { const bool hb = (lane & 8) != 0; const float send = hb ? r2[0] : r2[1]; const float recv = __shfl_xor(send, 8); r1 = (hb ? r2[1] : r2[0]) + recv; }
    r1 += __shfl_xor(r1, 4); r1 += __shfl_xor(r1, 2); r1 += __shfl_xor(r1, 1);
    if ((lane & 7) == 0) G[(size_t)r * 8 + ((lane >> 5) & 1) * 4 + ((lane >> 4) & 1) * 2 + ((lane >> 3) & 1)] = r1;
}

__device__ __forceinline__ void phase_prep(const Args& a, unsigned char* lds, int bid, int nb) {
    const int tid = opaque_tid(), lane = tid & 63, wave = tid >> 6;
    const int gw = bid * NWAVES + wave, NGW = nb * NWAVES;
    unsigned char* ws = a.ws;
    bf16_t* WinT = (bf16_t*)(ws + WS_WIN); bf16_t* WoutT = (bf16_t*)(ws + WS_WOUT); bf16_t* WqT = (bf16_t*)(ws + WS_WQ);
    bf16_t* U = (bf16_t*)(ws + WS_U); bf16_t* V = (bf16_t*)(ws + WS_V); bf16_t* HN = (bf16_t*)(ws + WS_HN);
    float* G = (float*)(ws + WS_GATES); float* rope = (float*)(ws + WS_ROPE);
    float* scr = (float*)lds + wave * (64 * 33);
    float* WG = (float*)(lds + 8 * 64 * 33 * 4);
    for (int i = tid; i < 8 * 2048; i += NTHREADS) { const int k = i >> 3, g = i & 7; WG[g * 2048 + k] = a.w_in[(size_t)k * INCOLS + 6144 + g]; }
    __syncthreads();
    constexpr int I_IN = 32 * 192, I_OUT = 32 * 64, I_Q = 32 * 64;
    for (int it = gw; it < I_IN + I_OUT + I_Q; it += NGW) {
        int r = it;
        if (r < I_IN) { transpose_item(a.w_in, INCOLS, 2048, 6144, WinT, true, scr, r, lane); continue; } r -= I_IN;
        if (r < I_OUT) { transpose_item(a.w_out, 2048, 2048, 2048, WoutT, false, scr, r, lane); continue; } r -= I_OUT;
        transpose_item(a.w_q, 2048, 2048, 2048, WqT, false, scr, r, lane, a.nfw_ffn);
    }
    {
        f32x4 vc[8], vn[8];
#pragma unroll
        for (int j = 0; j < 8; ++j) vc[j] = ((const f32x4*)(a.x + (size_t)gw * DM))[64 * j + lane];
        for (int r = gw; r < TREAL; r += NGW) {
            const int rn = r + NGW < TREAL ? r + NGW : r;
#pragma unroll
            for (int j = 0; j < 8; ++j) vn[j] = ((const f32x4*)(a.x + (size_t)rn * DM))[64 * j + lane];
            hn_row(a, HN, G, WG, r, vc, lane);
#pragma unroll
            for (int j = 0; j < 8; ++j) vc[j] = vn[j];
        }
    }
    for (int r = TREAL + gw; r < MROWS; r += NGW) {
        if (r >= META_ROW0 && r < META_ROW0 + NMETA) {
            f32x4 vm[8];
#pragma unroll
            for (int j = 0; j < 8; ++j) vm[j] = ((const f32x4*)(a.meta + (size_t)(r - META_ROW0) * DM))[64 * j + lane];
            hn_row(a, HN, G, WG, r, vm, lane);
        } else {
            unsigned long long* o8 = (unsigned long long*)(HN + (size_t)r * DM) + lane;
#pragma unroll
            for (int j = 0; j < 8; ++j) o8[64 * j] = 0ull;
            if (lane < 8) G[(size_t)r * 8 + lane] = 0.f;
        }
    }
    { bf16_t* SKB = (bf16_t*)(ws + WS_SKB);
      for (int i = bid * NTHREADS + tid; i < 8 * 2 * 128 * 128 / 2; i += nb * NTHREADS) { const float2 v = ((const float2*)a.subkeys)[i]; ((unsigned*)SKB)[i] = pk2(v.x, v.y); } }
    for (int i = bid * NTHREADS + tid; i < (SEQ + NMETA) * 32; i += nb * NTHREADS) {
        const int pos = i >> 5, j = i & 31;
        const float inv = (float)pow(10000.0, -(double)j / 32.0);
        const float ang = (float)pos * inv;
        rope[2 * i] = (float)cos((double)ang); rope[2 * i + 1] = (float)sin((double)ang);
    }
}


constexpr int CW_QTAB = 4096 + 1024, TAB_ITEMS = 2 * 16384 / 16;
__device__ __forceinline__ void phase_tables(const Args& a, unsigned char* lds, unsigned* ctl) {
    const int tid = opaque_tid(), lane = tid & 63, wave = __builtin_amdgcn_readfirstlane(tid >> 6);
    unsigned char* ws = a.ws;
    volatile LAS unsigned* slot = (volatile LAS unsigned*)((LAS unsigned char*)lds + LDS_MISC) + 2;
    for (;;) {
        const int item = next_item(ctl + CW_QTAB, slot);
        if (item >= TAB_ITEMS) break;
        const int rr = item * 16 + wave;
    {
        unsigned* U8 = (unsigned*)(ws + WS_U); unsigned* V8 = (unsigned*)(ws + WS_V); float* ISC = (float*)(ws + WS_ISC);
        {
            f32x4 v[2][8]; float am[2];
#pragma unroll
            for (int q = 0; q < 2; ++q) {
                const int r = rr + q * 8; const bool isu = r < 16384; const int e = r & 16383;
                const f32x4* xr = (const f32x4*)((isu ? a.pu : a.pv) + (size_t)e * DM) + lane;
#pragma unroll
                for (int j = 0; j < 8; ++j) v[q][j] = xr[64 * j];
            }
#pragma unroll
            for (int q = 0; q < 2; ++q) if (rr + q * 8 < 16384) {
#pragma unroll
                for (int j = 0; j < 8; ++j) v[q][j] = v[q][j] * ((const f32x4*)a.nfw_ffn)[64 * j + lane]; }
#pragma unroll
            for (int q = 0; q < 2; ++q) { float t = 0.f;
#pragma unroll
                for (int j = 0; j < 8; ++j) t = fmaxf(t, fmaxf(fmaxf(fabsf(v[q][j][0]), fabsf(v[q][j][1])), fmaxf(fabsf(v[q][j][2]), fabsf(v[q][j][3]))));
                am[q] = t; }
#pragma unroll
            for (int o = 1; o < 64; o <<= 1) { am[0] = fmaxf(am[0], __shfl_xor(am[0], o)); am[1] = fmaxf(am[1], __shfl_xor(am[1], o)); }
#pragma unroll
            for (int q = 0; q < 2; ++q) {
                const int r = rr + q * 8; const bool isu = r < 16384; const int e = r & 16383;
                const float top = isu ? 127.f : 256.f;
                const float sc = am[q] > 0.f ? top / am[q] : 0.f;
                unsigned* o8 = isu ? U8 : V8;
#pragma unroll
                for (int j = 0; j < 8; ++j) { int w;
                    if (isu) { const int q0 = (int)rintf(v[q][j][0] * sc), q1 = (int)rintf(v[q][j][1] * sc), q2 = (int)rintf(v[q][j][2] * sc), q3 = (int)rintf(v[q][j][3] * sc);
                        w = (int)((unsigned)(q0 & 255) | ((unsigned)(q1 & 255) << 8) | ((unsigned)(q2 & 255) << 16) | ((unsigned)q3 << 24)); }
                    else { w = __builtin_amdgcn_cvt_pk_fp8_f32(v[q][j][0] * sc, v[q][j][1] * sc, 0, false); w = __builtin_amdgcn_cvt_pk_fp8_f32(v[q][j][2] * sc, v[q][j][3] * sc, w, true); }
                    o8[((size_t)j * 16384 + e) * 64 + lane] = (unsigned)w; }
                if (lane == 0) ISC[(isu ? 0 : 16384) + e] = am[q] / top;
            }
        }
    }
    }
}

namespace att {
using bf16x8 = __attribute__((ext_vector_type(8))) short;
using s16x4 = __attribute__((ext_vector_type(4))) short;
using f32x16 = __attribute__((ext_vector_type(16))) float;
using u32x4 = __attribute__((ext_vector_type(4))) unsigned;
constexpr int SHM_V = 16384, SHM_K = 16384;
constexpr int L_V = 0, L_K = 2 * SHM_V, L_WS = L_K + 2 * SHM_K, L_P = L_WS + 8 * 64 * 4, L_END = L_P + 4 * 4096;
#define KSWZ(row, colB) ((row) * 256 + ((colB) ^ (((row) & 7) << 4)))
#define SBAR() __builtin_amdgcn_sched_barrier(0)
__device__ __forceinline__ int crow(int r, int hi) { return (r & 3) + 8 * (r >> 2) + 4 * hi; }
__device__ __forceinline__ unsigned cvtpk(float lo, float hi) { unsigned r; asm volatile("v_cvt_pk_bf16_f32 %0, %1, %2" : "=v"(r) : "v"(lo), "v"(hi)); return r; }
__device__ __forceinline__ int v_st(int k, int c) { const int kk = (k & ~0xC) | ((k & 4) << 1) | ((k & 8) >> 1); return ((kk >> 3) * 4 + (c >> 5)) * 512 + ((kk & 7) * 32 + (c & 31)) * 2; }
__device__ __forceinline__ int v_rd_base(int lane) { return ((lane & 3) << 3) | (((lane >> 2) & 3) << 6) | (((lane >> 4) & 1) << 5) | (((lane >> 5) & 1) << 8); }
constexpr int v_rd_off(int d0, int ks, int half) { return d0 * 512 + ks * 4096 + half * 2048; }
template <int OFF> __device__ __forceinline__ s16x4 tr_read(int vb) { s16x4 r; asm volatile("ds_read_b64_tr_b16 %0, %1 offset:%2" : "=&v"(r) : "v"(vb), "i"(OFF) : "memory"); return r; }
template <int D0> __device__ __forceinline__ void pv_one(f32x16& od, int vb, bf16x8 pa0, bf16x8 pa1, bf16x8 pa2, bf16x8 pa3) {
    const s16x4 l0 = tr_read<v_rd_off(D0, 0, 0)>(vb), h0 = tr_read<v_rd_off(D0, 0, 1)>(vb), l1 = tr_read<v_rd_off(D0, 1, 0)>(vb), h1 = tr_read<v_rd_off(D0, 1, 1)>(vb);
    const s16x4 l2 = tr_read<v_rd_off(D0, 2, 0)>(vb), h2 = tr_read<v_rd_off(D0, 2, 1)>(vb), l3 = tr_read<v_rd_off(D0, 3, 0)>(vb), h3 = tr_read<v_rd_off(D0, 3, 1)>(vb);
    asm volatile("s_waitcnt lgkmcnt(0)" ::: "memory"); SBAR();
#define PK(L, H) (bf16x8){L[0], L[1], L[2], L[3], H[0], H[1], H[2], H[3]}
    od = __builtin_amdgcn_mfma_f32_32x32x16_bf16(pa0, PK(l0, h0), od, 0, 0, 0);
    od = __builtin_amdgcn_mfma_f32_32x32x16_bf16(pa1, PK(l1, h1), od, 0, 0, 0);
    od = __builtin_amdgcn_mfma_f32_32x32x16_bf16(pa2, PK(l2, h2), od, 0, 0, 0);
    od = __builtin_amdgcn_mfma_f32_32x32x16_bf16(pa3, PK(l3, h3), od, 0, 0, 0);
#undef PK
}
__device__ __forceinline__ void qkt(f32x16& p0, f32x16& p1, const char* Ks, const bf16x8* qr, int r32, int hi, int comp) {
    p0 = f32x16{}; p1 = f32x16{};
#pragma unroll
    for (int d0 = 0; d0 < 4; ++d0) {
        const int cb = (comp * 64 + d0 * 16 + hi * 8) * 2;
        const bf16x8 b0 = *reinterpret_cast<const bf16x8*>(Ks + KSWZ(r32, cb));
        const bf16x8 b1 = *reinterpret_cast<const bf16x8*>(Ks + KSWZ(32 + r32, cb));
        p0 = __builtin_amdgcn_mfma_f32_32x32x16_bf16(b0, qr[d0], p0, 0, 0, 0);
        p1 = __builtin_amdgcn_mfma_f32_32x32x16_bf16(b1, qr[d0], p1, 0, 0, 0);
    }
}

__device__ __forceinline__ void attn_unit(int b, int h, int qb, const bf16_t* Z, bf16_t* MIX, float lam, const float* subln, char* lds) {
    const int tid = opaque_tid(), wid = __builtin_amdgcn_readfirstlane(tid >> 6), lane = tid & 63, r32 = lane & 31, hi = lane >> 5;
    const int comp = wid >> 2, rg = wid & 3;
    char* V_lds = lds + L_V; char* K_lds = lds + L_K;
    float* wsf = (float*)(lds + L_WS) + wid * 64;
    const int q0 = b * SEQ + qb * 128;
    const float NEGV = -1e30f;
    bf16x8 qr[4];
    {
        const bf16_t* Qw = Z + (size_t)(q0 + rg * 32 + r32) * NZ + ZQ + h * 128 + comp * 64 + hi * 8;
#pragma unroll
        for (int d0 = 0; d0 < 4; ++d0) qr[d0] = *reinterpret_cast<const bf16x8*>(Qw + d0 * 16);
    }
    const int NT = 2 * qb + 3;
    const int sr = tid >> 4, sc = (tid & 15) * 8;
    const int vst0 = v_st(sr, sc), vst1 = v_st(32 + sr, sc), kst0 = KSWZ(sr, sc * 2), kst1 = KSWZ(32 + sr, sc * 2);
    const int vb0 = (int)(uintptr_t)V_lds + v_rd_base(lane);
#define PK4(P, BASE, OUT) do { unsigned a0 = cvtpk(P[BASE + 0], P[BASE + 1]), a1 = cvtpk(P[BASE + 2], P[BASE + 3]); \
        unsigned b0 = cvtpk(P[BASE + 4], P[BASE + 5]), b1 = cvtpk(P[BASE + 6], P[BASE + 7]); \
        auto r0 = __builtin_amdgcn_permlane32_swap(a0, b0, false, false); auto r1 = __builtin_amdgcn_permlane32_swap(a1, b1, false, false); \
        u32x4 w = {r0[0], r1[0], r0[1], r1[1]}; OUT = *reinterpret_cast<bf16x8*>(&w); } while (0)
    bf16x8 vsA0, vsA1, ksA0, ksA1, vsB0, vsB1, ksB0, ksB1;
#define SLOAD(j, S) do { const size_t r0_ = (size_t)((j) == 0 ? META_TILE0 : b * SEQ + ((j) - 1) * 64) + sr; const bf16_t* zp_ = Z + r0_ * NZ + h * 128 + sc; \
        vs##S##0 = *reinterpret_cast<const bf16x8*>(zp_ + ZV); vs##S##1 = *reinterpret_cast<const bf16x8*>(zp_ + ZV + (size_t)32 * NZ); \
        ks##S##0 = *reinterpret_cast<const bf16x8*>(zp_ + ZK); ks##S##1 = *reinterpret_cast<const bf16x8*>(zp_ + ZK + (size_t)32 * NZ); } while (0)
#define SWRITE(bi, S) do { *reinterpret_cast<bf16x8*>(V_lds + (bi) * SHM_V + vst0) = vs##S##0; *reinterpret_cast<bf16x8*>(V_lds + (bi) * SHM_V + vst1) = vs##S##1; \
        *reinterpret_cast<bf16x8*>(K_lds + (bi) * SHM_K + kst0) = ks##S##0; *reinterpret_cast<bf16x8*>(K_lds + (bi) * SHM_K + kst1) = ks##S##1; } while (0)
    f32x16 o[4] = {}; float m_reg = NEGV, l_reg = 0.f;
    SLOAD(0, A); SWRITE(0, A); SLOAD(1, B); __syncthreads();
    const int qrel = rg * 32 + r32;
#define ATT_TILE(j, L_, W_) do { \
        const int cur = j & 1; \
        if (j + 2 < NT) SLOAD(j + 2, L_); \
        f32x16 p0, p1; \
        qkt(p0, p1, K_lds + cur * SHM_K, qr, r32, hi, comp); \
        if (j == 0) { \
    _Pragma("unroll") \
            for (int r = 0; r < 16; ++r) { p0[r] = NEGV; if (r < 8) p1[r] = NEGV; } \
        } else if (j >= NT - 2) { \
            const int kb0 = (j - (NT - 2)) * 64; \
    _Pragma("unroll") \
            for (int r = 0; r < 16; ++r) { const int kl = kb0 + crow(r, hi); if (kl > qrel) p0[r] = NEGV; if (kl + 32 > qrel) p1[r] = NEGV; } \
        } \
        float pmax = p0[0]; \
    _Pragma("unroll") \
        for (int r = 1; r < 16; ++r) pmax = fmaxf(pmax, p0[r]); \
    _Pragma("unroll") \
        for (int r = 0; r < 16; ++r) pmax = fmaxf(pmax, p1[r]); \
        { auto rr = __builtin_amdgcn_permlane32_swap(__float_as_uint(pmax), __float_as_uint(pmax), false, false); pmax = fmaxf(__uint_as_float(rr[0]), __uint_as_float(rr[1])); } \
        const float mn = fmaxf(m_reg, pmax); const float alpha = __builtin_amdgcn_exp2f(m_reg - mn); m_reg = mn; \
        float ps = 0.f; \
    _Pragma("unroll") \
        for (int r = 0; r < 16; ++r) { p0[r] = __builtin_amdgcn_exp2f(p0[r] - mn); ps += p0[r]; } \
    _Pragma("unroll") \
        for (int r = 0; r < 16; ++r) { p1[r] = __builtin_amdgcn_exp2f(p1[r] - mn); ps += p1[r]; } \
        { auto rr = __builtin_amdgcn_permlane32_swap(__float_as_uint(ps), __float_as_uint(ps), false, false); ps = __uint_as_float(rr[0]) + __uint_as_float(rr[1]); } \
        l_reg = l_reg * alpha + ps; \
        if (__any(alpha < 1.f)) { \
            if (hi == 0) wsf[r32] = alpha; \
            asm volatile("s_waitcnt lgkmcnt(0)" ::: "memory"); \
            float al[16]; \
    _Pragma("unroll") \
            for (int r = 0; r < 16; ++r) al[r] = wsf[crow(r, hi)]; \
    _Pragma("unroll") \
            for (int d = 0; d < 4; ++d) \
    _Pragma("unroll") \
                for (int r = 0; r < 16; ++r) o[d][r] *= al[r]; \
            asm volatile("s_waitcnt lgkmcnt(0)" ::: "memory"); \
        } \
        bf16x8 pa0, pa1, pa2, pa3; \
        PK4(p0, 0, pa0); PK4(p0, 8, pa1); PK4(p1, 0, pa2); PK4(p1, 8, pa3); \
        SBAR(); \
        { const int vb = vb0 + cur * SHM_V; \
          pv_one<0>(o[0], vb, pa0, pa1, pa2, pa3); pv_one<1>(o[1], vb, pa0, pa1, pa2, pa3); pv_one<2>(o[2], vb, pa0, pa1, pa2, pa3); pv_one<3>(o[3], vb, pa0, pa1, pa2, pa3); } \
        if (j + 1 < NT) SWRITE(cur ^ 1, W_); \
        __syncthreads(); \
    } while (0)
    for (int j = 0; j < NT; j += 2) { ATT_TILE(j, A, B); if (j + 1 < NT) ATT_TILE(j + 1, B, A); }
#undef ATT_TILE
#undef SLOAD
#undef SWRITE
#undef PK4
    if (hi == 0) wsf[r32] = l_reg;
    asm volatile("s_waitcnt lgkmcnt(0)" ::: "memory");
    float rli[16];
#pragma unroll
    for (int r = 0; r < 16; ++r) rli[r] = __builtin_amdgcn_rcpf(wsf[crow(r, hi)]);
    float* X = (float*)lds + rg * 4096;
    if (comp == 1) {
#pragma unroll
        for (int d0 = 0; d0 < 4; ++d0)
#pragma unroll
            for (int r = 0; r < 16; ++r) X[(d0 * 16 + r) * 64 + lane] = o[d0][r] * rli[r] * lam;
    }
    __syncthreads();
    if (comp == 0) {
        float ssr[16];
#pragma unroll
        for (int r = 0; r < 16; ++r) ssr[r] = 0.f;
#pragma unroll
        for (int d0 = 0; d0 < 4; ++d0)
#pragma unroll
            for (int r = 0; r < 16; ++r) { const float v = o[d0][r] * rli[r] - X[(d0 * 16 + r) * 64 + lane]; o[d0][r] = v; ssr[r] += v * v; }
        float* P = (float*)(lds + L_P) + rg * 1024;
#pragma unroll
        for (int r = 0; r < 16; ++r) P[r * 64 + lane] = ssr[r];
        asm volatile("s_waitcnt lgkmcnt(0)" ::: "memory");
        {
            const int rho = lane & 31, hh = (rho >> 2) & 1, rr = (rho & 3) + 4 * (rho >> 3);
            const float4* pp = (const float4*)(P + rr * 64 + hh * 32 + (lane >> 5) * 16);
            const float4 a0 = pp[0], a1 = pp[1], a2 = pp[2], a3 = pp[3];
            float s = ((a0.x + a0.y) + (a0.z + a0.w)) + ((a1.x + a1.y) + (a1.z + a1.w)) + ((a2.x + a2.y) + (a2.z + a2.w)) + ((a3.x + a3.y) + (a3.z + a3.w));
            auto sw = __builtin_amdgcn_permlane32_swap(__float_as_uint(s), __float_as_uint(s), false, false); s = __uint_as_float(sw[0]) + __uint_as_float(sw[1]);
            if (lane < 32) wsf[32 + rho] = rsqrtf(s * (1.f / 128.f) + EPS) * (1.f - LAMBDA_INIT);
        }
        asm volatile("s_waitcnt lgkmcnt(0)" ::: "memory");
        float sw4[4];
#pragma unroll
        for (int d0 = 0; d0 < 4; ++d0) sw4[d0] = subln[d0 * 32 + r32];
        bf16_t* Ow = MIX + (size_t)(q0 + rg * 32) * DM + h * 128 + r32;
#pragma unroll
        for (int r = 0; r < 16; ++r) {
            const int orow = crow(r, hi); const float rs = wsf[32 + orow];
#pragma unroll
            for (int d0 = 0; d0 < 4; ++d0) Ow[(size_t)orow * DM + d0 * 32] = (bf16_t)f2bf(o[d0][r] * rs * sw4[d0]);
        }
    }
    __syncthreads();
}
#undef KSWZ
#undef SBAR
}

__device__ __forceinline__ float attn_lambda(const Args& a) {
    const int lane = opaque_tid() & 63;
    const float l1 = wave_sum(a.lamqk[lane] * a.lamqk[64 + lane]), l2 = wave_sum(a.lamqk[128 + lane] * a.lamqk[192 + lane]);
    return expf(l1) - expf(l2) + LAMBDA_INIT;
}
namespace mls {
using bf16x8 = __attribute__((ext_vector_type(8))) short;
using bf16x4 = __attribute__((ext_vector_type(4))) short;
using s16x4 = __attribute__((ext_vector_type(4))) short;
using f32x16 = __attribute__((ext_vector_type(16))) float;
using f32x4v = __attribute__((ext_vector_type(4))) float;
using u32x4v = __attribute__((ext_vector_type(4))) unsigned;
using u32x2v = __attribute__((ext_vector_type(2))) unsigned;
constexpr int L_QS = 0, L_QP = 16384, L_KS = 32768, L_KW = 49152, L_VT = 65536, L_PT = 98304, L_HT = 106496, HT_STRIDE = 528;
constexpr int L_MISC = L_HT + 64 * HT_STRIDE;
constexpr int L_RS = L_MISC, L_QN = L_RS + 2 * 64 * 4, L_NV = L_QN + 64 * 4, L_NP = L_NV + 128 * 4, L_CW = L_NP + 8 * 128 * 4, L_RD = L_CW + 5 * 256 * 4, L_NW = L_RD + 8 * 64 * 4, L_END = L_NW + 8 * 36 * 4;
#define KSWZ(row, colB) ((row) * 256 + ((colB) ^ (((row) & 7) << 4)))
#define PSWZ(row, colB) ((row) * 128 + ((colB) ^ ((((row) >> 1) & 7) << 4)))
__device__ __forceinline__ int crow(int r, int hi) { return (r & 3) + 8 * (r >> 2) + 4 * hi; }
__device__ __forceinline__ unsigned cvtpk(float lo, float hi) { unsigned r; asm volatile("v_cvt_pk_bf16_f32 %0, %1, %2" : "=v"(r) : "v"(lo), "v"(hi)); return r; }
__device__ __forceinline__ int v_st(int k, int c) { const int kk = (k & ~0xC) | ((k & 4) << 1) | ((k & 8) >> 1); return ((kk >> 3) * 4 + (c >> 5)) * 512 + ((kk & 7) * 32 + (c & 31)) * 2; }
__device__ __forceinline__ int v_rd_base(int lane) { return ((lane & 3) << 3) | (((lane >> 2) & 3) << 6) | (((lane >> 4) & 1) << 5) | (((lane >> 5) & 1) << 8); }
__device__ __forceinline__ s16x4 tr_read_dyn(int addr) { s16x4 r; asm volatile("ds_read_b64_tr_b16 %0, %1" : "=&v"(r) : "v"(addr) : "memory"); return r; }
__device__ __forceinline__ bf16x8 tr_frag(int img_plus_base, int d0, int ks) {
    const s16x4 lo = tr_read_dyn(img_plus_base + d0 * 512 + ks * 4096), hi = tr_read_dyn(img_plus_base + d0 * 512 + ks * 4096 + 2048);
    return (bf16x8){lo[0], lo[1], lo[2], lo[3], hi[0], hi[1], hi[2], hi[3]};
}
template <int CTRL, int RMASK> __device__ __forceinline__ float dppf(float old, float v) { return __builtin_bit_cast(float, __builtin_amdgcn_update_dpp(__builtin_bit_cast(int, old), __builtin_bit_cast(int, v), CTRL, RMASK, 0xf, false)); }
__device__ __forceinline__ float scan_add(float v) {
    v += dppf<0x111, 0xf>(0.f, v); v += dppf<0x112, 0xf>(0.f, v); v += dppf<0x114, 0xf>(0.f, v); v += dppf<0x118, 0xf>(0.f, v);
    v += dppf<0x142, 0xa>(0.f, v); v += dppf<0x143, 0xc>(0.f, v); return v;
}
__device__ __forceinline__ float scan_max(float v) {
    const float NI = -3.0e38f;
    v = fmaxf(v, dppf<0x111, 0xf>(NI, v)); v = fmaxf(v, dppf<0x112, 0xf>(NI, v)); v = fmaxf(v, dppf<0x114, 0xf>(NI, v)); v = fmaxf(v, dppf<0x118, 0xf>(NI, v));
    v = fmaxf(v, dppf<0x142, 0xa>(NI, v)); v = fmaxf(v, dppf<0x143, 0xc>(NI, v)); return v;
}
__device__ __forceinline__ float rlane(float v, int l) { return __uint_as_float(__builtin_amdgcn_readlane(__float_as_uint(v), l)); }
__device__ __forceinline__ float silu(float x) { return x * __builtin_amdgcn_rcpf(1.f + __expf(-x)); }
__device__ __forceinline__ void fmac_v(float& y, float a, float b) { asm("v_fmac_f32 %0, %1, %2" : "+v"(y) : "v"(a), "v"(b)); }
__device__ __forceinline__ float mul_v(float a, float b) { float r; asm("v_mul_f32 %0, %1, %2" : "=v"(r) : "v"(a), "v"(b)); return r; }

__device__ __forceinline__ void mlstm_item(int b, int h, const Args& a, char* lds) {
    const int tid0 = opaque_tid(), wid = __builtin_amdgcn_readfirstlane(tid0 >> 6);
    const bf16_t* Z = (const bf16_t*)(a.ws + WS_Z); const float* G = (const float*)(a.ws + WS_GATES); bf16_t* MIX = (bf16_t*)(a.ws + WS_MIX);
    const int ldsb = (int)(uintptr_t)lds;
    float* RS = (float*)(lds + L_RS); float* QN = (float*)(lds + L_QN); float* NV = (float*)(lds + L_NV); float* NP = (float*)(lds + L_NP); float* CW = (float*)(lds + L_CW);
    for (int i = tid0; i < 5 * 256; i += NTHREADS) { const int j = i >> 8, c = i & 255; const int cc = c < 128 ? h * 128 + c : 512 + h * 128 + (c - 128); CW[i] = j < 4 ? a.convw[j * 1024 + cc] : a.convb[cc]; }
    if (tid0 < 128) NV[tid0] = 0.f;
    if (tid0 < 256) ((float*)(lds + L_NW))[(tid0 >> 5) * 36 + (tid0 & 31)] = a.mnw[h * 256 + tid0];
    const float ibh = a.ib[h], fbh = a.fb[h];
    float cw[4][4], cb[4];
    __syncthreads();
    { const int c4 = 4 * (tid0 & 63);
#pragma unroll
    for (int j = 0; j < 4; ++j)
#pragma unroll
        for (int q = 0; q < 4; ++q) cw[j][q] = CW[j * 256 + c4 + q];
#pragma unroll
    for (int q = 0; q < 4; ++q) cb[q] = CW[4 * 256 + c4 + q]; }
    f32x16 C[4] = {};
    float m_prev = -1e30f;
    u32x2v rq[11]; u32x4v rv[4]; float gi, gf;
    auto chunk_row0 = [&](int c) -> int { return c == 0 ? META_TILE0 : b * SEQ + (c - 1) * 64; };
#define LOAD_RAW(c) do { int tq_ = tid0; asm volatile("" : "+v"(tq_)); const int ln_ = tq_ & 63, c4_ = 4 * ln_, zc_qk = (c4_ < 128 ? ZMQ + h * 128 + c4_ : ZMK + h * 128 + (c4_ - 128)), erow = tq_ >> 3, eseg = tq_ & 7; const int r0_ = chunk_row0(c); \
        _Pragma("unroll") for (int i_ = 0; i_ < 11; ++i_) { const int t_ = 8 * wid - 3 + i_; int row_; bool ok_ = true; \
            if (t_ >= 0) row_ = r0_ + t_; else if ((c) == 0) { row_ = 0; ok_ = false; } else if ((c) == 1) row_ = META_TILE0 + 64 + t_; else row_ = r0_ + t_; \
            rq[i_] = ok_ ? *(const u32x2v*)(Z + (size_t)row_ * NZ + zc_qk) : (u32x2v){0u, 0u}; } \
        _Pragma("unroll") for (int i_ = 0; i_ < 4; ++i_) rv[i_] = *(const u32x4v*)(Z + (size_t)(r0_ + erow) * NZ + ZMV + h * 256 + eseg * 32 + 8 * i_); \
        { const int rowg_ = r0_ + ln_; gi = G[(size_t)rowg_ * 8 + h]; gf = G[(size_t)rowg_ * 8 + 4 + h]; } } while (0)
    LOAD_RAW(0);
    const int NCH = 33;
    for (int c = 0; c < NCH; ++c) {
        int tid = tid0; asm volatile("" : "+v"(tid));
        const int lane = tid & 63, r32 = lane & 31, hi = lane >> 5, cq = lane, c4 = 4 * cq, erow = tid >> 3, eseg = tid & 7;
        float* RD = (float*)(lds + L_RD) + wid * 64;
        float li = gi + ibh; float lf; { const float xf = gf + fbh; lf = fminf(xf, 0.f) - __logf(1.f + __expf(-fabsf(xf))); }
        if (c == 0 && lane < 48) { li = -1e30f; lf = 0.f; }
        const float bsum = scan_add(lf);
        const float u = li - bsum;
        const float cm = scan_max(u);
        const float Mrow = fmaxf(cm, m_prev);
        const float iw = __expf(m_prev - Mrow);
        const float Mend = rlane(Mrow, 63), gtot = rlane(bsum, 63);
        const float wrow = __expf(u - Mend);
        const float dec = __expf(m_prev - Mend);
        const float dexp = __expf(-(bsum + Mrow));
        {
            float qn_part[8], ksum[4] = {0.f, 0.f, 0.f, 0.f};
            float nvv[4];
#pragma unroll
            for (int q = 0; q < 4; ++q) nvv[q] = (cq < 32) ? NV[c4 + q] : 0.f;
#pragma unroll
            for (int i = 0; i < 8; ++i) {
                const int t = 8 * wid + i;
                float xo[4];
#pragma unroll
                for (int q = 0; q < 4; ++q) xo[q] = cb[q];
#pragma unroll
                for (int j = 0; j < 4; ++j) {
                    const u32x2v rr = rq[i + j];
                    fmac_v(xo[0], cw[j][0], bf_lo(rr.x)); fmac_v(xo[1], cw[j][1], bf_hi(rr.x)); fmac_v(xo[2], cw[j][2], bf_lo(rr.y)); fmac_v(xo[3], cw[j][3], bf_hi(rr.y));
                }
#pragma unroll
                for (int q = 0; q < 4; ++q) xo[q] = silu(xo[q]);
                const float iw_t = rlane(iw, t), w_t = rlane(wrow, t);
                if (cq < 32) {
#pragma unroll
                    for (int q = 0; q < 4; ++q) xo[q] = mul_v(xo[q], 0.08838834764831845f);
                    *(uint2*)(lds + L_QS + KSWZ(t, c4 * 2)) = make_uint2(cvtpk(xo[0], xo[1]), cvtpk(xo[2], xo[3]));
                    float qd = 0.f;
#pragma unroll
                    for (int q = 0; q < 4; ++q) { fmac_v(qd, xo[q], nvv[q]); xo[q] = mul_v(xo[q], iw_t); }
                    *(uint2*)(lds + L_QP + KSWZ(t, c4 * 2)) = make_uint2(cvtpk(xo[0], xo[1]), cvtpk(xo[2], xo[3]));
                    qn_part[i] = iw_t * qd;
                } else {
                    const int kc = c4 - 128;
                    *(uint2*)(lds + L_KS + KSWZ(t, kc * 2)) = make_uint2(cvtpk(xo[0], xo[1]), cvtpk(xo[2], xo[3]));
#pragma unroll
                    for (int q = 0; q < 4; ++q) { xo[q] = mul_v(xo[q], w_t); ksum[q] += xo[q]; }
                    *(uint2*)(lds + L_KW + v_st(t, kc)) = make_uint2(cvtpk(xo[0], xo[1]), cvtpk(xo[2], xo[3]));
                    qn_part[i] = 0.f;
                }
                __builtin_amdgcn_sched_barrier(0);
            }
            {
                float r4[4], r2[2], r1;
                { const bool hb = (lane & 16) != 0;
#pragma unroll
                  for (int i = 0; i < 4; ++i) { const float send = hb ? qn_part[i] : qn_part[i + 4]; const float recv = __shfl_xor(send, 16); r4[i] = (hb ? qn_part[i + 4] : qn_part[i]) + recv; } }
                { const bool hb = (lane & 8) != 0;
#pragma unroll
                  for (int i = 0; i < 2; ++i) { const float send = hb ? r4[i] : r4[i + 2]; const float recv = __shfl_xor(send, 8); r2[i] = (hb ? r4[i + 2] : r4[i]) + recv; } }
                { const bool hb = (lane & 4) != 0; const float send = hb ? r2[0] : r2[1]; const float recv = __shfl_xor(send, 4); r1 = (hb ? r2[1] : r2[0]) + recv; }
                r1 += __shfl_xor(r1, 2); r1 += __shfl_xor(r1, 1);
                if (lane < 32 && (lane & 3) == 0) QN[8 * wid + ((lane >> 4) & 1) * 4 + ((lane >> 3) & 1) * 2 + ((lane >> 2) & 1)] = r1;
            }
            if (cq >= 32) {
#pragma unroll
                for (int q = 0; q < 4; ++q) NP[wid * 128 + (c4 - 128) + q] = ksum[q];
            }
#pragma unroll
            for (int i = 0; i < 4; ++i) *(u32x4v*)(lds + L_VT + (eseg >> 2) * 16384 + v_st(erow, (eseg & 3) * 32 + 8 * i)) = rv[i];
        }
        u32x4v zo[4];
        {
            const int r0 = chunk_row0(c);
#pragma unroll
            for (int i = 0; i < 4; ++i) zo[i] = *(const u32x4v*)(Z + (size_t)(r0 + erow) * NZ + ZMO + h * 256 + eseg * 32 + 8 * i);
        }
        if (c + 1 < NCH) LOAD_RAW(c + 1);
        __syncthreads();
        {
            const int tb = wid >> 1, half = wid & 1;
            float rsum[4] = {0.f, 0.f, 0.f, 0.f};
            const int fr = lane & 15, fq = lane >> 4;
            float Mt[4];
#pragma unroll
            for (int i = 0; i < 4; ++i) Mt[i] = __shfl(Mrow, 16 * tb + 4 * fq + i);
#pragma unroll
            for (int sj = 0; sj < 2; ++sj) {
                const int sb = 2 * half + sj;
                unsigned short pw[4] = {0, 0, 0, 0};
                if (sb <= tb) {
                    f32x4v acc = {0.f, 0.f, 0.f, 0.f};
#pragma unroll
                    for (int ks = 0; ks < 4; ++ks) {
                        const bf16x8 af = *(const bf16x8*)(lds + L_QS + KSWZ(16 * tb + fr, (32 * ks + 8 * fq) * 2));
                        const bf16x8 bfr = *(const bf16x8*)(lds + L_KS + KSWZ(16 * sb + fr, (32 * ks + 8 * fq) * 2));
                        acc = __builtin_amdgcn_mfma_f32_16x16x32_bf16(af, bfr, acc, 0, 0, 0);
                    }
                    const int s = 16 * sb + fr; const float us = __shfl(u, s);
#pragma unroll
                    for (int i = 0; i < 4; ++i) {
                        const int t = 16 * tb + 4 * fq + i;
                        const float p = (s <= t) ? acc[i] * __expf(us - Mt[i]) : 0.f;
                        rsum[i] += p; pw[i] = (unsigned short)f2bf(p);
                    }
                }
#pragma unroll
                for (int i = 0; i < 4; ++i) *(unsigned short*)(lds + L_PT + PSWZ(16 * tb + 4 * fq + i, (16 * sb + fr) * 2)) = pw[i];
            }
#pragma unroll
            for (int i = 0; i < 4; ++i) {
                float v = rsum[i];
                v += __shfl_xor(v, 1); v += __shfl_xor(v, 2); v += __shfl_xor(v, 4); v += __shfl_xor(v, 8);
                if (fr == 0) RS[half * 64 + 16 * tb + 4 * fq + i] = v;
            }
        }
        __syncthreads();
        {
            const float nq = RS[lane] + RS[64 + lane] + QN[lane];
            RD[lane] = __builtin_amdgcn_rcpf(fmaxf(fabsf(nq), dexp));
            bf16x8 vf[4];
            const int vimg = ldsb + L_VT + (wid >> 2) * 16384 + v_rd_base(lane);
#pragma unroll
            for (int ks = 0; ks < 4; ++ks) vf[ks] = tr_frag(vimg, wid & 3, ks);
            asm volatile("s_waitcnt lgkmcnt(0)" ::: "memory"); __builtin_amdgcn_sched_barrier(0);
            f32x16 acc[2] = {};
#pragma unroll
            for (int rb = 0; rb < 2; ++rb) {
                const int row = 32 * rb + r32;
#pragma unroll
                for (int ks = 0; ks < 4; ++ks) {
                    if (rb == 0 && ks >= 2) continue;
                    const bf16x8 pf = *(const bf16x8*)(lds + L_PT + PSWZ(row, (16 * ks + 8 * hi) * 2));
                    acc[rb] = __builtin_amdgcn_mfma_f32_32x32x16_bf16(pf, vf[ks], acc[rb], 0, 0, 0);
                }
            }
#pragma unroll
            for (int kb = 0; kb < 4; ++kb)
#pragma unroll
                for (int sp = 0; sp < 2; ++sp) {
                    bf16x8 cf; { unsigned w0 = cvtpk(C[kb][8 * sp + 0], C[kb][8 * sp + 1]), w1 = cvtpk(C[kb][8 * sp + 2], C[kb][8 * sp + 3]), w2 = cvtpk(C[kb][8 * sp + 4], C[kb][8 * sp + 5]), w3 = cvtpk(C[kb][8 * sp + 6], C[kb][8 * sp + 7]);
                        typedef unsigned u32x4_ __attribute__((ext_vector_type(4))); u32x4_ ww = {w0, w1, w2, w3}; cf = __builtin_bit_cast(bf16x8, ww); }
                    const int base = 32 * kb + 16 * sp;
#pragma unroll
                    for (int rb = 0; rb < 2; ++rb) {
                        const int row = 32 * rb + r32;
                        const bf16x4 q0 = *(const bf16x4*)(lds + L_QP + KSWZ(row, (base + 4 * hi) * 2));
                        const bf16x4 q1 = *(const bf16x4*)(lds + L_QP + KSWZ(row, (base + 8 + 4 * hi) * 2));
                        const bf16x8 qf = {q0[0], q0[1], q0[2], q0[3], q1[0], q1[1], q1[2], q1[3]};
                        acc[rb] = __builtin_amdgcn_mfma_f32_32x32x16_bf16(qf, cf, acc[rb], 0, 0, 0);
                    }
                }
            asm volatile("s_waitcnt lgkmcnt(0)" ::: "memory");
#pragma unroll
            for (int rb = 0; rb < 2; ++rb)
#pragma unroll
                for (int r = 0; r < 16; ++r) {
                    const int row = 32 * rb + crow(r, hi);
                    *(unsigned short*)(lds + L_HT + row * HT_STRIDE + (32 * wid + r32) * 2) = (unsigned short)f2bf(acc[rb][r] * RD[row]);
                }
#pragma unroll
            for (int kb = 0; kb < 4; ++kb) {
#pragma unroll
                for (int r = 0; r < 16; ++r) C[kb][r] *= dec;
                const int kimg = ldsb + L_KW + v_rd_base(lane);
                bf16x8 kf[4];
#pragma unroll
                for (int ks = 0; ks < 4; ++ks) kf[ks] = tr_frag(kimg, kb, ks);
                asm volatile("s_waitcnt lgkmcnt(0)" ::: "memory"); __builtin_amdgcn_sched_barrier(0);
#pragma unroll
                for (int ks = 0; ks < 4; ++ks) C[kb] = __builtin_amdgcn_mfma_f32_32x32x16_bf16(kf[ks], vf[ks], C[kb], 0, 0, 0);
            }
            if (tid < 128) { float s = NV[tid] * dec;
#pragma unroll
                for (int w8 = 0; w8 < 8; ++w8) s += NP[w8 * 128 + tid];
                NV[tid] = s; }
        }
        m_prev = gtot + Mend;
        __syncthreads();
        if (c > 0) {
            float hv[32]; float ss = 0.f;
#pragma unroll
            for (int i = 0; i < 4; ++i) {
                const uint4 w = *(const uint4*)(lds + L_HT + erow * HT_STRIDE + eseg * 64 + 16 * i);
                hv[8 * i + 0] = bf_lo(w.x); hv[8 * i + 1] = bf_hi(w.x); hv[8 * i + 2] = bf_lo(w.y); hv[8 * i + 3] = bf_hi(w.y);
                hv[8 * i + 4] = bf_lo(w.z); hv[8 * i + 5] = bf_hi(w.z); hv[8 * i + 6] = bf_lo(w.w); hv[8 * i + 7] = bf_hi(w.w);
            }
#pragma unroll
            for (int i = 0; i < 32; ++i) ss += hv[i] * hv[i];
            ss += __shfl_xor(ss, 1); ss += __shfl_xor(ss, 2); ss += __shfl_xor(ss, 4);
            const float rstd = rsqrtf(ss * (1.f / 256.f) + EPS);
            const float* nw = (const float*)(lds + L_NW) + eseg * 36;
            bf16_t* op = MIX + (size_t)(chunk_row0(c) + erow) * DM + 1024 + h * 256 + eseg * 32;
#pragma unroll
            for (int i = 0; i < 4; ++i) {
                const unsigned zz[4] = {zo[i].x, zo[i].y, zo[i].z, zo[i].w};
                unsigned ow[4];
#pragma unroll
                for (int q = 0; q < 4; ++q) {
                    const float z0 = bf_lo(zz[q]), z1 = bf_hi(zz[q]);
                    const float o0 = hv[8 * i + 2 * q] * rstd * nw[8 * i + 2 * q] * __builtin_amdgcn_rcpf(1.f + __expf(-z0));
                    const float o1 = hv[8 * i + 2 * q + 1] * rstd * nw[8 * i + 2 * q + 1] * __builtin_amdgcn_rcpf(1.f + __expf(-z1));
                    ow[q] = pk2(o0, o1);
                }
                *(uint4*)(op + 8 * i) = make_uint4(ow[0], ow[1], ow[2], ow[3]);
            }
        }
    }
#undef LOAD_RAW
    __syncthreads();
}
#undef KSWZ
#undef PSWZ
}

namespace rt {
using bf16x8 = __attribute__((ext_vector_type(8))) short;
using f32x16 = __attribute__((ext_vector_type(16))) float;
#define CE(a, b) do { const unsigned x_ = (a), y_ = (b); (a) = x_ > y_ ? x_ : y_; (b) = x_ > y_ ? y_ : x_; } while (0)
#define SORT16_DESC(V) do { CE(V[0], V[1]); CE(V[2], V[3]); CE(V[0], V[2]); CE(V[1], V[3]); CE(V[1], V[2]); CE(V[4], V[5]); CE(V[6], V[7]); CE(V[4], V[6]); CE(V[5], V[7]); CE(V[5], V[6]); CE(V[0], V[4]); CE(V[2], V[6]); CE(V[2], V[4]); CE(V[1], V[5]); CE(V[3], V[7]); CE(V[3], V[5]); CE(V[1], V[2]); CE(V[3], V[4]); CE(V[5], V[6]); CE(V[8], V[9]); CE(V[10], V[11]); CE(V[8], V[10]); CE(V[9], V[11]); CE(V[9], V[10]); CE(V[12], V[13]); CE(V[14], V[15]); CE(V[12], V[14]); CE(V[13], V[15]); CE(V[13], V[14]); CE(V[8], V[12]); CE(V[10], V[14]); CE(V[10], V[12]); CE(V[9], V[13]); CE(V[11], V[15]); CE(V[11], V[13]); CE(V[9], V[10]); CE(V[11], V[12]); CE(V[13], V[14]); CE(V[0], V[8]); CE(V[4], V[12]); CE(V[4], V[8]); CE(V[2], V[10]); CE(V[6], V[14]); CE(V[6], V[10]); CE(V[2], V[4]); CE(V[6], V[8]); CE(V[10], V[12]); CE(V[1], V[9]); CE(V[5], V[13]); CE(V[5], V[9]); CE(V[3], V[11]); CE(V[7], V[15]); CE(V[7], V[11]); CE(V[3], V[5]); CE(V[7], V[9]); CE(V[11], V[13]); CE(V[1], V[2]); CE(V[3], V[4]); CE(V[5], V[6]); CE(V[7], V[8]); CE(V[9], V[10]); CE(V[11], V[12]); CE(V[13], V[14]); } while (0)
#define BMERGE16_DESC(V) do { CE(V[0], V[8]); CE(V[1], V[9]); CE(V[2], V[10]); CE(V[3], V[11]); CE(V[4], V[12]); CE(V[5], V[13]); CE(V[6], V[14]); CE(V[7], V[15]); CE(V[0], V[4]); CE(V[1], V[5]); CE(V[2], V[6]); CE(V[3], V[7]); CE(V[8], V[12]); CE(V[9], V[13]); CE(V[10], V[14]); CE(V[11], V[15]); CE(V[0], V[2]); CE(V[1], V[3]); CE(V[4], V[6]); CE(V[5], V[7]); CE(V[8], V[10]); CE(V[9], V[11]); CE(V[12], V[14]); CE(V[13], V[15]); CE(V[0], V[1]); CE(V[2], V[3]); CE(V[4], V[5]); CE(V[6], V[7]); CE(V[8], V[9]); CE(V[10], V[11]); CE(V[12], V[13]); CE(V[14], V[15]); } while (0)

#define TOP16(A, B) do { _Pragma("unroll") for (int i_ = 0; i_ < 16; ++i_) { const unsigned x_ = A[i_], y_ = B[15 - i_]; A[i_] = x_ > y_ ? x_ : y_; } BMERGE16_DESC(A); } while (0)
__device__ __forceinline__ unsigned ord_key(float f) { const unsigned u = __float_as_uint(f); return u ^ (((unsigned)((int)u >> 31)) | 0x80000000u); }
__device__ __forceinline__ float ord_val(unsigned k) { return __uint_as_float((k & 0x80000000u) ? (k ^ 0x80000000u) : ~k); }
__device__ __forceinline__ int crow(int r, int hi) { return (r & 3) + 8 * (r >> 2) + 4 * hi; }

__device__ __forceinline__ void route_item(int tb, int h, const bf16_t* QP, const bf16_t* SKB, const float* SSQ, int* IDX, float* GATE, int* scr, int lane_in) {
    int lane = lane_in; asm volatile("" : "+v"(lane));
    const int tok = lane & 31, hi = lane >> 5;
    const int row = tb * 32 + tok;
    float rstd;
    { const float4* sp = (const float4*)(SSQ + (size_t)row * 32); float s = 0.f;
#pragma unroll
      for (int i = 0; i < 8; ++i) { const float4 v = sp[i]; s += (v.x + v.y) + (v.z + v.w); }
      rstd = rsqrtf(s * (1.f / DM) + EPS); }
    unsigned top[2][16];
    bf16x8 qf[8], af[2][8];
    unsigned T[16];
#define RT_LOADQ(p_) do { const bf16_t* qp_ = QP + (size_t)row * DM + h * 256 + (p_) * 128 + hi * 8; \
        _Pragma("unroll") for (int ks = 0; ks < 8; ++ks) qf[ks] = *reinterpret_cast<const bf16x8*>(qp_ + ks * 16); } while (0)
#define RT_LOADK(b_, i_) do { const bf16_t* kp_ = SKB + ((size_t)((h * 2 + ((i_) >> 2)) * 128 + ((i_) & 3) * 32 + tok)) * 128 + hi * 8; \
        _Pragma("unroll") for (int ks = 0; ks < 8; ++ks) af[b_][ks] = *reinterpret_cast<const bf16x8*>(kp_ + ks * 16); } while (0)
    RT_LOADQ(0); RT_LOADK(0, 0);
#pragma unroll
    for (int i = 0; i < 8; ++i) {
        const int p = i >> 2, kb = i & 3;
        if (i + 1 < 8) RT_LOADK((i + 1) & 1, i + 1);
        f32x16 acc = {};
#pragma unroll
        for (int ks = 0; ks < 8; ++ks) acc = __builtin_amdgcn_mfma_f32_32x32x16_bf16(af[i & 1][ks], qf[ks], acc, 0, 0, 0);
        unsigned K[16];
#pragma unroll
        for (int r = 0; r < 16; ++r) { const int low = 127 - (32 * kb + (r & 3) + 8 * (r >> 2)) - 4 * hi; K[r] = (ord_key(acc[r]) & ~127u) | (unsigned)low; }
        if (i == 3) RT_LOADQ(1);
        SORT16_DESC(K);
        if (kb == 0) {
#pragma unroll
            for (int j = 0; j < 16; ++j) T[j] = K[j];
        } else { TOP16(T, K); }
        if (kb == 3) {
            unsigned O[16];
#pragma unroll
            for (int j = 0; j < 16; ++j) { auto rr = __builtin_amdgcn_permlane32_swap(T[j], T[j], false, false); O[j] = hi ? rr[0] : rr[1]; }
            TOP16(T, O);
#pragma unroll
            for (int j = 0; j < 16; ++j) top[p][j] = T[j];
        }
        __builtin_amdgcn_sched_barrier(0);
    }
#undef RT_LOADQ
#undef RT_LOADK
    float s1[16], s2[16];
#pragma unroll
    for (int i = 0; i < 16; ++i) {
        s1[i] = ord_val(top[0][i] & ~127u) * rstd; s2[i] = ord_val(top[1][i] & ~127u) * rstd;
        scr[i * 64 + lane] = 127 - (int)(top[0][i] & 127u); scr[(16 + i) * 64 + lane] = 127 - (int)(top[1][i] & 127u);
    }
#define CKEY(a_, b_) ((ord_key(s1[a_] + s2[b_]) & ~255u) | (unsigned)(255 - (16 * (a_) + (b_))))
    unsigned A[16], B[16], Cg[16];
#pragma unroll
    for (int b_ = 0; b_ < 16; ++b_) A[b_] = CKEY(0, b_);
#pragma unroll
    for (int b_ = 0; b_ < 8; ++b_) { B[b_] = CKEY(1, b_); B[8 + b_] = CKEY(15 - b_, 0); }
    BMERGE16_DESC(B);
    Cg[0] = CKEY(2, 0); Cg[1] = CKEY(2, 1); Cg[2] = CKEY(2, 2); Cg[3] = CKEY(2, 3); Cg[4] = CKEY(2, 4);
    Cg[5] = CKEY(3, 0); Cg[6] = CKEY(3, 1); Cg[7] = CKEY(3, 2); Cg[8] = CKEY(3, 3);
    Cg[9] = CKEY(4, 0); Cg[10] = CKEY(4, 1); Cg[11] = CKEY(4, 2);
    Cg[12] = CKEY(5, 0); Cg[13] = CKEY(5, 1); Cg[14] = CKEY(6, 0); Cg[15] = CKEY(6, 1);
    SORT16_DESC(Cg);
    { const unsigned d0 = CKEY(7, 0), d1 = CKEY(7, 1); Cg[15] = Cg[15] > d0 ? Cg[15] : d0; Cg[14] = Cg[14] > d1 ? Cg[14] : d1; BMERGE16_DESC(Cg); }
    TOP16(A, B); TOP16(A, Cg);
#undef CKEY
    asm volatile("s_waitcnt lgkmcnt(0)" ::: "memory");
    float e[16]; float z = 0.f; const float mx = ord_val(A[0] & ~255u);
#pragma unroll
    for (int j = 0; j < 16; ++j) { e[j] = __expf(ord_val(A[j] & ~255u) - mx); z += e[j]; }
    const float rz = 1.f / z;
    int* ip = IDX + (size_t)row * 128 + h * 16 + hi * 8; float* gp = GATE + (size_t)row * 128 + h * 16 + hi * 8;
    int oi[8] = {0, 0, 0, 0, 0, 0, 0, 0}; float og[8] = {0.f, 0.f, 0.f, 0.f, 0.f, 0.f, 0.f, 0.f};
#pragma unroll
    for (int j = 0; j < 16; ++j) {
        const int flat = 255 - (int)(A[j] & 255u), a_ = flat >> 4, b_ = flat & 15;
        const int ex = scr[a_ * 64 + lane] * 128 + scr[(16 + b_) * 64 + lane];
        if (j < 8) { if (!hi) { oi[j] = ex; og[j] = e[j] * rz; } } else { if (hi) { oi[j - 8] = ex; og[j - 8] = e[j] * rz; } }
    }
    *(int4*)(ip) = make_int4(oi[0], oi[1], oi[2], oi[3]); *(int4*)(ip + 4) = make_int4(oi[4], oi[5], oi[6], oi[7]);
    *(float4*)(gp) = make_float4(og[0], og[1], og[2], og[3]); *(float4*)(gp + 4) = make_float4(og[4], og[5], og[6], og[7]);
    asm volatile("s_waitcnt lgkmcnt(0)" ::: "memory");
}
#undef CE
#undef TOP16
}

__device__ __forceinline__ void phase_route(const Args& a, unsigned char* lds, int bid, int nb) {
    const int tid = opaque_tid(), wave = __builtin_amdgcn_readfirstlane(tid >> 6), lane = tid & 63;
    const bf16_t* QP = (const bf16_t*)(a.ws + WS_MIX); const bf16_t* SKB = (const bf16_t*)(a.ws + WS_SKB); const float* SSQ = (const float*)(a.ws + WS_SSQ);
    int* IDX = (int*)(a.ws + WS_IDX); float* GATE = (float*)(a.ws + WS_GATE);
    int* scr = (int*)lds + wave * 2048;
    {
        const bf16_t* X1W = (const bf16_t*)(a.ws + WS_HN); signed char* X1Q = (signed char*)(a.ws + WS_X1Q); float* XSC = (float*)(a.ws + WS_XSC);
        for (int row = bid * NWAVES + wave; row < TREAL; row += nb * NWAVES) {
            uint4 xr[4]; float am = 0.f;
#pragma unroll
            for (int j = 0; j < 4; ++j) { xr[j] = *(const uint4*)(X1W + (size_t)row * DM + 8 * lane + 512 * j);
                am = fmaxf(am, fmaxf(fmaxf(fmaxf(fabsf(bf_lo(xr[j].x)), fabsf(bf_hi(xr[j].x))), fmaxf(fabsf(bf_lo(xr[j].y)), fabsf(bf_hi(xr[j].y)))), fmaxf(fmaxf(fabsf(bf_lo(xr[j].z)), fabsf(bf_hi(xr[j].z))), fmaxf(fabsf(bf_lo(xr[j].w)), fabsf(bf_hi(xr[j].w)))))); }
            am = wave_max(am);
            const float sc = am > 0.f ? 127.f / am : 0.f;
#pragma unroll
            for (int j = 0; j < 4; ++j) {
                const unsigned ww[4] = {xr[j].x, xr[j].y, xr[j].z, xr[j].w}; unsigned o[2] = {0u, 0u};
#pragma unroll
                for (int q = 0; q < 4; ++q) { const int q0 = (int)rintf(bf_lo(ww[q]) * sc), q1 = (int)rintf(bf_hi(ww[q]) * sc); o[q >> 1] |= ((unsigned)(q0 & 255) | ((unsigned)(q1 & 255) << 8)) << (16 * (q & 1)); }
                *(uint2*)(X1Q + (size_t)row * DM + 8 * lane + 512 * j) = make_uint2(o[0], o[1]);
            }
            if (lane == 0) XSC[row] = am * (1.f / 127.f);
        }
    }
    for (int item = bid * NWAVES + wave; item < (TREAL / 32) * 8; item += nb * NWAVES) rt::route_item(item >> 3, item & 7, QP, SKB, SSQ, IDX, GATE, scr, lane);
}

constexpr int CW_QPV = 8192, CW_QPU = 8192 + 8 * 64;
constexpr int PX_ITEMS = TREAL / 64;
constexpr size_t WS_W = WS_Z + 4 * MiB, WS_PART = WS_Z + 32 * MiB, WS_Y = WS_Z + 160 * MiB;


template <int CTRL, int RMASK> __device__ __forceinline__ float dppf(float old, float v) { return __builtin_bit_cast(float, __builtin_amdgcn_update_dpp(__builtin_bit_cast(int, old), __builtin_bit_cast(int, v), CTRL, RMASK, 0xf, false)); }
template <int CTRL> __device__ __forceinline__ int dppi(int v) { return __builtin_amdgcn_update_dpp(0, v, CTRL, 0xf, 0xf, false); }
namespace pu2 {
typedef float f32x2v __attribute__((ext_vector_type(2)));
typedef unsigned u32x4v __attribute__((ext_vector_type(4)));
#define SBP() __builtin_amdgcn_sched_barrier(0)
#define PU_CHUNK_LD(dst, r_, q_) dst = __builtin_amdgcn_raw_buffer_load_b128(RI, g128, (r_) * 512 + (q_) * 16, 0)
#define PU_ROW_LD(buf, e_) buf = __builtin_amdgcn_raw_buffer_load_b128(U, (int)(e_) * 256 + c16, 0, 0)
#define PU_CONSUME(buf, I_) do { int s_ = __builtin_amdgcn_sdot4((int)buf[0], hq0, 0, false); s_ = __builtin_amdgcn_sdot4((int)buf[1], hq1, s_, false); \
    s_ = __builtin_amdgcn_sdot4((int)buf[2], hq2, s_, false); s_ = __builtin_amdgcn_sdot4((int)buf[3], hq3, s_, false); \
    s_ += dppi<0x128>(s_); s_ += dppi<0x124>(s_); s_ += dppi<0x122>(s_); s_ += dppi<0x121>(s_); \
    if ((I_) < 16) keep0 = (c == ((I_) & 15)) ? s_ : keep0; else keep1 = (c == ((I_) & 15)) ? s_ : keep1; } while (0)
#define PU_TOKEN_BODY(row_, nrow_, has_next_) do { \
    PU_CHUNK_LD(C7, row_, 7); \
    SBP(); PU_CONSUME(B0, 0); \
    PU_ROW_LD(B0, C2.x); \
    SBP(); PU_CONSUME(B1, 1); \
    PU_ROW_LD(B1, C2.y); \
    SBP(); PU_CONSUME(B2, 2); \
    PU_ROW_LD(B2, C2.z); \
    SBP(); PU_CONSUME(B3, 3); \
    PU_ROW_LD(B3, C2.w); \
    if (has_next_) PU_CHUNK_LD(C0, nrow_, 0); \
    SBP(); PU_CONSUME(B4, 4); \
    PU_ROW_LD(B4, C3.x); \
    SBP(); PU_CONSUME(B5, 5); \
    PU_ROW_LD(B5, C3.y); \
    SBP(); PU_CONSUME(B6, 6); \
    PU_ROW_LD(B6, C3.z); \
    SBP(); PU_CONSUME(B7, 7); \
    PU_ROW_LD(B7, C3.w); \
    if (has_next_) PU_CHUNK_LD(C1, nrow_, 1); \
    SBP(); PU_CONSUME(B0, 8); \
    PU_ROW_LD(B0, C4.x); \
    SBP(); PU_CONSUME(B1, 9); \
    PU_ROW_LD(B1, C4.y); \
    SBP(); PU_CONSUME(B2, 10); \
    PU_ROW_LD(B2, C4.z); \
    SBP(); PU_CONSUME(B3, 11); \
    PU_ROW_LD(B3, C4.w); \
    if (has_next_) PU_CHUNK_LD(C2, nrow_, 2); \
    SBP(); PU_CONSUME(B4, 12); \
    PU_ROW_LD(B4, C5.x); \
    SBP(); PU_CONSUME(B5, 13); \
    PU_ROW_LD(B5, C5.y); \
    SBP(); PU_CONSUME(B6, 14); \
    PU_ROW_LD(B6, C5.z); \
    SBP(); PU_CONSUME(B7, 15); \
    PU_ROW_LD(B7, C5.w); \
    if (has_next_) PU_CHUNK_LD(C3, nrow_, 3); \
    SBP(); PU_CONSUME(B0, 16); \
    PU_ROW_LD(B0, C6.x); \
    SBP(); PU_CONSUME(B1, 17); \
    PU_ROW_LD(B1, C6.y); \
    SBP(); PU_CONSUME(B2, 18); \
    PU_ROW_LD(B2, C6.z); \
    SBP(); PU_CONSUME(B3, 19); \
    PU_ROW_LD(B3, C6.w); \
    if (has_next_) PU_CHUNK_LD(C4, nrow_, 4); \
    SBP(); PU_CONSUME(B4, 20); \
    PU_ROW_LD(B4, C7.x); \
    SBP(); PU_CONSUME(B5, 21); \
    PU_ROW_LD(B5, C7.y); \
    SBP(); PU_CONSUME(B6, 22); \
    PU_ROW_LD(B6, C7.z); \
    SBP(); PU_CONSUME(B7, 23); \
    PU_ROW_LD(B7, C7.w); \
    if (has_next_) PU_CHUNK_LD(C5, nrow_, 5); \
    SBP(); PU_CONSUME(B0, 24); \
    if (has_next_) PU_ROW_LD(B0, C0.x); \
    SBP(); PU_CONSUME(B1, 25); \
    if (has_next_) PU_ROW_LD(B1, C0.y); \
    SBP(); PU_CONSUME(B2, 26); \
    if (has_next_) PU_ROW_LD(B2, C0.z); \
    SBP(); PU_CONSUME(B3, 27); \
    if (has_next_) PU_ROW_LD(B3, C0.w); \
    if (has_next_) PU_CHUNK_LD(C6, nrow_, 6); \
    SBP(); PU_CONSUME(B4, 28); \
    if (has_next_) PU_ROW_LD(B4, C1.x); \
    SBP(); PU_CONSUME(B5, 29); \
    if (has_next_) PU_ROW_LD(B5, C1.y); \
    SBP(); PU_CONSUME(B6, 30); \
    if (has_next_) PU_ROW_LD(B6, C1.z); \
    SBP(); PU_CONSUME(B7, 31); \
    if (has_next_) PU_ROW_LD(B7, C1.w); \
    } while (0)
#undef SBP
}

__device__ __forceinline__ void phase_pu(const Args& a, unsigned char* lds, unsigned* ctl, int xcc) {
    using namespace pu2;
#define SBP() __builtin_amdgcn_sched_barrier(0)
    const int tid = opaque_tid(), wave = __builtin_amdgcn_readfirstlane(tid >> 6), lane = tid & 63;
    volatile LAS unsigned* slot = (volatile LAS unsigned*)((LAS unsigned char*)lds + LDS_MISC) + 2;
    const signed char* X1Q = (const signed char*)(a.ws + WS_X1Q); float* PART = (float*)(a.ws + WS_PART);
    const __amdgpu_buffer_rsrc_t RI = __builtin_amdgcn_make_buffer_rsrc((void*)(a.ws + WS_IDX), (short)0, TREAL * 512, 0x00020000);
    for (int ss = 0; ss < 8; ++ss) {
        const int s = (xcc + ss) & 7;
        const __amdgpu_buffer_rsrc_t U = __builtin_amdgcn_make_buffer_rsrc((void*)(a.ws + WS_U + (size_t)s * (16384 * 256)), (short)0, 16384 * 256, 0x00020000);
        for (;;) {
            const int item = next_item(ctl + CW_QPU + 64 * s, slot);
            if (item >= PX_ITEMS) break;
            int ln = lane; asm volatile("" : "+v"(ln));
            const int g = ln >> 4, c = ln & 15, c16 = c * 16, g128 = g * 128;
            const int r0 = item * 64 + wave * 8;
            u32x4v C0, C1, C2, C3, C4, C5, C6, C7, B0, B1, B2, B3, B4, B5, B6, B7;
            PU_CHUNK_LD(C0, r0, 0); PU_CHUNK_LD(C1, r0, 1); PU_CHUNK_LD(C2, r0, 2); PU_CHUNK_LD(C3, r0, 3); PU_CHUNK_LD(C4, r0, 4); PU_CHUNK_LD(C5, r0, 5); PU_CHUNK_LD(C6, r0, 6);
            uint4 nxq = *(const uint4*)(X1Q + (size_t)r0 * DM + 256 * s + 16 * c);
            PU_ROW_LD(B0, C0.x); PU_ROW_LD(B1, C0.y); PU_ROW_LD(B2, C0.z); PU_ROW_LD(B3, C0.w); PU_ROW_LD(B4, C1.x); PU_ROW_LD(B5, C1.y); PU_ROW_LD(B6, C1.z); PU_ROW_LD(B7, C1.w);
#pragma unroll 1
            for (int t = 0; t < 8; ++t) {
                const int row = r0 + t, nrow = row + 1; const bool has_next = t < 7;
                const int hq0 = (int)nxq.x, hq1 = (int)nxq.y, hq2 = (int)nxq.z, hq3 = (int)nxq.w;
                if (has_next) nxq = *(const uint4*)(X1Q + (size_t)nrow * DM + 256 * s + 16 * c);
                int keep0 = 0, keep1 = 0;
                PU_TOKEN_BODY(row, nrow, has_next);
                float* pp = PART + (size_t)row * 1024 + s * 128 + 32 * g + c;
                pp[0] = (float)keep0; pp[16] = (float)keep1;
            }
        }
    }
#undef SBP
}
__device__ __forceinline__ void phase_pc(const Args& a, int bid, int nb) {
    const int tid = opaque_tid(), wave = __builtin_amdgcn_readfirstlane(tid >> 6), lane = tid & 63;
    const float* SSQ = (const float*)(a.ws + WS_SSQ); const int* IDX = (const int*)(a.ws + WS_IDX); const float* GATE = (const float*)(a.ws + WS_GATE);
    const float* ISC = (const float*)(a.ws + WS_ISC); const float* PART = (const float*)(a.ws + WS_PART); float* W = (float*)(a.ws + WS_W);
    for (int row = bid * NWAVES + wave; row < TREAL; row += nb * NWAVES) {
        float ssv = lane < 32 ? SSQ[(size_t)row * 32 + lane] : 0.f; ssv = wave_sum(ssv);
        const float rstd = rsqrtf(ssv * (1.f / DM) + EPS);
        const float xsc = ((const float*)(a.ws + WS_XSC))[row];
#pragma unroll
        for (int k = 0; k < 2; ++k) {
            const int p = 64 * k + lane; float d = 0.f;
#pragma unroll
            for (int s = 0; s < 8; ++s) d += PART[(size_t)row * 1024 + s * 128 + p];
            const int e = IDX[(size_t)row * 128 + p];
            const float pre = d * rstd * ISC[e] * xsc;
            W[(size_t)row * 128 + p] = GATE[(size_t)row * 128 + p] * ISC[16384 + e] * (0.5f * pre * (1.f + erff(pre * 0.7071067811865476f)));
        }
    }
}
namespace pv2 {
typedef float f32x2v __attribute__((ext_vector_type(2)));
typedef unsigned u32x4v __attribute__((ext_vector_type(4))); typedef float f32x4v __attribute__((ext_vector_type(4)));
struct Chunk { u32x4v i; f32x4v w; };
#define SBP() __builtin_amdgcn_sched_barrier(0)
#define PV_CHUNK_LD(dst, r_, q_) do { dst.i = __builtin_bit_cast(u32x4v, __builtin_amdgcn_raw_buffer_load_b128(RI, g128, (r_) * 512 + (q_) * 16, 0)); dst.w = __builtin_bit_cast(f32x4v, __builtin_amdgcn_raw_buffer_load_b128(RW, g128, (r_) * 512 + (q_) * 16, 0)); } while (0)
#define PV_ROW_LD(buf, e_) buf = __builtin_amdgcn_raw_buffer_load_b128(V, (int)(e_) * 256 + c16, 0, 0)
#define PV_FMA_LO(y_, c_, wp_) asm("v_pk_fma_f32 %0, %1, %2, %0 op_sel_hi:[1,0,1]" : "+v"(y_) : "v"(c_), "v"(wp_))
#define PV_FMA_HI(y_, c_, wp_) asm("v_pk_fma_f32 %0, %1, %2, %0 op_sel:[0,1,0] op_sel_hi:[1,1,1]" : "+v"(y_) : "v"(c_), "v"(wp_))
#define PV_CONSUME(buf, w4_, E_) do { const f32x2v wp_ = __builtin_shufflevector(w4_, w4_, ((E_) >> 1) * 2, ((E_) >> 1) * 2 + 1); const unsigned d_[4] = {buf[0], buf[1], buf[2], buf[3]}; \
    _Pragma("unroll") for (int k_ = 0; k_ < 4; ++k_) { const f32x2v lo_ = __builtin_amdgcn_cvt_pk_f32_fp8((int)d_[k_], false), hi_ = __builtin_amdgcn_cvt_pk_f32_fp8((int)d_[k_], true); \
        if (((E_) & 1) == 0) { PV_FMA_LO(y2[2 * k_], lo_, wp_); PV_FMA_LO(y2[2 * k_ + 1], hi_, wp_); } else { PV_FMA_HI(y2[2 * k_], lo_, wp_); PV_FMA_HI(y2[2 * k_ + 1], hi_, wp_); } } } while (0)
#define PV_TOKEN_BODY(row_, nrow_, has_next_) do { \
    PV_CHUNK_LD(C7, row_, 7); \
    SBP(); PV_CONSUME(B0, C0.w, 0); \
    PV_ROW_LD(B0, C2.i.x); \
    SBP(); PV_CONSUME(B1, C0.w, 1); \
    PV_ROW_LD(B1, C2.i.y); \
    SBP(); PV_CONSUME(B2, C0.w, 2); \
    PV_ROW_LD(B2, C2.i.z); \
    SBP(); PV_CONSUME(B3, C0.w, 3); \
    PV_ROW_LD(B3, C2.i.w); \
    if (has_next_) PV_CHUNK_LD(C0, nrow_, 0); \
    SBP(); PV_CONSUME(B4, C1.w, 0); \
    PV_ROW_LD(B4, C3.i.x); \
    SBP(); PV_CONSUME(B5, C1.w, 1); \
    PV_ROW_LD(B5, C3.i.y); \
    SBP(); PV_CONSUME(B6, C1.w, 2); \
    PV_ROW_LD(B6, C3.i.z); \
    SBP(); PV_CONSUME(B7, C1.w, 3); \
    PV_ROW_LD(B7, C3.i.w); \
    if (has_next_) PV_CHUNK_LD(C1, nrow_, 1); \
    SBP(); PV_CONSUME(B0, C2.w, 0); \
    PV_ROW_LD(B0, C4.i.x); \
    SBP(); PV_CONSUME(B1, C2.w, 1); \
    PV_ROW_LD(B1, C4.i.y); \
    SBP(); PV_CONSUME(B2, C2.w, 2); \
    PV_ROW_LD(B2, C4.i.z); \
    SBP(); PV_CONSUME(B3, C2.w, 3); \
    PV_ROW_LD(B3, C4.i.w); \
    if (has_next_) PV_CHUNK_LD(C2, nrow_, 2); \
    SBP(); PV_CONSUME(B4, C3.w, 0); \
    PV_ROW_LD(B4, C5.i.x); \
    SBP(); PV_CONSUME(B5, C3.w, 1); \
    PV_ROW_LD(B5, C5.i.y); \
    SBP(); PV_CONSUME(B6, C3.w, 2); \
    PV_ROW_LD(B6, C5.i.z); \
    SBP(); PV_CONSUME(B7, C3.w, 3); \
    PV_ROW_LD(B7, C5.i.w); \
    if (has_next_) PV_CHUNK_LD(C3, nrow_, 3); \
    SBP(); PV_CONSUME(B0, C4.w, 0); \
    PV_ROW_LD(B0, C6.i.x); \
    SBP(); PV_CONSUME(B1, C4.w, 1); \
    PV_ROW_LD(B1, C6.i.y); \
    SBP(); PV_CONSUME(B2, C4.w, 2); \
    PV_ROW_LD(B2, C6.i.z); \
    SBP(); PV_CONSUME(B3, C4.w, 3); \
    PV_ROW_LD(B3, C6.i.w); \
    if (has_next_) PV_CHUNK_LD(C4, nrow_, 4); \
    SBP(); PV_CONSUME(B4, C5.w, 0); \
    PV_ROW_LD(B4, C7.i.x); \
    SBP(); PV_CONSUME(B5, C5.w, 1); \
    PV_ROW_LD(B5, C7.i.y); \
    SBP(); PV_CONSUME(B6, C5.w, 2); \
    PV_ROW_LD(B6, C7.i.z); \
    SBP(); PV_CONSUME(B7, C5.w, 3); \
    PV_ROW_LD(B7, C7.i.w); \
    if (has_next_) PV_CHUNK_LD(C5, nrow_, 5); \
    SBP(); PV_CONSUME(B0, C6.w, 0); \
    if (has_next_) PV_ROW_LD(B0, C0.i.x); \
    SBP(); PV_CONSUME(B1, C6.w, 1); \
    if (has_next_) PV_ROW_LD(B1, C0.i.y); \
    SBP(); PV_CONSUME(B2, C6.w, 2); \
    if (has_next_) PV_ROW_LD(B2, C0.i.z); \
    SBP(); PV_CONSUME(B3, C6.w, 3); \
    if (has_next_) PV_ROW_LD(B3, C0.i.w); \
    if (has_next_) PV_CHUNK_LD(C6, nrow_, 6); \
    SBP(); PV_CONSUME(B4, C7.w, 0); \
    if (has_next_) PV_ROW_LD(B4, C1.i.x); \
    SBP(); PV_CONSUME(B5, C7.w, 1); \
    if (has_next_) PV_ROW_LD(B5, C1.i.y); \
    SBP(); PV_CONSUME(B6, C7.w, 2); \
    if (has_next_) PV_ROW_LD(B6, C1.i.z); \
    SBP(); PV_CONSUME(B7, C7.w, 3); \
    if (has_next_) PV_ROW_LD(B7, C1.i.w); \
    } while (0)
}

__device__ __forceinline__ void phase_pv(const Args& a, unsigned char* lds, unsigned* ctl, int xcc) {
    using namespace pv2;
    const int tid = opaque_tid(), wave = __builtin_amdgcn_readfirstlane(tid >> 6), lane = tid & 63;
    volatile LAS unsigned* slot = (volatile LAS unsigned*)((LAS unsigned char*)lds + LDS_MISC) + 2;
    bf16_t* Y = (bf16_t*)(a.ws + WS_Y);
    const __amdgpu_buffer_rsrc_t RI = __builtin_amdgcn_make_buffer_rsrc((void*)(a.ws + WS_IDX), (short)0, TREAL * 512, 0x00020000);
    const __amdgpu_buffer_rsrc_t RW = __builtin_amdgcn_make_buffer_rsrc((void*)(a.ws + WS_W), (short)0, TREAL * 512, 0x00020000);
    float* ybuf = (float*)lds + wave * 1024;
    for (int ss = 0; ss < 8; ++ss) {
        const int s = (xcc + ss) & 7;
        const __amdgpu_buffer_rsrc_t V = __builtin_amdgcn_make_buffer_rsrc((void*)(a.ws + WS_V + (size_t)s * (16384 * 256)), (short)0, 16384 * 256, 0x00020000);
        for (;;) {
            const int item = next_item(ctl + CW_QPV + 64 * s, slot);
            if (item >= PX_ITEMS) break;
            int ln = lane; asm volatile("" : "+v"(ln));
            const int g = ln >> 4, c = ln & 15, c16 = c * 16, g128 = g * 128;
            const int r0 = item * 64 + wave * 8;
            Chunk C0, C1, C2, C3, C4, C5, C6, C7; u32x4v B0, B1, B2, B3, B4, B5, B6, B7;
            PV_CHUNK_LD(C0, r0, 0); PV_CHUNK_LD(C1, r0, 1); PV_CHUNK_LD(C2, r0, 2); PV_CHUNK_LD(C3, r0, 3); PV_CHUNK_LD(C4, r0, 4); PV_CHUNK_LD(C5, r0, 5); PV_CHUNK_LD(C6, r0, 6);
            PV_ROW_LD(B0, C0.i.x); PV_ROW_LD(B1, C0.i.y); PV_ROW_LD(B2, C0.i.z); PV_ROW_LD(B3, C0.i.w); PV_ROW_LD(B4, C1.i.x); PV_ROW_LD(B5, C1.i.y); PV_ROW_LD(B6, C1.i.z); PV_ROW_LD(B7, C1.i.w);
#pragma unroll 1
            for (int t = 0; t < 8; ++t) {
                const int row = r0 + t, nrow = row + 1; const bool has_next = t < 7;
                f32x2v y2[8];
#pragma unroll
                for (int k = 0; k < 8; ++k) y2[k] = (f32x2v){0.f, 0.f};
                PV_TOKEN_BODY(row, nrow, has_next);
                float4* yb = (float4*)(ybuf + ln * 16);
#pragma unroll
                for (int k = 0; k < 4; ++k) yb[k] = make_float4(y2[2 * k][0], y2[2 * k][1], y2[2 * k + 1][0], y2[2 * k + 1][1]);
                asm volatile("s_waitcnt lgkmcnt(0)" ::: "memory");
                if (g == 0) {
                    unsigned yo[8];
#pragma unroll
                    for (int k = 0; k < 4; ++k) {
                        const float4 y0 = yb[k], y1 = yb[64 + k], y2b = yb[128 + k], y3 = yb[192 + k];
                        yo[2 * k] = pk2((y0.x + y1.x) + (y2b.x + y3.x), (y0.y + y1.y) + (y2b.y + y3.y)); yo[2 * k + 1] = pk2((y0.z + y1.z) + (y2b.z + y3.z), (y0.w + y1.w) + (y2b.w + y3.w));
                    }
                    uint4* yp = (uint4*)(Y + (size_t)row * DM + 256 * s + 16 * c);
                    yp[0] = make_uint4(yo[0], yo[1], yo[2], yo[3]); yp[1] = make_uint4(yo[4], yo[5], yo[6], yo[7]);
                }
                asm volatile("s_waitcnt lgkmcnt(0)" ::: "memory");
            }
        }
    }
}
__device__ __forceinline__ void phase_pn(const Args& a, int bid, int nb) {
    const int tid = opaque_tid(), wave = __builtin_amdgcn_readfirstlane(tid >> 6), lane = tid & 63;
    const bf16_t* Y = (const bf16_t*)(a.ws + WS_Y); const bf16_t* X1 = (const bf16_t*)(a.ws + WS_HN);
    for (int row = bid * NWAVES + wave; row < TREAL; row += nb * NWAVES) {
        f32x4* p = (f32x4*)(a.out + (size_t)row * DM) + lane;
        const uint2* yp = (const uint2*)(Y + (size_t)row * DM) + lane; const uint2* xp = (const uint2*)(X1 + (size_t)row * DM) + lane;
        f32x4 v[8]; float ss = 0.f;
#pragma unroll
        for (int j = 0; j < 8; ++j) { const uint2 yy = yp[64 * j], xx = xp[64 * j];
            v[j][0] = bf_lo(xx.x) + bf_lo(yy.x); v[j][1] = bf_hi(xx.x) + bf_hi(yy.x); v[j][2] = bf_lo(xx.y) + bf_lo(yy.y); v[j][3] = bf_hi(xx.y) + bf_hi(yy.y);
            ss += (v[j][0] * v[j][0] + v[j][1] * v[j][1]) + (v[j][2] * v[j][2] + v[j][3] * v[j][3]); }
        const float r = rsqrtf(wave_sum(ss) * (1.f / DM) + EPS);
        const f32x4* wp = (const f32x4*)a.nfinal + lane;
#pragma unroll
        for (int j = 0; j < 8; ++j) p[64 * j] = v[j] * r * wp[64 * j];
    }
}

__device__ __forceinline__ void phase_mix(const Args& a, unsigned char* lds, unsigned* ctr) {
    const bf16_t* Z = (const bf16_t*)(a.ws + WS_Z); bf16_t* MIX = (bf16_t*)(a.ws + WS_MIX);
    volatile LAS unsigned* slot = (volatile LAS unsigned*)((LAS unsigned char*)lds + LDS_MISC) + 2;
    for (;;) {
        const int item = next_item(ctr, slot);
        if (item >= 64 + 2048) break;
        if (item < 64) mls::mlstm_item(item >> 2, item & 3, a, (char*)lds);
        else { const int k = item - 64, qb = 15 - (k >> 7), bh = k & 127; const float lam = attn_lambda(a); att::attn_unit(bh >> 3, bh & 7, qb, Z, MIX, lam, a.subln, (char*)lds); }
    }
}

__global__ void __launch_bounds__(NTHREADS, 2) mega(Args a) {
    extern __shared__ __attribute__((aligned(16))) unsigned char lds[];
    cg::grid_group grid = cg::this_grid();
    const int bid = blockIdx.x, nb = gridDim.x;
    unsigned char* ws = a.ws;
    bf16_t* WinT = (bf16_t*)(ws + WS_WIN); bf16_t* WoutT = (bf16_t*)(ws + WS_WOUT); bf16_t* WqT = (bf16_t*)(ws + WS_WQ);
    float* rope = (float*)(ws + WS_ROPE); float* SSQ = (float*)(ws + WS_SSQ);
    bf16_t* HN = (bf16_t*)(ws + WS_HN); bf16_t* MIX = (bf16_t*)(ws + WS_MIX); bf16_t* Z = (bf16_t*)(ws + WS_Z);

    volatile LAS unsigned* MISC = (volatile LAS unsigned*)((LAS unsigned char*)lds + LDS_MISC);
    if (threadIdx.x < 16) MISC[threadIdx.x] = 0u;
    __syncthreads();
    unsigned* ctl = (unsigned*)(ws + WS_CTL);
    XcdBarrier bar = xcd_barrier_post(ctl + CW_BAR, MISC);
    phase_prep(a, lds, bid, nb);
    grid.sync();
    { pg8::Gemm g{HN, WinT, MROWS, NZ, DM}; EpiZ E{Z, rope}; pg8::StaticOrder S; S.init(g.M, g.N, nb, bid);
      pg8::gemm_phase<EpiZ, pg8::StaticOrder, true, true>((PG8_LAS unsigned char*)lds, g, S, E); }
    phase_tables(a, lds, ctl);
    xcd_barrier(bar);
    phase_mix(a, lds, ctl + CW_QUEUE);
    xcd_barrier(bar);
    { pg8::Gemm g{MIX, WoutT, TREAL, DM, DM}; EpiX1 E{a.x, HN, SSQ}; pg8::StaticOrder S; S.init(g.M, g.N, nb, bid);
      pg8::gemm_phase<EpiX1, pg8::StaticOrder, true, true>((PG8_LAS unsigned char*)lds, g, S, E); }
    xcd_barrier(bar);
    { pg8::Gemm g{HN, WqT, TREAL, DM, DM}; pg8::EpiBf16<0> E{MIX, DM, nullptr, 0, 0, 1.f}; pg8::StaticOrder S; S.init(g.M, g.N, nb, bid);
      pg8::gemm_phase<pg8::EpiBf16<0>, pg8::StaticOrder, true, true>((PG8_LAS unsigned char*)lds, g, S, E); }
    xcd_barrier(bar);
    phase_route(a, lds, bid, nb);
    xcd_barrier(bar);
    { const int xcc = (int)(xb_xcc_id() & 7u);
      phase_pu(a, lds, ctl, xcc); xcd_barrier(bar);
      phase_pc(a, bid, nb); xcd_barrier(bar);
      phase_pv(a, lds, ctl, xcc); xcd_barrier(bar);
      phase_pn(a, bid, nb); }
}

extern "C" void kernel_launch(void* const* d_in, const int* in_sizes, int n_in, void* d_out, int out_size, void* d_ws, size_t ws_size, hipStream_t stream) {
    if (n_in != 18 || out_size != TREAL * DM || ws_size < WS_END) { fprintf(stderr, "kernel_launch: unexpected shapes n_in %d out %d ws %zu (need %zu)\n", n_in, out_size, ws_size, (size_t)WS_END); return; }
    static int grid_blocks = 0;
    if (!grid_blocks) {
        int dev = 0, cus = 0, per_cu = 0;
        (void)hipGetDevice(&dev);
        (void)hipDeviceGetAttribute(&cus, hipDeviceAttributeMultiprocessorCount, dev);
        (void)hipFuncSetAttribute((const void*)mega, hipFuncAttributeMaxDynamicSharedMemorySize, LDS_BYTES);
        (void)hipOccupancyMaxActiveBlocksPerMultiprocessor(&per_cu, (const void*)mega, NTHREADS, LDS_BYTES);
        if (per_cu < 1) { fprintf(stderr, "kernel_launch: occupancy query says %d blocks/CU\n", per_cu); per_cu = 1; }
        if (per_cu > 1) per_cu = 1;
        grid_blocks = cus * per_cu;
    }
    Args a{};
    a.x = (const float*)d_in[0]; a.meta = (const float*)d_in[1]; a.nmw = (const float*)d_in[2]; a.w_in = (const float*)d_in[3];
    a.lamqk = (const float*)d_in[4]; a.subln = (const float*)d_in[5]; a.convw = (const float*)d_in[6]; a.convb = (const float*)d_in[7];
    a.ib = (const float*)d_in[8]; a.fb = (const float*)d_in[9]; a.mnw = (const float*)d_in[10]; a.w_out = (const float*)d_in[11];
    a.nfw_ffn = (const float*)d_in[12]; a.w_q = (const float*)d_in[13]; a.subkeys = (const float*)d_in[14]; a.pu = (const float*)d_in[15];
    a.pv = (const float*)d_in[16]; a.nfinal = (const float*)d_in[17];
    a.out = (float*)d_out; a.ws = (unsigned char*)d_ws;
    (void)hipMemsetAsync((char*)d_ws + WS_CTL, 0, 65536, stream);
    void* kargs[] = {&a};
    const hipError_t e = hipLaunchCooperativeKernel((const void*)mega, dim3(grid_blocks), dim3(NTHREADS), kargs, LDS_BYTES, stream);
    if (e != hipSuccess) fprintf(stderr, "kernel_launch: cooperative launch failed: %s (grid %d)\n", hipGetErrorString(e), grid_blocks);
}
```

```cpp
#include <hip/hip_runtime.h>
#include <hip/hip_bf16.h>
#include <cstdio>
#include <cstdint>
#include <cmath>
namespace pg8 {
#define PG8_LAS __attribute__((address_space(3)))
typedef unsigned short bf16_t;
typedef short bf16x8 __attribute__((ext_vector_type(8)));
typedef float f32x4 __attribute__((ext_vector_type(4)));
typedef unsigned u32x4 __attribute__((ext_vector_type(4)));
constexpr int BM = 256, BK = 64, HALF = 128, HTB = HALF * BK * 2  , STAGE_BYTES = 8 * HTB, NXCD = 8, WGM = 8;

__host__ __device__ __forceinline__ int lds_byte(int r, int c) { const int st = (r >> 4) * 2 + (c >> 5), rr = r & 15, cc = c & 31, ob = rr * 64 + cc * 2; return st * 1024 + (ob ^ (((ob >> 9) & 1) << 5)); }
__host__ __device__ __forceinline__ void stage_rc(int b, int& R, int& C) { const int st = b / 1024, sb = b % 1024, swz = sb ^ (((sb >> 9) & 1) << 5); R = (st >> 1) * 16 + swz / 64; C = (st & 1) * 32 + (swz % 64) / 2; }
__host__ __device__ __forceinline__ int perm32(int rho) { const int n = rho >> 4, i = rho & 15; return 8 * (i >> 2) + 4 * n + (i & 3); }

struct Unit { int pm, pn; };
struct Gemm { const bf16_t* A; const bf16_t* Bt; int M, N, K; };

struct StaticOrder {
    int nM, nN, nwg, G, c;
    __host__ __device__ void init(int M, int N, int G_, int c_) { nM = M / BM; nN = N / BM; nwg = nM * nN; G = G_; c = c_; }
    __host__ __device__ bool next(int i, Unit& u) const {
        const long L = (long)i * G + c; if (L >= nwg) return false;
        int wgid = (int)L; { const int q = nwg / NXCD, r = nwg % NXCD, xcd = wgid % NXCD, off = wgid / NXCD; wgid = (xcd < r ? xcd * (q + 1) : r * (q + 1) + (xcd - r) * q) + off; }
        const int nig = WGM * nN, gid = wgid / nig, fm = gid * WGM, gsz = (nM - fm) < WGM ? (nM - fm) : WGM;
        u.pm = fm + ((wgid % nig) % gsz); u.pn = (wgid % nig) / gsz; return true;
    }
    __device__ __forceinline__ void a_ready(const Unit&) const {}
    __device__ __forceinline__ void done(const Unit&) const {}
};

__device__ __forceinline__ unsigned cvt_pk_bf16(float lo, float hi) { unsigned r; asm volatile("v_cvt_pk_bf16_f32 %0, %1, %2" : "=v"(r) : "v"(lo), "v"(hi)); return r; }
typedef float f32x2 __attribute__((ext_vector_type(2)));
__device__ __forceinline__ f32x2 gelu_pk(f32x2 v) {
    const f32x2 av = __builtin_elementwise_abs(v), d = av * 0.2316418882f + 1.0f;
    f32x2 t; t.x = __builtin_amdgcn_rcpf(d.x); t.y = __builtin_amdgcn_rcpf(d.y);
    f32x2 q = t * 0.5307027145f + (-0.7265760135f); q = q * t + 0.7107068705f; q = q * t + (-0.142248368f); q = q * t + 0.127414796f; q = q * t;
    const f32x2 s = (v * v) * (-0.72134752044f);
    f32x2 e; e.x = __builtin_amdgcn_exp2f(s.x); e.y = __builtin_amdgcn_exp2f(s.y);
    const f32x2 m = v * (q * e), r = v - m;
    f32x2 o; o.x = v.x < 0.f ? m.x : r.x; o.y = v.y < 0.f ? m.y : r.y; return o;
}

template <int ACT  > struct EpiBf16 {
    static constexpr bool PERM = true, AFTER_DRAIN = false; static_assert(ACT == 0 || ACT == 1, "EpiBf16: ACT is 0 (none) or 1 (gelu_pk)");
    bf16_t* O; int ldc; const float* bias; int split_cols; size_t split_stride; float scale0;
    __device__ __forceinline__ void operator()(const f32x4 (&acc)[2][2][4][2], const Unit& u, int wr, int wc, int fr, int fq) const {
        const int row0 = u.pm * BM + wr * 64 + fr; int colt = u.pn * BM; bf16_t* base = O;
        float sc = 1.f; if (split_cols) { const int t = colt / split_cols; base += (size_t)t * split_stride; colt -= t * split_cols; if (t == 0) sc = scale0; }
        const int col0 = colt + wc * 32 + 8 * fq, bcol0 = u.pn * BM + wc * 32 + 8 * fq;
        f32x4 bv[2][2];
#pragma unroll
        for (int bj = 0; bj < 2; ++bj)
#pragma unroll
            for (int n = 0; n < 2; ++n) bv[bj][n] = bias ? *(const f32x4*)(bias + bcol0 + bj * HALF + 4 * n) : (f32x4){0.f, 0.f, 0.f, 0.f};
#pragma unroll
        for (int ai = 0; ai < 2; ++ai)
#pragma unroll
            for (int m = 0; m < 4; ++m) { bf16_t* rowp = base + (size_t)(row0 + ai * HALF + m * 16) * ldc + col0;
#pragma unroll
                for (int bj = 0; bj < 2; ++bj) { f32x4 v0 = acc[ai][bj][m][0] + bv[bj][0], v1 = acc[ai][bj][m][1] + bv[bj][1];
                    if (ACT == 1) { f32x2 a = gelu_pk((f32x2){v0[0], v0[1]}), b = gelu_pk((f32x2){v0[2], v0[3]}), c = gelu_pk((f32x2){v1[0], v1[1]}), d = gelu_pk((f32x2){v1[2], v1[3]});
                        v0 = (f32x4){a.x, a.y, b.x, b.y}; v1 = (f32x4){c.x, c.y, d.x, d.y}; }
                    v0 = v0 * sc; v1 = v1 * sc; u32x4 w; w.x = cvt_pk_bf16(v0[0], v0[1]); w.y = cvt_pk_bf16(v0[2], v0[3]); w.z = cvt_pk_bf16(v1[0], v1[1]); w.w = cvt_pk_bf16(v1[2], v1[3]);
                    *(u32x4*)(rowp + bj * HALF) = w; } }
    }
};
template <class Epi, class Sched, bool ALIGN_EPI = false, bool SP2 = false>
__device__ __forceinline__ void gemm_phase(PG8_LAS unsigned char* lds, const Gemm g, const Sched& S, const Epi& E) {
    int tid_ = threadIdx.x; asm volatile("" : "+v"(tid_));
    const int tid = tid_, wid = __builtin_amdgcn_readfirstlane(tid >> 6), lane = tid & 63, wr = wid >> 2, wc = wid & 3, fr = lane & 15, fq = lane >> 4;
    const int K = g.K, nt = K / BK;
    unsigned voffA[2], voffB[2];
#pragma unroll
    for (int i = 0; i < 2; ++i) { int R, C; stage_rc(tid * 16 + i * 8192, R, C); const int Rb = Epi::PERM ? ((R & ~31) + perm32(R & 31)) : R;
        voffA[i] = (unsigned)(R * K + C) * 2u; voffB[i] = (unsigned)(Rb * K + C) * 2u; }
    const size_t kstep = (size_t)(BK * 2);
    const size_t hstep = (size_t)HALF * K * 2;
    const size_t tstep = 2 * hstep;
    const unsigned ldsw = (unsigned)wid * 1024u;
    const int aoff = lds_byte(wr * 64 + fr, fq * 8), boff = lds_byte(wc * 32 + fr, fq * 8);
#define PG8_SA(b, h) (((b) * 2 + (h)) * HTB)
#define PG8_SB(b, h) ((4 + (b) * 2 + (h)) * HTB)
#define PG8_STAGE(bufoff, gbase, voff) do { _Pragma("unroll") for (int _i = 0; _i < 2; ++_i) \
        __builtin_amdgcn_global_load_lds((const unsigned*)((const char*)(gbase) + (voff)[_i]), (PG8_LAS unsigned*)(lds + (bufoff) + ldsw + _i * 8192), 16, 0, 0); } while (0)
#define PG8_LDA(dst, b, h) do { _Pragma("unroll") for (int m = 0; m < 4; ++m) _Pragma("unroll") for (int k = 0; k < 2; ++k) dst[m][k] = *(const PG8_LAS bf16x8*)(lds + PG8_SA(b, h) + aoff + m * 2048 + k * 1024); } while (0)
#define PG8_LDB(dst, b, h) do { _Pragma("unroll") for (int n = 0; n < 2; ++n) _Pragma("unroll") for (int k = 0; k < 2; ++k) dst[n][k] = *(const PG8_LAS bf16x8*)(lds + PG8_SB(b, h) + boff + n * 2048 + k * 1024); } while (0)
#define PG8_MMA(ai, bj, At, Bt) do { __builtin_amdgcn_s_setprio(1); _Pragma("unroll") for (int m = 0; m < 4; ++m) _Pragma("unroll") for (int n = 0; n < 2; ++n) _Pragma("unroll") for (int k = 0; k < 2; ++k) \
        acc[ai][bj][m][n] = __builtin_amdgcn_mfma_f32_16x16x32_bf16(Bt[n][k], At[m][k], acc[ai][bj][m][n], 0, 0, 0); __builtin_amdgcn_s_setprio(0); } while (0)
#define PG8_WAIT_V(n) asm volatile("s_waitcnt vmcnt(" #n ")" ::: "memory")
#define PG8_WAIT_L(n) asm volatile("s_waitcnt lgkmcnt(" #n ")" ::: "memory")
#define PG8_BAR __builtin_amdgcn_s_barrier()
#define PG8_SCHED __builtin_amdgcn_sched_barrier(0)
    Unit cur, nxt; int ui = 0;
    if (!S.next(0, cur)) return;
    f32x4 acc[2][2][4][2];
#pragma unroll
    for (int a = 0; a < 2; ++a)
#pragma unroll
        for (int b = 0; b < 2; ++b)
#pragma unroll
            for (int m = 0; m < 4; ++m)
#pragma unroll
                for (int n = 0; n < 2; ++n) acc[a][b][m][n] = (f32x4){0.f, 0.f, 0.f, 0.f};
    bf16x8 At[4][2], B0[2][2], B1[2][2];
    const char* cA = (const char*)g.A + (size_t)cur.pm * tstep; const char* cB = (const char*)g.Bt + (size_t)cur.pn * tstep;
    S.a_ready(cur);
    if constexpr (SP2) {
        PG8_STAGE(PG8_SB(0, 0), cB, voffB); PG8_STAGE(PG8_SB(0, 1), cB + hstep, voffB); PG8_STAGE(PG8_SA(0, 0), cA, voffA); PG8_STAGE(PG8_SA(0, 1), cA + hstep, voffA);
        if (wr == 1) PG8_BAR;
        PG8_WAIT_V(2); PG8_BAR;
        PG8_STAGE(PG8_SB(1, 0), cB + kstep, voffB); PG8_STAGE(PG8_SA(1, 0), cA + kstep, voffA); PG8_STAGE(PG8_SB(1, 1), cB + hstep + kstep, voffB);
        PG8_WAIT_V(6); PG8_BAR;
    } else {
        PG8_STAGE(PG8_SB(0, 0), cB, voffB); PG8_STAGE(PG8_SA(0, 0), cA, voffA); PG8_STAGE(PG8_SB(0, 1), cB + hstep, voffB); PG8_STAGE(PG8_SA(0, 1), cA + hstep, voffA);
        if (wr == 1) PG8_BAR;
        PG8_WAIT_V(4); PG8_BAR;
        PG8_STAGE(PG8_SB(1, 0), cB + kstep, voffB); PG8_STAGE(PG8_SA(1, 0), cA + kstep, voffA); PG8_STAGE(PG8_SB(1, 1), cB + hstep + kstep, voffB);
        PG8_WAIT_V(6); PG8_BAR;
    }
    for (;;) {
        const bool has_next = S.next(ui + 1, nxt);
        const char* nA = has_next ? (const char*)g.A + (size_t)nxt.pm * tstep : cA; const char* nB = has_next ? (const char*)g.Bt + (size_t)nxt.pn * tstep : cB;
        for (int t = 0; t < nt; t += 2) {
            const bool last = (t == nt - 2);
            const char* a1 = cA + (size_t)(t + 1) * kstep;
            const char* a2 = last ? nA : cA + (size_t)(t + 2) * kstep; const char* b2 = last ? nB : cB + (size_t)(t + 2) * kstep;
            const char* a3 = a2 + kstep; const char* b3 = b2 + kstep;
            if (last && has_next) S.a_ready(nxt);
            if constexpr (SP2) {
            PG8_LDB(B0, 0, 0); PG8_LDB(B1, 0, 1); PG8_SCHED; PG8_LDA(At, 0, 0); PG8_STAGE(PG8_SA(1, 1), a1 + hstep, voffA);
            PG8_WAIT_V(8); PG8_WAIT_L(0); PG8_BAR; PG8_MMA(0, 0, At, B0); PG8_MMA(0, 1, At, B1); PG8_BAR; PG8_SCHED;
            PG8_LDA(At, 0, 1); PG8_STAGE(PG8_SB(0, 0), b2, voffB); PG8_STAGE(PG8_SB(0, 1), b2 + hstep, voffB); PG8_STAGE(PG8_SA(0, 0), a2, voffA);
            PG8_WAIT_V(8); PG8_WAIT_L(0); PG8_BAR; PG8_MMA(1, 0, At, B0); PG8_MMA(1, 1, At, B1); PG8_BAR; PG8_SCHED;
            PG8_LDB(B0, 1, 0); PG8_LDB(B1, 1, 1); PG8_SCHED; PG8_LDA(At, 1, 0); PG8_STAGE(PG8_SA(0, 1), a2 + hstep, voffA);
            PG8_WAIT_V(8); PG8_WAIT_L(0); PG8_BAR; PG8_MMA(0, 0, At, B0); PG8_MMA(0, 1, At, B1); PG8_BAR; PG8_SCHED;
            PG8_LDA(At, 1, 1); PG8_STAGE(PG8_SB(1, 0), b3, voffB); PG8_STAGE(PG8_SB(1, 1), b3 + hstep, voffB); PG8_STAGE(PG8_SA(1, 0), a3, voffA);
            PG8_WAIT_V(8); PG8_WAIT_L(0); PG8_BAR; PG8_MMA(1, 0, At, B0); PG8_MMA(1, 1, At, B1); PG8_BAR; PG8_SCHED;
            } else {
            PG8_LDB(B0, 0, 0); PG8_SCHED; PG8_LDA(At, 0, 0); PG8_STAGE(PG8_SA(1, 1), a1 + hstep, voffA);
            PG8_WAIT_L(8); PG8_BAR; PG8_WAIT_L(0); PG8_MMA(0, 0, At, B0); PG8_BAR; PG8_SCHED;
            PG8_LDB(B1, 0, 1); PG8_STAGE(PG8_SB(0, 0), b2, voffB);
            PG8_BAR; PG8_WAIT_L(0); PG8_MMA(0, 1, At, B1); PG8_BAR;
            PG8_LDA(At, 0, 1); PG8_STAGE(PG8_SA(0, 0), a2, voffA);
            PG8_BAR; PG8_WAIT_L(0); PG8_MMA(1, 0, At, B0); PG8_BAR; PG8_SCHED;
            PG8_STAGE(PG8_SB(0, 1), b2 + hstep, voffB);
            PG8_WAIT_V(6); PG8_BAR; PG8_MMA(1, 1, At, B1); PG8_BAR;
            PG8_LDB(B0, 1, 0); PG8_SCHED; PG8_LDA(At, 1, 0); PG8_STAGE(PG8_SA(0, 1), a2 + hstep, voffA);
            PG8_WAIT_L(8); PG8_BAR; PG8_WAIT_L(0); PG8_MMA(0, 0, At, B0); PG8_BAR; PG8_SCHED;
            PG8_LDB(B1, 1, 1); PG8_STAGE(PG8_SB(1, 0), b3, voffB);
            PG8_BAR; PG8_WAIT_L(0); PG8_MMA(0, 1, At, B1); PG8_BAR;
            PG8_LDA(At, 1, 1); PG8_STAGE(PG8_SA(1, 0), a3, voffA);
            PG8_BAR; PG8_WAIT_L(0); PG8_MMA(1, 0, At, B0); PG8_BAR; PG8_SCHED;
            PG8_STAGE(PG8_SB(1, 1), b3 + hstep, voffB);
            PG8_WAIT_V(6); PG8_BAR; PG8_MMA(1, 1, At, B1); PG8_BAR;
            }
        }
        if constexpr (ALIGN_EPI) { if (wr == 0) PG8_BAR; }
        if constexpr (!Epi::AFTER_DRAIN) { E(acc, cur, wr, wc, fr, fq); S.done(cur); }
        if (!has_next) break;
#pragma unroll
        for (int a = 0; a < 2; ++a)
#pragma unroll
            for (int b = 0; b < 2; ++b)
#pragma unroll
                for (int m = 0; m < 4; ++m)
#pragma unroll
                    for (int n = 0; n < 2; ++n) acc[a][b][m][n] = (f32x4){0.f, 0.f, 0.f, 0.f};
        cur = nxt; cA = nA; cB = nB; ++ui;
        if constexpr (ALIGN_EPI) { if (wr == 1) PG8_BAR; }
    }
    PG8_WAIT_V(0);
    if constexpr (!ALIGN_EPI) { if (wr == 0) PG8_BAR; }
    PG8_BAR;
    if constexpr (Epi::AFTER_DRAIN) { E.fused(acc, cur, wr, wc, fr, fq, lds, wid, lane); S.done(cur); }
#undef PG8_SA
#undef PG8_SB
#undef PG8_STAGE
#undef PG8_LDA
#undef PG8_LDB
#undef PG8_MMA
#undef PG8_WAIT_V
#undef PG8_WAIT_L
#undef PG8_BAR
#undef PG8_SCHED
}
}

constexpr int BATCH = 16, SEQ = 2048, DM = 2048, NMETA = 16;
constexpr int TREAL = BATCH * SEQ;
constexpr int MROWS = 33024;
constexpr int META_TILE0 = 32768;
constexpr int META_ROW0 = 32816;
constexpr int NZ = 6144;
constexpr int ZQ = 0, ZK = 1024, ZV = 2048, ZMQ = 3072, ZMK = 3584, ZMV = 4096, ZMO = 5120;
constexpr int INCOLS = 6152;
constexpr float EPS = 1e-6f;
constexpr float QSCALE = 0.125f * 1.4426950408889634f;
constexpr float LAMBDA_INIT = 0.2f;

typedef unsigned short bf16_t;
typedef float f32x4 __attribute__((ext_vector_type(4)));
typedef __bf16 bf16x2_t __attribute__((ext_vector_type(2)));

constexpr size_t MiB = 1u << 20;
constexpr size_t WS_CTL = 0;
constexpr size_t WS_ISC = 655360;
constexpr size_t WS_SKB = 65536;
constexpr size_t WS_WIN = 1 * MiB;
constexpr size_t WS_WOUT = 25 * MiB;
constexpr size_t WS_WQ = 33 * MiB;
constexpr size_t WS_ROPE = 41 * MiB;
constexpr size_t WS_GATES = 42 * MiB;
constexpr size_t WS_SSQ = 44 * MiB;
constexpr size_t WS_IDX = 48 * MiB;
constexpr size_t WS_GATE = 64 * MiB;
constexpr size_t WS_U = 80 * MiB;
constexpr size_t WS_V = 144 * MiB;
constexpr size_t WS_HN = 208 * MiB;
constexpr size_t WS_MIX = 338 * MiB;
constexpr size_t WS_Z = 466 * MiB;
constexpr size_t WS_END = 854 * MiB;

__device__ __forceinline__ float bf_lo(unsigned w) { return __uint_as_float(w << 16); }
__device__ __forceinline__ float bf_hi(unsigned w) { return __uint_as_float(w & 0xffff0000u); }
__device__ __forceinline__ float bf2f(bf16_t v) { return __uint_as_float(((unsigned)v) << 16); }
__device__ __forceinline__ unsigned f2bf(float f) { unsigned r; asm("v_cvt_pk_bf16_f32 %0, %1, 0" : "=v"(r) : "v"(f)); return r; }
__device__ __forceinline__ unsigned pk2(float lo, float hi) { unsigned r; asm("v_cvt_pk_bf16_f32 %0, %1, %2" : "=v"(r) : "v"(lo), "v"(hi)); return r; }
__device__ __forceinline__ float dot2(unsigned a, unsigned b, float acc) { return __builtin_amdgcn_fdot2_f32_bf16(__builtin_bit_cast(bf16x2_t, a), __builtin_bit_cast(bf16x2_t, b), acc, false); }
__device__ __forceinline__ float wave_sum(float v) {
#pragma unroll
    for (int o = 1; o < 64; o <<= 1) v += __shfl_xor(v, o);
    return v;
}
__device__ __forceinline__ float wave_max(float v) {
#pragma unroll
    for (int o = 1; o < 64; o <<= 1) v = fmaxf(v, __shfl_xor(v, o));
    return v;
}
__device__ __forceinline__ int zrow_of(int b, int l) { return l < NMETA ? META_ROW0 + l : b * SEQ + (l - NMETA); }

struct EpiZ {
    static constexpr bool PERM = true, AFTER_DRAIN = false;
    bf16_t* Z; const float* rope;
    __device__ __forceinline__ void operator()(const pg8::f32x4 (&acc)[2][2][4][2], const pg8::Unit& u, int wr, int wc, int fr, int fq) const {
        const int row0 = u.pm * 256 + wr * 64 + fr, col0 = u.pn * 256 + wc * 32 + 8 * fq;
        const bool isq = u.pn < 4, isrope = u.pn < 8;
        const int j0 = 16 * (wc & 1) + 4 * fq;
#pragma unroll
        for (int ai = 0; ai < 2; ++ai)
#pragma unroll
            for (int m = 0; m < 4; ++m) {
                const int row = row0 + ai * 128 + m * 16;
                pg8::f32x4 c0 = {1.f, 0.f, 1.f, 0.f}, c1 = {1.f, 0.f, 1.f, 0.f};
                if (isrope) {
                    const int pos = row < TREAL ? (row & (SEQ - 1)) + NMETA : ((row >= META_ROW0 && row < META_ROW0 + NMETA) ? row - META_ROW0 : 0);
                    const pg8::f32x4* tp = (const pg8::f32x4*)(rope + ((size_t)pos * 32 + j0) * 2);
                    c0 = tp[0]; c1 = tp[1];
                }
                bf16_t* rowp = Z + (size_t)row * NZ + col0;
#pragma unroll
                for (int bj = 0; bj < 2; ++bj) {
                    pg8::f32x4 v0 = acc[ai][bj][m][0], v1 = acc[ai][bj][m][1];
                    if (isrope) {
                        pg8::f32x4 o0, o1;
                        o0[0] = v0[0] * c0[0] - v0[1] * c0[1]; o0[1] = v0[1] * c0[0] + v0[0] * c0[1];
                        o0[2] = v0[2] * c0[2] - v0[3] * c0[3]; o0[3] = v0[3] * c0[2] + v0[2] * c0[3];
                        o1[0] = v1[0] * c1[0] - v1[1] * c1[1]; o1[1] = v1[1] * c1[0] + v1[0] * c1[1];
                        o1[2] = v1[2] * c1[2] - v1[3] * c1[3]; o1[3] = v1[3] * c1[2] + v1[2] * c1[3];
                        v0 = o0; v1 = o1;
                        if (isq) { v0 = v0 * QSCALE; v1 = v1 * QSCALE; }
                    }
                    pg8::u32x4 w; w.x = pg8::cvt_pk_bf16(v0[0], v0[1]); w.y = pg8::cvt_pk_bf16(v0[2], v0[3]); w.z = pg8::cvt_pk_bf16(v1[0], v1[1]); w.w = pg8::cvt_pk_bf16(v1[2], v1[3]);
                    *(pg8::u32x4*)(rowp + bj * 128) = w;
                }
            }
    }
};
struct EpiX1 {
    static constexpr bool PERM = true, AFTER_DRAIN = false;
    const float* x; bf16_t* x1b; float* ssq;
    __device__ __forceinline__ void loadr(pg8::f32x4 (&xb)[2][2], int row0, int col0, int i) const {
#pragma unroll
        for (int bj = 0; bj < 2; ++bj) {
            const size_t off = (size_t)(row0 + (i >> 2) * 128 + (i & 3) * 16) * DM + col0 + bj * 128;
            xb[bj][0] = *(const pg8::f32x4*)(x + off); xb[bj][1] = *(const pg8::f32x4*)(x + off + 4);
        }
    }
    __device__ __forceinline__ void procr(const pg8::f32x4 (&acc)[2][2][4][2], const pg8::f32x4 (&xb)[2][2], int row0, int col0, int i, int pn, int wc, int fq) const {
        const int ai = i >> 2, m = i & 3;
        const int row = row0 + ai * 128 + m * 16; float ss = 0.f;
#pragma unroll
        for (int bj = 0; bj < 2; ++bj) {
            const size_t off = (size_t)row * DM + col0 + bj * 128;
            const pg8::f32x4 v0 = acc[ai][bj][m][0] + xb[bj][0], v1 = acc[ai][bj][m][1] + xb[bj][1];
            ss += (v0[0] * v0[0] + v0[1] * v0[1]) + (v0[2] * v0[2] + v0[3] * v0[3]) + (v1[0] * v1[0] + v1[1] * v1[1]) + (v1[2] * v1[2] + v1[3] * v1[3]);
            pg8::u32x4 w; w.x = pg8::cvt_pk_bf16(v0[0], v0[1]); w.y = pg8::cvt_pk_bf16(v0[2], v0[3]); w.z = pg8::cvt_pk_bf16(v1[0], v1[1]); w.w = pg8::cvt_pk_bf16(v1[2], v1[3]);
            *(pg8::u32x4*)(x1b + off) = w;
        }
        ss += __shfl_xor(ss, 16); ss += __shfl_xor(ss, 32);
        if (fq == 0) ssq[(size_t)row * 32 + pn * 4 + wc] = ss;
    }
    __device__ __forceinline__ void operator()(const pg8::f32x4 (&acc)[2][2][4][2], const pg8::Unit& u, int wr, int wc, int fr, int fq) const {
        const int row0 = u.pm * 256 + wr * 64 + fr, col0 = u.pn * 256 + wc * 32 + 8 * fq;
        pg8::f32x4 b0[2][2], b1[2][2], b2[2][2];
        loadr(b0, row0, col0, 0); loadr(b1, row0, col0, 1); loadr(b2, row0, col0, 2);
        procr(acc, b0, row0, col0, 0, u.pn, wc, fq); loadr(b0, row0, col0, 3);
        procr(acc, b1, row0, col0, 1, u.pn, wc, fq); loadr(b1, row0, col0, 4);
        procr(acc, b2, row0, col0, 2, u.pn, wc, fq); loadr(b2, row0, col0, 5);
        procr(acc, b0, row0, col0, 3, u.pn, wc, fq); loadr(b0, row0, col0, 6);
        procr(acc, b1, row0, col0, 4, u.pn, wc, fq); loadr(b1, row0, col0, 7);
        procr(acc, b2, row0, col0, 5, u.pn, wc, fq);
        procr(acc, b0, row0, col0, 6, u.pn, wc, fq);
        procr(acc, b1, row0, col0, 7, u.pn, wc, fq);
    }
};


#include <hip/hip_cooperative_groups.h>
namespace cg = cooperative_groups;

constexpr int NWAVES = 8, NTHREADS = 512;
constexpr size_t WS_X1Q = WS_Z + 300 * MiB, WS_XSC = WS_Z + 370 * MiB;
__device__ __forceinline__ int opaque_tid() { int t = threadIdx.x; asm volatile("" : "+v"(t)); return t; }
constexpr int LDS_BYTES = 163840;

struct Args {
    const float *x, *meta, *nmw, *w_in, *lamqk, *subln, *convw, *convb, *ib, *fb, *mnw, *w_out, *nfw_ffn, *w_q, *subkeys, *pu, *pv, *nfinal;
    float* out; unsigned char* ws;
};

#define LAS __attribute__((address_space(3)))
#define XB_TMO      128
#define XB_XCNT(j)  (256  + 64 * (j))
#define XB_XSUB(j)  (1280 + 64 * (j))
#define XB_XGEN(j)  (2304 + 64 * (j))
#define XB_TOP      3328
#define XB_TOPGEN   3392
#define XCD_BAR_WORDS 3456
#define XB_SPIN_CAP (1u << 18)

__device__ __forceinline__ unsigned xb_ld(unsigned* p)              { return __hip_atomic_load(p, __ATOMIC_RELAXED, __HIP_MEMORY_SCOPE_AGENT); }
__device__ __forceinline__ unsigned xb_add(unsigned* p, unsigned v) { return __hip_atomic_fetch_add(p, v, __ATOMIC_RELAXED, __HIP_MEMORY_SCOPE_AGENT); }
__device__ __forceinline__ unsigned xb_xcc_id() { return (unsigned)__builtin_amdgcn_s_getreg((3 << 11) | 20) & 0xFu; }
#define XB_SPIN(cond, bar) do { unsigned _sp = 0; while (cond) { __builtin_amdgcn_s_sleep(1); \
    if ((++_sp & 255u) == 0u) { if (xb_ld(&(bar)[XB_TMO])) break; if (_sp > XB_SPIN_CAP) { atomicAdd(&(bar)[XB_TMO], 1u); break; } } } } while (0)

struct XcdBarrier {
    unsigned* bar; unsigned x;
    volatile LAS unsigned* st;
};

__device__ __forceinline__ XcdBarrier xcd_barrier_post(unsigned* bar, volatile LAS unsigned* st) {
    XcdBarrier b; b.bar = bar; b.x = xb_xcc_id(); b.st = st;
    if (threadIdx.x == 0) (void)xb_add(&bar[XB_XCNT(b.x)], 1u);
    return b;
}
__device__ __forceinline__ void xcd_barrier_complete(unsigned* bar, unsigned x, unsigned& nloc, unsigned& nx) {
    const unsigned G = gridDim.x * gridDim.y * gridDim.z;
    unsigned sum, cnt, mine, sp = 0u;
    for (;;) {
        sum = 0u; cnt = 0u; mine = 0u;
#pragma unroll
        for (unsigned j = 0; j < 16; ++j) { const unsigned c = xb_ld(&bar[XB_XCNT(j)]); sum += c; cnt += (c > 0u) ? 1u : 0u; mine = (j == x) ? c : mine; }
        if (sum == G) break;
        __builtin_amdgcn_s_sleep(1);
        if ((++sp & 255u) == 0u) { if (xb_ld(&bar[XB_TMO])) break; if (sp > XB_SPIN_CAP) { atomicAdd(&bar[XB_TMO], 1u); break; } }
    }
    nloc = mine > 0u ? mine : 1u; nx = cnt > 0u ? cnt : 1u;
}

__device__ __forceinline__ void xcd_barrier(const XcdBarrier& b) {
    asm volatile("s_waitcnt vmcnt(0)" ::: "memory");
    __syncthreads();
    if (threadIdx.x == 0) {
        unsigned* bar = b.bar;
        __builtin_amdgcn_s_waitcnt(0);
        unsigned nloc = b.st[0], nx = b.st[1];
        if (nloc == 0u) { xcd_barrier_complete(bar, b.x, nloc, nx); b.st[0] = nloc; b.st[1] = nx; }
        const unsigned old = xb_add(&bar[XB_XSUB(b.x)], 1u);
        const unsigned gen = old / nloc;
        if (old + 1u == (gen + 1u) * nloc) {
            __builtin_amdgcn_fence(__ATOMIC_RELEASE, "agent");
            asm volatile("s_waitcnt vmcnt(0)" ::: "memory");
            const unsigned og = xb_add(&bar[XB_TOP], 1u);
            const unsigned tg = og / nx;
            if (og + 1u == (tg + 1u) * nx) xb_add(&bar[XB_TOPGEN], 1u);
            else XB_SPIN(xb_ld(&bar[XB_TOPGEN]) == tg, bar);
            __builtin_amdgcn_fence(__ATOMIC_ACQUIRE, "agent");
            xb_add(&bar[XB_XGEN(b.x)], 1u);
            asm volatile("s_waitcnt vmcnt(0)" ::: "memory");
        } else {
            XB_SPIN(xb_ld(&bar[XB_XGEN(b.x)]) == gen, bar);
            __builtin_amdgcn_fence(__ATOMIC_ACQUIRE, "agent");
            asm volatile("s_waitcnt vmcnt(0)" ::: "memory");
        }
    }
    __syncthreads();
}

constexpr int CW_BAR = 0, CW_QUEUE = 4096;
constexpr int LDS_MISC = LDS_BYTES - 256;
__device__ __forceinline__ int next_item(unsigned* ctr, volatile LAS unsigned* slot) {
    __syncthreads();
    if (threadIdx.x == 0) *slot = __hip_atomic_fetch_add(ctr, 1u, __ATOMIC_RELAXED, __HIP_MEMORY_SCOPE_AGENT);
    __syncthreads();
    return (int)*slot;
}

__device__ __forceinline__ void transpose_item(const float* W, int ldw, int K, int N, bf16_t* WT, bool ropeperm, float* scr, int item, int lane, const float* kscale = nullptr) {
    const int nblk = N / 32, kb = item / nblk, nb = item % nblk, k0 = 64 * kb, n0 = 32 * nb;
#pragma unroll 8
    for (int i = 0; i < 32; ++i) { const int kk = 2 * i + (lane >> 5); scr[kk * 33 + (lane & 31)] = W[(size_t)(k0 + kk) * ldw + n0 + (lane & 31)] * (kscale ? kscale[k0 + kk] : 1.f); }
    __builtin_amdgcn_s_waitcnt(0xC07F); asm volatile("" ::: "memory");
    const int c = lane & 7;
#pragma unroll
    for (int j = 0; j < 4; ++j) {
        const int n = (lane >> 3) + 8 * j; const float* s = scr + (8 * c) * 33 + n;
        uint4 o; o.x = pk2(s[0 * 33], s[1 * 33]); o.y = pk2(s[2 * 33], s[3 * 33]); o.z = pk2(s[4 * 33], s[5 * 33]); o.w = pk2(s[6 * 33], s[7 * 33]);
        int orow = n0 + n;
        if (ropeperm && n0 < 2048) orow = (n0 & ~63) + 2 * n + ((n0 >> 5) & 1);
        *(uint4*)(WT + (size_t)orow * K + k0 + 8 * c) = o;
    }
    __builtin_amdgcn_s_waitcnt(0xC07F); asm volatile("" ::: "memory");
}

__device__ __forceinline__ void hn_row(const Args& a, bf16_t* HN, float* G, const float* WG, int r, const f32x4 (&v)[8], int lane) {
    float ss = 0.f;
#pragma unroll
    for (int j = 0; j < 8; ++j) ss += (v[j][0] * v[j][0] + v[j][1] * v[j][1]) + (v[j][2] * v[j][2] + v[j][3] * v[j][3]);
    const float rstd = rsqrtf(wave_sum(ss) * (1.f / DM) + EPS);
    float g[8];
#pragma unroll
    for (int k = 0; k < 8; ++k) g[k] = 0.f;
    unsigned long long* o8 = (unsigned long long*)(HN + (size_t)r * DM) + lane;
#pragma unroll
    for (int j = 0; j < 8; ++j) {
        const f32x4 w = ((const f32x4*)a.nmw)[64 * j + lane];
        const f32x4 y = v[j] * rstd * w;
        o8[64 * j] = (unsigned long long)pk2(y[0], y[1]) | ((unsigned long long)pk2(y[2], y[3]) << 32);
#pragma unroll
        for (int k = 0; k < 8; ++k) { const f32x4 wg = ((const f32x4*)(WG + k * 2048))[64 * j + lane]; g[k] += (y[0] * wg[0] + y[1] * wg[1]) + (y[2] * wg[2] + y[3] * wg[3]); }
        __builtin_amdgcn_sched_barrier(0);
    }
    float r4[4], r2[2], r1;
    { const bool hb = (lane & 32) != 0;
#pragma unroll
      for (int i = 0; i < 4; ++i) { const float send = hb ? g[i] : g[i + 4]; const float recv = __shfl_xor(send, 32); r4[i] = (hb ? g[i + 4] : g[i]) + recv; } }
    { const bool hb = (lane & 16) != 0;
#pragma unroll
      for (int i = 0; i < 2; ++i) { const float send = hb ? r4[i] : r4[i + 2]; const float recv = __shfl_xor(send, 16); r2[i] = (hb ? r4[i + 2] : r4[i]) + recv; } }
    { const bool hb = (lane & 8) != 0; const float send = hb ? r2[0] : r2[1]; const float recv = __shfl_xor(send, 8); r1 = (hb ? r2[1] : r2[0]) + recv; }
    r1 += __shfl_xor(r1, 4); r1 += __shfl_xor(r1, 2); r1 += __shfl_xor(r1, 1);
    if ((lane & 7) == 0) G[(size_t)r * 8 + ((lane >> 5) & 1) * 4 + ((lane >> 4) & 1) * 2 + ((lane >> 3) & 1)] = r1;
}

__device__ __forceinline__ void phase_prep(const Args& a, unsigned char* lds, int bid, int nb) {
    const int tid = opaque_tid(), lane = tid & 63, wave = tid >> 6;
    const int gw = bid * NWAVES + wave, NGW = nb * NWAVES;
    unsigned char* ws = a.ws;
    bf16_t* WinT = (bf16_t*)(ws + WS_WIN); bf16_t* WoutT = (bf16_t*)(ws + WS_WOUT); bf16_t* WqT = (bf16_t*)(ws + WS_WQ);
    bf16_t* U = (bf16_t*)(ws + WS_U); bf16_t* V = (bf16_t*)(ws + WS_V); bf16_t* HN = (bf16_t*)(ws + WS_HN);
    float* G = (float*)(ws + WS_GATES); float* rope = (float*)(ws + WS_ROPE);
    float* scr = (float*)lds + wave * (64 * 33);
    float* WG = (float*)(lds + 8 * 64 * 33 * 4);
    for (int i = tid; i < 8 * 2048; i += NTHREADS) { const int k = i >> 3, g = i & 7; WG[g * 2048 + k] = a.w_in[(size_t)k * INCOLS + 6144 + g]; }
    __syncthreads();
    constexpr int I_IN = 32 * 192, I_OUT = 32 * 64, I_Q = 32 * 64;
    for (int it = gw; it < I_IN + I_OUT + I_Q; it += NGW) {
        int r = it;
        if (r < I_IN) { transpose_item(a.w_in, INCOLS, 2048, 6144, WinT, true, scr, r, lane); continue; } r -= I_IN;
        if (r < I_OUT) { transpose_item(a.w_out, 2048, 2048, 2048, WoutT, false, scr, r, lane); continue; } r -= I_OUT;
        transpose_item(a.w_q, 2048, 2048, 2048, WqT, false, scr, r, lane, a.nfw_ffn);
    }
    {
        f32x4 vc[8], vn[8];
#pragma unroll
        for (int j = 0; j < 8; ++j) vc[j] = ((const f32x4*)(a.x + (size_t)gw * DM))[64 * j + lane];
        for (int r = gw; r < TREAL; r += NGW) {
            const int rn = r + NGW < TREAL ? r + NGW : r;
#pragma unroll
            for (int j = 0; j < 8; ++j) vn[j] = ((const f32x4*)(a.x + (size_t)rn * DM))[64 * j + lane];
            hn_row(a, HN, G, WG, r, vc, lane);
#pragma unroll
            for (int j = 0; j < 8; ++j) vc[j] = vn[j];
        }
    }
    for (int r = TREAL + gw; r < MROWS; r += NGW) {
        if (r >= META_ROW0 && r < META_ROW0 + NMETA) {
            f32x4 vm[8];
#pragma unroll
            for (int j = 0; j < 8; ++j) vm[j] = ((const f32x4*)(a.meta + (size_t)(r - META_ROW0) * DM))[64 * j + lane];
            hn_row(a, HN, G, WG, r, vm, lane);
        } else {
            unsigned long long* o8 = (unsigned long long*)(HN + (size_t)r * DM) + lane;
#pragma unroll
            for (int j = 0; j < 8; ++j) o8[64 * j] = 0ull;
            if (lane < 8) G[(size_t)r * 8 + lane] = 0.f;
        }
    }
    { bf16_t* SKB = (bf16_t*)(ws + WS_SKB);
      for (int i = bid * NTHREADS + tid; i < 8 * 2 * 128 * 128 / 2; i += nb * NTHREADS) { const float2 v = ((const float2*)a.subkeys)[i]; ((unsigned*)SKB)[i] = pk2(v.x, v.y); } }
    for (int i = bid * NTHREADS + tid; i < (SEQ + NMETA) * 32; i += nb * NTHREADS) {
        const int pos = i >> 5, j = i & 31;
        const float inv = (float)pow(10000.0, -(double)j / 32.0);
        const float ang = (float)pos * inv;
        rope[2 * i] = (float)cos((double)ang); rope[2 * i + 1] = (float)sin((double)ang);
    }
}


constexpr int CW_QTAB = 4096 + 1024, TAB_ITEMS = 2 * 16384 / 16;
__device__ __forceinline__ void phase_tables(const Args& a, unsigned char* lds, unsigned* ctl) {
    const int tid = opaque_tid(), lane = tid & 63, wave = __builtin_amdgcn_readfirstlane(tid >> 6);
    unsigned char* ws = a.ws;
    volatile LAS unsigned* slot = (volatile LAS unsigned*)((LAS unsigned char*)lds + LDS_MISC) + 2;
    for (;;) {
        const int item = next_item(ctl + CW_QTAB, slot);
        if (item >= TAB_ITEMS) break;
        const int rr = item * 16 + wave;
    {
        unsigned* U8 = (unsigned*)(ws + WS_U); unsigned* V8 = (unsigned*)(ws + WS_V); float* ISC = (float*)(ws + WS_ISC);
        {
            f32x4 v[2][8]; float am[2];
#pragma unroll
            for (int q = 0; q < 2; ++q) {
                const int r = rr + q * 8; const bool isu = r < 16384; const int e = r & 16383;
                const f32x4* xr = (const f32x4*)((isu ? a.pu : a.pv) + (size_t)e * DM) + lane;
#pragma unroll
                for (int j = 0; j < 8; ++j) v[q][j] = xr[64 * j];
            }
#pragma unroll
            for (int q = 0; q < 2; ++q) if (rr + q * 8 < 16384) {
#pragma unroll
                for (int j = 0; j < 8; ++j) v[q][j] = v[q][j] * ((const f32x4*)a.nfw_ffn)[64 * j + lane]; }
#pragma unroll
            for (int q = 0; q < 2; ++q) { float t = 0.f;
#pragma unroll
                for (int j = 0; j < 8; ++j) t = fmaxf(t, fmaxf(fmaxf(fabsf(v[q][j][0]), fabsf(v[q][j][1])), fmaxf(fabsf(v[q][j][2]), fabsf(v[q][j][3]))));
                am[q] = t; }
#pragma unroll
            for (int o = 1; o < 64; o <<= 1) { am[0] = fmaxf(am[0], __shfl_xor(am[0], o)); am[1] = fmaxf(am[1], __shfl_xor(am[1], o)); }
#pragma unroll
            for (int q = 0; q < 2; ++q) {
                const int r = rr + q * 8; const bool isu = r < 16384; const int e = r & 16383;
                const float top = isu ? 127.f : 256.f;
                const float sc = am[q] > 0.f ? top / am[q] : 0.f;
                unsigned* o8 = isu ? U8 : V8;
#pragma unroll
                for (int j = 0; j < 8; ++j) { int w;
                    if (isu) { const int q0 = (int)rintf(v[q][j][0] * sc), q1 = (int)rintf(v[q][j][1] * sc), q2 = (int)rintf(v[q][j][2] * sc), q3 = (int)rintf(v[q][j][3] * sc);
                        w = (int)((unsigned)(q0 & 255) | ((unsigned)(q1 & 255) << 8) | ((unsigned)(q2 & 255) << 16) | ((unsigned)q3 << 24)); }
                    else { w = __builtin_amdgcn_cvt_pk_fp8_f32(v[q][j][0] * sc, v[q][j][1] * sc, 0, false); w = __builtin_amdgcn_cvt_pk_fp8_f32(v[q][j][2] * sc, v[q][j][3] * sc, w, true); }
                    o8[((size_t)j * 16384 + e) * 64 + lane] = (unsigned)w; }
                if (lane == 0) ISC[(isu ? 0 : 16384) + e] = am[q] / top;
            }
        }
    }
    }
}

namespace att {
using bf16x8 = __attribute__((ext_vector_type(8))) short;
using s16x4 = __attribute__((ext_vector_type(4))) short;
using f32x16 = __attribute__((ext_vector_type(16))) float;
using u32x4 = __attribute__((ext_vector_type(4))) unsigned;
constexpr int SHM_V = 16384, SHM_K = 16384;
constexpr int L_V = 0, L_K = 2 * SHM_V, L_WS = L_K + 2 * SHM_K, L_P = L_WS + 8 * 64 * 4, L_END = L_P + 4 * 4096;
#define KSWZ(row, colB) ((row) * 256 + ((colB) ^ (((row) & 7) << 4)))
#define SBAR() __builtin_amdgcn_sched_barrier(0)
__device__ __forceinline__ int crow(int r, int hi) { return (r & 3) + 8 * (r >> 2) + 4 * hi; }
__device__ __forceinline__ unsigned cvtpk(float lo, float hi) { unsigned r; asm volatile("v_cvt_pk_bf16_f32 %0, %1, %2" : "=v"(r) : "v"(lo), "v"(hi)); return r; }
__device__ __forceinline__ int v_st(int k, int c) { const int kk = (k & ~0xC) | ((k & 4) << 1) | ((k & 8) >> 1); return ((kk >> 3) * 4 + (c >> 5)) * 512 + ((kk & 7) * 32 + (c & 31)) * 2; }
__device__ __forceinline__ int v_rd_base(int lane) { return ((lane & 3) << 3) | (((lane >> 2) & 3) << 6) | (((lane >> 4) & 1) << 5) | (((lane >> 5) & 1) << 8); }
constexpr int v_rd_off(int d0, int ks, int half) { return d0 * 512 + ks * 4096 + half * 2048; }
template <int OFF> __device__ __forceinline__ s16x4 tr_read(int vb) { s16x4 r; asm volatile("ds_read_b64_tr_b16 %0, %1 offset:%2" : "=&v"(r) : "v"(vb), "i"(OFF) : "memory"); return r; }
template <int D0> __device__ __forceinline__ void pv_one(f32x16& od, int vb, bf16x8 pa0, bf16x8 pa1, bf16x8 pa2, bf16x8 pa3) {
    const s16x4 l0 = tr_read<v_rd_off(D0, 0, 0)>(vb), h0 = tr_read<v_rd_off(D0, 0, 1)>(vb), l1 = tr_read<v_rd_off(D0, 1, 0)>(vb), h1 = tr_read<v_rd_off(D0, 1, 1)>(vb);
    const s16x4 l2 = tr_read<v_rd_off(D0, 2, 0)>(vb), h2 = tr_read<v_rd_off(D0, 2, 1)>(vb), l3 = tr_read<v_rd_off(D0, 3, 0)>(vb), h3 = tr_read<v_rd_off(D0, 3, 1)>(vb);
    asm volatile("s_waitcnt lgkmcnt(0)" ::: "memory"); SBAR();
#define PK(L, H) (bf16x8){L[0], L[1], L[2], L[3], H[0], H[1], H[2], H[3]}
    od = __builtin_amdgcn_mfma_f32_32x32x16_bf16(pa0, PK(l0, h0), od, 0, 0, 0);
    od = __builtin_amdgcn_mfma_f32_32x32x16_bf16(pa1, PK(l1, h1), od, 0, 0, 0);
    od = __builtin_amdgcn_mfma_f32_32x32x16_bf16(pa2, PK(l2, h2), od, 0, 0, 0);
    od = __builtin_amdgcn_mfma_f32_32x32x16_bf16(pa3, PK(l3, h3), od, 0, 0, 0);
#undef PK
}
__device__ __forceinline__ void qkt(f32x16& p0, f32x16& p1, const char* Ks, const bf16x8* qr, int r32, int hi, int comp) {
    p0 = f32x16{}; p1 = f32x16{};
#pragma unroll
    for (int d0 = 0; d0 < 4; ++d0) {
        const int cb = (comp * 64 + d0 * 16 + hi * 8) * 2;
        const bf16x8 b0 = *reinterpret_cast<const bf16x8*>(Ks + KSWZ(r32, cb));
        const bf16x8 b1 = *reinterpret_cast<const bf16x8*>(Ks + KSWZ(32 + r32, cb));
        p0 = __builtin_amdgcn_mfma_f32_32x32x16_bf16(b0, qr[d0], p0, 0, 0, 0);
        p1 = __builtin_amdgcn_mfma_f32_32x32x16_bf16(b1, qr[d0], p1, 0, 0, 0);
    }
}

__device__ __forceinline__ void attn_unit(int b, int h, int qb, const bf16_t* Z, bf16_t* MIX, float lam, const float* subln, char* lds) {
    const int tid = opaque_tid(), wid = __builtin_amdgcn_readfirstlane(tid >> 6), lane = tid & 63, r32 = lane & 31, hi = lane >> 5;
    const int comp = wid >> 2, rg = wid & 3;
    char* V_lds = lds + L_V; char* K_lds = lds + L_K;
    float* wsf = (float*)(lds + L_WS) + wid * 64;
    const int q0 = b * SEQ + qb * 128;
    const float NEGV = -1e30f;
    bf16x8 qr[4];
    {
        const bf16_t* Qw = Z + (size_t)(q0 + rg * 32 + r32) * NZ + ZQ + h * 128 + comp * 64 + hi * 8;
#pragma unroll
        for (int d0 = 0; d0 < 4; ++d0) qr[d0] = *reinterpret_cast<const bf16x8*>(Qw + d0 * 16);
    }
    const int NT = 2 * qb + 3;
    const int sr = tid >> 4, sc = (tid & 15) * 8;
    const int vst0 = v_st(sr, sc), vst1 = v_st(32 + sr, sc), kst0 = KSWZ(sr, sc * 2), kst1 = KSWZ(32 + sr, sc * 2);
    const int vb0 = (int)(uintptr_t)V_lds + v_rd_base(lane);
#define PK4(P, BASE, OUT) do { unsigned a0 = cvtpk(P[BASE + 0], P[BASE + 1]), a1 = cvtpk(P[BASE + 2], P[BASE + 3]); \
        unsigned b0 = cvtpk(P[BASE + 4], P[BASE + 5]), b1 = cvtpk(P[BASE + 6], P[BASE + 7]); \
        auto r0 = __builtin_amdgcn_permlane32_swap(a0, b0, false, false); auto r1 = __builtin_amdgcn_permlane32_swap(a1, b1, false, false); \
        u32x4 w = {r0[0], r1[0], r0[1], r1[1]}; OUT = *reinterpret_cast<bf16x8*>(&w); } while (0)
    bf16x8 vsA0, vsA1, ksA0, ksA1, vsB0, vsB1, ksB0, ksB1;
#define SLOAD(j, S) do { const size_t r0_ = (size_t)((j) == 0 ? META_TILE0 : b * SEQ + ((j) - 1) * 64) + sr; const bf16_t* zp_ = Z + r0_ * NZ + h * 128 + sc; \
        vs##S##0 = *reinterpret_cast<const bf16x8*>(zp_ + ZV); vs##S##1 = *reinterpret_cast<const bf16x8*>(zp_ + ZV + (size_t)32 * NZ); \
        ks##S##0 = *reinterpret_cast<const bf16x8*>(zp_ + ZK); ks##S##1 = *reinterpret_cast<const bf16x8*>(zp_ + ZK + (size_t)32 * NZ); } while (0)
#define SWRITE(bi, S) do { *reinterpret_cast<bf16x8*>(V_lds + (bi) * SHM_V + vst0) = vs##S##0; *reinterpret_cast<bf16x8*>(V_lds + (bi) * SHM_V + vst1) = vs##S##1; \
        *reinterpret_cast<bf16x8*>(K_lds + (bi) * SHM_K + kst0) = ks##S##0; *reinterpret_cast<bf16x8*>(K_lds + (bi) * SHM_K + kst1) = ks##S##1; } while (0)
    f32x16 o[4] = {}; float m_reg = NEGV, l_reg = 0.f;
    SLOAD(0, A); SWRITE(0, A); SLOAD(1, B); __syncthreads();
    const int qrel = rg * 32 + r32;
#define ATT_TILE(j, L_, W_) do { \
        const int cur = j & 1; \
        if (j + 2 < NT) SLOAD(j + 2, L_); \
        f32x16 p0, p1; \
        qkt(p0, p1, K_lds + cur * SHM_K, qr, r32, hi, comp); \
        if (j == 0) { \
    _Pragma("unroll") \
            for (int r = 0; r < 16; ++r) { p0[r] = NEGV; if (r < 8) p1[r] = NEGV; } \
        } else if (j >= NT - 2) { \
            const int kb0 = (j - (NT - 2)) * 64; \
    _Pragma("unroll") \
            for (int r = 0; r < 16; ++r) { const int kl = kb0 + crow(r, hi); if (kl > qrel) p0[r] = NEGV; if (kl + 32 > qrel) p1[r] = NEGV; } \
        } \
        float pmax = p0[0]; \
    _Pragma("unroll") \
        for (int r = 1; r < 16; ++r) pmax = fmaxf(pmax, p0[r]); \
    _Pragma("unroll") \
        for (int r = 0; r < 16; ++r) pmax = fmaxf(pmax, p1[r]); \
        { auto rr = __builtin_amdgcn_permlane32_swap(__float_as_uint(pmax), __float_as_uint(pmax), false, false); pmax = fmaxf(__uint_as_float(rr[0]), __uint_as_float(rr[1])); } \
        const float mn = fmaxf(m_reg, pmax); const float alpha = __builtin_amdgcn_exp2f(m_reg - mn); m_reg = mn; \
        float ps = 0.f; \
    _Pragma("unroll") \
        for (int r = 0; r < 16; ++r) { p0[r] = __builtin_amdgcn_exp2f(p0[r] - mn); ps += p0[r]; } \
    _Pragma("unroll") \
        for (int r = 0; r < 16; ++r) { p1[r] = __builtin_amdgcn_exp2f(p1[r] - mn); ps += p1[r]; } \
        { auto rr = __builtin_amdgcn_permlane32_swap(__float_as_uint(ps), __float_as_uint(ps), false, false); ps = __uint_as_float(rr[0]) + __uint_as_float(rr[1]); } \
        l_reg = l_reg * alpha + ps; \
        if (__any(alpha < 1.f)) { \
            if (hi == 0) wsf[r32] = alpha; \
            asm volatile("s_waitcnt lgkmcnt(0)" ::: "memory"); \
            float al[16]; \
    _Pragma("unroll") \
            for (int r = 0; r < 16; ++r) al[r] = wsf[crow(r, hi)]; \
    _Pragma("unroll") \
            for (int d = 0; d < 4; ++d) \
    _Pragma("unroll") \
                for (int r = 0; r < 16; ++r) o[d][r] *= al[r]; \
            asm volatile("s_waitcnt lgkmcnt(0)" ::: "memory"); \
        } \
        bf16x8 pa0, pa1, pa2, pa3; \
        PK4(p0, 0, pa0); PK4(p0, 8, pa1); PK4(p1, 0, pa2); PK4(p1, 8, pa3); \
        SBAR(); \
        { const int vb = vb0 + cur * SHM_V; \
          pv_one<0>(o[0], vb, pa0, pa1, pa2, pa3); pv_one<1>(o[1], vb, pa0, pa1, pa2, pa3); pv_one<2>(o[2], vb, pa0, pa1, pa2, pa3); pv_one<3>(o[3], vb, pa0, pa1, pa2, pa3); } \
        if (j + 1 < NT) SWRITE(cur ^ 1, W_); \
        __syncthreads(); \
    } while (0)
    for (int j = 0; j < NT; j += 2) { ATT_TILE(j, A, B); if (j + 1 < NT) ATT_TILE(j + 1, B, A); }
#undef ATT_TILE
#undef SLOAD
#undef SWRITE
#undef PK4
    if (hi == 0) wsf[r32] = l_reg;
    asm volatile("s_waitcnt lgkmcnt(0)" ::: "memory");
    float rli[16];
#pragma unroll
    for (int r = 0; r < 16; ++r) rli[r] = __builtin_amdgcn_rcpf(wsf[crow(r, hi)]);
    float* X = (float*)lds + rg * 4096;
    if (comp == 1) {
#pragma unroll
        for (int d0 = 0; d0 < 4; ++d0)
#pragma unroll
            for (int r = 0; r < 16; ++r) X[(d0 * 16 + r) * 64 + lane] = o[d0][r] * rli[r] * lam;
    }
    __syncthreads();
    if (comp == 0) {
        float ssr[16];
#pragma unroll
        for (int r = 0; r < 16; ++r) ssr[r] = 0.f;
#pragma unroll
        for (int d0 = 0; d0 < 4; ++d0)
#pragma unroll
            for (int r = 0; r < 16; ++r) { const float v = o[d0][r] * rli[r] - X[(d0 * 16 + r) * 64 + lane]; o[d0][r] = v; ssr[r] += v * v; }
        float* P = (float*)(lds + L_P) + rg * 1024;
#pragma unroll
        for (int r = 0; r < 16; ++r) P[r * 64 + lane] = ssr[r];
        asm volatile("s_waitcnt lgkmcnt(0)" ::: "memory");
        {
            const int rho = lane & 31, hh = (rho >> 2) & 1, rr = (rho & 3) + 4 * (rho >> 3);
            const float4* pp = (const float4*)(P + rr * 64 + hh * 32 + (lane >> 5) * 16);
            const float4 a0 = pp[0], a1 = pp[1], a2 = pp[2], a3 = pp[3];
            float s = ((a0.x + a0.y) + (a0.z + a0.w)) + ((a1.x + a1.y) + (a1.z + a1.w)) + ((a2.x + a2.y) + (a2.z + a2.w)) + ((a3.x + a3.y) + (a3.z + a3.w));
            auto sw = __builtin_amdgcn_permlane32_swap(__float_as_uint(s), __float_as_uint(s), false, false); s = __uint_as_float(sw[0]) + __uint_as_float(sw[1]);
            if (lane < 32) wsf[32 + rho] = rsqrtf(s * (1.f / 128.f) + EPS) * (1.f - LAMBDA_INIT);
        }
        asm volatile("s_waitcnt lgkmcnt(0)" ::: "memory");
        float sw4[4];
#pragma unroll
        for (int d0 = 0; d0 < 4; ++d0) sw4[d0] = subln[d0 * 32 + r32];
        bf16_t* Ow = MIX + (size_t)(q0 + rg * 32) * DM + h * 128 + r32;
#pragma unroll
        for (int r = 0; r < 16; ++r) {
            const int orow = crow(r, hi); const float rs = wsf[32 + orow];
#pragma unroll
            for (int d0 = 0; d0 < 4; ++d0) Ow[(size_t)orow * DM + d0 * 32] = (bf16_t)f2bf(o[d0][r] * rs * sw4[d0]);
        }
    }
    __syncthreads();
}
#undef KSWZ
#undef SBAR
}

__device__ __forceinline__ float attn_lambda(const Args& a) {
    const int lane = opaque_tid() & 63;
    const float l1 = wave_sum(a.lamqk[lane] * a.lamqk[64 + lane]), l2 = wave_sum(a.lamqk[128 + lane] * a.lamqk[192 + lane]);
    return expf(l1) - expf(l2) + LAMBDA_INIT;
}
namespace mls {
using bf16x8 = __attribute__((ext_vector_type(8))) short;
using bf16x4 = __attribute__((ext_vector_type(4))) short;
using s16x4 = __attribute__((ext_vector_type(4))) short;
using f32x16 = __attribute__((ext_vector_type(16))) float;
using f32x4v = __attribute__((ext_vector_type(4))) float;
using u32x4v = __attribute__((ext_vector_type(4))) unsigned;
using u32x2v = __attribute__((ext_vector_type(2))) unsigned;
constexpr int L_QS = 0, L_QP = 16384, L_KS = 32768, L_KW = 49152, L_VT = 65536, L_PT = 98304, L_HT = 106496, HT_STRIDE = 528;
constexpr int L_MISC = L_HT + 64 * HT_STRIDE;
constexpr int L_RS = L_MISC, L_QN = L_RS + 2 * 64 * 4, L_NV = L_QN + 64 * 4, L_NP = L_NV + 128 * 4, L_CW = L_NP + 8 * 128 * 4, L_RD = L_CW + 5 * 256 * 4, L_NW = L_RD + 8 * 64 * 4, L_END = L_NW + 8 * 36 * 4;
#define KSWZ(row, colB) ((row) * 256 + ((colB) ^ (((row) & 7) << 4)))
#define PSWZ(row, colB) ((row) * 128 + ((colB) ^ ((((row) >> 1) & 7) << 4)))
__device__ __forceinline__ int crow(int r, int hi) { return (r & 3) + 8 * (r >> 2) + 4 * hi; }
__device__ __forceinline__ unsigned cvtpk(float lo, float hi) { unsigned r; asm volatile("v_cvt_pk_bf16_f32 %0, %1, %2" : "=v"(r) : "v"(lo), "v"(hi)); return r; }
__device__ __forceinline__ int v_st(int k, int c) { const int kk = (k & ~0xC) | ((k & 4) << 1) | ((k & 8) >> 1); return ((kk >> 3) * 4 + (c >> 5)) * 512 + ((kk & 7) * 32 + (c & 31)) * 2; }
__device__ __forceinline__ int v_rd_base(int lane) { return ((lane & 3) << 3) | (((lane >> 2) & 3) << 6) | (((lane >> 4) & 1) << 5) | (((lane >> 5) & 1) << 8); }
__device__ __forceinline__ s16x4 tr_read_dyn(int addr) { s16x4 r; asm volatile("ds_read_b64_tr_b16 %0, %1" : "=&v"(r) : "v"(addr) : "memory"); return r; }
__device__ __forceinline__ bf16x8 tr_frag(int img_plus_base, int d0, int ks) {
    const s16x4 lo = tr_read_dyn(img_plus_base + d0 * 512 + ks * 4096), hi = tr_read_dyn(img_plus_base + d0 * 512 + ks * 4096 + 2048);
    return (bf16x8){lo[0], lo[1], lo[2], lo[3], hi[0], hi[1], hi[2], hi[3]};
}
template <int CTRL, int RMASK> __device__ __forceinline__ float dppf(float old, float v) { return __builtin_bit_cast(float, __builtin_amdgcn_update_dpp(__builtin_bit_cast(int, old), __builtin_bit_cast(int, v), CTRL, RMASK, 0xf, false)); }
__device__ __forceinline__ float scan_add(float v) {
    v += dppf<0x111, 0xf>(0.f, v); v += dppf<0x112, 0xf>(0.f, v); v += dppf<0x114, 0xf>(0.f, v); v += dppf<0x118, 0xf>(0.f, v);
    v += dppf<0x142, 0xa>(0.f, v); v += dppf<0x143, 0xc>(0.f, v); return v;
}
__device__ __forceinline__ float scan_max(float v) {
    const float NI = -3.0e38f;
    v = fmaxf(v, dppf<0x111, 0xf>(NI, v)); v = fmaxf(v, dppf<0x112, 0xf>(NI, v)); v = fmaxf(v, dppf<0x114, 0xf>(NI, v)); v = fmaxf(v, dppf<0x118, 0xf>(NI, v));
    v = fmaxf(v, dppf<0x142, 0xa>(NI, v)); v = fmaxf(v, dppf<0x143, 0xc>(NI, v)); return v;
}
__device__ __forceinline__ float rlane(float v, int l) { return __uint_as_float(__builtin_amdgcn_readlane(__float_as_uint(v), l)); }
__device__ __forceinline__ float silu(float x) { return x * __builtin_amdgcn_rcpf(1.f + __expf(-x)); }
__device__ __forceinline__ void fmac_v(float& y, float a, float b) { asm("v_fmac_f32 %0, %1, %2" : "+v"(y) : "v"(a), "v"(b)); }
__device__ __forceinline__ float mul_v(float a, float b) { float r; asm("v_mul_f32 %0, %1, %2" : "=v"(r) : "v"(a), "v"(b)); return r; }

__device__ __forceinline__ void mlstm_item(int b, int h, const Args& a, char* lds) {
    const int tid0 = opaque_tid(), wid = __builtin_amdgcn_readfirstlane(tid0 >> 6);
    const bf16_t* Z = (const bf16_t*)(a.ws + WS_Z); const float* G = (const float*)(a.ws + WS_GATES); bf16_t* MIX = (bf16_t*)(a.ws + WS_MIX);
    const int ldsb = (int)(uintptr_t)lds;
    float* RS = (float*)(lds + L_RS); float* QN = (float*)(lds + L_QN); float* NV = (float*)(lds + L_NV); float* NP = (float*)(lds + L_NP); float* CW = (float*)(lds + L_CW);
    for (int i = tid0; i < 5 * 256; i += NTHREADS) { const int j = i >> 8, c = i & 255; const int cc = c < 128 ? h * 128 + c : 512 + h * 128 + (c - 128); CW[i] = j < 4 ? a.convw[j * 1024 + cc] : a.convb[cc]; }
    if (tid0 < 128) NV[tid0] = 0.f;
    if (tid0 < 256) ((float*)(lds + L_NW))[(tid0 >> 5) * 36 + (tid0 & 31)] = a.mnw[h * 256 + tid0];
    const float ibh = a.ib[h], fbh = a.fb[h];
    float cw[4][4], cb[4];
    __syncthreads();
    { const int c4 = 4 * (tid0 & 63);
#pragma unroll
    for (int j = 0; j < 4; ++j)
#pragma unroll
        for (int q = 0; q < 4; ++q) cw[j][q] = CW[j * 256 + c4 + q];
#pragma unroll
    for (int q = 0; q < 4; ++q) cb[q] = CW[4 * 256 + c4 + q]; }
    f32x16 C[4] = {};
    float m_prev = -1e30f;
    u32x2v rq[11]; u32x4v rv[4]; float gi, gf;
    auto chunk_row0 = [&](int c) -> int { return c == 0 ? META_TILE0 : b * SEQ + (c - 1) * 64; };
#define LOAD_RAW(c) do { int tq_ = tid0; asm volatile("" : "+v"(tq_)); const int ln_ = tq_ & 63, c4_ = 4 * ln_, zc_qk = (c4_ < 128 ? ZMQ + h * 128 + c4_ : ZMK + h * 128 + (c4_ - 128)), erow = tq_ >> 3, eseg = tq_ & 7; const int r0_ = chunk_row0(c); \
        _Pragma("unroll") for (int i_ = 0; i_ < 11; ++i_) { const int t_ = 8 * wid - 3 + i_; int row_; bool ok_ = true; \
            if (t_ >= 0) row_ = r0_ + t_; else if ((c) == 0) { row_ = 0; ok_ = false; } else if ((c) == 1) row_ = META_TILE0 + 64 + t_; else row_ = r0_ + t_; \
            rq[i_] = ok_ ? *(const u32x2v*)(Z + (size_t)row_ * NZ + zc_qk) : (u32x2v){0u, 0u}; } \
        _Pragma("unroll") for (int i_ = 0; i_ < 4; ++i_) rv[i_] = *(const u32x4v*)(Z + (size_t)(r0_ + erow) * NZ + ZMV + h * 256 + eseg * 32 + 8 * i_); \
        { const int rowg_ = r0_ + ln_; gi = G[(size_t)rowg_ * 8 + h]; gf = G[(size_t)rowg_ * 8 + 4 + h]; } } while (0)
    LOAD_RAW(0);
    const int NCH = 33;
    for (int c = 0; c < NCH; ++c) {
        int tid = tid0; asm volatile("" : "+v"(tid));
        const int lane = tid & 63, r32 = lane & 31, hi = lane >> 5, cq = lane, c4 = 4 * cq, erow = tid >> 3, eseg = tid & 7;
        float* RD = (float*)(lds + L_RD) + wid * 64;
        float li = gi + ibh; float lf; { const float xf = gf + fbh; lf = fminf(xf, 0.f) - __logf(1.f + __expf(-fabsf(xf))); }
        if (c == 0 && lane < 48) { li = -1e30f; lf = 0.f; }
        const float bsum = scan_add(lf);
        const float u = li - bsum;
        const float cm = scan_max(u);
        const float Mrow = fmaxf(cm, m_prev);
        const float iw = __expf(m_prev - Mrow);
        const float Mend = rlane(Mrow, 63), gtot = rlane(bsum, 63);
        const float wrow = __expf(u - Mend);
        const float dec = __expf(m_prev - Mend);
        const float dexp = __expf(-(bsum + Mrow));
        {
            float qn_part[8], ksum[4] = {0.f, 0.f, 0.f, 0.f};
            float nvv[4];
#pragma unroll
            for (int q = 0; q < 4; ++q) nvv[q] = (cq < 32) ? NV[c4 + q] : 0.f;
#pragma unroll
            for (int i = 0; i < 8; ++i) {
                const int t = 8 * wid + i;
                float xo[4];
#pragma unroll
                for (int q = 0; q < 4; ++q) xo[q] = cb[q];
#pragma unroll
                for (int j = 0; j < 4; ++j) {
                    const u32x2v rr = rq[i + j];
                    fmac_v(xo[0], cw[j][0], bf_lo(rr.x)); fmac_v(xo[1], cw[j][1], bf_hi(rr.x)); fmac_v(xo[2], cw[j][2], bf_lo(rr.y)); fmac_v(xo[3], cw[j][3], bf_hi(rr.y));
                }
#pragma unroll
                for (int q = 0; q < 4; ++q) xo[q] = silu(xo[q]);
                const float iw_t = rlane(iw, t), w_t = rlane(wrow, t);
                if (cq < 32) {
#pragma unroll
                    for (int q = 0; q < 4; ++q) xo[q] = mul_v(xo[q], 0.08838834764831845f);
                    *(uint2*)(lds + L_QS + KSWZ(t, c4 * 2)) = make_uint2(cvtpk(xo[0], xo[1]), cvtpk(xo[2], xo[3]));
                    float qd = 0.f;
#pragma unroll
                    for (int q = 0; q < 4; ++q) { fmac_v(qd, xo[q], nvv[q]); xo[q] = mul_v(xo[q], iw_t); }
                    *(uint2*)(lds + L_QP + KSWZ(t, c4 * 2)) = make_uint2(cvtpk(xo[0], xo[1]), cvtpk(xo[2], xo[3]));
                    qn_part[i] = iw_t * qd;
                } else {
                    const int kc = c4 - 128;
                    *(uint2*)(lds + L_KS + KSWZ(t, kc * 2)) = make_uint2(cvtpk(xo[0], xo[1]), cvtpk(xo[2], xo[3]));
#pragma unroll
                    for (int q = 0; q < 4; ++q) { xo[q] = mul_v(xo[q], w_t); ksum[q] += xo[q]; }
                    *(uint2*)(lds + L_KW + v_st(t, kc)) = make_uint2(cvtpk(xo[0], xo[1]), cvtpk(xo[2], xo[3]));
                    qn_part[i] = 0.f;
                }
                __builtin_amdgcn_sched_barrier(0);
            }
            {
                float r4[4], r2[2], r1;
                { const bool hb = (lane & 16) != 0;
#pragma unroll
                  for (int i = 0; i < 4; ++i) { const float send = hb ? qn_part[i] : qn_part[i + 4]; const float recv = __shfl_xor(send, 16); r4[i] = (hb ? qn_part[i + 4] : qn_part[i]) + recv; } }
                { const bool hb = (lane & 8) != 0;
#pragma unroll
                  for (int i = 0; i < 2; ++i) { const float send = hb ? r4[i] : r4[i + 2]; const float recv = __shfl_xor(send, 8); r2[i] = (hb ? r4[i + 2] : r4[i]) + recv; } }
                { const bool hb = (lane & 4) != 0; const float send = hb ? r2[0] : r2[1]; const float recv = __shfl_xor(send, 4); r1 = (hb ? r2[1] : r2[0]) + recv; }
                r1 += __shfl_xor(r1, 2); r1 += __shfl_xor(r1, 1);
                if (lane < 32 && (lane & 3) == 0) QN[8 * wid + ((lane >> 4) & 1) * 4 + ((lane >> 3) & 1) * 2 + ((lane >> 2) & 1)] = r1;
            }
            if (cq >= 32) {
#pragma unroll
                for (int q = 0; q < 4; ++q) NP[wid * 128 + (c4 - 128) + q] = ksum[q];
            }
#pragma unroll
            for (int i = 0; i < 4; ++i) *(u32x4v*)(lds + L_VT + (eseg >> 2) * 16384 + v_st(erow, (eseg & 3) * 32 + 8 * i)) = rv[i];
        }
        u32x4v zo[4];
        {
            const int r0 = chunk_row0(c);
#pragma unroll
            for (int i = 0; i < 4; ++i) zo[i] = *(const u32x4v*)(Z + (size_t)(r0 + erow) * NZ + ZMO + h * 256 + eseg * 32 + 8 * i);
        }
        if (c + 1 < NCH) LOAD_RAW(c + 1);
        __syncthreads();
        {
            const int tb = wid >> 1, half = wid & 1;
            float rsum[4] = {0.f, 0.f, 0.f, 0.f};
            const int fr = lane & 15, fq = lane >> 4;
            float Mt[4];
#pragma unroll
            for (int i = 0; i < 4; ++i) Mt[i] = __shfl(Mrow, 16 * tb + 4 * fq + i);
#pragma unroll
            for (int sj = 0; sj < 2; ++sj) {
                const int sb = 2 * half + sj;
                unsigned short pw[4] = {0, 0, 0, 0};
                if (sb <= tb) {
                    f32x4v acc = {0.f, 0.f, 0.f, 0.f};
#pragma unroll
                    for (int ks = 0; ks < 4; ++ks) {
                        const bf16x8 af = *(const bf16x8*)(lds + L_QS + KSWZ(16 * tb + fr, (32 * ks + 8 * fq) * 2));
                        const bf16x8 bfr = *(const bf16x8*)(lds + L_KS + KSWZ(16 * sb + fr, (32 * ks + 8 * fq) * 2));
                        acc = __builtin_amdgcn_mfma_f32_16x16x32_bf16(af, bfr, acc, 0, 0, 0);
                    }
                    const int s = 16 * sb + fr; const float us = __shfl(u, s);
#pragma unroll
                    for (int i = 0; i < 4; ++i) {
                        const int t = 16 * tb + 4 * fq + i;
                        const float p = (s <= t) ? acc[i] * __expf(us - Mt[i]) : 0.f;
                        rsum[i] += p; pw[i] = (unsigned short)f2bf(p);
                    }
                }
#pragma unroll
                for (int i = 0; i < 4; ++i) *(unsigned short*)(lds + L_PT + PSWZ(16 * tb + 4 * fq + i, (16 * sb + fr) * 2)) = pw[i];
            }
#pragma unroll
            for (int i = 0; i < 4; ++i) {
                float v = rsum[i];
                v += __shfl_xor(v, 1); v += __shfl_xor(v, 2); v += __shfl_xor(v, 4); v += __shfl_xor(v, 8);
                if (fr == 0) RS[half * 64 + 16 * tb + 4 * fq + i] = v;
            }
        }
        __syncthreads();
        {
            const float nq = RS[lane] + RS[64 + lane] + QN[lane];
            RD[lane] = __builtin_amdgcn_rcpf(fmaxf(fabsf(nq), dexp));
            bf16x8 vf[4];
            const int vimg = ldsb + L_VT + (wid >> 2) * 16384 + v_rd_base(lane);
#pragma unroll
            for (int ks = 0; ks < 4; ++ks) vf[ks] = tr_frag(vimg, wid & 3, ks);
            asm volatile("s_waitcnt lgkmcnt(0)" ::: "memory"); __builtin_amdgcn_sched_barrier(0);
            f32x16 acc[2] = {};
#pragma unroll
            for (int rb = 0; rb < 2; ++rb) {
                const int row = 32 * rb + r32;
#pragma unroll
                for (int ks = 0; ks < 4; ++ks) {
                    if (rb == 0 && ks >= 2) continue;
                    const bf16x8 pf = *(const bf16x8*)(lds + L_PT + PSWZ(row, (16 * ks + 8 * hi) * 2));
                    acc[rb] = __builtin_amdgcn_mfma_f32_32x32x16_bf16(pf, vf[ks], acc[rb], 0, 0, 0);
                }
            }
#pragma unroll
            for (int kb = 0; kb < 4; ++kb)
#pragma unroll
                for (int sp = 0; sp < 2; ++sp) {
                    bf16x8 cf; { unsigned w0 = cvtpk(C[kb][8 * sp + 0], C[kb][8 * sp + 1]), w1 = cvtpk(C[kb][8 * sp + 2], C[kb][8 * sp + 3]), w2 = cvtpk(C[kb][8 * sp + 4], C[kb][8 * sp + 5]), w3 = cvtpk(C[kb][8 * sp + 6], C[kb][8 * sp + 7]);
                        typedef unsigned u32x4_ __attribute__((ext_vector_type(4))); u32x4_ ww = {w0, w1, w2, w3}; cf = __builtin_bit_cast(bf16x8, ww); }
                    const int base = 32 * kb + 16 * sp;
#pragma unroll
                    for (int rb = 0; rb < 2; ++rb) {
                        const int row = 32 * rb + r32;
                        const bf16x4 q0 = *(const bf16x4*)(lds + L_QP + KSWZ(row, (base + 4 * hi) * 2));
                        const bf16x4 q1 = *(const bf16x4*)(lds + L_QP + KSWZ(row, (base + 8 + 4 * hi) * 2));
                        const bf16x8 qf = {q0[0], q0[1], q0[2], q0[3], q1[0], q1[1], q1[2], q1[3]};
                        acc[rb] = __builtin_amdgcn_mfma_f32_32x32x16_bf16(qf, cf, acc[rb], 0, 0, 0);
                    }
                }
            asm volatile("s_waitcnt lgkmcnt(0)" ::: "memory");
#pragma unroll
            for (int rb = 0; rb < 2; ++rb)
#pragma unroll
                for (int r = 0; r < 16; ++r) {
                    const int row = 32 * rb + crow(r, hi);
                    *(unsigned short*)(lds + L_HT + row * HT_STRIDE + (32 * wid + r32) * 2) = (unsigned short)f2bf(acc[rb][r] * RD[row]);
                }
#pragma unroll
            for (int kb = 0; kb < 4; ++kb) {
#pragma unroll
                for (int r = 0; r < 16; ++r) C[kb][r] *= dec;
                const int kimg = ldsb + L_KW + v_rd_base(lane);
                bf16x8 kf[4];
#pragma unroll
                for (int ks = 0; ks < 4; ++ks) kf[ks] = tr_frag(kimg, kb, ks);
                asm volatile("s_waitcnt lgkmcnt(0)" ::: "memory"); __builtin_amdgcn_sched_barrier(0);
#pragma unroll
                for (int ks = 0; ks < 4; ++ks) C[kb] = __builtin_amdgcn_mfma_f32_32x32x16_bf16(kf[ks], vf[ks], C[kb], 0, 0, 0);
            }
            if (tid < 128) { float s = NV[tid] * dec;
#pragma unroll
                for (int w8 = 0; w8 < 8; ++w8) s += NP[w8 * 128 + tid];
                NV[tid] = s; }
        }
        m_prev = gtot + Mend;
        __syncthreads();
        if (c > 0) {
            float hv[32]; float ss = 0.f;
#pragma unroll
            for (int i = 0; i < 4; ++i) {
                const uint4 w = *(const uint4*)(lds + L_HT + erow * HT_STRIDE + eseg * 64 + 16 * i);
                hv[8 * i + 0] = bf_lo(w.x); hv[8 * i + 1] = bf_hi(w.x); hv[8 * i + 2] = bf_lo(w.y); hv[8 * i + 3] = bf_hi(w.y);
                hv[8 * i + 4] = bf_lo(w.z); hv[8 * i + 5] = bf_hi(w.z); hv[8 * i + 6] = bf_lo(w.w); hv[8 * i + 7] = bf_hi(w.w);
            }
#pragma unroll
            for (int i = 0; i < 32; ++i) ss += hv[i] * hv[i];
            ss += __shfl_xor(ss, 1); ss += __shfl_xor(ss, 2); ss += __shfl_xor(ss, 4);
            const float rstd = rsqrtf(ss * (1.f / 256.f) + EPS);
            const float* nw = (const float*)(lds + L_NW) + eseg * 36;
            bf16_t* op = MIX + (size_t)(chunk_row0(c) + erow) * DM + 1024 + h * 256 + eseg * 32;
#pragma unroll
            for (int i = 0; i < 4; ++i) {
                const unsigned zz[4] = {zo[i].x, zo[i].y, zo[i].z, zo[i].w};
                unsigned ow[4];
#pragma unroll
                for (int q = 0; q < 4; ++q) {
                    const float z0 = bf_lo(zz[q]), z1 = bf_hi(zz[q]);
                    const float o0 = hv[8 * i + 2 * q] * rstd * nw[8 * i + 2 * q] * __builtin_amdgcn_rcpf(1.f + __expf(-z0));
                    const float o1 = hv[8 * i + 2 * q + 1] * rstd * nw[8 * i + 2 * q + 1] * __builtin_amdgcn_rcpf(1.f + __expf(-z1));
                    ow[q] = pk2(o0, o1);
                }
                *(uint4*)(op + 8 * i) = make_uint4(ow[0], ow[1], ow[2], ow[3]);
            }
        }
    }
#undef LOAD_RAW
    __syncthreads();
}
#undef KSWZ
#undef PSWZ
}

namespace rt {
using bf16x8 = __attribute__((ext_vector_type(8))) short;
using f32x16 = __attribute__((ext_vector_type(16))) float;
#define CE(a, b) do { const unsigned x_ = (a), y_ = (b); (a) = x_ > y_ ? x_ : y_; (b) = x_ > y_ ? y_ : x_; } while (0)
#define SORT16_DESC(V) do { CE(V[0], V[1]); CE(V[2], V[3]); CE(V[0], V[2]); CE(V[1], V[3]); CE(V[1], V[2]); CE(V[4], V[5]); CE(V[6], V[7]); CE(V[4], V[6]); CE(V[5], V[7]); CE(V[5], V[6]); CE(V[0], V[4]); CE(V[2], V[6]); CE(V[2], V[4]); CE(V[1], V[5]); CE(V[3], V[7]); CE(V[3], V[5]); CE(V[1], V[2]); CE(V[3], V[4]); CE(V[5], V[6]); CE(V[8], V[9]); CE(V[10], V[11]); CE(V[8], V[10]); CE(V[9], V[11]); CE(V[9], V[10]); CE(V[12], V[13]); CE(V[14], V[15]); CE(V[12], V[14]); CE(V[13], V[15]); CE(V[13], V[14]); CE(V[8], V[12]); CE(V[10], V[14]); CE(V[10], V[12]); CE(V[9], V[13]); CE(V[11], V[15]); CE(V[11], V[13]); CE(V[9], V[10]); CE(V[11], V[12]); CE(V[13], V[14]); CE(V[0], V[8]); CE(V[4], V[12]); CE(V[4], V[8]); CE(V[2], V[10]); CE(V[6], V[14]); CE(V[6], V[10]); CE(V[2], V[4]); CE(V[6], V[8]); CE(V[10], V[12]); CE(V[1], V[9]); CE(V[5], V[13]); CE(V[5], V[9]); CE(V[3], V[11]); CE(V[7], V[15]); CE(V[7], V[11]); CE(V[3], V[5]); CE(V[7], V[9]); CE(V[11], V[13]); CE(V[1], V[2]); CE(V[3], V[4]); CE(V[5], V[6]); CE(V[7], V[8]); CE(V[9], V[10]); CE(V[11], V[12]); CE(V[13], V[14]); } while (0)
#define BMERGE16_DESC(V) do { CE(V[0], V[8]); CE(V[1], V[9]); CE(V[2], V[10]); CE(V[3], V[11]); CE(V[4], V[12]); CE(V[5], V[13]); CE(V[6], V[14]); CE(V[7], V[15]); CE(V[0], V[4]); CE(V[1], V[5]); CE(V[2], V[6]); CE(V[3], V[7]); CE(V[8], V[12]); CE(V[9], V[13]); CE(V[10], V[14]); CE(V[11], V[15]); CE(V[0], V[2]); CE(V[1], V[3]); CE(V[4], V[6]); CE(V[5], V[7]); CE(V[8], V[10]); CE(V[9], V[11]); CE(V[12], V[14]); CE(V[13], V[15]); CE(V[0], V[1]); CE(V[2], V[3]); CE(V[4], V[5]); CE(V[6], V[7]); CE(V[8], V[9]); CE(V[10], V[11]); CE(V[12], V[13]); CE(V[14], V[15]); } while (0)

#define TOP16(A, B) do { _Pragma("unroll") for (int i_ = 0; i_ < 16; ++i_) { const unsigned x_ = A[i_], y_ = B[15 - i_]; A[i_] = x_ > y_ ? x_ : y_; } BMERGE16_DESC(A); } while (0)
__device__ __forceinline__ unsigned ord_key(float f) { const unsigned u = __float_as_uint(f); return u ^ (((unsigned)((int)u >> 31)) | 0x80000000u); }
__device__ __forceinline__ float ord_val(unsigned k) { return __uint_as_float((k & 0x80000000u) ? (k ^ 0x80000000u) : ~k); }
__device__ __forceinline__ int crow(int r, int hi) { return (r & 3) + 8 * (r >> 2) + 4 * hi; }

__device__ __forceinline__ void route_item(int tb, int h, const bf16_t* QP, const bf16_t* SKB, const float* SSQ, int* IDX, float* GATE, int* scr, int lane_in) {
    int lane = lane_in; asm volatile("" : "+v"(lane));
    const int tok = lane & 31, hi = lane >> 5;
    const int row = tb * 32 + tok;
    float rstd;
    { const float4* sp = (const float4*)(SSQ + (size_t)row * 32); float s = 0.f;
#pragma unroll
      for (int i = 0; i < 8; ++i) { const float4 v = sp[i]; s += (v.x + v.y) + (v.z + v.w); }
      rstd = rsqrtf(s * (1.f / DM) + EPS); }
    unsigned top[2][16];
    bf16x8 qf[8], af[2][8];
    unsigned T[16];
#define RT_LOADQ(p_) do { const bf16_t* qp_ = QP + (size_t)row * DM + h * 256 + (p_) * 128 + hi * 8; \
        _Pragma("unroll") for (int ks = 0; ks < 8; ++ks) qf[ks] = *reinterpret_cast<const bf16x8*>(qp_ + ks * 16); } while (0)
#define RT_LOADK(b_, i_) do { const bf16_t* kp_ = SKB + ((size_t)((h * 2 + ((i_) >> 2)) * 128 + ((i_) & 3) * 32 + tok)) * 128 + hi * 8; \
        _Pragma("unroll") for (int ks = 0; ks < 8; ++ks) af[b_][ks] = *reinterpret_cast<const bf16x8*>(kp_ + ks * 16); } while (0)
    RT_LOADQ(0); RT_LOADK(0, 0);
#pragma unroll
    for (int i = 0; i < 8; ++i) {
        const int p = i >> 2, kb = i & 3;
        if (i + 1 < 8) RT_LOADK((i + 1) & 1, i + 1);
        f32x16 acc = {};
#pragma unroll
        for (int ks = 0; ks < 8; ++ks) acc = __builtin_amdgcn_mfma_f32_32x32x16_bf16(af[i & 1][ks], qf[ks], acc, 0, 0, 0);
        unsigned K[16];
#pragma unroll
        for (int r = 0; r < 16; ++r) { const int low = 127 - (32 * kb + (r & 3) + 8 * (r >> 2)) - 4 * hi; K[r] = (ord_key(acc[r]) & ~127u) | (unsigned)low; }
        if (i == 3) RT_LOADQ(1);
        SORT16_DESC(K);
        if (kb == 0) {
#pragma unroll
            for (int j = 0; j < 16; ++j) T[j] = K[j];
        } else { TOP16(T, K); }
        if (kb == 3) {
            unsigned O[16];
#pragma unroll
            for (int j = 0; j < 16; ++j) { auto rr = __builtin_amdgcn_permlane32_swap(T[j], T[j], false, false); O[j] = hi ? rr[0] : rr[1]; }
            TOP16(T, O);
#pragma unroll
            for (int j = 0; j < 16; ++j) top[p][j] = T[j];
        }
        __builtin_amdgcn_sched_barrier(0);
    }
#undef RT_LOADQ
#undef RT_LOADK
    float s1[16], s2[16];
#pragma unroll
    for (int i = 0; i < 16; ++i) {
        s1[i] = ord_val(top[0][i] & ~127u) * rstd; s2[i] = ord_val(top[1][i] & ~127u) * rstd;
        scr[i * 64 + lane] = 127 - (int)(top[0][i] & 127u); scr[(16 + i) * 64 + lane] = 127 - (int)(top[1][i] & 127u);
    }
#define CKEY(a_, b_) ((ord_key(s1[a_] + s2[b_]) & ~255u) | (unsigned)(255 - (16 * (a_) + (b_))))
    unsigned A[16], B[16], Cg[16];
#pragma unroll
    for (int b_ = 0; b_ < 16; ++b_) A[b_] = CKEY(0, b_);
#pragma unroll
    for (int b_ = 0; b_ < 8; ++b_) { B[b_] = CKEY(1, b_); B[8 + b_] = CKEY(15 - b_, 0); }
    BMERGE16_DESC(B);
    Cg[0] = CKEY(2, 0); Cg[1] = CKEY(2, 1); Cg[2] = CKEY(2, 2); Cg[3] = CKEY(2, 3); Cg[4] = CKEY(2, 4);
    Cg[5] = CKEY(3, 0); Cg[6] = CKEY(3, 1); Cg[7] = CKEY(3, 2); Cg[8] = CKEY(3, 3);
    Cg[9] = CKEY(4, 0); Cg[10] = CKEY(4, 1); Cg[11] = CKEY(4, 2);
    Cg[12] = CKEY(5, 0); Cg[13] = CKEY(5, 1); Cg[14] = CKEY(6, 0); Cg[15] = CKEY(6, 1);
    SORT16_DESC(Cg);
    { const unsigned d0 = CKEY(7, 0), d1 = CKEY(7, 1); Cg[15] = Cg[15] > d0 ? Cg[15] : d0; Cg[14] = Cg[14] > d1 ? Cg[14] : d1; BMERGE16_DESC(Cg); }
    TOP16(A, B); TOP16(A, Cg);
#undef CKEY
    asm volatile("s_waitcnt lgkmcnt(0)" ::: "memory");
    float e[16]; float z = 0.f; const float mx = ord_val(A[0] & ~255u);
#pragma unroll
    for (int j = 0; j < 16; ++j) { e[j] = __expf(ord_val(A[j] & ~255u) - mx); z += e[j]; }
    const float rz = 1.f / z;
    int* ip = IDX + (size_t)row * 128 + h * 16 + hi * 8; float* gp = GATE + (size_t)row * 128 + h * 16 + hi * 8;
    int oi[8] = {0, 0, 0, 0, 0, 0, 0, 0}; float og[8] = {0.f, 0.f, 0.f, 0.f, 0.f, 0.f, 0.f, 0.f};
#pragma unroll
    for (int j = 0; j < 16; ++j) {
        const int flat = 255 - (int)(A[j] & 255u), a_ = flat >> 4, b_ = flat & 15;
        const int ex = scr[a_ * 64 + lane] * 128 + scr[(16 + b_) * 64 + lane];
        if (j < 8) { if (!hi) { oi[j] = ex; og[j] = e[j] * rz; } } else { if (hi) { oi[j - 8] = ex; og[j - 8] = e[j] * rz; } }
    }
    *(int4*)(ip) = make_int4(oi[0], oi[1], oi[2], oi[3]); *(int4*)(ip + 4) = make_int4(oi[4], oi[5], oi[6], oi[7]);
    *(float4*)(gp) = make_float4(og[0], og[1], og[2], og[3]); *(float4*)(gp + 4) = make_float4(og[4], og[5], og[6], og[7]);
    asm volatile("s_waitcnt lgkmcnt(0)" ::: "memory");
}
#undef CE
#undef TOP16
}

__device__ __forceinline__ void phase_route(const Args& a, unsigned char* lds, int bid, int nb) {
    const int tid = opaque_tid(), wave = __builtin_amdgcn_readfirstlane(tid >> 6), lane = tid & 63;
    const bf16_t* QP = (const bf16_t*)(a.ws + WS_MIX); const bf16_t* SKB = (const bf16_t*)(a.ws + WS_SKB); const float* SSQ = (const float*)(a.ws + WS_SSQ);
    int* IDX = (int*)(a.ws + WS_IDX); float* GATE = (float*)(a.ws + WS_GATE);
    int* scr = (int*)lds + wave * 2048;
    {
        const bf16_t* X1W = (const bf16_t*)(a.ws + WS_HN); signed char* X1Q = (signed char*)(a.ws + WS_X1Q); float* XSC = (float*)(a.ws + WS_XSC);
        for (int row = bid * NWAVES + wave; row < TREAL; row += nb * NWAVES) {
            uint4 xr[4]; float am = 0.f;
#pragma unroll
            for (int j = 0; j < 4; ++j) { xr[j] = *(const uint4*)(X1W + (size_t)row * DM + 8 * lane + 512 * j);
                am = fmaxf(am, fmaxf(fmaxf(fmaxf(fabsf(bf_lo(xr[j].x)), fabsf(bf_hi(xr[j].x))), fmaxf(fabsf(bf_lo(xr[j].y)), fabsf(bf_hi(xr[j].y)))), fmaxf(fmaxf(fabsf(bf_lo(xr[j].z)), fabsf(bf_hi(xr[j].z))), fmaxf(fabsf(bf_lo(xr[j].w)), fabsf(bf_hi(xr[j].w)))))); }
            am = wave_max(am);
            const float sc = am > 0.f ? 127.f / am : 0.f;
#pragma unroll
            for (int j = 0; j < 4; ++j) {
                const unsigned ww[4] = {xr[j].x, xr[j].y, xr[j].z, xr[j].w}; unsigned o[2] = {0u, 0u};
#pragma unroll
                for (int q = 0; q < 4; ++q) { const int q0 = (int)rintf(bf_lo(ww[q]) * sc), q1 = (int)rintf(bf_hi(ww[q]) * sc); o[q >> 1] |= ((unsigned)(q0 & 255) | ((unsigned)(q1 & 255) << 8)) << (16 * (q & 1)); }
                *(uint2*)(X1Q + (size_t)row * DM + 8 * lane + 512 * j) = make_uint2(o[0], o[1]);
            }
            if (lane == 0) XSC[row] = am * (1.f / 127.f);
        }
    }
    for (int item = bid * NWAVES + wave; item < (TREAL / 32) * 8; item += nb * NWAVES) rt::route_item(item >> 3, item & 7, QP, SKB, SSQ, IDX, GATE, scr, lane);
}

constexpr int CW_QPV = 8192, CW_QPU = 8192 + 8 * 64;
constexpr int PX_ITEMS = TREAL / 64;
constexpr size_t WS_W = WS_Z + 4 * MiB, WS_PART = WS_Z + 32 * MiB, WS_Y = WS_Z + 160 * MiB;


template <int CTRL, int RMASK> __device__ __forceinline__ float dppf(float old, float v) { return __builtin_bit_cast(float, __builtin_amdgcn_update_dpp(__builtin_bit_cast(int, old), __builtin_bit_cast(int, v), CTRL, RMASK, 0xf, false)); }
template <int CTRL> __device__ __forceinline__ int dppi(int v) { return __builtin_amdgcn_update_dpp(0, v, CTRL, 0xf, 0xf, false); }
namespace pu2 {
typedef float f32x2v __attribute__((ext_vector_type(2)));
typedef unsigned u32x4v __attribute__((ext_vector_type(4)));
#define SBP() __builtin_amdgcn_sched_barrier(0)
#define PU_CHUNK_LD(dst, r_, q_) dst = __builtin_amdgcn_raw_buffer_load_b128(RI, g128, (r_) * 512 + (q_) * 16, 0)
#define PU_ROW_LD(buf, e_) buf = __builtin_amdgcn_raw_buffer_load_b128(U, (int)(e_) * 256 + c16, 0, 0)
#define PU_CONSUME(buf, I_) do { int s_ = __builtin_amdgcn_sdot4((int)buf[0], hq0, 0, false); s_ = __builtin_amdgcn_sdot4((int)buf[1], hq1, s_, false); \
    s_ = __builtin_amdgcn_sdot4((int)buf[2], hq2, s_, false); s_ = __builtin_amdgcn_sdot4((int)buf[3], hq3, s_, false); \
    s_ += dppi<0x128>(s_); s_ += dppi<0x124>(s_); s_ += dppi<0x122>(s_); s_ += dppi<0x121>(s_); \
    if ((I_) < 16) keep0 = (c == ((I_) & 15)) ? s_ : keep0; else keep1 = (c == ((I_) & 15)) ? s_ : keep1; } while (0)
#define PU_TOKEN_BODY(row_, nrow_, has_next_) do { \
    PU_CHUNK_LD(C7, row_, 7); \
    SBP(); PU_CONSUME(B0, 0); \
    PU_ROW_LD(B0, C2.x); \
    SBP(); PU_CONSUME(B1, 1); \
    PU_ROW_LD(B1, C2.y); \
    SBP(); PU_CONSUME(B2, 2); \
    PU_ROW_LD(B2, C2.z); \
    SBP(); PU_CONSUME(B3, 3); \
    PU_ROW_LD(B3, C2.w); \
    if (has_next_) PU_CHUNK_LD(C0, nrow_, 0); \
    SBP(); PU_CONSUME(B4, 4); \
    PU_ROW_LD(B4, C3.x); \
    SBP(); PU_CONSUME(B5, 5); \
    PU_ROW_LD(B5, C3.y); \
    SBP(); PU_CONSUME(B6, 6); \
    PU_ROW_LD(B6, C3.z); \
    SBP(); PU_CONSUME(B7, 7); \
    PU_ROW_LD(B7, C3.w); \
    if (has_next_) PU_CHUNK_LD(C1, nrow_, 1); \
    SBP(); PU_CONSUME(B0, 8); \
    PU_ROW_LD(B0, C4.x); \
    SBP(); PU_CONSUME(B1, 9); \
    PU_ROW_LD(B1, C4.y); \
    SBP(); PU_CONSUME(B2, 10); \
    PU_ROW_LD(B2, C4.z); \
    SBP(); PU_CONSUME(B3, 11); \
    PU_ROW_LD(B3, C4.w); \
    if (has_next_) PU_CHUNK_LD(C2, nrow_, 2); \
    SBP(); PU_CONSUME(B4, 12); \
    PU_ROW_LD(B4, C5.x); \
    SBP(); PU_CONSUME(B5, 13); \
    PU_ROW_LD(B5, C5.y); \
    SBP(); PU_CONSUME(B6, 14); \
    PU_ROW_LD(B6, C5.z); \
    SBP(); PU_CONSUME(B7, 15); \
    PU_ROW_LD(B7, C5.w); \
    if (has_next_) PU_CHUNK_LD(C3, nrow_, 3); \
    SBP(); PU_CONSUME(B0, 16); \
    PU_ROW_LD(B0, C6.x); \
    SBP(); PU_CONSUME(B1, 17); \
    PU_ROW_LD(B1, C6.y); \
    SBP(); PU_CONSUME(B2, 18); \
    PU_ROW_LD(B2, C6.z); \
    SBP(); PU_CONSUME(B3, 19); \
    PU_ROW_LD(B3, C6.w); \
    if (has_next_) PU_CHUNK_LD(C4, nrow_, 4); \
    SBP(); PU_CONSUME(B4, 20); \
    PU_ROW_LD(B4, C7.x); \
    SBP(); PU_CONSUME(B5, 21); \
    PU_ROW_LD(B5, C7.y); \
    SBP(); PU_CONSUME(B6, 22); \
    PU_ROW_LD(B6, C7.z); \
    SBP(); PU_CONSUME(B7, 23); \
    PU_ROW_LD(B7, C7.w); \
    if (has_next_) PU_CHUNK_LD(C5, nrow_, 5); \
    SBP(); PU_CONSUME(B0, 24); \
    if (has_next_) PU_ROW_LD(B0, C0.x); \
    SBP(); PU_CONSUME(B1, 25); \
    if (has_next_) PU_ROW_LD(B1, C0.y); \
    SBP(); PU_CONSUME(B2, 26); \
    if (has_next_) PU_ROW_LD(B2, C0.z); \
    SBP(); PU_CONSUME(B3, 27); \
    if (has_next_) PU_ROW_LD(B3, C0.w); \
    if (has_next_) PU_CHUNK_LD(C6, nrow_, 6); \
    SBP(); PU_CONSUME(B4, 28); \
    if (has_next_) PU_ROW_LD(B4, C1.x); \
    SBP(); PU_CONSUME(B5, 29); \
    if (has_next_) PU_ROW_LD(B5, C1.y); \
    SBP(); PU_CONSUME(B6, 30); \
    if (has_next_) PU_ROW_LD(B6, C1.z); \
    SBP(); PU_CONSUME(B7, 31); \
    if (has_next_) PU_ROW_LD(B7, C1.w); \
    } while (0)
#undef SBP
}

__device__ __forceinline__ void phase_pu(const Args& a, unsigned char* lds, unsigned* ctl, int xcc) {
    using namespace pu2;
#define SBP() __builtin_amdgcn_sched_barrier(0)
    const int tid = opaque_tid(), wave = __builtin_amdgcn_readfirstlane(tid >> 6), lane = tid & 63;
    volatile LAS unsigned* slot = (volatile LAS unsigned*)((LAS unsigned char*)lds + LDS_MISC) + 2;
    const signed char* X1Q = (const signed char*)(a.ws + WS_X1Q); float* PART = (float*)(a.ws + WS_PART);
    const __amdgpu_buffer_rsrc_t RI = __builtin_amdgcn_make_buffer_rsrc((void*)(a.ws + WS_IDX), (short)0, TREAL * 512, 0x00020000);
    for (int ss = 0; ss < 8; ++ss) {
        const int s = (xcc + ss) & 7;
        const __amdgpu_buffer_rsrc_t U = __builtin_amdgcn_make_buffer_rsrc((void*)(a.ws + WS_U + (size_t)s * (16384 * 256)), (short)0, 16384 * 256, 0x00020000);
        for (;;) {
            const int item = next_item(ctl + CW_QPU + 64 * s, slot);
            if (item >= PX_ITEMS) break;
            int ln = lane; asm volatile("" : "+v"(ln));
            const int g = ln >> 4, c = ln & 15, c16 = c * 16, g128 = g * 128;
            const int r0 = item * 64 + wave * 8;
            u32x4v C0, C1, C2, C3, C4, C5, C6, C7, B0, B1, B2, B3, B4, B5, B6, B7;
            PU_CHUNK_LD(C0, r0, 0); PU_CHUNK_LD(C1, r0, 1); PU_CHUNK_LD(C2, r0, 2); PU_CHUNK_LD(C3, r0, 3); PU_CHUNK_LD(C4, r0, 4); PU_CHUNK_LD(C5, r0, 5); PU_CHUNK_LD(C6, r0, 6);
            uint4 nxq = *(const uint4*)(X1Q + (size_t)r0 * DM + 256 * s + 16 * c);
            PU_ROW_LD(B0, C0.x); PU_ROW_LD(B1, C0.y); PU_ROW_LD(B2, C0.z); PU_ROW_LD(B3, C0.w); PU_ROW_LD(B4, C1.x); PU_ROW_LD(B5, C1.y); PU_ROW_LD(B6, C1.z); PU_ROW_LD(B7, C1.w);
#pragma unroll 1
            for (int t = 0; t < 8; ++t) {
                const int row = r0 + t, nrow = row + 1; const bool has_next = t < 7;
                const int hq0 = (int)nxq.x, hq1 = (int)nxq.y, hq2 = (int)nxq.z, hq3 = (int)nxq.w;
                if (has_next) nxq = *(const uint4*)(X1Q + (size_t)nrow * DM + 256 * s + 16 * c);
                int keep0 = 0, keep1 = 0;
                PU_TOKEN_BODY(row, nrow, has_next);
                float* pp = PART + (size_t)row * 1024 + s * 128 + 32 * g + c;
                pp[0] = (float)keep0; pp[16] = (float)keep1;
            }
        }
    }
#undef SBP
}
__device__ __forceinline__ void phase_pc(const Args& a, int bid, int nb) {
    const int tid = opaque_tid(), wave = __builtin_amdgcn_readfirstlane(tid >> 6), lane = tid & 63;
    const float* SSQ = (const float*)(a.ws + WS_SSQ); const int* IDX = (const int*)(a.ws + WS_IDX); const float* GATE = (const float*)(a.ws + WS_GATE);
    const float* ISC = (const float*)(a.ws + WS_ISC); const float* PART = (const float*)(a.ws + WS_PART); float* W = (float*)(a.ws + WS_W);
    for (int row = bid * NWAVES + wave; row < TREAL; row += nb * NWAVES) {
        float ssv = lane < 32 ? SSQ[(size_t)row * 32 + lane] : 0.f; ssv = wave_sum(ssv);
        const float rstd = rsqrtf(ssv * (1.f / DM) + EPS);
        const float xsc = ((const float*)(a.ws + WS_XSC))[row];
#pragma unroll
        for (int k = 0; k < 2; ++k) {
            const int p = 64 * k + lane; float d = 0.f;
#pragma unroll
            for (int s = 0; s < 8; ++s) d += PART[(size_t)row * 1024 + s * 128 + p];
            const int e = IDX[(size_t)row * 128 + p];
            const float pre = d * rstd * ISC[e] * xsc;
            W[(size_t)row * 128 + p] = GATE[(size_t)row * 128 + p] * ISC[16384 + e] * (0.5f * pre * (1.f + erff(pre * 0.7071067811865476f)));
        }
    }
}
namespace pv2 {
typedef float f32x2v __attribute__((ext_vector_type(2)));
typedef unsigned u32x4v __attribute__((ext_vector_type(4))); typedef float f32x4v __attribute__((ext_vector_type(4)));
struct Chunk { u32x4v i; f32x4v w; };
#define SBP() __builtin_amdgcn_sched_barrier(0)
#define PV_CHUNK_LD(dst, r_, q_) do { dst.i = __builtin_bit_cast(u32x4v, __builtin_amdgcn_raw_buffer_load_b128(RI, g128, (r_) * 512 + (q_) * 16, 0)); dst.w = __builtin_bit_cast(f32x4v, __builtin_amdgcn_raw_buffer_load_b128(RW, g128, (r_) * 512 + (q_) * 16, 0)); } while (0)
#define PV_ROW_LD(buf, e_) buf = __builtin_amdgcn_raw_buffer_load_b128(V, (int)(e_) * 256 + c16, 0, 0)
#define PV_FMA_LO(y_, c_, wp_) asm("v_pk_fma_f32 %0, %1, %2, %0 op_sel_hi:[1,0,1]" : "+v"(y_) : "v"(c_), "v"(wp_))
#define PV_FMA_HI(y_, c_, wp_) asm("v_pk_fma_f32 %0, %1, %2, %0 op_sel:[0,1,0] op_sel_hi:[1,1,1]" : "+v"(y_) : "v"(c_), "v"(wp_))
#define PV_CONSUME(buf, w4_, E_) do { const f32x2v wp_ = __builtin_shufflevector(w4_, w4_, ((E_) >> 1) * 2, ((E_) >> 1) * 2 + 1); const unsigned d_[4] = {buf[0], buf[1], buf[2], buf[3]}; \
    _Pragma("unroll") for (int k_ = 0; k_ < 4; ++k_) { const f32x2v lo_ = __builtin_amdgcn_cvt_pk_f32_fp8((int)d_[k_], false), hi_ = __builtin_amdgcn_cvt_pk_f32_fp8((int)d_[k_], true); \
        if (((E_) & 1) == 0) { PV_FMA_LO(y2[2 * k_], lo_, wp_); PV_FMA_LO(y2[2 * k_ + 1], hi_, wp_); } else { PV_FMA_HI(y2[2 * k_], lo_, wp_); PV_FMA_HI(y2[2 * k_ + 1], hi_, wp_); } } } while (0)
#define PV_TOKEN_BODY(row_, nrow_, has_next_) do { \
    PV_CHUNK_LD(C7, row_, 7); \
    SBP(); PV_CONSUME(B0, C0.w, 0); \
    PV_ROW_LD(B0, C2.i.x); \
    SBP(); PV_CONSUME(B1, C0.w, 1); \
    PV_ROW_LD(B1, C2.i.y); \
    SBP(); PV_CONSUME(B2, C0.w, 2); \
    PV_ROW_LD(B2, C2.i.z); \
    SBP(); PV_CONSUME(B3, C0.w, 3); \
    PV_ROW_LD(B3, C2.i.w); \
    if (has_next_) PV_CHUNK_LD(C0, nrow_, 0); \
    SBP(); PV_CONSUME(B4, C1.w, 0); \
    PV_ROW_LD(B4, C3.i.x); \
    SBP(); PV_CONSUME(B5, C1.w, 1); \
    PV_ROW_LD(B5, C3.i.y); \
    SBP(); PV_CONSUME(B6, C1.w, 2); \
    PV_ROW_LD(B6, C3.i.z); \
    SBP(); PV_CONSUME(B7, C1.w, 3); \
    PV_ROW_LD(B7, C3.i.w); \
    if (has_next_) PV_CHUNK_LD(C1, nrow_, 1); \
    SBP(); PV_CONSUME(B0, C2.w, 0); \
    PV_ROW_LD(B0, C4.i.x); \
    SBP(); PV_CONSUME(B1, C2.w, 1); \
    PV_ROW_LD(B1, C4.i.y); \
    SBP(); PV_CONSUME(B2, C2.w, 2); \
    PV_ROW_LD(B2, C4.i.z); \
    SBP(); PV_CONSUME(B3, C2.w, 3); \
    PV_ROW_LD(B3, C4.i.w); \
    if (has_next_) PV_CHUNK_LD(C2, nrow_, 2); \
    SBP(); PV_CONSUME(B4, C3.w, 0); \
    PV_ROW_LD(B4, C5.i.x); \
    SBP(); PV_CONSUME(B5, C3.w, 1); \
    PV_ROW_LD(B5, C5.i.y); \
    SBP(); PV_CONSUME(B6, C3.w, 2); \
    PV_ROW_LD(B6, C5.i.z); \
    SBP(); PV_CONSUME(B7, C3.w, 3); \
    PV_ROW_LD(B7, C5.i.w); \
    if (has_next_) PV_CHUNK_LD(C3, nrow_, 3); \
    SBP(); PV_CONSUME(B0, C4.w, 0); \
    PV_ROW_LD(B0, C6.i.x); \
    SBP(); PV_CONSUME(B1, C4.w, 1); \
    PV_ROW_LD(B1, C6.i.y); \
    SBP(); PV_CONSUME(B2, C4.w, 2); \
    PV_ROW_LD(B2, C6.i.z); \
    SBP(); PV_CONSUME(B3, C4.w, 3); \
    PV_ROW_LD(B3, C6.i.w); \
    if (has_next_) PV_CHUNK_LD(C4, nrow_, 4); \
    SBP(); PV_CONSUME(B4, C5.w, 0); \
    PV_ROW_LD(B4, C7.i.x); \
    SBP(); PV_CONSUME(B5, C5.w, 1); \
    PV_ROW_LD(B5, C7.i.y); \
    SBP(); PV_CONSUME(B6, C5.w, 2); \
    PV_ROW_LD(B6, C7.i.z); \
    SBP(); PV_CONSUME(B7, C5.w, 3); \
    PV_ROW_LD(B7, C7.i.w); \
    if (has_next_) PV_CHUNK_LD(C5, nrow_, 5); \
    SBP(); PV_CONSUME(B0, C6.w, 0); \
    if (has_next_) PV_ROW_LD(B0, C0.i.x); \
    SBP(); PV_CONSUME(B1, C6.w, 1); \
    if (has_next_) PV_ROW_LD(B1, C0.i.y); \
    SBP(); PV_CONSUME(B2, C6.w, 2); \
    if (has_next_) PV_ROW_LD(B2, C0.i.z); \
    SBP(); PV_CONSUME(B3, C6.w, 3); \
    if (has_next_) PV_ROW_LD(B3, C0.i.w); \
    if (has_next_) PV_CHUNK_LD(C6, nrow_, 6); \
    SBP(); PV_CONSUME(B4, C7.w, 0); \
    if (has_next_) PV_ROW_LD(B4, C1.i.x); \
    SBP(); PV_CONSUME(B5, C7.w, 1); \
    if (has_next_) PV_ROW_LD(B5, C1.i.y); \
    SBP(); PV_CONSUME(B6, C7.w, 2); \
    if (has_next_) PV_ROW_LD(B6, C1.i.z); \
    SBP(); PV_CONSUME(B7, C7.w, 3); \
    if (has_next_) PV_ROW_LD(B7, C1.i.w); \
    } while (0)
}

__device__ __forceinline__ void phase_pv(const Args& a, unsigned char* lds, unsigned* ctl, int xcc) {
    using namespace pv2;
    const int tid = opaque_tid(), wave = __builtin_amdgcn_readfirstlane(tid >> 6), lane = tid & 63;
    volatile LAS unsigned* slot = (volatile LAS unsigned*)((LAS unsigned char*)lds + LDS_MISC) + 2;
    bf16_t* Y = (bf16_t*)(a.ws + WS_Y);
    const __amdgpu_buffer_rsrc_t RI = __builtin_amdgcn_make_buffer_rsrc((void*)(a.ws + WS_IDX), (short)0, TREAL * 512, 0x00020000);
    const __amdgpu_buffer_rsrc_t RW = __builtin_amdgcn_make_buffer_rsrc((void*)(a.ws + WS_W), (short)0, TREAL * 512, 0x00020000);
    float* ybuf = (float*)lds + wave * 1024;
    for (int ss = 0; ss < 8; ++ss) {
        const int s = (xcc + ss) & 7;
        const __amdgpu_buffer_rsrc_t V = __builtin_amdgcn_make_buffer_rsrc((void*)(a.ws + WS_V + (size_t)s * (16384 * 256)), (short)0, 16384 * 256, 0x00020000);
        for (;;) {
            const int item = next_item(ctl + CW_QPV + 64 * s, slot);
            if (item >= PX_ITEMS) break;
            int ln = lane; asm volatile("" : "+v"(ln));
            const int g = ln >> 4, c = ln & 15, c16 = c * 16, g128 = g * 128;
            const int r0 = item * 64 + wave * 8;
            Chunk C0, C1, C2, C3, C4, C5, C6, C7; u32x4v B0, B1, B2, B3, B4, B5, B6, B7;
            PV_CHUNK_LD(C0, r0, 0); PV_CHUNK_LD(C1, r0, 1); PV_CHUNK_LD(C2, r0, 2); PV_CHUNK_LD(C3, r0, 3); PV_CHUNK_LD(C4, r0, 4); PV_CHUNK_LD(C5, r0, 5); PV_CHUNK_LD(C6, r0, 6);
            PV_ROW_LD(B0, C0.i.x); PV_ROW_LD(B1, C0.i.y); PV_ROW_LD(B2, C0.i.z); PV_ROW_LD(B3, C0.i.w); PV_ROW_LD(B4, C1.i.x); PV_ROW_LD(B5, C1.i.y); PV_ROW_LD(B6, C1.i.z); PV_ROW_LD(B7, C1.i.w);
#pragma unroll 1
            for (int t = 0; t < 8; ++t) {
                const int row = r0 + t, nrow = row + 1; const bool has_next = t < 7;
                f32x2v y2[8];
#pragma unroll
                for (int k = 0; k < 8; ++k) y2[k] = (f32x2v){0.f, 0.f};
                PV_TOKEN_BODY(row, nrow, has_next);
                float4* yb = (float4*)(ybuf + ln * 16);
#pragma unroll
                for (int k = 0; k < 4; ++k) yb[k] = make_float4(y2[2 * k][0], y2[2 * k][1], y2[2 * k + 1][0], y2[2 * k + 1][1]);
                asm volatile("s_waitcnt lgkmcnt(0)" ::: "memory");
                {
                    const float4* yr = (const float4*)ybuf + ln;
                    const float4 y0 = yr[0], y1 = yr[64], y2b = yr[128], y3 = yr[192];
                    const unsigned o0 = pk2((y0.x + y1.x) + (y2b.x + y3.x), (y0.y + y1.y) + (y2b.y + y3.y)), o1 = pk2((y0.z + y1.z) + (y2b.z + y3.z), (y0.w + y1.w) + (y2b.w + y3.w));
                    *(uint2*)(Y + (size_t)row * DM + 256 * s + 4 * ln) = make_uint2(o0, o1);
                }
                asm volatile("s_waitcnt lgkmcnt(0)" ::: "memory");
            }
        }
    }
}
__device__ __forceinline__ void phase_pn(const Args& a, int bid, int nb) {
    const int tid = opaque_tid(), wave = __builtin_amdgcn_readfirstlane(tid >> 6), lane = tid & 63;
    const bf16_t* Y = (const bf16_t*)(a.ws + WS_Y); const bf16_t* X1 = (const bf16_t*)(a.ws + WS_HN);
    for (int row = bid * NWAVES + wave; row < TREAL; row += nb * NWAVES) {
        f32x4* p = (f32x4*)(a.out + (size_t)row * DM) + lane;
        const uint2* yp = (const uint2*)(Y + (size_t)row * DM) + lane; const uint2* xp = (const uint2*)(X1 + (size_t)row * DM) + lane;
        f32x4 v[8]; float ss = 0.f;
#pragma unroll
        for (int j = 0; j < 8; ++j) { const uint2 yy = yp[64 * j], xx = xp[64 * j];
            v[j][0] = bf_lo(xx.x) + bf_lo(yy.x); v[j][1] = bf_hi(xx.x) + bf_hi(yy.x); v[j][2] = bf_lo(xx.y) + bf_lo(yy.y); v[j][3] = bf_hi(xx.y) + bf_hi(yy.y);
            ss += (v[j][0] * v[j][0] + v[j][1] * v[j][1]) + (v[j][2] * v[j][2] + v[j][3] * v[j][3]); }
        const float r = rsqrtf(wave_sum(ss) * (1.f / DM) + EPS);
        const f32x4* wp = (const f32x4*)a.nfinal + lane;
#pragma unroll
        for (int j = 0; j < 8; ++j) p[64 * j] = v[j] * r * wp[64 * j];
    }
}

__device__ __forceinline__ void phase_mix(const Args& a, unsigned char* lds, unsigned* ctr) {
    const bf16_t* Z = (const bf16_t*)(a.ws + WS_Z); bf16_t* MIX = (bf16_t*)(a.ws + WS_MIX);
    volatile LAS unsigned* slot = (volatile LAS unsigned*)((LAS unsigned char*)lds + LDS_MISC) + 2;
    for (;;) {
        const int item = next_item(ctr, slot);
        if (item >= 64 + 2048) break;
        if (item < 64) mls::mlstm_item(item >> 2, item & 3, a, (char*)lds);
        else { const int k = item - 64, qb = 15 - (k >> 7), bh = k & 127; const float lam = attn_lambda(a); att::attn_unit(bh >> 3, bh & 7, qb, Z, MIX, lam, a.subln, (char*)lds); }
    }
}

__global__ void __launch_bounds__(NTHREADS, 2) mega(Args a) {
    extern __shared__ __attribute__((aligned(16))) unsigned char lds[];
    cg::grid_group grid = cg::this_grid();
    const int bid = blockIdx.x, nb = gridDim.x;
    unsigned char* ws = a.ws;
    bf16_t* WinT = (bf16_t*)(ws + WS_WIN); bf16_t* WoutT = (bf16_t*)(ws + WS_WOUT); bf16_t* WqT = (bf16_t*)(ws + WS_WQ);
    float* rope = (float*)(ws + WS_ROPE); float* SSQ = (float*)(ws + WS_SSQ);
    bf16_t* HN = (bf16_t*)(ws + WS_HN); bf16_t* MIX = (bf16_t*)(ws + WS_MIX); bf16_t* Z = (bf16_t*)(ws + WS_Z);

    volatile LAS unsigned* MISC = (volatile LAS unsigned*)((LAS unsigned char*)lds + LDS_MISC);
    if (threadIdx.x < 16) MISC[threadIdx.x] = 0u;
    __syncthreads();
    unsigned* ctl = (unsigned*)(ws + WS_CTL);
    XcdBarrier bar = xcd_barrier_post(ctl + CW_BAR, MISC);
    phase_prep(a, lds, bid, nb);
    grid.sync();
    { pg8::Gemm g{HN, WinT, MROWS, NZ, DM}; EpiZ E{Z, rope}; pg8::StaticOrder S; S.init(g.M, g.N, nb, bid);
      pg8::gemm_phase<EpiZ, pg8::StaticOrder, true, true>((PG8_LAS unsigned char*)lds, g, S, E); }
    phase_tables(a, lds, ctl);
    xcd_barrier(bar);
    phase_mix(a, lds, ctl + CW_QUEUE);
    xcd_barrier(bar);
    { pg8::Gemm g{MIX, WoutT, TREAL, DM, DM}; EpiX1 E{a.x, HN, SSQ}; pg8::StaticOrder S; S.init(g.M, g.N, nb, bid);
      pg8::gemm_phase<EpiX1, pg8::StaticOrder, true, true>((PG8_LAS unsigned char*)lds, g, S, E); }
    xcd_barrier(bar);
    { pg8::Gemm g{HN, WqT, TREAL, DM, DM}; pg8::EpiBf16<0> E{MIX, DM, nullptr, 0, 0, 1.f}; pg8::StaticOrder S; S.init(g.M, g.N, nb, bid);
      pg8::gemm_phase<pg8::EpiBf16<0>, pg8::StaticOrder, true, true>((PG8_LAS unsigned char*)lds, g, S, E); }
    xcd_barrier(bar);
    phase_route(a, lds, bid, nb);
    xcd_barrier(bar);
    { const int xcc = (int)(xb_xcc_id() & 7u);
      phase_pu(a, lds, ctl, xcc); xcd_barrier(bar);
      phase_pc(a, bid, nb); xcd_barrier(bar);
      phase_pv(a, lds, ctl, xcc); xcd_barrier(bar);
      phase_pn(a, bid, nb); }
}

extern "C" void kernel_launch(void* const* d_in, const int* in_sizes, int n_in, void* d_out, int out_size, void* d_ws, size_t ws_size, hipStream_t stream) {
    if (n_in != 18 || out_size != TREAL * DM || ws_size < WS_END) { fprintf(stderr, "kernel_launch: unexpected shapes n_in %d out %d ws %zu (need %zu)\n", n_in, out_size, ws_size, (size_t)WS_END); return; }
    static int grid_blocks = 0;
    if (!grid_blocks) {
        int dev = 0, cus = 0, per_cu = 0;
        (void)hipGetDevice(&dev);
        (void)hipDeviceGetAttribute(&cus, hipDeviceAttributeMultiprocessorCount, dev);
        (void)hipFuncSetAttribute((const void*)mega, hipFuncAttributeMaxDynamicSharedMemorySize, LDS_BYTES);
        (void)hipOccupancyMaxActiveBlocksPerMultiprocessor(&per_cu, (const void*)mega, NTHREADS, LDS_BYTES);
        if (per_cu < 1) { fprintf(stderr, "kernel_launch: occupancy query says %d blocks/CU\n", per_cu); per_cu = 1; }
        if (per_cu > 1) per_cu = 1;
        grid_blocks = cus * per_cu;
    }
    Args a{};
    a.x = (const float*)d_in[0]; a.meta = (const float*)d_in[1]; a.nmw = (const float*)d_in[2]; a.w_in = (const float*)d_in[3];
    a.lamqk = (const float*)d_in[4]; a.subln = (const float*)d_in[5]; a.convw = (const float*)d_in[6]; a.convb = (const float*)d_in[7];
    a.ib = (const float*)d_in[8]; a.fb = (const float*)d_in[9]; a.mnw = (const float*)d_in[10]; a.w_out = (const float*)d_in[11];
    a.nfw_ffn = (const float*)d_in[12]; a.w_q = (const float*)d_in[13]; a.subkeys = (const float*)d_in[14]; a.pu = (const float*)d_in[15];
    a.pv = (const float*)d_in[16]; a.nfinal = (const float*)d_in[17];
    a.out = (float*)d_out; a.ws = (unsigned char*)d_ws;
    (void)hipMemsetAsync((char*)d_ws + WS_CTL, 0, 65536, stream);
    void* kargs[] = {&a};
    const hipError_t e = hipLaunchCooperativeKernel((const void*)mega, dim3(grid_blocks), dim3(NTHREADS), kargs, LDS_BYTES, stream);
    if (e != hipSuccess) fprintf(stderr, "kernel_launch: cooperative launch failed: %s (grid %d)\n", hipGetErrorString(e), grid_blocks);
}
```

```cpp
#include <hip/hip_runtime.h>
#include <hip/hip_bf16.h>
#include <cstdio>
#include <cstdint>
#include <cmath>
namespace pg8 {
#define PG8_LAS __attribute__((address_space(3)))
typedef unsigned short bf16_t;
typedef short bf16x8 __attribute__((ext_vector_type(8)));
typedef float f32x4 __attribute__((ext_vector_type(4)));
typedef unsigned u32x4 __attribute__((ext_vector_type(4)));
constexpr int BM = 256, BK = 64, HALF = 128, HTB = HALF * BK * 2  , STAGE_BYTES = 8 * HTB, NXCD = 8, WGM = 8;

__host__ __device__ __forceinline__ int lds_byte(int r, int c) { const int st = (r >> 4) * 2 + (c >> 5), rr = r & 15, cc = c & 31, ob = rr * 64 + cc * 2; return st * 1024 + (ob ^ (((ob >> 9) & 1) << 5)); }
__host__ __device__ __forceinline__ void stage_rc(int b, int& R, int& C) { const int st = b / 1024, sb = b % 1024, swz = sb ^ (((sb >> 9) & 1) << 5); R = (st >> 1) * 16 + swz / 64; C = (st & 1) * 32 + (swz % 64) / 2; }
__host__ __device__ __forceinline__ int perm32(int rho) { const int n = rho >> 4, i = rho & 15; return 8 * (i >> 2) + 4 * n + (i & 3); }

struct Unit { int pm, pn; };
struct Gemm { const bf16_t* A; const bf16_t* Bt; int M, N, K; };

struct StaticOrder {
    int nM, nN, nwg, G, c;
    __host__ __device__ void init(int M, int N, int G_, int c_) { nM = M / BM; nN = N / BM; nwg = nM * nN; G = G_; c = c_; }
    __host__ __device__ bool next(int i, Unit& u) const {
        const long L = (long)i * G + c; if (L >= nwg) return false;
        int wgid = (int)L; { const int q = nwg / NXCD, r = nwg % NXCD, xcd = wgid % NXCD, off = wgid / NXCD; wgid = (xcd < r ? xcd * (q + 1) : r * (q + 1) + (xcd - r) * q) + off; }
        const int nig = WGM * nN, gid = wgid / nig, fm = gid * WGM, gsz = (nM - fm) < WGM ? (nM - fm) : WGM;
        u.pm = fm + ((wgid % nig) % gsz); u.pn = (wgid % nig) / gsz; return true;
    }
    __device__ __forceinline__ void a_ready(const Unit&) const {}
    __device__ __forceinline__ void done(const Unit&) const {}
};

__device__ __forceinline__ unsigned cvt_pk_bf16(float lo, float hi) { unsigned r; asm volatile("v_cvt_pk_bf16_f32 %0, %1, %2" : "=v"(r) : "v"(lo), "v"(hi)); return r; }
typedef float f32x2 __attribute__((ext_vector_type(2)));
__device__ __forceinline__ f32x2 gelu_pk(f32x2 v) {
    const f32x2 av = __builtin_elementwise_abs(v), d = av * 0.2316418882f + 1.0f;
    f32x2 t; t.x = __builtin_amdgcn_rcpf(d.x); t.y = __builtin_amdgcn_rcpf(d.y);
    f32x2 q = t * 0.5307027145f + (-0.7265760135f); q = q * t + 0.7107068705f; q = q * t + (-0.142248368f); q = q * t + 0.127414796f; q = q * t;
    const f32x2 s = (v * v) * (-0.72134752044f);
    f32x2 e; e.x = __builtin_amdgcn_exp2f(s.x); e.y = __builtin_amdgcn_exp2f(s.y);
    const f32x2 m = v * (q * e), r = v - m;
    f32x2 o; o.x = v.x < 0.f ? m.x : r.x; o.y = v.y < 0.f ? m.y : r.y; return o;
}

template <int ACT  > struct EpiBf16 {
    static constexpr bool PERM = true, AFTER_DRAIN = false; static_assert(ACT == 0 || ACT == 1, "EpiBf16: ACT is 0 (none) or 1 (gelu_pk)");
    bf16_t* O; int ldc; const float* bias; int split_cols; size_t split_stride; float scale0;
    __device__ __forceinline__ void operator()(const f32x4 (&acc)[2][2][4][2], const Unit& u, int wr, int wc, int fr, int fq) const {
        const int row0 = u.pm * BM + wr * 64 + fr; int colt = u.pn * BM; bf16_t* base = O;
        float sc = 1.f; if (split_cols) { const int t = colt / split_cols; base += (size_t)t * split_stride; colt -= t * split_cols; if (t == 0) sc = scale0; }
        const int col0 = colt + wc * 32 + 8 * fq, bcol0 = u.pn * BM + wc * 32 + 8 * fq;
        f32x4 bv[2][2];
#pragma unroll
        for (int bj = 0; bj < 2; ++bj)
#pragma unroll
            for (int n = 0; n < 2; ++n) bv[bj][n] = bias ? *(const f32x4*)(bias + bcol0 + bj * HALF + 4 * n) : (f32x4){0.f, 0.f, 0.f, 0.f};
#pragma unroll
        for (int ai = 0; ai < 2; ++ai)
#pragma unroll
            for (int m = 0; m < 4; ++m) { bf16_t* rowp = base + (size_t)(row0 + ai * HALF + m * 16) * ldc + col0;
#pragma unroll
                for (int bj = 0; bj < 2; ++bj) { f32x4 v0 = acc[ai][bj][m][0] + bv[bj][0], v1 = acc[ai][bj][m][1] + bv[bj][1];
                    if (ACT == 1) { f32x2 a = gelu_pk((f32x2){v0[0], v0[1]}), b = gelu_pk((f32x2){v0[2], v0[3]}), c = gelu_pk((f32x2){v1[0], v1[1]}), d = gelu_pk((f32x2){v1[2], v1[3]});
                        v0 = (f32x4){a.x, a.y, b.x, b.y}; v1 = (f32x4){c.x, c.y, d.x, d.y}; }
                    v0 = v0 * sc; v1 = v1 * sc; u32x4 w; w.x = cvt_pk_bf16(v0[0], v0[1]); w.y = cvt_pk_bf16(v0[2], v0[3]); w.z = cvt_pk_bf16(v1[0], v1[1]); w.w = cvt_pk_bf16(v1[2], v1[3]);
                    *(u32x4*)(rowp + bj * HALF) = w; } }
    }
};
template <class Epi, class Sched, bool ALIGN_EPI = false, bool SP2 = false>
__device__ __forceinline__ void gemm_phase(PG8_LAS unsigned char* lds, const Gemm g, const Sched& S, const Epi& E) {
    int tid_ = threadIdx.x; asm volatile("" : "+v"(tid_));
    const int tid = tid_, wid = __builtin_amdgcn_readfirstlane(tid >> 6), lane = tid & 63, wr = wid >> 2, wc = wid & 3, fr = lane & 15, fq = lane >> 4;
    const int K = g.K, nt = K / BK;
    unsigned voffA[2], voffB[2];
#pragma unroll
    for (int i = 0; i < 2; ++i) { int R, C; stage_rc(tid * 16 + i * 8192, R, C); const int Rb = Epi::PERM ? ((R & ~31) + perm32(R & 31)) : R;
        voffA[i] = (unsigned)(R * K + C) * 2u; voffB[i] = (unsigned)(Rb * K + C) * 2u; }
    const size_t kstep = (size_t)(BK * 2);
    const size_t hstep = (size_t)HALF * K * 2;
    const size_t tstep = 2 * hstep;
    const unsigned ldsw = (unsigned)wid * 1024u;
    const int aoff = lds_byte(wr * 64 + fr, fq * 8), boff = lds_byte(wc * 32 + fr, fq * 8);
#define PG8_SA(b, h) (((b) * 2 + (h)) * HTB)
#define PG8_SB(b, h) ((4 + (b) * 2 + (h)) * HTB)
#define PG8_STAGE(bufoff, gbase, voff) do { _Pragma("unroll") for (int _i = 0; _i < 2; ++_i) \
        __builtin_amdgcn_global_load_lds((const unsigned*)((const char*)(gbase) + (voff)[_i]), (PG8_LAS unsigned*)(lds + (bufoff) + ldsw + _i * 8192), 16, 0, 0); } while (0)
#define PG8_LDA(dst, b, h) do { _Pragma("unroll") for (int m = 0; m < 4; ++m) _Pragma("unroll") for (int k = 0; k < 2; ++k) dst[m][k] = *(const PG8_LAS bf16x8*)(lds + PG8_SA(b, h) + aoff + m * 2048 + k * 1024); } while (0)
#define PG8_LDB(dst, b, h) do { _Pragma("unroll") for (int n = 0; n < 2; ++n) _Pragma("unroll") for (int k = 0; k < 2; ++k) dst[n][k] = *(const PG8_LAS bf16x8*)(lds + PG8_SB(b, h) + boff + n * 2048 + k * 1024); } while (0)
#define PG8_MMA(ai, bj, At, Bt) do { __builtin_amdgcn_s_setprio(1); _Pragma("unroll") for (int m = 0; m < 4; ++m) _Pragma("unroll") for (int n = 0; n < 2; ++n) _Pragma("unroll") for (int k = 0; k < 2; ++k) \
        acc[ai][bj][m][n] = __builtin_amdgcn_mfma_f32_16x16x32_bf16(Bt[n][k], At[m][k], acc[ai][bj][m][n], 0, 0, 0); __builtin_amdgcn_s_setprio(0); } while (0)
#define PG8_WAIT_V(n) asm volatile("s_waitcnt vmcnt(" #n ")" ::: "memory")
#define PG8_WAIT_L(n) asm volatile("s_waitcnt lgkmcnt(" #n ")" ::: "memory")
#define PG8_BAR __builtin_amdgcn_s_barrier()
#define PG8_SCHED __builtin_amdgcn_sched_barrier(0)
    Unit cur, nxt; int ui = 0;
    if (!S.next(0, cur)) return;
    f32x4 acc[2][2][4][2];
#pragma unroll
    for (int a = 0; a < 2; ++a)
#pragma unroll
        for (int b = 0; b < 2; ++b)
#pragma unroll
            for (int m = 0; m < 4; ++m)
#pragma unroll
                for (int n = 0; n < 2; ++n) acc[a][b][m][n] = (f32x4){0.f, 0.f, 0.f, 0.f};
    bf16x8 At[4][2], B0[2][2], B1[2][2];
    const char* cA = (const char*)g.A + (size_t)cur.pm * tstep; const char* cB = (const char*)g.Bt + (size_t)cur.pn * tstep;
    S.a_ready(cur);
    if constexpr (SP2) {
        PG8_STAGE(PG8_SB(0, 0), cB, voffB); PG8_STAGE(PG8_SB(0, 1), cB + hstep, voffB); PG8_STAGE(PG8_SA(0, 0), cA, voffA); PG8_STAGE(PG8_SA(0, 1), cA + hstep, voffA);
        if (wr == 1) PG8_BAR;
        PG8_WAIT_V(2); PG8_BAR;
        PG8_STAGE(PG8_SB(1, 0), cB + kstep, voffB); PG8_STAGE(PG8_SA(1, 0), cA + kstep, voffA); PG8_STAGE(PG8_SB(1, 1), cB + hstep + kstep, voffB);
        PG8_WAIT_V(6); PG8_BAR;
    } else {
        PG8_STAGE(PG8_SB(0, 0), cB, voffB); PG8_STAGE(PG8_SA(0, 0), cA, voffA); PG8_STAGE(PG8_SB(0, 1), cB + hstep, voffB); PG8_STAGE(PG8_SA(0, 1), cA + hstep, voffA);
        if (wr == 1) PG8_BAR;
        PG8_WAIT_V(4); PG8_BAR;
        PG8_STAGE(PG8_SB(1, 0), cB + kstep, voffB); PG8_STAGE(PG8_SA(1, 0), cA + kstep, voffA); PG8_STAGE(PG8_SB(1, 1), cB + hstep + kstep, voffB);
        PG8_WAIT_V(6); PG8_BAR;
    }
    for (;;) {
        const bool has_next = S.next(ui + 1, nxt);
        const char* nA = has_next ? (const char*)g.A + (size_t)nxt.pm * tstep : cA; const char* nB = has_next ? (const char*)g.Bt + (size_t)nxt.pn * tstep : cB;
        for (int t = 0; t < nt; t += 2) {
            const bool last = (t == nt - 2);
            const char* a1 = cA + (size_t)(t + 1) * kstep;
            const char* a2 = last ? nA : cA + (size_t)(t + 2) * kstep; const char* b2 = last ? nB : cB + (size_t)(t + 2) * kstep;
            const char* a3 = a2 + kstep; const char* b3 = b2 + kstep;
            if (last && has_next) S.a_ready(nxt);
            if constexpr (SP2) {
            PG8_LDB(B0, 0, 0); PG8_LDB(B1, 0, 1); PG8_SCHED; PG8_LDA(At, 0, 0); PG8_STAGE(PG8_SA(1, 1), a1 + hstep, voffA);
            PG8_WAIT_V(8); PG8_WAIT_L(0); PG8_BAR; PG8_MMA(0, 0, At, B0); PG8_MMA(0, 1, At, B1); PG8_BAR; PG8_SCHED;
            PG8_LDA(At, 0, 1); PG8_STAGE(PG8_SB(0, 0), b2, voffB); PG8_STAGE(PG8_SB(0, 1), b2 + hstep, voffB); PG8_STAGE(PG8_SA(0, 0), a2, voffA);
            PG8_WAIT_V(8); PG8_WAIT_L(0); PG8_BAR; PG8_MMA(1, 0, At, B0); PG8_MMA(1, 1, At, B1); PG8_BAR; PG8_SCHED;
            PG8_LDB(B0, 1, 0); PG8_LDB(B1, 1, 1); PG8_SCHED; PG8_LDA(At, 1, 0); PG8_STAGE(PG8_SA(0, 1), a2 + hstep, voffA);
            PG8_WAIT_V(8); PG8_WAIT_L(0); PG8_BAR; PG8_MMA(0, 0, At, B0); PG8_MMA(0, 1, At, B1); PG8_BAR; PG8_SCHED;
            PG8_LDA(At, 1, 1); PG8_STAGE(PG8_SB(1, 0), b3, voffB); PG8_STAGE(PG8_SB(1, 1), b3 + hstep, voffB); PG8_STAGE(PG8_SA(1, 0), a3, voffA);
            PG8_WAIT_V(8); PG8_WAIT_L(0); PG8_BAR; PG8_MMA(1, 0, At, B0); PG8_MMA(1, 1, At, B1); PG8_BAR; PG8_SCHED;
            } else {
            PG8_LDB(B0, 0, 0); PG8_SCHED; PG8_LDA(At, 0, 0); PG8_STAGE(PG8_SA(1, 1), a1 + hstep, voffA);
            PG8_WAIT_L(8); PG8_BAR; PG8_WAIT_L(0); PG8_MMA(0, 0, At, B0); PG8_BAR; PG8_SCHED;
            PG8_LDB(B1, 0, 1); PG8_STAGE(PG8_SB(0, 0), b2, voffB);
            PG8_BAR; PG8_WAIT_L(0); PG8_MMA(0, 1, At, B1); PG8_BAR;
            PG8_LDA(At, 0, 1); PG8_STAGE(PG8_SA(0, 0), a2, voffA);
            PG8_BAR; PG8_WAIT_L(0); PG8_MMA(1, 0, At, B0); PG8_BAR; PG8_SCHED;
            PG8_STAGE(PG8_SB(0, 1), b2 + hstep, voffB);
            PG8_WAIT_V(6); PG8_BAR; PG8_MMA(1, 1, At, B1); PG8_BAR;
            PG8_LDB(B0, 1, 0); PG8_SCHED; PG8_LDA(At, 1, 0); PG8_STAGE(PG8_SA(0, 1), a2 + hstep, voffA);
            PG8_WAIT_L(8); PG8_BAR; PG8_WAIT_L(0); PG8_MMA(0, 0, At, B0); PG8_BAR; PG8_SCHED;
            PG8_LDB(B1, 1, 1); PG8_STAGE(PG8_SB(1, 0), b3, voffB);
            PG8_BAR; PG8_WAIT_L(0); PG8_MMA(0, 1, At, B1); PG8_BAR;
            PG8_LDA(At, 1, 1); PG8_STAGE(PG8_SA(1, 0), a3, voffA);
            PG8_BAR; PG8_WAIT_L(0); PG8_MMA(1, 0, At, B0); PG8_BAR; PG8_SCHED;
            PG8_STAGE(PG8_SB(1, 1), b3 + hstep, voffB);
            PG8_WAIT_V(6); PG8_BAR; PG8_MMA(1, 1, At, B1); PG8_BAR;
            }
        }
        if constexpr (ALIGN_EPI) { if (wr == 0) PG8_BAR; }
        if constexpr (!Epi::AFTER_DRAIN) { E(acc, cur, wr, wc, fr, fq); S.done(cur); }
        if (!has_next) break;
#pragma unroll
        for (int a = 0; a < 2; ++a)
#pragma unroll
            for (int b = 0; b < 2; ++b)
#pragma unroll
                for (int m = 0; m < 4; ++m)
#pragma unroll
                    for (int n = 0; n < 2; ++n) acc[a][b][m][n] = (f32x4){0.f, 0.f, 0.f, 0.f};
        cur = nxt; cA = nA; cB = nB; ++ui;
        if constexpr (ALIGN_EPI) { if (wr == 1) PG8_BAR; }
    }
    PG8_WAIT_V(0);
    if constexpr (!ALIGN_EPI) { if (wr == 0) PG8_BAR; }
    PG8_BAR;
    if constexpr (Epi::AFTER_DRAIN) { E.fused(acc, cur, wr, wc, fr, fq, lds, wid, lane); S.done(cur); }
#undef PG8_SA
#undef PG8_SB
#undef PG8_STAGE
#undef PG8_LDA
#undef PG8_LDB
#undef PG8_MMA
#undef PG8_WAIT_V
#undef PG8_WAIT_L
#undef PG8_BAR
#undef PG8_SCHED
}
}

constexpr int BATCH = 16, SEQ = 2048, DM = 2048, NMETA = 16;
constexpr int TREAL = BATCH * SEQ;
constexpr int MROWS = 33024;
constexpr int META_TILE0 = 32768;
constexpr int META_ROW0 = 32816;
constexpr int NZ = 6144;
constexpr int ZQ = 0, ZK = 1024, ZV = 2048, ZMQ = 3072, ZMK = 3584, ZMV = 4096, ZMO = 5120;
constexpr int INCOLS = 6152;
constexpr float EPS = 1e-6f;
constexpr float QSCALE = 0.125f * 1.4426950408889634f;
constexpr float LAMBDA_INIT = 0.2f;

typedef unsigned short bf16_t;
typedef float f32x4 __attribute__((ext_vector_type(4)));
typedef __bf16 bf16x2_t __attribute__((ext_vector_type(2)));

constexpr size_t MiB = 1u << 20;
constexpr size_t WS_CTL = 0;
constexpr size_t WS_ISC = 655360;
constexpr size_t WS_SKB = 65536;
constexpr size_t WS_WIN = 1 * MiB;
constexpr size_t WS_WOUT = 25 * MiB;
constexpr size_t WS_WQ = 33 * MiB;
constexpr size_t WS_ROPE = 41 * MiB;
constexpr size_t WS_GATES = 42 * MiB;
constexpr size_t WS_SSQ = 44 * MiB;
constexpr size_t WS_IDX = 48 * MiB;
constexpr size_t WS_GATE = 64 * MiB;
constexpr size_t WS_U = 80 * MiB;
constexpr size_t WS_V = 144 * MiB;
constexpr size_t WS_HN = 208 * MiB;
constexpr size_t WS_MIX = 338 * MiB;
constexpr size_t WS_Z = 466 * MiB;
constexpr size_t WS_END = 854 * MiB;

__device__ __forceinline__ float bf_lo(unsigned w) { return __uint_as_float(w << 16); }
__device__ __forceinline__ float bf_hi(unsigned w) { return __uint_as_float(w & 0xffff0000u); }
__device__ __forceinline__ float bf2f(bf16_t v) { return __uint_as_float(((unsigned)v) << 16); }
__device__ __forceinline__ unsigned f2bf(float f) { unsigned r; asm("v_cvt_pk_bf16_f32 %0, %1, 0" : "=v"(r) : "v"(f)); return r; }
__device__ __forceinline__ unsigned pk2(float lo, float hi) { unsigned r; asm("v_cvt_pk_bf16_f32 %0, %1, %2" : "=v"(r) : "v"(lo), "v"(hi)); return r; }
__device__ __forceinline__ float dot2(unsigned a, unsigned b, float acc) { return __builtin_amdgcn_fdot2_f32_bf16(__builtin_bit_cast(bf16x2_t, a), __builtin_bit_cast(bf16x2_t, b), acc, false); }
__device__ __forceinline__ float wave_sum(float v) {
#pragma unroll
    for (int o = 1; o < 64; o <<= 1) v += __shfl_xor(v, o);
    return v;
}
__device__ __forceinline__ float wave_max(float v) {
#pragma unroll
    for (int o = 1; o < 64; o <<= 1) v = fmaxf(v, __shfl_xor(v, o));
    return v;
}
__device__ __forceinline__ int zrow_of(int b, int l) { return l < NMETA ? META_ROW0 + l : b * SEQ + (l - NMETA); }

struct EpiZ {
    static constexpr bool PERM = true, AFTER_DRAIN = false;
    bf16_t* Z; const float* rope;
    __device__ __forceinline__ void operator()(const pg8::f32x4 (&acc)[2][2][4][2], const pg8::Unit& u, int wr, int wc, int fr, int fq) const {
        const int row0 = u.pm * 256 + wr * 64 + fr, col0 = u.pn * 256 + wc * 32 + 8 * fq;
        const bool isq = u.pn < 4, isrope = u.pn < 8;
        const int j0 = 16 * (wc & 1) + 4 * fq;
#pragma unroll
        for (int ai = 0; ai < 2; ++ai)
#pragma unroll
            for (int m = 0; m < 4; ++m) {
                const int row = row0 + ai * 128 + m * 16;
                pg8::f32x4 c0 = {1.f, 0.f, 1.f, 0.f}, c1 = {1.f, 0.f, 1.f, 0.f};
                if (isrope) {
                    const int pos = row < TREAL ? (row & (SEQ - 1)) + NMETA : ((row >= META_ROW0 && row < META_ROW0 + NMETA) ? row - META_ROW0 : 0);
                    const pg8::f32x4* tp = (const pg8::f32x4*)(rope + ((size_t)pos * 32 + j0) * 2);
                    c0 = tp[0]; c1 = tp[1];
                }
                bf16_t* rowp = Z + (size_t)row * NZ + col0;
#pragma unroll
                for (int bj = 0; bj < 2; ++bj) {
                    pg8::f32x4 v0 = acc[ai][bj][m][0], v1 = acc[ai][bj][m][1];
                    if (isrope) {
                        pg8::f32x4 o0, o1;
                        o0[0] = v0[0] * c0[0] - v0[1] * c0[1]; o0[1] = v0[1] * c0[0] + v0[0] * c0[1];
                        o0[2] = v0[2] * c0[2] - v0[3] * c0[3]; o0[3] = v0[3] * c0[2] + v0[2] * c0[3];
                        o1[0] = v1[0] * c1[0] - v1[1] * c1[1]; o1[1] = v1[1] * c1[0] + v1[0] * c1[1];
                        o1[2] = v1[2] * c1[2] - v1[3] * c1[3]; o1[3] = v1[3] * c1[2] + v1[2] * c1[3];
                        v0 = o0; v1 = o1;
                        if (isq) { v0 = v0 * QSCALE; v1 = v1 * QSCALE; }
                    }
                    pg8::u32x4 w; w.x = pg8::cvt_pk_bf16(v0[0], v0[1]); w.y = pg8::cvt_pk_bf16(v0[2], v0[3]); w.z = pg8::cvt_pk_bf16(v1[0], v1[1]); w.w = pg8::cvt_pk_bf16(v1[2], v1[3]);
                    *(pg8::u32x4*)(rowp + bj * 128) = w;
                }
            }
    }
};
struct EpiX1 {
    static constexpr bool PERM = true, AFTER_DRAIN = false;
    const float* x; bf16_t* x1b; float* ssq;
    __device__ __forceinline__ void loadr(pg8::f32x4 (&xb)[2][2], int row0, int col0, int i) const {
#pragma unroll
        for (int bj = 0; bj < 2; ++bj) {
            const size_t off = (size_t)(row0 + (i >> 2) * 128 + (i & 3) * 16) * DM + col0 + bj * 128;
            xb[bj][0] = *(const pg8::f32x4*)(x + off); xb[bj][1] = *(const pg8::f32x4*)(x + off + 4);
        }
    }
    __device__ __forceinline__ void procr(const pg8::f32x4 (&acc)[2][2][4][2], const pg8::f32x4 (&xb)[2][2], int row0, int col0, int i, int pn, int wc, int fq) const {
        const int ai = i >> 2, m = i & 3;
        const int row = row0 + ai * 128 + m * 16; float ss = 0.f;
#pragma unroll
        for (int bj = 0; bj < 2; ++bj) {
            const size_t off = (size_t)row * DM + col0 + bj * 128;
            const pg8::f32x4 v0 = acc[ai][bj][m][0] + xb[bj][0], v1 = acc[ai][bj][m][1] + xb[bj][1];
            ss += (v0[0] * v0[0] + v0[1] * v0[1]) + (v0[2] * v0[2] + v0[3] * v0[3]) + (v1[0] * v1[0] + v1[1] * v1[1]) + (v1[2] * v1[2] + v1[3] * v1[3]);
            pg8::u32x4 w; w.x = pg8::cvt_pk_bf16(v0[0], v0[1]); w.y = pg8::cvt_pk_bf16(v0[2], v0[3]); w.z = pg8::cvt_pk_bf16(v1[0], v1[1]); w.w = pg8::cvt_pk_bf16(v1[2], v1[3]);
            *(pg8::u32x4*)(x1b + off) = w;
        }
        ss += __shfl_xor(ss, 16); ss += __shfl_xor(ss, 32);
        if (fq == 0) ssq[(size_t)row * 32 + pn * 4 + wc] = ss;
    }
    __device__ __forceinline__ void operator()(const pg8::f32x4 (&acc)[2][2][4][2], const pg8::Unit& u, int wr, int wc, int fr, int fq) const {
        const int row0 = u.pm * 256 + wr * 64 + fr, col0 = u.pn * 256 + wc * 32 + 8 * fq;
        pg8::f32x4 b0[2][2], b1[2][2], b2[2][2];
        loadr(b0, row0, col0, 0); loadr(b1, row0, col0, 1); loadr(b2, row0, col0, 2);
        procr(acc, b0, row0, col0, 0, u.pn, wc, fq); loadr(b0, row0, col0, 3);
        procr(acc, b1, row0, col0, 1, u.pn, wc, fq); loadr(b1, row0, col0, 4);
        procr(acc, b2, row0, col0, 2, u.pn, wc, fq); loadr(b2, row0, col0, 5);
        procr(acc, b0, row0, col0, 3, u.pn, wc, fq); loadr(b0, row0, col0, 6);
        procr(acc, b1, row0, col0, 4, u.pn, wc, fq); loadr(b1, row0, col0, 7);
        procr(acc, b2, row0, col0, 5, u.pn, wc, fq);
        procr(acc, b0, row0, col0, 6, u.pn, wc, fq);
        procr(acc, b1, row0, col0, 7, u.pn, wc, fq);
    }
};


#include <hip/hip_cooperative_groups.h>
namespace cg = cooperative_groups;

constexpr int NWAVES = 8, NTHREADS = 512;
constexpr size_t WS_X1Q = WS_Z + 300 * MiB, WS_XSC = WS_Z + 370 * MiB;
__device__ __forceinline__ int opaque_tid() { int t = threadIdx.x; asm volatile("" : "+v"(t)); return t; }
constexpr int LDS_BYTES = 163840;

struct Args {
    const float *x, *meta, *nmw, *w_in, *lamqk, *subln, *convw, *convb, *ib, *fb, *mnw, *w_out, *nfw_ffn, *w_q, *subkeys, *pu, *pv, *nfinal;
    float* out; unsigned char* ws;
};

#define LAS __attribute__((address_space(3)))
#define XB_TMO      128
#define XB_XCNT(j)  (256  + 64 * (j))
#define XB_XSUB(j)  (1280 + 64 * (j))
#define XB_XGEN(j)  (2304 + 64 * (j))
#define XB_TOP      3328
#define XB_TOPGEN   3392
#define XCD_BAR_WORDS 3456
#define XB_SPIN_CAP (1u << 18)

__device__ __forceinline__ unsigned xb_ld(unsigned* p)              { return __hip_atomic_load(p, __ATOMIC_RELAXED, __HIP_MEMORY_SCOPE_AGENT); }
__device__ __forceinline__ unsigned xb_add(unsigned* p, unsigned v) { return __hip_atomic_fetch_add(p, v, __ATOMIC_RELAXED, __HIP_MEMORY_SCOPE_AGENT); }
__device__ __forceinline__ unsigned xb_xcc_id() { return (unsigned)__builtin_amdgcn_s_getreg((3 << 11) | 20) & 0xFu; }
#define XB_SPIN(cond, bar) do { unsigned _sp = 0; while (cond) { __builtin_amdgcn_s_sleep(1); \
    if ((++_sp & 255u) == 0u) { if (xb_ld(&(bar)[XB_TMO])) break; if (_sp > XB_SPIN_CAP) { atomicAdd(&(bar)[XB_TMO], 1u); break; } } } } while (0)

struct XcdBarrier {
    unsigned* bar; unsigned x;
    volatile LAS unsigned* st;
};

__device__ __forceinline__ XcdBarrier xcd_barrier_post(unsigned* bar, volatile LAS unsigned* st) {
    XcdBarrier b; b.bar = bar; b.x = xb_xcc_id(); b.st = st;
    if (threadIdx.x == 0) (void)xb_add(&bar[XB_XCNT(b.x)], 1u);
    return b;
}
__device__ __forceinline__ void xcd_barrier_complete(unsigned* bar, unsigned x, unsigned& nloc, unsigned& nx) {
    const unsigned G = gridDim.x * gridDim.y * gridDim.z;
    unsigned sum, cnt, mine, sp = 0u;
    for (;;) {
        sum = 0u; cnt = 0u; mine = 0u;
#pragma unroll
        for (unsigned j = 0; j < 16; ++j) { const unsigned c = xb_ld(&bar[XB_XCNT(j)]); sum += c; cnt += (c > 0u) ? 1u : 0u; mine = (j == x) ? c : mine; }
        if (sum == G) break;
        __builtin_amdgcn_s_sleep(1);
        if ((++sp & 255u) == 0u) { if (xb_ld(&bar[XB_TMO])) break; if (sp > XB_SPIN_CAP) { atomicAdd(&bar[XB_TMO], 1u); break; } }
    }
    nloc = mine > 0u ? mine : 1u; nx = cnt > 0u ? cnt : 1u;
}

__device__ __forceinline__ void xcd_barrier(const XcdBarrier& b) {
    asm volatile("s_waitcnt vmcnt(0)" ::: "memory");
    __syncthreads();
    if (threadIdx.x == 0) {
        unsigned* bar = b.bar;
        __builtin_amdgcn_s_waitcnt(0);
        unsigned nloc = b.st[0], nx = b.st[1];
        if (nloc == 0u) { xcd_barrier_complete(bar, b.x, nloc, nx); b.st[0] = nloc; b.st[1] = nx; }
        const unsigned old = xb_add(&bar[XB_XSUB(b.x)], 1u);
        const unsigned gen = old / nloc;
        if (old + 1u == (gen + 1u) * nloc) {
            __builtin_amdgcn_fence(__ATOMIC_RELEASE, "agent");
            asm volatile("s_waitcnt vmcnt(0)" ::: "memory");
            const unsigned og = xb_add(&bar[XB_TOP], 1u);
            const unsigned tg = og / nx;
            if (og + 1u == (tg + 1u) * nx) xb_add(&bar[XB_TOPGEN], 1u);
            else XB_SPIN(xb_ld(&bar[XB_TOPGEN]) == tg, bar);
            __builtin_amdgcn_fence(__ATOMIC_ACQUIRE, "agent");
            xb_add(&bar[XB_XGEN(b.x)], 1u);
            asm volatile("s_waitcnt vmcnt(0)" ::: "memory");
        } else {
            XB_SPIN(xb_ld(&bar[XB_XGEN(b.x)]) == gen, bar);
            __builtin_amdgcn_fence(__ATOMIC_ACQUIRE, "agent");
            asm volatile("s_waitcnt vmcnt(0)" ::: "memory");
        }
    }
    __syncthreads();
}

constexpr int CW_BAR = 0, CW_QUEUE = 4096;
constexpr int LDS_MISC = LDS_BYTES - 256;
__device__ __forceinline__ int next_item(unsigned* ctr, volatile LAS unsigned* slot) {
    __syncthreads();
    if (threadIdx.x == 0) *slot = __hip_atomic_fetch_add(ctr, 1u, __ATOMIC_RELAXED, __HIP_MEMORY_SCOPE_AGENT);
    __syncthreads();
    return (int)*slot;
}

__device__ __forceinline__ void transpose_item(const float* W, int ldw, int K, int N, bf16_t* WT, bool ropeperm, float* scr, int item, int lane, const float* kscale = nullptr) {
    const int nblk = N / 32, kb = item / nblk, nb = item % nblk, k0 = 64 * kb, n0 = 32 * nb;
#pragma unroll 8
    for (int i = 0; i < 32; ++i) { const int kk = 2 * i + (lane >> 5); scr[kk * 33 + (lane & 31)] = W[(size_t)(k0 + kk) * ldw + n0 + (lane & 31)] * (kscale ? kscale[k0 + kk] : 1.f); }
    __builtin_amdgcn_s_waitcnt(0xC07F); asm volatile("" ::: "memory");
    const int c = lane & 7;
#pragma unroll
    for (int j = 0; j < 4; ++j) {
        const int n = (lane >> 3) + 8 * j; const float* s = scr + (8 * c) * 33 + n;
        uint4 o; o.x = pk2(s[0 * 33], s[1 * 33]); o.y = pk2(s[2 * 33], s[3 * 33]); o.z = pk2(s[4 * 33], s[5 * 33]); o.w = pk2(s[6 * 33], s[7 * 33]);
        int orow = n0 + n;
        if (ropeperm && n0 < 2048) orow = (n0 & ~63) + 2 * n + ((n0 >> 5) & 1);
        *(uint4*)(WT + (size_t)orow * K + k0 + 8 * c) = o;
    }
    __builtin_amdgcn_s_waitcnt(0xC07F); asm volatile("" ::: "memory");
}

__device__ __forceinline__ void hn_row(const Args& a, bf16_t* HN, float* G, const float* WG, int r, const f32x4 (&v)[8], int lane) {
    float ss = 0.f;
#pragma unroll
    for (int j = 0; j < 8; ++j) ss += (v[j][0] * v[j][0] + v[j][1] * v[j][1]) + (v[j][2] * v[j][2] + v[j][3] * v[j][3]);
    const float rstd = rsqrtf(wave_sum(ss) * (1.f / DM) + EPS);
    float g[8];
#pragma unroll
    for (int k = 0; k < 8; ++k) g[k] = 0.f;
    unsigned long long* o8 = (unsigned long long*)(HN + (size_t)r * DM) + lane;
#pragma unroll
    for (int j = 0; j < 8; ++j) {
        const f32x4 w = ((const f32x4*)a.nmw)[64 * j + lane];
        const f32x4 y = v[j] * rstd * w;
        o8[64 * j] = (unsigned long long)pk2(y[0], y[1]) | ((unsigned long long)pk2(y[2], y[3]) << 32);
#pragma unroll
        for (int k = 0; k < 8; ++k) { const f32x4 wg = ((const f32x4*)(WG + k * 2048))[64 * j + lane]; g[k] += (y[0] * wg[0] + y[1] * wg[1]) + (y[2] * wg[2] + y[3] * wg[3]); }
        __builtin_amdgcn_sched_barrier(0);
    }
    float r4[4], r2[2], r1;
    { const bool hb = (lane & 32) != 0;
#pragma unroll
      for (int i = 0; i < 4; ++i) { const float send = hb ? g[i] : g[i + 4]; const float recv = __shfl_xor(send, 32); r4[i] = (hb ? g[i + 4] : g[i]) + recv; } }
    { const bool hb = (lane & 16) != 0;
#pragma unroll
      for (int i = 0; i < 2; ++i) { const float send = hb ? r4[i] : r4[i + 2]; const float recv = __shfl_xor(send, 16); r2[i] = (hb ? r4[i + 2] : r4[i]) + recv; } }
    { const bool hb = (lane & 8) != 0; const float send = hb ? r2[0] : r2[1]; const float recv = __shfl_xor(send, 8); r1 = (hb ? r2[1] : r2[0]) + recv; }
    r1 += __shfl_xor(r1, 4); r1 += __shfl_xor(r1, 2); r1 += __shfl_xor(r1, 1);
    if ((lane & 7) == 0) G[(size_t)r * 8 + ((lane >> 5) & 1) * 4 + ((lane >> 4) & 1) * 2 + ((lane >> 3) & 1)] = r1;
}

__device__ __forceinline__ void phase_prep(const Args& a, unsigned char* lds, int bid, int nb) {
    const int tid = opaque_tid(), lane = tid & 63, wave = tid >> 6;
    const int gw = bid * NWAVES + wave, NGW = nb * NWAVES;
    unsigned char* ws = a.ws;
    bf16_t* WinT = (bf16_t*)(ws + WS_WIN); bf16_t* WoutT = (bf16_t*)(ws + WS_WOUT); bf16_t* WqT = (bf16_t*)(ws + WS_WQ);
    bf16_t* U = (bf16_t*)(ws + WS_U); bf16_t* V = (bf16_t*)(ws + WS_V); bf16_t* HN = (bf16_t*)(ws + WS_HN);
    float* G = (float*)(ws + WS_GATES); float* rope = (float*)(ws + WS_ROPE);
    float* scr = (float*)lds + wave * (64 * 33);
    float* WG = (float*)(lds + 8 * 64 * 33 * 4);
    for (int i = tid; i < 8 * 2048; i += NTHREADS) { const int k = i >> 3, g = i & 7; WG[g * 2048 + k] = a.w_in[(size_t)k * INCOLS + 6144 + g]; }
    __syncthreads();
    constexpr int I_IN = 32 * 192, I_OUT = 32 * 64, I_Q = 32 * 64;
    for (int it = gw; it < I_IN + I_OUT + I_Q; it += NGW) {
        int r = it;
        if (r < I_IN) { transpose_item(a.w_in, INCOLS, 2048, 6144, WinT, true, scr, r, lane); continue; } r -= I_IN;
        if (r < I_OUT) { transpose_item(a.w_out, 2048, 2048, 2048, WoutT, false, scr, r, lane); continue; } r -= I_OUT;
        transpose_item(a.w_q, 2048, 2048, 2048, WqT, false, scr, r, lane, a.nfw_ffn);
    }
    {
        f32x4 vc[8], vn[8];
#pragma unroll
        for (int j = 0; j < 8; ++j) vc[j] = ((const f32x4*)(a.x + (size_t)gw * DM))[64 * j + lane];
        for (int r = gw; r < TREAL; r += NGW) {
            const int rn = r + NGW < TREAL ? r + NGW : r;
#pragma unroll
            for (int j = 0; j < 8; ++j) vn[j] = ((const f32x4*)(a.x + (size_t)rn * DM))[64 * j + lane];
            hn_row(a, HN, G, WG, r, vc, lane);
#pragma unroll
            for (int j = 0; j < 8; ++j) vc[j] = vn[j];
        }
    }
    for (int r = TREAL + gw; r < MROWS; r += NGW) {
        if (r >= META_ROW0 && r < META_ROW0 + NMETA) {
            f32x4 vm[8];
#pragma unroll
            for (int j = 0; j < 8; ++j) vm[j] = ((const f32x4*)(a.meta + (size_t)(r - META_ROW0) * DM))[64 * j + lane];
            hn_row(a, HN, G, WG, r, vm, lane);
        } else {
            unsigned long long* o8 = (unsigned long long*)(HN + (size_t)r * DM) + lane;
#pragma unroll
            for (int j = 0; j < 8; ++j) o8[64 * j] = 0ull;
            if (lane < 8) G[(size_t)r * 8 + lane] = 0.f;
        }
    }
    { bf16_t* SKB = (bf16_t*)(ws + WS_SKB);
      for (int i = bid * NTHREADS + tid; i < 8 * 2 * 128 * 128 / 2; i += nb * NTHREADS) { const float2 v = ((const float2*)a.subkeys)[i]; ((unsigned*)SKB)[i] = pk2(v.x, v.y); } }
    for (int i = bid * NTHREADS + tid; i < (SEQ + NMETA) * 32; i += nb * NTHREADS) {
        const int pos = i >> 5, j = i & 31;
        const float inv = (float)pow(10000.0, -(double)j / 32.0);
        const float ang = (float)pos * inv;
        rope[2 * i] = (float)cos((double)ang); rope[2 * i + 1] = (float)sin((double)ang);
    }
}


constexpr int CW_QTAB = 4096 + 1024, TAB_ITEMS = 2 * 16384 / 16;
__device__ __forceinline__ void phase_tables(const Args& a, unsigned char* lds, unsigned* ctl) {
    const int tid = opaque_tid(), lane = tid & 63, wave = __builtin_amdgcn_readfirstlane(tid >> 6);
    unsigned char* ws = a.ws;
    volatile LAS unsigned* slot = (volatile LAS unsigned*)((LAS unsigned char*)lds + LDS_MISC) + 2;
    for (;;) {
        const int item = next_item(ctl + CW_QTAB, slot);
        if (item >= TAB_ITEMS) break;
        const int rr = item * 16 + wave;
    {
        unsigned* U8 = (unsigned*)(ws + WS_U); unsigned* V8 = (unsigned*)(ws + WS_V); float* ISC = (float*)(ws + WS_ISC);
        {
            f32x4 v[2][8]; float am[2];
#pragma unroll
            for (int q = 0; q < 2; ++q) {
                const int r = rr + q * 8; const bool isu = r < 16384; const int e = r & 16383;
                const f32x4* xr = (const f32x4*)((isu ? a.pu : a.pv) + (size_t)e * DM) + lane;
#pragma unroll
                for (int j = 0; j < 8; ++j) v[q][j] = xr[64 * j];
            }
#pragma unroll
            for (int q = 0; q < 2; ++q) if (rr + q * 8 < 16384) {
#pragma unroll
                for (int j = 0; j < 8; ++j) v[q][j] = v[q][j] * ((const f32x4*)a.nfw_ffn)[64 * j + lane]; }
#pragma unroll
            for (int q = 0; q < 2; ++q) { float t = 0.f;
#pragma unroll
                for (int j = 0; j < 8; ++j) t = fmaxf(t, fmaxf(fmaxf(fabsf(v[q][j][0]), fabsf(v[q][j][1])), fmaxf(fabsf(v[q][j][2]), fabsf(v[q][j][3]))));
                am[q] = t; }
#pragma unroll
            for (int o = 1; o < 64; o <<= 1) { am[0] = fmaxf(am[0], __shfl_xor(am[0], o)); am[1] = fmaxf(am[1], __shfl_xor(am[1], o)); }
#pragma unroll
            for (int q = 0; q < 2; ++q) {
                const int r = rr + q * 8; const bool isu = r < 16384; const int e = r & 16383;
                const float top = isu ? 127.f : 256.f;
                const float sc = am[q] > 0.f ? top / am[q] : 0.f;
                unsigned* o8 = isu ? U8 : V8;
#pragma unroll
                for (int j = 0; j < 8; ++j) { int w;
                    if (isu) { const int q0 = (int)rintf(v[q][j][0] * sc), q1 = (int)rintf(v[q][j][1] * sc), q2 = (int)rintf(v[q][j][2] * sc), q3 = (int)rintf(v[q][j][3] * sc);
                        w = (int)((unsigned)(q0 & 255) | ((unsigned)(q1 & 255) << 8) | ((unsigned)(q2 & 255) << 16) | ((unsigned)q3 << 24)); }
                    else { w = __builtin_amdgcn_cvt_pk_fp8_f32(v[q][j][0] * sc, v[q][j][1] * sc, 0, false); w = __builtin_amdgcn_cvt_pk_fp8_f32(v[q][j][2] * sc, v[q][j][3] * sc, w, true); }
                    o8[((size_t)j * 16384 + e) * 64 + lane] = (unsigned)w; }
                if (lane == 0) ISC[(isu ? 0 : 16384) + e] = am[q] / top;
            }
        }
    }
    }
}

namespace att {
using bf16x8 = __attribute__((ext_vector_type(8))) short;
using s16x4 = __attribute__((ext_vector_type(4))) short;
using f32x16 = __attribute__((ext_vector_type(16))) float;
using u32x4 = __attribute__((ext_vector_type(4))) unsigned;
constexpr int SHM_V = 16384, SHM_K = 16384;
constexpr int L_V = 0, L_K = 2 * SHM_V, L_WS = L_K + 2 * SHM_K, L_P = L_WS + 8 * 64 * 4, L_END = L_P + 4 * 4096;
#define KSWZ(row, colB) ((row) * 256 + ((colB) ^ (((row) & 7) << 4)))
#define SBAR() __builtin_amdgcn_sched_barrier(0)
__device__ __forceinline__ int crow(int r, int hi) { return (r & 3) + 8 * (r >> 2) + 4 * hi; }
__device__ __forceinline__ unsigned cvtpk(float lo, float hi) { unsigned r; asm volatile("v_cvt_pk_bf16_f32 %0, %1, %2" : "=v"(r) : "v"(lo), "v"(hi)); return r; }
__device__ __forceinline__ int v_st(int k, int c) { const int kk = (k & ~0xC) | ((k & 4) << 1) | ((k & 8) >> 1); return ((kk >> 3) * 4 + (c >> 5)) * 512 + ((kk & 7) * 32 + (c & 31)) * 2; }
__device__ __forceinline__ int v_rd_base(int lane) { return ((lane & 3) << 3) | (((lane >> 2) & 3) << 6) | (((lane >> 4) & 1) << 5) | (((lane >> 5) & 1) << 8); }
constexpr int v_rd_off(int d0, int ks, int half) { return d0 * 512 + ks * 4096 + half * 2048; }
template <int OFF> __device__ __forceinline__ s16x4 tr_read(int vb) { s16x4 r; asm volatile("ds_read_b64_tr_b16 %0, %1 offset:%2" : "=&v"(r) : "v"(vb), "i"(OFF) : "memory"); return r; }
template <int D0> __device__ __forceinline__ void pv_one(f32x16& od, int vb, bf16x8 pa0, bf16x8 pa1, bf16x8 pa2, bf16x8 pa3) {
    const s16x4 l0 = tr_read<v_rd_off(D0, 0, 0)>(vb), h0 = tr_read<v_rd_off(D0, 0, 1)>(vb), l1 = tr_read<v_rd_off(D0, 1, 0)>(vb), h1 = tr_read<v_rd_off(D0, 1, 1)>(vb);
    const s16x4 l2 = tr_read<v_rd_off(D0, 2, 0)>(vb), h2 = tr_read<v_rd_off(D0, 2, 1)>(vb), l3 = tr_read<v_rd_off(D0, 3, 0)>(vb), h3 = tr_read<v_rd_off(D0, 3, 1)>(vb);
    asm volatile("s_waitcnt lgkmcnt(0)" ::: "memory"); SBAR();
#define PK(L, H) (bf16x8){L[0], L[1], L[2], L[3], H[0], H[1], H[2], H[3]}
    od = __builtin_amdgcn_mfma_f32_32x32x16_bf16(pa0, PK(l0, h0), od, 0, 0, 0);
    od = __builtin_amdgcn_mfma_f32_32x32x16_bf16(pa1, PK(l1, h1), od, 0, 0, 0);
    od = __builtin_amdgcn_mfma_f32_32x32x16_bf16(pa2, PK(l2, h2), od, 0, 0, 0);
    od = __builtin_amdgcn_mfma_f32_32x32x16_bf16(pa3, PK(l3, h3), od, 0, 0, 0);
#undef PK
}
__device__ __forceinline__ void qkt(f32x16& p0, f32x16& p1, const char* Ks, const bf16x8* qr, int r32, int hi, int comp) {
    p0 = f32x16{}; p1 = f32x16{};
#pragma unroll
    for (int d0 = 0; d0 < 4; ++d0) {
        const int cb = (comp * 64 + d0 * 16 + hi * 8) * 2;
        const bf16x8 b0 = *reinterpret_cast<const bf16x8*>(Ks + KSWZ(r32, cb));
        const bf16x8 b1 = *reinterpret_cast<const bf16x8*>(Ks + KSWZ(32 + r32, cb));
        p0 = __builtin_amdgcn_mfma_f32_32x32x16_bf16(b0, qr[d0], p0, 0, 0, 0);
        p1 = __builtin_amdgcn_mfma_f32_32x32x16_bf16(b1, qr[d0], p1, 0, 0, 0);
    }
}

__device__ __forceinline__ void attn_unit(int b, int h, int qb, const bf16_t* Z, bf16_t* MIX, float lam, const float* subln, char* lds) {
    const int tid = opaque_tid(), wid = __builtin_amdgcn_readfirstlane(tid >> 6), lane = tid & 63, r32 = lane & 31, hi = lane >> 5;
    const int comp = wid >> 2, rg = wid & 3;
    char* V_lds = lds + L_V; char* K_lds = lds + L_K;
    float* wsf = (float*)(lds + L_WS) + wid * 64;
    const int q0 = b * SEQ + qb * 128;
    const float NEGV = -1e30f;
    bf16x8 qr[4];
    {
        const bf16_t* Qw = Z + (size_t)(q0 + rg * 32 + r32) * NZ + ZQ + h * 128 + comp * 64 + hi * 8;
#pragma unroll
        for (int d0 = 0; d0 < 4; ++d0) qr[d0] = *reinterpret_cast<const bf16x8*>(Qw + d0 * 16);
    }
    const int NT = 2 * qb + 3;
    const int sr = tid >> 4, sc = (tid & 15) * 8;
    const int vst0 = v_st(sr, sc), vst1 = v_st(32 + sr, sc), kst0 = KSWZ(sr, sc * 2), kst1 = KSWZ(32 + sr, sc * 2);
    const int vb0 = (int)(uintptr_t)V_lds + v_rd_base(lane);
#define PK4(P, BASE, OUT) do { unsigned a0 = cvtpk(P[BASE + 0], P[BASE + 1]), a1 = cvtpk(P[BASE + 2], P[BASE + 3]); \
        unsigned b0 = cvtpk(P[BASE + 4], P[BASE + 5]), b1 = cvtpk(P[BASE + 6], P[BASE + 7]); \
        auto r0 = __builtin_amdgcn_permlane32_swap(a0, b0, false, false); auto r1 = __builtin_amdgcn_permlane32_swap(a1, b1, false, false); \
        u32x4 w = {r0[0], r1[0], r0[1], r1[1]}; OUT = *reinterpret_cast<bf16x8*>(&w); } while (0)
    bf16x8 vsA0, vsA1, ksA0, ksA1, vsB0, vsB1, ksB0, ksB1;
#define SLOAD(j, S) do { const size_t r0_ = (size_t)((j) == 0 ? META_TILE0 : b * SEQ + ((j) - 1) * 64) + sr; const bf16_t* zp_ = Z + r0_ * NZ + h * 128 + sc; \
        vs##S##0 = *reinterpret_cast<const bf16x8*>(zp_ + ZV); vs##S##1 = *reinterpret_cast<const bf16x8*>(zp_ + ZV + (size_t)32 * NZ); \
        ks##S##0 = *reinterpret_cast<const bf16x8*>(zp_ + ZK); ks##S##1 = *reinterpret_cast<const bf16x8*>(zp_ + ZK + (size_t)32 * NZ); } while (0)
#define SWRITE(bi, S) do { *reinterpret_cast<bf16x8*>(V_lds + (bi) * SHM_V + vst0) = vs##S##0; *reinterpret_cast<bf16x8*>(V_lds + (bi) * SHM_V + vst1) = vs##S##1; \
        *reinterpret_cast<bf16x8*>(K_lds + (bi) * SHM_K + kst0) = ks##S##0; *reinterpret_cast<bf16x8*>(K_lds + (bi) * SHM_K + kst1) = ks##S##1; } while (0)
    f32x16 o[4] = {}; float m_reg = NEGV, l_reg = 0.f;
    SLOAD(0, A); SWRITE(0, A); SLOAD(1, B); __syncthreads();
    const int qrel = rg * 32 + r32;
#define ATT_TILE(j, L_, W_) do { \
        const int cur = j & 1; \
        if (j + 2 < NT) SLOAD(j + 2, L_); \
        f32x16 p0, p1; \
        qkt(p0, p1, K_lds + cur * SHM_K, qr, r32, hi, comp); \
        if (j == 0) { \
    _Pragma("unroll") \
            for (int r = 0; r < 16; ++r) { p0[r] = NEGV; if (r < 8) p1[r] = NEGV; } \
        } else if (j >= NT - 2) { \
            const int kb0 = (j - (NT - 2)) * 64; \
    _Pragma("unroll") \
            for (int r = 0; r < 16; ++r) { const int kl = kb0 + crow(r, hi); if (kl > qrel) p0[r] = NEGV; if (kl + 32 > qrel) p1[r] = NEGV; } \
        } \
        float pmax = p0[0]; \
    _Pragma("unroll") \
        for (int r = 1; r < 16; ++r) pmax = fmaxf(pmax, p0[r]); \
    _Pragma("unroll") \
        for (int r = 0; r < 16; ++r) pmax = fmaxf(pmax, p1[r]); \
        { auto rr = __builtin_amdgcn_permlane32_swap(__float_as_uint(pmax), __float_as_uint(pmax), false, false); pmax = fmaxf(__uint_as_float(rr[0]), __uint_as_float(rr[1])); } \
        const float mn = fmaxf(m_reg, pmax); const float alpha = __builtin_amdgcn_exp2f(m_reg - mn); m_reg = mn; \
        float ps = 0.f; \
    _Pragma("unroll") \
        for (int r = 0; r < 16; ++r) { p0[r] = __builtin_amdgcn_exp2f(p0[r] - mn); ps += p0[r]; } \
    _Pragma("unroll") \
        for (int r = 0; r < 16; ++r) { p1[r] = __builtin_amdgcn_exp2f(p1[r] - mn); ps += p1[r]; } \
        { auto rr = __builtin_amdgcn_permlane32_swap(__float_as_uint(ps), __float_as_uint(ps), false, false); ps = __uint_as_float(rr[0]) + __uint_as_float(rr[1]); } \
        l_reg = l_reg * alpha + ps; \
        if (__any(alpha < 1.f)) { \
            if (hi == 0) wsf[r32] = alpha; \
            asm volatile("s_waitcnt lgkmcnt(0)" ::: "memory"); \
            float al[16]; \
    _Pragma("unroll") \
            for (int r = 0; r < 16; ++r) al[r] = wsf[crow(r, hi)]; \
    _Pragma("unroll") \
            for (int d = 0; d < 4; ++d) \
    _Pragma("unroll") \
                for (int r = 0; r < 16; ++r) o[d][r] *= al[r]; \
            asm volatile("s_waitcnt lgkmcnt(0)" ::: "memory"); \
        } \
        bf16x8 pa0, pa1, pa2, pa3; \
        PK4(p0, 0, pa0); PK4(p0, 8, pa1); PK4(p1, 0, pa2); PK4(p1, 8, pa3); \
        SBAR(); \
        { const int vb = vb0 + cur * SHM_V; \
          pv_one<0>(o[0], vb, pa0, pa1, pa2, pa3); pv_one<1>(o[1], vb, pa0, pa1, pa2, pa3); pv_one<2>(o[2], vb, pa0, pa1, pa2, pa3); pv_one<3>(o[3], vb, pa0, pa1, pa2, pa3); } \
        if (j + 1 < NT) SWRITE(cur ^ 1, W_); \
        __syncthreads(); \
    } while (0)
    for (int j = 0; j < NT; j += 2) { ATT_TILE(j, A, B); if (j + 1 < NT) ATT_TILE(j + 1, B, A); }
#undef ATT_TILE
#undef SLOAD
#undef SWRITE
#undef PK4
    if (hi == 0) wsf[r32] = l_reg;
    asm volatile("s_waitcnt lgkmcnt(0)" ::: "memory");
    float rli[16];
#pragma unroll
    for (int r = 0; r < 16; ++r) rli[r] = __builtin_amdgcn_rcpf(wsf[crow(r, hi)]);
    float* X = (float*)lds + rg * 4096;
    if (comp == 1) {
#pragma unroll
        for (int d0 = 0; d0 < 4; ++d0)
#pragma unroll
            for (int r = 0; r < 16; ++r) X[(d0 * 16 + r) * 64 + lane] = o[d0][r] * rli[r] * lam;
    }
    __syncthreads();
    if (comp == 0) {
        float ssr[16];
#pragma unroll
        for (int r = 0; r < 16; ++r) ssr[r] = 0.f;
#pragma unroll
        for (int d0 = 0; d0 < 4; ++d0)
#pragma unroll
            for (int r = 0; r < 16; ++r) { const float v = o[d0][r] * rli[r] - X[(d0 * 16 + r) * 64 + lane]; o[d0][r] = v; ssr[r] += v * v; }
        float* P = (float*)(lds + L_P) + rg * 1024;
#pragma unroll
        for (int r = 0; r < 16; ++r) P[r * 64 + lane] = ssr[r];
        asm volatile("s_waitcnt lgkmcnt(0)" ::: "memory");
        {
            const int rho = lane & 31, hh = (rho >> 2) & 1, rr = (rho & 3) + 4 * (rho >> 3);
            const float4* pp = (const float4*)(P + rr * 64 + hh * 32 + (lane >> 5) * 16);
            const float4 a0 = pp[0], a1 = pp[1], a2 = pp[2], a3 = pp[3];
            float s = ((a0.x + a0.y) + (a0.z + a0.w)) + ((a1.x + a1.y) + (a1.z + a1.w)) + ((a2.x + a2.y) + (a2.z + a2.w)) + ((a3.x + a3.y) + (a3.z + a3.w));
            auto sw = __builtin_amdgcn_permlane32_swap(__float_as_uint(s), __float_as_uint(s), false, false); s = __uint_as_float(sw[0]) + __uint_as_float(sw[1]);
            if (lane < 32) wsf[32 + rho] = rsqrtf(s * (1.f / 128.f) + EPS) * (1.f - LAMBDA_INIT);
        }
        asm volatile("s_waitcnt lgkmcnt(0)" ::: "memory");
        float sw4[4];
#pragma unroll
        for (int d0 = 0; d0 < 4; ++d0) sw4[d0] = subln[d0 * 32 + r32];
        bf16_t* Ow = MIX + (size_t)(q0 + rg * 32) * DM + h * 128 + r32;
#pragma unroll
        for (int r = 0; r < 16; ++r) {
            const int orow = crow(r, hi); const float rs = wsf[32 + orow];
#pragma unroll
            for (int d0 = 0; d0 < 4; ++d0) Ow[(size_t)orow * DM + d0 * 32] = (bf16_t)f2bf(o[d0][r] * rs * sw4[d0]);
        }
    }
    __syncthreads();
}
#undef KSWZ
#undef SBAR
}

__device__ __forceinline__ float attn_lambda(const Args& a) {
    const int lane = opaque_tid() & 63;
    const float l1 = wave_sum(a.lamqk[lane] * a.lamqk[64 + lane]), l2 = wave_sum(a.lamqk[128 + lane] * a.lamqk[192 + lane]);
    return expf(l1) - expf(l2) + LAMBDA_INIT;
}
namespace mls {
using bf16x8 = __attribute__((ext_vector_type(8))) short;
using bf16x4 = __attribute__((ext_vector_type(4))) short;
using s16x4 = __attribute__((ext_vector_type(4))) short;
using f32x16 = __attribute__((ext_vector_type(16))) float;
using f32x4v = __attribute__((ext_vector_type(4))) float;
using u32x4v = __attribute__((ext_vector_type(4))) unsigned;
using u32x2v = __attribute__((ext_vector_type(2))) unsigned;
constexpr int L_QS = 0, L_QP = 16384, L_KS = 32768, L_KW = 49152, L_VT = 65536, L_PT = 98304, L_HT = 106496, HT_STRIDE = 528;
constexpr int L_MISC = L_HT + 64 * HT_STRIDE;
constexpr int L_RS = L_MISC, L_QN = L_RS + 2 * 64 * 4, L_NV = L_QN + 64 * 4, L_NP = L_NV + 128 * 4, L_CW = L_NP + 8 * 128 * 4, L_RD = L_CW + 5 * 256 * 4, L_NW = L_RD + 8 * 64 * 4, L_END = L_NW + 8 * 36 * 4;
#define KSWZ(row, colB) ((row) * 256 + ((colB) ^ (((row) & 7) << 4)))
#define PSWZ(row, colB) ((row) * 128 + ((colB) ^ ((((row) >> 1) & 7) << 4)))
__device__ __forceinline__ int crow(int r, int hi) { return (r & 3) + 8 * (r >> 2) + 4 * hi; }
__device__ __forceinline__ unsigned cvtpk(float lo, float hi) { unsigned r; asm volatile("v_cvt_pk_bf16_f32 %0, %1, %2" : "=v"(r) : "v"(lo), "v"(hi)); return r; }
__device__ __forceinline__ int v_st(int k, int c) { const int kk = (k & ~0xC) | ((k & 4) << 1) | ((k & 8) >> 1); return ((kk >> 3) * 4 + (c >> 5)) * 512 + ((kk & 7) * 32 + (c & 31)) * 2; }
__device__ __forceinline__ int v_rd_base(int lane) { return ((lane & 3) << 3) | (((lane >> 2) & 3) << 6) | (((lane >> 4) & 1) << 5) | (((lane >> 5) & 1) << 8); }
__device__ __forceinline__ s16x4 tr_read_dyn(int addr) { s16x4 r; asm volatile("ds_read_b64_tr_b16 %0, %1" : "=&v"(r) : "v"(addr) : "memory"); return r; }
__device__ __forceinline__ bf16x8 tr_frag(int img_plus_base, int d0, int ks) {
    const s16x4 lo = tr_read_dyn(img_plus_base + d0 * 512 + ks * 4096), hi = tr_read_dyn(img_plus_base + d0 * 512 + ks * 4096 + 2048);
    return (bf16x8){lo[0], lo[1], lo[2], lo[3], hi[0], hi[1], hi[2], hi[3]};
}
template <int CTRL, int RMASK> __device__ __forceinline__ float dppf(float old, float v) { return __builtin_bit_cast(float, __builtin_amdgcn_update_dpp(__builtin_bit_cast(int, old), __builtin_bit_cast(int, v), CTRL, RMASK, 0xf, false)); }
__device__ __forceinline__ float scan_add(float v) {
    v += dppf<0x111, 0xf>(0.f, v); v += dppf<0x112, 0xf>(0.f, v); v += dppf<0x114, 0xf>(0.f, v); v += dppf<0x118, 0xf>(0.f, v);
    v += dppf<0x142, 0xa>(0.f, v); v += dppf<0x143, 0xc>(0.f, v); return v;
}
__device__ __forceinline__ float scan_max(float v) {
    const float NI = -3.0e38f;
    v = fmaxf(v, dppf<0x111, 0xf>(NI, v)); v = fmaxf(v, dppf<0x112, 0xf>(NI, v)); v = fmaxf(v, dppf<0x114, 0xf>(NI, v)); v = fmaxf(v, dppf<0x118, 0xf>(NI, v));
    v = fmaxf(v, dppf<0x142, 0xa>(NI, v)); v = fmaxf(v, dppf<0x143, 0xc>(NI, v)); return v;
}
__device__ __forceinline__ float rlane(float v, int l) { return __uint_as_float(__builtin_amdgcn_readlane(__float_as_uint(v), l)); }
__device__ __forceinline__ float silu(float x) { return x * __builtin_amdgcn_rcpf(1.f + __expf(-x)); }
__device__ __forceinline__ void fmac_v(float& y, float a, float b) { asm("v_fmac_f32 %0, %1, %2" : "+v"(y) : "v"(a), "v"(b)); }
__device__ __forceinline__ float mul_v(float a, float b) { float r; asm("v_mul_f32 %0, %1, %2" : "=v"(r) : "v"(a), "v"(b)); return r; }

__device__ __forceinline__ void mlstm_item(int b, int h, const Args& a, char* lds) {
    const int tid0 = opaque_tid(), wid = __builtin_amdgcn_readfirstlane(tid0 >> 6);
    const bf16_t* Z = (const bf16_t*)(a.ws + WS_Z); const float* G = (const float*)(a.ws + WS_GATES); bf16_t* MIX = (bf16_t*)(a.ws + WS_MIX);
    const int ldsb = (int)(uintptr_t)lds;
    float* RS = (float*)(lds + L_RS); float* QN = (float*)(lds + L_QN); float* NV = (float*)(lds + L_NV); float* NP = (float*)(lds + L_NP); float* CW = (float*)(lds + L_CW);
    for (int i = tid0; i < 5 * 256; i += NTHREADS) { const int j = i >> 8, c = i & 255; const int cc = c < 128 ? h * 128 + c : 512 + h * 128 + (c - 128); CW[i] = j < 4 ? a.convw[j * 1024 + cc] : a.convb[cc]; }
    if (tid0 < 128) NV[tid0] = 0.f;
    if (tid0 < 256) ((float*)(lds + L_NW))[(tid0 >> 5) * 36 + (tid0 & 31)] = a.mnw[h * 256 + tid0];
    const float ibh = a.ib[h], fbh = a.fb[h];
    float cw[4][4], cb[4];
    __syncthreads();
    { const int c4 = 4 * (tid0 & 63);
#pragma unroll
    for (int j = 0; j < 4; ++j)
#pragma unroll
        for (int q = 0; q < 4; ++q) cw[j][q] = CW[j * 256 + c4 + q];
#pragma unroll
    for (int q = 0; q < 4; ++q) cb[q] = CW[4 * 256 + c4 + q]; }
    f32x16 C[4] = {};
    float m_prev = -1e30f;
    u32x2v rq[11]; u32x4v rv[4]; float gi, gf;
    auto chunk_row0 = [&](int c) -> int { return c == 0 ? META_TILE0 : b * SEQ + (c - 1) * 64; };
#define LOAD_RAW(c) do { int tq_ = tid0; asm volatile("" : "+v"(tq_)); const int ln_ = tq_ & 63, c4_ = 4 * ln_, zc_qk = (c4_ < 128 ? ZMQ + h * 128 + c4_ : ZMK + h * 128 + (c4_ - 128)), erow = tq_ >> 3, eseg = tq_ & 7; const int r0_ = chunk_row0(c); \
        _Pragma("unroll") for (int i_ = 0; i_ < 11; ++i_) { const int t_ = 8 * wid - 3 + i_; int row_; bool ok_ = true; \
            if (t_ >= 0) row_ = r0_ + t_; else if ((c) == 0) { row_ = 0; ok_ = false; } else if ((c) == 1) row_ = META_TILE0 + 64 + t_; else row_ = r0_ + t_; \
            rq[i_] = ok_ ? *(const u32x2v*)(Z + (size_t)row_ * NZ + zc_qk) : (u32x2v){0u, 0u}; } \
        _Pragma("unroll") for (int i_ = 0; i_ < 4; ++i_) rv[i_] = *(const u32x4v*)(Z + (size_t)(r0_ + erow) * NZ + ZMV + h * 256 + eseg * 32 + 8 * i_); \
        { const int rowg_ = r0_ + ln_; gi = G[(size_t)rowg_ * 8 + h]; gf = G[(size_t)rowg_ * 8 + 4 + h]; } } while (0)
    LOAD_RAW(0);
    const int NCH = 33;
    for (int c = 0; c < NCH; ++c) {
        int tid = tid0; asm volatile("" : "+v"(tid));
        const int lane = tid & 63, r32 = lane & 31, hi = lane >> 5, cq = lane, c4 = 4 * cq, erow = tid >> 3, eseg = tid & 7;
        float* RD = (float*)(lds + L_RD) + wid * 64;
        float li = gi + ibh; float lf; { const float xf = gf + fbh; lf = fminf(xf, 0.f) - __logf(1.f + __expf(-fabsf(xf))); }
        if (c == 0 && lane < 48) { li = -1e30f; lf = 0.f; }
        const float bsum = scan_add(lf);
        const float u = li - bsum;
        const float cm = scan_max(u);
        const float Mrow = fmaxf(cm, m_prev);
        const float iw = __expf(m_prev - Mrow);
        const float Mend = rlane(Mrow, 63), gtot = rlane(bsum, 63);
        const float wrow = __expf(u - Mend);
        const float dec = __expf(m_prev - Mend);
        const float dexp = __expf(-(bsum + Mrow));
        {
            float qn_part[8], ksum[4] = {0.f, 0.f, 0.f, 0.f};
            float nvv[4];
#pragma unroll
            for (int q = 0; q < 4; ++q) nvv[q] = (cq < 32) ? NV[c4 + q] : 0.f;
#pragma unroll
            for (int i = 0; i < 8; ++i) {
                const int t = 8 * wid + i;
                float xo[4];
#pragma unroll
                for (int q = 0; q < 4; ++q) xo[q] = cb[q];
#pragma unroll
                for (int j = 0; j < 4; ++j) {
                    const u32x2v rr = rq[i + j];
                    fmac_v(xo[0], cw[j][0], bf_lo(rr.x)); fmac_v(xo[1], cw[j][1], bf_hi(rr.x)); fmac_v(xo[2], cw[j][2], bf_lo(rr.y)); fmac_v(xo[3], cw[j][3], bf_hi(rr.y));
                }
#pragma unroll
                for (int q = 0; q < 4; ++q) xo[q] = silu(xo[q]);
                const float iw_t = rlane(iw, t), w_t = rlane(wrow, t);
                if (cq < 32) {
#pragma unroll
                    for (int q = 0; q < 4; ++q) xo[q] = mul_v(xo[q], 0.08838834764831845f);
                    *(uint2*)(lds + L_QS + KSWZ(t, c4 * 2)) = make_uint2(cvtpk(xo[0], xo[1]), cvtpk(xo[2], xo[3]));
                    float qd = 0.f;
#pragma unroll
                    for (int q = 0; q < 4; ++q) { fmac_v(qd, xo[q], nvv[q]); xo[q] = mul_v(xo[q], iw_t); }
                    *(uint2*)(lds + L_QP + KSWZ(t, c4 * 2)) = make_uint2(cvtpk(xo[0], xo[1]), cvtpk(xo[2], xo[3]));
                    qn_part[i] = iw_t * qd;
                } else {
                    const int kc = c4 - 128;
                    *(uint2*)(lds + L_KS + KSWZ(t, kc * 2)) = make_uint2(cvtpk(xo[0], xo[1]), cvtpk(xo[2], xo[3]));
#pragma unroll
                    for (int q = 0; q < 4; ++q) { xo[q] = mul_v(xo[q], w_t); ksum[q] += xo[q]; }
                    *(uint2*)(lds + L_KW + v_st(t, kc)) = make_uint2(cvtpk(xo[0], xo[1]), cvtpk(xo[2], xo[3]));
                    qn_part[i] = 0.f;
                }
                __builtin_amdgcn_sched_barrier(0);
            }
            {
                float r4[4], r2[2], r1;
                { const bool hb = (lane & 16) != 0;
#pragma unroll
                  for (int i = 0; i < 4; ++i) { const float send = hb ? qn_part[i] : qn_part[i + 4]; const float recv = __shfl_xor(send, 16); r4[i] = (hb ? qn_part[i + 4] : qn_part[i]) + recv; } }
                { const bool hb = (lane & 8) != 0;
#pragma unroll
                  for (int i = 0; i < 2; ++i) { const float send = hb ? r4[i] : r4[i + 2]; const float recv = __shfl_xor(send, 8); r2[i] = (hb ? r4[i + 2] : r4[i]) + recv; } }
                { const bool hb = (lane & 4) != 0; const float send = hb ? r2[0] : r2[1]; const float recv = __shfl_xor(send, 4); r1 = (hb ? r2[1] : r2[0]) + recv; }
                r1 += __shfl_xor(r1, 2); r1 += __shfl_xor(r1, 1);
                if (lane < 32 && (lane & 3) == 0) QN[8 * wid + ((lane >> 4) & 1) * 4 + ((lane >> 3) & 1) * 2 + ((lane >> 2) & 1)] = r1;
            }
            if (cq >= 32) {
#pragma unroll
                for (int q = 0; q < 4; ++q) NP[wid * 128 + (c4 - 128) + q] = ksum[q];
            }
#pragma unroll
            for (int i = 0; i < 4; ++i) *(u32x4v*)(lds + L_VT + (eseg >> 2) * 16384 + v_st(erow, (eseg & 3) * 32 + 8 * i)) = rv[i];
        }
        u32x4v zo[4];
        {
            const int r0 = chunk_row0(c);
#pragma unroll
            for (int i = 0; i < 4; ++i) zo[i] = *(const u32x4v*)(Z + (size_t)(r0 + erow) * NZ + ZMO + h * 256 + eseg * 32 + 8 * i);
        }
        if (c + 1 < NCH) LOAD_RAW(c + 1);
        __syncthreads();
        {
            const int tb = wid >> 1, half = wid & 1;
            float rsum[4] = {0.f, 0.f, 0.f, 0.f};
            const int fr = lane & 15, fq = lane >> 4;
            float Mt[4];
#pragma unroll
            for (int i = 0; i < 4; ++i) Mt[i] = __shfl(Mrow, 16 * tb + 4 * fq + i);
#pragma unroll
            for (int sj = 0; sj < 2; ++sj) {
                const int sb = 2 * half + sj;
                unsigned short pw[4] = {0, 0, 0, 0};
                if (sb <= tb) {
                    f32x4v acc = {0.f, 0.f, 0.f, 0.f};
#pragma unroll
                    for (int ks = 0; ks < 4; ++ks) {
                        const bf16x8 af = *(const bf16x8*)(lds + L_QS + KSWZ(16 * tb + fr, (32 * ks + 8 * fq) * 2));
                        const bf16x8 bfr = *(const bf16x8*)(lds + L_KS + KSWZ(16 * sb + fr, (32 * ks + 8 * fq) * 2));
                        acc = __builtin_amdgcn_mfma_f32_16x16x32_bf16(af, bfr, acc, 0, 0, 0);
                    }
                    const int s = 16 * sb + fr; const float us = __shfl(u, s);
#pragma unroll
                    for (int i = 0; i < 4; ++i) {
                        const int t = 16 * tb + 4 * fq + i;
                        const float p = (s <= t) ? acc[i] * __expf(us - Mt[i]) : 0.f;
                        rsum[i] += p; pw[i] = (unsigned short)f2bf(p);
                    }
                }
#pragma unroll
                for (int i = 0; i < 4; ++i) *(unsigned short*)(lds + L_PT + PSWZ(16 * tb + 4 * fq + i, (16 * sb + fr) * 2)) = pw[i];
            }
#pragma unroll
            for (int i = 0; i < 4; ++i) {
                float v = rsum[i];
                v += __shfl_xor(v, 1); v += __shfl_xor(v, 2); v += __shfl_xor(v, 4); v += __shfl_xor(v, 8);
                if (fr == 0) RS[half * 64 + 16 * tb + 4 * fq + i] = v;
            }
        }
        __syncthreads();
        {
            const float nq = RS[lane] + RS[64 + lane] + QN[lane];
            RD[lane] = __builtin_amdgcn_rcpf(fmaxf(fabsf(nq), dexp));
            bf16x8 vf[4];
            const int vimg = ldsb + L_VT + (wid >> 2) * 16384 + v_rd_base(lane);
#pragma unroll
            for (int ks = 0; ks < 4; ++ks) vf[ks] = tr_frag(vimg, wid & 3, ks);
            asm volatile("s_waitcnt lgkmcnt(0)" ::: "memory"); __builtin_amdgcn_sched_barrier(0);
            f32x16 acc[2] = {};
#pragma unroll
            for (int rb = 0; rb < 2; ++rb) {
                const int row = 32 * rb + r32;
#pragma unroll
                for (int ks = 0; ks < 4; ++ks) {
                    if (rb == 0 && ks >= 2) continue;
                    const bf16x8 pf = *(const bf16x8*)(lds + L_PT + PSWZ(row, (16 * ks + 8 * hi) * 2));
                    acc[rb] = __builtin_amdgcn_mfma_f32_32x32x16_bf16(pf, vf[ks], acc[rb], 0, 0, 0);
                }
            }
#pragma unroll
            for (int kb = 0; kb < 4; ++kb)
#pragma unroll
                for (int sp = 0; sp < 2; ++sp) {
                    bf16x8 cf; { unsigned w0 = cvtpk(C[kb][8 * sp + 0], C[kb][8 * sp + 1]), w1 = cvtpk(C[kb][8 * sp + 2], C[kb][8 * sp + 3]), w2 = cvtpk(C[kb][8 * sp + 4], C[kb][8 * sp + 5]), w3 = cvtpk(C[kb][8 * sp + 6], C[kb][8 * sp + 7]);
                        typedef unsigned u32x4_ __attribute__((ext_vector_type(4))); u32x4_ ww = {w0, w1, w2, w3}; cf = __builtin_bit_cast(bf16x8, ww); }
                    const int base = 32 * kb + 16 * sp;
#pragma unroll
                    for (int rb = 0; rb < 2; ++rb) {
                        const int row = 32 * rb + r32;
                        const bf16x4 q0 = *(const bf16x4*)(lds + L_QP + KSWZ(row, (base + 4 * hi) * 2));
                        const bf16x4 q1 = *(const bf16x4*)(lds + L_QP + KSWZ(row, (base + 8 + 4 * hi) * 2));
                        const bf16x8 qf = {q0[0], q0[1], q0[2], q0[3], q1[0], q1[1], q1[2], q1[3]};
                        acc[rb] = __builtin_amdgcn_mfma_f32_32x32x16_bf16(qf, cf, acc[rb], 0, 0, 0);
                    }
                }
            asm volatile("s_waitcnt lgkmcnt(0)" ::: "memory");
#pragma unroll
            for (int rb = 0; rb < 2; ++rb)
#pragma unroll
                for (int r = 0; r < 16; ++r) {
                    const int row = 32 * rb + crow(r, hi);
                    *(unsigned short*)(lds + L_HT + row * HT_STRIDE + (32 * wid + r32) * 2) = (unsigned short)f2bf(acc[rb][r] * RD[row]);
                }
#pragma unroll
            for (int kb = 0; kb < 4; ++kb) {
#pragma unroll
                for (int r = 0; r < 16; ++r) C[kb][r] *= dec;
                const int kimg = ldsb + L_KW + v_rd_base(lane);
                bf16x8 kf[4];
#pragma unroll
                for (int ks = 0; ks < 4; ++ks) kf[ks] = tr_frag(kimg, kb, ks);
                asm volatile("s_waitcnt lgkmcnt(0)" ::: "memory"); __builtin_amdgcn_sched_barrier(0);
#pragma unroll
                for (int ks = 0; ks < 4; ++ks) C[kb] = __builtin_amdgcn_mfma_f32_32x32x16_bf16(kf[ks], vf[ks], C[kb], 0, 0, 0);
            }
            if (tid < 128) { float s = NV[tid] * dec;
#pragma unroll
                for (int w8 = 0; w8 < 8; ++w8) s += NP[w8 * 128 + tid];
                NV[tid] = s; }
        }
        m_prev = gtot + Mend;
        __syncthreads();
        if (c > 0) {
            float hv[32]; float ss = 0.f;
#pragma unroll
            for (int i = 0; i < 4; ++i) {
                const uint4 w = *(const uint4*)(lds + L_HT + erow * HT_STRIDE + eseg * 64 + 16 * i);
                hv[8 * i + 0] = bf_lo(w.x); hv[8 * i + 1] = bf_hi(w.x); hv[8 * i + 2] = bf_lo(w.y); hv[8 * i + 3] = bf_hi(w.y);
                hv[8 * i + 4] = bf_lo(w.z); hv[8 * i + 5] = bf_hi(w.z); hv[8 * i + 6] = bf_lo(w.w); hv[8 * i + 7] = bf_hi(w.w);
            }
#pragma unroll
            for (int i = 0; i < 32; ++i) ss += hv[i] * hv[i];
            ss += __shfl_xor(ss, 1); ss += __shfl_xor(ss, 2); ss += __shfl_xor(ss, 4);
            const float rstd = rsqrtf(ss * (1.f / 256.f) + EPS);
            const float* nw = (const float*)(lds + L_NW) + eseg * 36;
            bf16_t* op = MIX + (size_t)(chunk_row0(c) + erow) * DM + 1024 + h * 256 + eseg * 32;
#pragma unroll
            for (int i = 0; i < 4; ++i) {
                const unsigned zz[4] = {zo[i].x, zo[i].y, zo[i].z, zo[i].w};
                unsigned ow[4];
#pragma unroll
                for (int q = 0; q < 4; ++q) {
                    const float z0 = bf_lo(zz[q]), z1 = bf_hi(zz[q]);
                    const float o0 = hv[8 * i + 2 * q] * rstd * nw[8 * i + 2 * q] * __builtin_amdgcn_rcpf(1.f + __expf(-z0));
                    const float o1 = hv[8 * i + 2 * q + 1] * rstd * nw[8 * i + 2 * q + 1] * __builtin_amdgcn_rcpf(1.f + __expf(-z1));
                    ow[q] = pk2(o0, o1);
                }
                *(uint4*)(op + 8 * i) = make_uint4(ow[0], ow[1], ow[2], ow[3]);
            }
        }
    }
#undef LOAD_RAW
    __syncthreads();
}
#undef KSWZ
#undef PSWZ
}

namespace rt {
using bf16x8 = __attribute__((ext_vector_type(8))) short;
using f32x16 = __attribute__((ext_vector_type(16))) float;
#define CE(a, b) do { const unsigned x_ = (a), y_ = (b); (a) = x_ > y_ ? x_ : y_; (b) = x_ > y_ ? y_ : x_; } while (0)
#define SORT16_DESC(V) do { CE(V[0], V[1]); CE(V[2], V[3]); CE(V[0], V[2]); CE(V[1], V[3]); CE(V[1], V[2]); CE(V[4], V[5]); CE(V[6], V[7]); CE(V[4], V[6]); CE(V[5], V[7]); CE(V[5], V[6]); CE(V[0], V[4]); CE(V[2], V[6]); CE(V[2], V[4]); CE(V[1], V[5]); CE(V[3], V[7]); CE(V[3], V[5]); CE(V[1], V[2]); CE(V[3], V[4]); CE(V[5], V[6]); CE(V[8], V[9]); CE(V[10], V[11]); CE(V[8], V[10]); CE(V[9], V[11]); CE(V[9], V[10]); CE(V[12], V[13]); CE(V[14], V[15]); CE(V[12], V[14]); CE(V[13], V[15]); CE(V[13], V[14]); CE(V[8], V[12]); CE(V[10], V[14]); CE(V[10], V[12]); CE(V[9], V[13]); CE(V[11], V[15]); CE(V[11], V[13]); CE(V[9], V[10]); CE(V[11], V[12]); CE(V[13], V[14]); CE(V[0], V[8]); CE(V[4], V[12]); CE(V[4], V[8]); CE(V[2], V[10]); CE(V[6], V[14]); CE(V[6], V[10]); CE(V[2], V[4]); CE(V[6], V[8]); CE(V[10], V[12]); CE(V[1], V[9]); CE(V[5], V[13]); CE(V[5], V[9]); CE(V[3], V[11]); CE(V[7], V[15]); CE(V[7], V[11]); CE(V[3], V[5]); CE(V[7], V[9]); CE(V[11], V[13]); CE(V[1], V[2]); CE(V[3], V[4]); CE(V[5], V[6]); CE(V[7], V[8]); CE(V[9], V[10]); CE(V[11], V[12]); CE(V[13], V[14]); } while (0)
#define BMERGE16_DESC(V) do { CE(V[0], V[8]); CE(V[1], V[9]); CE(V[2], V[10]); CE(V[3], V[11]); CE(V[4], V[12]); CE(V[5], V[13]); CE(V[6], V[14]); CE(V[7], V[15]); CE(V[0], V[4]); CE(V[1], V[5]); CE(V[2], V[6]); CE(V[3], V[7]); CE(V[8], V[12]); CE(V[9], V[13]); CE(V[10], V[14]); CE(V[11], V[15]); CE(V[0], V[2]); CE(V[1], V[3]); CE(V[4], V[6]); CE(V[5], V[7]); CE(V[8], V[10]); CE(V[9], V[11]); CE(V[12], V[14]); CE(V[13], V[15]); CE(V[0], V[1]); CE(V[2], V[3]); CE(V[4], V[5]); CE(V[6], V[7]); CE(V[8], V[9]); CE(V[10], V[11]); CE(V[12], V[13]); CE(V[14], V[15]); } while (0)

#define TOP16(A, B) do { _Pragma("unroll") for (int i_ = 0; i_ < 16; ++i_) { const unsigned x_ = A[i_], y_ = B[15 - i_]; A[i_] = x_ > y_ ? x_ : y_; } BMERGE16_DESC(A); } while (0)
__device__ __forceinline__ unsigned ord_key(float f) { const unsigned u = __float_as_uint(f); return u ^ (((unsigned)((int)u >> 31)) | 0x80000000u); }
__device__ __forceinline__ float ord_val(unsigned k) { return __uint_as_float((k & 0x80000000u) ? (k ^ 0x80000000u) : ~k); }
__device__ __forceinline__ int crow(int r, int hi) { return (r & 3) + 8 * (r >> 2) + 4 * hi; }

__device__ __forceinline__ void route_item(int tb, int h, const bf16_t* QP, const bf16_t* SKB, const float* SSQ, int* IDX, float* GATE, int* scr, int lane_in) {
    int lane = lane_in; asm volatile("" : "+v"(lane));
    const int tok = lane & 31, hi = lane >> 5;
    const int row = tb * 32 + tok;
    float rstd;
    { const float4* sp = (const float4*)(SSQ + (size_t)row * 32); float s = 0.f;
#pragma unroll
      for (int i = 0; i < 8; ++i) { const float4 v = sp[i]; s += (v.x + v.y) + (v.z + v.w); }
      rstd = rsqrtf(s * (1.f / DM) + EPS); }
    unsigned top[2][16];
    bf16x8 qf[8], af[2][8];
    unsigned T[16];
#define RT_LOADQ(p_) do { const bf16_t* qp_ = QP + (size_t)row * DM + h * 256 + (p_) * 128 + hi * 8; \
        _Pragma("unroll") for (int ks = 0; ks < 8; ++ks) qf[ks] = *reinterpret_cast<const bf16x8*>(qp_ + ks * 16); } while (0)
#define RT_LOADK(b_, i_) do { const bf16_t* kp_ = SKB + ((size_t)((h * 2 + ((i_) >> 2)) * 128 + ((i_) & 3) * 32 + tok)) * 128 + hi * 8; \
        _Pragma("unroll") for (int ks = 0; ks < 8; ++ks) af[b_][ks] = *reinterpret_cast<const bf16x8*>(kp_ + ks * 16); } while (0)
    RT_LOADQ(0); RT_LOADK(0, 0);
#pragma unroll
    for (int i = 0; i < 8; ++i) {
        const int p = i >> 2, kb = i & 3;
        if (i + 1 < 8) RT_LOADK((i + 1) & 1, i + 1);
        f32x16 acc = {};
#pragma unroll
        for (int ks = 0; ks < 8; ++ks) acc = __builtin_amdgcn_mfma_f32_32x32x16_bf16(af[i & 1][ks], qf[ks], acc, 0, 0, 0);
        unsigned K[16];
#pragma unroll
        for (int r = 0; r < 16; ++r) { const int low = 127 - (32 * kb + (r & 3) + 8 * (r >> 2)) - 4 * hi; K[r] = (ord_key(acc[r]) & ~127u) | (unsigned)low; }
        if (i == 3) RT_LOADQ(1);
        SORT16_DESC(K);
        if (kb == 0) {
#pragma unroll
            for (int j = 0; j < 16; ++j) T[j] = K[j];
        } else { TOP16(T, K); }
        if (kb == 3) {
            unsigned O[16];
#pragma unroll
            for (int j = 0; j < 16; ++j) { auto rr = __builtin_amdgcn_permlane32_swap(T[j], T[j], false, false); O[j] = hi ? rr[0] : rr[1]; }
            TOP16(T, O);
#pragma unroll
            for (int j = 0; j < 16; ++j) top[p][j] = T[j];
        }
        __builtin_amdgcn_sched_barrier(0);
    }
#undef RT_LOADQ
#undef RT_LOADK
    float s1[16], s2[16];
#pragma unroll
    for (int i = 0; i < 16; ++i) {
        s1[i] = ord_val(top[0][i] & ~127u) * rstd; s2[i] = ord_val(top[1][i] & ~127u) * rstd;
        scr[i * 64 + lane] = 127 - (int)(top[0][i] & 127u); scr[(16 + i) * 64 + lane] = 127 - (int)(top[1][i] & 127u);
    }
#define CKEY(a_, b_) ((ord_key(s1[a_] + s2[b_]) & ~255u) | (unsigned)(255 - (16 * (a_) + (b_))))
    unsigned A[16], B[16], Cg[16];
#pragma unroll
    for (int b_ = 0; b_ < 16; ++b_) A[b_] = CKEY(0, b_);
#pragma unroll
    for (int b_ = 0; b_ < 8; ++b_) { B[b_] = CKEY(1, b_); B[8 + b_] = CKEY(15 - b_, 0); }
    BMERGE16_DESC(B);
    Cg[0] = CKEY(2, 0); Cg[1] = CKEY(2, 1); Cg[2] = CKEY(2, 2); Cg[3] = CKEY(2, 3); Cg[4] = CKEY(2, 4);
    Cg[5] = CKEY(3, 0); Cg[6] = CKEY(3, 1); Cg[7] = CKEY(3, 2); Cg[8] = CKEY(3, 3);
    Cg[9] = CKEY(4, 0); Cg[10] = CKEY(4, 1); Cg[11] = CKEY(4, 2);
    Cg[12] = CKEY(5, 0); Cg[13] = CKEY(5, 1); Cg[14] = CKEY(6, 0); Cg[15] = CKEY(6, 1);
    SORT16_DESC(Cg);
    { const unsigned d0 = CKEY(7, 0), d1 = CKEY(7, 1); Cg[15] = Cg[15] > d0 ? Cg[15] : d0; Cg[14] = Cg[14] > d1 ? Cg[14] : d1; BMERGE16_DESC(Cg); }
    TOP16(A, B); TOP16(A, Cg);
#undef CKEY
    asm volatile("s_waitcnt lgkmcnt(0)" ::: "memory");
    float e[16]; float z = 0.f; const float mx = ord_val(A[0] & ~255u);
#pragma unroll
    for (int j = 0; j < 16; ++j) { e[j] = __expf(ord_val(A[j] & ~255u) - mx); z += e[j]; }
    const float rz = 1.f / z;
    int* ip = IDX + (size_t)row * 128 + h * 16 + hi * 8; float* gp = GATE + (size_t)row * 128 + h * 16 + hi * 8;
    int oi[8] = {0, 0, 0, 0, 0, 0, 0, 0}; float og[8] = {0.f, 0.f, 0.f, 0.f, 0.f, 0.f, 0.f, 0.f};
#pragma unroll
    for (int j = 0; j < 16; ++j) {
        const int flat = 255 - (int)(A[j] & 255u), a_ = flat >> 4, b_ = flat & 15;
        const int ex = scr[a_ * 64 + lane] * 128 + scr[(16 + b_) * 64 + lane];
        if (j < 8) { if (!hi) { oi[j] = ex; og[j] = e[j] * rz; } } else { if (hi) { oi[j - 8] = ex; og[j - 8] = e[j] * rz; } }
    }
    *(int4*)(ip) = make_int4(oi[0], oi[1], oi[2], oi[3]); *(int4*)(ip + 4) = make_int4(oi[4], oi[5], oi[6], oi[7]);
    *(float4*)(gp) = make_float4(og[0], og[1], og[2], og[3]); *(float4*)(gp + 4) = make_float4(og[4], og[5], og[6], og[7]);
    asm volatile("s_waitcnt lgkmcnt(0)" ::: "memory");
}
#undef CE
#undef TOP16
}

__device__ __forceinline__ void phase_route(const Args& a, unsigned char* lds, int bid, int nb) {
    const int tid = opaque_tid(), wave = __builtin_amdgcn_readfirstlane(tid >> 6), lane = tid & 63;
    const bf16_t* QP = (const bf16_t*)(a.ws + WS_MIX); const bf16_t* SKB = (const bf16_t*)(a.ws + WS_SKB); const float* SSQ = (const float*)(a.ws + WS_SSQ);
    int* IDX = (int*)(a.ws + WS_IDX); float* GATE = (float*)(a.ws + WS_GATE);
    int* scr = (int*)lds + wave * 2048;
    {
        const bf16_t* X1W = (const bf16_t*)(a.ws + WS_HN); signed char* X1Q = (signed char*)(a.ws + WS_X1Q); float* XSC = (float*)(a.ws + WS_XSC);
        for (int row = bid * NWAVES + wave; row < TREAL; row += nb * NWAVES) {
            uint4 xr[4]; float am = 0.f;
#pragma unroll
            for (int j = 0; j < 4; ++j) { xr[j] = *(const uint4*)(X1W + (size_t)row * DM + 8 * lane + 512 * j);
                am = fmaxf(am, fmaxf(fmaxf(fmaxf(fabsf(bf_lo(xr[j].x)), fabsf(bf_hi(xr[j].x))), fmaxf(fabsf(bf_lo(xr[j].y)), fabsf(bf_hi(xr[j].y)))), fmaxf(fmaxf(fabsf(bf_lo(xr[j].z)), fabsf(bf_hi(xr[j].z))), fmaxf(fabsf(bf_lo(xr[j].w)), fabsf(bf_hi(xr[j].w)))))); }
            am = wave_max(am);
            const float sc = am > 0.f ? 127.f / am : 0.f;
#pragma unroll
            for (int j = 0; j < 4; ++j) {
                const unsigned ww[4] = {xr[j].x, xr[j].y, xr[j].z, xr[j].w}; unsigned o[2] = {0u, 0u};
#pragma unroll
                for (int q = 0; q < 4; ++q) { const int q0 = (int)rintf(bf_lo(ww[q]) * sc), q1 = (int)rintf(bf_hi(ww[q]) * sc); o[q >> 1] |= ((unsigned)(q0 & 255) | ((unsigned)(q1 & 255) << 8)) << (16 * (q & 1)); }
                *(uint2*)(X1Q + (size_t)row * DM + 8 * lane + 512 * j) = make_uint2(o[0], o[1]);
            }
            if (lane == 0) XSC[row] = am * (1.f / 127.f);
        }
    }
    for (int item = bid * NWAVES + wave; item < (TREAL / 32) * 8; item += nb * NWAVES) rt::route_item(item >> 3, item & 7, QP, SKB, SSQ, IDX, GATE, scr, lane);
}

constexpr int CW_QPV = 8192, CW_QPU = 8192 + 8 * 64;
constexpr int PX_ITEMS = TREAL / 64;
constexpr size_t WS_W = WS_Z + 4 * MiB, WS_PART = WS_Z + 32 * MiB, WS_Y = WS_Z + 160 * MiB;


template <int CTRL, int RMASK> __device__ __forceinline__ float dppf(float old, float v) { return __builtin_bit_cast(float, __builtin_amdgcn_update_dpp(__builtin_bit_cast(int, old), __builtin_bit_cast(int, v), CTRL, RMASK, 0xf, false)); }
template <int CTRL> __device__ __forceinline__ int dppi(int v) { return __builtin_amdgcn_update_dpp(0, v, CTRL, 0xf, 0xf, false); }
namespace pu2 {
typedef float f32x2v __attribute__((ext_vector_type(2)));
typedef unsigned u32x4v __attribute__((ext_vector_type(4)));
#define SBP() __builtin_amdgcn_sched_barrier(0)
#define PU_CHUNK_LD(dst, r_, q_) dst = __builtin_amdgcn_raw_buffer_load_b128(RI, g128, (r_) * 512 + (q_) * 16, 0)
#define PU_ROW_LD(buf, e_) buf = __builtin_amdgcn_raw_buffer_load_b128(U, (int)(e_) * 256 + c16, 0, 0)
#define PU_CONSUME(buf, I_) do { int s_ = __builtin_amdgcn_sdot4((int)buf[0], hq0, 0, false); s_ = __builtin_amdgcn_sdot4((int)buf[1], hq1, s_, false); \
    s_ = __builtin_amdgcn_sdot4((int)buf[2], hq2, s_, false); s_ = __builtin_amdgcn_sdot4((int)buf[3], hq3, s_, false); \
    s_ += dppi<0x128>(s_); s_ += dppi<0x124>(s_); s_ += dppi<0x122>(s_); s_ += dppi<0x121>(s_); \
    if ((I_) < 16) keep0 = (c == ((I_) & 15)) ? s_ : keep0; else keep1 = (c == ((I_) & 15)) ? s_ : keep1; } while (0)
#define PU_TOKEN_BODY(row_, nrow_, has_next_) do { \
    PU_CHUNK_LD(C7, row_, 7); \
    SBP(); PU_CONSUME(B0, 0); \
    PU_ROW_LD(B0, C2.x); \
    SBP(); PU_CONSUME(B1, 1); \
    PU_ROW_LD(B1, C2.y); \
    SBP(); PU_CONSUME(B2, 2); \
    PU_ROW_LD(B2, C2.z); \
    SBP(); PU_CONSUME(B3, 3); \
    PU_ROW_LD(B3, C2.w); \
    if (has_next_) PU_CHUNK_LD(C0, nrow_, 0); \
    SBP(); PU_CONSUME(B4, 4); \
    PU_ROW_LD(B4, C3.x); \
    SBP(); PU_CONSUME(B5, 5); \
    PU_ROW_LD(B5, C3.y); \
    SBP(); PU_CONSUME(B6, 6); \
    PU_ROW_LD(B6, C3.z); \
    SBP(); PU_CONSUME(B7, 7); \
    PU_ROW_LD(B7, C3.w); \
    if (has_next_) PU_CHUNK_LD(C1, nrow_, 1); \
    SBP(); PU_CONSUME(B0, 8); \
    PU_ROW_LD(B0, C4.x); \
    SBP(); PU_CONSUME(B1, 9); \
    PU_ROW_LD(B1, C4.y); \
    SBP(); PU_CONSUME(B2, 10); \
    PU_ROW_LD(B2, C4.z); \
    SBP(); PU_CONSUME(B3, 11); \
    PU_ROW_LD(B3, C4.w); \
    if (has_next_) PU_CHUNK_LD(C2, nrow_, 2); \
    SBP(); PU_CONSUME(B4, 12); \
    PU_ROW_LD(B4, C5.x); \
    SBP(); PU_CONSUME(B5, 13); \
    PU_ROW_LD(B5, C5.y); \
    SBP(); PU_CONSUME(B6, 14); \
    PU_ROW_LD(B6, C5.z); \
    SBP(); PU_CONSUME(B7, 15); \
    PU_ROW_LD(B7, C5.w); \
    if (has_next_) PU_CHUNK_LD(C3, nrow_, 3); \
    SBP(); PU_CONSUME(B0, 16); \
    PU_ROW_LD(B0, C6.x); \
    SBP(); PU_CONSUME(B1, 17); \
    PU_ROW_LD(B1, C6.y); \
    SBP(); PU_CONSUME(B2, 18); \
    PU_ROW_LD(B2, C6.z); \
    SBP(); PU_CONSUME(B3, 19); \
    PU_ROW_LD(B3, C6.w); \
    if (has_next_) PU_CHUNK_LD(C4, nrow_, 4); \
    SBP(); PU_CONSUME(B4, 20); \
    PU_ROW_LD(B4, C7.x); \
    SBP(); PU_CONSUME(B5, 21); \
    PU_ROW_LD(B5, C7.y); \
    SBP(); PU_CONSUME(B6, 22); \
    PU_ROW_LD(B6, C7.z); \
    SBP(); PU_CONSUME(B7, 23); \
    PU_ROW_LD(B7, C7.w); \
    if (has_next_) PU_CHUNK_LD(C5, nrow_, 5); \
    SBP(); PU_CONSUME(B0, 24); \
    if (has_next_) PU_ROW_LD(B0, C0.x); \
    SBP(); PU_CONSUME(B1, 25); \
    if (has_next_) PU_ROW_LD(B1, C0.y); \
    SBP(); PU_CONSUME(B2, 26); \
    if (has_next_) PU_ROW_LD(B2, C0.z); \
    SBP(); PU_CONSUME(B3, 27); \
    if (has_next_) PU_ROW_LD(B3, C0.w); \
    if (has_next_) PU_CHUNK_LD(C6, nrow_, 6); \
    SBP(); PU_CONSUME(B4, 28); \
    if (has_next_) PU_ROW_LD(B4, C1.x); \
    SBP(); PU_CONSUME(B5, 29); \
    if (has_next_) PU_ROW_LD(B5, C1.y); \
    SBP(); PU_CONSUME(B6, 30); \
    if (has_next_) PU_ROW_LD(B6, C1.z); \
    SBP(); PU_CONSUME(B7, 31); \
    if (has_next_) PU_ROW_LD(B7, C1.w); \
    } while (0)
#undef SBP
}

__device__ __forceinline__ void phase_pu(const Args& a, unsigned char* lds, unsigned* ctl, int xcc) {
    using namespace pu2;
#define SBP() __builtin_amdgcn_sched_barrier(0)
    const int tid = opaque_tid(), wave = __builtin_amdgcn_readfirstlane(tid >> 6), lane = tid & 63;
    volatile LAS unsigned* slot = (volatile LAS unsigned*)((LAS unsigned char*)lds + LDS_MISC) + 2;
    const signed char* X1Q = (const signed char*)(a.ws + WS_X1Q); float* PART = (float*)(a.ws + WS_PART);
    const __amdgpu_buffer_rsrc_t RI = __builtin_amdgcn_make_buffer_rsrc((void*)(a.ws + WS_IDX), (short)0, TREAL * 512, 0x00020000);
    for (int ss = 0; ss < 8; ++ss) {
        const int s = (xcc + ss) & 7;
        const __amdgpu_buffer_rsrc_t U = __builtin_amdgcn_make_buffer_rsrc((void*)(a.ws + WS_U + (size_t)s * (16384 * 256)), (short)0, 16384 * 256, 0x00020000);
        for (;;) {
            const int item = next_item(ctl + CW_QPU + 64 * s, slot);
            if (item >= PX_ITEMS) break;
            int ln = lane; asm volatile("" : "+v"(ln));
            const int g = ln >> 4, c = ln & 15, c16 = c * 16, g128 = g * 128;
            const int r0 = item * 64 + wave * 8;
            u32x4v C0, C1, C2, C3, C4, C5, C6, C7, B0, B1, B2, B3, B4, B5, B6, B7;
            PU_CHUNK_LD(C0, r0, 0); PU_CHUNK_LD(C1, r0, 1); PU_CHUNK_LD(C2, r0, 2); PU_CHUNK_LD(C3, r0, 3); PU_CHUNK_LD(C4, r0, 4); PU_CHUNK_LD(C5, r0, 5); PU_CHUNK_LD(C6, r0, 6);
            uint4 nxq = *(const uint4*)(X1Q + (size_t)r0 * DM + 256 * s + 16 * c);
            PU_ROW_LD(B0, C0.x); PU_ROW_LD(B1, C0.y); PU_ROW_LD(B2, C0.z); PU_ROW_LD(B3, C0.w); PU_ROW_LD(B4, C1.x); PU_ROW_LD(B5, C1.y); PU_ROW_LD(B6, C1.z); PU_ROW_LD(B7, C1.w);
#pragma unroll 1
            for (int t = 0; t < 8; ++t) {
                const int row = r0 + t, nrow = row + 1; const bool has_next = t < 7;
                const int hq0 = (int)nxq.x, hq1 = (int)nxq.y, hq2 = (int)nxq.z, hq3 = (int)nxq.w;
                if (has_next) nxq = *(const uint4*)(X1Q + (size_t)nrow * DM + 256 * s + 16 * c);
                int keep0 = 0, keep1 = 0;
                PU_TOKEN_BODY(row, nrow, has_next);
                float* pp = PART + (size_t)row * 1024 + s * 128 + 32 * g + c;
                pp[0] = (float)keep0; pp[16] = (float)keep1;
            }
        }
    }
#undef SBP
}
__device__ __forceinline__ void phase_pc(const Args& a, int bid, int nb) {
    const int tid = opaque_tid(), wave = __builtin_amdgcn_readfirstlane(tid >> 6), lane = tid & 63;
    const float* SSQ = (const float*)(a.ws + WS_SSQ); const int* IDX = (const int*)(a.ws + WS_IDX); const float* GATE = (const float*)(a.ws + WS_GATE);
    const float* ISC = (const float*)(a.ws + WS_ISC); const float* PART = (const float*)(a.ws + WS_PART); unsigned short* W16 = (unsigned short*)(a.ws + WS_W); float* WSC = (float*)(a.ws + WS_W + 12 * MiB);
    for (int row = bid * NWAVES + wave; row < TREAL; row += nb * NWAVES) {
        float ssv = lane < 32 ? SSQ[(size_t)row * 32 + lane] : 0.f; ssv = wave_sum(ssv);
        const float rstd = rsqrtf(ssv * (1.f / DM) + EPS);
        const float xsc = ((const float*)(a.ws + WS_XSC))[row];
        float wv[2];
#pragma unroll
        for (int k = 0; k < 2; ++k) {
            const int p = 64 * k + lane; float d = 0.f;
#pragma unroll
            for (int s = 0; s < 8; ++s) d += PART[(size_t)row * 1024 + s * 128 + p];
            const int e = IDX[(size_t)row * 128 + p];
            const float pre = d * rstd * ISC[e] * xsc;
            wv[k] = GATE[(size_t)row * 128 + p] * ISC[16384 + e] * (0.5f * pre * (1.f + erff(pre * 0.7071067811865476f)));
        }
        const float wmax = wave_max(fmaxf(fabsf(wv[0]), fabsf(wv[1])));
        const float wsc = wmax > 0.f ? 240.f / wmax : 0.f;
#pragma unroll
        for (int k = 0; k < 2; ++k) {
            const float ws = wv[k] * wsc;
            const int hi = __builtin_amdgcn_cvt_pk_fp8_f32(ws, 0.f, 0, false) & 255;
            const int lo = __builtin_amdgcn_cvt_pk_fp8_f32(ws - __builtin_amdgcn_cvt_f32_fp8(hi, 0), 0.f, 0, false) & 255;
            W16[(size_t)row * 128 + 64 * k + lane] = (unsigned short)(hi | (lo << 8));
        }
        if (lane == 0) WSC[row] = wmax * (1.f / 240.f);
    }
}
namespace pv2 {
typedef float f32x2v __attribute__((ext_vector_type(2)));
typedef unsigned u32x4v __attribute__((ext_vector_type(4))); typedef float f32x4v __attribute__((ext_vector_type(4)));
typedef unsigned u32x2v __attribute__((ext_vector_type(2)));
struct Chunk { u32x4v i; u32x2v w; };
#define SBP() __builtin_amdgcn_sched_barrier(0)
#define PV_CHUNK_LD(dst, r_, q_) do { dst.i = __builtin_bit_cast(u32x4v, __builtin_amdgcn_raw_buffer_load_b128(RI, g128, (r_) * 512 + (q_) * 16, 0)); dst.w = __builtin_bit_cast(u32x2v, __builtin_amdgcn_raw_buffer_load_b64(RW, g64, (r_) * 256 + (q_) * 8, 0)); } while (0)
#define PV_ROW_LD(buf, e_) buf = __builtin_amdgcn_raw_buffer_load_b128(V, (int)(e_) * 256 + c16, 0, 0)
#define PV_CONSUME(buf, ww_, S0_, S1_) do { const u32x2v b2_ = {__builtin_amdgcn_perm(0u, (ww_), (S0_)), __builtin_amdgcn_perm(0u, (ww_), (S1_))}; const long bb_ = __builtin_bit_cast(long, b2_); \
    const u32x2v a0_ = {buf[0], buf[1]}, a1_ = {buf[2], buf[3]}; \
    acc_lo = __builtin_amdgcn_mfma_f32_16x16x32_fp8_fp8(__builtin_bit_cast(long, a0_), bb_, acc_lo, 0, 0, 0); acc_hi = __builtin_amdgcn_mfma_f32_16x16x32_fp8_fp8(__builtin_bit_cast(long, a1_), bb_, acc_hi, 0, 0, 0); } while (0)
#define PV_TOKEN_BODY(row_, nrow_, has_next_) do { \
    PV_CHUNK_LD(C7, row_, 7); \
    SBP(); PV_CONSUME(B0, C0.w[0], sele0, sele1); \
    PV_ROW_LD(B0, C2.i.x); \
    SBP(); PV_CONSUME(B1, C0.w[0], selo0, selo1); \
    PV_ROW_LD(B1, C2.i.y); \
    SBP(); PV_CONSUME(B2, C0.w[1], sele0, sele1); \
    PV_ROW_LD(B2, C2.i.z); \
    SBP(); PV_CONSUME(B3, C0.w[1], selo0, selo1); \
    PV_ROW_LD(B3, C2.i.w); \
    if (has_next_) PV_CHUNK_LD(C0, nrow_, 0); \
    SBP(); PV_CONSUME(B4, C1.w[0], sele0, sele1); \
    PV_ROW_LD(B4, C3.i.x); \
    SBP(); PV_CONSUME(B5, C1.w[0], selo0, selo1); \
    PV_ROW_LD(B5, C3.i.y); \
    SBP(); PV_CONSUME(B6, C1.w[1], sele0, sele1); \
    PV_ROW_LD(B6, C3.i.z); \
    SBP(); PV_CONSUME(B7, C1.w[1], selo0, selo1); \
    PV_ROW_LD(B7, C3.i.w); \
    if (has_next_) PV_CHUNK_LD(C1, nrow_, 1); \
    SBP(); PV_CONSUME(B0, C2.w[0], sele0, sele1); \
    PV_ROW_LD(B0, C4.i.x); \
    SBP(); PV_CONSUME(B1, C2.w[0], selo0, selo1); \
    PV_ROW_LD(B1, C4.i.y); \
    SBP(); PV_CONSUME(B2, C2.w[1], sele0, sele1); \
    PV_ROW_LD(B2, C4.i.z); \
    SBP(); PV_CONSUME(B3, C2.w[1], selo0, selo1); \
    PV_ROW_LD(B3, C4.i.w); \
    if (has_next_) PV_CHUNK_LD(C2, nrow_, 2); \
    SBP(); PV_CONSUME(B4, C3.w[0], sele0, sele1); \
    PV_ROW_LD(B4, C5.i.x); \
    SBP(); PV_CONSUME(B5, C3.w[0], selo0, selo1); \
    PV_ROW_LD(B5, C5.i.y); \
    SBP(); PV_CONSUME(B6, C3.w[1], sele0, sele1); \
    PV_ROW_LD(B6, C5.i.z); \
    SBP(); PV_CONSUME(B7, C3.w[1], selo0, selo1); \
    PV_ROW_LD(B7, C5.i.w); \
    if (has_next_) PV_CHUNK_LD(C3, nrow_, 3); \
    SBP(); PV_CONSUME(B0, C4.w[0], sele0, sele1); \
    PV_ROW_LD(B0, C6.i.x); \
    SBP(); PV_CONSUME(B1, C4.w[0], selo0, selo1); \
    PV_ROW_LD(B1, C6.i.y); \
    SBP(); PV_CONSUME(B2, C4.w[1], sele0, sele1); \
    PV_ROW_LD(B2, C6.i.z); \
    SBP(); PV_CONSUME(B3, C4.w[1], selo0, selo1); \
    PV_ROW_LD(B3, C6.i.w); \
    if (has_next_) PV_CHUNK_LD(C4, nrow_, 4); \
    SBP(); PV_CONSUME(B4, C5.w[0], sele0, sele1); \
    PV_ROW_LD(B4, C7.i.x); \
    SBP(); PV_CONSUME(B5, C5.w[0], selo0, selo1); \
    PV_ROW_LD(B5, C7.i.y); \
    SBP(); PV_CONSUME(B6, C5.w[1], sele0, sele1); \
    PV_ROW_LD(B6, C7.i.z); \
    SBP(); PV_CONSUME(B7, C5.w[1], selo0, selo1); \
    PV_ROW_LD(B7, C7.i.w); \
    if (has_next_) PV_CHUNK_LD(C5, nrow_, 5); \
    SBP(); PV_CONSUME(B0, C6.w[0], sele0, sele1); \
    if (has_next_) PV_ROW_LD(B0, C0.i.x); \
    SBP(); PV_CONSUME(B1, C6.w[0], selo0, selo1); \
    if (has_next_) PV_ROW_LD(B1, C0.i.y); \
    SBP(); PV_CONSUME(B2, C6.w[1], sele0, sele1); \
    if (has_next_) PV_ROW_LD(B2, C0.i.z); \
    SBP(); PV_CONSUME(B3, C6.w[1], selo0, selo1); \
    if (has_next_) PV_ROW_LD(B3, C0.i.w); \
    if (has_next_) PV_CHUNK_LD(C6, nrow_, 6); \
    SBP(); PV_CONSUME(B4, C7.w[0], sele0, sele1); \
    if (has_next_) PV_ROW_LD(B4, C1.i.x); \
    SBP(); PV_CONSUME(B5, C7.w[0], selo0, selo1); \
    if (has_next_) PV_ROW_LD(B5, C1.i.y); \
    SBP(); PV_CONSUME(B6, C7.w[1], sele0, sele1); \
    if (has_next_) PV_ROW_LD(B6, C1.i.z); \
    SBP(); PV_CONSUME(B7, C7.w[1], selo0, selo1); \
    if (has_next_) PV_ROW_LD(B7, C1.i.w); \
    } while (0)
#undef SBP
}

__device__ __forceinline__ void phase_pv(const Args& a, unsigned char* lds, unsigned* ctl, int xcc) {
    using namespace pv2;
#define SBP() __builtin_amdgcn_sched_barrier(0)
    const int tid = opaque_tid(), wave = __builtin_amdgcn_readfirstlane(tid >> 6), lane = tid & 63;
    volatile LAS unsigned* slot = (volatile LAS unsigned*)((LAS unsigned char*)lds + LDS_MISC) + 2;
    bf16_t* Y = (bf16_t*)(a.ws + WS_Y); const float* WSC = (const float*)(a.ws + WS_W + 12 * MiB);
    const __amdgpu_buffer_rsrc_t RI = __builtin_amdgcn_make_buffer_rsrc((void*)(a.ws + WS_IDX), (short)0, TREAL * 512, 0x00020000);
    const __amdgpu_buffer_rsrc_t RW = __builtin_amdgcn_make_buffer_rsrc((void*)(a.ws + WS_W), (short)0, TREAL * 256, 0x00020000);
    float* ybuf = (float*)lds + wave * 256;
    for (int ss = 0; ss < 8; ++ss) {
        const int s = (xcc + ss) & 7;
        const __amdgpu_buffer_rsrc_t V = __builtin_amdgcn_make_buffer_rsrc((void*)(a.ws + WS_V + (size_t)s * (16384 * 256)), (short)0, 16384 * 256, 0x00020000);
        for (;;) {
            const int item = next_item(ctl + CW_QPV + 64 * s, slot);
            if (item >= PX_ITEMS) break;
            int ln = lane; asm volatile("" : "+v"(ln));
            const int g = ln >> 4, n = ln & 15, c16 = n * 16, g128 = g * 128, g64 = g * 64;
            const int r0 = item * 64 + wave * 8;
            unsigned sele0, sele1, selo0, selo1;
            { const unsigned sh = 8u * (unsigned)(n & 3), keep = ~(255u << sh), se = (unsigned)(n >> 3), so = 2u + se;
              const unsigned ve = (0x0c0c0c0cu & keep) | (se << sh), vo = (0x0c0c0c0cu & keep) | (so << sh);
              const bool d0 = (n & 4) == 0;
              sele0 = d0 ? ve : 0x0c0c0c0cu; sele1 = d0 ? 0x0c0c0c0cu : ve; selo0 = d0 ? vo : 0x0c0c0c0cu; selo1 = d0 ? 0x0c0c0c0cu : vo; }
            Chunk C0, C1, C2, C3, C4, C5, C6, C7; u32x4v B0, B1, B2, B3, B4, B5, B6, B7;
            const float wscv = WSC[r0 + (ln & 7)];
            PV_CHUNK_LD(C0, r0, 0); PV_CHUNK_LD(C1, r0, 1); PV_CHUNK_LD(C2, r0, 2); PV_CHUNK_LD(C3, r0, 3); PV_CHUNK_LD(C4, r0, 4); PV_CHUNK_LD(C5, r0, 5); PV_CHUNK_LD(C6, r0, 6);
            PV_ROW_LD(B0, C0.i.x); PV_ROW_LD(B1, C0.i.y); PV_ROW_LD(B2, C0.i.z); PV_ROW_LD(B3, C0.i.w); PV_ROW_LD(B4, C1.i.x); PV_ROW_LD(B5, C1.i.y); PV_ROW_LD(B6, C1.i.z); PV_ROW_LD(B7, C1.i.w);
#pragma unroll 1
            for (int t = 0; t < 8; ++t) {
                const int row = r0 + t, nrow = row + 1; const bool has_next = t < 7;
                f32x4v acc_lo = {0.f, 0.f, 0.f, 0.f}, acc_hi = {0.f, 0.f, 0.f, 0.f};
                PV_TOKEN_BODY(row, nrow, has_next);
                const float wsc = __uint_as_float(__builtin_amdgcn_readlane(__float_as_uint(wscv), t));
#pragma unroll
                for (int i = 0; i < 4; ++i) {
                    const float lo_ = acc_lo[i] + __uint_as_float(__builtin_amdgcn_update_dpp(0, __float_as_uint(acc_lo[i]), 0x128, 0xf, 0xf, false));
                    const float hi_ = acc_hi[i] + __uint_as_float(__builtin_amdgcn_update_dpp(0, __float_as_uint(acc_hi[i]), 0x128, 0xf, 0xf, false));
                    ybuf[16 * (4 * g + i) + n] = (n < 8 ? lo_ : hi_) * wsc;
                }
                asm volatile("s_waitcnt lgkmcnt(0)" ::: "memory");
                {
                    const float4 yv = ((const float4*)ybuf)[ln];
                    *(uint2*)(Y + (size_t)row * DM + 256 * s + 4 * ln) = make_uint2(pk2(yv.x, yv.y), pk2(yv.z, yv.w));
                }
                asm volatile("s_waitcnt lgkmcnt(0)" ::: "memory");
            }
        }
    }
#undef SBP
}
__device__ __forceinline__ void phase_pn(const Args& a, int bid, int nb) {
    const int tid = opaque_tid(), wave = __builtin_amdgcn_readfirstlane(tid >> 6), lane = tid & 63;
    const bf16_t* Y = (const bf16_t*)(a.ws + WS_Y); const bf16_t* X1 = (const bf16_t*)(a.ws + WS_HN);
    for (int row = bid * NWAVES + wave; row < TREAL; row += nb * NWAVES) {
        f32x4* p = (f32x4*)(a.out + (size_t)row * DM) + lane;
        const uint2* yp = (const uint2*)(Y + (size_t)row * DM) + lane; const uint2* xp = (const uint2*)(X1 + (size_t)row * DM) + lane;
        f32x4 v[8]; float ss = 0.f;
#pragma unroll
        for (int j = 0; j < 8; ++j) { const uint2 yy = yp[64 * j], xx = xp[64 * j];
            v[j][0] = bf_lo(xx.x) + bf_lo(yy.x); v[j][1] = bf_hi(xx.x) + bf_hi(yy.x); v[j][2] = bf_lo(xx.y) + bf_lo(yy.y); v[j][3] = bf_hi(xx.y) + bf_hi(yy.y);
            ss += (v[j][0] * v[j][0] + v[j][1] * v[j][1]) + (v[j][2] * v[j][2] + v[j][3] * v[j][3]); }
        const float r = rsqrtf(wave_sum(ss) * (1.f / DM) + EPS);
        const f32x4* wp = (const f32x4*)a.nfinal + lane;
#pragma unroll
        for (int j = 0; j < 8; ++j) p[64 * j] = v[j] * r * wp[64 * j];
    }
}

__device__ __forceinline__ void phase_mix(const Args& a, unsigned char* lds, unsigned* ctr) {
    const bf16_t* Z = (const bf16_t*)(a.ws + WS_Z); bf16_t* MIX = (bf16_t*)(a.ws + WS_MIX);
    volatile LAS unsigned* slot = (volatile LAS unsigned*)((LAS unsigned char*)lds + LDS_MISC) + 2;
    for (;;) {
        const int item = next_item(ctr, slot);
        if (item >= 64 + 2048) break;
        if (item < 64) mls::mlstm_item(item >> 2, item & 3, a, (char*)lds);
        else { const int k = item - 64, qb = 15 - (k >> 7), bh = k & 127; const float lam = attn_lambda(a); att::attn_unit(bh >> 3, bh & 7, qb, Z, MIX, lam, a.subln, (char*)lds); }
    }
}

__global__ void __launch_bounds__(NTHREADS, 2) mega(Args a) {
    extern __shared__ __attribute__((aligned(16))) unsigned char lds[];
    cg::grid_group grid = cg::this_grid();
    const int bid = blockIdx.x, nb = gridDim.x;
    unsigned char* ws = a.ws;
    bf16_t* WinT = (bf16_t*)(ws + WS_WIN); bf16_t* WoutT = (bf16_t*)(ws + WS_WOUT); bf16_t* WqT = (bf16_t*)(ws + WS_WQ);
    float* rope = (float*)(ws + WS_ROPE); float* SSQ = (float*)(ws + WS_SSQ);
    bf16_t* HN = (bf16_t*)(ws + WS_HN); bf16_t* MIX = (bf16_t*)(ws + WS_MIX); bf16_t* Z = (bf16_t*)(ws + WS_Z);

    volatile LAS unsigned* MISC = (volatile LAS unsigned*)((LAS unsigned char*)lds + LDS_MISC);
    if (threadIdx.x < 16) MISC[threadIdx.x] = 0u;
    __syncthreads();
    unsigned* ctl = (unsigned*)(ws + WS_CTL);
    XcdBarrier bar = xcd_barrier_post(ctl + CW_BAR, MISC);
    phase_prep(a, lds, bid, nb);
    grid.sync();
    { pg8::Gemm g{HN, WinT, MROWS, NZ, DM}; EpiZ E{Z, rope}; pg8::StaticOrder S; S.init(g.M, g.N, nb, bid);
      pg8::gemm_phase<EpiZ, pg8::StaticOrder, true, true>((PG8_LAS unsigned char*)lds, g, S, E); }
    phase_tables(a, lds, ctl);
    xcd_barrier(bar);
    phase_mix(a, lds, ctl + CW_QUEUE);
    xcd_barrier(bar);
    { pg8::Gemm g{MIX, WoutT, TREAL, DM, DM}; EpiX1 E{a.x, HN, SSQ}; pg8::StaticOrder S; S.init(g.M, g.N, nb, bid);
      pg8::gemm_phase<EpiX1, pg8::StaticOrder, true, true>((PG8_LAS unsigned char*)lds, g, S, E); }
    xcd_barrier(bar);
    { pg8::Gemm g{HN, WqT, TREAL, DM, DM}; pg8::EpiBf16<0> E{MIX, DM, nullptr, 0, 0, 1.f}; pg8::StaticOrder S; S.init(g.M, g.N, nb, bid);
      pg8::gemm_phase<pg8::EpiBf16<0>, pg8::StaticOrder, true, true>((PG8_LAS unsigned char*)lds, g, S, E); }
    xcd_barrier(bar);
    phase_route(a, lds, bid, nb);
    xcd_barrier(bar);
    { const int xcc = (int)(xb_xcc_id() & 7u);
      phase_pu(a, lds, ctl, xcc); xcd_barrier(bar);
      phase_pc(a, bid, nb); xcd_barrier(bar);
      phase_pv(a, lds, ctl, xcc); xcd_barrier(bar);
      phase_pn(a, bid, nb); }
}

extern "C" void kernel_launch(void* const* d_in, const int* in_sizes, int n_in, void* d_out, int out_size, void* d_ws, size_t ws_size, hipStream_t stream) {
    if (n_in != 18 || out_size != TREAL * DM || ws_size < WS_END) { fprintf(stderr, "kernel_launch: unexpected shapes n_in %d out %d ws %zu (need %zu)\n", n_in, out_size, ws_size, (size_t)WS_END); return; }
    static int grid_blocks = 0;
    if (!grid_blocks) {
        int dev = 0, cus = 0, per_cu = 0;
        (void)hipGetDevice(&dev);
        (void)hipDeviceGetAttribute(&cus, hipDeviceAttributeMultiprocessorCount, dev);
        (void)hipFuncSetAttribute((const void*)mega, hipFuncAttributeMaxDynamicSharedMemorySize, LDS_BYTES);
        (void)hipOccupancyMaxActiveBlocksPerMultiprocessor(&per_cu, (const void*)mega, NTHREADS, LDS_BYTES);
        if (per_cu < 1) { fprintf(stderr, "kernel_launch: occupancy query says %d blocks/CU\n", per_cu); per_cu = 1; }
        if (per_cu > 1) per_cu = 1;
        grid_blocks = cus * per_cu;
    }
    Args a{};
    a.x = (const float*)d_in[0]; a.meta = (const float*)d_in[1]; a.nmw = (const float*)d_in[2]; a.w_in = (const float*)d_in[3];
    a.lamqk = (const float*)d_in[4]; a.subln = (const float*)d_in[5]; a.convw = (const float*)d_in[6]; a.convb = (const float*)d_in[7];
    a.ib = (const float*)d_in[8]; a.fb = (const float*)d_in[9]; a.mnw = (const float*)d_in[10]; a.w_out = (const float*)d_in[11];
    a.nfw_ffn = (const float*)d_in[12]; a.w_q = (const float*)d_in[13]; a.subkeys = (const float*)d_in[14]; a.pu = (const float*)d_in[15];
    a.pv = (const float*)d_in[16]; a.nfinal = (const float*)d_in[17];
    a.out = (float*)d_out; a.ws = (unsigned char*)d_ws;
    (void)hipMemsetAsync((char*)d_ws + WS_CTL, 0, 65536, stream);
    void* kargs[] = {&a};
    const hipError_t e = hipLaunchCooperativeKernel((const void*)mega, dim3(grid_blocks), dim3(NTHREADS), kargs, LDS_BYTES, stream);
    if (e != hipSuccess) fprintf(stderr, "kernel_launch: cooperative launch failed: %s (grid %d)\n", hipGetErrorString(e), grid_blocks);
}
```

```cpp
#include <hip/hip_runtime.h>
#include <hip/hip_bf16.h>
#include <cstdio>
#include <cstdint>
#include <cmath>
namespace pg8 {
#define PG8_LAS __attribute__((address_space(3)))
typedef unsigned short bf16_t;
typedef short bf16x8 __attribute__((ext_vector_type(8)));
typedef float f32x4 __attribute__((ext_vector_type(4)));
typedef unsigned u32x4 __attribute__((ext_vector_type(4)));
constexpr int BM = 256, BK = 64, HALF = 128, HTB = HALF * BK * 2  , STAGE_BYTES = 8 * HTB, NXCD = 8, WGM = 8;

__host__ __device__ __forceinline__ int lds_byte(int r, int c) { const int st = (r >> 4) * 2 + (c >> 5), rr = r & 15, cc = c & 31, ob = rr * 64 + cc * 2; return st * 1024 + (ob ^ (((ob >> 9) & 1) << 5)); }
__host__ __device__ __forceinline__ void stage_rc(int b, int& R, int& C) { const int st = b / 1024, sb = b % 1024, swz = sb ^ (((sb >> 9) & 1) << 5); R = (st >> 1) * 16 + swz / 64; C = (st & 1) * 32 + (swz % 64) / 2; }
__host__ __device__ __forceinline__ int perm32(int rho) { const int n = rho >> 4, i = rho & 15; return 8 * (i >> 2) + 4 * n + (i & 3); }

struct Unit { int pm, pn; };
struct Gemm { const bf16_t* A; const bf16_t* Bt; int M, N, K; };

struct StaticOrder {
    int nM, nN, nwg, G, c;
    __host__ __device__ void init(int M, int N, int G_, int c_) { nM = M / BM; nN = N / BM; nwg = nM * nN; G = G_; c = c_; }
    __host__ __device__ bool next(int i, Unit& u) const {
        const long L = (long)i * G + c; if (L >= nwg) return false;
        int wgid = (int)L; { const int q = nwg / NXCD, r = nwg % NXCD, xcd = wgid % NXCD, off = wgid / NXCD; wgid = (xcd < r ? xcd * (q + 1) : r * (q + 1) + (xcd - r) * q) + off; }
        const int nig = WGM * nN, gid = wgid / nig, fm = gid * WGM, gsz = (nM - fm) < WGM ? (nM - fm) : WGM;
        u.pm = fm + ((wgid % nig) % gsz); u.pn = (wgid % nig) / gsz; return true;
    }
    __device__ __forceinline__ void a_ready(const Unit&) const {}
    __device__ __forceinline__ void done(const Unit&) const {}
};

__device__ __forceinline__ unsigned cvt_pk_bf16(float lo, float hi) { unsigned r; asm volatile("v_cvt_pk_bf16_f32 %0, %1, %2" : "=v"(r) : "v"(lo), "v"(hi)); return r; }
typedef float f32x2 __attribute__((ext_vector_type(2)));
__device__ __forceinline__ f32x2 gelu_pk(f32x2 v) {
    const f32x2 av = __builtin_elementwise_abs(v), d = av * 0.2316418882f + 1.0f;
    f32x2 t; t.x = __builtin_amdgcn_rcpf(d.x); t.y = __builtin_amdgcn_rcpf(d.y);
    f32x2 q = t * 0.5307027145f + (-0.7265760135f); q = q * t + 0.7107068705f; q = q * t + (-0.142248368f); q = q * t + 0.127414796f; q = q * t;
    const f32x2 s = (v * v) * (-0.72134752044f);
    f32x2 e; e.x = __builtin_amdgcn_exp2f(s.x); e.y = __builtin_amdgcn_exp2f(s.y);
    const f32x2 m = v * (q * e), r = v - m;
    f32x2 o; o.x = v.x < 0.f ? m.x : r.x; o.y = v.y < 0.f ? m.y : r.y; return o;
}

template <int ACT  > struct EpiBf16 {
    static constexpr bool PERM = true, AFTER_DRAIN = false; static_assert(ACT == 0 || ACT == 1, "EpiBf16: ACT is 0 (none) or 1 (gelu_pk)");
    bf16_t* O; int ldc; const float* bias; int split_cols; size_t split_stride; float scale0;
    __device__ __forceinline__ void operator()(const f32x4 (&acc)[2][2][4][2], const Unit& u, int wr, int wc, int fr, int fq) const {
        const int row0 = u.pm * BM + wr * 64 + fr; int colt = u.pn * BM; bf16_t* base = O;
        float sc = 1.f; if (split_cols) { const int t = colt / split_cols; base += (size_t)t * split_stride; colt -= t * split_cols; if (t == 0) sc = scale0; }
        const int col0 = colt + wc * 32 + 8 * fq, bcol0 = u.pn * BM + wc * 32 + 8 * fq;
        f32x4 bv[2][2];
#pragma unroll
        for (int bj = 0; bj < 2; ++bj)
#pragma unroll
            for (int n = 0; n < 2; ++n) bv[bj][n] = bias ? *(const f32x4*)(bias + bcol0 + bj * HALF + 4 * n) : (f32x4){0.f, 0.f, 0.f, 0.f};
#pragma unroll
        for (int ai = 0; ai < 2; ++ai)
#pragma unroll
            for (int m = 0; m < 4; ++m) { bf16_t* rowp = base + (size_t)(row0 + ai * HALF + m * 16) * ldc + col0;
#pragma unroll
                for (int bj = 0; bj < 2; ++bj) { f32x4 v0 = acc[ai][bj][m][0] + bv[bj][0], v1 = acc[ai][bj][m][1] + bv[bj][1];
                    if (ACT == 1) { f32x2 a = gelu_pk((f32x2){v0[0], v0[1]}), b = gelu_pk((f32x2){v0[2], v0[3]}), c = gelu_pk((f32x2){v1[0], v1[1]}), d = gelu_pk((f32x2){v1[2], v1[3]});
                        v0 = (f32x4){a.x, a.y, b.x, b.y}; v1 = (f32x4){c.x, c.y, d.x, d.y}; }
                    v0 = v0 * sc; v1 = v1 * sc; u32x4 w; w.x = cvt_pk_bf16(v0[0], v0[1]); w.y = cvt_pk_bf16(v0[2], v0[3]); w.z = cvt_pk_bf16(v1[0], v1[1]); w.w = cvt_pk_bf16(v1[2], v1[3]);
                    *(u32x4*)(rowp + bj * HALF) = w; } }
    }
};
template <class Epi, class Sched, bool ALIGN_EPI = false, bool SP2 = false>
__device__ __forceinline__ void gemm_phase(PG8_LAS unsigned char* lds, const Gemm g, const Sched& S, const Epi& E) {
    int tid_ = threadIdx.x; asm volatile("" : "+v"(tid_));
    const int tid = tid_, wid = __builtin_amdgcn_readfirstlane(tid >> 6), lane = tid & 63, wr = wid >> 2, wc = wid & 3, fr = lane & 15, fq = lane >> 4;
    const int K = g.K, nt = K / BK;
    unsigned voffA[2], voffB[2];
#pragma unroll
    for (int i = 0; i < 2; ++i) { int R, C; stage_rc(tid * 16 + i * 8192, R, C); const int Rb = Epi::PERM ? ((R & ~31) + perm32(R & 31)) : R;
        voffA[i] = (unsigned)(R * K + C) * 2u; voffB[i] = (unsigned)(Rb * K + C) * 2u; }
    const size_t kstep = (size_t)(BK * 2);
    const size_t hstep = (size_t)HALF * K * 2;
    const size_t tstep = 2 * hstep;
    const unsigned ldsw = (unsigned)wid * 1024u;
    const int aoff = lds_byte(wr * 64 + fr, fq * 8), boff = lds_byte(wc * 32 + fr, fq * 8);
#define PG8_SA(b, h) (((b) * 2 + (h)) * HTB)
#define PG8_SB(b, h) ((4 + (b) * 2 + (h)) * HTB)
#define PG8_STAGE(bufoff, gbase, voff) do { _Pragma("unroll") for (int _i = 0; _i < 2; ++_i) \
        __builtin_amdgcn_global_load_lds((const unsigned*)((const char*)(gbase) + (voff)[_i]), (PG8_LAS unsigned*)(lds + (bufoff) + ldsw + _i * 8192), 16, 0, 0); } while (0)
#define PG8_LDA(dst, b, h) do { _Pragma("unroll") for (int m = 0; m < 4; ++m) _Pragma("unroll") for (int k = 0; k < 2; ++k) dst[m][k] = *(const PG8_LAS bf16x8*)(lds + PG8_SA(b, h) + aoff + m * 2048 + k * 1024); } while (0)
#define PG8_LDB(dst, b, h) do { _Pragma("unroll") for (int n = 0; n < 2; ++n) _Pragma("unroll") for (int k = 0; k < 2; ++k) dst[n][k] = *(const PG8_LAS bf16x8*)(lds + PG8_SB(b, h) + boff + n * 2048 + k * 1024); } while (0)
#define PG8_MMA(ai, bj, At, Bt) do { __builtin_amdgcn_s_setprio(1); _Pragma("unroll") for (int m = 0; m < 4; ++m) _Pragma("unroll") for (int n = 0; n < 2; ++n) _Pragma("unroll") for (int k = 0; k < 2; ++k) \
        acc[ai][bj][m][n] = __builtin_amdgcn_mfma_f32_16x16x32_bf16(Bt[n][k], At[m][k], acc[ai][bj][m][n], 0, 0, 0); __builtin_amdgcn_s_setprio(0); } while (0)
#define PG8_WAIT_V(n) asm volatile("s_waitcnt vmcnt(" #n ")" ::: "memory")
#define PG8_WAIT_L(n) asm volatile("s_waitcnt lgkmcnt(" #n ")" ::: "memory")
#define PG8_BAR __builtin_amdgcn_s_barrier()
#define PG8_SCHED __builtin_amdgcn_sched_barrier(0)
    Unit cur, nxt; int ui = 0;
    if (!S.next(0, cur)) return;
    f32x4 acc[2][2][4][2];
#pragma unroll
    for (int a = 0; a < 2; ++a)
#pragma unroll
        for (int b = 0; b < 2; ++b)
#pragma unroll
            for (int m = 0; m < 4; ++m)
#pragma unroll
                for (int n = 0; n < 2; ++n) acc[a][b][m][n] = (f32x4){0.f, 0.f, 0.f, 0.f};
    bf16x8 At[4][2], B0[2][2], B1[2][2];
    const char* cA = (const char*)g.A + (size_t)cur.pm * tstep; const char* cB = (const char*)g.Bt + (size_t)cur.pn * tstep;
    S.a_ready(cur);
    if constexpr (SP2) {
        PG8_STAGE(PG8_SB(0, 0), cB, voffB); PG8_STAGE(PG8_SB(0, 1), cB + hstep, voffB); PG8_STAGE(PG8_SA(0, 0), cA, voffA); PG8_STAGE(PG8_SA(0, 1), cA + hstep, voffA);
        if (wr == 1) PG8_BAR;
        PG8_WAIT_V(2); PG8_BAR;
        PG8_STAGE(PG8_SB(1, 0), cB + kstep, voffB); PG8_STAGE(PG8_SA(1, 0), cA + kstep, voffA); PG8_STAGE(PG8_SB(1, 1), cB + hstep + kstep, voffB);
        PG8_WAIT_V(6); PG8_BAR;
    } else {
        PG8_STAGE(PG8_SB(0, 0), cB, voffB); PG8_STAGE(PG8_SA(0, 0), cA, voffA); PG8_STAGE(PG8_SB(0, 1), cB + hstep, voffB); PG8_STAGE(PG8_SA(0, 1), cA + hstep, voffA);
        if (wr == 1) PG8_BAR;
        PG8_WAIT_V(4); PG8_BAR;
        PG8_STAGE(PG8_SB(1, 0), cB + kstep, voffB); PG8_STAGE(PG8_SA(1, 0), cA + kstep, voffA); PG8_STAGE(PG8_SB(1, 1), cB + hstep + kstep, voffB);
        PG8_WAIT_V(6); PG8_BAR;
    }
    for (;;) {
        const bool has_next = S.next(ui + 1, nxt);
        const char* nA = has_next ? (const char*)g.A + (size_t)nxt.pm * tstep : cA; const char* nB = has_next ? (const char*)g.Bt + (size_t)nxt.pn * tstep : cB;
        for (int t = 0; t < nt; t += 2) {
            const bool last = (t == nt - 2);
            const char* a1 = cA + (size_t)(t + 1) * kstep;
            const char* a2 = last ? nA : cA + (size_t)(t + 2) * kstep; const char* b2 = last ? nB : cB + (size_t)(t + 2) * kstep;
            const char* a3 = a2 + kstep; const char* b3 = b2 + kstep;
            if (last && has_next) S.a_ready(nxt);
            if constexpr (SP2) {
            PG8_LDB(B0, 0, 0); PG8_LDB(B1, 0, 1); PG8_SCHED; PG8_LDA(At, 0, 0); PG8_STAGE(PG8_SA(1, 1), a1 + hstep, voffA);
            PG8_WAIT_V(8); PG8_WAIT_L(0); PG8_BAR; PG8_MMA(0, 0, At, B0); PG8_MMA(0, 1, At, B1); PG8_BAR; PG8_SCHED;
            PG8_LDA(At, 0, 1); PG8_STAGE(PG8_SB(0, 0), b2, voffB); PG8_STAGE(PG8_SB(0, 1), b2 + hstep, voffB); PG8_STAGE(PG8_SA(0, 0), a2, voffA);
            PG8_WAIT_V(8); PG8_WAIT_L(0); PG8_BAR; PG8_MMA(1, 0, At, B0); PG8_MMA(1, 1, At, B1); PG8_BAR; PG8_SCHED;
            PG8_LDB(B0, 1, 0); PG8_LDB(B1, 1, 1); PG8_SCHED; PG8_LDA(At, 1, 0); PG8_STAGE(PG8_SA(0, 1), a2 + hstep, voffA);
            PG8_WAIT_V(8); PG8_WAIT_L(0); PG8_BAR; PG8_MMA(0, 0, At, B0); PG8_MMA(0, 1, At, B1); PG8_BAR; PG8_SCHED;
            PG8_LDA(At, 1, 1); PG8_STAGE(PG8_SB(1, 0), b3, voffB); PG8_STAGE(PG8_SB(1, 1), b3 + hstep, voffB); PG8_STAGE(PG8_SA(1, 0), a3, voffA);
            PG8_WAIT_V(8); PG8_WAIT_L(0); PG8_BAR; PG8_MMA(1, 0, At, B0); PG8_MMA(1, 1, At, B1); PG8_BAR; PG8_SCHED;
            } else {
            PG8_LDB(B0, 0, 0); PG8_SCHED; PG8_LDA(At, 0, 0); PG8_STAGE(PG8_SA(1, 1), a1 + hstep, voffA);
            PG8_WAIT_L(8); PG8_BAR; PG8_WAIT_L(0); PG8_MMA(0, 0, At, B0); PG8_BAR; PG8_SCHED;
            PG8_LDB(B1, 0, 1); PG8_STAGE(PG8_SB(0, 0), b2, voffB);
            PG8_BAR; PG8_WAIT_L(0); PG8_MMA(0, 1, At, B1); PG8_BAR;
            PG8_LDA(At, 0, 1); PG8_STAGE(PG8_SA(0, 0), a2, voffA);
            PG8_BAR; PG8_WAIT_L(0); PG8_MMA(1, 0, At, B0); PG8_BAR; PG8_SCHED;
            PG8_STAGE(PG8_SB(0, 1), b2 + hstep, voffB);
            PG8_WAIT_V(6); PG8_BAR; PG8_MMA(1, 1, At, B1); PG8_BAR;
            PG8_LDB(B0, 1, 0); PG8_SCHED; PG8_LDA(At, 1, 0); PG8_STAGE(PG8_SA(0, 1), a2 + hstep, voffA);
            PG8_WAIT_L(8); PG8_BAR; PG8_WAIT_L(0); PG8_MMA(0, 0, At, B0); PG8_BAR; PG8_SCHED;
            PG8_LDB(B1, 1, 1); PG8_STAGE(PG8_SB(1, 0), b3, voffB);
            PG8_BAR; PG8_WAIT_L(0); PG8_MMA(0, 1, At, B1); PG8_BAR;
            PG8_LDA(At, 1, 1); PG8_STAGE(PG8_SA(1, 0), a3, voffA);
            PG8_BAR; PG8_WAIT_L(0); PG8_MMA(1, 0, At, B0); PG8_BAR; PG8_SCHED;
            PG8_STAGE(PG8_SB(1, 1), b3 + hstep, voffB);
            PG8_WAIT_V(6); PG8_BAR; PG8_MMA(1, 1, At, B1); PG8_BAR;
            }
        }
        if constexpr (ALIGN_EPI) { if (wr == 0) PG8_BAR; }
        if constexpr (!Epi::AFTER_DRAIN) { E(acc, cur, wr, wc, fr, fq); S.done(cur); }
        if (!has_next) break;
#pragma unroll
        for (int a = 0; a < 2; ++a)
#pragma unroll
            for (int b = 0; b < 2; ++b)
#pragma unroll
                for (int m = 0; m < 4; ++m)
#pragma unroll
                    for (int n = 0; n < 2; ++n) acc[a][b][m][n] = (f32x4){0.f, 0.f, 0.f, 0.f};
        cur = nxt; cA = nA; cB = nB; ++ui;
        if constexpr (ALIGN_EPI) { if (wr == 1) PG8_BAR; }
    }
    PG8_WAIT_V(0);
    if constexpr (!ALIGN_EPI) { if (wr == 0) PG8_BAR; }
    PG8_BAR;
    if constexpr (Epi::AFTER_DRAIN) { E.fused(acc, cur, wr, wc, fr, fq, lds, wid, lane); S.done(cur); }
#undef PG8_SA
#undef PG8_SB
#undef PG8_STAGE
#undef PG8_LDA
#undef PG8_LDB
#undef PG8_MMA
#undef PG8_WAIT_V
#undef PG8_WAIT_L
#undef PG8_BAR
#undef PG8_SCHED
}
}

constexpr int BATCH = 16, SEQ = 2048, DM = 2048, NMETA = 16;
constexpr int TREAL = BATCH * SEQ;
constexpr int MROWS = 33024;
constexpr int META_TILE0 = 32768;
constexpr int META_ROW0 = 32816;
constexpr int NZ = 6144;
constexpr int ZQ = 0, ZK = 1024, ZV = 2048, ZMQ = 3072, ZMK = 3584, ZMV = 4096, ZMO = 5120;
constexpr int INCOLS = 6152;
constexpr float EPS = 1e-6f;
constexpr float QSCALE = 0.125f * 1.4426950408889634f;
constexpr float LAMBDA_INIT = 0.2f;

typedef unsigned short bf16_t;
typedef float f32x4 __attribute__((ext_vector_type(4)));
typedef __bf16 bf16x2_t __attribute__((ext_vector_type(2)));

constexpr size_t MiB = 1u << 20;
constexpr size_t WS_CTL = 0;
constexpr size_t WS_ISC = 655360;
constexpr size_t WS_SKB = 65536;
constexpr size_t WS_WIN = 1 * MiB;
constexpr size_t WS_WOUT = 25 * MiB;
constexpr size_t WS_WQ = 33 * MiB;
constexpr size_t WS_ROPE = 41 * MiB;
constexpr size_t WS_GATES = 42 * MiB;
constexpr size_t WS_SSQ = 44 * MiB;
constexpr size_t WS_IDX = 48 * MiB;
constexpr size_t WS_GATE = 64 * MiB;
constexpr size_t WS_U = 80 * MiB;
constexpr size_t WS_V = 144 * MiB;
constexpr size_t WS_HN = 208 * MiB;
constexpr size_t WS_MIX = 338 * MiB;
constexpr size_t WS_Z = 466 * MiB;
constexpr size_t WS_END = 854 * MiB;

__device__ __forceinline__ float bf_lo(unsigned w) { return __uint_as_float(w << 16); }
__device__ __forceinline__ float bf_hi(unsigned w) { return __uint_as_float(w & 0xffff0000u); }
__device__ __forceinline__ float bf2f(bf16_t v) { return __uint_as_float(((unsigned)v) << 16); }
__device__ __forceinline__ unsigned f2bf(float f) { unsigned r; asm("v_cvt_pk_bf16_f32 %0, %1, 0" : "=v"(r) : "v"(f)); return r; }
__device__ __forceinline__ unsigned pk2(float lo, float hi) { unsigned r; asm("v_cvt_pk_bf16_f32 %0, %1, %2" : "=v"(r) : "v"(lo), "v"(hi)); return r; }
__device__ __forceinline__ float dot2(unsigned a, unsigned b, float acc) { return __builtin_amdgcn_fdot2_f32_bf16(__builtin_bit_cast(bf16x2_t, a), __builtin_bit_cast(bf16x2_t, b), acc, false); }
__device__ __forceinline__ float wave_sum(float v) {
#pragma unroll
    for (int o = 1; o < 64; o <<= 1) v += __shfl_xor(v, o);
    return v;
}
__device__ __forceinline__ float wave_max(float v) {
#pragma unroll
    for (int o = 1; o < 64; o <<= 1) v = fmaxf(v, __shfl_xor(v, o));
    return v;
}
__device__ __forceinline__ int zrow_of(int b, int l) { return l < NMETA ? META_ROW0 + l : b * SEQ + (l - NMETA); }

struct EpiZ {
    static constexpr bool PERM = true, AFTER_DRAIN = false;
    bf16_t* Z; const float* rope;
    __device__ __forceinline__ void operator()(const pg8::f32x4 (&acc)[2][2][4][2], const pg8::Unit& u, int wr, int wc, int fr, int fq) const {
        const int row0 = u.pm * 256 + wr * 64 + fr, col0 = u.pn * 256 + wc * 32 + 8 * fq;
        const bool isq = u.pn < 4, isrope = u.pn < 8;
        const int j0 = 16 * (wc & 1) + 4 * fq;
#pragma unroll
        for (int ai = 0; ai < 2; ++ai)
#pragma unroll
            for (int m = 0; m < 4; ++m) {
                const int row = row0 + ai * 128 + m * 16;
                pg8::f32x4 c0 = {1.f, 0.f, 1.f, 0.f}, c1 = {1.f, 0.f, 1.f, 0.f};
                if (isrope) {
                    const int pos = row < TREAL ? (row & (SEQ - 1)) + NMETA : ((row >= META_ROW0 && row < META_ROW0 + NMETA) ? row - META_ROW0 : 0);
                    const pg8::f32x4* tp = (const pg8::f32x4*)(rope + ((size_t)pos * 32 + j0) * 2);
                    c0 = tp[0]; c1 = tp[1];
                }
                bf16_t* rowp = Z + (size_t)row * NZ + col0;
#pragma unroll
                for (int bj = 0; bj < 2; ++bj) {
                    pg8::f32x4 v0 = acc[ai][bj][m][0], v1 = acc[ai][bj][m][1];
                    if (isrope) {
                        pg8::f32x4 o0, o1;
                        o0[0] = v0[0] * c0[0] - v0[1] * c0[1]; o0[1] = v0[1] * c0[0] + v0[0] * c0[1];
                        o0[2] = v0[2] * c0[2] - v0[3] * c0[3]; o0[3] = v0[3] * c0[2] + v0[2] * c0[3];
                        o1[0] = v1[0] * c1[0] - v1[1] * c1[1]; o1[1] = v1[1] * c1[0] + v1[0] * c1[1];
                        o1[2] = v1[2] * c1[2] - v1[3] * c1[3]; o1[3] = v1[3] * c1[2] + v1[2] * c1[3];
                        v0 = o0; v1 = o1;
                        if (isq) { v0 = v0 * QSCALE; v1 = v1 * QSCALE; }
                    }
                    pg8::u32x4 w; w.x = pg8::cvt_pk_bf16(v0[0], v0[1]); w.y = pg8::cvt_pk_bf16(v0[2], v0[3]); w.z = pg8::cvt_pk_bf16(v1[0], v1[1]); w.w = pg8::cvt_pk_bf16(v1[2], v1[3]);
                    *(pg8::u32x4*)(rowp + bj * 128) = w;
                }
            }
    }
};
struct EpiX1 {
    static constexpr bool PERM = true, AFTER_DRAIN = false;
    const float* x; bf16_t* x1b; float* ssq;
    __device__ __forceinline__ void loadr(pg8::f32x4 (&xb)[2][2], int row0, int col0, int i) const {
#pragma unroll
        for (int bj = 0; bj < 2; ++bj) {
            const size_t off = (size_t)(row0 + (i >> 2) * 128 + (i & 3) * 16) * DM + col0 + bj * 128;
            xb[bj][0] = *(const pg8::f32x4*)(x + off); xb[bj][1] = *(const pg8::f32x4*)(x + off + 4);
        }
    }
    __device__ __forceinline__ void procr(const pg8::f32x4 (&acc)[2][2][4][2], const pg8::f32x4 (&xb)[2][2], int row0, int col0, int i, int pn, int wc, int fq) const {
        const int ai = i >> 2, m = i & 3;
        const int row = row0 + ai * 128 + m * 16; float ss = 0.f;
#pragma unroll
        for (int bj = 0; bj < 2; ++bj) {
            const size_t off = (size_t)row * DM + col0 + bj * 128;
            const pg8::f32x4 v0 = acc[ai][bj][m][0] + xb[bj][0], v1 = acc[ai][bj][m][1] + xb[bj][1];
            ss += (v0[0] * v0[0] + v0[1] * v0[1]) + (v0[2] * v0[2] + v0[3] * v0[3]) + (v1[0] * v1[0] + v1[1] * v1[1]) + (v1[2] * v1[2] + v1[3] * v1[3]);
            pg8::u32x4 w; w.x = pg8::cvt_pk_bf16(v0[0], v0[1]); w.y = pg8::cvt_pk_bf16(v0[2], v0[3]); w.z = pg8::cvt_pk_bf16(v1[0], v1[1]); w.w = pg8::cvt_pk_bf16(v1[2], v1[3]);
            *(pg8::u32x4*)(x1b + off) = w;
        }
        ss += __shfl_xor(ss, 16); ss += __shfl_xor(ss, 32);
        if (fq == 0) ssq[(size_t)row * 32 + pn * 4 + wc] = ss;
    }
    __device__ __forceinline__ void operator()(const pg8::f32x4 (&acc)[2][2][4][2], const pg8::Unit& u, int wr, int wc, int fr, int fq) const {
        const int row0 = u.pm * 256 + wr * 64 + fr, col0 = u.pn * 256 + wc * 32 + 8 * fq;
        pg8::f32x4 b0[2][2], b1[2][2], b2[2][2];
        loadr(b0, row0, col0, 0); loadr(b1, row0, col0, 1); loadr(b2, row0, col0, 2);
        procr(acc, b0, row0, col0, 0, u.pn, wc, fq); loadr(b0, row0, col0, 3);
        procr(acc, b1, row0, col0, 1, u.pn, wc, fq); loadr(b1, row0, col0, 4);
        procr(acc, b2, row0, col0, 2, u.pn, wc, fq); loadr(b2, row0, col0, 5);
        procr(acc, b0, row0, col0, 3, u.pn, wc, fq); loadr(b0, row0, col0, 6);
        procr(acc, b1, row0, col0, 4, u.pn, wc, fq); loadr(b1, row0, col0, 7);
        procr(acc, b2, row0, col0, 5, u.pn, wc, fq);
        procr(acc, b0, row0, col0, 6, u.pn, wc, fq);
        procr(acc, b1, row0, col0, 7, u.pn, wc, fq);
    }
};


#include <hip/hip_cooperative_groups.h>
namespace cg = cooperative_groups;

constexpr int NWAVES = 8, NTHREADS = 512;
constexpr size_t WS_X1Q = WS_Z + 300 * MiB, WS_XSC = WS_Z + 370 * MiB;
__device__ __forceinline__ int opaque_tid() { int t = threadIdx.x; asm volatile("" : "+v"(t)); return t; }
constexpr int LDS_BYTES = 163840;

struct Args {
    const float *x, *meta, *nmw, *w_in, *lamqk, *subln, *convw, *convb, *ib, *fb, *mnw, *w_out, *nfw_ffn, *w_q, *subkeys, *pu, *pv, *nfinal;
    float* out; unsigned char* ws;
};

#define LAS __attribute__((address_space(3)))
#define XB_TMO      128
#define XB_XCNT(j)  (256  + 64 * (j))
#define XB_XSUB(j)  (1280 + 64 * (j))
#define XB_XGEN(j)  (2304 + 64 * (j))
#define XB_TOP      3328
#define XB_TOPGEN   3392
#define XCD_BAR_WORDS 3456
#define XB_SPIN_CAP (1u << 18)

__device__ __forceinline__ unsigned xb_ld(unsigned* p)              { return __hip_atomic_load(p, __ATOMIC_RELAXED, __HIP_MEMORY_SCOPE_AGENT); }
__device__ __forceinline__ unsigned xb_add(unsigned* p, unsigned v) { return __hip_atomic_fetch_add(p, v, __ATOMIC_RELAXED, __HIP_MEMORY_SCOPE_AGENT); }
__device__ __forceinline__ unsigned xb_xcc_id() { return (unsigned)__builtin_amdgcn_s_getreg((3 << 11) | 20) & 0xFu; }
#define XB_SPIN(cond, bar) do { unsigned _sp = 0; while (cond) { __builtin_amdgcn_s_sleep(1); \
    if ((++_sp & 255u) == 0u) { if (xb_ld(&(bar)[XB_TMO])) break; if (_sp > XB_SPIN_CAP) { atomicAdd(&(bar)[XB_TMO], 1u); break; } } } } while (0)

struct XcdBarrier {
    unsigned* bar; unsigned x;
    volatile LAS unsigned* st;
};

__device__ __forceinline__ XcdBarrier xcd_barrier_post(unsigned* bar, volatile LAS unsigned* st) {
    XcdBarrier b; b.bar = bar; b.x = xb_xcc_id(); b.st = st;
    if (threadIdx.x == 0) (void)xb_add(&bar[XB_XCNT(b.x)], 1u);
    return b;
}
__device__ __forceinline__ void xcd_barrier_complete(unsigned* bar, unsigned x, unsigned& nloc, unsigned& nx) {
    const unsigned G = gridDim.x * gridDim.y * gridDim.z;
    unsigned sum, cnt, mine, sp = 0u;
    for (;;) {
        sum = 0u; cnt = 0u; mine = 0u;
#pragma unroll
        for (unsigned j = 0; j < 16; ++j) { const unsigned c = xb_ld(&bar[XB_XCNT(j)]); sum += c; cnt += (c > 0u) ? 1u : 0u; mine = (j == x) ? c : mine; }
        if (sum == G) break;
        __builtin_amdgcn_s_sleep(1);
        if ((++sp & 255u) == 0u) { if (xb_ld(&bar[XB_TMO])) break; if (sp > XB_SPIN_CAP) { atomicAdd(&bar[XB_TMO], 1u); break; } }
    }
    nloc = mine > 0u ? mine : 1u; nx = cnt > 0u ? cnt : 1u;
}

__device__ __forceinline__ void xcd_barrier(const XcdBarrier& b) {
    asm volatile("s_waitcnt vmcnt(0)" ::: "memory");
    __syncthreads();
    if (threadIdx.x == 0) {
        unsigned* bar = b.bar;
        __builtin_amdgcn_s_waitcnt(0);
        unsigned nloc = b.st[0], nx = b.st[1];
        if (nloc == 0u) { xcd_barrier_complete(bar, b.x, nloc, nx); b.st[0] = nloc; b.st[1] = nx; }
        const unsigned old = xb_add(&bar[XB_XSUB(b.x)], 1u);
        const unsigned gen = old / nloc;
        if (old + 1u == (gen + 1u) * nloc) {
            __builtin_amdgcn_fence(__ATOMIC_RELEASE, "agent");
            asm volatile("s_waitcnt vmcnt(0)" ::: "memory");
            const unsigned og = xb_add(&bar[XB_TOP], 1u);
            const unsigned tg = og / nx;
            if (og + 1u == (tg + 1u) * nx) xb_add(&bar[XB_TOPGEN], 1u);
            else XB_SPIN(xb_ld(&bar[XB_TOPGEN]) == tg, bar);
            __builtin_amdgcn_fence(__ATOMIC_ACQUIRE, "agent");
            xb_add(&bar[XB_XGEN(b.x)], 1u);
            asm volatile("s_waitcnt vmcnt(0)" ::: "memory");
        } else {
            XB_SPIN(xb_ld(&bar[XB_XGEN(b.x)]) == gen, bar);
            __builtin_amdgcn_fence(__ATOMIC_ACQUIRE, "agent");
            asm volatile("s_waitcnt vmcnt(0)" ::: "memory");
        }
    }
    __syncthreads();
}

constexpr int CW_BAR = 0, CW_QUEUE = 4096;
constexpr int LDS_MISC = LDS_BYTES - 256;
__device__ __forceinline__ int next_item(unsigned* ctr, volatile LAS unsigned* slot) {
    __syncthreads();
    if (threadIdx.x == 0) *slot = __hip_atomic_fetch_add(ctr, 1u, __ATOMIC_RELAXED, __HIP_MEMORY_SCOPE_AGENT);
    __syncthreads();
    return (int)*slot;
}

__device__ __forceinline__ void transpose_item(const float* W, int ldw, int K, int N, bf16_t* WT, bool ropeperm, float* scr, int item, int lane, const float* kscale = nullptr) {
    const int nblk = N / 32, kb = item / nblk, nb = item % nblk, k0 = 64 * kb, n0 = 32 * nb;
#pragma unroll 8
    for (int i = 0; i < 32; ++i) { const int kk = 2 * i + (lane >> 5); scr[kk * 33 + (lane & 31)] = W[(size_t)(k0 + kk) * ldw + n0 + (lane & 31)] * (kscale ? kscale[k0 + kk] : 1.f); }
    __builtin_amdgcn_s_waitcnt(0xC07F); asm volatile("" ::: "memory");
    const int c = lane & 7;
#pragma unroll
    for (int j = 0; j < 4; ++j) {
        const int n = (lane >> 3) + 8 * j; const float* s = scr + (8 * c) * 33 + n;
        uint4 o; o.x = pk2(s[0 * 33], s[1 * 33]); o.y = pk2(s[2 * 33], s[3 * 33]); o.z = pk2(s[4 * 33], s[5 * 33]); o.w = pk2(s[6 * 33], s[7 * 33]);
        int orow = n0 + n;
        if (ropeperm && n0 < 2048) orow = (n0 & ~63) + 2 * n + ((n0 >> 5) & 1);
        *(uint4*)(WT + (size_t)orow * K + k0 + 8 * c) = o;
    }
    __builtin_amdgcn_s_waitcnt(0xC07F); asm volatile("" ::: "memory");
}

__device__ __forceinline__ void hn_row(const Args& a, bf16_t* HN, float* G, const float* WG, int r, const f32x4 (&v)[8], int lane) {
    float ss = 0.f;
#pragma unroll
    for (int j = 0; j < 8; ++j) ss += (v[j][0] * v[j][0] + v[j][1] * v[j][1]) + (v[j][2] * v[j][2] + v[j][3] * v[j][3]);
    const float rstd = rsqrtf(wave_sum(ss) * (1.f / DM) + EPS);
    float g[8];
#pragma unroll
    for (int k = 0; k < 8; ++k) g[k] = 0.f;
    unsigned long long* o8 = (unsigned long long*)(HN + (size_t)r * DM) + lane;
#pragma unroll
    for (int j = 0; j < 8; ++j) {
        const f32x4 w = ((const f32x4*)a.nmw)[64 * j + lane];
        const f32x4 y = v[j] * rstd * w;
        o8[64 * j] = (unsigned long long)pk2(y[0], y[1]) | ((unsigned long long)pk2(y[2], y[3]) << 32);
#pragma unroll
        for (int k = 0; k < 8; ++k) { const f32x4 wg = ((const f32x4*)(WG + k * 2048))[64 * j + lane]; g[k] += (y[0] * wg[0] + y[1] * wg[1]) + (y[2] * wg[2] + y[3] * wg[3]); }
        __builtin_amdgcn_sched_barrier(0);
    }
    float r4[4], r2[2], r1;
    { const bool hb = (lane & 32) != 0;
#pragma unroll
      for (int i = 0; i < 4; ++i) { const float send = hb ? g[i] : g[i + 4]; const float recv = __shfl_xor(send, 32); r4[i] = (hb ? g[i + 4] : g[i]) + recv; } }
    { const bool hb = (lane & 16) != 0;
#pragma unroll
      for (int i = 0; i < 2; ++i) { const float send = hb ? r4[i] : r4[i + 2]; const float recv = __shfl_xor(send, 16); r2[i] = (hb ? r4[i + 2] : r4[i]) + recv; } }
    { const bool hb = (lane & 8) != 0; const float send = hb ? r2[0] : r2[1]; const float recv = __shfl_xor(send, 8); r1 = (hb ? r2[1] : r2[0]) + recv; }
    r1 += __shfl_xor(r1, 4); r1 += __shfl_xor(r1, 2); r1 += __shfl_xor(r1, 1);
    if ((lane & 7) == 0) G[(size_t)r * 8 + ((lane >> 5) & 1) * 4 + ((lane >> 4) & 1) * 2 + ((lane >> 3) & 1)] = r1;
}

__device__ __forceinline__ void phase_prep(const Args& a, unsigned char* lds, int bid, int nb) {
    const int tid = opaque_tid(), lane = tid & 63, wave = tid >> 6;
    const int gw = bid * NWAVES + wave, NGW = nb * NWAVES;
    unsigned char* ws = a.ws;
    bf16_t* WinT = (bf16_t*)(ws + WS_WIN); bf16_t* WoutT = (bf16_t*)(ws + WS_WOUT); bf16_t* WqT = (bf16_t*)(ws + WS_WQ);
    bf16_t* U = (bf16_t*)(ws + WS_U); bf16_t* V = (bf16_t*)(ws + WS_V); bf16_t* HN = (bf16_t*)(ws + WS_HN);
    float* G = (float*)(ws + WS_GATES); float* rope = (float*)(ws + WS_ROPE);
    float* scr = (float*)lds + wave * (64 * 33);
    float* WG = (float*)(lds + 8 * 64 * 33 * 4);
    for (int i = tid; i < 8 * 2048; i += NTHREADS) { const int k = i >> 3, g = i & 7; WG[g * 2048 + k] = a.w_in[(size_t)k * INCOLS + 6144 + g]; }
    __syncthreads();
    constexpr int I_IN = 32 * 192, I_OUT = 32 * 64, I_Q = 32 * 64;
    for (int it = gw; it < I_IN + I_OUT + I_Q; it += NGW) {
        int r = it;
        if (r < I_IN) { transpose_item(a.w_in, INCOLS, 2048, 6144, WinT, true, scr, r, lane); continue; } r -= I_IN;
        if (r < I_OUT) { transpose_item(a.w_out, 2048, 2048, 2048, WoutT, false, scr, r, lane); continue; } r -= I_OUT;
        transpose_item(a.w_q, 2048, 2048, 2048, WqT, false, scr, r, lane, a.nfw_ffn);
    }
    {
        f32x4 vc[8], vn[8];
#pragma unroll
        for (int j = 0; j < 8; ++j) vc[j] = ((const f32x4*)(a.x + (size_t)gw * DM))[64 * j + lane];
        for (int r = gw; r < TREAL; r += NGW) {
            const int rn = r + NGW < TREAL ? r + NGW : r;
#pragma unroll
            for (int j = 0; j < 8; ++j) vn[j] = ((const f32x4*)(a.x + (size_t)rn * DM))[64 * j + lane];
            hn_row(a, HN, G, WG, r, vc, lane);
#pragma unroll
            for (int j = 0; j < 8; ++j) vc[j] = vn[j];
        }
    }
    for (int r = TREAL + gw; r < MROWS; r += NGW) {
        if (r >= META_ROW0 && r < META_ROW0 + NMETA) {
            f32x4 vm[8];
#pragma unroll
            for (int j = 0; j < 8; ++j) vm[j] = ((const f32x4*)(a.meta + (size_t)(r - META_ROW0) * DM))[64 * j + lane];
            hn_row(a, HN, G, WG, r, vm, lane);
        } else {
            unsigned long long* o8 = (unsigned long long*)(HN + (size_t)r * DM) + lane;
#pragma unroll
            for (int j = 0; j < 8; ++j) o8[64 * j] = 0ull;
            if (lane < 8) G[(size_t)r * 8 + lane] = 0.f;
        }
    }
    { bf16_t* SKB = (bf16_t*)(ws + WS_SKB);
      for (int i = bid * NTHREADS + tid; i < 8 * 2 * 128 * 128 / 2; i += nb * NTHREADS) { const float2 v = ((const float2*)a.subkeys)[i]; ((unsigned*)SKB)[i] = pk2(v.x, v.y); } }
    for (int i = bid * NTHREADS + tid; i < (SEQ + NMETA) * 32; i += nb * NTHREADS) {
        const int pos = i >> 5, j = i & 31;
        const float inv = (float)pow(10000.0, -(double)j / 32.0);
        const float ang = (float)pos * inv;
        rope[2 * i] = (float)cos((double)ang); rope[2 * i + 1] = (float)sin((double)ang);
    }
}


constexpr int CW_QTAB = 4096 + 1024, TAB_ITEMS = 2 * 16384 / 16;
__device__ __forceinline__ void phase_tables(const Args& a, unsigned char* lds, unsigned* ctl) {
    const int tid = opaque_tid(), lane = tid & 63, wave = __builtin_amdgcn_readfirstlane(tid >> 6);
    unsigned char* ws = a.ws;
    volatile LAS unsigned* slot = (volatile LAS unsigned*)((LAS unsigned char*)lds + LDS_MISC) + 2;
    for (;;) {
        const int item = next_item(ctl + CW_QTAB, slot);
        if (item >= TAB_ITEMS) break;
        const int rr = item * 16 + wave;
    {
        unsigned* U8 = (unsigned*)(ws + WS_U); unsigned* V8 = (unsigned*)(ws + WS_V); float* ISC = (float*)(ws + WS_ISC);
        {
            f32x4 v[2][8]; float am[2];
#pragma unroll
            for (int q = 0; q < 2; ++q) {
                const int r = rr + q * 8; const bool isu = r < 16384; const int e = r & 16383;
                const f32x4* xr = (const f32x4*)((isu ? a.pu : a.pv) + (size_t)e * DM) + lane;
#pragma unroll
                for (int j = 0; j < 8; ++j) v[q][j] = xr[64 * j];
            }
#pragma unroll
            for (int q = 0; q < 2; ++q) if (rr + q * 8 < 16384) {
#pragma unroll
                for (int j = 0; j < 8; ++j) v[q][j] = v[q][j] * ((const f32x4*)a.nfw_ffn)[64 * j + lane]; }
#pragma unroll
            for (int q = 0; q < 2; ++q) { float t = 0.f;
#pragma unroll
                for (int j = 0; j < 8; ++j) t = fmaxf(t, fmaxf(fmaxf(fabsf(v[q][j][0]), fabsf(v[q][j][1])), fmaxf(fabsf(v[q][j][2]), fabsf(v[q][j][3]))));
                am[q] = t; }
#pragma unroll
            for (int o = 1; o < 64; o <<= 1) { am[0] = fmaxf(am[0], __shfl_xor(am[0], o)); am[1] = fmaxf(am[1], __shfl_xor(am[1], o)); }
#pragma unroll
            for (int q = 0; q < 2; ++q) {
                const int r = rr + q * 8; const bool isu = r < 16384; const int e = r & 16383;
                const float top = isu ? 127.f : 256.f;
                const float sc = am[q] > 0.f ? top / am[q] : 0.f;
                unsigned* o8 = isu ? U8 : V8;
#pragma unroll
                for (int j = 0; j < 8; ++j) { int w;
                    if (isu) { const int q0 = (int)rintf(v[q][j][0] * sc), q1 = (int)rintf(v[q][j][1] * sc), q2 = (int)rintf(v[q][j][2] * sc), q3 = (int)rintf(v[q][j][3] * sc);
                        w = (int)((unsigned)(q0 & 255) | ((unsigned)(q1 & 255) << 8) | ((unsigned)(q2 & 255) << 16) | ((unsigned)q3 << 24)); }
                    else { w = __builtin_amdgcn_cvt_pk_fp8_f32(v[q][j][0] * sc, v[q][j][1] * sc, 0, false); w = __builtin_amdgcn_cvt_pk_fp8_f32(v[q][j][2] * sc, v[q][j][3] * sc, w, true); }
                    o8[((size_t)j * 16384 + e) * 64 + lane] = (unsigned)w; }
                if (lane == 0) ISC[(isu ? 0 : 16384) + e] = am[q] / top;
            }
        }
    }
    }
}

namespace att {
using bf16x8 = __attribute__((ext_vector_type(8))) short;
using s16x4 = __attribute__((ext_vector_type(4))) short;
using f32x16 = __attribute__((ext_vector_type(16))) float;
using u32x4 = __attribute__((ext_vector_type(4))) unsigned;
constexpr int SHM_V = 16384, SHM_K = 16384;
constexpr int L_V = 0, L_K = 2 * SHM_V, L_WS = L_K + 2 * SHM_K, L_P = L_WS + 8 * 64 * 4, L_END = L_P + 4 * 4096;
#define KSWZ(row, colB) ((row) * 256 + ((colB) ^ (((row) & 7) << 4)))
#define SBAR() __builtin_amdgcn_sched_barrier(0)
__device__ __forceinline__ int crow(int r, int hi) { return (r & 3) + 8 * (r >> 2) + 4 * hi; }
__device__ __forceinline__ unsigned cvtpk(float lo, float hi) { unsigned r; asm volatile("v_cvt_pk_bf16_f32 %0, %1, %2" : "=v"(r) : "v"(lo), "v"(hi)); return r; }
__device__ __forceinline__ int v_st(int k, int c) { const int kk = (k & ~0xC) | ((k & 4) << 1) | ((k & 8) >> 1); return ((kk >> 3) * 4 + (c >> 5)) * 512 + ((kk & 7) * 32 + (c & 31)) * 2; }
__device__ __forceinline__ int v_rd_base(int lane) { return ((lane & 3) << 3) | (((lane >> 2) & 3) << 6) | (((lane >> 4) & 1) << 5) | (((lane >> 5) & 1) << 8); }
constexpr int v_rd_off(int d0, int ks, int half) { return d0 * 512 + ks * 4096 + half * 2048; }
template <int OFF> __device__ __forceinline__ s16x4 tr_read(int vb) { s16x4 r; asm volatile("ds_read_b64_tr_b16 %0, %1 offset:%2" : "=&v"(r) : "v"(vb), "i"(OFF) : "memory"); return r; }
template <int D0> __device__ __forceinline__ void pv_one(f32x16& od, int vb, bf16x8 pa0, bf16x8 pa1, bf16x8 pa2, bf16x8 pa3) {
    const s16x4 l0 = tr_read<v_rd_off(D0, 0, 0)>(vb), h0 = tr_read<v_rd_off(D0, 0, 1)>(vb), l1 = tr_read<v_rd_off(D0, 1, 0)>(vb), h1 = tr_read<v_rd_off(D0, 1, 1)>(vb);
    const s16x4 l2 = tr_read<v_rd_off(D0, 2, 0)>(vb), h2 = tr_read<v_rd_off(D0, 2, 1)>(vb), l3 = tr_read<v_rd_off(D0, 3, 0)>(vb), h3 = tr_read<v_rd_off(D0, 3, 1)>(vb);
    asm volatile("s_waitcnt lgkmcnt(0)" ::: "memory"); SBAR();
#define PK(L, H) (bf16x8){L[0], L[1], L[2], L[3], H[0], H[1], H[2], H[3]}
    od = __builtin_amdgcn_mfma_f32_32x32x16_bf16(pa0, PK(l0, h0), od, 0, 0, 0);
    od = __builtin_amdgcn_mfma_f32_32x32x16_bf16(pa1, PK(l1, h1), od, 0, 0, 0);
    od = __builtin_amdgcn_mfma_f32_32x32x16_bf16(pa2, PK(l2, h2), od, 0, 0, 0);
    od = __builtin_amdgcn_mfma_f32_32x32x16_bf16(pa3, PK(l3, h3), od, 0, 0, 0);
#undef PK
}
__device__ __forceinline__ void qkt(f32x16& p0, f32x16& p1, const char* Ks, const bf16x8* qr, int r32, int hi, int comp) {
    p0 = f32x16{}; p1 = f32x16{};
#pragma unroll
    for (int d0 = 0; d0 < 4; ++d0) {
        const int cb = (comp * 64 + d0 * 16 + hi * 8) * 2;
        const bf16x8 b0 = *reinterpret_cast<const bf16x8*>(Ks + KSWZ(r32, cb));
        const bf16x8 b1 = *reinterpret_cast<const bf16x8*>(Ks + KSWZ(32 + r32, cb));
        p0 = __builtin_amdgcn_mfma_f32_32x32x16_bf16(b0, qr[d0], p0, 0, 0, 0);
        p1 = __builtin_amdgcn_mfma_f32_32x32x16_bf16(b1, qr[d0], p1, 0, 0, 0);
    }
}

__device__ __forceinline__ void attn_unit(int b, int h, int qb, const bf16_t* Z, bf16_t* MIX, float lam, const float* subln, char* lds) {
    const int tid = opaque_tid(), wid = __builtin_amdgcn_readfirstlane(tid >> 6), lane = tid & 63, r32 = lane & 31, hi = lane >> 5;
    const int comp = wid >> 2, rg = wid & 3;
    char* V_lds = lds + L_V; char* K_lds = lds + L_K;
    float* wsf = (float*)(lds + L_WS) + wid * 64;
    const int q0 = b * SEQ + qb * 128;
    const float NEGV = -1e30f;
    bf16x8 qr[4];
    {
        const bf16_t* Qw = Z + (size_t)(q0 + rg * 32 + r32) * NZ + ZQ + h * 128 + comp * 64 + hi * 8;
#pragma unroll
        for (int d0 = 0; d0 < 4; ++d0) qr[d0] = *reinterpret_cast<const bf16x8*>(Qw + d0 * 16);
    }
    const int NT = 2 * qb + 3;
    const int sr = tid >> 4, sc = (tid & 15) * 8;
    const int vst0 = v_st(sr, sc), vst1 = v_st(32 + sr, sc), kst0 = KSWZ(sr, sc * 2), kst1 = KSWZ(32 + sr, sc * 2);
    const int vb0 = (int)(uintptr_t)V_lds + v_rd_base(lane);
#define PK4(P, BASE, OUT) do { unsigned a0 = cvtpk(P[BASE + 0], P[BASE + 1]), a1 = cvtpk(P[BASE + 2], P[BASE + 3]); \
        unsigned b0 = cvtpk(P[BASE + 4], P[BASE + 5]), b1 = cvtpk(P[BASE + 6], P[BASE + 7]); \
        auto r0 = __builtin_amdgcn_permlane32_swap(a0, b0, false, false); auto r1 = __builtin_amdgcn_permlane32_swap(a1, b1, false, false); \
        u32x4 w = {r0[0], r1[0], r0[1], r1[1]}; OUT = *reinterpret_cast<bf16x8*>(&w); } while (0)
    bf16x8 vsA0, vsA1, ksA0, ksA1, vsB0, vsB1, ksB0, ksB1;
#define SLOAD(j, S) do { const size_t r0_ = (size_t)((j) == 0 ? META_TILE0 : b * SEQ + ((j) - 1) * 64) + sr; const bf16_t* zp_ = Z + r0_ * NZ + h * 128 + sc; \
        vs##S##0 = *reinterpret_cast<const bf16x8*>(zp_ + ZV); vs##S##1 = *reinterpret_cast<const bf16x8*>(zp_ + ZV + (size_t)32 * NZ); \
        ks##S##0 = *reinterpret_cast<const bf16x8*>(zp_ + ZK); ks##S##1 = *reinterpret_cast<const bf16x8*>(zp_ + ZK + (size_t)32 * NZ); } while (0)
#define SWRITE(bi, S) do { *reinterpret_cast<bf16x8*>(V_lds + (bi) * SHM_V + vst0) = vs##S##0; *reinterpret_cast<bf16x8*>(V_lds + (bi) * SHM_V + vst1) = vs##S##1; \
        *reinterpret_cast<bf16x8*>(K_lds + (bi) * SHM_K + kst0) = ks##S##0; *reinterpret_cast<bf16x8*>(K_lds + (bi) * SHM_K + kst1) = ks##S##1; } while (0)
    f32x16 o[4] = {}; float m_reg = NEGV, l_reg = 0.f;
    SLOAD(0, A); SWRITE(0, A); SLOAD(1, B); __syncthreads();
    const int qrel = rg * 32 + r32;
#define ATT_TILE(j, L_, W_) do { \
        const int cur = j & 1; \
        if (j + 2 < NT) SLOAD(j + 2, L_); \
        f32x16 p0, p1; \
        qkt(p0, p1, K_lds + cur * SHM_K, qr, r32, hi, comp); \
        if (j == 0) { \
    _Pragma("unroll") \
            for (int r = 0; r < 16; ++r) { p0[r] = NEGV; if (r < 8) p1[r] = NEGV; } \
        } else if (j >= NT - 2) { \
            const int kb0 = (j - (NT - 2)) * 64; \
    _Pragma("unroll") \
            for (int r = 0; r < 16; ++r) { const int kl = kb0 + crow(r, hi); if (kl > qrel) p0[r] = NEGV; if (kl + 32 > qrel) p1[r] = NEGV; } \
        } \
        float pmax = p0[0]; \
    _Pragma("unroll") \
        for (int r = 1; r < 16; ++r) pmax = fmaxf(pmax, p0[r]); \
    _Pragma("unroll") \
        for (int r = 0; r < 16; ++r) pmax = fmaxf(pmax, p1[r]); \
        { auto rr = __builtin_amdgcn_permlane32_swap(__float_as_uint(pmax), __float_as_uint(pmax), false, false); pmax = fmaxf(__uint_as_float(rr[0]), __uint_as_float(rr[1])); } \
        const float mn = fmaxf(m_reg, pmax); const float alpha = __builtin_amdgcn_exp2f(m_reg - mn); m_reg = mn; \
        float ps = 0.f; \
    _Pragma("unroll") \
        for (int r = 0; r < 16; ++r) { p0[r] = __builtin_amdgcn_exp2f(p0[r] - mn); ps += p0[r]; } \
    _Pragma("unroll") \
        for (int r = 0; r < 16; ++r) { p1[r] = __builtin_amdgcn_exp2f(p1[r] - mn); ps += p1[r]; } \
        { auto rr = __builtin_amdgcn_permlane32_swap(__float_as_uint(ps), __float_as_uint(ps), false, false); ps = __uint_as_float(rr[0]) + __uint_as_float(rr[1]); } \
        l_reg = l_reg * alpha + ps; \
        if (__any(alpha < 1.f)) { \
            if (hi == 0) wsf[r32] = alpha; \
            asm volatile("s_waitcnt lgkmcnt(0)" ::: "memory"); \
            float al[16]; \
    _Pragma("unroll") \
            for (int r = 0; r < 16; ++r) al[r] = wsf[crow(r, hi)]; \
    _Pragma("unroll") \
            for (int d = 0; d < 4; ++d) \
    _Pragma("unroll") \
                for (int r = 0; r < 16; ++r) o[d][r] *= al[r]; \
            asm volatile("s_waitcnt lgkmcnt(0)" ::: "memory"); \
        } \
        bf16x8 pa0, pa1, pa2, pa3; \
        PK4(p0, 0, pa0); PK4(p0, 8, pa1); PK4(p1, 0, pa2); PK4(p1, 8, pa3); \
        SBAR(); \
        { const int vb = vb0 + cur * SHM_V; \
          pv_one<0>(o[0], vb, pa0, pa1, pa2, pa3); pv_one<1>(o[1], vb, pa0, pa1, pa2, pa3); pv_one<2>(o[2], vb, pa0, pa1, pa2, pa3); pv_one<3>(o[3], vb, pa0, pa1, pa2, pa3); } \
        if (j + 1 < NT) SWRITE(cur ^ 1, W_); \
        __syncthreads(); \
    } while (0)
    {
        SLOAD(2, A);
        f32x16 p1 = f32x16{};
#pragma unroll
        for (int d0 = 0; d0 < 4; ++d0) {
            const int cb = (comp * 64 + d0 * 16 + hi * 8) * 2;
            const bf16x8 b1 = *reinterpret_cast<const bf16x8*>(K_lds + KSWZ(32 + r32, cb));
            p1 = __builtin_amdgcn_mfma_f32_32x32x16_bf16(b1, qr[d0], p1, 0, 0, 0);
        }
        float pmax = p1[8];
#pragma unroll
        for (int r = 9; r < 16; ++r) pmax = fmaxf(pmax, p1[r]);
        { auto rr = __builtin_amdgcn_permlane32_swap(__float_as_uint(pmax), __float_as_uint(pmax), false, false); pmax = fmaxf(__uint_as_float(rr[0]), __uint_as_float(rr[1])); }
        m_reg = pmax;
        float ps = 0.f;
#pragma unroll
        for (int r = 0; r < 8; ++r) p1[r] = 0.f;
#pragma unroll
        for (int r = 8; r < 16; ++r) { p1[r] = __builtin_amdgcn_exp2f(p1[r] - pmax); ps += p1[r]; }
        { auto rr = __builtin_amdgcn_permlane32_swap(__float_as_uint(ps), __float_as_uint(ps), false, false); ps = __uint_as_float(rr[0]) + __uint_as_float(rr[1]); }
        l_reg = ps;
        bf16x8 pa3; PK4(p1, 8, pa3);
        SBAR();
        {
#define PKF(L, H) (bf16x8){L[0], L[1], L[2], L[3], H[0], H[1], H[2], H[3]}
            const s16x4 l0 = tr_read<v_rd_off(0, 3, 0)>(vb0), h0 = tr_read<v_rd_off(0, 3, 1)>(vb0), l1 = tr_read<v_rd_off(1, 3, 0)>(vb0), h1 = tr_read<v_rd_off(1, 3, 1)>(vb0);
            const s16x4 l2 = tr_read<v_rd_off(2, 3, 0)>(vb0), h2 = tr_read<v_rd_off(2, 3, 1)>(vb0), l3 = tr_read<v_rd_off(3, 3, 0)>(vb0), h3 = tr_read<v_rd_off(3, 3, 1)>(vb0);
            asm volatile("s_waitcnt lgkmcnt(0)" ::: "memory"); SBAR();
            o[0] = __builtin_amdgcn_mfma_f32_32x32x16_bf16(pa3, PKF(l0, h0), o[0], 0, 0, 0); o[1] = __builtin_amdgcn_mfma_f32_32x32x16_bf16(pa3, PKF(l1, h1), o[1], 0, 0, 0);
            o[2] = __builtin_amdgcn_mfma_f32_32x32x16_bf16(pa3, PKF(l2, h2), o[2], 0, 0, 0); o[3] = __builtin_amdgcn_mfma_f32_32x32x16_bf16(pa3, PKF(l3, h3), o[3], 0, 0, 0);
#undef PKF
        }
        SWRITE(1, B);
        __syncthreads();
    }
    for (int j = 1; j < NT; j += 2) { ATT_TILE(j, B, A); ATT_TILE(j + 1, A, B); }
#undef ATT_TILE
#undef SLOAD
#undef SWRITE
#undef PK4
    if (hi == 0) wsf[r32] = l_reg;
    asm volatile("s_waitcnt lgkmcnt(0)" ::: "memory");
    float rli[16];
#pragma unroll
    for (int r = 0; r < 16; ++r) rli[r] = __builtin_amdgcn_rcpf(wsf[crow(r, hi)]);
    float* X = (float*)lds + rg * 4096;
    if (comp == 1) {
#pragma unroll
        for (int d0 = 0; d0 < 4; ++d0)
#pragma unroll
            for (int r = 0; r < 16; ++r) X[(d0 * 16 + r) * 64 + lane] = o[d0][r] * rli[r] * lam;
    }
    __syncthreads();
    if (comp == 0) {
        float ssr[16];
#pragma unroll
        for (int r = 0; r < 16; ++r) ssr[r] = 0.f;
#pragma unroll
        for (int d0 = 0; d0 < 4; ++d0)
#pragma unroll
            for (int r = 0; r < 16; ++r) { const float v = o[d0][r] * rli[r] - X[(d0 * 16 + r) * 64 + lane]; o[d0][r] = v; ssr[r] += v * v; }
        float* P = (float*)(lds + L_P) + rg * 1024;
#pragma unroll
        for (int r = 0; r < 16; ++r) P[r * 64 + lane] = ssr[r];
        asm volatile("s_waitcnt lgkmcnt(0)" ::: "memory");
        {
            const int rho = lane & 31, hh = (rho >> 2) & 1, rr = (rho & 3) + 4 * (rho >> 3);
            const float4* pp = (const float4*)(P + rr * 64 + hh * 32 + (lane >> 5) * 16);
            const float4 a0 = pp[0], a1 = pp[1], a2 = pp[2], a3 = pp[3];
            float s = ((a0.x + a0.y) + (a0.z + a0.w)) + ((a1.x + a1.y) + (a1.z + a1.w)) + ((a2.x + a2.y) + (a2.z + a2.w)) + ((a3.x + a3.y) + (a3.z + a3.w));
            auto sw = __builtin_amdgcn_permlane32_swap(__float_as_uint(s), __float_as_uint(s), false, false); s = __uint_as_float(sw[0]) + __uint_as_float(sw[1]);
            if (lane < 32) wsf[32 + rho] = rsqrtf(s * (1.f / 128.f) + EPS) * (1.f - LAMBDA_INIT);
        }
        asm volatile("s_waitcnt lgkmcnt(0)" ::: "memory");
        float sw4[4];
#pragma unroll
        for (int d0 = 0; d0 < 4; ++d0) sw4[d0] = subln[d0 * 32 + r32];
        bf16_t* Ow = MIX + (size_t)(q0 + rg * 32) * DM + h * 128 + r32;
#pragma unroll
        for (int r = 0; r < 16; ++r) {
            const int orow = crow(r, hi); const float rs = wsf[32 + orow];
#pragma unroll
            for (int d0 = 0; d0 < 4; ++d0) Ow[(size_t)orow * DM + d0 * 32] = (bf16_t)f2bf(o[d0][r] * rs * sw4[d0]);
        }
    }
    __syncthreads();
}
#undef KSWZ
#undef SBAR
}

__device__ __forceinline__ float attn_lambda(const Args& a) {
    const int lane = opaque_tid() & 63;
    const float l1 = wave_sum(a.lamqk[lane] * a.lamqk[64 + lane]), l2 = wave_sum(a.lamqk[128 + lane] * a.lamqk[192 + lane]);
    return expf(l1) - expf(l2) + LAMBDA_INIT;
}
namespace mls {
using bf16x8 = __attribute__((ext_vector_type(8))) short;
using bf16x4 = __attribute__((ext_vector_type(4))) short;
using s16x4 = __attribute__((ext_vector_type(4))) short;
using f32x16 = __attribute__((ext_vector_type(16))) float;
using f32x4v = __attribute__((ext_vector_type(4))) float;
using u32x4v = __attribute__((ext_vector_type(4))) unsigned;
using u32x2v = __attribute__((ext_vector_type(2))) unsigned;
constexpr int L_QS = 0, L_QP = 16384, L_KS = 32768, L_KW = 49152, L_VT = 65536, L_PT = 98304, L_HT = 106496, HT_STRIDE = 528;
constexpr int L_MISC = L_HT + 64 * HT_STRIDE;
constexpr int L_RS = L_MISC, L_QN = L_RS + 2 * 64 * 4, L_NV = L_QN + 64 * 4, L_NP = L_NV + 128 * 4, L_CW = L_NP + 8 * 128 * 4, L_RD = L_CW + 5 * 256 * 4, L_NW = L_RD + 8 * 64 * 4, L_END = L_NW + 8 * 36 * 4;
#define KSWZ(row, colB) ((row) * 256 + ((colB) ^ (((row) & 7) << 4)))
#define PSWZ(row, colB) ((row) * 128 + ((colB) ^ ((((row) >> 1) & 7) << 4)))
__device__ __forceinline__ int crow(int r, int hi) { return (r & 3) + 8 * (r >> 2) + 4 * hi; }
__device__ __forceinline__ unsigned cvtpk(float lo, float hi) { unsigned r; asm volatile("v_cvt_pk_bf16_f32 %0, %1, %2" : "=v"(r) : "v"(lo), "v"(hi)); return r; }
__device__ __forceinline__ int v_st(int k, int c) { const int kk = (k & ~0xC) | ((k & 4) << 1) | ((k & 8) >> 1); return ((kk >> 3) * 4 + (c >> 5)) * 512 + ((kk & 7) * 32 + (c & 31)) * 2; }
__device__ __forceinline__ int v_rd_base(int lane) { return ((lane & 3) << 3) | (((lane >> 2) & 3) << 6) | (((lane >> 4) & 1) << 5) | (((lane >> 5) & 1) << 8); }
__device__ __forceinline__ s16x4 tr_read_dyn(int addr) { s16x4 r; asm volatile("ds_read_b64_tr_b16 %0, %1" : "=&v"(r) : "v"(addr) : "memory"); return r; }
__device__ __forceinline__ bf16x8 tr_frag(int img_plus_base, int d0, int ks) {
    const s16x4 lo = tr_read_dyn(img_plus_base + d0 * 512 + ks * 4096), hi = tr_read_dyn(img_plus_base + d0 * 512 + ks * 4096 + 2048);
    return (bf16x8){lo[0], lo[1], lo[2], lo[3], hi[0], hi[1], hi[2], hi[3]};
}
template <int CTRL, int RMASK> __device__ __forceinline__ float dppf(float old, float v) { return __builtin_bit_cast(float, __builtin_amdgcn_update_dpp(__builtin_bit_cast(int, old), __builtin_bit_cast(int, v), CTRL, RMASK, 0xf, false)); }
__device__ __forceinline__ float scan_add(float v) {
    v += dppf<0x111, 0xf>(0.f, v); v += dppf<0x112, 0xf>(0.f, v); v += dppf<0x114, 0xf>(0.f, v); v += dppf<0x118, 0xf>(0.f, v);
    v += dppf<0x142, 0xa>(0.f, v); v += dppf<0x143, 0xc>(0.f, v); return v;
}
__device__ __forceinline__ float scan_max(float v) {
    const float NI = -3.0e38f;
    v = fmaxf(v, dppf<0x111, 0xf>(NI, v)); v = fmaxf(v, dppf<0x112, 0xf>(NI, v)); v = fmaxf(v, dppf<0x114, 0xf>(NI, v)); v = fmaxf(v, dppf<0x118, 0xf>(NI, v));
    v = fmaxf(v, dppf<0x142, 0xa>(NI, v)); v = fmaxf(v, dppf<0x143, 0xc>(NI, v)); return v;
}
__device__ __forceinline__ float rlane(float v, int l) { return __uint_as_float(__builtin_amdgcn_readlane(__float_as_uint(v), l)); }
__device__ __forceinline__ float silu(float x) { return x * __builtin_amdgcn_rcpf(1.f + __expf(-x)); }
__device__ __forceinline__ void fmac_v(float& y, float a, float b) { asm("v_fmac_f32 %0, %1, %2" : "+v"(y) : "v"(a), "v"(b)); }
__device__ __forceinline__ float mul_v(float a, float b) { float r; asm("v_mul_f32 %0, %1, %2" : "=v"(r) : "v"(a), "v"(b)); return r; }

__device__ __forceinline__ void mlstm_item(int b, int h, const Args& a, char* lds) {
    const int tid0 = opaque_tid(), wid = __builtin_amdgcn_readfirstlane(tid0 >> 6);
    const bf16_t* Z = (const bf16_t*)(a.ws + WS_Z); const float* G = (const float*)(a.ws + WS_GATES); bf16_t* MIX = (bf16_t*)(a.ws + WS_MIX);
    const int ldsb = (int)(uintptr_t)lds;
    float* RS = (float*)(lds + L_RS); float* QN = (float*)(lds + L_QN); float* NV = (float*)(lds + L_NV); float* NP = (float*)(lds + L_NP); float* CW = (float*)(lds + L_CW);
    for (int i = tid0; i < 5 * 256; i += NTHREADS) { const int j = i >> 8, c = i & 255; const int cc = c < 128 ? h * 128 + c : 512 + h * 128 + (c - 128); CW[i] = j < 4 ? a.convw[j * 1024 + cc] : a.convb[cc]; }
    if (tid0 < 128) NV[tid0] = 0.f;
    if (tid0 < 256) ((float*)(lds + L_NW))[(tid0 >> 5) * 36 + (tid0 & 31)] = a.mnw[h * 256 + tid0];
    const float ibh = a.ib[h], fbh = a.fb[h];
    float cw[4][4], cb[4];
    __syncthreads();
    { const int c4 = 4 * (tid0 & 63);
#pragma unroll
    for (int j = 0; j < 4; ++j)
#pragma unroll
        for (int q = 0; q < 4; ++q) cw[j][q] = CW[j * 256 + c4 + q];
#pragma unroll
    for (int q = 0; q < 4; ++q) cb[q] = CW[4 * 256 + c4 + q]; }
    f32x16 C[4] = {};
    float m_prev = -1e30f;
    u32x2v rq[11]; u32x4v rv[4]; float gi, gf;
    auto chunk_row0 = [&](int c) -> int { return c == 0 ? META_TILE0 : b * SEQ + (c - 1) * 64; };
#define LOAD_RAW(c) do { int tq_ = tid0; asm volatile("" : "+v"(tq_)); const int ln_ = tq_ & 63, c4_ = 4 * ln_, zc_qk = (c4_ < 128 ? ZMQ + h * 128 + c4_ : ZMK + h * 128 + (c4_ - 128)), erow = tq_ >> 3, eseg = tq_ & 7; const int r0_ = chunk_row0(c); \
        _Pragma("unroll") for (int i_ = 0; i_ < 11; ++i_) { const int t_ = 8 * wid - 3 + i_; int row_; bool ok_ = true; \
            if (t_ >= 0) row_ = r0_ + t_; else if ((c) == 0) { row_ = 0; ok_ = false; } else if ((c) == 1) row_ = META_TILE0 + 64 + t_; else row_ = r0_ + t_; \
            rq[i_] = ok_ ? *(const u32x2v*)(Z + (size_t)row_ * NZ + zc_qk) : (u32x2v){0u, 0u}; } \
        _Pragma("unroll") for (int i_ = 0; i_ < 4; ++i_) rv[i_] = *(const u32x4v*)(Z + (size_t)(r0_ + erow) * NZ + ZMV + h * 256 + eseg * 32 + 8 * i_); \
        { const int rowg_ = r0_ + ln_; gi = G[(size_t)rowg_ * 8 + h]; gf = G[(size_t)rowg_ * 8 + 4 + h]; } } while (0)
    LOAD_RAW(0);
    const int NCH = 33;
    for (int c = 0; c < NCH; ++c) {
        int tid = tid0; asm volatile("" : "+v"(tid));
        const int lane = tid & 63, r32 = lane & 31, hi = lane >> 5, cq = lane, c4 = 4 * cq, erow = tid >> 3, eseg = tid & 7;
        float* RD = (float*)(lds + L_RD) + wid * 64;
        float li = gi + ibh; float lf; { const float xf = gf + fbh; lf = fminf(xf, 0.f) - __logf(1.f + __expf(-fabsf(xf))); }
        if (c == 0 && lane < 48) { li = -1e30f; lf = 0.f; }
        const float bsum = scan_add(lf);
        const float u = li - bsum;
        const float cm = scan_max(u);
        const float Mrow = fmaxf(cm, m_prev);
        const float iw = __expf(m_prev - Mrow);
        const float Mend = rlane(Mrow, 63), gtot = rlane(bsum, 63);
        const float wrow = __expf(u - Mend);
        const float dec = __expf(m_prev - Mend);
        const float dexp = __expf(-(bsum + Mrow));
        {
            float qn_part[8], ksum[4] = {0.f, 0.f, 0.f, 0.f};
            float nvv[4];
#pragma unroll
            for (int q = 0; q < 4; ++q) nvv[q] = (cq < 32) ? NV[c4 + q] : 0.f;
#pragma unroll
            for (int i = 0; i < 8; ++i) {
                const int t = 8 * wid + i;
                float xo[4];
#pragma unroll
                for (int q = 0; q < 4; ++q) xo[q] = cb[q];
#pragma unroll
                for (int j = 0; j < 4; ++j) {
                    const u32x2v rr = rq[i + j];
                    fmac_v(xo[0], cw[j][0], bf_lo(rr.x)); fmac_v(xo[1], cw[j][1], bf_hi(rr.x)); fmac_v(xo[2], cw[j][2], bf_lo(rr.y)); fmac_v(xo[3], cw[j][3], bf_hi(rr.y));
                }
#pragma unroll
                for (int q = 0; q < 4; ++q) xo[q] = silu(xo[q]);
                const float iw_t = rlane(iw, t), w_t = rlane(wrow, t);
                if (cq < 32) {
#pragma unroll
                    for (int q = 0; q < 4; ++q) xo[q] = mul_v(xo[q], 0.08838834764831845f);
                    *(uint2*)(lds + L_QS + KSWZ(t, c4 * 2)) = make_uint2(cvtpk(xo[0], xo[1]), cvtpk(xo[2], xo[3]));
                    float qd = 0.f;
#pragma unroll
                    for (int q = 0; q < 4; ++q) { fmac_v(qd, xo[q], nvv[q]); xo[q] = mul_v(xo[q], iw_t); }
                    *(uint2*)(lds + L_QP + KSWZ(t, c4 * 2)) = make_uint2(cvtpk(xo[0], xo[1]), cvtpk(xo[2], xo[3]));
                    qn_part[i] = iw_t * qd;
                } else {
                    const int kc = c4 - 128;
                    *(uint2*)(lds + L_KS + KSWZ(t, kc * 2)) = make_uint2(cvtpk(xo[0], xo[1]), cvtpk(xo[2], xo[3]));
#pragma unroll
                    for (int q = 0; q < 4; ++q) { xo[q] = mul_v(xo[q], w_t); ksum[q] += xo[q]; }
                    *(uint2*)(lds + L_KW + v_st(t, kc)) = make_uint2(cvtpk(xo[0], xo[1]), cvtpk(xo[2], xo[3]));
                    qn_part[i] = 0.f;
                }
                __builtin_amdgcn_sched_barrier(0);
            }
            {
                float r4[4], r2[2], r1;
                { const bool hb = (lane & 16) != 0;
#pragma unroll
                  for (int i = 0; i < 4; ++i) { const float send = hb ? qn_part[i] : qn_part[i + 4]; const float recv = __shfl_xor(send, 16); r4[i] = (hb ? qn_part[i + 4] : qn_part[i]) + recv; } }
                { const bool hb = (lane & 8) != 0;
#pragma unroll
                  for (int i = 0; i < 2; ++i) { const float send = hb ? r4[i] : r4[i + 2]; const float recv = __shfl_xor(send, 8); r2[i] = (hb ? r4[i + 2] : r4[i]) + recv; } }
                { const bool hb = (lane & 4) != 0; const float send = hb ? r2[0] : r2[1]; const float recv = __shfl_xor(send, 4); r1 = (hb ? r2[1] : r2[0]) + recv; }
                r1 += __shfl_xor(r1, 2); r1 += __shfl_xor(r1, 1);
                if (lane < 32 && (lane & 3) == 0) QN[8 * wid + ((lane >> 4) & 1) * 4 + ((lane >> 3) & 1) * 2 + ((lane >> 2) & 1)] = r1;
            }
            if (cq >= 32) {
#pragma unroll
                for (int q = 0; q < 4; ++q) NP[wid * 128 + (c4 - 128) + q] = ksum[q];
            }
#pragma unroll
            for (int i = 0; i < 4; ++i) *(u32x4v*)(lds + L_VT + (eseg >> 2) * 16384 + v_st(erow, (eseg & 3) * 32 + 8 * i)) = rv[i];
        }
        u32x4v zo[4];
        {
            const int r0 = chunk_row0(c);
#pragma unroll
            for (int i = 0; i < 4; ++i) zo[i] = *(const u32x4v*)(Z + (size_t)(r0 + erow) * NZ + ZMO + h * 256 + eseg * 32 + 8 * i);
        }
        if (c + 1 < NCH) LOAD_RAW(c + 1);
        __syncthreads();
        {
            const int tb = wid >> 1, half = wid & 1;
            float rsum[4] = {0.f, 0.f, 0.f, 0.f};
            const int fr = lane & 15, fq = lane >> 4;
            float Mt[4];
#pragma unroll
            for (int i = 0; i < 4; ++i) Mt[i] = __shfl(Mrow, 16 * tb + 4 * fq + i);
#pragma unroll
            for (int sj = 0; sj < 2; ++sj) {
                const int sb = 2 * half + sj;
                unsigned short pw[4] = {0, 0, 0, 0};
                if (sb <= tb) {
                    f32x4v acc = {0.f, 0.f, 0.f, 0.f};
#pragma unroll
                    for (int ks = 0; ks < 4; ++ks) {
                        const bf16x8 af = *(const bf16x8*)(lds + L_QS + KSWZ(16 * tb + fr, (32 * ks + 8 * fq) * 2));
                        const bf16x8 bfr = *(const bf16x8*)(lds + L_KS + KSWZ(16 * sb + fr, (32 * ks + 8 * fq) * 2));
                        acc = __builtin_amdgcn_mfma_f32_16x16x32_bf16(af, bfr, acc, 0, 0, 0);
                    }
                    const int s = 16 * sb + fr; const float us = __shfl(u, s);
#pragma unroll
                    for (int i = 0; i < 4; ++i) {
                        const int t = 16 * tb + 4 * fq + i;
                        const float p = (s <= t) ? acc[i] * __expf(us - Mt[i]) : 0.f;
                        rsum[i] += p; pw[i] = (unsigned short)f2bf(p);
                    }
                }
#pragma unroll
                for (int i = 0; i < 4; ++i) *(unsigned short*)(lds + L_PT + PSWZ(16 * tb + 4 * fq + i, (16 * sb + fr) * 2)) = pw[i];
            }
#pragma unroll
            for (int i = 0; i < 4; ++i) {
                float v = rsum[i];
                v += __shfl_xor(v, 1); v += __shfl_xor(v, 2); v += __shfl_xor(v, 4); v += __shfl_xor(v, 8);
                if (fr == 0) RS[half * 64 + 16 * tb + 4 * fq + i] = v;
            }
        }
        __syncthreads();
        {
            const float nq = RS[lane] + RS[64 + lane] + QN[lane];
            RD[lane] = __builtin_amdgcn_rcpf(fmaxf(fabsf(nq), dexp));
            bf16x8 vf[4];
            const int vimg = ldsb + L_VT + (wid >> 2) * 16384 + v_rd_base(lane);
#pragma unroll
            for (int ks = 0; ks < 4; ++ks) vf[ks] = tr_frag(vimg, wid & 3, ks);
            asm volatile("s_waitcnt lgkmcnt(0)" ::: "memory"); __builtin_amdgcn_sched_barrier(0);
            f32x16 acc[2] = {};
#pragma unroll
            for (int rb = 0; rb < 2; ++rb) {
                const int row = 32 * rb + r32;
#pragma unroll
                for (int ks = 0; ks < 4; ++ks) {
                    if (rb == 0 && ks >= 2) continue;
                    const bf16x8 pf = *(const bf16x8*)(lds + L_PT + PSWZ(row, (16 * ks + 8 * hi) * 2));
                    acc[rb] = __builtin_amdgcn_mfma_f32_32x32x16_bf16(pf, vf[ks], acc[rb], 0, 0, 0);
                }
            }
#pragma unroll
            for (int kb = 0; kb < 4; ++kb)
#pragma unroll
                for (int sp = 0; sp < 2; ++sp) {
                    bf16x8 cf; { unsigned w0 = cvtpk(C[kb][8 * sp + 0], C[kb][8 * sp + 1]), w1 = cvtpk(C[kb][8 * sp + 2], C[kb][8 * sp + 3]), w2 = cvtpk(C[kb][8 * sp + 4], C[kb][8 * sp + 5]), w3 = cvtpk(C[kb][8 * sp + 6], C[kb][8 * sp + 7]);
                        typedef unsigned u32x4_ __attribute__((ext_vector_type(4))); u32x4_ ww = {w0, w1, w2, w3}; cf = __builtin_bit_cast(bf16x8, ww); }
                    const int base = 32 * kb + 16 * sp;
#pragma unroll
                    for (int rb = 0; rb < 2; ++rb) {
                        const int row = 32 * rb + r32;
                        const bf16x4 q0 = *(const bf16x4*)(lds + L_QP + KSWZ(row, (base + 4 * hi) * 2));
                        const bf16x4 q1 = *(const bf16x4*)(lds + L_QP + KSWZ(row, (base + 8 + 4 * hi) * 2));
                        const bf16x8 qf = {q0[0], q0[1], q0[2], q0[3], q1[0], q1[1], q1[2], q1[3]};
                        acc[rb] = __builtin_amdgcn_mfma_f32_32x32x16_bf16(qf, cf, acc[rb], 0, 0, 0);
                    }
                }
            asm volatile("s_waitcnt lgkmcnt(0)" ::: "memory");
#pragma unroll
            for (int rb = 0; rb < 2; ++rb)
#pragma unroll
                for (int r = 0; r < 16; ++r) {
                    const int row = 32 * rb + crow(r, hi);
                    *(unsigned short*)(lds + L_HT + row * HT_STRIDE + (32 * wid + r32) * 2) = (unsigned short)f2bf(acc[rb][r] * RD[row]);
                }
#pragma unroll
            for (int kb = 0; kb < 4; ++kb) {
#pragma unroll
                for (int r = 0; r < 16; ++r) C[kb][r] *= dec;
                const int kimg = ldsb + L_KW + v_rd_base(lane);
                bf16x8 kf[4];
#pragma unroll
                for (int ks = 0; ks < 4; ++ks) kf[ks] = tr_frag(kimg, kb, ks);
                asm volatile("s_waitcnt lgkmcnt(0)" ::: "memory"); __builtin_amdgcn_sched_barrier(0);
#pragma unroll
                for (int ks = 0; ks < 4; ++ks) C[kb] = __builtin_amdgcn_mfma_f32_32x32x16_bf16(kf[ks], vf[ks], C[kb], 0, 0, 0);
            }
            if (tid < 128) { float s = NV[tid] * dec;
#pragma unroll
                for (int w8 = 0; w8 < 8; ++w8) s += NP[w8 * 128 + tid];
                NV[tid] = s; }
        }
        m_prev = gtot + Mend;
        __syncthreads();
        if (c > 0) {
            float hv[32]; float ss = 0.f;
#pragma unroll
            for (int i = 0; i < 4; ++i) {
                const uint4 w = *(const uint4*)(lds + L_HT + erow * HT_STRIDE + eseg * 64 + 16 * i);
                hv[8 * i + 0] = bf_lo(w.x); hv[8 * i + 1] = bf_hi(w.x); hv[8 * i + 2] = bf_lo(w.y); hv[8 * i + 3] = bf_hi(w.y);
                hv[8 * i + 4] = bf_lo(w.z); hv[8 * i + 5] = bf_hi(w.z); hv[8 * i + 6] = bf_lo(w.w); hv[8 * i + 7] = bf_hi(w.w);
            }
#pragma unroll
            for (int i = 0; i < 32; ++i) ss += hv[i] * hv[i];
            ss += __shfl_xor(ss, 1); ss += __shfl_xor(ss, 2); ss += __shfl_xor(ss, 4);
            const float rstd = rsqrtf(ss * (1.f / 256.f) + EPS);
            const float* nw = (const float*)(lds + L_NW) + eseg * 36;
            bf16_t* op = MIX + (size_t)(chunk_row0(c) + erow) * DM + 1024 + h * 256 + eseg * 32;
#pragma unroll
            for (int i = 0; i < 4; ++i) {
                const unsigned zz[4] = {zo[i].x, zo[i].y, zo[i].z, zo[i].w};
                unsigned ow[4];
#pragma unroll
                for (int q = 0; q < 4; ++q) {
                    const float z0 = bf_lo(zz[q]), z1 = bf_hi(zz[q]);
                    const float o0 = hv[8 * i + 2 * q] * rstd * nw[8 * i + 2 * q] * __builtin_amdgcn_rcpf(1.f + __expf(-z0));
                    const float o1 = hv[8 * i + 2 * q + 1] * rstd * nw[8 * i + 2 * q + 1] * __builtin_amdgcn_rcpf(1.f + __expf(-z1));
                    ow[q] = pk2(o0, o1);
                }
                *(uint4*)(op + 8 * i) = make_uint4(ow[0], ow[1], ow[2], ow[3]);
            }
        }
    }
#undef LOAD_RAW
    __syncthreads();
}
#undef KSWZ
#undef PSWZ
}

namespace rt {
using bf16x8 = __attribute__((ext_vector_type(8))) short;
using f32x16 = __attribute__((ext_vector_type(16))) float;
#define CE(a, b) do { const unsigned x_ = (a), y_ = (b); (a) = x_ > y_ ? x_ : y_; (b) = x_ > y_ ? y_ : x_; } while (0)
#define SORT16_DESC(V) do { CE(V[0], V[1]); CE(V[2], V[3]); CE(V[0], V[2]); CE(V[1], V[3]); CE(V[1], V[2]); CE(V[4], V[5]); CE(V[6], V[7]); CE(V[4], V[6]); CE(V[5], V[7]); CE(V[5], V[6]); CE(V[0], V[4]); CE(V[2], V[6]); CE(V[2], V[4]); CE(V[1], V[5]); CE(V[3], V[7]); CE(V[3], V[5]); CE(V[1], V[2]); CE(V[3], V[4]); CE(V[5], V[6]); CE(V[8], V[9]); CE(V[10], V[11]); CE(V[8], V[10]); CE(V[9], V[11]); CE(V[9], V[10]); CE(V[12], V[13]); CE(V[14], V[15]); CE(V[12], V[14]); CE(V[13], V[15]); CE(V[13], V[14]); CE(V[8], V[12]); CE(V[10], V[14]); CE(V[10], V[12]); CE(V[9], V[13]); CE(V[11], V[15]); CE(V[11], V[13]); CE(V[9], V[10]); CE(V[11], V[12]); CE(V[13], V[14]); CE(V[0], V[8]); CE(V[4], V[12]); CE(V[4], V[8]); CE(V[2], V[10]); CE(V[6], V[14]); CE(V[6], V[10]); CE(V[2], V[4]); CE(V[6], V[8]); CE(V[10], V[12]); CE(V[1], V[9]); CE(V[5], V[13]); CE(V[5], V[9]); CE(V[3], V[11]); CE(V[7], V[15]); CE(V[7], V[11]); CE(V[3], V[5]); CE(V[7], V[9]); CE(V[11], V[13]); CE(V[1], V[2]); CE(V[3], V[4]); CE(V[5], V[6]); CE(V[7], V[8]); CE(V[9], V[10]); CE(V[11], V[12]); CE(V[13], V[14]); } while (0)
#define BMERGE16_DESC(V) do { CE(V[0], V[8]); CE(V[1], V[9]); CE(V[2], V[10]); CE(V[3], V[11]); CE(V[4], V[12]); CE(V[5], V[13]); CE(V[6], V[14]); CE(V[7], V[15]); CE(V[0], V[4]); CE(V[1], V[5]); CE(V[2], V[6]); CE(V[3], V[7]); CE(V[8], V[12]); CE(V[9], V[13]); CE(V[10], V[14]); CE(V[11], V[15]); CE(V[0], V[2]); CE(V[1], V[3]); CE(V[4], V[6]); CE(V[5], V[7]); CE(V[8], V[10]); CE(V[9], V[11]); CE(V[12], V[14]); CE(V[13], V[15]); CE(V[0], V[1]); CE(V[2], V[3]); CE(V[4], V[5]); CE(V[6], V[7]); CE(V[8], V[9]); CE(V[10], V[11]); CE(V[12], V[13]); CE(V[14], V[15]); } while (0)

#define TOP16(A, B) do { _Pragma("unroll") for (int i_ = 0; i_ < 16; ++i_) { const unsigned x_ = A[i_], y_ = B[15 - i_]; A[i_] = x_ > y_ ? x_ : y_; } BMERGE16_DESC(A); } while (0)
__device__ __forceinline__ unsigned ord_key(float f) { const unsigned u = __float_as_uint(f); return u ^ (((unsigned)((int)u >> 31)) | 0x80000000u); }
__device__ __forceinline__ float ord_val(unsigned k) { return __uint_as_float((k & 0x80000000u) ? (k ^ 0x80000000u) : ~k); }
__device__ __forceinline__ int crow(int r, int hi) { return (r & 3) + 8 * (r >> 2) + 4 * hi; }

__device__ __forceinline__ void route_item(int tb, int h, const bf16_t* QP, const bf16_t* SKB, const float* SSQ, int* IDX, float* GATE, int* scr, int lane_in) {
    int lane = lane_in; asm volatile("" : "+v"(lane));
    const int tok = lane & 31, hi = lane >> 5;
    const int row = tb * 32 + tok;
    float rstd;
    { const float4* sp = (const float4*)(SSQ + (size_t)row * 32); float s = 0.f;
#pragma unroll
      for (int i = 0; i < 8; ++i) { const float4 v = sp[i]; s += (v.x + v.y) + (v.z + v.w); }
      rstd = rsqrtf(s * (1.f / DM) + EPS); }
    unsigned top[2][16];
    bf16x8 qf[8], af[2][8];
    unsigned T[16];
#define RT_LOADQ(p_) do { const bf16_t* qp_ = QP + (size_t)row * DM + h * 256 + (p_) * 128 + hi * 8; \
        _Pragma("unroll") for (int ks = 0; ks < 8; ++ks) qf[ks] = *reinterpret_cast<const bf16x8*>(qp_ + ks * 16); } while (0)
#define RT_LOADK(b_, i_) do { const bf16_t* kp_ = SKB + ((size_t)((h * 2 + ((i_) >> 2)) * 128 + ((i_) & 3) * 32 + tok)) * 128 + hi * 8; \
        _Pragma("unroll") for (int ks = 0; ks < 8; ++ks) af[b_][ks] = *reinterpret_cast<const bf16x8*>(kp_ + ks * 16); } while (0)
    RT_LOADQ(0); RT_LOADK(0, 0);
#pragma unroll
    for (int i = 0; i < 8; ++i) {
        const int p = i >> 2, kb = i & 3;
        if (i + 1 < 8) RT_LOADK((i + 1) & 1, i + 1);
        f32x16 acc = {};
#pragma unroll
        for (int ks = 0; ks < 8; ++ks) acc = __builtin_amdgcn_mfma_f32_32x32x16_bf16(af[i & 1][ks], qf[ks], acc, 0, 0, 0);
        unsigned K[16];
#pragma unroll
        for (int r = 0; r < 16; ++r) { const int low = 127 - (32 * kb + (r & 3) + 8 * (r >> 2)) - 4 * hi; K[r] = (ord_key(acc[r]) & ~127u) | (unsigned)low; }
        if (i == 3) RT_LOADQ(1);
        SORT16_DESC(K);
        if (kb == 0) {
#pragma unroll
            for (int j = 0; j < 16; ++j) T[j] = K[j];
        } else { TOP16(T, K); }
        if (kb == 3) {
            unsigned O[16];
#pragma unroll
            for (int j = 0; j < 16; ++j) { auto rr = __builtin_amdgcn_permlane32_swap(T[j], T[j], false, false); O[j] = hi ? rr[0] : rr[1]; }
            TOP16(T, O);
#pragma unroll
            for (int j = 0; j < 16; ++j) top[p][j] = T[j];
        }
        __builtin_amdgcn_sched_barrier(0);
    }
#undef RT_LOADQ
#undef RT_LOADK
    float s1[16], s2[16];
#pragma unroll
    for (int i = 0; i < 16; ++i) {
        s1[i] = ord_val(top[0][i] & ~127u) * rstd; s2[i] = ord_val(top[1][i] & ~127u) * rstd;
        scr[i * 64 + lane] = 127 - (int)(top[0][i] & 127u); scr[(16 + i) * 64 + lane] = 127 - (int)(top[1][i] & 127u);
    }
#define CKEY(a_, b_) ((ord_key(s1[a_] + s2[b_]) & ~255u) | (unsigned)(255 - (16 * (a_) + (b_))))
    unsigned A[16], B[16], Cg[16];
#pragma unroll
    for (int b_ = 0; b_ < 16; ++b_) A[b_] = CKEY(0, b_);
#pragma unroll
    for (int b_ = 0; b_ < 8; ++b_) { B[b_] = CKEY(1, b_); B[8 + b_] = CKEY(15 - b_, 0); }
    BMERGE16_DESC(B);
    Cg[0] = CKEY(2, 0); Cg[1] = CKEY(2, 1); Cg[2] = CKEY(2, 2); Cg[3] = CKEY(2, 3); Cg[4] = CKEY(2, 4);
    Cg[5] = CKEY(3, 0); Cg[6] = CKEY(3, 1); Cg[7] = CKEY(3, 2); Cg[8] = CKEY(3, 3);
    Cg[9] = CKEY(4, 0); Cg[10] = CKEY(4, 1); Cg[11] = CKEY(4, 2);
    Cg[12] = CKEY(5, 0); Cg[13] = CKEY(5, 1); Cg[14] = CKEY(6, 0); Cg[15] = CKEY(6, 1);
    SORT16_DESC(Cg);
    { const unsigned d0 = CKEY(7, 0), d1 = CKEY(7, 1); Cg[15] = Cg[15] > d0 ? Cg[15] : d0; Cg[14] = Cg[14] > d1 ? Cg[14] : d1; BMERGE16_DESC(Cg); }
    TOP16(A, B); TOP16(A, Cg);
#undef CKEY
    asm volatile("s_waitcnt lgkmcnt(0)" ::: "memory");
    float e[16]; float z = 0.f; const float mx = ord_val(A[0] & ~255u);
#pragma unroll
    for (int j = 0; j < 16; ++j) { e[j] = __expf(ord_val(A[j] & ~255u) - mx); z += e[j]; }
    const float rz = 1.f / z;
    int* ip = IDX + (size_t)row * 128 + h * 16 + hi * 8; float* gp = GATE + (size_t)row * 128 + h * 16 + hi * 8;
    int oi[8] = {0, 0, 0, 0, 0, 0, 0, 0}; float og[8] = {0.f, 0.f, 0.f, 0.f, 0.f, 0.f, 0.f, 0.f};
#pragma unroll
    for (int j = 0; j < 16; ++j) {
        const int flat = 255 - (int)(A[j] & 255u), a_ = flat >> 4, b_ = flat & 15;
        const int ex = scr[a_ * 64 + lane] * 128 + scr[(16 + b_) * 64 + lane];
        if (j < 8) { if (!hi) { oi[j] = ex; og[j] = e[j] * rz; } } else { if (hi) { oi[j - 8] = ex; og[j - 8] = e[j] * rz; } }
    }
    *(int4*)(ip) = make_int4(oi[0], oi[1], oi[2], oi[3]); *(int4*)(ip + 4) = make_int4(oi[4], oi[5], oi[6], oi[7]);
    *(float4*)(gp) = make_float4(og[0], og[1], og[2], og[3]); *(float4*)(gp + 4) = make_float4(og[4], og[5], og[6], og[7]);
    asm volatile("s_waitcnt lgkmcnt(0)" ::: "memory");
}
#undef CE
#undef TOP16
}

__device__ __forceinline__ void phase_route(const Args& a, unsigned char* lds, int bid, int nb) {
    const int tid = opaque_tid(), wave = __builtin_amdgcn_readfirstlane(tid >> 6), lane = tid & 63;
    const bf16_t* QP = (const bf16_t*)(a.ws + WS_MIX); const bf16_t* SKB = (const bf16_t*)(a.ws + WS_SKB); const float* SSQ = (const float*)(a.ws + WS_SSQ);
    int* IDX = (int*)(a.ws + WS_IDX); float* GATE = (float*)(a.ws + WS_GATE);
    int* scr = (int*)lds + wave * 2048;
    {
        const bf16_t* X1W = (const bf16_t*)(a.ws + WS_HN); signed char* X1Q = (signed char*)(a.ws + WS_X1Q); float* XSC = (float*)(a.ws + WS_XSC);
        for (int row = bid * NWAVES + wave; row < TREAL; row += nb * NWAVES) {
            uint4 xr[4]; float am = 0.f;
#pragma unroll
            for (int j = 0; j < 4; ++j) { xr[j] = *(const uint4*)(X1W + (size_t)row * DM + 8 * lane + 512 * j);
                am = fmaxf(am, fmaxf(fmaxf(fmaxf(fabsf(bf_lo(xr[j].x)), fabsf(bf_hi(xr[j].x))), fmaxf(fabsf(bf_lo(xr[j].y)), fabsf(bf_hi(xr[j].y)))), fmaxf(fmaxf(fabsf(bf_lo(xr[j].z)), fabsf(bf_hi(xr[j].z))), fmaxf(fabsf(bf_lo(xr[j].w)), fabsf(bf_hi(xr[j].w)))))); }
            am = wave_max(am);
            const float sc = am > 0.f ? 127.f / am : 0.f;
#pragma unroll
            for (int j = 0; j < 4; ++j) {
                const unsigned ww[4] = {xr[j].x, xr[j].y, xr[j].z, xr[j].w}; unsigned o[2] = {0u, 0u};
#pragma unroll
                for (int q = 0; q < 4; ++q) { const int q0 = (int)rintf(bf_lo(ww[q]) * sc), q1 = (int)rintf(bf_hi(ww[q]) * sc); o[q >> 1] |= ((unsigned)(q0 & 255) | ((unsigned)(q1 & 255) << 8)) << (16 * (q & 1)); }
                *(uint2*)(X1Q + (size_t)row * DM + 8 * lane + 512 * j) = make_uint2(o[0], o[1]);
            }
            if (lane == 0) XSC[row] = am * (1.f / 127.f);
        }
    }
    for (int item = bid * NWAVES + wave; item < (TREAL / 32) * 8; item += nb * NWAVES) rt::route_item(item >> 3, item & 7, QP, SKB, SSQ, IDX, GATE, scr, lane);
}

constexpr int CW_QPV = 8192, CW_QPU = 8192 + 8 * 64;
constexpr int PX_ITEMS = TREAL / 64;
constexpr size_t WS_W = WS_Z + 4 * MiB, WS_PART = WS_Z + 32 * MiB, WS_Y = WS_Z + 160 * MiB;


template <int CTRL, int RMASK> __device__ __forceinline__ float dppf(float old, float v) { return __builtin_bit_cast(float, __builtin_amdgcn_update_dpp(__builtin_bit_cast(int, old), __builtin_bit_cast(int, v), CTRL, RMASK, 0xf, false)); }
template <int CTRL> __device__ __forceinline__ int dppi(int v) { return __builtin_amdgcn_update_dpp(0, v, CTRL, 0xf, 0xf, false); }
namespace pu2 {
typedef float f32x2v __attribute__((ext_vector_type(2)));
typedef unsigned u32x4v __attribute__((ext_vector_type(4)));
#define SBP() __builtin_amdgcn_sched_barrier(0)
#define PU_CHUNK_LD(dst, r_, q_) dst = __builtin_amdgcn_raw_buffer_load_b128(RI, g128, (r_) * 512 + (q_) * 16, 0)
#define PU_ROW_LD(buf, e_) buf = __builtin_amdgcn_raw_buffer_load_b128(U, (int)(e_) * 256 + c16, 0, 0)
#define PU_CONSUME(buf, I_) do { int s_ = __builtin_amdgcn_sdot4((int)buf[0], hq0, 0, false); s_ = __builtin_amdgcn_sdot4((int)buf[1], hq1, s_, false); \
    s_ = __builtin_amdgcn_sdot4((int)buf[2], hq2, s_, false); s_ = __builtin_amdgcn_sdot4((int)buf[3], hq3, s_, false); \
    s_ += dppi<0x128>(s_); s_ += dppi<0x124>(s_); s_ += dppi<0x122>(s_); s_ += dppi<0x121>(s_); \
    if ((I_) < 16) keep0 = (c == ((I_) & 15)) ? s_ : keep0; else keep1 = (c == ((I_) & 15)) ? s_ : keep1; } while (0)
#define PU_TOKEN_BODY(row_, nrow_, has_next_) do { \
    PU_CHUNK_LD(C7, row_, 7); \
    SBP(); PU_CONSUME(B0, 0); \
    PU_ROW_LD(B0, C2.x); \
    SBP(); PU_CONSUME(B1, 1); \
    PU_ROW_LD(B1, C2.y); \
    SBP(); PU_CONSUME(B2, 2); \
    PU_ROW_LD(B2, C2.z); \
    SBP(); PU_CONSUME(B3, 3); \
    PU_ROW_LD(B3, C2.w); \
    if (has_next_) PU_CHUNK_LD(C0, nrow_, 0); \
    SBP(); PU_CONSUME(B4, 4); \
    PU_ROW_LD(B4, C3.x); \
    SBP(); PU_CONSUME(B5, 5); \
    PU_ROW_LD(B5, C3.y); \
    SBP(); PU_CONSUME(B6, 6); \
    PU_ROW_LD(B6, C3.z); \
    SBP(); PU_CONSUME(B7, 7); \
    PU_ROW_LD(B7, C3.w); \
    if (has_next_) PU_CHUNK_LD(C1, nrow_, 1); \
    SBP(); PU_CONSUME(B0, 8); \
    PU_ROW_LD(B0, C4.x); \
    SBP(); PU_CONSUME(B1, 9); \
    PU_ROW_LD(B1, C4.y); \
    SBP(); PU_CONSUME(B2, 10); \
    PU_ROW_LD(B2, C4.z); \
    SBP(); PU_CONSUME(B3, 11); \
    PU_ROW_LD(B3, C4.w); \
    if (has_next_) PU_CHUNK_LD(C2, nrow_, 2); \
    SBP(); PU_CONSUME(B4, 12); \
    PU_ROW_LD(B4, C5.x); \
    SBP(); PU_CONSUME(B5, 13); \
    PU_ROW_LD(B5, C5.y); \
    SBP(); PU_CONSUME(B6, 14); \
    PU_ROW_LD(B6, C5.z); \
    SBP(); PU_CONSUME(B7, 15); \
    PU_ROW_LD(B7, C5.w); \
    if (has_next_) PU_CHUNK_LD(C3, nrow_, 3); \
    SBP(); PU_CONSUME(B0, 16); \
    PU_ROW_LD(B0, C6.x); \
    SBP(); PU_CONSUME(B1, 17); \
    PU_ROW_LD(B1, C6.y); \
    SBP(); PU_CONSUME(B2, 18); \
    PU_ROW_LD(B2, C6.z); \
    SBP(); PU_CONSUME(B3, 19); \
    PU_ROW_LD(B3, C6.w); \
    if (has_next_) PU_CHUNK_LD(C4, nrow_, 4); \
    SBP(); PU_CONSUME(B4, 20); \
    PU_ROW_LD(B4, C7.x); \
    SBP(); PU_CONSUME(B5, 21); \
    PU_ROW_LD(B5, C7.y); \
    SBP(); PU_CONSUME(B6, 22); \
    PU_ROW_LD(B6, C7.z); \
    SBP(); PU_CONSUME(B7, 23); \
    PU_ROW_LD(B7, C7.w); \
    if (has_next_) PU_CHUNK_LD(C5, nrow_, 5); \
    SBP(); PU_CONSUME(B0, 24); \
    if (has_next_) PU_ROW_LD(B0, C0.x); \
    SBP(); PU_CONSUME(B1, 25); \
    if (has_next_) PU_ROW_LD(B1, C0.y); \
    SBP(); PU_CONSUME(B2, 26); \
    if (has_next_) PU_ROW_LD(B2, C0.z); \
    SBP(); PU_CONSUME(B3, 27); \
    if (has_next_) PU_ROW_LD(B3, C0.w); \
    if (has_next_) PU_CHUNK_LD(C6, nrow_, 6); \
    SBP(); PU_CONSUME(B4, 28); \
    if (has_next_) PU_ROW_LD(B4, C1.x); \
    SBP(); PU_CONSUME(B5, 29); \
    if (has_next_) PU_ROW_LD(B5, C1.y); \
    SBP(); PU_CONSUME(B6, 30); \
    if (has_next_) PU_ROW_LD(B6, C1.z); \
    SBP(); PU_CONSUME(B7, 31); \
    if (has_next_) PU_ROW_LD(B7, C1.w); \
    } while (0)
#undef SBP
}

__device__ __forceinline__ void phase_pu(const Args& a, unsigned char* lds, unsigned* ctl, int xcc) {
    using namespace pu2;
#define SBP() __builtin_amdgcn_sched_barrier(0)
    const int tid = opaque_tid(), wave = __builtin_amdgcn_readfirstlane(tid >> 6), lane = tid & 63;
    volatile LAS unsigned* slot = (volatile LAS unsigned*)((LAS unsigned char*)lds + LDS_MISC) + 2;
    const signed char* X1Q = (const signed char*)(a.ws + WS_X1Q); float* PART = (float*)(a.ws + WS_PART);
    const __amdgpu_buffer_rsrc_t RI = __builtin_amdgcn_make_buffer_rsrc((void*)(a.ws + WS_IDX), (short)0, TREAL * 512, 0x00020000);
    for (int ss = 0; ss < 8; ++ss) {
        const int s = (xcc + ss) & 7;
        const __amdgpu_buffer_rsrc_t U = __builtin_amdgcn_make_buffer_rsrc((void*)(a.ws + WS_U + (size_t)s * (16384 * 256)), (short)0, 16384 * 256, 0x00020000);
        for (;;) {
            const int item = next_item(ctl + CW_QPU + 64 * s, slot);
            if (item >= PX_ITEMS) break;
            int ln = lane; asm volatile("" : "+v"(ln));
            const int g = ln >> 4, c = ln & 15, c16 = c * 16, g128 = g * 128;
            const int r0 = item * 64 + wave * 8;
            u32x4v C0, C1, C2, C3, C4, C5, C6, C7, B0, B1, B2, B3, B4, B5, B6, B7;
            PU_CHUNK_LD(C0, r0, 0); PU_CHUNK_LD(C1, r0, 1); PU_CHUNK_LD(C2, r0, 2); PU_CHUNK_LD(C3, r0, 3); PU_CHUNK_LD(C4, r0, 4); PU_CHUNK_LD(C5, r0, 5); PU_CHUNK_LD(C6, r0, 6);
            uint4 nxq = *(const uint4*)(X1Q + (size_t)r0 * DM + 256 * s + 16 * c);
            PU_ROW_LD(B0, C0.x); PU_ROW_LD(B1, C0.y); PU_ROW_LD(B2, C0.z); PU_ROW_LD(B3, C0.w); PU_ROW_LD(B4, C1.x); PU_ROW_LD(B5, C1.y); PU_ROW_LD(B6, C1.z); PU_ROW_LD(B7, C1.w);
#pragma unroll 1
            for (int t = 0; t < 8; ++t) {
                const int row = r0 + t, nrow = row + 1; const bool has_next = t < 7;
                const int hq0 = (int)nxq.x, hq1 = (int)nxq.y, hq2 = (int)nxq.z, hq3 = (int)nxq.w;
                if (has_next) nxq = *(const uint4*)(X1Q + (size_t)nrow * DM + 256 * s + 16 * c);
                int keep0 = 0, keep1 = 0;
                PU_TOKEN_BODY(row, nrow, has_next);
                float* pp = PART + (size_t)row * 1024 + s * 128 + 32 * g + c;
                pp[0] = (float)keep0; pp[16] = (float)keep1;
            }
        }
    }
#undef SBP
}
__device__ __forceinline__ void phase_pc(const Args& a, int bid, int nb) {
    const int tid = opaque_tid(), wave = __builtin_amdgcn_readfirstlane(tid >> 6), lane = tid & 63;
    const float* SSQ = (const float*)(a.ws + WS_SSQ); const int* IDX = (const int*)(a.ws + WS_IDX); const float* GATE = (const float*)(a.ws + WS_GATE);
    const float* ISC = (const float*)(a.ws + WS_ISC); const float* PART = (const float*)(a.ws + WS_PART); unsigned short* W16 = (unsigned short*)(a.ws + WS_W); float* WSC = (float*)(a.ws + WS_W + 12 * MiB);
    for (int row = bid * NWAVES + wave; row < TREAL; row += nb * NWAVES) {
        float ssv = lane < 32 ? SSQ[(size_t)row * 32 + lane] : 0.f; ssv = wave_sum(ssv);
        const float rstd = rsqrtf(ssv * (1.f / DM) + EPS);
        const float xsc = ((const float*)(a.ws + WS_XSC))[row];
        float wv[2];
#pragma unroll
        for (int k = 0; k < 2; ++k) {
            const int p = 64 * k + lane; float d = 0.f;
#pragma unroll
            for (int s = 0; s < 8; ++s) d += PART[(size_t)row * 1024 + s * 128 + p];
            const int e = IDX[(size_t)row * 128 + p];
            const float pre = d * rstd * ISC[e] * xsc;
            wv[k] = GATE[(size_t)row * 128 + p] * ISC[16384 + e] * (0.5f * pre * (1.f + erff(pre * 0.7071067811865476f)));
        }
        const float wmax = wave_max(fmaxf(fabsf(wv[0]), fabsf(wv[1])));
        const float wsc = wmax > 0.f ? 240.f / wmax : 0.f;
#pragma unroll
        for (int k = 0; k < 2; ++k) {
            const float ws = wv[k] * wsc;
            const int hi = __builtin_amdgcn_cvt_pk_fp8_f32(ws, 0.f, 0, false) & 255;
            const int lo = __builtin_amdgcn_cvt_pk_fp8_f32(ws - __builtin_amdgcn_cvt_f32_fp8(hi, 0), 0.f, 0, false) & 255;
            W16[(size_t)row * 128 + 64 * k + lane] = (unsigned short)(hi | (lo << 8));
        }
        if (lane == 0) WSC[row] = wmax * (1.f / 240.f);
    }
}
namespace pv2 {
typedef float f32x2v __attribute__((ext_vector_type(2)));
typedef unsigned u32x4v __attribute__((ext_vector_type(4))); typedef float f32x4v __attribute__((ext_vector_type(4)));
typedef unsigned u32x2v __attribute__((ext_vector_type(2)));
struct Chunk { u32x4v i; u32x2v w; };
#define SBP() __builtin_amdgcn_sched_barrier(0)
#define PV_CHUNK_LD(dst, r_, q_) do { dst.i = __builtin_bit_cast(u32x4v, __builtin_amdgcn_raw_buffer_load_b128(RI, g128, (r_) * 512 + (q_) * 16, 0)); dst.w = __builtin_bit_cast(u32x2v, __builtin_amdgcn_raw_buffer_load_b64(RW, g64, (r_) * 256 + (q_) * 8, 0)); } while (0)
#define PV_ROW_LD(buf, e_) buf = __builtin_amdgcn_raw_buffer_load_b128(V, (int)(e_) * 256 + c16, 0, 0)
#define PV_CONSUME(buf, ww_, S0_, S1_) do { const u32x2v b2_ = {__builtin_amdgcn_perm(0u, (ww_), (S0_)), __builtin_amdgcn_perm(0u, (ww_), (S1_))}; const long bb_ = __builtin_bit_cast(long, b2_); \
    const u32x2v a0_ = {buf[0], buf[1]}, a1_ = {buf[2], buf[3]}; \
    acc_lo = __builtin_amdgcn_mfma_f32_16x16x32_fp8_fp8(__builtin_bit_cast(long, a0_), bb_, acc_lo, 0, 0, 0); acc_hi = __builtin_amdgcn_mfma_f32_16x16x32_fp8_fp8(__builtin_bit_cast(long, a1_), bb_, acc_hi, 0, 0, 0); } while (0)
#define PV_TOKEN_BODY(row_, nrow_, has_next_) do { \
    PV_CHUNK_LD(C7, row_, 7); \
    SBP(); PV_CONSUME(B0, C0.w[0], sele0, sele1); \
    PV_ROW_LD(B0, C2.i.x); \
    SBP(); PV_CONSUME(B1, C0.w[0], selo0, selo1); \
    PV_ROW_LD(B1, C2.i.y); \
    SBP(); PV_CONSUME(B2, C0.w[1], sele0, sele1); \
    PV_ROW_LD(B2, C2.i.z); \
    SBP(); PV_CONSUME(B3, C0.w[1], selo0, selo1); \
    PV_ROW_LD(B3, C2.i.w); \
    if (has_next_) PV_CHUNK_LD(C0, nrow_, 0); \
    SBP(); PV_CONSUME(B4, C1.w[0], sele0, sele1); \
    PV_ROW_LD(B4, C3.i.x); \
    SBP(); PV_CONSUME(B5, C1.w[0], selo0, selo1); \
    PV_ROW_LD(B5, C3.i.y); \
    SBP(); PV_CONSUME(B6, C1.w[1], sele0, sele1); \
    PV_ROW_LD(B6, C3.i.z); \
    SBP(); PV_CONSUME(B7, C1.w[1], selo0, selo1); \
    PV_ROW_LD(B7, C3.i.w); \
    if (has_next_) PV_CHUNK_LD(C1, nrow_, 1); \
    SBP(); PV_CONSUME(B0, C2.w[0], sele0, sele1); \
    PV_ROW_LD(B0, C4.i.x); \
    SBP(); PV_CONSUME(B1, C2.w[0], selo0, selo1); \
    PV_ROW_LD(B1, C4.i.y); \
    SBP(); PV_CONSUME(B2, C2.w[1], sele0, sele1); \
    PV_ROW_LD(B2, C4.i.z); \
    SBP(); PV_CONSUME(B3, C2.w[1], selo0, selo1); \
    PV_ROW_LD(B3, C4.i.w); \
    if (has_next_) PV_CHUNK_LD(C2, nrow_, 2); \
    SBP(); PV_CONSUME(B4, C3.w[0], sele0, sele1); \
    PV_ROW_LD(B4, C5.i.x); \
    SBP(); PV_CONSUME(B5, C3.w[0], selo0, selo1); \
    PV_ROW_LD(B5, C5.i.y); \
    SBP(); PV_CONSUME(B6, C3.w[1], sele0, sele1); \
    PV_ROW_LD(B6, C5.i.z); \
    SBP(); PV_CONSUME(B7, C3.w[1], selo0, selo1); \
    PV_ROW_LD(B7, C5.i.w); \
    if (has_next_) PV_CHUNK_LD(C3, nrow_, 3); \
    SBP(); PV_CONSUME(B0, C4.w[0], sele0, sele1); \
    PV_ROW_LD(B0, C6.i.x); \
    SBP(); PV_CONSUME(B1, C4.w[0], selo0, selo1); \
    PV_ROW_LD(B1, C6.i.y); \
    SBP(); PV_CONSUME(B2, C4.w[1], sele0, sele1); \
    PV_ROW_LD(B2, C6.i.z); \
    SBP(); PV_CONSUME(B3, C4.w[1], selo0, selo1); \
    PV_ROW_LD(B3, C6.i.w); \
    if (has_next_) PV_CHUNK_LD(C4, nrow_, 4); \
    SBP(); PV_CONSUME(B4, C5.w[0], sele0, sele1); \
    PV_ROW_LD(B4, C7.i.x); \
    SBP(); PV_CONSUME(B5, C5.w[0], selo0, selo1); \
    PV_ROW_LD(B5, C7.i.y); \
    SBP(); PV_CONSUME(B6, C5.w[1], sele0, sele1); \
    PV_ROW_LD(B6, C7.i.z); \
    SBP(); PV_CONSUME(B7, C5.w[1], selo0, selo1); \
    PV_ROW_LD(B7, C7.i.w); \
    if (has_next_) PV_CHUNK_LD(C5, nrow_, 5); \
    SBP(); PV_CONSUME(B0, C6.w[0], sele0, sele1); \
    if (has_next_) PV_ROW_LD(B0, C0.i.x); \
    SBP(); PV_CONSUME(B1, C6.w[0], selo0, selo1); \
    if (has_next_) PV_ROW_LD(B1, C0.i.y); \
    SBP(); PV_CONSUME(B2, C6.w[1], sele0, sele1); \
    if (has_next_) PV_ROW_LD(B2, C0.i.z); \
    SBP(); PV_CONSUME(B3, C6.w[1], selo0, selo1); \
    if (has_next_) PV_ROW_LD(B3, C0.i.w); \
    if (has_next_) PV_CHUNK_LD(C6, nrow_, 6); \
    SBP(); PV_CONSUME(B4, C7.w[0], sele0, sele1); \
    if (has_next_) PV_ROW_LD(B4, C1.i.x); \
    SBP(); PV_CONSUME(B5, C7.w[0], selo0, selo1); \
    if (has_next_) PV_ROW_LD(B5, C1.i.y); \
    SBP(); PV_CONSUME(B6, C7.w[1], sele0, sele1); \
    if (has_next_) PV_ROW_LD(B6, C1.i.z); \
    SBP(); PV_CONSUME(B7, C7.w[1], selo0, selo1); \
    if (has_next_) PV_ROW_LD(B7, C1.i.w); \
    } while (0)
#undef SBP
}

__device__ __forceinline__ void phase_pv(const Args& a, unsigned char* lds, unsigned* ctl, int xcc) {
    using namespace pv2;
#define SBP() __builtin_amdgcn_sched_barrier(0)
    const int tid = opaque_tid(), wave = __builtin_amdgcn_readfirstlane(tid >> 6), lane = tid & 63;
    volatile LAS unsigned* slot = (volatile LAS unsigned*)((LAS unsigned char*)lds + LDS_MISC) + 2;
    bf16_t* Y = (bf16_t*)(a.ws + WS_Y); const float* WSC = (const float*)(a.ws + WS_W + 12 * MiB);
    const __amdgpu_buffer_rsrc_t RI = __builtin_amdgcn_make_buffer_rsrc((void*)(a.ws + WS_IDX), (short)0, TREAL * 512, 0x00020000);
    const __amdgpu_buffer_rsrc_t RW = __builtin_amdgcn_make_buffer_rsrc((void*)(a.ws + WS_W), (short)0, TREAL * 256, 0x00020000);
    float* ybuf = (float*)lds + wave * 256;
    for (int ss = 0; ss < 8; ++ss) {
        const int s = (xcc + ss) & 7;
        const __amdgpu_buffer_rsrc_t V = __builtin_amdgcn_make_buffer_rsrc((void*)(a.ws + WS_V + (size_t)s * (16384 * 256)), (short)0, 16384 * 256, 0x00020000);
        for (;;) {
            const int item = next_item(ctl + CW_QPV + 64 * s, slot);
            if (item >= PX_ITEMS) break;
            int ln = lane; asm volatile("" : "+v"(ln));
            const int g = ln >> 4, n = ln & 15, c16 = n * 16, g128 = g * 128, g64 = g * 64;
            const int r0 = item * 64 + wave * 8;
            unsigned sele0, sele1, selo0, selo1;
            { const unsigned sh = 8u * (unsigned)(n & 3), keep = ~(255u << sh), se = (unsigned)(n >> 3), so = 2u + se;
              const unsigned ve = (0x0c0c0c0cu & keep) | (se << sh), vo = (0x0c0c0c0cu & keep) | (so << sh);
              const bool d0 = (n & 4) == 0;
              sele0 = d0 ? ve : 0x0c0c0c0cu; sele1 = d0 ? 0x0c0c0c0cu : ve; selo0 = d0 ? vo : 0x0c0c0c0cu; selo1 = d0 ? 0x0c0c0c0cu : vo; }
            Chunk C0, C1, C2, C3, C4, C5, C6, C7; u32x4v B0, B1, B2, B3, B4, B5, B6, B7;
            const float wscv = WSC[r0 + (ln & 7)];
            PV_CHUNK_LD(C0, r0, 0); PV_CHUNK_LD(C1, r0, 1); PV_CHUNK_LD(C2, r0, 2); PV_CHUNK_LD(C3, r0, 3); PV_CHUNK_LD(C4, r0, 4); PV_CHUNK_LD(C5, r0, 5); PV_CHUNK_LD(C6, r0, 6);
            PV_ROW_LD(B0, C0.i.x); PV_ROW_LD(B1, C0.i.y); PV_ROW_LD(B2, C0.i.z); PV_ROW_LD(B3, C0.i.w); PV_ROW_LD(B4, C1.i.x); PV_ROW_LD(B5, C1.i.y); PV_ROW_LD(B6, C1.i.z); PV_ROW_LD(B7, C1.i.w);
#pragma unroll 1
            for (int t = 0; t < 8; ++t) {
                const int row = r0 + t, nrow = row + 1; const bool has_next = t < 7;
                f32x4v acc_lo = {0.f, 0.f, 0.f, 0.f}, acc_hi = {0.f, 0.f, 0.f, 0.f};
                PV_TOKEN_BODY(row, nrow, has_next);
                const float wsc = __uint_as_float(__builtin_amdgcn_readlane(__float_as_uint(wscv), t));
#pragma unroll
                for (int i = 0; i < 4; ++i) {
                    const float lo_ = acc_lo[i] + __uint_as_float(__builtin_amdgcn_update_dpp(0, __float_as_uint(acc_lo[i]), 0x128, 0xf, 0xf, false));
                    const float hi_ = acc_hi[i] + __uint_as_float(__builtin_amdgcn_update_dpp(0, __float_as_uint(acc_hi[i]), 0x128, 0xf, 0xf, false));
                    ybuf[16 * (4 * g + i) + n] = (n < 8 ? lo_ : hi_) * wsc;
                }
                asm volatile("s_waitcnt lgkmcnt(0)" ::: "memory");
                {
                    const float4 yv = ((const float4*)ybuf)[ln];
                    *(uint2*)(Y + (size_t)row * DM + 256 * s + 4 * ln) = make_uint2(pk2(yv.x, yv.y), pk2(yv.z, yv.w));
                }
                asm volatile("s_waitcnt lgkmcnt(0)" ::: "memory");
            }
        }
    }
#undef SBP
}
__device__ __forceinline__ void phase_pn(const Args& a, int bid, int nb) {
    const int tid = opaque_tid(), wave = __builtin_amdgcn_readfirstlane(tid >> 6), lane = tid & 63;
    const bf16_t* Y = (const bf16_t*)(a.ws + WS_Y); const bf16_t* X1 = (const bf16_t*)(a.ws + WS_HN);
    for (int row = bid * NWAVES + wave; row < TREAL; row += nb * NWAVES) {
        f32x4* p = (f32x4*)(a.out + (size_t)row * DM) + lane;
        const uint2* yp = (const uint2*)(Y + (size_t)row * DM) + lane; const uint2* xp = (const uint2*)(X1 + (size_t)row * DM) + lane;
        f32x4 v[8]; float ss = 0.f;
#pragma unroll
        for (int j = 0; j < 8; ++j) { const uint2 yy = yp[64 * j], xx = xp[64 * j];
            v[j][0] = bf_lo(xx.x) + bf_lo(yy.x); v[j][1] = bf_hi(xx.x) + bf_hi(yy.x); v[j][2] = bf_lo(xx.y) + bf_lo(yy.y); v[j][3] = bf_hi(xx.y) + bf_hi(yy.y);
            ss += (v[j][0] * v[j][0] + v[j][1] * v[j][1]) + (v[j][2] * v[j][2] + v[j][3] * v[j][3]); }
        const float r = rsqrtf(wave_sum(ss) * (1.f / DM) + EPS);
        const f32x4* wp = (const f32x4*)a.nfinal + lane;
#pragma unroll
        for (int j = 0; j < 8; ++j) p[64 * j] = v[j] * r * wp[64 * j];
    }
}

__device__ __forceinline__ void phase_mix(const Args& a, unsigned char* lds, unsigned* ctr) {
    const bf16_t* Z = (const bf16_t*)(a.ws + WS_Z); bf16_t* MIX = (bf16_t*)(a.ws + WS_MIX);
    volatile LAS unsigned* slot = (volatile LAS unsigned*)((LAS unsigned char*)lds + LDS_MISC) + 2;
    for (;;) {
        const int item = next_item(ctr, slot);
        if (item >= 64 + 2048) break;
        if (item < 64) mls::mlstm_item(item >> 2, item & 3, a, (char*)lds);
        else { const int k = item - 64, qb = 15 - (k >> 7), bh = k & 127; const float lam = attn_lambda(a); att::attn_unit(bh >> 3, bh & 7, qb, Z, MIX, lam, a.subln, (char*)lds); }
    }
}

__global__ void __launch_bounds__(NTHREADS, 2) mega(Args a) {
    extern __shared__ __attribute__((aligned(16))) unsigned char lds[];
    cg::grid_group grid = cg::this_grid();
    const int bid = blockIdx.x, nb = gridDim.x;
    unsigned char* ws = a.ws;
    bf16_t* WinT = (bf16_t*)(ws + WS_WIN); bf16_t* WoutT = (bf16_t*)(ws + WS_WOUT); bf16_t* WqT = (bf16_t*)(ws + WS_WQ);
    float* rope = (float*)(ws + WS_ROPE); float* SSQ = (float*)(ws + WS_SSQ);
    bf16_t* HN = (bf16_t*)(ws + WS_HN); bf16_t* MIX = (bf16_t*)(ws + WS_MIX); bf16_t* Z = (bf16_t*)(ws + WS_Z);

    volatile LAS unsigned* MISC = (volatile LAS unsigned*)((LAS unsigned char*)lds + LDS_MISC);
    if (threadIdx.x < 16) MISC[threadIdx.x] = 0u;
    __syncthreads();
    unsigned* ctl = (unsigned*)(ws + WS_CTL);
    XcdBarrier bar = xcd_barrier_post(ctl + CW_BAR, MISC);
    phase_prep(a, lds, bid, nb);
    grid.sync();
    { pg8::Gemm g{HN, WinT, MROWS, NZ, DM}; EpiZ E{Z, rope}; pg8::StaticOrder S; S.init(g.M, g.N, nb, bid);
      pg8::gemm_phase<EpiZ, pg8::StaticOrder, true, true>((PG8_LAS unsigned char*)lds, g, S, E); }
    phase_tables(a, lds, ctl);
    xcd_barrier(bar);
    phase_mix(a, lds, ctl + CW_QUEUE);
    xcd_barrier(bar);
    { pg8::Gemm g{MIX, WoutT, TREAL, DM, DM}; EpiX1 E{a.x, HN, SSQ}; pg8::StaticOrder S; S.init(g.M, g.N, nb, bid);
      pg8::gemm_phase<EpiX1, pg8::StaticOrder, true, true>((PG8_LAS unsigned char*)lds, g, S, E); }
    xcd_barrier(bar);
    { pg8::Gemm g{HN, WqT, TREAL, DM, DM}; pg8::EpiBf16<0> E{MIX, DM, nullptr, 0, 0, 1.f}; pg8::StaticOrder S; S.init(g.M, g.N, nb, bid);
      pg8::gemm_phase<pg8::EpiBf16<0>, pg8::StaticOrder, true, true>((PG8_LAS unsigned char*)lds, g, S, E); }
    xcd_barrier(bar);
    phase_route(a, lds, bid, nb);
    xcd_barrier(bar);
    { const int xcc = (int)(xb_xcc_id() & 7u);
      phase_pu(a, lds, ctl, xcc); xcd_barrier(bar);
      phase_pc(a, bid, nb); xcd_barrier(bar);
      phase_pv(a, lds, ctl, xcc); xcd_barrier(bar);
      phase_pn(a, bid, nb); }
}

extern "C" void kernel_launch(void* const* d_in, const int* in_sizes, int n_in, void* d_out, int out_size, void* d_ws, size_t ws_size, hipStream_t stream) {
    if (n_in != 18 || out_size != TREAL * DM || ws_size < WS_END) { fprintf(stderr, "kernel_launch: unexpected shapes n_in %d out %d ws %zu (need %zu)\n", n_in, out_size, ws_size, (size_t)WS_END); return; }
    static int grid_blocks = 0;
    if (!grid_blocks) {
        int dev = 0, cus = 0, per_cu = 0;
        (void)hipGetDevice(&dev);
        (void)hipDeviceGetAttribute(&cus, hipDeviceAttributeMultiprocessorCount, dev);
        (void)hipFuncSetAttribute((const void*)mega, hipFuncAttributeMaxDynamicSharedMemorySize, LDS_BYTES);
        (void)hipOccupancyMaxActiveBlocksPerMultiprocessor(&per_cu, (const void*)mega, NTHREADS, LDS_BYTES);
        if (per_cu < 1) { fprintf(stderr, "kernel_launch: occupancy query says %d blocks/CU\n", per_cu); per_cu = 1; }
        if (per_cu > 1) per_cu = 1;
        grid_blocks = cus * per_cu;
    }
    Args a{};
    a.x = (const float*)d_in[0]; a.meta = (const float*)d_in[1]; a.nmw = (const float*)d_in[2]; a.w_in = (const float*)d_in[3];
    a.lamqk = (const float*)d_in[4]; a.subln = (const float*)d_in[5]; a.convw = (const float*)d_in[6]; a.convb = (const float*)d_in[7];
    a.ib = (const float*)d_in[8]; a.fb = (const float*)d_in[9]; a.mnw = (const float*)d_in[10]; a.w_out = (const float*)d_in[11];
    a.nfw_ffn = (const float*)d_in[12]; a.w_q = (const float*)d_in[13]; a.subkeys = (const float*)d_in[14]; a.pu = (const float*)d_in[15];
    a.pv = (const float*)d_in[16]; a.nfinal = (const float*)d_in[17];
    a.out = (float*)d_out; a.ws = (unsigned char*)d_ws;
    (void)hipMemsetAsync((char*)d_ws + WS_CTL, 0, 65536, stream);
    void* kargs[] = {&a};
    const hipError_t e = hipLaunchCooperativeKernel((const void*)mega, dim3(grid_blocks), dim3(NTHREADS), kargs, LDS_BYTES, stream);
    if (e != hipSuccess) fprintf(stderr, "kernel_launch: cooperative launch failed: %s (grid %d)\n", hipGetErrorString(e), grid_blocks);
}
```

```cpp
#include <hip/hip_runtime.h>
#include <hip/hip_bf16.h>
#include <cstdio>
#include <cstdint>
#include <cmath>
namespace pg8 {
#define PG8_LAS __attribute__((address_space(3)))
typedef unsigned short bf16_t;
typedef short bf16x8 __attribute__((ext_vector_type(8)));
typedef float f32x4 __attribute__((ext_vector_type(4)));
typedef unsigned u32x4 __attribute__((ext_vector_type(4)));
constexpr int BM = 256, BK = 64, HALF = 128, HTB = HALF * BK * 2  , STAGE_BYTES = 8 * HTB, NXCD = 8, WGM = 8;

__host__ __device__ __forceinline__ int lds_byte(int r, int c) { const int st = (r >> 4) * 2 + (c >> 5), rr = r & 15, cc = c & 31, ob = rr * 64 + cc * 2; return st * 1024 + (ob ^ (((ob >> 9) & 1) << 5)); }
__host__ __device__ __forceinline__ void stage_rc(int b, int& R, int& C) { const int st = b / 1024, sb = b % 1024, swz = sb ^ (((sb >> 9) & 1) << 5); R = (st >> 1) * 16 + swz / 64; C = (st & 1) * 32 + (swz % 64) / 2; }
__host__ __device__ __forceinline__ int perm32(int rho) { const int n = rho >> 4, i = rho & 15; return 8 * (i >> 2) + 4 * n + (i & 3); }

struct Unit { int pm, pn; };
struct Gemm { const bf16_t* A; const bf16_t* Bt; int M, N, K; };

struct StaticOrder {
    int nM, nN, nwg, G, c;
    __host__ __device__ void init(int M, int N, int G_, int c_) { nM = M / BM; nN = N / BM; nwg = nM * nN; G = G_; c = c_; }
    __host__ __device__ bool next(int i, Unit& u) const {
        const long L = (long)i * G + c; if (L >= nwg) return false;
        int wgid = (int)L; { const int q = nwg / NXCD, r = nwg % NXCD, xcd = wgid % NXCD, off = wgid / NXCD; wgid = (xcd < r ? xcd * (q + 1) : r * (q + 1) + (xcd - r) * q) + off; }
        const int nig = WGM * nN, gid = wgid / nig, fm = gid * WGM, gsz = (nM - fm) < WGM ? (nM - fm) : WGM;
        u.pm = fm + ((wgid % nig) % gsz); u.pn = (wgid % nig) / gsz; return true;
    }
    __device__ __forceinline__ void a_ready(const Unit&) const {}
    __device__ __forceinline__ void done(const Unit&) const {}
};

__device__ __forceinline__ unsigned cvt_pk_bf16(float lo, float hi) { unsigned r; asm volatile("v_cvt_pk_bf16_f32 %0, %1, %2" : "=v"(r) : "v"(lo), "v"(hi)); return r; }
typedef float f32x2 __attribute__((ext_vector_type(2)));
__device__ __forceinline__ f32x2 gelu_pk(f32x2 v) {
    const f32x2 av = __builtin_elementwise_abs(v), d = av * 0.2316418882f + 1.0f;
    f32x2 t; t.x = __builtin_amdgcn_rcpf(d.x); t.y = __builtin_amdgcn_rcpf(d.y);
    f32x2 q = t * 0.5307027145f + (-0.7265760135f); q = q * t + 0.7107068705f; q = q * t + (-0.142248368f); q = q * t + 0.127414796f; q = q * t;
    const f32x2 s = (v * v) * (-0.72134752044f);
    f32x2 e; e.x = __builtin_amdgcn_exp2f(s.x); e.y = __builtin_amdgcn_exp2f(s.y);
    const f32x2 m = v * (q * e), r = v - m;
    f32x2 o; o.x = v.x < 0.f ? m.x : r.x; o.y = v.y < 0.f ? m.y : r.y; return o;
}

template <int ACT  > struct EpiBf16 {
    static constexpr bool PERM = true, AFTER_DRAIN = false; static_assert(ACT == 0 || ACT == 1, "EpiBf16: ACT is 0 (none) or 1 (gelu_pk)");
    bf16_t* O; int ldc; const float* bias; int split_cols; size_t split_stride; float scale0;
    __device__ __forceinline__ void operator()(const f32x4 (&acc)[2][2][4][2], const Unit& u, int wr, int wc, int fr, int fq) const {
        const int row0 = u.pm * BM + wr * 64 + fr; int colt = u.pn * BM; bf16_t* base = O;
        float sc = 1.f; if (split_cols) { const int t = colt / split_cols; base += (size_t)t * split_stride; colt -= t * split_cols; if (t == 0) sc = scale0; }
        const int col0 = colt + wc * 32 + 8 * fq, bcol0 = u.pn * BM + wc * 32 + 8 * fq;
        f32x4 bv[2][2];
#pragma unroll
        for (int bj = 0; bj < 2; ++bj)
#pragma unroll
            for (int n = 0; n < 2; ++n) bv[bj][n] = bias ? *(const f32x4*)(bias + bcol0 + bj * HALF + 4 * n) : (f32x4){0.f, 0.f, 0.f, 0.f};
#pragma unroll
        for (int ai = 0; ai < 2; ++ai)
#pragma unroll
            for (int m = 0; m < 4; ++m) { bf16_t* rowp = base + (size_t)(row0 + ai * HALF + m * 16) * ldc + col0;
#pragma unroll
                for (int bj = 0; bj < 2; ++bj) { f32x4 v0 = acc[ai][bj][m][0] + bv[bj][0], v1 = acc[ai][bj][m][1] + bv[bj][1];
                    if (ACT == 1) { f32x2 a = gelu_pk((f32x2){v0[0], v0[1]}), b = gelu_pk((f32x2){v0[2], v0[3]}), c = gelu_pk((f32x2){v1[0], v1[1]}), d = gelu_pk((f32x2){v1[2], v1[3]});
                        v0 = (f32x4){a.x, a.y, b.x, b.y}; v1 = (f32x4){c.x, c.y, d.x, d.y}; }
                    v0 = v0 * sc; v1 = v1 * sc; u32x4 w; w.x = cvt_pk_bf16(v0[0], v0[1]); w.y = cvt_pk_bf16(v0[2], v0[3]); w.z = cvt_pk_bf16(v1[0], v1[1]); w.w = cvt_pk_bf16(v1[2], v1[3]);
                    *(u32x4*)(rowp + bj * HALF) = w; } }
    }
};
template <class Epi, class Sched, bool ALIGN_EPI = false, bool SP2 = false>
__device__ __forceinline__ void gemm_phase(PG8_LAS unsigned char* lds, const Gemm g, const Sched& S, const Epi& E) {
    int tid_ = threadIdx.x; asm volatile("" : "+v"(tid_));
    const int tid = tid_, wid = __builtin_amdgcn_readfirstlane(tid >> 6), lane = tid & 63, wr = wid >> 2, wc = wid & 3, fr = lane & 15, fq = lane >> 4;
    const int K = g.K, nt = K / BK;
    unsigned voffA[2], voffB[2];
#pragma unroll
    for (int i = 0; i < 2; ++i) { int R, C; stage_rc(tid * 16 + i * 8192, R, C); const int Rb = Epi::PERM ? ((R & ~31) + perm32(R & 31)) : R;
        voffA[i] = (unsigned)(R * K + C) * 2u; voffB[i] = (unsigned)(Rb * K + C) * 2u; }
    const size_t kstep = (size_t)(BK * 2);
    const size_t hstep = (size_t)HALF * K * 2;
    const size_t tstep = 2 * hstep;
    const unsigned ldsw = (unsigned)wid * 1024u;
    const int aoff = lds_byte(wr * 64 + fr, fq * 8), boff = lds_byte(wc * 32 + fr, fq * 8);
#define PG8_SA(b, h) (((b) * 2 + (h)) * HTB)
#define PG8_SB(b, h) ((4 + (b) * 2 + (h)) * HTB)
#define PG8_STAGE(bufoff, gbase, voff) do { _Pragma("unroll") for (int _i = 0; _i < 2; ++_i) \
        __builtin_amdgcn_global_load_lds((const unsigned*)((const char*)(gbase) + (voff)[_i]), (PG8_LAS unsigned*)(lds + (bufoff) + ldsw + _i * 8192), 16, 0, 0); } while (0)
#define PG8_LDA(dst, b, h) do { _Pragma("unroll") for (int m = 0; m < 4; ++m) _Pragma("unroll") for (int k = 0; k < 2; ++k) dst[m][k] = *(const PG8_LAS bf16x8*)(lds + PG8_SA(b, h) + aoff + m * 2048 + k * 1024); } while (0)
#define PG8_LDB(dst, b, h) do { _Pragma("unroll") for (int n = 0; n < 2; ++n) _Pragma("unroll") for (int k = 0; k < 2; ++k) dst[n][k] = *(const PG8_LAS bf16x8*)(lds + PG8_SB(b, h) + boff + n * 2048 + k * 1024); } while (0)
#define PG8_MMA(ai, bj, At, Bt) do { __builtin_amdgcn_s_setprio(1); _Pragma("unroll") for (int m = 0; m < 4; ++m) _Pragma("unroll") for (int n = 0; n < 2; ++n) _Pragma("unroll") for (int k = 0; k < 2; ++k) \
        acc[ai][bj][m][n] = __builtin_amdgcn_mfma_f32_16x16x32_bf16(Bt[n][k], At[m][k], acc[ai][bj][m][n], 0, 0, 0); __builtin_amdgcn_s_setprio(0); } while (0)
#define PG8_WAIT_V(n) asm volatile("s_waitcnt vmcnt(" #n ")" ::: "memory")
#define PG8_WAIT_L(n) asm volatile("s_waitcnt lgkmcnt(" #n ")" ::: "memory")
#define PG8_BAR __builtin_amdgcn_s_barrier()
#define PG8_SCHED __builtin_amdgcn_sched_barrier(0)
    Unit cur, nxt; int ui = 0;
    if (!S.next(0, cur)) return;
    f32x4 acc[2][2][4][2];
#pragma unroll
    for (int a = 0; a < 2; ++a)
#pragma unroll
        for (int b = 0; b < 2; ++b)
#pragma unroll
            for (int m = 0; m < 4; ++m)
#pragma unroll
                for (int n = 0; n < 2; ++n) acc[a][b][m][n] = (f32x4){0.f, 0.f, 0.f, 0.f};
    bf16x8 At[4][2], B0[2][2], B1[2][2];
    const char* cA = (const char*)g.A + (size_t)cur.pm * tstep; const char* cB = (const char*)g.Bt + (size_t)cur.pn * tstep;
    S.a_ready(cur);
    if constexpr (SP2) {
        PG8_STAGE(PG8_SB(0, 0), cB, voffB); PG8_STAGE(PG8_SB(0, 1), cB + hstep, voffB); PG8_STAGE(PG8_SA(0, 0), cA, voffA); PG8_STAGE(PG8_SA(0, 1), cA + hstep, voffA);
        if (wr == 1) PG8_BAR;
        PG8_WAIT_V(2); PG8_BAR;
        PG8_STAGE(PG8_SB(1, 0), cB + kstep, voffB); PG8_STAGE(PG8_SA(1, 0), cA + kstep, voffA); PG8_STAGE(PG8_SB(1, 1), cB + hstep + kstep, voffB);
        PG8_WAIT_V(6); PG8_BAR;
    } else {
        PG8_STAGE(PG8_SB(0, 0), cB, voffB); PG8_STAGE(PG8_SA(0, 0), cA, voffA); PG8_STAGE(PG8_SB(0, 1), cB + hstep, voffB); PG8_STAGE(PG8_SA(0, 1), cA + hstep, voffA);
        if (wr == 1) PG8_BAR;
        PG8_WAIT_V(4); PG8_BAR;
        PG8_STAGE(PG8_SB(1, 0), cB + kstep, voffB); PG8_STAGE(PG8_SA(1, 0), cA + kstep, voffA); PG8_STAGE(PG8_SB(1, 1), cB + hstep + kstep, voffB);
        PG8_WAIT_V(6); PG8_BAR;
    }
    for (;;) {
        const bool has_next = S.next(ui + 1, nxt);
        const char* nA = has_next ? (const char*)g.A + (size_t)nxt.pm * tstep : cA; const char* nB = has_next ? (const char*)g.Bt + (size_t)nxt.pn * tstep : cB;
        for (int t = 0; t < nt; t += 2) {
            const bool last = (t == nt - 2);
            const char* a1 = cA + (size_t)(t + 1) * kstep;
            const char* a2 = last ? nA : cA + (size_t)(t + 2) * kstep; const char* b2 = last ? nB : cB + (size_t)(t + 2) * kstep;
            const char* a3 = a2 + kstep; const char* b3 = b2 + kstep;
            if (last && has_next) S.a_ready(nxt);
            if constexpr (SP2) {
            PG8_LDB(B0, 0, 0); PG8_LDB(B1, 0, 1); PG8_SCHED; PG8_LDA(At, 0, 0); PG8_STAGE(PG8_SA(1, 1), a1 + hstep, voffA);
            PG8_WAIT_V(8); PG8_WAIT_L(0); PG8_BAR; PG8_MMA(0, 0, At, B0); PG8_MMA(0, 1, At, B1); PG8_BAR; PG8_SCHED;
            PG8_LDA(At, 0, 1); PG8_STAGE(PG8_SB(0, 0), b2, voffB); PG8_STAGE(PG8_SB(0, 1), b2 + hstep, voffB); PG8_STAGE(PG8_SA(0, 0), a2, voffA);
            PG8_WAIT_V(8); PG8_WAIT_L(0); PG8_BAR; PG8_MMA(1, 0, At, B0); PG8_MMA(1, 1, At, B1); PG8_BAR; PG8_SCHED;
            PG8_LDB(B0, 1, 0); PG8_LDB(B1, 1, 1); PG8_SCHED; PG8_LDA(At, 1, 0); PG8_STAGE(PG8_SA(0, 1), a2 + hstep, voffA);
            PG8_WAIT_V(8); PG8_WAIT_L(0); PG8_BAR; PG8_MMA(0, 0, At, B0); PG8_MMA(0, 1, At, B1); PG8_BAR; PG8_SCHED;
            PG8_LDA(At, 1, 1); PG8_STAGE(PG8_SB(1, 0), b3, voffB); PG8_STAGE(PG8_SB(1, 1), b3 + hstep, voffB); PG8_STAGE(PG8_SA(1, 0), a3, voffA);
            PG8_WAIT_V(8); PG8_WAIT_L(0); PG8_BAR; PG8_MMA(1, 0, At, B0); PG8_MMA(1, 1, At, B1); PG8_BAR; PG8_SCHED;
            } else {
            PG8_LDB(B0, 0, 0); PG8_SCHED; PG8_LDA(At, 0, 0); PG8_STAGE(PG8_SA(1, 1), a1 + hstep, voffA);
            PG8_WAIT_L(8); PG8_BAR; PG8_WAIT_L(0); PG8_MMA(0, 0, At, B0); PG8_BAR; PG8_SCHED;
            PG8_LDB(B1, 0, 1); PG8_STAGE(PG8_SB(0, 0), b2, voffB);
            PG8_BAR; PG8_WAIT_L(0); PG8_MMA(0, 1, At, B1); PG8_BAR;
            PG8_LDA(At, 0, 1); PG8_STAGE(PG8_SA(0, 0), a2, voffA);
            PG8_BAR; PG8_WAIT_L(0); PG8_MMA(1, 0, At, B0); PG8_BAR; PG8_SCHED;
            PG8_STAGE(PG8_SB(0, 1), b2 + hstep, voffB);
            PG8_WAIT_V(6); PG8_BAR; PG8_MMA(1, 1, At, B1); PG8_BAR;
            PG8_LDB(B0, 1, 0); PG8_SCHED; PG8_LDA(At, 1, 0); PG8_STAGE(PG8_SA(0, 1), a2 + hstep, voffA);
            PG8_WAIT_L(8); PG8_BAR; PG8_WAIT_L(0); PG8_MMA(0, 0, At, B0); PG8_BAR; PG8_SCHED;
            PG8_LDB(B1, 1, 1); PG8_STAGE(PG8_SB(1, 0), b3, voffB);
            PG8_BAR; PG8_WAIT_L(0); PG8_MMA(0, 1, At, B1); PG8_BAR;
            PG8_LDA(At, 1, 1); PG8_STAGE(PG8_SA(1, 0), a3, voffA);
            PG8_BAR; PG8_WAIT_L(0); PG8_MMA(1, 0, At, B0); PG8_BAR; PG8_SCHED;
            PG8_STAGE(PG8_SB(1, 1), b3 + hstep, voffB);
            PG8_WAIT_V(6); PG8_BAR; PG8_MMA(1, 1, At, B1); PG8_BAR;
            }
        }
        if constexpr (ALIGN_EPI) { if (wr == 0) PG8_BAR; }
        if constexpr (!Epi::AFTER_DRAIN) { E(acc, cur, wr, wc, fr, fq); S.done(cur); }
        if (!has_next) break;
#pragma unroll
        for (int a = 0; a < 2; ++a)
#pragma unroll
            for (int b = 0; b < 2; ++b)
#pragma unroll
                for (int m = 0; m < 4; ++m)
#pragma unroll
                    for (int n = 0; n < 2; ++n) acc[a][b][m][n] = (f32x4){0.f, 0.f, 0.f, 0.f};
        cur = nxt; cA = nA; cB = nB; ++ui;
        if constexpr (ALIGN_EPI) { if (wr == 1) PG8_BAR; }
    }
    PG8_WAIT_V(0);
    if constexpr (!ALIGN_EPI) { if (wr == 0) PG8_BAR; }
    PG8_BAR;
    if constexpr (Epi::AFTER_DRAIN) { E.fused(acc, cur, wr, wc, fr, fq, lds, wid, lane); S.done(cur); }
#undef PG8_SA
#undef PG8_SB
#undef PG8_STAGE
#undef PG8_LDA
#undef PG8_LDB
#undef PG8_MMA
#undef PG8_WAIT_V
#undef PG8_WAIT_L
#undef PG8_BAR
#undef PG8_SCHED
}
}

constexpr int BATCH = 16, SEQ = 2048, DM = 2048, NMETA = 16;
constexpr int TREAL = BATCH * SEQ;
constexpr int MROWS = 33024;
constexpr int META_TILE0 = 32768;
constexpr int META_ROW0 = 32816;
constexpr int NZ = 6144;
constexpr int ZQ = 0, ZK = 1024, ZV = 2048, ZMQ = 3072, ZMK = 3584, ZMV = 4096, ZMO = 5120;
constexpr int INCOLS = 6152;
constexpr float EPS = 1e-6f;
constexpr float QSCALE = 0.125f * 1.4426950408889634f;
constexpr float LAMBDA_INIT = 0.2f;

typedef unsigned short bf16_t;
typedef float f32x4 __attribute__((ext_vector_type(4)));
typedef __bf16 bf16x2_t __attribute__((ext_vector_type(2)));

constexpr size_t MiB = 1u << 20;
constexpr size_t WS_CTL = 0;
constexpr size_t WS_ISC = 655360;
constexpr size_t WS_SKB = 65536;
constexpr size_t WS_WIN = 1 * MiB;
constexpr size_t WS_WOUT = 25 * MiB;
constexpr size_t WS_WQ = 33 * MiB;
constexpr size_t WS_ROPE = 41 * MiB;
constexpr size_t WS_GATES = 42 * MiB;
constexpr size_t WS_SSQ = 44 * MiB;
constexpr size_t WS_IDX = 48 * MiB;
constexpr size_t WS_GATE = 64 * MiB;
constexpr size_t WS_U = 80 * MiB;
constexpr size_t WS_V = 144 * MiB;
constexpr size_t WS_HN = 208 * MiB;
constexpr size_t WS_MIX = 338 * MiB;
constexpr size_t WS_Z = 466 * MiB;
constexpr size_t WS_END = 854 * MiB;

__device__ __forceinline__ float bf_lo(unsigned w) { return __uint_as_float(w << 16); }
__device__ __forceinline__ float bf_hi(unsigned w) { return __uint_as_float(w & 0xffff0000u); }
__device__ __forceinline__ float bf2f(bf16_t v) { return __uint_as_float(((unsigned)v) << 16); }
__device__ __forceinline__ unsigned f2bf(float f) { unsigned r; asm("v_cvt_pk_bf16_f32 %0, %1, 0" : "=v"(r) : "v"(f)); return r; }
__device__ __forceinline__ unsigned pk2(float lo, float hi) { unsigned r; asm("v_cvt_pk_bf16_f32 %0, %1, %2" : "=v"(r) : "v"(lo), "v"(hi)); return r; }
__device__ __forceinline__ float dot2(unsigned a, unsigned b, float acc) { return __builtin_amdgcn_fdot2_f32_bf16(__builtin_bit_cast(bf16x2_t, a), __builtin_bit_cast(bf16x2_t, b), acc, false); }
__device__ __forceinline__ float wave_sum(float v) {
#pragma unroll
    for (int o = 1; o < 64; o <<= 1) v += __shfl_xor(v, o);
    return v;
}
__device__ __forceinline__ float wave_max(float v) {
#pragma unroll
    for (int o = 1; o < 64; o <<= 1) v = fmaxf(v, __shfl_xor(v, o));
    return v;
}
__device__ __forceinline__ int zrow_of(int b, int l) { return l < NMETA ? META_ROW0 + l : b * SEQ + (l - NMETA); }

struct EpiZ {
    static constexpr bool PERM = true, AFTER_DRAIN = false;
    bf16_t* Z; const float* rope;
    __device__ __forceinline__ void operator()(const pg8::f32x4 (&acc)[2][2][4][2], const pg8::Unit& u, int wr, int wc, int fr, int fq) const {
        const int row0 = u.pm * 256 + wr * 64 + fr, col0 = u.pn * 256 + wc * 32 + 8 * fq;
        const bool isq = u.pn < 4, isrope = u.pn < 8;
        const int j0 = 16 * (wc & 1) + 4 * fq;
#pragma unroll
        for (int ai = 0; ai < 2; ++ai)
#pragma unroll
            for (int m = 0; m < 4; ++m) {
                const int row = row0 + ai * 128 + m * 16;
                pg8::f32x4 c0 = {1.f, 0.f, 1.f, 0.f}, c1 = {1.f, 0.f, 1.f, 0.f};
                if (isrope) {
                    const int pos = row < TREAL ? (row & (SEQ - 1)) + NMETA : ((row >= META_ROW0 && row < META_ROW0 + NMETA) ? row - META_ROW0 : 0);
                    const pg8::f32x4* tp = (const pg8::f32x4*)(rope + ((size_t)pos * 32 + j0) * 2);
                    c0 = tp[0]; c1 = tp[1];
                }
                bf16_t* rowp = Z + (size_t)row * NZ + col0;
#pragma unroll
                for (int bj = 0; bj < 2; ++bj) {
                    pg8::f32x4 v0 = acc[ai][bj][m][0], v1 = acc[ai][bj][m][1];
                    if (isrope) {
                        pg8::f32x4 o0, o1;
                        o0[0] = v0[0] * c0[0] - v0[1] * c0[1]; o0[1] = v0[1] * c0[0] + v0[0] * c0[1];
                        o0[2] = v0[2] * c0[2] - v0[3] * c0[3]; o0[3] = v0[3] * c0[2] + v0[2] * c0[3];
                        o1[0] = v1[0] * c1[0] - v1[1] * c1[1]; o1[1] = v1[1] * c1[0] + v1[0] * c1[1];
                        o1[2] = v1[2] * c1[2] - v1[3] * c1[3]; o1[3] = v1[3] * c1[2] + v1[2] * c1[3];
                        v0 = o0; v1 = o1;
                        if (isq) { v0 = v0 * QSCALE; v1 = v1 * QSCALE; }
                    }
                    pg8::u32x4 w; w.x = pg8::cvt_pk_bf16(v0[0], v0[1]); w.y = pg8::cvt_pk_bf16(v0[2], v0[3]); w.z = pg8::cvt_pk_bf16(v1[0], v1[1]); w.w = pg8::cvt_pk_bf16(v1[2], v1[3]);
                    *(pg8::u32x4*)(rowp + bj * 128) = w;
                }
            }
    }
};
struct EpiX1 {
    static constexpr bool PERM = true, AFTER_DRAIN = false;
    const float* x; bf16_t* x1b; float* ssq;
    __device__ __forceinline__ void loadr(pg8::f32x4 (&xb)[2][2], int row0, int col0, int i) const {
#pragma unroll
        for (int bj = 0; bj < 2; ++bj) {
            const size_t off = (size_t)(row0 + (i >> 2) * 128 + (i & 3) * 16) * DM + col0 + bj * 128;
            xb[bj][0] = *(const pg8::f32x4*)(x + off); xb[bj][1] = *(const pg8::f32x4*)(x + off + 4);
        }
    }
    __device__ __forceinline__ void procr(const pg8::f32x4 (&acc)[2][2][4][2], const pg8::f32x4 (&xb)[2][2], int row0, int col0, int i, int pn, int wc, int fq) const {
        const int ai = i >> 2, m = i & 3;
        const int row = row0 + ai * 128 + m * 16; float ss = 0.f;
#pragma unroll
        for (int bj = 0; bj < 2; ++bj) {
            const size_t off = (size_t)row * DM + col0 + bj * 128;
            const pg8::f32x4 v0 = acc[ai][bj][m][0] + xb[bj][0], v1 = acc[ai][bj][m][1] + xb[bj][1];
            ss += (v0[0] * v0[0] + v0[1] * v0[1]) + (v0[2] * v0[2] + v0[3] * v0[3]) + (v1[0] * v1[0] + v1[1] * v1[1]) + (v1[2] * v1[2] + v1[3] * v1[3]);
            pg8::u32x4 w; w.x = pg8::cvt_pk_bf16(v0[0], v0[1]); w.y = pg8::cvt_pk_bf16(v0[2], v0[3]); w.z = pg8::cvt_pk_bf16(v1[0], v1[1]); w.w = pg8::cvt_pk_bf16(v1[2], v1[3]);
            *(pg8::u32x4*)(x1b + off) = w;
        }
        ss += __shfl_xor(ss, 16); ss += __shfl_xor(ss, 32);
        if (fq == 0) ssq[(size_t)row * 32 + pn * 4 + wc] = ss;
    }
    __device__ __forceinline__ void operator()(const pg8::f32x4 (&acc)[2][2][4][2], const pg8::Unit& u, int wr, int wc, int fr, int fq) const {
        const int row0 = u.pm * 256 + wr * 64 + fr, col0 = u.pn * 256 + wc * 32 + 8 * fq;
        pg8::f32x4 b0[2][2], b1[2][2], b2[2][2];
        loadr(b0, row0, col0, 0); loadr(b1, row0, col0, 1); loadr(b2, row0, col0, 2);
        procr(acc, b0, row0, col0, 0, u.pn, wc, fq); loadr(b0, row0, col0, 3);
        procr(acc, b1, row0, col0, 1, u.pn, wc, fq); loadr(b1, row0, col0, 4);
        procr(acc, b2, row0, col0, 2, u.pn, wc, fq); loadr(b2, row0, col0, 5);
        procr(acc, b0, row0, col0, 3, u.pn, wc, fq); loadr(b0, row0, col0, 6);
        procr(acc, b1, row0, col0, 4, u.pn, wc, fq); loadr(b1, row0, col0, 7);
        procr(acc, b2, row0, col0, 5, u.pn, wc, fq);
        procr(acc, b0, row0, col0, 6, u.pn, wc, fq);
        procr(acc, b1, row0, col0, 7, u.pn, wc, fq);
    }
};


#include <hip/hip_cooperative_groups.h>
namespace cg = cooperative_groups;

constexpr int NWAVES = 8, NTHREADS = 512;
constexpr size_t WS_X1Q = WS_Z + 300 * MiB, WS_XSC = WS_Z + 370 * MiB;
__device__ __forceinline__ int opaque_tid() { int t = threadIdx.x; asm volatile("" : "+v"(t)); return t; }
constexpr int LDS_BYTES = 163840;

struct Args {
    const float *x, *meta, *nmw, *w_in, *lamqk, *subln, *convw, *convb, *ib, *fb, *mnw, *w_out, *nfw_ffn, *w_q, *subkeys, *pu, *pv, *nfinal;
    float* out; unsigned char* ws;
};

#define LAS __attribute__((address_space(3)))
#define XB_TMO      128
#define XB_XCNT(j)  (256  + 64 * (j))
#define XB_XSUB(j)  (1280 + 64 * (j))
#define XB_XGEN(j)  (2304 + 64 * (j))
#define XB_TOP      3328
#define XB_TOPGEN   3392
#define XCD_BAR_WORDS 3456
#define XB_SPIN_CAP (1u << 18)

__device__ __forceinline__ unsigned xb_ld(unsigned* p)              { return __hip_atomic_load(p, __ATOMIC_RELAXED, __HIP_MEMORY_SCOPE_AGENT); }
__device__ __forceinline__ unsigned xb_add(unsigned* p, unsigned v) { return __hip_atomic_fetch_add(p, v, __ATOMIC_RELAXED, __HIP_MEMORY_SCOPE_AGENT); }
__device__ __forceinline__ unsigned xb_xcc_id() { return (unsigned)__builtin_amdgcn_s_getreg((3 << 11) | 20) & 0xFu; }
#define XB_SPIN(cond, bar) do { unsigned _sp = 0; while (cond) { __builtin_amdgcn_s_sleep(1); \
    if ((++_sp & 255u) == 0u) { if (xb_ld(&(bar)[XB_TMO])) break; if (_sp > XB_SPIN_CAP) { atomicAdd(&(bar)[XB_TMO], 1u); break; } } } } while (0)

struct XcdBarrier {
    unsigned* bar; unsigned x;
    volatile LAS unsigned* st;
};

__device__ __forceinline__ XcdBarrier xcd_barrier_post(unsigned* bar, volatile LAS unsigned* st) {
    XcdBarrier b; b.bar = bar; b.x = xb_xcc_id(); b.st = st;
    if (threadIdx.x == 0) (void)xb_add(&bar[XB_XCNT(b.x)], 1u);
    return b;
}
__device__ __forceinline__ void xcd_barrier_complete(unsigned* bar, unsigned x, unsigned& nloc, unsigned& nx) {
    const unsigned G = gridDim.x * gridDim.y * gridDim.z;
    unsigned sum, cnt, mine, sp = 0u;
    for (;;) {
        sum = 0u; cnt = 0u; mine = 0u;
#pragma unroll
        for (unsigned j = 0; j < 16; ++j) { const unsigned c = xb_ld(&bar[XB_XCNT(j)]); sum += c; cnt += (c > 0u) ? 1u : 0u; mine = (j == x) ? c : mine; }
        if (sum == G) break;
        __builtin_amdgcn_s_sleep(1);
        if ((++sp & 255u) == 0u) { if (xb_ld(&bar[XB_TMO])) break; if (sp > XB_SPIN_CAP) { atomicAdd(&bar[XB_TMO], 1u); break; } }
    }
    nloc = mine > 0u ? mine : 1u; nx = cnt > 0u ? cnt : 1u;
}

__device__ __forceinline__ void xcd_barrier(const XcdBarrier& b) {
    asm volatile("s_waitcnt vmcnt(0)" ::: "memory");
    __syncthreads();
    if (threadIdx.x == 0) {
        unsigned* bar = b.bar;
        __builtin_amdgcn_s_waitcnt(0);
        unsigned nloc = b.st[0], nx = b.st[1];
        if (nloc == 0u) { xcd_barrier_complete(bar, b.x, nloc, nx); b.st[0] = nloc; b.st[1] = nx; }
        const unsigned old = xb_add(&bar[XB_XSUB(b.x)], 1u);
        const unsigned gen = old / nloc;
        if (old + 1u == (gen + 1u) * nloc) {
            __builtin_amdgcn_fence(__ATOMIC_RELEASE, "agent");
            asm volatile("s_waitcnt vmcnt(0)" ::: "memory");
            const unsigned og = xb_add(&bar[XB_TOP], 1u);
            const unsigned tg = og / nx;
            if (og + 1u == (tg + 1u) * nx) xb_add(&bar[XB_TOPGEN], 1u);
            else XB_SPIN(xb_ld(&bar[XB_TOPGEN]) == tg, bar);
            __builtin_amdgcn_fence(__ATOMIC_ACQUIRE, "agent");
            xb_add(&bar[XB_XGEN(b.x)], 1u);
            asm volatile("s_waitcnt vmcnt(0)" ::: "memory");
        } else {
            XB_SPIN(xb_ld(&bar[XB_XGEN(b.x)]) == gen, bar);
            __builtin_amdgcn_fence(__ATOMIC_ACQUIRE, "agent");
            asm volatile("s_waitcnt vmcnt(0)" ::: "memory");
        }
    }
    __syncthreads();
}

constexpr int CW_BAR = 0, CW_QUEUE = 4096;
constexpr int LDS_MISC = LDS_BYTES - 256;
__device__ __forceinline__ int next_item(unsigned* ctr, volatile LAS unsigned* slot) {
    __syncthreads();
    if (threadIdx.x == 0) *slot = __hip_atomic_fetch_add(ctr, 1u, __ATOMIC_RELAXED, __HIP_MEMORY_SCOPE_AGENT);
    __syncthreads();
    return (int)*slot;
}

__device__ __forceinline__ void transpose_item(const float* W, int ldw, int K, int N, bf16_t* WT, bool ropeperm, float* scr, int item, int lane, const float* kscale = nullptr) {
    const int nblk = N / 32, kb = item / nblk, nb = item % nblk, k0 = 64 * kb, n0 = 32 * nb;
#pragma unroll 8
    for (int i = 0; i < 32; ++i) { const int kk = 2 * i + (lane >> 5); scr[kk * 33 + (lane & 31)] = W[(size_t)(k0 + kk) * ldw + n0 + (lane & 31)] * (kscale ? kscale[k0 + kk] : 1.f); }
    __builtin_amdgcn_s_waitcnt(0xC07F); asm volatile("" ::: "memory");
    const int c = lane & 7;
#pragma unroll
    for (int j = 0; j < 4; ++j) {
        const int n = (lane >> 3) + 8 * j; const float* s = scr + (8 * c) * 33 + n;
        uint4 o; o.x = pk2(s[0 * 33], s[1 * 33]); o.y = pk2(s[2 * 33], s[3 * 33]); o.z = pk2(s[4 * 33], s[5 * 33]); o.w = pk2(s[6 * 33], s[7 * 33]);
        int orow = n0 + n;
        if (ropeperm && n0 < 2048) orow = (n0 & ~63) + 2 * n + ((n0 >> 5) & 1);
        *(uint4*)(WT + (size_t)orow * K + k0 + 8 * c) = o;
    }
    __builtin_amdgcn_s_waitcnt(0xC07F); asm volatile("" ::: "memory");
}

__device__ __forceinline__ void hn_row(const Args& a, bf16_t* HN, float* G, const float* WG, int r, const f32x4 (&v)[8], int lane) {
    float ss = 0.f;
#pragma unroll
    for (int j = 0; j < 8; ++j) ss += (v[j][0] * v[j][0] + v[j][1] * v[j][1]) + (v[j][2] * v[j][2] + v[j][3] * v[j][3]);
    const float rstd = rsqrtf(wave_sum(ss) * (1.f / DM) + EPS);
    float g[8];
#pragma unroll
    for (int k = 0; k < 8; ++k) g[k] = 0.f;
    unsigned long long* o8 = (unsigned long long*)(HN + (size_t)r * DM) + lane;
#pragma unroll
    for (int j = 0; j < 8; ++j) {
        const f32x4 w = ((const f32x4*)a.nmw)[64 * j + lane];
        const f32x4 y = v[j] * rstd * w;
        o8[64 * j] = (unsigned long long)pk2(y[0], y[1]) | ((unsigned long long)pk2(y[2], y[3]) << 32);
#pragma unroll
        for (int k = 0; k < 8; ++k) { const f32x4 wg = ((const f32x4*)(WG + k * 2048))[64 * j + lane]; g[k] += (y[0] * wg[0] + y[1] * wg[1]) + (y[2] * wg[2] + y[3] * wg[3]); }
        __builtin_amdgcn_sched_barrier(0);
    }
    float r4[4], r2[2], r1;
    { const bool hb = (lane & 32) != 0;
#pragma unroll
      for (int i = 0; i < 4; ++i) { const float send = hb ? g[i] : g[i + 4]; const float recv = __shfl_xor(send, 32); r4[i] = (hb ? g[i + 4] : g[i]) + recv; } }
    { const bool hb = (lane & 16) != 0;
#pragma unroll
      for (int i = 0; i < 2; ++i) { const float send = hb ? r4[i] : r4[i + 2]; const float recv = __shfl_xor(send, 16); r2[i] = (hb ? r4[i + 2] : r4[i]) + recv; } }
    { const bool hb = (lane & 8) != 0; const float send = hb ? r2[0] : r2[1]; const float recv = __shfl_xor(send, 8); r1 = (hb ? r2[1] : r2[0]) + recv; }
    r1 += __shfl_xor(r1, 4); r1 += __shfl_xor(r1, 2); r1 += __shfl_xor(r1, 1);
    if ((lane & 7) == 0) G[(size_t)r * 8 + ((lane >> 5) & 1) * 4 + ((lane >> 4) & 1) * 2 + ((lane >> 3) & 1)] = r1;
}

__device__ __forceinline__ void phase_prep(const Args& a, unsigned char* lds, int bid, int nb) {
    const int tid = opaque_tid(), lane = tid & 63, wave = tid >> 6;
    const int gw = bid * NWAVES + wave, NGW = nb * NWAVES;
    unsigned char* ws = a.ws;
    bf16_t* WinT = (bf16_t*)(ws + WS_WIN); bf16_t* WoutT = (bf16_t*)(ws + WS_WOUT); bf16_t* WqT = (bf16_t*)(ws + WS_WQ);
    bf16_t* U = (bf16_t*)(ws + WS_U); bf16_t* V = (bf16_t*)(ws + WS_V); bf16_t* HN = (bf16_t*)(ws + WS_HN);
    float* G = (float*)(ws + WS_GATES); float* rope = (float*)(ws + WS_ROPE);
    float* scr = (float*)lds + wave * (64 * 33);
    float* WG = (float*)(lds + 8 * 64 * 33 * 4);
    for (int i = tid; i < 8 * 2048; i += NTHREADS) { const int k = i >> 3, g = i & 7; WG[g * 2048 + k] = a.w_in[(size_t)k * INCOLS + 6144 + g]; }
    __syncthreads();
    constexpr int I_IN = 32 * 192, I_OUT = 32 * 64, I_Q = 32 * 64;
    for (int it = gw; it < I_IN + I_OUT + I_Q; it += NGW) {
        int r = it;
        if (r < I_IN) { transpose_item(a.w_in, INCOLS, 2048, 6144, WinT, true, scr, r, lane); continue; } r -= I_IN;
        if (r < I_OUT) { transpose_item(a.w_out, 2048, 2048, 2048, WoutT, false, scr, r, lane); continue; } r -= I_OUT;
        transpose_item(a.w_q, 2048, 2048, 2048, WqT, false, scr, r, lane, a.nfw_ffn);
    }
    {
        f32x4 vc[8], vn[8];
#pragma unroll
        for (int j = 0; j < 8; ++j) vc[j] = ((const f32x4*)(a.x + (size_t)gw * DM))[64 * j + lane];
        for (int r = gw; r < TREAL; r += NGW) {
            const int rn = r + NGW < TREAL ? r + NGW : r;
#pragma unroll
            for (int j = 0; j < 8; ++j) vn[j] = ((const f32x4*)(a.x + (size_t)rn * DM))[64 * j + lane];
            hn_row(a, HN, G, WG, r, vc, lane);
#pragma unroll
            for (int j = 0; j < 8; ++j) vc[j] = vn[j];
        }
    }
    for (int r = TREAL + gw; r < MROWS; r += NGW) {
        if (r >= META_ROW0 && r < META_ROW0 + NMETA) {
            f32x4 vm[8];
#pragma unroll
            for (int j = 0; j < 8; ++j) vm[j] = ((const f32x4*)(a.meta + (size_t)(r - META_ROW0) * DM))[64 * j + lane];
            hn_row(a, HN, G, WG, r, vm, lane);
        } else {
            unsigned long long* o8 = (unsigned long long*)(HN + (size_t)r * DM) + lane;
#pragma unroll
            for (int j = 0; j < 8; ++j) o8[64 * j] = 0ull;
            if (lane < 8) G[(size_t)r * 8 + lane] = 0.f;
        }
    }
    { bf16_t* SKB = (bf16_t*)(ws + WS_SKB);
      for (int i = bid * NTHREADS + tid; i < 8 * 2 * 128 * 128 / 2; i += nb * NTHREADS) { const float2 v = ((const float2*)a.subkeys)[i]; ((unsigned*)SKB)[i] = pk2(v.x, v.y); } }
    for (int i = bid * NTHREADS + tid; i < (SEQ + NMETA) * 32; i += nb * NTHREADS) {
        const int pos = i >> 5, j = i & 31;
        const float inv = (float)pow(10000.0, -(double)j / 32.0);
        const float ang = (float)pos * inv;
        rope[2 * i] = (float)cos((double)ang); rope[2 * i + 1] = (float)sin((double)ang);
    }
}


constexpr int CW_QTAB = 4096 + 1024, TAB_ITEMS = 2 * 16384 / 16;
__device__ __forceinline__ void phase_tables(const Args& a, unsigned char* lds, unsigned* ctl) {
    const int tid = opaque_tid(), lane = tid & 63, wave = __builtin_amdgcn_readfirstlane(tid >> 6);
    unsigned char* ws = a.ws;
    volatile LAS unsigned* slot = (volatile LAS unsigned*)((LAS unsigned char*)lds + LDS_MISC) + 2;
    for (;;) {
        const int item = next_item(ctl + CW_QTAB, slot);
        if (item >= TAB_ITEMS) break;
        const int rr = item * 16 + wave;
    {
        unsigned* U8 = (unsigned*)(ws + WS_U); unsigned* V8 = (unsigned*)(ws + WS_V); float* ISC = (float*)(ws + WS_ISC);
        {
            f32x4 v[2][8]; float am[2];
#pragma unroll
            for (int q = 0; q < 2; ++q) {
                const int r = rr + q * 8; const bool isu = r < 16384; const int e = r & 16383;
                const f32x4* xr = (const f32x4*)((isu ? a.pu : a.pv) + (size_t)e * DM) + lane;
#pragma unroll
                for (int j = 0; j < 8; ++j) v[q][j] = xr[64 * j];
            }
#pragma unroll
            for (int q = 0; q < 2; ++q) if (rr + q * 8 < 16384) {
#pragma unroll
                for (int j = 0; j < 8; ++j) v[q][j] = v[q][j] * ((const f32x4*)a.nfw_ffn)[64 * j + lane]; }
#pragma unroll
            for (int q = 0; q < 2; ++q) { float t = 0.f;
#pragma unroll
                for (int j = 0; j < 8; ++j) t = fmaxf(t, fmaxf(fmaxf(fabsf(v[q][j][0]), fabsf(v[q][j][1])), fmaxf(fabsf(v[q][j][2]), fabsf(v[q][j][3]))));
                am[q] = t; }
#pragma unroll
            for (int o = 1; o < 64; o <<= 1) { am[0] = fmaxf(am[0], __shfl_xor(am[0], o)); am[1] = fmaxf(am[1], __shfl_xor(am[1], o)); }
#pragma unroll
            for (int q = 0; q < 2; ++q) {
                const int r = rr + q * 8; const bool isu = r < 16384; const int e = r & 16383;
                const float top = isu ? 127.f : 256.f;
                const float sc = am[q] > 0.f ? top / am[q] : 0.f;
                unsigned* o8 = isu ? U8 : V8;
#pragma unroll
                for (int j = 0; j < 8; ++j) { int w;
                    if (isu) { const int q0 = (int)rintf(v[q][j][0] * sc), q1 = (int)rintf(v[q][j][1] * sc), q2 = (int)rintf(v[q][j][2] * sc), q3 = (int)rintf(v[q][j][3] * sc);
                        w = (int)((unsigned)(q0 & 255) | ((unsigned)(q1 & 255) << 8) | ((unsigned)(q2 & 255) << 16) | ((unsigned)q3 << 24)); }
                    else { w = __builtin_amdgcn_cvt_pk_fp8_f32(v[q][j][0] * sc, v[q][j][1] * sc, 0, false); w = __builtin_amdgcn_cvt_pk_fp8_f32(v[q][j][2] * sc, v[q][j][3] * sc, w, true); }
                    o8[((size_t)j * 16384 + e) * 64 + lane] = (unsigned)w; }
                if (lane == 0) ISC[(isu ? 0 : 16384) + e] = am[q] / top;
            }
        }
    }
    }
}

namespace att {
using bf16x8 = __attribute__((ext_vector_type(8))) short;
using s16x4 = __attribute__((ext_vector_type(4))) short;
using f32x16 = __attribute__((ext_vector_type(16))) float;
using u32x4 = __attribute__((ext_vector_type(4))) unsigned;
constexpr int SHM_V = 16384, SHM_K = 16384;
constexpr int L_V = 0, L_K = 2 * SHM_V, L_WS = L_K + 2 * SHM_K, L_P = L_WS + 8 * 64 * 4, L_END = L_P + 4 * 4096;
#define KSWZ(row, colB) ((row) * 256 + ((colB) ^ (((row) & 7) << 4)))
#define SBAR() __builtin_amdgcn_sched_barrier(0)
__device__ __forceinline__ int crow(int r, int hi) { return (r & 3) + 8 * (r >> 2) + 4 * hi; }
__device__ __forceinline__ unsigned cvtpk(float lo, float hi) { unsigned r; asm volatile("v_cvt_pk_bf16_f32 %0, %1, %2" : "=v"(r) : "v"(lo), "v"(hi)); return r; }
__device__ __forceinline__ int v_st(int k, int c) { const int kk = (k & ~0xC) | ((k & 4) << 1) | ((k & 8) >> 1); return ((kk >> 3) * 4 + (c >> 5)) * 512 + ((kk & 7) * 32 + (c & 31)) * 2; }
__device__ __forceinline__ int v_rd_base(int lane) { return ((lane & 3) << 3) | (((lane >> 2) & 3) << 6) | (((lane >> 4) & 1) << 5) | (((lane >> 5) & 1) << 8); }
constexpr int v_rd_off(int d0, int ks, int half) { return d0 * 512 + ks * 4096 + half * 2048; }
template <int OFF> __device__ __forceinline__ s16x4 tr_read(int vb) { s16x4 r; asm volatile("ds_read_b64_tr_b16 %0, %1 offset:%2" : "=&v"(r) : "v"(vb), "i"(OFF) : "memory"); return r; }
template <int D0> __device__ __forceinline__ void pv_one(f32x16& od, int vb, bf16x8 pa0, bf16x8 pa1, bf16x8 pa2, bf16x8 pa3) {
    const s16x4 l0 = tr_read<v_rd_off(D0, 0, 0)>(vb), h0 = tr_read<v_rd_off(D0, 0, 1)>(vb), l1 = tr_read<v_rd_off(D0, 1, 0)>(vb), h1 = tr_read<v_rd_off(D0, 1, 1)>(vb);
    const s16x4 l2 = tr_read<v_rd_off(D0, 2, 0)>(vb), h2 = tr_read<v_rd_off(D0, 2, 1)>(vb), l3 = tr_read<v_rd_off(D0, 3, 0)>(vb), h3 = tr_read<v_rd_off(D0, 3, 1)>(vb);
    asm volatile("s_waitcnt lgkmcnt(0)" ::: "memory"); SBAR();
#define PK(L, H) (bf16x8){L[0], L[1], L[2], L[3], H[0], H[1], H[2], H[3]}
    od = __builtin_amdgcn_mfma_f32_32x32x16_bf16(pa0, PK(l0, h0), od, 0, 0, 0);
    od = __builtin_amdgcn_mfma_f32_32x32x16_bf16(pa1, PK(l1, h1), od, 0, 0, 0);
    od = __builtin_amdgcn_mfma_f32_32x32x16_bf16(pa2, PK(l2, h2), od, 0, 0, 0);
    od = __builtin_amdgcn_mfma_f32_32x32x16_bf16(pa3, PK(l3, h3), od, 0, 0, 0);
#undef PK
}
__device__ __forceinline__ void qkt(f32x16& p0, f32x16& p1, const char* Ks, const bf16x8* qr, int r32, int hi, int comp) {
    p0 = f32x16{}; p1 = f32x16{};
#pragma unroll
    for (int d0 = 0; d0 < 4; ++d0) {
        const int cb = (comp * 64 + d0 * 16 + hi * 8) * 2;
        const bf16x8 b0 = *reinterpret_cast<const bf16x8*>(Ks + KSWZ(r32, cb));
        const bf16x8 b1 = *reinterpret_cast<const bf16x8*>(Ks + KSWZ(32 + r32, cb));
        p0 = __builtin_amdgcn_mfma_f32_32x32x16_bf16(b0, qr[d0], p0, 0, 0, 0);
        p1 = __builtin_amdgcn_mfma_f32_32x32x16_bf16(b1, qr[d0], p1, 0, 0, 0);
    }
}

__device__ __forceinline__ void attn_unit(int b, int h, int qb, const bf16_t* Z, bf16_t* MIX, float lam, const float* subln, char* lds) {
    const int tid = opaque_tid(), wid = __builtin_amdgcn_readfirstlane(tid >> 6), lane = tid & 63, r32 = lane & 31, hi = lane >> 5;
    const int comp = wid >> 2, rg = wid & 3;
    char* V_lds = lds + L_V; char* K_lds = lds + L_K;
    float* wsf = (float*)(lds + L_WS) + wid * 64;
    const int q0 = b * SEQ + qb * 128;
    const float NEGV = -1e30f;
    bf16x8 qr[4];
    {
        const bf16_t* Qw = Z + (size_t)(q0 + rg * 32 + r32) * NZ + ZQ + h * 128 + comp * 64 + hi * 8;
#pragma unroll
        for (int d0 = 0; d0 < 4; ++d0) qr[d0] = *reinterpret_cast<const bf16x8*>(Qw + d0 * 16);
    }
    const int NT = 2 * qb + 3;
    const int sr = tid >> 4, sc = (tid & 15) * 8;
    const int vst0 = v_st(sr, sc), vst1 = v_st(32 + sr, sc), kst0 = KSWZ(sr, sc * 2), kst1 = KSWZ(32 + sr, sc * 2);
    const int vb0 = (int)(uintptr_t)V_lds + v_rd_base(lane);
#define PK4(P, BASE, OUT) do { unsigned a0 = cvtpk(P[BASE + 0], P[BASE + 1]), a1 = cvtpk(P[BASE + 2], P[BASE + 3]); \
        unsigned b0 = cvtpk(P[BASE + 4], P[BASE + 5]), b1 = cvtpk(P[BASE + 6], P[BASE + 7]); \
        auto r0 = __builtin_amdgcn_permlane32_swap(a0, b0, false, false); auto r1 = __builtin_amdgcn_permlane32_swap(a1, b1, false, false); \
        u32x4 w = {r0[0], r1[0], r0[1], r1[1]}; OUT = *reinterpret_cast<bf16x8*>(&w); } while (0)
    bf16x8 vsA0, vsA1, ksA0, ksA1, vsB0, vsB1, ksB0, ksB1;
#define SLOAD(j, S) do { const size_t r0_ = (size_t)((j) == 0 ? META_TILE0 : b * SEQ + ((j) - 1) * 64) + sr; const bf16_t* zp_ = Z + r0_ * NZ + h * 128 + sc; \
        vs##S##0 = *reinterpret_cast<const bf16x8*>(zp_ + ZV); vs##S##1 = *reinterpret_cast<const bf16x8*>(zp_ + ZV + (size_t)32 * NZ); \
        ks##S##0 = *reinterpret_cast<const bf16x8*>(zp_ + ZK); ks##S##1 = *reinterpret_cast<const bf16x8*>(zp_ + ZK + (size_t)32 * NZ); } while (0)
#define SWRITE(bi, S) do { *reinterpret_cast<bf16x8*>(V_lds + (bi) * SHM_V + vst0) = vs##S##0; *reinterpret_cast<bf16x8*>(V_lds + (bi) * SHM_V + vst1) = vs##S##1; \
        *reinterpret_cast<bf16x8*>(K_lds + (bi) * SHM_K + kst0) = ks##S##0; *reinterpret_cast<bf16x8*>(K_lds + (bi) * SHM_K + kst1) = ks##S##1; } while (0)
    f32x16 o[4] = {}; float m_reg = NEGV, l_reg = 0.f;
    SLOAD(0, A); SWRITE(0, A); SLOAD(1, B); __syncthreads();
    const int qrel = rg * 32 + r32;
#define ATT_TILE(j, L_, W_) do { \
        const int cur = j & 1; \
        if (j + 2 < NT) SLOAD(j + 2, L_); \
        f32x16 p0, p1; \
        qkt(p0, p1, K_lds + cur * SHM_K, qr, r32, hi, comp); \
        if (j == 0) { \
    _Pragma("unroll") \
            for (int r = 0; r < 16; ++r) { p0[r] = NEGV; if (r < 8) p1[r] = NEGV; } \
        } else if (j >= NT - 2) { \
            const int kb0 = (j - (NT - 2)) * 64; \
    _Pragma("unroll") \
            for (int r = 0; r < 16; ++r) { const int kl = kb0 + crow(r, hi); if (kl > qrel) p0[r] = NEGV; if (kl + 32 > qrel) p1[r] = NEGV; } \
        } \
        float pmax = p0[0]; \
    _Pragma("unroll") \
        for (int r = 1; r < 16; ++r) pmax = fmaxf(pmax, p0[r]); \
    _Pragma("unroll") \
        for (int r = 0; r < 16; ++r) pmax = fmaxf(pmax, p1[r]); \
        { auto rr = __builtin_amdgcn_permlane32_swap(__float_as_uint(pmax), __float_as_uint(pmax), false, false); pmax = fmaxf(__uint_as_float(rr[0]), __uint_as_float(rr[1])); } \
        const float mn = fmaxf(m_reg, pmax); const float alpha = __builtin_amdgcn_exp2f(m_reg - mn); m_reg = mn; \
        float ps = 0.f; \
    _Pragma("unroll") \
        for (int r = 0; r < 16; ++r) { p0[r] = __builtin_amdgcn_exp2f(p0[r] - mn); ps += p0[r]; } \
    _Pragma("unroll") \
        for (int r = 0; r < 16; ++r) { p1[r] = __builtin_amdgcn_exp2f(p1[r] - mn); ps += p1[r]; } \
        { auto rr = __builtin_amdgcn_permlane32_swap(__float_as_uint(ps), __float_as_uint(ps), false, false); ps = __uint_as_float(rr[0]) + __uint_as_float(rr[1]); } \
        l_reg = l_reg * alpha + ps; \
        if (__any(alpha < 1.f)) { \
            if (hi == 0) wsf[r32] = alpha; \
            asm volatile("s_waitcnt lgkmcnt(0)" ::: "memory"); \
            float al[16]; \
    _Pragma("unroll") \
            for (int r = 0; r < 16; ++r) al[r] = wsf[crow(r, hi)]; \
    _Pragma("unroll") \
            for (int d = 0; d < 4; ++d) \
    _Pragma("unroll") \
                for (int r = 0; r < 16; ++r) o[d][r] *= al[r]; \
            asm volatile("s_waitcnt lgkmcnt(0)" ::: "memory"); \
        } \
        bf16x8 pa0, pa1, pa2, pa3; \
        PK4(p0, 0, pa0); PK4(p0, 8, pa1); PK4(p1, 0, pa2); PK4(p1, 8, pa3); \
        SBAR(); \
        { const int vb = vb0 + cur * SHM_V; \
          pv_one<0>(o[0], vb, pa0, pa1, pa2, pa3); pv_one<1>(o[1], vb, pa0, pa1, pa2, pa3); pv_one<2>(o[2], vb, pa0, pa1, pa2, pa3); pv_one<3>(o[3], vb, pa0, pa1, pa2, pa3); } \
        if (j + 1 < NT) SWRITE(cur ^ 1, W_); \
        __syncthreads(); \
    } while (0)
    {
        SLOAD(2, A);
        f32x16 p1 = f32x16{};
#pragma unroll
        for (int d0 = 0; d0 < 4; ++d0) {
            const int cb = (comp * 64 + d0 * 16 + hi * 8) * 2;
            const bf16x8 b1 = *reinterpret_cast<const bf16x8*>(K_lds + KSWZ(32 + r32, cb));
            p1 = __builtin_amdgcn_mfma_f32_32x32x16_bf16(b1, qr[d0], p1, 0, 0, 0);
        }
        float pmax = p1[8];
#pragma unroll
        for (int r = 9; r < 16; ++r) pmax = fmaxf(pmax, p1[r]);
        { auto rr = __builtin_amdgcn_permlane32_swap(__float_as_uint(pmax), __float_as_uint(pmax), false, false); pmax = fmaxf(__uint_as_float(rr[0]), __uint_as_float(rr[1])); }
        m_reg = pmax;
        float ps = 0.f;
#pragma unroll
        for (int r = 0; r < 8; ++r) p1[r] = 0.f;
#pragma unroll
        for (int r = 8; r < 16; ++r) { p1[r] = __builtin_amdgcn_exp2f(p1[r] - pmax); ps += p1[r]; }
        { auto rr = __builtin_amdgcn_permlane32_swap(__float_as_uint(ps), __float_as_uint(ps), false, false); ps = __uint_as_float(rr[0]) + __uint_as_float(rr[1]); }
        l_reg = ps;
        bf16x8 pa3; PK4(p1, 8, pa3);
        SBAR();
        {
#define PKF(L, H) (bf16x8){L[0], L[1], L[2], L[3], H[0], H[1], H[2], H[3]}
            const s16x4 l0 = tr_read<v_rd_off(0, 3, 0)>(vb0), h0 = tr_read<v_rd_off(0, 3, 1)>(vb0), l1 = tr_read<v_rd_off(1, 3, 0)>(vb0), h1 = tr_read<v_rd_off(1, 3, 1)>(vb0);
            const s16x4 l2 = tr_read<v_rd_off(2, 3, 0)>(vb0), h2 = tr_read<v_rd_off(2, 3, 1)>(vb0), l3 = tr_read<v_rd_off(3, 3, 0)>(vb0), h3 = tr_read<v_rd_off(3, 3, 1)>(vb0);
            asm volatile("s_waitcnt lgkmcnt(0)" ::: "memory"); SBAR();
            o[0] = __builtin_amdgcn_mfma_f32_32x32x16_bf16(pa3, PKF(l0, h0), o[0], 0, 0, 0); o[1] = __builtin_amdgcn_mfma_f32_32x32x16_bf16(pa3, PKF(l1, h1), o[1], 0, 0, 0);
            o[2] = __builtin_amdgcn_mfma_f32_32x32x16_bf16(pa3, PKF(l2, h2), o[2], 0, 0, 0); o[3] = __builtin_amdgcn_mfma_f32_32x32x16_bf16(pa3, PKF(l3, h3), o[3], 0, 0, 0);
#undef PKF
        }
        SWRITE(1, B);
        __syncthreads();
    }
    for (int j = 1; j < NT; j += 2) { ATT_TILE(j, B, A); ATT_TILE(j + 1, A, B); }
#undef ATT_TILE
#undef SLOAD
#undef SWRITE
#undef PK4
    if (hi == 0) wsf[r32] = l_reg;
    asm volatile("s_waitcnt lgkmcnt(0)" ::: "memory");
    float rli[16];
#pragma unroll
    for (int r = 0; r < 16; ++r) rli[r] = __builtin_amdgcn_rcpf(wsf[crow(r, hi)]);
    float* X = (float*)lds + rg * 4096;
    if (comp == 1) {
#pragma unroll
        for (int d0 = 0; d0 < 4; ++d0)
#pragma unroll
            for (int r = 0; r < 16; ++r) X[(d0 * 16 + r) * 64 + lane] = o[d0][r] * rli[r] * lam;
    }
    __syncthreads();
    if (comp == 0) {
        float ssr[16];
#pragma unroll
        for (int r = 0; r < 16; ++r) ssr[r] = 0.f;
#pragma unroll
        for (int d0 = 0; d0 < 4; ++d0)
#pragma unroll
            for (int r = 0; r < 16; ++r) { const float v = o[d0][r] * rli[r] - X[(d0 * 16 + r) * 64 + lane]; o[d0][r] = v; ssr[r] += v * v; }
        float* P = (float*)(lds + L_P) + rg * 1024;
#pragma unroll
        for (int r = 0; r < 16; ++r) P[r * 64 + lane] = ssr[r];
        asm volatile("s_waitcnt lgkmcnt(0)" ::: "memory");
        {
            const int rho = lane & 31, hh = (rho >> 2) & 1, rr = (rho & 3) + 4 * (rho >> 3);
            const float4* pp = (const float4*)(P + rr * 64 + hh * 32 + (lane >> 5) * 16);
            const float4 a0 = pp[0], a1 = pp[1], a2 = pp[2], a3 = pp[3];
            float s = ((a0.x + a0.y) + (a0.z + a0.w)) + ((a1.x + a1.y) + (a1.z + a1.w)) + ((a2.x + a2.y) + (a2.z + a2.w)) + ((a3.x + a3.y) + (a3.z + a3.w));
            auto sw = __builtin_amdgcn_permlane32_swap(__float_as_uint(s), __float_as_uint(s), false, false); s = __uint_as_float(sw[0]) + __uint_as_float(sw[1]);
            if (lane < 32) wsf[32 + rho] = rsqrtf(s * (1.f / 128.f) + EPS) * (1.f - LAMBDA_INIT);
        }
        asm volatile("s_waitcnt lgkmcnt(0)" ::: "memory");
        float sw4[4];
#pragma unroll
        for (int d0 = 0; d0 < 4; ++d0) sw4[d0] = subln[d0 * 32 + r32];
        bf16_t* Ow = MIX + (size_t)(q0 + rg * 32) * DM + h * 128 + r32;
#pragma unroll
        for (int r = 0; r < 16; ++r) {
            const int orow = crow(r, hi); const float rs = wsf[32 + orow];
#pragma unroll
            for (int d0 = 0; d0 < 4; ++d0) Ow[(size_t)orow * DM + d0 * 32] = (bf16_t)f2bf(o[d0][r] * rs * sw4[d0]);
        }
    }
    __syncthreads();
}
#undef KSWZ
#undef SBAR
}

__device__ __forceinline__ float attn_lambda(const Args& a) {
    const int lane = opaque_tid() & 63;
    const float l1 = wave_sum(a.lamqk[lane] * a.lamqk[64 + lane]), l2 = wave_sum(a.lamqk[128 + lane] * a.lamqk[192 + lane]);
    return expf(l1) - expf(l2) + LAMBDA_INIT;
}
namespace mls {
using bf16x8 = __attribute__((ext_vector_type(8))) short;
using bf16x4 = __attribute__((ext_vector_type(4))) short;
using s16x4 = __attribute__((ext_vector_type(4))) short;
using f32x16 = __attribute__((ext_vector_type(16))) float;
using f32x4v = __attribute__((ext_vector_type(4))) float;
using u32x4v = __attribute__((ext_vector_type(4))) unsigned;
using u32x2v = __attribute__((ext_vector_type(2))) unsigned;
constexpr int L_QS = 0, L_QP = 16384, L_KS = 32768, L_KW = 49152, L_VT = 65536, L_PT = 98304, L_HT = 106496, HT_STRIDE = 528;
constexpr int L_MISC = L_HT + 64 * HT_STRIDE;
constexpr int L_RS = L_MISC, L_QN = L_RS + 2 * 64 * 4, L_NV = L_QN + 64 * 4, L_NP = L_NV + 128 * 4, L_CW = L_NP + 8 * 128 * 4, L_RD = L_CW + 5 * 256 * 4, L_NW = L_RD + 8 * 64 * 4, L_END = L_NW + 8 * 36 * 4;
#define KSWZ(row, colB) ((row) * 256 + ((colB) ^ (((row) & 7) << 4)))
#define PSWZ(row, colB) ((row) * 128 + ((colB) ^ ((((row) >> 1) & 7) << 4)))
__device__ __forceinline__ int crow(int r, int hi) { return (r & 3) + 8 * (r >> 2) + 4 * hi; }
__device__ __forceinline__ unsigned cvtpk(float lo, float hi) { unsigned r; asm volatile("v_cvt_pk_bf16_f32 %0, %1, %2" : "=v"(r) : "v"(lo), "v"(hi)); return r; }
__device__ __forceinline__ int v_st(int k, int c) { const int kk = (k & ~0xC) | ((k & 4) << 1) | ((k & 8) >> 1); return ((kk >> 3) * 4 + (c >> 5)) * 512 + ((kk & 7) * 32 + (c & 31)) * 2; }
__device__ __forceinline__ int v_rd_base(int lane) { return ((lane & 3) << 3) | (((lane >> 2) & 3) << 6) | (((lane >> 4) & 1) << 5) | (((lane >> 5) & 1) << 8); }
__device__ __forceinline__ s16x4 tr_read_dyn(int addr) { s16x4 r; asm volatile("ds_read_b64_tr_b16 %0, %1" : "=&v"(r) : "v"(addr) : "memory"); return r; }
__device__ __forceinline__ bf16x8 tr_frag(int img_plus_base, int d0, int ks) {
    const s16x4 lo = tr_read_dyn(img_plus_base + d0 * 512 + ks * 4096), hi = tr_read_dyn(img_plus_base + d0 * 512 + ks * 4096 + 2048);
    return (bf16x8){lo[0], lo[1], lo[2], lo[3], hi[0], hi[1], hi[2], hi[3]};
}
template <int CTRL, int RMASK> __device__ __forceinline__ float dppf(float old, float v) { return __builtin_bit_cast(float, __builtin_amdgcn_update_dpp(__builtin_bit_cast(int, old), __builtin_bit_cast(int, v), CTRL, RMASK, 0xf, false)); }
__device__ __forceinline__ float scan_add(float v) {
    v += dppf<0x111, 0xf>(0.f, v); v += dppf<0x112, 0xf>(0.f, v); v += dppf<0x114, 0xf>(0.f, v); v += dppf<0x118, 0xf>(0.f, v);
    v += dppf<0x142, 0xa>(0.f, v); v += dppf<0x143, 0xc>(0.f, v); return v;
}
__device__ __forceinline__ float scan_max(float v) {
    const float NI = -3.0e38f;
    v = fmaxf(v, dppf<0x111, 0xf>(NI, v)); v = fmaxf(v, dppf<0x112, 0xf>(NI, v)); v = fmaxf(v, dppf<0x114, 0xf>(NI, v)); v = fmaxf(v, dppf<0x118, 0xf>(NI, v));
    v = fmaxf(v, dppf<0x142, 0xa>(NI, v)); v = fmaxf(v, dppf<0x143, 0xc>(NI, v)); return v;
}
__device__ __forceinline__ float rlane(float v, int l) { return __uint_as_float(__builtin_amdgcn_readlane(__float_as_uint(v), l)); }
__device__ __forceinline__ float silu(float x) { return x * __builtin_amdgcn_rcpf(1.f + __expf(-x)); }
__device__ __forceinline__ void fmac_v(float& y, float a, float b) { asm("v_fmac_f32 %0, %1, %2" : "+v"(y) : "v"(a), "v"(b)); }
__device__ __forceinline__ float mul_v(float a, float b) { float r; asm("v_mul_f32 %0, %1, %2" : "=v"(r) : "v"(a), "v"(b)); return r; }

__device__ __forceinline__ void mlstm_item(int b, int h, const Args& a, char* lds) {
    const int tid0 = opaque_tid(), wid = __builtin_amdgcn_readfirstlane(tid0 >> 6);
    const bf16_t* Z = (const bf16_t*)(a.ws + WS_Z); const float* G = (const float*)(a.ws + WS_GATES); bf16_t* MIX = (bf16_t*)(a.ws + WS_MIX);
    const int ldsb = (int)(uintptr_t)lds;
    float* RS = (float*)(lds + L_RS); float* QN = (float*)(lds + L_QN); float* NV = (float*)(lds + L_NV); float* NP = (float*)(lds + L_NP); float* CW = (float*)(lds + L_CW);
    for (int i = tid0; i < 5 * 256; i += NTHREADS) { const int j = i >> 8, c = i & 255; const int cc = c < 128 ? h * 128 + c : 512 + h * 128 + (c - 128); CW[i] = j < 4 ? a.convw[j * 1024 + cc] : a.convb[cc]; }
    if (tid0 < 128) NV[tid0] = 0.f;
    if (tid0 < 256) ((float*)(lds + L_NW))[(tid0 >> 5) * 36 + (tid0 & 31)] = a.mnw[h * 256 + tid0];
    const float ibh = a.ib[h], fbh = a.fb[h];
    float cw[4][4], cb[4];
    __syncthreads();
    { const int c4 = 4 * (tid0 & 63);
#pragma unroll
    for (int j = 0; j < 4; ++j)
#pragma unroll
        for (int q = 0; q < 4; ++q) cw[j][q] = CW[j * 256 + c4 + q];
#pragma unroll
    for (int q = 0; q < 4; ++q) cb[q] = CW[4 * 256 + c4 + q]; }
    f32x16 C[4] = {};
    float m_prev = -1e30f;
    u32x2v rq[11]; u32x4v rv[4]; float gi, gf;
    auto chunk_row0 = [&](int c) -> int { return c == 0 ? META_TILE0 : b * SEQ + (c - 1) * 64; };
#define LOAD_RAW(c) do { int tq_ = tid0; asm volatile("" : "+v"(tq_)); const int ln_ = tq_ & 63, c4_ = 4 * ln_, zc_qk = (c4_ < 128 ? ZMQ + h * 128 + c4_ : ZMK + h * 128 + (c4_ - 128)), erow = tq_ >> 3, eseg = tq_ & 7; const int r0_ = chunk_row0(c); \
        _Pragma("unroll") for (int i_ = 0; i_ < 11; ++i_) { const int t_ = 8 * wid - 3 + i_; int row_; bool ok_ = true; \
            if (t_ >= 0) row_ = r0_ + t_; else if ((c) == 0) { row_ = 0; ok_ = false; } else if ((c) == 1) row_ = META_TILE0 + 64 + t_; else row_ = r0_ + t_; \
            rq[i_] = ok_ ? *(const u32x2v*)(Z + (size_t)row_ * NZ + zc_qk) : (u32x2v){0u, 0u}; } \
        _Pragma("unroll") for (int i_ = 0; i_ < 4; ++i_) rv[i_] = *(const u32x4v*)(Z + (size_t)(r0_ + erow) * NZ + ZMV + h * 256 + eseg * 32 + 8 * i_); \
        { const int rowg_ = r0_ + ln_; gi = G[(size_t)rowg_ * 8 + h]; gf = G[(size_t)rowg_ * 8 + 4 + h]; } } while (0)
    LOAD_RAW(0);
    const int NCH = 33;
    for (int c = 0; c < NCH; ++c) {
        int tid = tid0; asm volatile("" : "+v"(tid));
        const int lane = tid & 63, r32 = lane & 31, hi = lane >> 5, cq = lane, c4 = 4 * cq, erow = tid >> 3, eseg = tid & 7;
        float* RD = (float*)(lds + L_RD) + wid * 64;
        float li = gi + ibh; float lf; { const float xf = gf + fbh; lf = fminf(xf, 0.f) - __logf(1.f + __expf(-fabsf(xf))); }
        if (c == 0 && lane < 48) { li = -1e30f; lf = 0.f; }
        const float bsum = scan_add(lf);
        const float u = li - bsum;
        const float cm = scan_max(u);
        const float Mrow = fmaxf(cm, m_prev);
        const float iw = __expf(m_prev - Mrow);
        const float Mend = rlane(Mrow, 63), gtot = rlane(bsum, 63);
        const float wrow = __expf(u - Mend);
        const float dec = __expf(m_prev - Mend);
        const float dexp = __expf(-(bsum + Mrow));
        {
            float qn_part[8], ksum[4] = {0.f, 0.f, 0.f, 0.f};
            float nvv[4];
#pragma unroll
            for (int q = 0; q < 4; ++q) nvv[q] = (cq < 32) ? NV[c4 + q] : 0.f;
#pragma unroll
            for (int i = 0; i < 8; ++i) {
                const int t = 8 * wid + i;
                float xo[4];
#pragma unroll
                for (int q = 0; q < 4; ++q) xo[q] = cb[q];
#pragma unroll
                for (int j = 0; j < 4; ++j) {
                    const u32x2v rr = rq[i + j];
                    fmac_v(xo[0], cw[j][0], bf_lo(rr.x)); fmac_v(xo[1], cw[j][1], bf_hi(rr.x)); fmac_v(xo[2], cw[j][2], bf_lo(rr.y)); fmac_v(xo[3], cw[j][3], bf_hi(rr.y));
                }
#pragma unroll
                for (int q = 0; q < 4; ++q) xo[q] = silu(xo[q]);
                const float iw_t = rlane(iw, t), w_t = rlane(wrow, t);
                if (cq < 32) {
#pragma unroll
                    for (int q = 0; q < 4; ++q) xo[q] = mul_v(xo[q], 0.08838834764831845f);
                    *(uint2*)(lds + L_QS + KSWZ(t, c4 * 2)) = make_uint2(cvtpk(xo[0], xo[1]), cvtpk(xo[2], xo[3]));
                    float qd = 0.f;
#pragma unroll
                    for (int q = 0; q < 4; ++q) { fmac_v(qd, xo[q], nvv[q]); xo[q] = mul_v(xo[q], iw_t); }
                    *(uint2*)(lds + L_QP + KSWZ(t, c4 * 2)) = make_uint2(cvtpk(xo[0], xo[1]), cvtpk(xo[2], xo[3]));
                    qn_part[i] = iw_t * qd;
                } else {
                    const int kc = c4 - 128;
                    *(uint2*)(lds + L_KS + KSWZ(t, kc * 2)) = make_uint2(cvtpk(xo[0], xo[1]), cvtpk(xo[2], xo[3]));
#pragma unroll
                    for (int q = 0; q < 4; ++q) { xo[q] = mul_v(xo[q], w_t); ksum[q] += xo[q]; }
                    *(uint2*)(lds + L_KW + v_st(t, kc)) = make_uint2(cvtpk(xo[0], xo[1]), cvtpk(xo[2], xo[3]));
                    qn_part[i] = 0.f;
                }
                __builtin_amdgcn_sched_barrier(0);
            }
            {
                float r4[4], r2[2], r1;
                { const bool hb = (lane & 16) != 0;
#pragma unroll
                  for (int i = 0; i < 4; ++i) { const float send = hb ? qn_part[i] : qn_part[i + 4]; const float recv = __shfl_xor(send, 16); r4[i] = (hb ? qn_part[i + 4] : qn_part[i]) + recv; } }
                { const bool hb = (lane & 8) != 0;
#pragma unroll
                  for (int i = 0; i < 2; ++i) { const float send = hb ? r4[i] : r4[i + 2]; const float recv = __shfl_xor(send, 8); r2[i] = (hb ? r4[i + 2] : r4[i]) + recv; } }
                { const bool hb = (lane & 4) != 0; const float send = hb ? r2[0] : r2[1]; const float recv = __shfl_xor(send, 4); r1 = (hb ? r2[1] : r2[0]) + recv; }
                r1 += __shfl_xor(r1, 2); r1 += __shfl_xor(r1, 1);
                if (lane < 32 && (lane & 3) == 0) QN[8 * wid + ((lane >> 4) & 1) * 4 + ((lane >> 3) & 1) * 2 + ((lane >> 2) & 1)] = r1;
            }
            if (cq >= 32) {
#pragma unroll
                for (int q = 0; q < 4; ++q) NP[wid * 128 + (c4 - 128) + q] = ksum[q];
            }
#pragma unroll
            for (int i = 0; i < 4; ++i) *(u32x4v*)(lds + L_VT + (eseg >> 2) * 16384 + v_st(erow, (eseg & 3) * 32 + 8 * i)) = rv[i];
        }
        u32x4v zo[4];
        {
            const int r0 = chunk_row0(c);
#pragma unroll
            for (int i = 0; i < 4; ++i) zo[i] = *(const u32x4v*)(Z + (size_t)(r0 + erow) * NZ + ZMO + h * 256 + eseg * 32 + 8 * i);
        }
        if (c + 1 < NCH) LOAD_RAW(c + 1);
        __syncthreads();
        {
            const int tb = wid >> 1, half = wid & 1;
            float rsum[4] = {0.f, 0.f, 0.f, 0.f};
            const int fr = lane & 15, fq = lane >> 4;
            float Mt[4];
#pragma unroll
            for (int i = 0; i < 4; ++i) Mt[i] = __shfl(Mrow, 16 * tb + 4 * fq + i);
#pragma unroll
            for (int sj = 0; sj < 2; ++sj) {
                const int sb = 2 * half + sj;
                unsigned short pw[4] = {0, 0, 0, 0};
                if (sb <= tb) {
                    f32x4v acc = {0.f, 0.f, 0.f, 0.f};
#pragma unroll
                    for (int ks = 0; ks < 4; ++ks) {
                        const bf16x8 af = *(const bf16x8*)(lds + L_QS + KSWZ(16 * tb + fr, (32 * ks + 8 * fq) * 2));
                        const bf16x8 bfr = *(const bf16x8*)(lds + L_KS + KSWZ(16 * sb + fr, (32 * ks + 8 * fq) * 2));
                        acc = __builtin_amdgcn_mfma_f32_16x16x32_bf16(af, bfr, acc, 0, 0, 0);
                    }
                    const int s = 16 * sb + fr; const float us = __shfl(u, s);
#pragma unroll
                    for (int i = 0; i < 4; ++i) {
                        const int t = 16 * tb + 4 * fq + i;
                        const float p = (s <= t) ? acc[i] * __expf(us - Mt[i]) : 0.f;
                        rsum[i] += p; pw[i] = (unsigned short)f2bf(p);
                    }
                }
#pragma unroll
                for (int i = 0; i < 4; ++i) *(unsigned short*)(lds + L_PT + PSWZ(16 * tb + 4 * fq + i, (16 * sb + fr) * 2)) = pw[i];
            }
#pragma unroll
            for (int i = 0; i < 4; ++i) {
                float v = rsum[i];
                v += __shfl_xor(v, 1); v += __shfl_xor(v, 2); v += __shfl_xor(v, 4); v += __shfl_xor(v, 8);
                if (fr == 0) RS[half * 64 + 16 * tb + 4 * fq + i] = v;
            }
        }
        __syncthreads();
        {
            const float nq = RS[lane] + RS[64 + lane] + QN[lane];
            RD[lane] = __builtin_amdgcn_rcpf(fmaxf(fabsf(nq), dexp));
            bf16x8 vf[4];
            const int vimg = ldsb + L_VT + (wid >> 2) * 16384 + v_rd_base(lane);
#pragma unroll
            for (int ks = 0; ks < 4; ++ks) vf[ks] = tr_frag(vimg, wid & 3, ks);
            asm volatile("s_waitcnt lgkmcnt(0)" ::: "memory"); __builtin_amdgcn_sched_barrier(0);
            f32x16 acc[2] = {};
#pragma unroll
            for (int rb = 0; rb < 2; ++rb) {
                const int row = 32 * rb + r32;
#pragma unroll
                for (int ks = 0; ks < 4; ++ks) {
                    if (rb == 0 && ks >= 2) continue;
                    const bf16x8 pf = *(const bf16x8*)(lds + L_PT + PSWZ(row, (16 * ks + 8 * hi) * 2));
                    acc[rb] = __builtin_amdgcn_mfma_f32_32x32x16_bf16(pf, vf[ks], acc[rb], 0, 0, 0);
                }
            }
#pragma unroll
            for (int kb = 0; kb < 4; ++kb)
#pragma unroll
                for (int sp = 0; sp < 2; ++sp) {
                    bf16x8 cf; { unsigned w0 = cvtpk(C[kb][8 * sp + 0], C[kb][8 * sp + 1]), w1 = cvtpk(C[kb][8 * sp + 2], C[kb][8 * sp + 3]), w2 = cvtpk(C[kb][8 * sp + 4], C[kb][8 * sp + 5]), w3 = cvtpk(C[kb][8 * sp + 6], C[kb][8 * sp + 7]);
                        typedef unsigned u32x4_ __attribute__((ext_vector_type(4))); u32x4_ ww = {w0, w1, w2, w3}; cf = __builtin_bit_cast(bf16x8, ww); }
                    const int base = 32 * kb + 16 * sp;
#pragma unroll
                    for (int rb = 0; rb < 2; ++rb) {
                        const int row = 32 * rb + r32;
                        const bf16x4 q0 = *(const bf16x4*)(lds + L_QP + KSWZ(row, (base + 4 * hi) * 2));
                        const bf16x4 q1 = *(const bf16x4*)(lds + L_QP + KSWZ(row, (base + 8 + 4 * hi) * 2));
                        const bf16x8 qf = {q0[0], q0[1], q0[2], q0[3], q1[0], q1[1], q1[2], q1[3]};
                        acc[rb] = __builtin_amdgcn_mfma_f32_32x32x16_bf16(qf, cf, acc[rb], 0, 0, 0);
                    }
                }
            asm volatile("s_waitcnt lgkmcnt(0)" ::: "memory");
#pragma unroll
            for (int rb = 0; rb < 2; ++rb)
#pragma unroll
                for (int r = 0; r < 16; ++r) {
                    const int row = 32 * rb + crow(r, hi);
                    *(unsigned short*)(lds + L_HT + row * HT_STRIDE + (32 * wid + r32) * 2) = (unsigned short)f2bf(acc[rb][r] * RD[row]);
                }
#pragma unroll
            for (int kb = 0; kb < 4; ++kb) {
#pragma unroll
                for (int r = 0; r < 16; ++r) C[kb][r] *= dec;
                const int kimg = ldsb + L_KW + v_rd_base(lane);
                bf16x8 kf[4];
#pragma unroll
                for (int ks = 0; ks < 4; ++ks) kf[ks] = tr_frag(kimg, kb, ks);
                asm volatile("s_waitcnt lgkmcnt(0)" ::: "memory"); __builtin_amdgcn_sched_barrier(0);
#pragma unroll
                for (int ks = 0; ks < 4; ++ks) C[kb] = __builtin_amdgcn_mfma_f32_32x32x16_bf16(kf[ks], vf[ks], C[kb], 0, 0, 0);
            }
            if (tid < 128) { float s = NV[tid] * dec;
#pragma unroll
                for (int w8 = 0; w8 < 8; ++w8) s += NP[w8 * 128 + tid];
                NV[tid] = s; }
        }
        m_prev = gtot + Mend;
        __syncthreads();
        if (c > 0) {
            float hv[32]; float ss = 0.f;
#pragma unroll
            for (int i = 0; i < 4; ++i) {
                const uint4 w = *(const uint4*)(lds + L_HT + erow * HT_STRIDE + eseg * 64 + 16 * i);
                hv[8 * i + 0] = bf_lo(w.x); hv[8 * i + 1] = bf_hi(w.x); hv[8 * i + 2] = bf_lo(w.y); hv[8 * i + 3] = bf_hi(w.y);
                hv[8 * i + 4] = bf_lo(w.z); hv[8 * i + 5] = bf_hi(w.z); hv[8 * i + 6] = bf_lo(w.w); hv[8 * i + 7] = bf_hi(w.w);
            }
#pragma unroll
            for (int i = 0; i < 32; ++i) ss += hv[i] * hv[i];
            ss += __shfl_xor(ss, 1); ss += __shfl_xor(ss, 2); ss += __shfl_xor(ss, 4);
            const float rstd = rsqrtf(ss * (1.f / 256.f) + EPS);
            const float* nw = (const float*)(lds + L_NW) + eseg * 36;
            bf16_t* op = MIX + (size_t)(chunk_row0(c) + erow) * DM + 1024 + h * 256 + eseg * 32;
#pragma unroll
            for (int i = 0; i < 4; ++i) {
                const unsigned zz[4] = {zo[i].x, zo[i].y, zo[i].z, zo[i].w};
                unsigned ow[4];
#pragma unroll
                for (int q = 0; q < 4; ++q) {
                    const float z0 = bf_lo(zz[q]), z1 = bf_hi(zz[q]);
                    const float o0 = hv[8 * i + 2 * q] * rstd * nw[8 * i + 2 * q] * __builtin_amdgcn_rcpf(1.f + __expf(-z0));
                    const float o1 = hv[8 * i + 2 * q + 1] * rstd * nw[8 * i + 2 * q + 1] * __builtin_amdgcn_rcpf(1.f + __expf(-z1));
                    ow[q] = pk2(o0, o1);
                }
                *(uint4*)(op + 8 * i) = make_uint4(ow[0], ow[1], ow[2], ow[3]);
            }
        }
    }
#undef LOAD_RAW
    __syncthreads();
}
#undef KSWZ
#undef PSWZ
}

namespace rt {
using bf16x8 = __attribute__((ext_vector_type(8))) short;
using f32x16 = __attribute__((ext_vector_type(16))) float;
#define CE(a, b) do { const unsigned x_ = (a), y_ = (b); (a) = x_ > y_ ? x_ : y_; (b) = x_ > y_ ? y_ : x_; } while (0)
#define SORT16_DESC(V) do { CE(V[0], V[1]); CE(V[2], V[3]); CE(V[0], V[2]); CE(V[1], V[3]); CE(V[1], V[2]); CE(V[4], V[5]); CE(V[6], V[7]); CE(V[4], V[6]); CE(V[5], V[7]); CE(V[5], V[6]); CE(V[0], V[4]); CE(V[2], V[6]); CE(V[2], V[4]); CE(V[1], V[5]); CE(V[3], V[7]); CE(V[3], V[5]); CE(V[1], V[2]); CE(V[3], V[4]); CE(V[5], V[6]); CE(V[8], V[9]); CE(V[10], V[11]); CE(V[8], V[10]); CE(V[9], V[11]); CE(V[9], V[10]); CE(V[12], V[13]); CE(V[14], V[15]); CE(V[12], V[14]); CE(V[13], V[15]); CE(V[13], V[14]); CE(V[8], V[12]); CE(V[10], V[14]); CE(V[10], V[12]); CE(V[9], V[13]); CE(V[11], V[15]); CE(V[11], V[13]); CE(V[9], V[10]); CE(V[11], V[12]); CE(V[13], V[14]); CE(V[0], V[8]); CE(V[4], V[12]); CE(V[4], V[8]); CE(V[2], V[10]); CE(V[6], V[14]); CE(V[6], V[10]); CE(V[2], V[4]); CE(V[6], V[8]); CE(V[10], V[12]); CE(V[1], V[9]); CE(V[5], V[13]); CE(V[5], V[9]); CE(V[3], V[11]); CE(V[7], V[15]); CE(V[7], V[11]); CE(V[3], V[5]); CE(V[7], V[9]); CE(V[11], V[13]); CE(V[1], V[2]); CE(V[3], V[4]); CE(V[5], V[6]); CE(V[7], V[8]); CE(V[9], V[10]); CE(V[11], V[12]); CE(V[13], V[14]); } while (0)
#define BMERGE16_DESC(V) do { CE(V[0], V[8]); CE(V[1], V[9]); CE(V[2], V[10]); CE(V[3], V[11]); CE(V[4], V[12]); CE(V[5], V[13]); CE(V[6], V[14]); CE(V[7], V[15]); CE(V[0], V[4]); CE(V[1], V[5]); CE(V[2], V[6]); CE(V[3], V[7]); CE(V[8], V[12]); CE(V[9], V[13]); CE(V[10], V[14]); CE(V[11], V[15]); CE(V[0], V[2]); CE(V[1], V[3]); CE(V[4], V[6]); CE(V[5], V[7]); CE(V[8], V[10]); CE(V[9], V[11]); CE(V[12], V[14]); CE(V[13], V[15]); CE(V[0], V[1]); CE(V[2], V[3]); CE(V[4], V[5]); CE(V[6], V[7]); CE(V[8], V[9]); CE(V[10], V[11]); CE(V[12], V[13]); CE(V[14], V[15]); } while (0)

#define TOP16(A, B) do { _Pragma("unroll") for (int i_ = 0; i_ < 16; ++i_) { const unsigned x_ = A[i_], y_ = B[15 - i_]; A[i_] = x_ > y_ ? x_ : y_; } BMERGE16_DESC(A); } while (0)
__device__ __forceinline__ unsigned ord_key(float f) { const unsigned u = __float_as_uint(f); return u ^ (((unsigned)((int)u >> 31)) | 0x80000000u); }
__device__ __forceinline__ float ord_val(unsigned k) { return __uint_as_float((k & 0x80000000u) ? (k ^ 0x80000000u) : ~k); }
__device__ __forceinline__ int crow(int r, int hi) { return (r & 3) + 8 * (r >> 2) + 4 * hi; }

__device__ __forceinline__ void route_item(int tb, int h, const bf16_t* QP, const bf16_t* SKB, const float* SSQ, int* IDX, float* GATE, int* scr, int lane_in) {
    int lane = lane_in; asm volatile("" : "+v"(lane));
    const int tok = lane & 31, hi = lane >> 5;
    const int row = tb * 32 + tok;
    float rstd;
    { const float4* sp = (const float4*)(SSQ + (size_t)row * 32); float s = 0.f;
#pragma unroll
      for (int i = 0; i < 8; ++i) { const float4 v = sp[i]; s += (v.x + v.y) + (v.z + v.w); }
      rstd = rsqrtf(s * (1.f / DM) + EPS); }
    unsigned top[2][16];
    bf16x8 qf[8], af[2][8];
    unsigned T[16];
#define RT_LOADQ(p_) do { const bf16_t* qp_ = QP + (size_t)row * DM + h * 256 + (p_) * 128 + hi * 8; \
        _Pragma("unroll") for (int ks = 0; ks < 8; ++ks) qf[ks] = *reinterpret_cast<const bf16x8*>(qp_ + ks * 16); } while (0)
#define RT_LOADK(b_, i_) do { const bf16_t* kp_ = SKB + ((size_t)((h * 2 + ((i_) >> 2)) * 128 + ((i_) & 3) * 32 + tok)) * 128 + hi * 8; \
        _Pragma("unroll") for (int ks = 0; ks < 8; ++ks) af[b_][ks] = *reinterpret_cast<const bf16x8*>(kp_ + ks * 16); } while (0)
    RT_LOADQ(0); RT_LOADK(0, 0);
#pragma unroll
    for (int i = 0; i < 8; ++i) {
        const int p = i >> 2, kb = i & 3;
        if (i + 1 < 8) RT_LOADK((i + 1) & 1, i + 1);
        f32x16 acc = {};
#pragma unroll
        for (int ks = 0; ks < 8; ++ks) acc = __builtin_amdgcn_mfma_f32_32x32x16_bf16(af[i & 1][ks], qf[ks], acc, 0, 0, 0);
        unsigned K[16];
#pragma unroll
        for (int r = 0; r < 16; ++r) { const int low = 127 - (32 * kb + (r & 3) + 8 * (r >> 2)) - 4 * hi; K[r] = (ord_key(acc[r]) & ~127u) | (unsigned)low; }
        if (i == 3) RT_LOADQ(1);
        SORT16_DESC(K);
        if (kb == 0) {
#pragma unroll
            for (int j = 0; j < 16; ++j) T[j] = K[j];
        } else { TOP16(T, K); }
        if (kb == 3) {
            unsigned O[16];
#pragma unroll
            for (int j = 0; j < 16; ++j) { auto rr = __builtin_amdgcn_permlane32_swap(T[j], T[j], false, false); O[j] = hi ? rr[0] : rr[1]; }
            TOP16(T, O);
#pragma unroll
            for (int j = 0; j < 16; ++j) top[p][j] = T[j];
        }
        __builtin_amdgcn_sched_barrier(0);
    }
#undef RT_LOADQ
#undef RT_LOADK
    float s1[16], s2[16];
#pragma unroll
    for (int i = 0; i < 16; ++i) {
        s1[i] = ord_val(top[0][i] & ~127u) * rstd; s2[i] = ord_val(top[1][i] & ~127u) * rstd;
        scr[i * 64 + lane] = 127 - (int)(top[0][i] & 127u); scr[(16 + i) * 64 + lane] = 127 - (int)(top[1][i] & 127u);
    }
#define CKEY(a_, b_) ((ord_key(s1[a_] + s2[b_]) & ~255u) | (unsigned)(255 - (16 * (a_) + (b_))))
    unsigned A[16], B[16], Cg[16];
#pragma unroll
    for (int b_ = 0; b_ < 16; ++b_) A[b_] = CKEY(0, b_);
#pragma unroll
    for (int b_ = 0; b_ < 8; ++b_) { B[b_] = CKEY(1, b_); B[8 + b_] = CKEY(15 - b_, 0); }
    BMERGE16_DESC(B);
    Cg[0] = CKEY(2, 0); Cg[1] = CKEY(2, 1); Cg[2] = CKEY(2, 2); Cg[3] = CKEY(2, 3); Cg[4] = CKEY(2, 4);
    Cg[5] = CKEY(3, 0); Cg[6] = CKEY(3, 1); Cg[7] = CKEY(3, 2); Cg[8] = CKEY(3, 3);
    Cg[9] = CKEY(4, 0); Cg[10] = CKEY(4, 1); Cg[11] = CKEY(4, 2);
    Cg[12] = CKEY(5, 0); Cg[13] = CKEY(5, 1); Cg[14] = CKEY(6, 0); Cg[15] = CKEY(6, 1);
    SORT16_DESC(Cg);
    { const unsigned d0 = CKEY(7, 0), d1 = CKEY(7, 1); Cg[15] = Cg[15] > d0 ? Cg[15] : d0; Cg[14] = Cg[14] > d1 ? Cg[14] : d1; BMERGE16_DESC(Cg); }
    TOP16(A, B); TOP16(A, Cg);
#undef CKEY
    asm volatile("s_waitcnt lgkmcnt(0)" ::: "memory");
    float e[16]; float z = 0.f; const float mx = ord_val(A[0] & ~255u);
#pragma unroll
    for (int j = 0; j < 16; ++j) { e[j] = __expf(ord_val(A[j] & ~255u) - mx); z += e[j]; }
    const float rz = 1.f / z;
    int* ip = IDX + (size_t)row * 128 + h * 16 + hi * 8; float* gp = GATE + (size_t)row * 128 + h * 16 + hi * 8;
    int oi[8] = {0, 0, 0, 0, 0, 0, 0, 0}; float og[8] = {0.f, 0.f, 0.f, 0.f, 0.f, 0.f, 0.f, 0.f};
#pragma unroll
    for (int j = 0; j < 16; ++j) {
        const int flat = 255 - (int)(A[j] & 255u), a_ = flat >> 4, b_ = flat & 15;
        const int ex = scr[a_ * 64 + lane] * 128 + scr[(16 + b_) * 64 + lane];
        if (j < 8) { if (!hi) { oi[j] = ex; og[j] = e[j] * rz; } } else { if (hi) { oi[j - 8] = ex; og[j - 8] = e[j] * rz; } }
    }
    *(int4*)(ip) = make_int4(oi[0], oi[1], oi[2], oi[3]); *(int4*)(ip + 4) = make_int4(oi[4], oi[5], oi[6], oi[7]);
    *(float4*)(gp) = make_float4(og[0], og[1], og[2], og[3]); *(float4*)(gp + 4) = make_float4(og[4], og[5], og[6], og[7]);
    asm volatile("s_waitcnt lgkmcnt(0)" ::: "memory");
}
#undef CE
#undef TOP16
}

__device__ __forceinline__ void phase_route(const Args& a, unsigned char* lds, int bid, int nb) {
    const int tid = opaque_tid(), wave = __builtin_amdgcn_readfirstlane(tid >> 6), lane = tid & 63;
    const bf16_t* QP = (const bf16_t*)(a.ws + WS_MIX); const bf16_t* SKB = (const bf16_t*)(a.ws + WS_SKB); const float* SSQ = (const float*)(a.ws + WS_SSQ);
    int* IDX = (int*)(a.ws + WS_IDX); float* GATE = (float*)(a.ws + WS_GATE);
    int* scr = (int*)lds + wave * 2048;
    {
        const bf16_t* X1W = (const bf16_t*)(a.ws + WS_HN); signed char* X1Q = (signed char*)(a.ws + WS_X1Q); float* XSC = (float*)(a.ws + WS_XSC);
        for (int row = bid * NWAVES + wave; row < TREAL; row += nb * NWAVES) {
            uint4 xr[4]; float am = 0.f;
#pragma unroll
            for (int j = 0; j < 4; ++j) { xr[j] = *(const uint4*)(X1W + (size_t)row * DM + 8 * lane + 512 * j);
                am = fmaxf(am, fmaxf(fmaxf(fmaxf(fabsf(bf_lo(xr[j].x)), fabsf(bf_hi(xr[j].x))), fmaxf(fabsf(bf_lo(xr[j].y)), fabsf(bf_hi(xr[j].y)))), fmaxf(fmaxf(fabsf(bf_lo(xr[j].z)), fabsf(bf_hi(xr[j].z))), fmaxf(fabsf(bf_lo(xr[j].w)), fabsf(bf_hi(xr[j].w)))))); }
            am = wave_max(am);
            const float sc = am > 0.f ? 127.f / am : 0.f;
#pragma unroll
            for (int j = 0; j < 4; ++j) {
                const unsigned ww[4] = {xr[j].x, xr[j].y, xr[j].z, xr[j].w}; unsigned o[2] = {0u, 0u};
#pragma unroll
                for (int q = 0; q < 4; ++q) { const int q0 = (int)rintf(bf_lo(ww[q]) * sc), q1 = (int)rintf(bf_hi(ww[q]) * sc); o[q >> 1] |= ((unsigned)(q0 & 255) | ((unsigned)(q1 & 255) << 8)) << (16 * (q & 1)); }
                *(uint2*)(X1Q + (size_t)row * DM + 8 * lane + 512 * j) = make_uint2(o[0], o[1]);
            }
            if (lane == 0) XSC[row] = am * (1.f / 127.f);
        }
    }
    for (int item = bid * NWAVES + wave; item < (TREAL / 32) * 8; item += nb * NWAVES) rt::route_item(item >> 3, item & 7, QP, SKB, SSQ, IDX, GATE, scr, lane);
}

constexpr int CW_QPV = 8192, CW_QPU = 8192 + 8 * 64;
constexpr int PX_ITEMS = TREAL / 64;
constexpr size_t WS_W = WS_Z + 4 * MiB, WS_PART = WS_Z + 32 * MiB, WS_Y = WS_Z + 160 * MiB;


template <int CTRL, int RMASK> __device__ __forceinline__ float dppf(float old, float v) { return __builtin_bit_cast(float, __builtin_amdgcn_update_dpp(__builtin_bit_cast(int, old), __builtin_bit_cast(int, v), CTRL, RMASK, 0xf, false)); }
template <int CTRL> __device__ __forceinline__ int dppi(int v) { return __builtin_amdgcn_update_dpp(0, v, CTRL, 0xf, 0xf, false); }
namespace pu2 {
typedef float f32x2v __attribute__((ext_vector_type(2)));
typedef unsigned u32x4v __attribute__((ext_vector_type(4)));
#define SBP() __builtin_amdgcn_sched_barrier(0)
#define PU_CHUNK_LD(dst, r_, q_) dst = *(const u32x4v*)(sidx + ((r_) - r0) * 512 + g128 + (q_) * 16)
#define PU_ROW_LD(buf, e_) buf = __builtin_amdgcn_raw_buffer_load_b128(U, (int)(e_) * 256 + c16, 0, 0)
#define PU_CONSUME(buf, I_) do { int s_ = __builtin_amdgcn_sdot4((int)buf[0], hq0, 0, false); s_ = __builtin_amdgcn_sdot4((int)buf[1], hq1, s_, false); \
    s_ = __builtin_amdgcn_sdot4((int)buf[2], hq2, s_, false); s_ = __builtin_amdgcn_sdot4((int)buf[3], hq3, s_, false); \
    s_ += dppi<0x128>(s_); s_ += dppi<0x124>(s_); s_ += dppi<0x122>(s_); s_ += dppi<0x121>(s_); \
    if ((I_) < 16) keep0 = (c == ((I_) & 15)) ? s_ : keep0; else keep1 = (c == ((I_) & 15)) ? s_ : keep1; } while (0)
#define PU_TOKEN_BODY(row_, nrow_, has_next_) do { \
    PU_CHUNK_LD(C7, row_, 7); \
    SBP(); PU_CONSUME(B0, 0); \
    PU_ROW_LD(B0, C2.x); \
    SBP(); PU_CONSUME(B1, 1); \
    PU_ROW_LD(B1, C2.y); \
    SBP(); PU_CONSUME(B2, 2); \
    PU_ROW_LD(B2, C2.z); \
    SBP(); PU_CONSUME(B3, 3); \
    PU_ROW_LD(B3, C2.w); \
    if (has_next_) PU_CHUNK_LD(C0, nrow_, 0); \
    SBP(); PU_CONSUME(B4, 4); \
    PU_ROW_LD(B4, C3.x); \
    SBP(); PU_CONSUME(B5, 5); \
    PU_ROW_LD(B5, C3.y); \
    SBP(); PU_CONSUME(B6, 6); \
    PU_ROW_LD(B6, C3.z); \
    SBP(); PU_CONSUME(B7, 7); \
    PU_ROW_LD(B7, C3.w); \
    if (has_next_) PU_CHUNK_LD(C1, nrow_, 1); \
    SBP(); PU_CONSUME(B0, 8); \
    PU_ROW_LD(B0, C4.x); \
    SBP(); PU_CONSUME(B1, 9); \
    PU_ROW_LD(B1, C4.y); \
    SBP(); PU_CONSUME(B2, 10); \
    PU_ROW_LD(B2, C4.z); \
    SBP(); PU_CONSUME(B3, 11); \
    PU_ROW_LD(B3, C4.w); \
    if (has_next_) PU_CHUNK_LD(C2, nrow_, 2); \
    SBP(); PU_CONSUME(B4, 12); \
    PU_ROW_LD(B4, C5.x); \
    SBP(); PU_CONSUME(B5, 13); \
    PU_ROW_LD(B5, C5.y); \
    SBP(); PU_CONSUME(B6, 14); \
    PU_ROW_LD(B6, C5.z); \
    SBP(); PU_CONSUME(B7, 15); \
    PU_ROW_LD(B7, C5.w); \
    if (has_next_) PU_CHUNK_LD(C3, nrow_, 3); \
    SBP(); PU_CONSUME(B0, 16); \
    PU_ROW_LD(B0, C6.x); \
    SBP(); PU_CONSUME(B1, 17); \
    PU_ROW_LD(B1, C6.y); \
    SBP(); PU_CONSUME(B2, 18); \
    PU_ROW_LD(B2, C6.z); \
    SBP(); PU_CONSUME(B3, 19); \
    PU_ROW_LD(B3, C6.w); \
    if (has_next_) PU_CHUNK_LD(C4, nrow_, 4); \
    SBP(); PU_CONSUME(B4, 20); \
    PU_ROW_LD(B4, C7.x); \
    SBP(); PU_CONSUME(B5, 21); \
    PU_ROW_LD(B5, C7.y); \
    SBP(); PU_CONSUME(B6, 22); \
    PU_ROW_LD(B6, C7.z); \
    SBP(); PU_CONSUME(B7, 23); \
    PU_ROW_LD(B7, C7.w); \
    if (has_next_) PU_CHUNK_LD(C5, nrow_, 5); \
    SBP(); PU_CONSUME(B0, 24); \
    if (has_next_) PU_ROW_LD(B0, C0.x); \
    SBP(); PU_CONSUME(B1, 25); \
    if (has_next_) PU_ROW_LD(B1, C0.y); \
    SBP(); PU_CONSUME(B2, 26); \
    if (has_next_) PU_ROW_LD(B2, C0.z); \
    SBP(); PU_CONSUME(B3, 27); \
    if (has_next_) PU_ROW_LD(B3, C0.w); \
    if (has_next_) PU_CHUNK_LD(C6, nrow_, 6); \
    SBP(); PU_CONSUME(B4, 28); \
    if (has_next_) PU_ROW_LD(B4, C1.x); \
    SBP(); PU_CONSUME(B5, 29); \
    if (has_next_) PU_ROW_LD(B5, C1.y); \
    SBP(); PU_CONSUME(B6, 30); \
    if (has_next_) PU_ROW_LD(B6, C1.z); \
    SBP(); PU_CONSUME(B7, 31); \
    if (has_next_) PU_ROW_LD(B7, C1.w); \
    } while (0)
#undef SBP
}

__device__ __forceinline__ void phase_pu(const Args& a, unsigned char* lds, unsigned* ctl, int xcc) {
    using namespace pu2;
#define SBP() __builtin_amdgcn_sched_barrier(0)
    const int tid = opaque_tid(), wave = __builtin_amdgcn_readfirstlane(tid >> 6), lane = tid & 63;
    volatile LAS unsigned* slot = (volatile LAS unsigned*)((LAS unsigned char*)lds + LDS_MISC) + 2;
    const signed char* X1Q = (const signed char*)(a.ws + WS_X1Q); float* PART = (float*)(a.ws + WS_PART);
    unsigned char* sidx = lds + wave * 4096; unsigned char* sxq = lds + 32768 + wave * 2048;
    const __amdgpu_buffer_rsrc_t RI = __builtin_amdgcn_make_buffer_rsrc((void*)(a.ws + WS_IDX), (short)0, TREAL * 512, 0x00020000);
    for (int ss = 0; ss < 8; ++ss) {
        const int s = (xcc + ss) & 7;
        const __amdgpu_buffer_rsrc_t U = __builtin_amdgcn_make_buffer_rsrc((void*)(a.ws + WS_U + (size_t)s * (16384 * 256)), (short)0, 16384 * 256, 0x00020000);
        for (;;) {
            const int item = next_item(ctl + CW_QPU + 64 * s, slot);
            if (item >= PX_ITEMS) break;
            int ln = lane; asm volatile("" : "+v"(ln));
            const int g = ln >> 4, c = ln & 15, c16 = c * 16, g128 = g * 128;
            const int r0 = item * 64 + wave * 8;
            u32x4v C0, C1, C2, C3, C4, C5, C6, C7, B0, B1, B2, B3, B4, B5, B6, B7;
            {
                const u32x4v* gi = (const u32x4v*)(a.ws + WS_IDX + (size_t)r0 * 512) + ln;
                const u32x4v i0 = gi[0], i1 = gi[64], i2 = gi[128], i3 = gi[192];
                const u32x4v xa = *(const u32x4v*)(X1Q + (size_t)(r0 + g) * DM + 256 * s + 16 * c), xb = *(const u32x4v*)(X1Q + (size_t)(r0 + 4 + g) * DM + 256 * s + 16 * c);
                u32x4v* si = (u32x4v*)sidx + ln; u32x4v* sx = (u32x4v*)sxq + ln;
                si[0] = i0; si[64] = i1; si[128] = i2; si[192] = i3; sx[0] = xa; sx[64] = xb;
                asm volatile("s_waitcnt lgkmcnt(0)" ::: "memory");
            }
            PU_CHUNK_LD(C0, r0, 0); PU_CHUNK_LD(C1, r0, 1); PU_CHUNK_LD(C2, r0, 2); PU_CHUNK_LD(C3, r0, 3); PU_CHUNK_LD(C4, r0, 4); PU_CHUNK_LD(C5, r0, 5); PU_CHUNK_LD(C6, r0, 6);
            uint4 nxq = ((const uint4*)sxq)[c];
            PU_ROW_LD(B0, C0.x); PU_ROW_LD(B1, C0.y); PU_ROW_LD(B2, C0.z); PU_ROW_LD(B3, C0.w); PU_ROW_LD(B4, C1.x); PU_ROW_LD(B5, C1.y); PU_ROW_LD(B6, C1.z); PU_ROW_LD(B7, C1.w);
#pragma unroll 1
            for (int t = 0; t < 8; ++t) {
                const int row = r0 + t, nrow = row + 1; const bool has_next = t < 7;
                const int hq0 = (int)nxq.x, hq1 = (int)nxq.y, hq2 = (int)nxq.z, hq3 = (int)nxq.w;
                if (has_next) nxq = ((const uint4*)sxq)[(t + 1) * 16 + c];
                int keep0 = 0, keep1 = 0;
                PU_TOKEN_BODY(row, nrow, has_next);
                float* pp = PART + (size_t)row * 1024 + s * 128 + 32 * g + c;
                pp[0] = (float)keep0; pp[16] = (float)keep1;
            }
        }
    }
#undef SBP
}
__device__ __forceinline__ void phase_pc(const Args& a, int bid, int nb) {
    const int tid = opaque_tid(), wave = __builtin_amdgcn_readfirstlane(tid >> 6), lane = tid & 63;
    const float* SSQ = (const float*)(a.ws + WS_SSQ); const int* IDX = (const int*)(a.ws + WS_IDX); const float* GATE = (const float*)(a.ws + WS_GATE);
    const float* ISC = (const float*)(a.ws + WS_ISC); const float* PART = (const float*)(a.ws + WS_PART); unsigned short* W16 = (unsigned short*)(a.ws + WS_W); float* WSC = (float*)(a.ws + WS_W + 12 * MiB);
    for (int row = bid * NWAVES + wave; row < TREAL; row += nb * NWAVES) {
        float ssv = lane < 32 ? SSQ[(size_t)row * 32 + lane] : 0.f; ssv = wave_sum(ssv);
        const float rstd = rsqrtf(ssv * (1.f / DM) + EPS);
        const float xsc = ((const float*)(a.ws + WS_XSC))[row];
        float wv[2];
#pragma unroll
        for (int k = 0; k < 2; ++k) {
            const int p = 64 * k + lane; float d = 0.f;
#pragma unroll
            for (int s = 0; s < 8; ++s) d += PART[(size_t)row * 1024 + s * 128 + p];
            const int e = IDX[(size_t)row * 128 + p];
            const float pre = d * rstd * ISC[e] * xsc;
            wv[k] = GATE[(size_t)row * 128 + p] * ISC[16384 + e] * (0.5f * pre * (1.f + erff(pre * 0.7071067811865476f)));
        }
        const float wmax = wave_max(fmaxf(fabsf(wv[0]), fabsf(wv[1])));
        const float wsc = wmax > 0.f ? 240.f / wmax : 0.f;
#pragma unroll
        for (int k = 0; k < 2; ++k) {
            const float ws = wv[k] * wsc;
            const int hi = __builtin_amdgcn_cvt_pk_fp8_f32(ws, 0.f, 0, false) & 255;
            const int lo = __builtin_amdgcn_cvt_pk_fp8_f32(ws - __builtin_amdgcn_cvt_f32_fp8(hi, 0), 0.f, 0, false) & 255;
            W16[(size_t)row * 128 + 64 * k + lane] = (unsigned short)(hi | (lo << 8));
        }
        if (lane == 0) WSC[row] = wmax * (1.f / 240.f);
    }
}
namespace pv2 {
typedef float f32x2v __attribute__((ext_vector_type(2)));
typedef unsigned u32x4v __attribute__((ext_vector_type(4))); typedef float f32x4v __attribute__((ext_vector_type(4)));
typedef unsigned u32x2v __attribute__((ext_vector_type(2)));
struct Chunk { u32x4v i; u32x2v w; };
#define SBP() __builtin_amdgcn_sched_barrier(0)
#define PV_CHUNK_LD(dst, r_, q_) do { dst.i = *(const u32x4v*)(sidx + ((r_) - r0) * 512 + g128 + (q_) * 16); dst.w = *(const u32x2v*)(swt + ((r_) - r0) * 256 + g64 + (q_) * 8); } while (0)
#define PV_ROW_LD(buf, e_) buf = __builtin_amdgcn_raw_buffer_load_b128(V, (int)(e_) * 256 + c16, 0, 0)
#define PV_CONSUME(buf, ww_, S0_, S1_) do { const u32x2v b2_ = {__builtin_amdgcn_perm(0u, (ww_), (S0_)), __builtin_amdgcn_perm(0u, (ww_), (S1_))}; const long bb_ = __builtin_bit_cast(long, b2_); \
    const u32x2v a0_ = {buf[0], buf[1]}, a1_ = {buf[2], buf[3]}; \
    acc_lo = __builtin_amdgcn_mfma_f32_16x16x32_fp8_fp8(__builtin_bit_cast(long, a0_), bb_, acc_lo, 0, 0, 0); acc_hi = __builtin_amdgcn_mfma_f32_16x16x32_fp8_fp8(__builtin_bit_cast(long, a1_), bb_, acc_hi, 0, 0, 0); } while (0)
#define PV_TOKEN_BODY(row_, nrow_, has_next_) do { \
    PV_CHUNK_LD(C7, row_, 7); \
    SBP(); PV_CONSUME(B0, C0.w[0], sele0, sele1); \
    PV_ROW_LD(B0, C2.i.x); \
    SBP(); PV_CONSUME(B1, C0.w[0], selo0, selo1); \
    PV_ROW_LD(B1, C2.i.y); \
    SBP(); PV_CONSUME(B2, C0.w[1], sele0, sele1); \
    PV_ROW_LD(B2, C2.i.z); \
    SBP(); PV_CONSUME(B3, C0.w[1], selo0, selo1); \
    PV_ROW_LD(B3, C2.i.w); \
    if (has_next_) PV_CHUNK_LD(C0, nrow_, 0); \
    SBP(); PV_CONSUME(B4, C1.w[0], sele0, sele1); \
    PV_ROW_LD(B4, C3.i.x); \
    SBP(); PV_CONSUME(B5, C1.w[0], selo0, selo1); \
    PV_ROW_LD(B5, C3.i.y); \
    SBP(); PV_CONSUME(B6, C1.w[1], sele0, sele1); \
    PV_ROW_LD(B6, C3.i.z); \
    SBP(); PV_CONSUME(B7, C1.w[1], selo0, selo1); \
    PV_ROW_LD(B7, C3.i.w); \
    if (has_next_) PV_CHUNK_LD(C1, nrow_, 1); \
    SBP(); PV_CONSUME(B0, C2.w[0], sele0, sele1); \
    PV_ROW_LD(B0, C4.i.x); \
    SBP(); PV_CONSUME(B1, C2.w[0], selo0, selo1); \
    PV_ROW_LD(B1, C4.i.y); \
    SBP(); PV_CONSUME(B2, C2.w[1], sele0, sele1); \
    PV_ROW_LD(B2, C4.i.z); \
    SBP(); PV_CONSUME(B3, C2.w[1], selo0, selo1); \
    PV_ROW_LD(B3, C4.i.w); \
    if (has_next_) PV_CHUNK_LD(C2, nrow_, 2); \
    SBP(); PV_CONSUME(B4, C3.w[0], sele0, sele1); \
    PV_ROW_LD(B4, C5.i.x); \
    SBP(); PV_CONSUME(B5, C3.w[0], selo0, selo1); \
    PV_ROW_LD(B5, C5.i.y); \
    SBP(); PV_CONSUME(B6, C3.w[1], sele0, sele1); \
    PV_ROW_LD(B6, C5.i.z); \
    SBP(); PV_CONSUME(B7, C3.w[1], selo0, selo1); \
    PV_ROW_LD(B7, C5.i.w); \
    if (has_next_) PV_CHUNK_LD(C3, nrow_, 3); \
    SBP(); PV_CONSUME(B0, C4.w[0], sele0, sele1); \
    PV_ROW_LD(B0, C6.i.x); \
    SBP(); PV_CONSUME(B1, C4.w[0], selo0, selo1); \
    PV_ROW_LD(B1, C6.i.y); \
    SBP(); PV_CONSUME(B2, C4.w[1], sele0, sele1); \
    PV_ROW_LD(B2, C6.i.z); \
    SBP(); PV_CONSUME(B3, C4.w[1], selo0, selo1); \
    PV_ROW_LD(B3, C6.i.w); \
    if (has_next_) PV_CHUNK_LD(C4, nrow_, 4); \
    SBP(); PV_CONSUME(B4, C5.w[0], sele0, sele1); \
    PV_ROW_LD(B4, C7.i.x); \
    SBP(); PV_CONSUME(B5, C5.w[0], selo0, selo1); \
    PV_ROW_LD(B5, C7.i.y); \
    SBP(); PV_CONSUME(B6, C5.w[1], sele0, sele1); \
    PV_ROW_LD(B6, C7.i.z); \
    SBP(); PV_CONSUME(B7, C5.w[1], selo0, selo1); \
    PV_ROW_LD(B7, C7.i.w); \
    if (has_next_) PV_CHUNK_LD(C5, nrow_, 5); \
    SBP(); PV_CONSUME(B0, C6.w[0], sele0, sele1); \
    if (has_next_) PV_ROW_LD(B0, C0.i.x); \
    SBP(); PV_CONSUME(B1, C6.w[0], selo0, selo1); \
    if (has_next_) PV_ROW_LD(B1, C0.i.y); \
    SBP(); PV_CONSUME(B2, C6.w[1], sele0, sele1); \
    if (has_next_) PV_ROW_LD(B2, C0.i.z); \
    SBP(); PV_CONSUME(B3, C6.w[1], selo0, selo1); \
    if (has_next_) PV_ROW_LD(B3, C0.i.w); \
    if (has_next_) PV_CHUNK_LD(C6, nrow_, 6); \
    SBP(); PV_CONSUME(B4, C7.w[0], sele0, sele1); \
    if (has_next_) PV_ROW_LD(B4, C1.i.x); \
    SBP(); PV_CONSUME(B5, C7.w[0], selo0, selo1); \
    if (has_next_) PV_ROW_LD(B5, C1.i.y); \
    SBP(); PV_CONSUME(B6, C7.w[1], sele0, sele1); \
    if (has_next_) PV_ROW_LD(B6, C1.i.z); \
    SBP(); PV_CONSUME(B7, C7.w[1], selo0, selo1); \
    if (has_next_) PV_ROW_LD(B7, C1.i.w); \
    } while (0)
#undef SBP
}

__device__ __forceinline__ void phase_pv(const Args& a, unsigned char* lds, unsigned* ctl, int xcc) {
    using namespace pv2;
#define SBP() __builtin_amdgcn_sched_barrier(0)
    const int tid = opaque_tid(), wave = __builtin_amdgcn_readfirstlane(tid >> 6), lane = tid & 63;
    volatile LAS unsigned* slot = (volatile LAS unsigned*)((LAS unsigned char*)lds + LDS_MISC) + 2;
    bf16_t* Y = (bf16_t*)(a.ws + WS_Y); const float* WSC = (const float*)(a.ws + WS_W + 12 * MiB);
    const __amdgpu_buffer_rsrc_t RI = __builtin_amdgcn_make_buffer_rsrc((void*)(a.ws + WS_IDX), (short)0, TREAL * 512, 0x00020000);
    const __amdgpu_buffer_rsrc_t RW = __builtin_amdgcn_make_buffer_rsrc((void*)(a.ws + WS_W), (short)0, TREAL * 256, 0x00020000);
    float* ybuf = (float*)lds + wave * 256;
    unsigned char* sidx = lds + 8192 + wave * 4096; unsigned char* swt = lds + 8192 + 32768 + wave * 2048;
    for (int ss = 0; ss < 8; ++ss) {
        const int s = (xcc + ss) & 7;
        const __amdgpu_buffer_rsrc_t V = __builtin_amdgcn_make_buffer_rsrc((void*)(a.ws + WS_V + (size_t)s * (16384 * 256)), (short)0, 16384 * 256, 0x00020000);
        for (;;) {
            const int item = next_item(ctl + CW_QPV + 64 * s, slot);
            if (item >= PX_ITEMS) break;
            int ln = lane; asm volatile("" : "+v"(ln));
            const int g = ln >> 4, n = ln & 15, c16 = n * 16, g128 = g * 128, g64 = g * 64;
            const int r0 = item * 64 + wave * 8;
            unsigned sele0, sele1, selo0, selo1;
            { const unsigned sh = 8u * (unsigned)(n & 3), keep = ~(255u << sh), se = (unsigned)(n >> 3), so = 2u + se;
              const unsigned ve = (0x0c0c0c0cu & keep) | (se << sh), vo = (0x0c0c0c0cu & keep) | (so << sh);
              const bool d0 = (n & 4) == 0;
              sele0 = d0 ? ve : 0x0c0c0c0cu; sele1 = d0 ? 0x0c0c0c0cu : ve; selo0 = d0 ? vo : 0x0c0c0c0cu; selo1 = d0 ? 0x0c0c0c0cu : vo; }
            Chunk C0, C1, C2, C3, C4, C5, C6, C7; u32x4v B0, B1, B2, B3, B4, B5, B6, B7;
            const float wscv = WSC[r0 + (ln & 7)];
            {
                const u32x4v* gi = (const u32x4v*)(a.ws + WS_IDX + (size_t)r0 * 512) + ln; const u32x4v* gw = (const u32x4v*)(a.ws + WS_W + (size_t)r0 * 256) + ln;
                const u32x4v i0 = gi[0], i1 = gi[64], i2 = gi[128], i3 = gi[192], w0 = gw[0], w1 = gw[64];
                u32x4v* si = (u32x4v*)sidx + ln; u32x4v* sw = (u32x4v*)swt + ln;
                si[0] = i0; si[64] = i1; si[128] = i2; si[192] = i3; sw[0] = w0; sw[64] = w1;
                asm volatile("s_waitcnt lgkmcnt(0)" ::: "memory");
            }
            PV_CHUNK_LD(C0, r0, 0); PV_CHUNK_LD(C1, r0, 1); PV_CHUNK_LD(C2, r0, 2); PV_CHUNK_LD(C3, r0, 3); PV_CHUNK_LD(C4, r0, 4); PV_CHUNK_LD(C5, r0, 5); PV_CHUNK_LD(C6, r0, 6);
            PV_ROW_LD(B0, C0.i.x); PV_ROW_LD(B1, C0.i.y); PV_ROW_LD(B2, C0.i.z); PV_ROW_LD(B3, C0.i.w); PV_ROW_LD(B4, C1.i.x); PV_ROW_LD(B5, C1.i.y); PV_ROW_LD(B6, C1.i.z); PV_ROW_LD(B7, C1.i.w);
#pragma unroll 1
            for (int t = 0; t < 8; ++t) {
                const int row = r0 + t, nrow = row + 1; const bool has_next = t < 7;
                f32x4v acc_lo = {0.f, 0.f, 0.f, 0.f}, acc_hi = {0.f, 0.f, 0.f, 0.f};
                PV_TOKEN_BODY(row, nrow, has_next);
                const float wsc = __uint_as_float(__builtin_amdgcn_readlane(__float_as_uint(wscv), t));
#pragma unroll
                for (int i = 0; i < 4; ++i) {
                    const float lo_ = acc_lo[i] + __uint_as_float(__builtin_amdgcn_update_dpp(0, __float_as_uint(acc_lo[i]), 0x128, 0xf, 0xf, false));
                    const float hi_ = acc_hi[i] + __uint_as_float(__builtin_amdgcn_update_dpp(0, __float_as_uint(acc_hi[i]), 0x128, 0xf, 0xf, false));
                    ybuf[16 * (4 * g + i) + n] = (n < 8 ? lo_ : hi_) * wsc;
                }
                asm volatile("s_waitcnt lgkmcnt(0)" ::: "memory");
                {
                    const float4 yv = ((const float4*)ybuf)[ln];
                    *(uint2*)(Y + (size_t)row * DM + 256 * s + 4 * ln) = make_uint2(pk2(yv.x, yv.y), pk2(yv.z, yv.w));
                }
                asm volatile("s_waitcnt lgkmcnt(0)" ::: "memory");
            }
        }
    }
#undef SBP
}
__device__ __forceinline__ void phase_pn(const Args& a, int bid, int nb) {
    const int tid = opaque_tid(), wave = __builtin_amdgcn_readfirstlane(tid >> 6), lane = tid & 63;
    const bf16_t* Y = (const bf16_t*)(a.ws + WS_Y); const bf16_t* X1 = (const bf16_t*)(a.ws + WS_HN);
    for (int row = bid * NWAVES + wave; row < TREAL; row += nb * NWAVES) {
        f32x4* p = (f32x4*)(a.out + (size_t)row * DM) + lane;
        const uint2* yp = (const uint2*)(Y + (size_t)row * DM) + lane; const uint2* xp = (const uint2*)(X1 + (size_t)row * DM) + lane;
        f32x4 v[8]; float ss = 0.f;
#pragma unroll
        for (int j = 0; j < 8; ++j) { const uint2 yy = yp[64 * j], xx = xp[64 * j];
            v[j][0] = bf_lo(xx.x) + bf_lo(yy.x); v[j][1] = bf_hi(xx.x) + bf_hi(yy.x); v[j][2] = bf_lo(xx.y) + bf_lo(yy.y); v[j][3] = bf_hi(xx.y) + bf_hi(yy.y);
            ss += (v[j][0] * v[j][0] + v[j][1] * v[j][1]) + (v[j][2] * v[j][2] + v[j][3] * v[j][3]); }
        const float r = rsqrtf(wave_sum(ss) * (1.f / DM) + EPS);
        const f32x4* wp = (const f32x4*)a.nfinal + lane;
#pragma unroll
        for (int j = 0; j < 8; ++j) p[64 * j] = v[j] * r * wp[64 * j];
    }
}

__device__ __forceinline__ void phase_mix(const Args& a, unsigned char* lds, unsigned* ctr) {
    const bf16_t* Z = (const bf16_t*)(a.ws + WS_Z); bf16_t* MIX = (bf16_t*)(a.ws + WS_MIX);
    volatile LAS unsigned* slot = (volatile LAS unsigned*)((LAS unsigned char*)lds + LDS_MISC) + 2;
    for (;;) {
        const int item = next_item(ctr, slot);
        if (item >= 64 + 2048) break;
        if (item < 64) mls::mlstm_item(item >> 2, item & 3, a, (char*)lds);
        else { const int k = item - 64, qb = 15 - (k >> 7), bh = k & 127; const float lam = attn_lambda(a); att::attn_unit(bh >> 3, bh & 7, qb, Z, MIX, lam, a.subln, (char*)lds); }
    }
}

__global__ void __launch_bounds__(NTHREADS, 2) mega(Args a) {
    extern __shared__ __attribute__((aligned(16))) unsigned char lds[];
    cg::grid_group grid = cg::this_grid();
    const int bid = blockIdx.x, nb = gridDim.x;
    unsigned char* ws = a.ws;
    bf16_t* WinT = (bf16_t*)(ws + WS_WIN); bf16_t* WoutT = (bf16_t*)(ws + WS_WOUT); bf16_t* WqT = (bf16_t*)(ws + WS_WQ);
    float* rope = (float*)(ws + WS_ROPE); float* SSQ = (float*)(ws + WS_SSQ);
    bf16_t* HN = (bf16_t*)(ws + WS_HN); bf16_t* MIX = (bf16_t*)(ws + WS_MIX); bf16_t* Z = (bf16_t*)(ws + WS_Z);

    volatile LAS unsigned* MISC = (volatile LAS unsigned*)((LAS unsigned char*)lds + LDS_MISC);
    if (threadIdx.x < 16) MISC[threadIdx.x] = 0u;
    __syncthreads();
    unsigned* ctl = (unsigned*)(ws + WS_CTL);
    XcdBarrier bar = xcd_barrier_post(ctl + CW_BAR, MISC);
    phase_prep(a, lds, bid, nb);
    grid.sync();
    { pg8::Gemm g{HN, WinT, MROWS, NZ, DM}; EpiZ E{Z, rope}; pg8::StaticOrder S; S.init(g.M, g.N, nb, bid);
      pg8::gemm_phase<EpiZ, pg8::StaticOrder, true, true>((PG8_LAS unsigned char*)lds, g, S, E); }
    phase_tables(a, lds, ctl);
    xcd_barrier(bar);
    phase_mix(a, lds, ctl + CW_QUEUE);
    xcd_barrier(bar);
    { pg8::Gemm g{MIX, WoutT, TREAL, DM, DM}; EpiX1 E{a.x, HN, SSQ}; pg8::StaticOrder S; S.init(g.M, g.N, nb, bid);
      pg8::gemm_phase<EpiX1, pg8::StaticOrder, true, true>((PG8_LAS unsigned char*)lds, g, S, E); }
    xcd_barrier(bar);
    { pg8::Gemm g{HN, WqT, TREAL, DM, DM}; pg8::EpiBf16<0> E{MIX, DM, nullptr, 0, 0, 1.f}; pg8::StaticOrder S; S.init(g.M, g.N, nb, bid);
      pg8::gemm_phase<pg8::EpiBf16<0>, pg8::StaticOrder, true, true>((PG8_LAS unsigned char*)lds, g, S, E); }
    xcd_barrier(bar);
    phase_route(a, lds, bid, nb);
    xcd_barrier(bar);
    { const int xcc = (int)(xb_xcc_id() & 7u);
      phase_pu(a, lds, ctl, xcc); xcd_barrier(bar);
      phase_pc(a, bid, nb); xcd_barrier(bar);
      phase_pv(a, lds, ctl, xcc); xcd_barrier(bar);
      phase_pn(a, bid, nb); }
}

extern "C" void kernel_launch(void* const* d_in, const int* in_sizes, int n_in, void* d_out, int out_size, void* d_ws, size_t ws_size, hipStream_t stream) {
    if (n_in != 18 || out_size != TREAL * DM || ws_size < WS_END) { fprintf(stderr, "kernel_launch: unexpected shapes n_in %d out %d ws %zu (need %zu)\n", n_in, out_size, ws_size, (size_t)WS_END); return; }
    static int grid_blocks = 0;
    if (!grid_blocks) {
        int dev = 0, cus = 0, per_cu = 0;
        (void)hipGetDevice(&dev);
        (void)hipDeviceGetAttribute(&cus, hipDeviceAttributeMultiprocessorCount, dev);
        (void)hipFuncSetAttribute((const void*)mega, hipFuncAttributeMaxDynamicSharedMemorySize, LDS_BYTES);
        (void)hipOccupancyMaxActiveBlocksPerMultiprocessor(&per_cu, (const void*)mega, NTHREADS, LDS_BYTES);
        if (per_cu < 1) { fprintf(stderr, "kernel_launch: occupancy query says %d blocks/CU\n", per_cu); per_cu = 1; }
        if (per_cu > 1) per_cu = 1;
        grid_blocks = cus * per_cu;
    }
    Args a{};
    a.x = (const float*)d_in[0]; a.meta = (const float*)d_in[1]; a.nmw = (const float*)d_in[2]; a.w_in = (const float*)d_in[3];
    a.lamqk = (const float*)d_in[4]; a.subln = (const float*)d_in[5]; a.convw = (const float*)d_in[6]; a.convb = (const float*)d_in[7];
    a.ib = (const float*)d_in[8]; a.fb = (const float*)d_in[9]; a.mnw = (const float*)d_in[10]; a.w_out = (const float*)d_in[11];
    a.nfw_ffn = (const float*)d_in[12]; a.w_q = (const float*)d_in[13]; a.subkeys = (const float*)d_in[14]; a.pu = (const float*)d_in[15];
    a.pv = (const float*)d_in[16]; a.nfinal = (const float*)d_in[17];
    a.out = (float*)d_out; a.ws = (unsigned char*)d_ws;
    (void)hipMemsetAsync((char*)d_ws + WS_CTL, 0, 65536, stream);
    void* kargs[] = {&a};
    const hipError_t e = hipLaunchCooperativeKernel((const void*)mega, dim3(grid_blocks), dim3(NTHREADS), kargs, LDS_BYTES, stream);
    if (e != hipSuccess) fprintf(stderr, "kernel_launch: cooperative launch failed: %s (grid %d)\n", hipGetErrorString(e), grid_blocks);
}
```

```cpp
#include <hip/hip_runtime.h>
#include <hip/hip_bf16.h>
#include <cstdio>
#include <cstdint>
#include <cmath>
namespace pg8 {
#define PG8_LAS __attribute__((address_space(3)))
typedef unsigned short bf16_t;
typedef short bf16x8 __attribute__((ext_vector_type(8)));
typedef float f32x4 __attribute__((ext_vector_type(4)));
typedef unsigned u32x4 __attribute__((ext_vector_type(4)));
constexpr int BM = 256, BK = 64, HALF = 128, HTB = HALF * BK * 2  , STAGE_BYTES = 8 * HTB, NXCD = 8, WGM = 8;

__host__ __device__ __forceinline__ int lds_byte(int r, int c) { const int st = (r >> 4) * 2 + (c >> 5), rr = r & 15, cc = c & 31, ob = rr * 64 + cc * 2; return st * 1024 + (ob ^ (((ob >> 9) & 1) << 5)); }
__host__ __device__ __forceinline__ void stage_rc(int b, int& R, int& C) { const int st = b / 1024, sb = b % 1024, swz = sb ^ (((sb >> 9) & 1) << 5); R = (st >> 1) * 16 + swz / 64; C = (st & 1) * 32 + (swz % 64) / 2; }
__host__ __device__ __forceinline__ int perm32(int rho) { const int n = rho >> 4, i = rho & 15; return 8 * (i >> 2) + 4 * n + (i & 3); }

struct Unit { int pm, pn; };
struct Gemm { const bf16_t* A; const bf16_t* Bt; int M, N, K; };

struct StaticOrder {
    int nM, nN, nwg, G, c;
    __host__ __device__ void init(int M, int N, int G_, int c_) { nM = M / BM; nN = N / BM; nwg = nM * nN; G = G_; c = c_; }
    __host__ __device__ bool next(int i, Unit& u) const {
        const long L = (long)i * G + c; if (L >= nwg) return false;
        int wgid = (int)L; { const int q = nwg / NXCD, r = nwg % NXCD, xcd = wgid % NXCD, off = wgid / NXCD; wgid = (xcd < r ? xcd * (q + 1) : r * (q + 1) + (xcd - r) * q) + off; }
        const int nig = WGM * nN, gid = wgid / nig, fm = gid * WGM, gsz = (nM - fm) < WGM ? (nM - fm) : WGM;
        u.pm = fm + ((wgid % nig) % gsz); u.pn = (wgid % nig) / gsz; return true;
    }
    __device__ __forceinline__ void a_ready(const Unit&) const {}
    __device__ __forceinline__ void done(const Unit&) const {}
};

__device__ __forceinline__ unsigned cvt_pk_bf16(float lo, float hi) { unsigned r; asm volatile("v_cvt_pk_bf16_f32 %0, %1, %2" : "=v"(r) : "v"(lo), "v"(hi)); return r; }
typedef float f32x2 __attribute__((ext_vector_type(2)));
__device__ __forceinline__ f32x2 gelu_pk(f32x2 v) {
    const f32x2 av = __builtin_elementwise_abs(v), d = av * 0.2316418882f + 1.0f;
    f32x2 t; t.x = __builtin_amdgcn_rcpf(d.x); t.y = __builtin_amdgcn_rcpf(d.y);
    f32x2 q = t * 0.5307027145f + (-0.7265760135f); q = q * t + 0.7107068705f; q = q * t + (-0.142248368f); q = q * t + 0.127414796f; q = q * t;
    const f32x2 s = (v * v) * (-0.72134752044f);
    f32x2 e; e.x = __builtin_amdgcn_exp2f(s.x); e.y = __builtin_amdgcn_exp2f(s.y);
    const f32x2 m = v * (q * e), r = v - m;
    f32x2 o; o.x = v.x < 0.f ? m.x : r.x; o.y = v.y < 0.f ? m.y : r.y; return o;
}

template <int ACT  > struct EpiBf16 {
    static constexpr bool PERM = true, AFTER_DRAIN = false; static_assert(ACT == 0 || ACT == 1, "EpiBf16: ACT is 0 (none) or 1 (gelu_pk)");
    bf16_t* O; int ldc; const float* bias; int split_cols; size_t split_stride; float scale0;
    __device__ __forceinline__ void operator()(const f32x4 (&acc)[2][2][4][2], const Unit& u, int wr, int wc, int fr, int fq) const {
        const int row0 = u.pm * BM + wr * 64 + fr; int colt = u.pn * BM; bf16_t* base = O;
        float sc = 1.f; if (split_cols) { const int t = colt / split_cols; base += (size_t)t * split_stride; colt -= t * split_cols; if (t == 0) sc = scale0; }
        const int col0 = colt + wc * 32 + 8 * fq, bcol0 = u.pn * BM + wc * 32 + 8 * fq;
        f32x4 bv[2][2];
#pragma unroll
        for (int bj = 0; bj < 2; ++bj)
#pragma unroll
            for (int n = 0; n < 2; ++n) bv[bj][n] = bias ? *(const f32x4*)(bias + bcol0 + bj * HALF + 4 * n) : (f32x4){0.f, 0.f, 0.f, 0.f};
#pragma unroll
        for (int ai = 0; ai < 2; ++ai)
#pragma unroll
            for (int m = 0; m < 4; ++m) { bf16_t* rowp = base + (size_t)(row0 + ai * HALF + m * 16) * ldc + col0;
#pragma unroll
                for (int bj = 0; bj < 2; ++bj) { f32x4 v0 = acc[ai][bj][m][0] + bv[bj][0], v1 = acc[ai][bj][m][1] + bv[bj][1];
                    if (ACT == 1) { f32x2 a = gelu_pk((f32x2){v0[0], v0[1]}), b = gelu_pk((f32x2){v0[2], v0[3]}), c = gelu_pk((f32x2){v1[0], v1[1]}), d = gelu_pk((f32x2){v1[2], v1[3]});
                        v0 = (f32x4){a.x, a.y, b.x, b.y}; v1 = (f32x4){c.x, c.y, d.x, d.y}; }
                    v0 = v0 * sc; v1 = v1 * sc; u32x4 w; w.x = cvt_pk_bf16(v0[0], v0[1]); w.y = cvt_pk_bf16(v0[2], v0[3]); w.z = cvt_pk_bf16(v1[0], v1[1]); w.w = cvt_pk_bf16(v1[2], v1[3]);
                    *(u32x4*)(rowp + bj * HALF) = w; } }
    }
};
template <class Epi, class Sched, bool ALIGN_EPI = false, bool SP2 = false>
__device__ __forceinline__ void gemm_phase(PG8_LAS unsigned char* lds, const Gemm g, const Sched& S, const Epi& E) {
    int tid_ = threadIdx.x; asm volatile("" : "+v"(tid_));
    const int tid = tid_, wid = __builtin_amdgcn_readfirstlane(tid >> 6), lane = tid & 63, wr = wid >> 2, wc = wid & 3, fr = lane & 15, fq = lane >> 4;
    const int K = g.K, nt = K / BK;
    unsigned voffA[2], voffB[2];
#pragma unroll
    for (int i = 0; i < 2; ++i) { int R, C; stage_rc(tid * 16 + i * 8192, R, C); const int Rb = Epi::PERM ? ((R & ~31) + perm32(R & 31)) : R;
        voffA[i] = (unsigned)(R * K + C) * 2u; voffB[i] = (unsigned)(Rb * K + C) * 2u; }
    const size_t kstep = (size_t)(BK * 2);
    const size_t hstep = (size_t)HALF * K * 2;
    const size_t tstep = 2 * hstep;
    const unsigned ldsw = (unsigned)wid * 1024u;
    const int aoff = lds_byte(wr * 64 + fr, fq * 8), boff = lds_byte(wc * 32 + fr, fq * 8);
#define PG8_SA(b, h) (((b) * 2 + (h)) * HTB)
#define PG8_SB(b, h) ((4 + (b) * 2 + (h)) * HTB)
#define PG8_STAGE(bufoff, gbase, voff) do { _Pragma("unroll") for (int _i = 0; _i < 2; ++_i) \
        __builtin_amdgcn_global_load_lds((const unsigned*)((const char*)(gbase) + (voff)[_i]), (PG8_LAS unsigned*)(lds + (bufoff) + ldsw + _i * 8192), 16, 0, 0); } while (0)
#define PG8_LDA(dst, b, h) do { _Pragma("unroll") for (int m = 0; m < 4; ++m) _Pragma("unroll") for (int k = 0; k < 2; ++k) dst[m][k] = *(const PG8_LAS bf16x8*)(lds + PG8_SA(b, h) + aoff + m * 2048 + k * 1024); } while (0)
#define PG8_LDB(dst, b, h) do { _Pragma("unroll") for (int n = 0; n < 2; ++n) _Pragma("unroll") for (int k = 0; k < 2; ++k) dst[n][k] = *(const PG8_LAS bf16x8*)(lds + PG8_SB(b, h) + boff + n * 2048 + k * 1024); } while (0)
#define PG8_MMA(ai, bj, At, Bt) do { __builtin_amdgcn_s_setprio(1); _Pragma("unroll") for (int m = 0; m < 4; ++m) _Pragma("unroll") for (int n = 0; n < 2; ++n) _Pragma("unroll") for (int k = 0; k < 2; ++k) \
        acc[ai][bj][m][n] = __builtin_amdgcn_mfma_f32_16x16x32_bf16(Bt[n][k], At[m][k], acc[ai][bj][m][n], 0, 0, 0); __builtin_amdgcn_s_setprio(0); } while (0)
#define PG8_WAIT_V(n) asm volatile("s_waitcnt vmcnt(" #n ")" ::: "memory")
#define PG8_WAIT_L(n) asm volatile("s_waitcnt lgkmcnt(" #n ")" ::: "memory")
#define PG8_BAR __builtin_amdgcn_s_barrier()
#define PG8_SCHED __builtin_amdgcn_sched_barrier(0)
    Unit cur, nxt; int ui = 0;
    if (!S.next(0, cur)) return;
    f32x4 acc[2][2][4][2];
#pragma unroll
    for (int a = 0; a < 2; ++a)
#pragma unroll
        for (int b = 0; b < 2; ++b)
#pragma unroll
            for (int m = 0; m < 4; ++m)
#pragma unroll
                for (int n = 0; n < 2; ++n) acc[a][b][m][n] = (f32x4){0.f, 0.f, 0.f, 0.f};
    bf16x8 At[4][2], B0[2][2], B1[2][2];
    const char* cA = (const char*)g.A + (size_t)cur.pm * tstep; const char* cB = (const char*)g.Bt + (size_t)cur.pn * tstep;
    S.a_ready(cur);
    if constexpr (SP2) {
        PG8_STAGE(PG8_SB(0, 0), cB, voffB); PG8_STAGE(PG8_SB(0, 1), cB + hstep, voffB); PG8_STAGE(PG8_SA(0, 0), cA, voffA); PG8_STAGE(PG8_SA(0, 1), cA + hstep, voffA);
        if (wr == 1) PG8_BAR;
        PG8_WAIT_V(2); PG8_BAR;
        PG8_STAGE(PG8_SB(1, 0), cB + kstep, voffB); PG8_STAGE(PG8_SA(1, 0), cA + kstep, voffA); PG8_STAGE(PG8_SB(1, 1), cB + hstep + kstep, voffB);
        PG8_WAIT_V(6); PG8_BAR;
    } else {
        PG8_STAGE(PG8_SB(0, 0), cB, voffB); PG8_STAGE(PG8_SA(0, 0), cA, voffA); PG8_STAGE(PG8_SB(0, 1), cB + hstep, voffB); PG8_STAGE(PG8_SA(0, 1), cA + hstep, voffA);
        if (wr == 1) PG8_BAR;
        PG8_WAIT_V(4); PG8_BAR;
        PG8_STAGE(PG8_SB(1, 0), cB + kstep, voffB); PG8_STAGE(PG8_SA(1, 0), cA + kstep, voffA); PG8_STAGE(PG8_SB(1, 1), cB + hstep + kstep, voffB);
        PG8_WAIT_V(6); PG8_BAR;
    }
    for (;;) {
        const bool has_next = S.next(ui + 1, nxt);
        const char* nA = has_next ? (const char*)g.A + (size_t)nxt.pm * tstep : cA; const char* nB = has_next ? (const char*)g.Bt + (size_t)nxt.pn * tstep : cB;
        for (int t = 0; t < nt; t += 2) {
            const bool last = (t == nt - 2);
            const char* a1 = cA + (size_t)(t + 1) * kstep;
            const char* a2 = last ? nA : cA + (size_t)(t + 2) * kstep; const char* b2 = last ? nB : cB + (size_t)(t + 2) * kstep;
            const char* a3 = a2 + kstep; const char* b3 = b2 + kstep;
            if (last && has_next) S.a_ready(nxt);
            if constexpr (SP2) {
            PG8_LDB(B0, 0, 0); PG8_LDB(B1, 0, 1); PG8_SCHED; PG8_LDA(At, 0, 0); PG8_STAGE(PG8_SA(1, 1), a1 + hstep, voffA);
            PG8_WAIT_V(8); PG8_WAIT_L(0); PG8_BAR; PG8_MMA(0, 0, At, B0); PG8_MMA(0, 1, At, B1); PG8_BAR; PG8_SCHED;
            PG8_LDA(At, 0, 1); PG8_STAGE(PG8_SB(0, 0), b2, voffB); PG8_STAGE(PG8_SB(0, 1), b2 + hstep, voffB); PG8_STAGE(PG8_SA(0, 0), a2, voffA);
            PG8_WAIT_V(8); PG8_WAIT_L(0); PG8_BAR; PG8_MMA(1, 0, At, B0); PG8_MMA(1, 1, At, B1); PG8_BAR; PG8_SCHED;
            PG8_LDB(B0, 1, 0); PG8_LDB(B1, 1, 1); PG8_SCHED; PG8_LDA(At, 1, 0); PG8_STAGE(PG8_SA(0, 1), a2 + hstep, voffA);
            PG8_WAIT_V(8); PG8_WAIT_L(0); PG8_BAR; PG8_MMA(0, 0, At, B0); PG8_MMA(0, 1, At, B1); PG8_BAR; PG8_SCHED;
            PG8_LDA(At, 1, 1); PG8_STAGE(PG8_SB(1, 0), b3, voffB); PG8_STAGE(PG8_SB(1, 1), b3 + hstep, voffB); PG8_STAGE(PG8_SA(1, 0), a3, voffA);
            PG8_WAIT_V(8); PG8_WAIT_L(0); PG8_BAR; PG8_MMA(1, 0, At, B0); PG8_MMA(1, 1, At, B1); PG8_BAR; PG8_SCHED;
            } else {
            PG8_LDB(B0, 0, 0); PG8_SCHED; PG8_LDA(At, 0, 0); PG8_STAGE(PG8_SA(1, 1), a1 + hstep, voffA);
            PG8_WAIT_L(8); PG8_BAR; PG8_WAIT_L(0); PG8_MMA(0, 0, At, B0); PG8_BAR; PG8_SCHED;
            PG8_LDB(B1, 0, 1); PG8_STAGE(PG8_SB(0, 0), b2, voffB);
            PG8_BAR; PG8_WAIT_L(0); PG8_MMA(0, 1, At, B1); PG8_BAR;
            PG8_LDA(At, 0, 1); PG8_STAGE(PG8_SA(0, 0), a2, voffA);
            PG8_BAR; PG8_WAIT_L(0); PG8_MMA(1, 0, At, B0); PG8_BAR; PG8_SCHED;
            PG8_STAGE(PG8_SB(0, 1), b2 + hstep, voffB);
            PG8_WAIT_V(6); PG8_BAR; PG8_MMA(1, 1, At, B1); PG8_BAR;
            PG8_LDB(B0, 1, 0); PG8_SCHED; PG8_LDA(At, 1, 0); PG8_STAGE(PG8_SA(0, 1), a2 + hstep, voffA);
            PG8_WAIT_L(8); PG8_BAR; PG8_WAIT_L(0); PG8_MMA(0, 0, At, B0); PG8_BAR; PG8_SCHED;
            PG8_LDB(B1, 1, 1); PG8_STAGE(PG8_SB(1, 0), b3, voffB);
            PG8_BAR; PG8_WAIT_L(0); PG8_MMA(0, 1, At, B1); PG8_BAR;
            PG8_LDA(At, 1, 1); PG8_STAGE(PG8_SA(1, 0), a3, voffA);
            PG8_BAR; PG8_WAIT_L(0); PG8_MMA(1, 0, At, B0); PG8_BAR; PG8_SCHED;
            PG8_STAGE(PG8_SB(1, 1), b3 + hstep, voffB);
            PG8_WAIT_V(6); PG8_BAR; PG8_MMA(1, 1, At, B1); PG8_BAR;
            }
        }
        if constexpr (ALIGN_EPI) { if (wr == 0) PG8_BAR; }
        if constexpr (!Epi::AFTER_DRAIN) { E(acc, cur, wr, wc, fr, fq); S.done(cur); }
        if (!has_next) break;
#pragma unroll
        for (int a = 0; a < 2; ++a)
#pragma unroll
            for (int b = 0; b < 2; ++b)
#pragma unroll
                for (int m = 0; m < 4; ++m)
#pragma unroll
                    for (int n = 0; n < 2; ++n) acc[a][b][m][n] = (f32x4){0.f, 0.f, 0.f, 0.f};
        cur = nxt; cA = nA; cB = nB; ++ui;
        if constexpr (ALIGN_EPI) { if (wr == 1) PG8_BAR; }
    }
    PG8_WAIT_V(0);
    if constexpr (!ALIGN_EPI) { if (wr == 0) PG8_BAR; }
    PG8_BAR;
    if constexpr (Epi::AFTER_DRAIN) { E.fused(acc, cur, wr, wc, fr, fq, lds, wid, lane); S.done(cur); }
#undef PG8_SA
#undef PG8_SB
#undef PG8_STAGE
#undef PG8_LDA
#undef PG8_LDB
#undef PG8_MMA
#undef PG8_WAIT_V
#undef PG8_WAIT_L
#undef PG8_BAR
#undef PG8_SCHED
}
}

constexpr int BATCH = 16, SEQ = 2048, DM = 2048, NMETA = 16;
constexpr int TREAL = BATCH * SEQ;
constexpr int MROWS = 33024;
constexpr int META_TILE0 = 32768;
constexpr int META_ROW0 = 32816;
constexpr int NZ = 6144;
constexpr int ZQ = 0, ZK = 1024, ZV = 2048, ZMQ = 3072, ZMK = 3584, ZMV = 4096, ZMO = 5120;
constexpr int INCOLS = 6152;
constexpr float EPS = 1e-6f;
constexpr float QSCALE = 0.125f * 1.4426950408889634f;
constexpr float LAMBDA_INIT = 0.2f;

typedef unsigned short bf16_t;
typedef float f32x4 __attribute__((ext_vector_type(4)));
typedef __bf16 bf16x2_t __attribute__((ext_vector_type(2)));

constexpr size_t MiB = 1u << 20;
constexpr size_t WS_CTL = 0;
constexpr size_t WS_ISC = 655360;
constexpr size_t WS_SKB = 65536;
constexpr size_t WS_WIN = 1 * MiB;
constexpr size_t WS_WOUT = 25 * MiB;
constexpr size_t WS_WQ = 33 * MiB;
constexpr size_t WS_ROPE = 41 * MiB;
constexpr size_t WS_GATES = 42 * MiB;
constexpr size_t WS_SSQ = 44 * MiB;
constexpr size_t WS_IDX = 48 * MiB;
constexpr size_t WS_GATE = 64 * MiB;
constexpr size_t WS_U = 80 * MiB;
constexpr size_t WS_V = 144 * MiB;
constexpr size_t WS_HN = 208 * MiB;
constexpr size_t WS_MIX = 338 * MiB;
constexpr size_t WS_Z = 466 * MiB;
constexpr size_t WS_END = 854 * MiB;

__device__ __forceinline__ float bf_lo(unsigned w) { return __uint_as_float(w << 16); }
__device__ __forceinline__ float bf_hi(unsigned w) { return __uint_as_float(w & 0xffff0000u); }
__device__ __forceinline__ float bf2f(bf16_t v) { return __uint_as_float(((unsigned)v) << 16); }
__device__ __forceinline__ unsigned f2bf(float f) { unsigned r; asm("v_cvt_pk_bf16_f32 %0, %1, 0" : "=v"(r) : "v"(f)); return r; }
__device__ __forceinline__ unsigned pk2(float lo, float hi) { unsigned r; asm("v_cvt_pk_bf16_f32 %0, %1, %2" : "=v"(r) : "v"(lo), "v"(hi)); return r; }
__device__ __forceinline__ float dot2(unsigned a, unsigned b, float acc) { return __builtin_amdgcn_fdot2_f32_bf16(__builtin_bit_cast(bf16x2_t, a), __builtin_bit_cast(bf16x2_t, b), acc, false); }
__device__ __forceinline__ float wave_sum(float v) {
#pragma unroll
    for (int o = 1; o < 64; o <<= 1) v += __shfl_xor(v, o);
    return v;
}
__device__ __forceinline__ float wave_max(float v) {
#pragma unroll
    for (int o = 1; o < 64; o <<= 1) v = fmaxf(v, __shfl_xor(v, o));
    return v;
}
__device__ __forceinline__ int zrow_of(int b, int l) { return l < NMETA ? META_ROW0 + l : b * SEQ + (l - NMETA); }

struct EpiZ {
    static constexpr bool PERM = true, AFTER_DRAIN = false;
    bf16_t* Z; const float* rope;
    __device__ __forceinline__ void operator()(const pg8::f32x4 (&acc)[2][2][4][2], const pg8::Unit& u, int wr, int wc, int fr, int fq) const {
        const int row0 = u.pm * 256 + wr * 64 + fr, col0 = u.pn * 256 + wc * 32 + 8 * fq;
        const bool isq = u.pn < 4, isrope = u.pn < 8;
        const int j0 = 16 * (wc & 1) + 4 * fq;
#pragma unroll
        for (int ai = 0; ai < 2; ++ai)
#pragma unroll
            for (int m = 0; m < 4; ++m) {
                const int row = row0 + ai * 128 + m * 16;
                pg8::f32x4 c0 = {1.f, 0.f, 1.f, 0.f}, c1 = {1.f, 0.f, 1.f, 0.f};
                if (isrope) {
                    const int pos = row < TREAL ? (row & (SEQ - 1)) + NMETA : ((row >= META_ROW0 && row < META_ROW0 + NMETA) ? row - META_ROW0 : 0);
                    const pg8::f32x4* tp = (const pg8::f32x4*)(rope + ((size_t)pos * 32 + j0) * 2);
                    c0 = tp[0]; c1 = tp[1];
                }
                bf16_t* rowp = Z + (size_t)row * NZ + col0;
#pragma unroll
                for (int bj = 0; bj < 2; ++bj) {
                    pg8::f32x4 v0 = acc[ai][bj][m][0], v1 = acc[ai][bj][m][1];
                    if (isrope) {
                        pg8::f32x4 o0, o1;
                        o0[0] = v0[0] * c0[0] - v0[1] * c0[1]; o0[1] = v0[1] * c0[0] + v0[0] * c0[1];
                        o0[2] = v0[2] * c0[2] - v0[3] * c0[3]; o0[3] = v0[3] * c0[2] + v0[2] * c0[3];
                        o1[0] = v1[0] * c1[0] - v1[1] * c1[1]; o1[1] = v1[1] * c1[0] + v1[0] * c1[1];
                        o1[2] = v1[2] * c1[2] - v1[3] * c1[3]; o1[3] = v1[3] * c1[2] + v1[2] * c1[3];
                        v0 = o0; v1 = o1;
                        if (isq) { v0 = v0 * QSCALE; v1 = v1 * QSCALE; }
                    }
                    pg8::u32x4 w; w.x = pg8::cvt_pk_bf16(v0[0], v0[1]); w.y = pg8::cvt_pk_bf16(v0[2], v0[3]); w.z = pg8::cvt_pk_bf16(v1[0], v1[1]); w.w = pg8::cvt_pk_bf16(v1[2], v1[3]);
                    *(pg8::u32x4*)(rowp + bj * 128) = w;
                }
            }
    }
};
struct EpiX1 {
    static constexpr bool PERM = true, AFTER_DRAIN = false;
    const float* x; bf16_t* x1b; float* ssq;
    __device__ __forceinline__ void loadr(pg8::f32x4 (&xb)[2][2], int row0, int col0, int i) const {
#pragma unroll
        for (int bj = 0; bj < 2; ++bj) {
            const size_t off = (size_t)(row0 + (i >> 2) * 128 + (i & 3) * 16) * DM + col0 + bj * 128;
            xb[bj][0] = *(const pg8::f32x4*)(x + off); xb[bj][1] = *(const pg8::f32x4*)(x + off + 4);
        }
    }
    __device__ __forceinline__ void procr(const pg8::f32x4 (&acc)[2][2][4][2], const pg8::f32x4 (&xb)[2][2], int row0, int col0, int i, int pn, int wc, int fq) const {
        const int ai = i >> 2, m = i & 3;
        const int row = row0 + ai * 128 + m * 16; float ss = 0.f;
#pragma unroll
        for (int bj = 0; bj < 2; ++bj) {
            const size_t off = (size_t)row * DM + col0 + bj * 128;
            const pg8::f32x4 v0 = acc[ai][bj][m][0] + xb[bj][0], v1 = acc[ai][bj][m][1] + xb[bj][1];
            ss += (v0[0] * v0[0] + v0[1] * v0[1]) + (v0[2] * v0[2] + v0[3] * v0[3]) + (v1[0] * v1[0] + v1[1] * v1[1]) + (v1[2] * v1[2] + v1[3] * v1[3]);
            pg8::u32x4 w; w.x = pg8::cvt_pk_bf16(v0[0], v0[1]); w.y = pg8::cvt_pk_bf16(v0[2], v0[3]); w.z = pg8::cvt_pk_bf16(v1[0], v1[1]); w.w = pg8::cvt_pk_bf16(v1[2], v1[3]);
            *(pg8::u32x4*)(x1b + off) = w;
        }
        ss += __shfl_xor(ss, 16); ss += __shfl_xor(ss, 32);
        if (fq == 0) ssq[(size_t)row * 32 + pn * 4 + wc] = ss;
    }
    __device__ __forceinline__ void operator()(const pg8::f32x4 (&acc)[2][2][4][2], const pg8::Unit& u, int wr, int wc, int fr, int fq) const {
        const int row0 = u.pm * 256 + wr * 64 + fr, col0 = u.pn * 256 + wc * 32 + 8 * fq;
        pg8::f32x4 b0[2][2], b1[2][2], b2[2][2];
        loadr(b0, row0, col0, 0); loadr(b1, row0, col0, 1); loadr(b2, row0, col0, 2);
        procr(acc, b0, row0, col0, 0, u.pn, wc, fq); loadr(b0, row0, col0, 3);
        procr(acc, b1, row0, col0, 1, u.pn, wc, fq); loadr(b1, row0, col0, 4);
        procr(acc, b2, row0, col0, 2, u.pn, wc, fq); loadr(b2, row0, col0, 5);
        procr(acc, b0, row0, col0, 3, u.pn, wc, fq); loadr(b0, row0, col0, 6);
        procr(acc, b1, row0, col0, 4, u.pn, wc, fq); loadr(b1, row0, col0, 7);
        procr(acc, b2, row0, col0, 5, u.pn, wc, fq);
        procr(acc, b0, row0, col0, 6, u.pn, wc, fq);
        procr(acc, b1, row0, col0, 7, u.pn, wc, fq);
    }
};


#include <hip/hip_cooperative_groups.h>
namespace cg = cooperative_groups;

constexpr int NWAVES = 8, NTHREADS = 512;
constexpr size_t WS_X1Q = WS_Z + 300 * MiB, WS_XSC = WS_Z + 370 * MiB;
__device__ __forceinline__ int opaque_tid() { int t = threadIdx.x; asm volatile("" : "+v"(t)); return t; }
constexpr int LDS_BYTES = 163840;

struct Args {
    const float *x, *meta, *nmw, *w_in, *lamqk, *subln, *convw, *convb, *ib, *fb, *mnw, *w_out, *nfw_ffn, *w_q, *subkeys, *pu, *pv, *nfinal;
    float* out; unsigned char* ws;
};

#define LAS __attribute__((address_space(3)))
#define XB_TMO      128
#define XB_XCNT(j)  (256  + 64 * (j))
#define XB_XSUB(j)  (1280 + 64 * (j))
#define XB_XGEN(j)  (2304 + 64 * (j))
#define XB_TOP      3328
#define XB_TOPGEN   3392
#define XCD_BAR_WORDS 3456
#define XB_SPIN_CAP (1u << 18)

__device__ __forceinline__ unsigned xb_ld(unsigned* p)              { return __hip_atomic_load(p, __ATOMIC_RELAXED, __HIP_MEMORY_SCOPE_AGENT); }
__device__ __forceinline__ unsigned xb_add(unsigned* p, unsigned v) { return __hip_atomic_fetch_add(p, v, __ATOMIC_RELAXED, __HIP_MEMORY_SCOPE_AGENT); }
__device__ __forceinline__ unsigned xb_xcc_id() { return (unsigned)__builtin_amdgcn_s_getreg((3 << 11) | 20) & 0xFu; }
#define XB_SPIN(cond, bar) do { unsigned _sp = 0; while (cond) { __builtin_amdgcn_s_sleep(1); \
    if ((++_sp & 255u) == 0u) { if (xb_ld(&(bar)[XB_TMO])) break; if (_sp > XB_SPIN_CAP) { atomicAdd(&(bar)[XB_TMO], 1u); break; } } } } while (0)

struct XcdBarrier {
    unsigned* bar; unsigned x;
    volatile LAS unsigned* st;
};

__device__ __forceinline__ XcdBarrier xcd_barrier_post(unsigned* bar, volatile LAS unsigned* st) {
    XcdBarrier b; b.bar = bar; b.x = xb_xcc_id(); b.st = st;
    if (threadIdx.x == 0) (void)xb_add(&bar[XB_XCNT(b.x)], 1u);
    return b;
}
__device__ __forceinline__ void xcd_barrier_complete(unsigned* bar, unsigned x, unsigned& nloc, unsigned& nx) {
    const unsigned G = gridDim.x * gridDim.y * gridDim.z;
    unsigned sum, cnt, mine, sp = 0u;
    for (;;) {
        sum = 0u; cnt = 0u; mine = 0u;
#pragma unroll
        for (unsigned j = 0; j < 16; ++j) { const unsigned c = xb_ld(&bar[XB_XCNT(j)]); sum += c; cnt += (c > 0u) ? 1u : 0u; mine = (j == x) ? c : mine; }
        if (sum == G) break;
        __builtin_amdgcn_s_sleep(1);
        if ((++sp & 255u) == 0u) { if (xb_ld(&bar[XB_TMO])) break; if (sp > XB_SPIN_CAP) { atomicAdd(&bar[XB_TMO], 1u); break; } }
    }
    nloc = mine > 0u ? mine : 1u; nx = cnt > 0u ? cnt : 1u;
}

__device__ __forceinline__ void xcd_barrier(const XcdBarrier& b) {
    asm volatile("s_waitcnt vmcnt(0)" ::: "memory");
    __syncthreads();
    if (threadIdx.x == 0) {
        unsigned* bar = b.bar;
        __builtin_amdgcn_s_waitcnt(0);
        unsigned nloc = b.st[0], nx = b.st[1];
        if (nloc == 0u) { xcd_barrier_complete(bar, b.x, nloc, nx); b.st[0] = nloc; b.st[1] = nx; }
        const unsigned old = xb_add(&bar[XB_XSUB(b.x)], 1u);
        const unsigned gen = old / nloc;
        if (old + 1u == (gen + 1u) * nloc) {
            __builtin_amdgcn_fence(__ATOMIC_RELEASE, "agent");
            asm volatile("s_waitcnt vmcnt(0)" ::: "memory");
            const unsigned og = xb_add(&bar[XB_TOP], 1u);
            const unsigned tg = og / nx;
            if (og + 1u == (tg + 1u) * nx) xb_add(&bar[XB_TOPGEN], 1u);
            else XB_SPIN(xb_ld(&bar[XB_TOPGEN]) == tg, bar);
            __builtin_amdgcn_fence(__ATOMIC_ACQUIRE, "agent");
            xb_add(&bar[XB_XGEN(b.x)], 1u);
            asm volatile("s_waitcnt vmcnt(0)" ::: "memory");
        } else {
            XB_SPIN(xb_ld(&bar[XB_XGEN(b.x)]) == gen, bar);
            __builtin_amdgcn_fence(__ATOMIC_ACQUIRE, "agent");
            asm volatile("s_waitcnt vmcnt(0)" ::: "memory");
        }
    }
    __syncthreads();
}

constexpr int CW_BAR = 0, CW_QUEUE = 4096;
constexpr int LDS_MISC = LDS_BYTES - 256;
__device__ __forceinline__ unsigned wave_draw(unsigned* ctr, int lane) {
    unsigned v = 0u;
    if (lane == 0) v = __hip_atomic_fetch_add(ctr, 1u, __ATOMIC_RELAXED, __HIP_MEMORY_SCOPE_AGENT);
    return v;
}
__device__ __forceinline__ int wave_item(unsigned v) { return (int)__builtin_amdgcn_readfirstlane(v); }
__device__ __forceinline__ int next_item(unsigned* ctr, volatile LAS unsigned* slot) {
    __syncthreads();
    if (threadIdx.x == 0) *slot = __hip_atomic_fetch_add(ctr, 1u, __ATOMIC_RELAXED, __HIP_MEMORY_SCOPE_AGENT);
    __syncthreads();
    return (int)*slot;
}

__device__ __forceinline__ void transpose_item(const float* W, int ldw, int K, int N, bf16_t* WT, bool ropeperm, float* scr, int item, int lane, const float* kscale = nullptr) {
    const int nblk = N / 32, kb = item / nblk, nb = item % nblk, k0 = 64 * kb, n0 = 32 * nb;
#pragma unroll 8
    for (int i = 0; i < 32; ++i) { const int kk = 2 * i + (lane >> 5); scr[kk * 33 + (lane & 31)] = W[(size_t)(k0 + kk) * ldw + n0 + (lane & 31)] * (kscale ? kscale[k0 + kk] : 1.f); }
    __builtin_amdgcn_s_waitcnt(0xC07F); asm volatile("" ::: "memory");
    const int c = lane & 7;
#pragma unroll
    for (int j = 0; j < 4; ++j) {
        const int n = (lane >> 3) + 8 * j; const float* s = scr + (8 * c) * 33 + n;
        uint4 o; o.x = pk2(s[0 * 33], s[1 * 33]); o.y = pk2(s[2 * 33], s[3 * 33]); o.z = pk2(s[4 * 33], s[5 * 33]); o.w = pk2(s[6 * 33], s[7 * 33]);
        int orow = n0 + n;
        if (ropeperm && n0 < 2048) orow = (n0 & ~63) + 2 * n + ((n0 >> 5) & 1);
        *(uint4*)(WT + (size_t)orow * K + k0 + 8 * c) = o;
    }
    __builtin_amdgcn_s_waitcnt(0xC07F); asm volatile("" ::: "memory");
}

__device__ __forceinline__ void hn_row(const Args& a, bf16_t* HN, float* G, const float* WG, int r, const f32x4 (&v)[8], int lane) {
    float ss = 0.f;
#pragma unroll
    for (int j = 0; j < 8; ++j) ss += (v[j][0] * v[j][0] + v[j][1] * v[j][1]) + (v[j][2] * v[j][2] + v[j][3] * v[j][3]);
    const float rstd = rsqrtf(wave_sum(ss) * (1.f / DM) + EPS);
    float g[8];
#pragma unroll
    for (int k = 0; k < 8; ++k) g[k] = 0.f;
    unsigned long long* o8 = (unsigned long long*)(HN + (size_t)r * DM) + lane;
#pragma unroll
    for (int j = 0; j < 8; ++j) {
        const f32x4 w = ((const f32x4*)a.nmw)[64 * j + lane];
        const f32x4 y = v[j] * rstd * w;
        o8[64 * j] = (unsigned long long)pk2(y[0], y[1]) | ((unsigned long long)pk2(y[2], y[3]) << 32);
#pragma unroll
        for (int k = 0; k < 8; ++k) { const f32x4 wg = ((const f32x4*)(WG + k * 2048))[64 * j + lane]; g[k] += (y[0] * wg[0] + y[1] * wg[1]) + (y[2] * wg[2] + y[3] * wg[3]); }
        __builtin_amdgcn_sched_barrier(0);
    }
    float r4[4], r2[2], r1;
    { const bool hb = (lane & 32) != 0;
#pragma unroll
      for (int i = 0; i < 4; ++i) { const float send = hb ? g[i] : g[i + 4]; const float recv = __shfl_xor(send, 32); r4[i] = (hb ? g[i + 4] : g[i]) + recv; } }
    { const bool hb = (lane & 16) != 0;
#pragma unroll
      for (int i = 0; i < 2; ++i) { const float send = hb ? r4[i] : r4[i + 2]; const float recv = __shfl_xor(send, 16); r2[i] = (hb ? r4[i + 2] : r4[i]) + recv; } }
    { const bool hb = (lane & 8) != 0; const float send = hb ? r2[0] : r2[1]; const float recv = __shfl_xor(send, 8); r1 = (hb ? r2[1] : r2[0]) + recv; }
    r1 += __shfl_xor(r1, 4); r1 += __shfl_xor(r1, 2); r1 += __shfl_xor(r1, 1);
    if ((lane & 7) == 0) G[(size_t)r * 8 + ((lane >> 5) & 1) * 4 + ((lane >> 4) & 1) * 2 + ((lane >> 3) & 1)] = r1;
}

__device__ __forceinline__ void phase_prep(const Args& a, unsigned char* lds, int bid, int nb) {
    const int tid = opaque_tid(), lane = tid & 63, wave = tid >> 6;
    const int gw = bid * NWAVES + wave, NGW = nb * NWAVES;
    unsigned char* ws = a.ws;
    bf16_t* WinT = (bf16_t*)(ws + WS_WIN); bf16_t* WoutT = (bf16_t*)(ws + WS_WOUT); bf16_t* WqT = (bf16_t*)(ws + WS_WQ);
    bf16_t* U = (bf16_t*)(ws + WS_U); bf16_t* V = (bf16_t*)(ws + WS_V); bf16_t* HN = (bf16_t*)(ws + WS_HN);
    float* G = (float*)(ws + WS_GATES); float* rope = (float*)(ws + WS_ROPE);
    float* scr = (float*)lds + wave * (64 * 33);
    float* WG = (float*)(lds + 8 * 64 * 33 * 4);
    for (int i = tid; i < 8 * 2048; i += NTHREADS) { const int k = i >> 3, g = i & 7; WG[g * 2048 + k] = a.w_in[(size_t)k * INCOLS + 6144 + g]; }
    __syncthreads();
    constexpr int I_IN = 32 * 192, I_OUT = 32 * 64, I_Q = 32 * 64;
    for (int it = gw; it < I_IN + I_OUT + I_Q; it += NGW) {
        int r = it;
        if (r < I_IN) { transpose_item(a.w_in, INCOLS, 2048, 6144, WinT, true, scr, r, lane); continue; } r -= I_IN;
        if (r < I_OUT) { transpose_item(a.w_out, 2048, 2048, 2048, WoutT, false, scr, r, lane); continue; } r -= I_OUT;
        transpose_item(a.w_q, 2048, 2048, 2048, WqT, false, scr, r, lane, a.nfw_ffn);
    }
    {
        f32x4 vc[8], vn[8];
#pragma unroll
        for (int j = 0; j < 8; ++j) vc[j] = ((const f32x4*)(a.x + (size_t)gw * DM))[64 * j + lane];
        for (int r = gw; r < TREAL; r += NGW) {
            const int rn = r + NGW < TREAL ? r + NGW : r;
#pragma unroll
            for (int j = 0; j < 8; ++j) vn[j] = ((const f32x4*)(a.x + (size_t)rn * DM))[64 * j + lane];
            hn_row(a, HN, G, WG, r, vc, lane);
#pragma unroll
            for (int j = 0; j < 8; ++j) vc[j] = vn[j];
        }
    }
    for (int r = TREAL + gw; r < MROWS; r += NGW) {
        if (r >= META_ROW0 && r < META_ROW0 + NMETA) {
            f32x4 vm[8];
#pragma unroll
            for (int j = 0; j < 8; ++j) vm[j] = ((const f32x4*)(a.meta + (size_t)(r - META_ROW0) * DM))[64 * j + lane];
            hn_row(a, HN, G, WG, r, vm, lane);
        } else {
            unsigned long long* o8 = (unsigned long long*)(HN + (size_t)r * DM) + lane;
#pragma unroll
            for (int j = 0; j < 8; ++j) o8[64 * j] = 0ull;
            if (lane < 8) G[(size_t)r * 8 + lane] = 0.f;
        }
    }
    { bf16_t* SKB = (bf16_t*)(ws + WS_SKB);
      for (int i = bid * NTHREADS + tid; i < 8 * 2 * 128 * 128 / 2; i += nb * NTHREADS) { const float2 v = ((const float2*)a.subkeys)[i]; ((unsigned*)SKB)[i] = pk2(v.x, v.y); } }
    for (int i = bid * NTHREADS + tid; i < (SEQ + NMETA) * 32; i += nb * NTHREADS) {
        const int pos = i >> 5, j = i & 31;
        const float inv = (float)pow(10000.0, -(double)j / 32.0);
        const float ang = (float)pos * inv;
        rope[2 * i] = (float)cos((double)ang); rope[2 * i + 1] = (float)sin((double)ang);
    }
}


constexpr int CW_QTAB = 4096 + 1024, TAB_ITEMS = 2 * 16384 / 16;
__device__ __forceinline__ void phase_tables(const Args& a, unsigned char* lds, unsigned* ctl) {
    const int tid = opaque_tid(), lane = tid & 63, wave = __builtin_amdgcn_readfirstlane(tid >> 6);
    unsigned char* ws = a.ws;
    volatile LAS unsigned* slot = (volatile LAS unsigned*)((LAS unsigned char*)lds + LDS_MISC) + 2;
    for (;;) {
        const int item = next_item(ctl + CW_QTAB, slot);
        if (item >= TAB_ITEMS) break;
        const int rr = item * 16 + wave;
    {
        unsigned* U8 = (unsigned*)(ws + WS_U); unsigned* V8 = (unsigned*)(ws + WS_V); float* ISC = (float*)(ws + WS_ISC);
        {
            f32x4 v[2][8]; float am[2];
#pragma unroll
            for (int q = 0; q < 2; ++q) {
                const int r = rr + q * 8; const bool isu = r < 16384; const int e = r & 16383;
                const f32x4* xr = (const f32x4*)((isu ? a.pu : a.pv) + (size_t)e * DM) + lane;
#pragma unroll
                for (int j = 0; j < 8; ++j) v[q][j] = xr[64 * j];
            }
#pragma unroll
            for (int q = 0; q < 2; ++q) if (rr + q * 8 < 16384) {
#pragma unroll
                for (int j = 0; j < 8; ++j) v[q][j] = v[q][j] * ((const f32x4*)a.nfw_ffn)[64 * j + lane]; }
#pragma unroll
            for (int q = 0; q < 2; ++q) { float t = 0.f;
#pragma unroll
                for (int j = 0; j < 8; ++j) t = fmaxf(t, fmaxf(fmaxf(fabsf(v[q][j][0]), fabsf(v[q][j][1])), fmaxf(fabsf(v[q][j][2]), fabsf(v[q][j][3]))));
                am[q] = t; }
#pragma unroll
            for (int o = 1; o < 64; o <<= 1) { am[0] = fmaxf(am[0], __shfl_xor(am[0], o)); am[1] = fmaxf(am[1], __shfl_xor(am[1], o)); }
#pragma unroll
            for (int q = 0; q < 2; ++q) {
                const int r = rr + q * 8; const bool isu = r < 16384; const int e = r & 16383;
                const float top = isu ? 127.f : 256.f;
                const float sc = am[q] > 0.f ? top / am[q] : 0.f;
                unsigned* o8 = isu ? U8 : V8;
#pragma unroll
                for (int j = 0; j < 8; ++j) { int w;
                    if (isu) { const int q0 = (int)rintf(v[q][j][0] * sc), q1 = (int)rintf(v[q][j][1] * sc), q2 = (int)rintf(v[q][j][2] * sc), q3 = (int)rintf(v[q][j][3] * sc);
                        w = (int)((unsigned)(q0 & 255) | ((unsigned)(q1 & 255) << 8) | ((unsigned)(q2 & 255) << 16) | ((unsigned)q3 << 24)); }
                    else { w = __builtin_amdgcn_cvt_pk_fp8_f32(v[q][j][0] * sc, v[q][j][1] * sc, 0, false); w = __builtin_amdgcn_cvt_pk_fp8_f32(v[q][j][2] * sc, v[q][j][3] * sc, w, true); }
                    o8[((size_t)j * 16384 + e) * 64 + lane] = (unsigned)w; }
                if (lane == 0) ISC[(isu ? 0 : 16384) + e] = am[q] / top;
            }
        }
    }
    }
}

namespace att {
using bf16x8 = __attribute__((ext_vector_type(8))) short;
using s16x4 = __attribute__((ext_vector_type(4))) short;
using f32x16 = __attribute__((ext_vector_type(16))) float;
using u32x4 = __attribute__((ext_vector_type(4))) unsigned;
constexpr int SHM_V = 16384, SHM_K = 16384;
constexpr int L_V = 0, L_K = 2 * SHM_V, L_WS = L_K + 2 * SHM_K, L_P = L_WS + 8 * 64 * 4, L_END = L_P + 4 * 4096;
#define KSWZ(row, colB) ((row) * 256 + ((colB) ^ (((row) & 7) << 4)))
#define SBAR() __builtin_amdgcn_sched_barrier(0)
__device__ __forceinline__ int crow(int r, int hi) { return (r & 3) + 8 * (r >> 2) + 4 * hi; }
__device__ __forceinline__ unsigned cvtpk(float lo, float hi) { unsigned r; asm volatile("v_cvt_pk_bf16_f32 %0, %1, %2" : "=v"(r) : "v"(lo), "v"(hi)); return r; }
__device__ __forceinline__ int v_st(int k, int c) { const int kk = (k & ~0xC) | ((k & 4) << 1) | ((k & 8) >> 1); return ((kk >> 3) * 4 + (c >> 5)) * 512 + ((kk & 7) * 32 + (c & 31)) * 2; }
__device__ __forceinline__ int v_rd_base(int lane) { return ((lane & 3) << 3) | (((lane >> 2) & 3) << 6) | (((lane >> 4) & 1) << 5) | (((lane >> 5) & 1) << 8); }
constexpr int v_rd_off(int d0, int ks, int half) { return d0 * 512 + ks * 4096 + half * 2048; }
template <int OFF> __device__ __forceinline__ s16x4 tr_read(int vb) { s16x4 r; asm volatile("ds_read_b64_tr_b16 %0, %1 offset:%2" : "=&v"(r) : "v"(vb), "i"(OFF) : "memory"); return r; }
template <int D0> __device__ __forceinline__ void pv_one(f32x16& od, int vb, bf16x8 pa0, bf16x8 pa1, bf16x8 pa2, bf16x8 pa3) {
    const s16x4 l0 = tr_read<v_rd_off(D0, 0, 0)>(vb), h0 = tr_read<v_rd_off(D0, 0, 1)>(vb), l1 = tr_read<v_rd_off(D0, 1, 0)>(vb), h1 = tr_read<v_rd_off(D0, 1, 1)>(vb);
    const s16x4 l2 = tr_read<v_rd_off(D0, 2, 0)>(vb), h2 = tr_read<v_rd_off(D0, 2, 1)>(vb), l3 = tr_read<v_rd_off(D0, 3, 0)>(vb), h3 = tr_read<v_rd_off(D0, 3, 1)>(vb);
    asm volatile("s_waitcnt lgkmcnt(0)" ::: "memory"); SBAR();
#define PK(L, H) (bf16x8){L[0], L[1], L[2], L[3], H[0], H[1], H[2], H[3]}
    od = __builtin_amdgcn_mfma_f32_32x32x16_bf16(pa0, PK(l0, h0), od, 0, 0, 0);
    od = __builtin_amdgcn_mfma_f32_32x32x16_bf16(pa1, PK(l1, h1), od, 0, 0, 0);
    od = __builtin_amdgcn_mfma_f32_32x32x16_bf16(pa2, PK(l2, h2), od, 0, 0, 0);
    od = __builtin_amdgcn_mfma_f32_32x32x16_bf16(pa3, PK(l3, h3), od, 0, 0, 0);
#undef PK
}
__device__ __forceinline__ void qkt(f32x16& p0, f32x16& p1, const char* Ks, const bf16x8* qr, int r32, int hi, int comp) {
    p0 = f32x16{}; p1 = f32x16{};
#pragma unroll
    for (int d0 = 0; d0 < 4; ++d0) {
        const int cb = (comp * 64 + d0 * 16 + hi * 8) * 2;
        const bf16x8 b0 = *reinterpret_cast<const bf16x8*>(Ks + KSWZ(r32, cb));
        const bf16x8 b1 = *reinterpret_cast<const bf16x8*>(Ks + KSWZ(32 + r32, cb));
        p0 = __builtin_amdgcn_mfma_f32_32x32x16_bf16(b0, qr[d0], p0, 0, 0, 0);
        p1 = __builtin_amdgcn_mfma_f32_32x32x16_bf16(b1, qr[d0], p1, 0, 0, 0);
    }
}

__device__ __forceinline__ void attn_unit(int b, int h, int qb, const bf16_t* Z, bf16_t* MIX, float lam, const float* subln, char* lds) {
    const int tid = opaque_tid(), wid = __builtin_amdgcn_readfirstlane(tid >> 6), lane = tid & 63, r32 = lane & 31, hi = lane >> 5;
    const int comp = wid >> 2, rg = wid & 3;
    char* V_lds = lds + L_V; char* K_lds = lds + L_K;
    float* wsf = (float*)(lds + L_WS) + wid * 64;
    const int q0 = b * SEQ + qb * 128;
    const float NEGV = -1e30f;
    bf16x8 qr[4];
    {
        const bf16_t* Qw = Z + (size_t)(q0 + rg * 32 + r32) * NZ + ZQ + h * 128 + comp * 64 + hi * 8;
#pragma unroll
        for (int d0 = 0; d0 < 4; ++d0) qr[d0] = *reinterpret_cast<const bf16x8*>(Qw + d0 * 16);
    }
    const int NT = 2 * qb + 3;
    const int sr = tid >> 4, sc = (tid & 15) * 8;
    const int vst0 = v_st(sr, sc), vst1 = v_st(32 + sr, sc), kst0 = KSWZ(sr, sc * 2), kst1 = KSWZ(32 + sr, sc * 2);
    const int vb0 = (int)(uintptr_t)V_lds + v_rd_base(lane);
#define PK4(P, BASE, OUT) do { unsigned a0 = cvtpk(P[BASE + 0], P[BASE + 1]), a1 = cvtpk(P[BASE + 2], P[BASE + 3]); \
        unsigned b0 = cvtpk(P[BASE + 4], P[BASE + 5]), b1 = cvtpk(P[BASE + 6], P[BASE + 7]); \
        auto r0 = __builtin_amdgcn_permlane32_swap(a0, b0, false, false); auto r1 = __builtin_amdgcn_permlane32_swap(a1, b1, false, false); \
        u32x4 w = {r0[0], r1[0], r0[1], r1[1]}; OUT = *reinterpret_cast<bf16x8*>(&w); } while (0)
    bf16x8 vsA0, vsA1, ksA0, ksA1, vsB0, vsB1, ksB0, ksB1;
#define SLOAD(j, S) do { const size_t r0_ = (size_t)((j) == 0 ? META_TILE0 : b * SEQ + ((j) - 1) * 64) + sr; const bf16_t* zp_ = Z + r0_ * NZ + h * 128 + sc; \
        vs##S##0 = *reinterpret_cast<const bf16x8*>(zp_ + ZV); vs##S##1 = *reinterpret_cast<const bf16x8*>(zp_ + ZV + (size_t)32 * NZ); \
        ks##S##0 = *reinterpret_cast<const bf16x8*>(zp_ + ZK); ks##S##1 = *reinterpret_cast<const bf16x8*>(zp_ + ZK + (size_t)32 * NZ); } while (0)
#define SWRITE(bi, S) do { *reinterpret_cast<bf16x8*>(V_lds + (bi) * SHM_V + vst0) = vs##S##0; *reinterpret_cast<bf16x8*>(V_lds + (bi) * SHM_V + vst1) = vs##S##1; \
        *reinterpret_cast<bf16x8*>(K_lds + (bi) * SHM_K + kst0) = ks##S##0; *reinterpret_cast<bf16x8*>(K_lds + (bi) * SHM_K + kst1) = ks##S##1; } while (0)
    f32x16 o[4] = {}; float m_reg = NEGV, l_reg = 0.f;
    SLOAD(0, A); SWRITE(0, A); SLOAD(1, B); __syncthreads();
    const int qrel = rg * 32 + r32;
#define ATT_TILE(j, L_, W_) do { \
        const int cur = j & 1; \
        if (j + 2 < NT) SLOAD(j + 2, L_); \
        f32x16 p0, p1; \
        qkt(p0, p1, K_lds + cur * SHM_K, qr, r32, hi, comp); \
        if (j == 0) { \
    _Pragma("unroll") \
            for (int r = 0; r < 16; ++r) { p0[r] = NEGV; if (r < 8) p1[r] = NEGV; } \
        } else if (j >= NT - 2) { \
            const int kb0 = (j - (NT - 2)) * 64; \
    _Pragma("unroll") \
            for (int r = 0; r < 16; ++r) { const int kl = kb0 + crow(r, hi); if (kl > qrel) p0[r] = NEGV; if (kl + 32 > qrel) p1[r] = NEGV; } \
        } \
        float pmax = p0[0]; \
    _Pragma("unroll") \
        for (int r = 1; r < 16; ++r) pmax = fmaxf(pmax, p0[r]); \
    _Pragma("unroll") \
        for (int r = 0; r < 16; ++r) pmax = fmaxf(pmax, p1[r]); \
        { auto rr = __builtin_amdgcn_permlane32_swap(__float_as_uint(pmax), __float_as_uint(pmax), false, false); pmax = fmaxf(__uint_as_float(rr[0]), __uint_as_float(rr[1])); } \
        const float mn = fmaxf(m_reg, pmax); const float alpha = __builtin_amdgcn_exp2f(m_reg - mn); m_reg = mn; \
        float ps = 0.f; \
    _Pragma("unroll") \
        for (int r = 0; r < 16; ++r) { p0[r] = __builtin_amdgcn_exp2f(p0[r] - mn); ps += p0[r]; } \
    _Pragma("unroll") \
        for (int r = 0; r < 16; ++r) { p1[r] = __builtin_amdgcn_exp2f(p1[r] - mn); ps += p1[r]; } \
        { auto rr = __builtin_amdgcn_permlane32_swap(__float_as_uint(ps), __float_as_uint(ps), false, false); ps = __uint_as_float(rr[0]) + __uint_as_float(rr[1]); } \
        l_reg = l_reg * alpha + ps; \
        if (__any(alpha < 1.f)) { \
            if (hi == 0) wsf[r32] = alpha; \
            asm volatile("s_waitcnt lgkmcnt(0)" ::: "memory"); \
            float al[16]; \
    _Pragma("unroll") \
            for (int r = 0; r < 16; ++r) al[r] = wsf[crow(r, hi)]; \
    _Pragma("unroll") \
            for (int d = 0; d < 4; ++d) \
    _Pragma("unroll") \
                for (int r = 0; r < 16; ++r) o[d][r] *= al[r]; \
            asm volatile("s_waitcnt lgkmcnt(0)" ::: "memory"); \
        } \
        bf16x8 pa0, pa1, pa2, pa3; \
        PK4(p0, 0, pa0); PK4(p0, 8, pa1); PK4(p1, 0, pa2); PK4(p1, 8, pa3); \
        SBAR(); \
        { const int vb = vb0 + cur * SHM_V; \
          pv_one<0>(o[0], vb, pa0, pa1, pa2, pa3); pv_one<1>(o[1], vb, pa0, pa1, pa2, pa3); pv_one<2>(o[2], vb, pa0, pa1, pa2, pa3); pv_one<3>(o[3], vb, pa0, pa1, pa2, pa3); } \
        if (j + 1 < NT) SWRITE(cur ^ 1, W_); \
        __syncthreads(); \
    } while (0)
    {
        SLOAD(2, A);
        f32x16 p1 = f32x16{};
#pragma unroll
        for (int d0 = 0; d0 < 4; ++d0) {
            const int cb = (comp * 64 + d0 * 16 + hi * 8) * 2;
            const bf16x8 b1 = *reinterpret_cast<const bf16x8*>(K_lds + KSWZ(32 + r32, cb));
            p1 = __builtin_amdgcn_mfma_f32_32x32x16_bf16(b1, qr[d0], p1, 0, 0, 0);
        }
        float pmax = p1[8];
#pragma unroll
        for (int r = 9; r < 16; ++r) pmax = fmaxf(pmax, p1[r]);
        { auto rr = __builtin_amdgcn_permlane32_swap(__float_as_uint(pmax), __float_as_uint(pmax), false, false); pmax = fmaxf(__uint_as_float(rr[0]), __uint_as_float(rr[1])); }
        m_reg = pmax;
        float ps = 0.f;
#pragma unroll
        for (int r = 0; r < 8; ++r) p1[r] = 0.f;
#pragma unroll
        for (int r = 8; r < 16; ++r) { p1[r] = __builtin_amdgcn_exp2f(p1[r] - pmax); ps += p1[r]; }
        { auto rr = __builtin_amdgcn_permlane32_swap(__float_as_uint(ps), __float_as_uint(ps), false, false); ps = __uint_as_float(rr[0]) + __uint_as_float(rr[1]); }
        l_reg = ps;
        bf16x8 pa3; PK4(p1, 8, pa3);
        SBAR();
        {
#define PKF(L, H) (bf16x8){L[0], L[1], L[2], L[3], H[0], H[1], H[2], H[3]}
            const s16x4 l0 = tr_read<v_rd_off(0, 3, 0)>(vb0), h0 = tr_read<v_rd_off(0, 3, 1)>(vb0), l1 = tr_read<v_rd_off(1, 3, 0)>(vb0), h1 = tr_read<v_rd_off(1, 3, 1)>(vb0);
            const s16x4 l2 = tr_read<v_rd_off(2, 3, 0)>(vb0), h2 = tr_read<v_rd_off(2, 3, 1)>(vb0), l3 = tr_read<v_rd_off(3, 3, 0)>(vb0), h3 = tr_read<v_rd_off(3, 3, 1)>(vb0);
            asm volatile("s_waitcnt lgkmcnt(0)" ::: "memory"); SBAR();
            o[0] = __builtin_amdgcn_mfma_f32_32x32x16_bf16(pa3, PKF(l0, h0), o[0], 0, 0, 0); o[1] = __builtin_amdgcn_mfma_f32_32x32x16_bf16(pa3, PKF(l1, h1), o[1], 0, 0, 0);
            o[2] = __builtin_amdgcn_mfma_f32_32x32x16_bf16(pa3, PKF(l2, h2), o[2], 0, 0, 0); o[3] = __builtin_amdgcn_mfma_f32_32x32x16_bf16(pa3, PKF(l3, h3), o[3], 0, 0, 0);
#undef PKF
        }
        SWRITE(1, B);
        __syncthreads();
    }
    for (int j = 1; j < NT; j += 2) { ATT_TILE(j, B, A); ATT_TILE(j + 1, A, B); }
#undef ATT_TILE
#undef SLOAD
#undef SWRITE
#undef PK4
    if (hi == 0) wsf[r32] = l_reg;
    asm volatile("s_waitcnt lgkmcnt(0)" ::: "memory");
    float rli[16];
#pragma unroll
    for (int r = 0; r < 16; ++r) rli[r] = __builtin_amdgcn_rcpf(wsf[crow(r, hi)]);
    float* X = (float*)lds + rg * 4096;
    if (comp == 1) {
#pragma unroll
        for (int d0 = 0; d0 < 4; ++d0)
#pragma unroll
            for (int r = 0; r < 16; ++r) X[(d0 * 16 + r) * 64 + lane] = o[d0][r] * rli[r] * lam;
    }
    __syncthreads();
    if (comp == 0) {
        float ssr[16];
#pragma unroll
        for (int r = 0; r < 16; ++r) ssr[r] = 0.f;
#pragma unroll
        for (int d0 = 0; d0 < 4; ++d0)
#pragma unroll
            for (int r = 0; r < 16; ++r) { const float v = o[d0][r] * rli[r] - X[(d0 * 16 + r) * 64 + lane]; o[d0][r] = v; ssr[r] += v * v; }
        float* P = (float*)(lds + L_P) + rg * 1024;
#pragma unroll
        for (int r = 0; r < 16; ++r) P[r * 64 + lane] = ssr[r];
        asm volatile("s_waitcnt lgkmcnt(0)" ::: "memory");
        {
            const int rho = lane & 31, hh = (rho >> 2) & 1, rr = (rho & 3) + 4 * (rho >> 3);
            const float4* pp = (const float4*)(P + rr * 64 + hh * 32 + (lane >> 5) * 16);
            const float4 a0 = pp[0], a1 = pp[1], a2 = pp[2], a3 = pp[3];
            float s = ((a0.x + a0.y) + (a0.z + a0.w)) + ((a1.x + a1.y) + (a1.z + a1.w)) + ((a2.x + a2.y) + (a2.z + a2.w)) + ((a3.x + a3.y) + (a3.z + a3.w));
            auto sw = __builtin_amdgcn_permlane32_swap(__float_as_uint(s), __float_as_uint(s), false, false); s = __uint_as_float(sw[0]) + __uint_as_float(sw[1]);
            if (lane < 32) wsf[32 + rho] = rsqrtf(s * (1.f / 128.f) + EPS) * (1.f - LAMBDA_INIT);
        }
        asm volatile("s_waitcnt lgkmcnt(0)" ::: "memory");
        float sw4[4];
#pragma unroll
        for (int d0 = 0; d0 < 4; ++d0) sw4[d0] = subln[d0 * 32 + r32];
        bf16_t* Ow = MIX + (size_t)(q0 + rg * 32) * DM + h * 128 + r32;
#pragma unroll
        for (int r = 0; r < 16; ++r) {
            const int orow = crow(r, hi); const float rs = wsf[32 + orow];
#pragma unroll
            for (int d0 = 0; d0 < 4; ++d0) Ow[(size_t)orow * DM + d0 * 32] = (bf16_t)f2bf(o[d0][r] * rs * sw4[d0]);
        }
    }
    __syncthreads();
}
#undef KSWZ
#undef SBAR
}

__device__ __forceinline__ float attn_lambda(const Args& a) {
    const int lane = opaque_tid() & 63;
    const float l1 = wave_sum(a.lamqk[lane] * a.lamqk[64 + lane]), l2 = wave_sum(a.lamqk[128 + lane] * a.lamqk[192 + lane]);
    return expf(l1) - expf(l2) + LAMBDA_INIT;
}
namespace mls {
using bf16x8 = __attribute__((ext_vector_type(8))) short;
using bf16x4 = __attribute__((ext_vector_type(4))) short;
using s16x4 = __attribute__((ext_vector_type(4))) short;
using f32x16 = __attribute__((ext_vector_type(16))) float;
using f32x4v = __attribute__((ext_vector_type(4))) float;
using u32x4v = __attribute__((ext_vector_type(4))) unsigned;
using u32x2v = __attribute__((ext_vector_type(2))) unsigned;
constexpr int L_QS = 0, L_QP = 16384, L_KS = 32768, L_KW = 49152, L_VT = 65536, L_PT = 98304, L_HT = 106496, HT_STRIDE = 528;
constexpr int L_MISC = L_HT + 64 * HT_STRIDE;
constexpr int L_RS = L_MISC, L_QN = L_RS + 2 * 64 * 4, L_NV = L_QN + 64 * 4, L_NP = L_NV + 128 * 4, L_CW = L_NP + 8 * 128 * 4, L_RD = L_CW + 5 * 256 * 4, L_NW = L_RD + 8 * 64 * 4, L_END = L_NW + 8 * 36 * 4;
#define KSWZ(row, colB) ((row) * 256 + ((colB) ^ (((row) & 7) << 4)))
#define PSWZ(row, colB) ((row) * 128 + ((colB) ^ ((((row) >> 1) & 7) << 4)))
__device__ __forceinline__ int crow(int r, int hi) { return (r & 3) + 8 * (r >> 2) + 4 * hi; }
__device__ __forceinline__ unsigned cvtpk(float lo, float hi) { unsigned r; asm volatile("v_cvt_pk_bf16_f32 %0, %1, %2" : "=v"(r) : "v"(lo), "v"(hi)); return r; }
__device__ __forceinline__ int v_st(int k, int c) { const int kk = (k & ~0xC) | ((k & 4) << 1) | ((k & 8) >> 1); return ((kk >> 3) * 4 + (c >> 5)) * 512 + ((kk & 7) * 32 + (c & 31)) * 2; }
__device__ __forceinline__ int v_rd_base(int lane) { return ((lane & 3) << 3) | (((lane >> 2) & 3) << 6) | (((lane >> 4) & 1) << 5) | (((lane >> 5) & 1) << 8); }
__device__ __forceinline__ s16x4 tr_read_dyn(int addr) { s16x4 r; asm volatile("ds_read_b64_tr_b16 %0, %1" : "=&v"(r) : "v"(addr) : "memory"); return r; }
__device__ __forceinline__ bf16x8 tr_frag(int img_plus_base, int d0, int ks) {
    const s16x4 lo = tr_read_dyn(img_plus_base + d0 * 512 + ks * 4096), hi = tr_read_dyn(img_plus_base + d0 * 512 + ks * 4096 + 2048);
    return (bf16x8){lo[0], lo[1], lo[2], lo[3], hi[0], hi[1], hi[2], hi[3]};
}
template <int CTRL, int RMASK> __device__ __forceinline__ float dppf(float old, float v) { return __builtin_bit_cast(float, __builtin_amdgcn_update_dpp(__builtin_bit_cast(int, old), __builtin_bit_cast(int, v), CTRL, RMASK, 0xf, false)); }
__device__ __forceinline__ float scan_add(float v) {
    v += dppf<0x111, 0xf>(0.f, v); v += dppf<0x112, 0xf>(0.f, v); v += dppf<0x114, 0xf>(0.f, v); v += dppf<0x118, 0xf>(0.f, v);
    v += dppf<0x142, 0xa>(0.f, v); v += dppf<0x143, 0xc>(0.f, v); return v;
}
__device__ __forceinline__ float scan_max(float v) {
    const float NI = -3.0e38f;
    v = fmaxf(v, dppf<0x111, 0xf>(NI, v)); v = fmaxf(v, dppf<0x112, 0xf>(NI, v)); v = fmaxf(v, dppf<0x114, 0xf>(NI, v)); v = fmaxf(v, dppf<0x118, 0xf>(NI, v));
    v = fmaxf(v, dppf<0x142, 0xa>(NI, v)); v = fmaxf(v, dppf<0x143, 0xc>(NI, v)); return v;
}
__device__ __forceinline__ float rlane(float v, int l) { return __uint_as_float(__builtin_amdgcn_readlane(__float_as_uint(v), l)); }
__device__ __forceinline__ float silu(float x) { return x * __builtin_amdgcn_rcpf(1.f + __expf(-x)); }
__device__ __forceinline__ void fmac_v(float& y, float a, float b) { asm("v_fmac_f32 %0, %1, %2" : "+v"(y) : "v"(a), "v"(b)); }
__device__ __forceinline__ float mul_v(float a, float b) { float r; asm("v_mul_f32 %0, %1, %2" : "=v"(r) : "v"(a), "v"(b)); return r; }

__device__ __forceinline__ void mlstm_item(int b, int h, const Args& a, char* lds) {
    const int tid0 = opaque_tid(), wid = __builtin_amdgcn_readfirstlane(tid0 >> 6);
    const bf16_t* Z = (const bf16_t*)(a.ws + WS_Z); const float* G = (const float*)(a.ws + WS_GATES); bf16_t* MIX = (bf16_t*)(a.ws + WS_MIX);
    const int ldsb = (int)(uintptr_t)lds;
    float* RS = (float*)(lds + L_RS); float* QN = (float*)(lds + L_QN); float* NV = (float*)(lds + L_NV); float* NP = (float*)(lds + L_NP); float* CW = (float*)(lds + L_CW);
    for (int i = tid0; i < 5 * 256; i += NTHREADS) { const int j = i >> 8, c = i & 255; const int cc = c < 128 ? h * 128 + c : 512 + h * 128 + (c - 128); CW[i] = j < 4 ? a.convw[j * 1024 + cc] : a.convb[cc]; }
    if (tid0 < 128) NV[tid0] = 0.f;
    if (tid0 < 256) ((float*)(lds + L_NW))[(tid0 >> 5) * 36 + (tid0 & 31)] = a.mnw[h * 256 + tid0];
    const float ibh = a.ib[h], fbh = a.fb[h];
    float cw[4][4], cb[4];
    __syncthreads();
    { const int c4 = 4 * (tid0 & 63);
#pragma unroll
    for (int j = 0; j < 4; ++j)
#pragma unroll
        for (int q = 0; q < 4; ++q) cw[j][q] = CW[j * 256 + c4 + q];
#pragma unroll
    for (int q = 0; q < 4; ++q) cb[q] = CW[4 * 256 + c4 + q]; }
    f32x16 C[4] = {};
    float m_prev = -1e30f;
    u32x2v rq[11]; u32x4v rv[4]; float gi, gf;
    auto chunk_row0 = [&](int c) -> int { return c == 0 ? META_TILE0 : b * SEQ + (c - 1) * 64; };
#define LOAD_RAW(c) do { int tq_ = tid0; asm volatile("" : "+v"(tq_)); const int ln_ = tq_ & 63, c4_ = 4 * ln_, zc_qk = (c4_ < 128 ? ZMQ + h * 128 + c4_ : ZMK + h * 128 + (c4_ - 128)), erow = tq_ >> 3, eseg = tq_ & 7; const int r0_ = chunk_row0(c); \
        _Pragma("unroll") for (int i_ = 0; i_ < 11; ++i_) { const int t_ = 8 * wid - 3 + i_; int row_; bool ok_ = true; \
            if (t_ >= 0) row_ = r0_ + t_; else if ((c) == 0) { row_ = 0; ok_ = false; } else if ((c) == 1) row_ = META_TILE0 + 64 + t_; else row_ = r0_ + t_; \
            rq[i_] = ok_ ? *(const u32x2v*)(Z + (size_t)row_ * NZ + zc_qk) : (u32x2v){0u, 0u}; } \
        _Pragma("unroll") for (int i_ = 0; i_ < 4; ++i_) rv[i_] = *(const u32x4v*)(Z + (size_t)(r0_ + erow) * NZ + ZMV + h * 256 + eseg * 32 + 8 * i_); \
        { const int rowg_ = r0_ + ln_; gi = G[(size_t)rowg_ * 8 + h]; gf = G[(size_t)rowg_ * 8 + 4 + h]; } } while (0)
    LOAD_RAW(0);
    const int NCH = 33;
    for (int c = 0; c < NCH; ++c) {
        int tid = tid0; asm volatile("" : "+v"(tid));
        const int lane = tid & 63, r32 = lane & 31, hi = lane >> 5, cq = lane, c4 = 4 * cq, erow = tid >> 3, eseg = tid & 7;
        float* RD = (float*)(lds + L_RD) + wid * 64;
        float li = gi + ibh; float lf; { const float xf = gf + fbh; lf = fminf(xf, 0.f) - __logf(1.f + __expf(-fabsf(xf))); }
        if (c == 0 && lane < 48) { li = -1e30f; lf = 0.f; }
        const float bsum = scan_add(lf);
        const float u = li - bsum;
        const float cm = scan_max(u);
        const float Mrow = fmaxf(cm, m_prev);
        const float iw = __expf(m_prev - Mrow);
        const float Mend = rlane(Mrow, 63), gtot = rlane(bsum, 63);
        const float wrow = __expf(u - Mend);
        const float dec = __expf(m_prev - Mend);
        const float dexp = __expf(-(bsum + Mrow));
        {
            float qn_part[8], ksum[4] = {0.f, 0.f, 0.f, 0.f};
            float nvv[4];
#pragma unroll
            for (int q = 0; q < 4; ++q) nvv[q] = (cq < 32) ? NV[c4 + q] : 0.f;
#pragma unroll
            for (int i = 0; i < 8; ++i) {
                const int t = 8 * wid + i;
                float xo[4];
#pragma unroll
                for (int q = 0; q < 4; ++q) xo[q] = cb[q];
#pragma unroll
                for (int j = 0; j < 4; ++j) {
                    const u32x2v rr = rq[i + j];
                    fmac_v(xo[0], cw[j][0], bf_lo(rr.x)); fmac_v(xo[1], cw[j][1], bf_hi(rr.x)); fmac_v(xo[2], cw[j][2], bf_lo(rr.y)); fmac_v(xo[3], cw[j][3], bf_hi(rr.y));
                }
#pragma unroll
                for (int q = 0; q < 4; ++q) xo[q] = silu(xo[q]);
                const float iw_t = rlane(iw, t), w_t = rlane(wrow, t);
                if (cq < 32) {
#pragma unroll
                    for (int q = 0; q < 4; ++q) xo[q] = mul_v(xo[q], 0.08838834764831845f);
                    *(uint2*)(lds + L_QS + KSWZ(t, c4 * 2)) = make_uint2(cvtpk(xo[0], xo[1]), cvtpk(xo[2], xo[3]));
                    float qd = 0.f;
#pragma unroll
                    for (int q = 0; q < 4; ++q) { fmac_v(qd, xo[q], nvv[q]); xo[q] = mul_v(xo[q], iw_t); }
                    *(uint2*)(lds + L_QP + KSWZ(t, c4 * 2)) = make_uint2(cvtpk(xo[0], xo[1]), cvtpk(xo[2], xo[3]));
                    qn_part[i] = iw_t * qd;
                } else {
                    const int kc = c4 - 128;
                    *(uint2*)(lds + L_KS + KSWZ(t, kc * 2)) = make_uint2(cvtpk(xo[0], xo[1]), cvtpk(xo[2], xo[3]));
#pragma unroll
                    for (int q = 0; q < 4; ++q) { xo[q] = mul_v(xo[q], w_t); ksum[q] += xo[q]; }
                    *(uint2*)(lds + L_KW + v_st(t, kc)) = make_uint2(cvtpk(xo[0], xo[1]), cvtpk(xo[2], xo[3]));
                    qn_part[i] = 0.f;
                }
                __builtin_amdgcn_sched_barrier(0);
            }
            {
                float r4[4], r2[2], r1;
                { const bool hb = (lane & 16) != 0;
#pragma unroll
                  for (int i = 0; i < 4; ++i) { const float send = hb ? qn_part[i] : qn_part[i + 4]; const float recv = __shfl_xor(send, 16); r4[i] = (hb ? qn_part[i + 4] : qn_part[i]) + recv; } }
                { const bool hb = (lane & 8) != 0;
#pragma unroll
                  for (int i = 0; i < 2; ++i) { const float send = hb ? r4[i] : r4[i + 2]; const float recv = __shfl_xor(send, 8); r2[i] = (hb ? r4[i + 2] : r4[i]) + recv; } }
                { const bool hb = (lane & 4) != 0; const float send = hb ? r2[0] : r2[1]; const float recv = __shfl_xor(send, 4); r1 = (hb ? r2[1] : r2[0]) + recv; }
                r1 += __shfl_xor(r1, 2); r1 += __shfl_xor(r1, 1);
                if (lane < 32 && (lane & 3) == 0) QN[8 * wid + ((lane >> 4) & 1) * 4 + ((lane >> 3) & 1) * 2 + ((lane >> 2) & 1)] = r1;
            }
            if (cq >= 32) {
#pragma unroll
                for (int q = 0; q < 4; ++q) NP[wid * 128 + (c4 - 128) + q] = ksum[q];
            }
#pragma unroll
            for (int i = 0; i < 4; ++i) *(u32x4v*)(lds + L_VT + (eseg >> 2) * 16384 + v_st(erow, (eseg & 3) * 32 + 8 * i)) = rv[i];
        }
        u32x4v zo[4];
        {
            const int r0 = chunk_row0(c);
#pragma unroll
            for (int i = 0; i < 4; ++i) zo[i] = *(const u32x4v*)(Z + (size_t)(r0 + erow) * NZ + ZMO + h * 256 + eseg * 32 + 8 * i);
        }
        if (c + 1 < NCH) LOAD_RAW(c + 1);
        __syncthreads();
        {
            const int tb = wid >> 1, half = wid & 1;
            float rsum[4] = {0.f, 0.f, 0.f, 0.f};
            const int fr = lane & 15, fq = lane >> 4;
            float Mt[4];
#pragma unroll
            for (int i = 0; i < 4; ++i) Mt[i] = __shfl(Mrow, 16 * tb + 4 * fq + i);
#pragma unroll
            for (int sj = 0; sj < 2; ++sj) {
                const int sb = 2 * half + sj;
                unsigned short pw[4] = {0, 0, 0, 0};
                if (sb <= tb) {
                    f32x4v acc = {0.f, 0.f, 0.f, 0.f};
#pragma unroll
                    for (int ks = 0; ks < 4; ++ks) {
                        const bf16x8 af = *(const bf16x8*)(lds + L_QS + KSWZ(16 * tb + fr, (32 * ks + 8 * fq) * 2));
                        const bf16x8 bfr = *(const bf16x8*)(lds + L_KS + KSWZ(16 * sb + fr, (32 * ks + 8 * fq) * 2));
                        acc = __builtin_amdgcn_mfma_f32_16x16x32_bf16(af, bfr, acc, 0, 0, 0);
                    }
                    const int s = 16 * sb + fr; const float us = __shfl(u, s);
#pragma unroll
                    for (int i = 0; i < 4; ++i) {
                        const int t = 16 * tb + 4 * fq + i;
                        const float p = (s <= t) ? acc[i] * __expf(us - Mt[i]) : 0.f;
                        rsum[i] += p; pw[i] = (unsigned short)f2bf(p);
                    }
                }
#pragma unroll
                for (int i = 0; i < 4; ++i) *(unsigned short*)(lds + L_PT + PSWZ(16 * tb + 4 * fq + i, (16 * sb + fr) * 2)) = pw[i];
            }
#pragma unroll
            for (int i = 0; i < 4; ++i) {
                float v = rsum[i];
                v += __shfl_xor(v, 1); v += __shfl_xor(v, 2); v += __shfl_xor(v, 4); v += __shfl_xor(v, 8);
                if (fr == 0) RS[half * 64 + 16 * tb + 4 * fq + i] = v;
            }
        }
        __syncthreads();
        {
            const float nq = RS[lane] + RS[64 + lane] + QN[lane];
            RD[lane] = __builtin_amdgcn_rcpf(fmaxf(fabsf(nq), dexp));
            bf16x8 vf[4];
            const int vimg = ldsb + L_VT + (wid >> 2) * 16384 + v_rd_base(lane);
#pragma unroll
            for (int ks = 0; ks < 4; ++ks) vf[ks] = tr_frag(vimg, wid & 3, ks);
            asm volatile("s_waitcnt lgkmcnt(0)" ::: "memory"); __builtin_amdgcn_sched_barrier(0);
            f32x16 acc[2] = {};
#pragma unroll
            for (int rb = 0; rb < 2; ++rb) {
                const int row = 32 * rb + r32;
#pragma unroll
                for (int ks = 0; ks < 4; ++ks) {
                    if (rb == 0 && ks >= 2) continue;
                    const bf16x8 pf = *(const bf16x8*)(lds + L_PT + PSWZ(row, (16 * ks + 8 * hi) * 2));
                    acc[rb] = __builtin_amdgcn_mfma_f32_32x32x16_bf16(pf, vf[ks], acc[rb], 0, 0, 0);
                }
            }
#pragma unroll
            for (int kb = 0; kb < 4; ++kb)
#pragma unroll
                for (int sp = 0; sp < 2; ++sp) {
                    bf16x8 cf; { unsigned w0 = cvtpk(C[kb][8 * sp + 0], C[kb][8 * sp + 1]), w1 = cvtpk(C[kb][8 * sp + 2], C[kb][8 * sp + 3]), w2 = cvtpk(C[kb][8 * sp + 4], C[kb][8 * sp + 5]), w3 = cvtpk(C[kb][8 * sp + 6], C[kb][8 * sp + 7]);
                        typedef unsigned u32x4_ __attribute__((ext_vector_type(4))); u32x4_ ww = {w0, w1, w2, w3}; cf = __builtin_bit_cast(bf16x8, ww); }
                    const int base = 32 * kb + 16 * sp;
#pragma unroll
                    for (int rb = 0; rb < 2; ++rb) {
                        const int row = 32 * rb + r32;
                        const bf16x4 q0 = *(const bf16x4*)(lds + L_QP + KSWZ(row, (base + 4 * hi) * 2));
                        const bf16x4 q1 = *(const bf16x4*)(lds + L_QP + KSWZ(row, (base + 8 + 4 * hi) * 2));
                        const bf16x8 qf = {q0[0], q0[1], q0[2], q0[3], q1[0], q1[1], q1[2], q1[3]};
                        acc[rb] = __builtin_amdgcn_mfma_f32_32x32x16_bf16(qf, cf, acc[rb], 0, 0, 0);
                    }
                }
            asm volatile("s_waitcnt lgkmcnt(0)" ::: "memory");
#pragma unroll
            for (int rb = 0; rb < 2; ++rb)
#pragma unroll
                for (int r = 0; r < 16; ++r) {
                    const int row = 32 * rb + crow(r, hi);
                    *(unsigned short*)(lds + L_HT + row * HT_STRIDE + (32 * wid + r32) * 2) = (unsigned short)f2bf(acc[rb][r] * RD[row]);
                }
#pragma unroll
            for (int kb = 0; kb < 4; ++kb) {
#pragma unroll
                for (int r = 0; r < 16; ++r) C[kb][r] *= dec;
                const int kimg = ldsb + L_KW + v_rd_base(lane);
                bf16x8 kf[4];
#pragma unroll
                for (int ks = 0; ks < 4; ++ks) kf[ks] = tr_frag(kimg, kb, ks);
                asm volatile("s_waitcnt lgkmcnt(0)" ::: "memory"); __builtin_amdgcn_sched_barrier(0);
#pragma unroll
                for (int ks = 0; ks < 4; ++ks) C[kb] = __builtin_amdgcn_mfma_f32_32x32x16_bf16(kf[ks], vf[ks], C[kb], 0, 0, 0);
            }
            if (tid < 128) { float s = NV[tid] * dec;
#pragma unroll
                for (int w8 = 0; w8 < 8; ++w8) s += NP[w8 * 128 + tid];
                NV[tid] = s; }
        }
        m_prev = gtot + Mend;
        __syncthreads();
        if (c > 0) {
            float hv[32]; float ss = 0.f;
#pragma unroll
            for (int i = 0; i < 4; ++i) {
                const uint4 w = *(const uint4*)(lds + L_HT + erow * HT_STRIDE + eseg * 64 + 16 * i);
                hv[8 * i + 0] = bf_lo(w.x); hv[8 * i + 1] = bf_hi(w.x); hv[8 * i + 2] = bf_lo(w.y); hv[8 * i + 3] = bf_hi(w.y);
                hv[8 * i + 4] = bf_lo(w.z); hv[8 * i + 5] = bf_hi(w.z); hv[8 * i + 6] = bf_lo(w.w); hv[8 * i + 7] = bf_hi(w.w);
            }
#pragma unroll
            for (int i = 0; i < 32; ++i) ss += hv[i] * hv[i];
            ss += __shfl_xor(ss, 1); ss += __shfl_xor(ss, 2); ss += __shfl_xor(ss, 4);
            const float rstd = rsqrtf(ss * (1.f / 256.f) + EPS);
            const float* nw = (const float*)(lds + L_NW) + eseg * 36;
            bf16_t* op = MIX + (size_t)(chunk_row0(c) + erow) * DM + 1024 + h * 256 + eseg * 32;
#pragma unroll
            for (int i = 0; i < 4; ++i) {
                const unsigned zz[4] = {zo[i].x, zo[i].y, zo[i].z, zo[i].w};
                unsigned ow[4];
#pragma unroll
                for (int q = 0; q < 4; ++q) {
                    const float z0 = bf_lo(zz[q]), z1 = bf_hi(zz[q]);
                    const float o0 = hv[8 * i + 2 * q] * rstd * nw[8 * i + 2 * q] * __builtin_amdgcn_rcpf(1.f + __expf(-z0));
                    const float o1 = hv[8 * i + 2 * q + 1] * rstd * nw[8 * i + 2 * q + 1] * __builtin_amdgcn_rcpf(1.f + __expf(-z1));
                    ow[q] = pk2(o0, o1);
                }
                *(uint4*)(op + 8 * i) = make_uint4(ow[0], ow[1], ow[2], ow[3]);
            }
        }
    }
#undef LOAD_RAW
    __syncthreads();
}
#undef KSWZ
#undef PSWZ
}

namespace rt {
using bf16x8 = __attribute__((ext_vector_type(8))) short;
using f32x16 = __attribute__((ext_vector_type(16))) float;
#define CE(a, b) do { const unsigned x_ = (a), y_ = (b); (a) = x_ > y_ ? x_ : y_; (b) = x_ > y_ ? y_ : x_; } while (0)
#define SORT16_DESC(V) do { CE(V[0], V[1]); CE(V[2], V[3]); CE(V[0], V[2]); CE(V[1], V[3]); CE(V[1], V[2]); CE(V[4], V[5]); CE(V[6], V[7]); CE(V[4], V[6]); CE(V[5], V[7]); CE(V[5], V[6]); CE(V[0], V[4]); CE(V[2], V[6]); CE(V[2], V[4]); CE(V[1], V[5]); CE(V[3], V[7]); CE(V[3], V[5]); CE(V[1], V[2]); CE(V[3], V[4]); CE(V[5], V[6]); CE(V[8], V[9]); CE(V[10], V[11]); CE(V[8], V[10]); CE(V[9], V[11]); CE(V[9], V[10]); CE(V[12], V[13]); CE(V[14], V[15]); CE(V[12], V[14]); CE(V[13], V[15]); CE(V[13], V[14]); CE(V[8], V[12]); CE(V[10], V[14]); CE(V[10], V[12]); CE(V[9], V[13]); CE(V[11], V[15]); CE(V[11], V[13]); CE(V[9], V[10]); CE(V[11], V[12]); CE(V[13], V[14]); CE(V[0], V[8]); CE(V[4], V[12]); CE(V[4], V[8]); CE(V[2], V[10]); CE(V[6], V[14]); CE(V[6], V[10]); CE(V[2], V[4]); CE(V[6], V[8]); CE(V[10], V[12]); CE(V[1], V[9]); CE(V[5], V[13]); CE(V[5], V[9]); CE(V[3], V[11]); CE(V[7], V[15]); CE(V[7], V[11]); CE(V[3], V[5]); CE(V[7], V[9]); CE(V[11], V[13]); CE(V[1], V[2]); CE(V[3], V[4]); CE(V[5], V[6]); CE(V[7], V[8]); CE(V[9], V[10]); CE(V[11], V[12]); CE(V[13], V[14]); } while (0)
#define BMERGE16_DESC(V) do { CE(V[0], V[8]); CE(V[1], V[9]); CE(V[2], V[10]); CE(V[3], V[11]); CE(V[4], V[12]); CE(V[5], V[13]); CE(V[6], V[14]); CE(V[7], V[15]); CE(V[0], V[4]); CE(V[1], V[5]); CE(V[2], V[6]); CE(V[3], V[7]); CE(V[8], V[12]); CE(V[9], V[13]); CE(V[10], V[14]); CE(V[11], V[15]); CE(V[0], V[2]); CE(V[1], V[3]); CE(V[4], V[6]); CE(V[5], V[7]); CE(V[8], V[10]); CE(V[9], V[11]); CE(V[12], V[14]); CE(V[13], V[15]); CE(V[0], V[1]); CE(V[2], V[3]); CE(V[4], V[5]); CE(V[6], V[7]); CE(V[8], V[9]); CE(V[10], V[11]); CE(V[12], V[13]); CE(V[14], V[15]); } while (0)

#define TOP16(A, B) do { _Pragma("unroll") for (int i_ = 0; i_ < 16; ++i_) { const unsigned x_ = A[i_], y_ = B[15 - i_]; A[i_] = x_ > y_ ? x_ : y_; } BMERGE16_DESC(A); } while (0)
__device__ __forceinline__ unsigned ord_key(float f) { const unsigned u = __float_as_uint(f); return u ^ (((unsigned)((int)u >> 31)) | 0x80000000u); }
__device__ __forceinline__ float ord_val(unsigned k) { return __uint_as_float((k & 0x80000000u) ? (k ^ 0x80000000u) : ~k); }
__device__ __forceinline__ int crow(int r, int hi) { return (r & 3) + 8 * (r >> 2) + 4 * hi; }

__device__ __forceinline__ void route_item(int tb, int h, const bf16_t* QP, const bf16_t* SKB, const float* SSQ, int* IDX, float* GATE, int* scr, int lane_in) {
    int lane = lane_in; asm volatile("" : "+v"(lane));
    const int tok = lane & 31, hi = lane >> 5;
    const int row = tb * 32 + tok;
    float rstd;
    { const float4* sp = (const float4*)(SSQ + (size_t)row * 32); float s = 0.f;
#pragma unroll
      for (int i = 0; i < 8; ++i) { const float4 v = sp[i]; s += (v.x + v.y) + (v.z + v.w); }
      rstd = rsqrtf(s * (1.f / DM) + EPS); }
    unsigned top[2][16];
    bf16x8 qf[8], af[2][8];
    unsigned T[16];
#define RT_LOADQ(p_) do { const bf16_t* qp_ = QP + (size_t)row * DM + h * 256 + (p_) * 128 + hi * 8; \
        _Pragma("unroll") for (int ks = 0; ks < 8; ++ks) qf[ks] = *reinterpret_cast<const bf16x8*>(qp_ + ks * 16); } while (0)
#define RT_LOADK(b_, i_) do { const bf16_t* kp_ = SKB + ((size_t)((h * 2 + ((i_) >> 2)) * 128 + ((i_) & 3) * 32 + tok)) * 128 + hi * 8; \
        _Pragma("unroll") for (int ks = 0; ks < 8; ++ks) af[b_][ks] = *reinterpret_cast<const bf16x8*>(kp_ + ks * 16); } while (0)
    RT_LOADQ(0); RT_LOADK(0, 0);
#pragma unroll
    for (int i = 0; i < 8; ++i) {
        const int p = i >> 2, kb = i & 3;
        if (i + 1 < 8) RT_LOADK((i + 1) & 1, i + 1);
        f32x16 acc = {};
#pragma unroll
        for (int ks = 0; ks < 8; ++ks) acc = __builtin_amdgcn_mfma_f32_32x32x16_bf16(af[i & 1][ks], qf[ks], acc, 0, 0, 0);
        unsigned K[16];
#pragma unroll
        for (int r = 0; r < 16; ++r) { const int low = 127 - (32 * kb + (r & 3) + 8 * (r >> 2)) - 4 * hi; K[r] = (ord_key(acc[r]) & ~127u) | (unsigned)low; }
        if (i == 3) RT_LOADQ(1);
        SORT16_DESC(K);
        if (kb == 0) {
#pragma unroll
            for (int j = 0; j < 16; ++j) T[j] = K[j];
        } else { TOP16(T, K); }
        if (kb == 3) {
            unsigned O[16];
#pragma unroll
            for (int j = 0; j < 16; ++j) { auto rr = __builtin_amdgcn_permlane32_swap(T[j], T[j], false, false); O[j] = hi ? rr[0] : rr[1]; }
            TOP16(T, O);
#pragma unroll
            for (int j = 0; j < 16; ++j) top[p][j] = T[j];
        }
        __builtin_amdgcn_sched_barrier(0);
    }
#undef RT_LOADQ
#undef RT_LOADK
    float s1[16], s2[16];
#pragma unroll
    for (int i = 0; i < 16; ++i) {
        s1[i] = ord_val(top[0][i] & ~127u) * rstd; s2[i] = ord_val(top[1][i] & ~127u) * rstd;
        scr[i * 64 + lane] = 127 - (int)(top[0][i] & 127u); scr[(16 + i) * 64 + lane] = 127 - (int)(top[1][i] & 127u);
    }
#define CKEY(a_, b_) ((ord_key(s1[a_] + s2[b_]) & ~255u) | (unsigned)(255 - (16 * (a_) + (b_))))
    unsigned A[16], B[16], Cg[16];
#pragma unroll
    for (int b_ = 0; b_ < 16; ++b_) A[b_] = CKEY(0, b_);
#pragma unroll
    for (int b_ = 0; b_ < 8; ++b_) { B[b_] = CKEY(1, b_); B[8 + b_] = CKEY(15 - b_, 0); }
    BMERGE16_DESC(B);
    Cg[0] = CKEY(2, 0); Cg[1] = CKEY(2, 1); Cg[2] = CKEY(2, 2); Cg[3] = CKEY(2, 3); Cg[4] = CKEY(2, 4);
    Cg[5] = CKEY(3, 0); Cg[6] = CKEY(3, 1); Cg[7] = CKEY(3, 2); Cg[8] = CKEY(3, 3);
    Cg[9] = CKEY(4, 0); Cg[10] = CKEY(4, 1); Cg[11] = CKEY(4, 2);
    Cg[12] = CKEY(5, 0); Cg[13] = CKEY(5, 1); Cg[14] = CKEY(6, 0); Cg[15] = CKEY(6, 1);
    SORT16_DESC(Cg);
    { const unsigned d0 = CKEY(7, 0), d1 = CKEY(7, 1); Cg[15] = Cg[15] > d0 ? Cg[15] : d0; Cg[14] = Cg[14] > d1 ? Cg[14] : d1; BMERGE16_DESC(Cg); }
    TOP16(A, B); TOP16(A, Cg);
#undef CKEY
    asm volatile("s_waitcnt lgkmcnt(0)" ::: "memory");
    float e[16]; float z = 0.f; const float mx = ord_val(A[0] & ~255u);
#pragma unroll
    for (int j = 0; j < 16; ++j) { e[j] = __expf(ord_val(A[j] & ~255u) - mx); z += e[j]; }
    const float rz = 1.f / z;
    int* ip = IDX + (size_t)row * 128 + h * 16 + hi * 8; float* gp = GATE + (size_t)row * 128 + h * 16 + hi * 8;
    int oi[8] = {0, 0, 0, 0, 0, 0, 0, 0}; float og[8] = {0.f, 0.f, 0.f, 0.f, 0.f, 0.f, 0.f, 0.f};
#pragma unroll
    for (int j = 0; j < 16; ++j) {
        const int flat = 255 - (int)(A[j] & 255u), a_ = flat >> 4, b_ = flat & 15;
        const int ex = scr[a_ * 64 + lane] * 128 + scr[(16 + b_) * 64 + lane];
        if (j < 8) { if (!hi) { oi[j] = ex; og[j] = e[j] * rz; } } else { if (hi) { oi[j - 8] = ex; og[j - 8] = e[j] * rz; } }
    }
    *(int4*)(ip) = make_int4(oi[0], oi[1], oi[2], oi[3]); *(int4*)(ip + 4) = make_int4(oi[4], oi[5], oi[6], oi[7]);
    *(float4*)(gp) = make_float4(og[0], og[1], og[2], og[3]); *(float4*)(gp + 4) = make_float4(og[4], og[5], og[6], og[7]);
    asm volatile("s_waitcnt lgkmcnt(0)" ::: "memory");
}
#undef CE
#undef TOP16
}

__device__ __forceinline__ void phase_route(const Args& a, unsigned char* lds, int bid, int nb) {
    const int tid = opaque_tid(), wave = __builtin_amdgcn_readfirstlane(tid >> 6), lane = tid & 63;
    const bf16_t* QP = (const bf16_t*)(a.ws + WS_MIX); const bf16_t* SKB = (const bf16_t*)(a.ws + WS_SKB); const float* SSQ = (const float*)(a.ws + WS_SSQ);
    int* IDX = (int*)(a.ws + WS_IDX); float* GATE = (float*)(a.ws + WS_GATE);
    int* scr = (int*)lds + wave * 2048;
    {
        const bf16_t* X1W = (const bf16_t*)(a.ws + WS_HN); signed char* X1Q = (signed char*)(a.ws + WS_X1Q); float* XSC = (float*)(a.ws + WS_XSC);
        for (int row = bid * NWAVES + wave; row < TREAL; row += nb * NWAVES) {
            uint4 xr[4]; float am = 0.f;
#pragma unroll
            for (int j = 0; j < 4; ++j) { xr[j] = *(const uint4*)(X1W + (size_t)row * DM + 8 * lane + 512 * j);
                am = fmaxf(am, fmaxf(fmaxf(fmaxf(fabsf(bf_lo(xr[j].x)), fabsf(bf_hi(xr[j].x))), fmaxf(fabsf(bf_lo(xr[j].y)), fabsf(bf_hi(xr[j].y)))), fmaxf(fmaxf(fabsf(bf_lo(xr[j].z)), fabsf(bf_hi(xr[j].z))), fmaxf(fabsf(bf_lo(xr[j].w)), fabsf(bf_hi(xr[j].w)))))); }
            am = wave_max(am);
            const float sc = am > 0.f ? 127.f / am : 0.f;
#pragma unroll
            for (int j = 0; j < 4; ++j) {
                const unsigned ww[4] = {xr[j].x, xr[j].y, xr[j].z, xr[j].w}; unsigned o[2] = {0u, 0u};
#pragma unroll
                for (int q = 0; q < 4; ++q) { const int q0 = (int)rintf(bf_lo(ww[q]) * sc), q1 = (int)rintf(bf_hi(ww[q]) * sc); o[q >> 1] |= ((unsigned)(q0 & 255) | ((unsigned)(q1 & 255) << 8)) << (16 * (q & 1)); }
                *(uint2*)(X1Q + (size_t)row * DM + 8 * lane + 512 * j) = make_uint2(o[0], o[1]);
            }
            if (lane == 0) XSC[row] = am * (1.f / 127.f);
        }
    }
    for (int item = bid * NWAVES + wave; item < (TREAL / 32) * 8; item += nb * NWAVES) rt::route_item(item >> 3, item & 7, QP, SKB, SSQ, IDX, GATE, scr, lane);
}

constexpr int CW_QPV = 8192, CW_QPU = 8192 + 8 * 64;
constexpr int PX_ITEMS = TREAL / 64;
constexpr size_t WS_W = WS_Z + 4 * MiB, WS_PART = WS_Z + 32 * MiB, WS_Y = WS_Z + 160 * MiB;


template <int CTRL, int RMASK> __device__ __forceinline__ float dppf(float old, float v) { return __builtin_bit_cast(float, __builtin_amdgcn_update_dpp(__builtin_bit_cast(int, old), __builtin_bit_cast(int, v), CTRL, RMASK, 0xf, false)); }
template <int CTRL> __device__ __forceinline__ int dppi(int v) { return __builtin_amdgcn_update_dpp(0, v, CTRL, 0xf, 0xf, false); }
namespace pu2 {
typedef float f32x2v __attribute__((ext_vector_type(2)));
typedef unsigned u32x4v __attribute__((ext_vector_type(4)));
#define SBP() __builtin_amdgcn_sched_barrier(0)
#define PU_CHUNK_LD(dst, r_, q_) dst = *(const u32x4v*)(sidx + ((r_) - r0) * 512 + g128 + (q_) * 16)
#define PU_ROW_LD(buf, e_) buf = __builtin_amdgcn_raw_buffer_load_b128(U, (int)(e_) * 256 + c16, 0, 0)
#define PU_CONSUME(buf, I_) do { int s_ = __builtin_amdgcn_sdot4((int)buf[0], hq0, 0, false); s_ = __builtin_amdgcn_sdot4((int)buf[1], hq1, s_, false); \
    s_ = __builtin_amdgcn_sdot4((int)buf[2], hq2, s_, false); s_ = __builtin_amdgcn_sdot4((int)buf[3], hq3, s_, false); \
    s_ += dppi<0x128>(s_); s_ += dppi<0x124>(s_); s_ += dppi<0x122>(s_); s_ += dppi<0x121>(s_); \
    if ((I_) < 16) keep0 = (c == ((I_) & 15)) ? s_ : keep0; else keep1 = (c == ((I_) & 15)) ? s_ : keep1; } while (0)
#define PU_TOKEN_BODY(row_, nrow_, has_next_) do { \
    PU_CHUNK_LD(C7, row_, 7); \
    SBP(); PU_CONSUME(B0, 0); \
    PU_ROW_LD(B0, C2.x); \
    SBP(); PU_CONSUME(B1, 1); \
    PU_ROW_LD(B1, C2.y); \
    SBP(); PU_CONSUME(B2, 2); \
    PU_ROW_LD(B2, C2.z); \
    SBP(); PU_CONSUME(B3, 3); \
    PU_ROW_LD(B3, C2.w); \
    if (has_next_) PU_CHUNK_LD(C0, nrow_, 0); \
    SBP(); PU_CONSUME(B4, 4); \
    PU_ROW_LD(B4, C3.x); \
    SBP(); PU_CONSUME(B5, 5); \
    PU_ROW_LD(B5, C3.y); \
    SBP(); PU_CONSUME(B6, 6); \
    PU_ROW_LD(B6, C3.z); \
    SBP(); PU_CONSUME(B7, 7); \
    PU_ROW_LD(B7, C3.w); \
    if (has_next_) PU_CHUNK_LD(C1, nrow_, 1); \
    SBP(); PU_CONSUME(B0, 8); \
    PU_ROW_LD(B0, C4.x); \
    SBP(); PU_CONSUME(B1, 9); \
    PU_ROW_LD(B1, C4.y); \
    SBP(); PU_CONSUME(B2, 10); \
    PU_ROW_LD(B2, C4.z); \
    SBP(); PU_CONSUME(B3, 11); \
    PU_ROW_LD(B3, C4.w); \
    if (has_next_) PU_CHUNK_LD(C2, nrow_, 2); \
    SBP(); PU_CONSUME(B4, 12); \
    PU_ROW_LD(B4, C5.x); \
    SBP(); PU_CONSUME(B5, 13); \
    PU_ROW_LD(B5, C5.y); \
    SBP(); PU_CONSUME(B6, 14); \
    PU_ROW_LD(B6, C5.z); \
    SBP(); PU_CONSUME(B7, 15); \
    PU_ROW_LD(B7, C5.w); \
    if (has_next_) PU_CHUNK_LD(C3, nrow_, 3); \
    SBP(); PU_CONSUME(B0, 16); \
    PU_ROW_LD(B0, C6.x); \
    SBP(); PU_CONSUME(B1, 17); \
    PU_ROW_LD(B1, C6.y); \
    SBP(); PU_CONSUME(B2, 18); \
    PU_ROW_LD(B2, C6.z); \
    SBP(); PU_CONSUME(B3, 19); \
    PU_ROW_LD(B3, C6.w); \
    if (has_next_) PU_CHUNK_LD(C4, nrow_, 4); \
    SBP(); PU_CONSUME(B4, 20); \
    PU_ROW_LD(B4, C7.x); \
    SBP(); PU_CONSUME(B5, 21); \
    PU_ROW_LD(B5, C7.y); \
    SBP(); PU_CONSUME(B6, 22); \
    PU_ROW_LD(B6, C7.z); \
    SBP(); PU_CONSUME(B7, 23); \
    PU_ROW_LD(B7, C7.w); \
    if (has_next_) PU_CHUNK_LD(C5, nrow_, 5); \
    SBP(); PU_CONSUME(B0, 24); \
    if (has_next_) PU_ROW_LD(B0, C0.x); \
    SBP(); PU_CONSUME(B1, 25); \
    if (has_next_) PU_ROW_LD(B1, C0.y); \
    SBP(); PU_CONSUME(B2, 26); \
    if (has_next_) PU_ROW_LD(B2, C0.z); \
    SBP(); PU_CONSUME(B3, 27); \
    if (has_next_) PU_ROW_LD(B3, C0.w); \
    if (has_next_) PU_CHUNK_LD(C6, nrow_, 6); \
    SBP(); PU_CONSUME(B4, 28); \
    if (has_next_) PU_ROW_LD(B4, C1.x); \
    SBP(); PU_CONSUME(B5, 29); \
    if (has_next_) PU_ROW_LD(B5, C1.y); \
    SBP(); PU_CONSUME(B6, 30); \
    if (has_next_) PU_ROW_LD(B6, C1.z); \
    SBP(); PU_CONSUME(B7, 31); \
    if (has_next_) PU_ROW_LD(B7, C1.w); \
    } while (0)
#undef SBP
}

__device__ __forceinline__ void phase_pu(const Args& a, unsigned char* lds, unsigned* ctl, int xcc) {
    using namespace pu2;
#define SBP() __builtin_amdgcn_sched_barrier(0)
    const int tid = opaque_tid(), wave = __builtin_amdgcn_readfirstlane(tid >> 6), lane = tid & 63;
    volatile LAS unsigned* slot = (volatile LAS unsigned*)((LAS unsigned char*)lds + LDS_MISC) + 2;
    const signed char* X1Q = (const signed char*)(a.ws + WS_X1Q); float* PART = (float*)(a.ws + WS_PART);
    unsigned char* sidx = lds + wave * 4096; unsigned char* sxq = lds + 32768 + wave * 2048;
    const __amdgpu_buffer_rsrc_t RI = __builtin_amdgcn_make_buffer_rsrc((void*)(a.ws + WS_IDX), (short)0, TREAL * 512, 0x00020000);
    for (int ss = 0; ss < 8; ++ss) {
        const int s = (xcc + ss) & 7;
        const __amdgpu_buffer_rsrc_t U = __builtin_amdgcn_make_buffer_rsrc((void*)(a.ws + WS_U + (size_t)s * (16384 * 256)), (short)0, 16384 * 256, 0x00020000);
        unsigned wdraw = wave_draw(ctl + CW_QPU + 64 * s, lane);
        for (;;) {
            const int item8 = wave_item(wdraw);
            if (item8 >= PX_ITEMS * 8) break;
            wdraw = wave_draw(ctl + CW_QPU + 64 * s, lane);
            int ln = lane; asm volatile("" : "+v"(ln));
            const int g = ln >> 4, c = ln & 15, c16 = c * 16, g128 = g * 128;
            const int r0 = item8 * 8;
            u32x4v C0, C1, C2, C3, C4, C5, C6, C7, B0, B1, B2, B3, B4, B5, B6, B7;
            {
                const u32x4v* gi = (const u32x4v*)(a.ws + WS_IDX + (size_t)r0 * 512) + ln;
                const u32x4v i0 = gi[0], i1 = gi[64], i2 = gi[128], i3 = gi[192];
                const u32x4v xa = *(const u32x4v*)(X1Q + (size_t)(r0 + g) * DM + 256 * s + 16 * c), xb = *(const u32x4v*)(X1Q + (size_t)(r0 + 4 + g) * DM + 256 * s + 16 * c);
                u32x4v* si = (u32x4v*)sidx + ln; u32x4v* sx = (u32x4v*)sxq + ln;
                si[0] = i0; si[64] = i1; si[128] = i2; si[192] = i3; sx[0] = xa; sx[64] = xb;
                asm volatile("s_waitcnt lgkmcnt(0)" ::: "memory");
            }
            PU_CHUNK_LD(C0, r0, 0); PU_CHUNK_LD(C1, r0, 1); PU_CHUNK_LD(C2, r0, 2); PU_CHUNK_LD(C3, r0, 3); PU_CHUNK_LD(C4, r0, 4); PU_CHUNK_LD(C5, r0, 5); PU_CHUNK_LD(C6, r0, 6);
            uint4 nxq = ((const uint4*)sxq)[c];
            PU_ROW_LD(B0, C0.x); PU_ROW_LD(B1, C0.y); PU_ROW_LD(B2, C0.z); PU_ROW_LD(B3, C0.w); PU_ROW_LD(B4, C1.x); PU_ROW_LD(B5, C1.y); PU_ROW_LD(B6, C1.z); PU_ROW_LD(B7, C1.w);
#pragma unroll 1
            for (int t = 0; t < 8; ++t) {
                const int row = r0 + t, nrow = row + 1; const bool has_next = t < 7;
                const int hq0 = (int)nxq.x, hq1 = (int)nxq.y, hq2 = (int)nxq.z, hq3 = (int)nxq.w;
                if (has_next) nxq = ((const uint4*)sxq)[(t + 1) * 16 + c];
                int keep0 = 0, keep1 = 0;
                PU_TOKEN_BODY(row, nrow, has_next);
                float* pp = PART + (size_t)row * 1024 + s * 128 + 32 * g + c;
                pp[0] = (float)keep0; pp[16] = (float)keep1;
            }
        }
    }
#undef SBP
}
__device__ __forceinline__ void phase_pc(const Args& a, int bid, int nb) {
    const int tid = opaque_tid(), wave = __builtin_amdgcn_readfirstlane(tid >> 6), lane = tid & 63;
    const float* SSQ = (const float*)(a.ws + WS_SSQ); const int* IDX = (const int*)(a.ws + WS_IDX); const float* GATE = (const float*)(a.ws + WS_GATE);
    const float* ISC = (const float*)(a.ws + WS_ISC); const float* PART = (const float*)(a.ws + WS_PART); unsigned short* W16 = (unsigned short*)(a.ws + WS_W); float* WSC = (float*)(a.ws + WS_W + 12 * MiB);
    for (int row = bid * NWAVES + wave; row < TREAL; row += nb * NWAVES) {
        float ssv = lane < 32 ? SSQ[(size_t)row * 32 + lane] : 0.f; ssv = wave_sum(ssv);
        const float rstd = rsqrtf(ssv * (1.f / DM) + EPS);
        const float xsc = ((const float*)(a.ws + WS_XSC))[row];
        float wv[2];
#pragma unroll
        for (int k = 0; k < 2; ++k) {
            const int p = 64 * k + lane; float d = 0.f;
#pragma unroll
            for (int s = 0; s < 8; ++s) d += PART[(size_t)row * 1024 + s * 128 + p];
            const int e = IDX[(size_t)row * 128 + p];
            const float pre = d * rstd * ISC[e] * xsc;
            wv[k] = GATE[(size_t)row * 128 + p] * ISC[16384 + e] * (0.5f * pre * (1.f + erff(pre * 0.7071067811865476f)));
        }
        const float wmax = wave_max(fmaxf(fabsf(wv[0]), fabsf(wv[1])));
        const float wsc = wmax > 0.f ? 240.f / wmax : 0.f;
#pragma unroll
        for (int k = 0; k < 2; ++k) {
            const float ws = wv[k] * wsc;
            const int hi = __builtin_amdgcn_cvt_pk_fp8_f32(ws, 0.f, 0, false) & 255;
            const int lo = __builtin_amdgcn_cvt_pk_fp8_f32(ws - __builtin_amdgcn_cvt_f32_fp8(hi, 0), 0.f, 0, false) & 255;
            W16[(size_t)row * 128 + 64 * k + lane] = (unsigned short)(hi | (lo << 8));
        }
        if (lane == 0) WSC[row] = wmax * (1.f / 240.f);
    }
}
namespace pv2 {
typedef float f32x2v __attribute__((ext_vector_type(2)));
typedef unsigned u32x4v __attribute__((ext_vector_type(4))); typedef float f32x4v __attribute__((ext_vector_type(4)));
typedef unsigned u32x2v __attribute__((ext_vector_type(2)));
struct Chunk { u32x4v i; u32x2v w; };
#define SBP() __builtin_amdgcn_sched_barrier(0)
#define PV_CHUNK_LD(dst, r_, q_) do { dst.i = *(const u32x4v*)(sidx + ((r_) - r0) * 512 + g128 + (q_) * 16); dst.w = *(const u32x2v*)(swt + ((r_) - r0) * 256 + g64 + (q_) * 8); } while (0)
#define PV_ROW_LD(buf, e_) buf = __builtin_amdgcn_raw_buffer_load_b128(V, (int)(e_) * 256 + c16, 0, 0)
#define PV_CONSUME(buf, ww_, S0_, S1_) do { const u32x2v b2_ = {__builtin_amdgcn_perm(0u, (ww_), (S0_)), __builtin_amdgcn_perm(0u, (ww_), (S1_))}; const long bb_ = __builtin_bit_cast(long, b2_); \
    const u32x2v a0_ = {buf[0], buf[1]}, a1_ = {buf[2], buf[3]}; \
    acc_lo = __builtin_amdgcn_mfma_f32_16x16x32_fp8_fp8(__builtin_bit_cast(long, a0_), bb_, acc_lo, 0, 0, 0); acc_hi = __builtin_amdgcn_mfma_f32_16x16x32_fp8_fp8(__builtin_bit_cast(long, a1_), bb_, acc_hi, 0, 0, 0); } while (0)
#define PV_TOKEN_BODY(row_, nrow_, has_next_) do { \
    PV_CHUNK_LD(C7, row_, 7); \
    SBP(); PV_CONSUME(B0, C0.w[0], sele0, sele1); \
    PV_ROW_LD(B0, C2.i.x); \
    SBP(); PV_CONSUME(B1, C0.w[0], selo0, selo1); \
    PV_ROW_LD(B1, C2.i.y); \
    SBP(); PV_CONSUME(B2, C0.w[1], sele0, sele1); \
    PV_ROW_LD(B2, C2.i.z); \
    SBP(); PV_CONSUME(B3, C0.w[1], selo0, selo1); \
    PV_ROW_LD(B3, C2.i.w); \
    if (has_next_) PV_CHUNK_LD(C0, nrow_, 0); \
    SBP(); PV_CONSUME(B4, C1.w[0], sele0, sele1); \
    PV_ROW_LD(B4, C3.i.x); \
    SBP(); PV_CONSUME(B5, C1.w[0], selo0, selo1); \
    PV_ROW_LD(B5, C3.i.y); \
    SBP(); PV_CONSUME(B6, C1.w[1], sele0, sele1); \
    PV_ROW_LD(B6, C3.i.z); \
    SBP(); PV_CONSUME(B7, C1.w[1], selo0, selo1); \
    PV_ROW_LD(B7, C3.i.w); \
    if (has_next_) PV_CHUNK_LD(C1, nrow_, 1); \
    SBP(); PV_CONSUME(B0, C2.w[0], sele0, sele1); \
    PV_ROW_LD(B0, C4.i.x); \
    SBP(); PV_CONSUME(B1, C2.w[0], selo0, selo1); \
    PV_ROW_LD(B1, C4.i.y); \
    SBP(); PV_CONSUME(B2, C2.w[1], sele0, sele1); \
    PV_ROW_LD(B2, C4.i.z); \
    SBP(); PV_CONSUME(B3, C2.w[1], selo0, selo1); \
    PV_ROW_LD(B3, C4.i.w); \
    if (has_next_) PV_CHUNK_LD(C2, nrow_, 2); \
    SBP(); PV_CONSUME(B4, C3.w[0], sele0, sele1); \
    PV_ROW_LD(B4, C5.i.x); \
    SBP(); PV_CONSUME(B5, C3.w[0], selo0, selo1); \
    PV_ROW_LD(B5, C5.i.y); \
    SBP(); PV_CONSUME(B6, C3.w[1], sele0, sele1); \
    PV_ROW_LD(B6, C5.i.z); \
    SBP(); PV_CONSUME(B7, C3.w[1], selo0, selo1); \
    PV_ROW_LD(B7, C5.i.w); \
    if (has_next_) PV_CHUNK_LD(C3, nrow_, 3); \
    SBP(); PV_CONSUME(B0, C4.w[0], sele0, sele1); \
    PV_ROW_LD(B0, C6.i.x); \
    SBP(); PV_CONSUME(B1, C4.w[0], selo0, selo1); \
    PV_ROW_LD(B1, C6.i.y); \
    SBP(); PV_CONSUME(B2, C4.w[1], sele0, sele1); \
    PV_ROW_LD(B2, C6.i.z); \
    SBP(); PV_CONSUME(B3, C4.w[1], selo0, selo1); \
    PV_ROW_LD(B3, C6.i.w); \
    if (has_next_) PV_CHUNK_LD(C4, nrow_, 4); \
    SBP(); PV_CONSUME(B4, C5.w[0], sele0, sele1); \
    PV_ROW_LD(B4, C7.i.x); \
    SBP(); PV_CONSUME(B5, C5.w[0], selo0, selo1); \
    PV_ROW_LD(B5, C7.i.y); \
    SBP(); PV_CONSUME(B6, C5.w[1], sele0, sele1); \
    PV_ROW_LD(B6, C7.i.z); \
    SBP(); PV_CONSUME(B7, C5.w[1], selo0, selo1); \
    PV_ROW_LD(B7, C7.i.w); \
    if (has_next_) PV_CHUNK_LD(C5, nrow_, 5); \
    SBP(); PV_CONSUME(B0, C6.w[0], sele0, sele1); \
    if (has_next_) PV_ROW_LD(B0, C0.i.x); \
    SBP(); PV_CONSUME(B1, C6.w[0], selo0, selo1); \
    if (has_next_) PV_ROW_LD(B1, C0.i.y); \
    SBP(); PV_CONSUME(B2, C6.w[1], sele0, sele1); \
    if (has_next_) PV_ROW_LD(B2, C0.i.z); \
    SBP(); PV_CONSUME(B3, C6.w[1], selo0, selo1); \
    if (has_next_) PV_ROW_LD(B3, C0.i.w); \
    if (has_next_) PV_CHUNK_LD(C6, nrow_, 6); \
    SBP(); PV_CONSUME(B4, C7.w[0], sele0, sele1); \
    if (has_next_) PV_ROW_LD(B4, C1.i.x); \
    SBP(); PV_CONSUME(B5, C7.w[0], selo0, selo1); \
    if (has_next_) PV_ROW_LD(B5, C1.i.y); \
    SBP(); PV_CONSUME(B6, C7.w[1], sele0, sele1); \
    if (has_next_) PV_ROW_LD(B6, C1.i.z); \
    SBP(); PV_CONSUME(B7, C7.w[1], selo0, selo1); \
    if (has_next_) PV_ROW_LD(B7, C1.i.w); \
    } while (0)
#undef SBP
}

__device__ __forceinline__ void phase_pv(const Args& a, unsigned char* lds, unsigned* ctl, int xcc) {
    using namespace pv2;
#define SBP() __builtin_amdgcn_sched_barrier(0)
    const int tid = opaque_tid(), wave = __builtin_amdgcn_readfirstlane(tid >> 6), lane = tid & 63;
    volatile LAS unsigned* slot = (volatile LAS unsigned*)((LAS unsigned char*)lds + LDS_MISC) + 2;
    bf16_t* Y = (bf16_t*)(a.ws + WS_Y); const float* WSC = (const float*)(a.ws + WS_W + 12 * MiB);
    const __amdgpu_buffer_rsrc_t RI = __builtin_amdgcn_make_buffer_rsrc((void*)(a.ws + WS_IDX), (short)0, TREAL * 512, 0x00020000);
    const __amdgpu_buffer_rsrc_t RW = __builtin_amdgcn_make_buffer_rsrc((void*)(a.ws + WS_W), (short)0, TREAL * 256, 0x00020000);
    float* ybuf = (float*)lds + wave * 256;
    unsigned char* sidx = lds + 8192 + wave * 4096; unsigned char* swt = lds + 8192 + 32768 + wave * 2048;
    for (int ss = 0; ss < 8; ++ss) {
        const int s = (xcc + ss) & 7;
        const __amdgpu_buffer_rsrc_t V = __builtin_amdgcn_make_buffer_rsrc((void*)(a.ws + WS_V + (size_t)s * (16384 * 256)), (short)0, 16384 * 256, 0x00020000);
        unsigned wdraw = wave_draw(ctl + CW_QPV + 64 * s, lane);
        for (;;) {
            const int item8 = wave_item(wdraw);
            if (item8 >= PX_ITEMS * 8) break;
            wdraw = wave_draw(ctl + CW_QPV + 64 * s, lane);
            int ln = lane; asm volatile("" : "+v"(ln));
            const int g = ln >> 4, n = ln & 15, c16 = n * 16, g128 = g * 128, g64 = g * 64;
            const int r0 = item8 * 8;
            unsigned sele0, sele1, selo0, selo1;
            { const unsigned sh = 8u * (unsigned)(n & 3), keep = ~(255u << sh), se = (unsigned)(n >> 3), so = 2u + se;
              const unsigned ve = (0x0c0c0c0cu & keep) | (se << sh), vo = (0x0c0c0c0cu & keep) | (so << sh);
              const bool d0 = (n & 4) == 0;
              sele0 = d0 ? ve : 0x0c0c0c0cu; sele1 = d0 ? 0x0c0c0c0cu : ve; selo0 = d0 ? vo : 0x0c0c0c0cu; selo1 = d0 ? 0x0c0c0c0cu : vo; }
            Chunk C0, C1, C2, C3, C4, C5, C6, C7; u32x4v B0, B1, B2, B3, B4, B5, B6, B7;
            const float wscv = WSC[r0 + (ln & 7)];
            {
                const u32x4v* gi = (const u32x4v*)(a.ws + WS_IDX + (size_t)r0 * 512) + ln; const u32x4v* gw = (const u32x4v*)(a.ws + WS_W + (size_t)r0 * 256) + ln;
                const u32x4v i0 = gi[0], i1 = gi[64], i2 = gi[128], i3 = gi[192], w0 = gw[0], w1 = gw[64];
                u32x4v* si = (u32x4v*)sidx + ln; u32x4v* sw = (u32x4v*)swt + ln;
                si[0] = i0; si[64] = i1; si[128] = i2; si[192] = i3; sw[0] = w0; sw[64] = w1;
                asm volatile("s_waitcnt lgkmcnt(0)" ::: "memory");
            }
            PV_CHUNK_LD(C0, r0, 0); PV_CHUNK_LD(C1, r0, 1); PV_CHUNK_LD(C2, r0, 2); PV_CHUNK_LD(C3, r0, 3); PV_CHUNK_LD(C4, r0, 4); PV_CHUNK_LD(C5, r0, 5); PV_CHUNK_LD(C6, r0, 6);
            PV_ROW_LD(B0, C0.i.x); PV_ROW_LD(B1, C0.i.y); PV_ROW_LD(B2, C0.i.z); PV_ROW_LD(B3, C0.i.w); PV_ROW_LD(B4, C1.i.x); PV_ROW_LD(B5, C1.i.y); PV_ROW_LD(B6, C1.i.z); PV_ROW_LD(B7, C1.i.w);
#pragma unroll 1
            for (int t = 0; t < 8; ++t) {
                const int row = r0 + t, nrow = row + 1; const bool has_next = t < 7;
                f32x4v acc_lo = {0.f, 0.f, 0.f, 0.f}, acc_hi = {0.f, 0.f, 0.f, 0.f};
                PV_TOKEN_BODY(row, nrow, has_next);
                const float wsc = __uint_as_float(__builtin_amdgcn_readlane(__float_as_uint(wscv), t));
#pragma unroll
                for (int i = 0; i < 4; ++i) {
                    const float lo_ = acc_lo[i] + __uint_as_float(__builtin_amdgcn_update_dpp(0, __float_as_uint(acc_lo[i]), 0x128, 0xf, 0xf, false));
                    const float hi_ = acc_hi[i] + __uint_as_float(__builtin_amdgcn_update_dpp(0, __float_as_uint(acc_hi[i]), 0x128, 0xf, 0xf, false));
                    ybuf[16 * (4 * g + i) + n] = (n < 8 ? lo_ : hi_) * wsc;
                }
                asm volatile("s_waitcnt lgkmcnt(0)" ::: "memory");
                {
                    const float4 yv = ((const float4*)ybuf)[ln];
                    *(uint2*)(Y + (size_t)row * DM + 256 * s + 4 * ln) = make_uint2(pk2(yv.x, yv.y), pk2(yv.z, yv.w));
                }
                asm volatile("s_waitcnt lgkmcnt(0)" ::: "memory");
            }
        }
    }
#undef SBP
}
__device__ __forceinline__ void phase_pn(const Args& a, int bid, int nb) {
    const int tid = opaque_tid(), wave = __builtin_amdgcn_readfirstlane(tid >> 6), lane = tid & 63;
    const bf16_t* Y = (const bf16_t*)(a.ws + WS_Y); const bf16_t* X1 = (const bf16_t*)(a.ws + WS_HN);
    for (int row = bid * NWAVES + wave; row < TREAL; row += nb * NWAVES) {
        f32x4* p = (f32x4*)(a.out + (size_t)row * DM) + lane;
        const uint2* yp = (const uint2*)(Y + (size_t)row * DM) + lane; const uint2* xp = (const uint2*)(X1 + (size_t)row * DM) + lane;
        f32x4 v[8]; float ss = 0.f;
#pragma unroll
        for (int j = 0; j < 8; ++j) { const uint2 yy = yp[64 * j], xx = xp[64 * j];
            v[j][0] = bf_lo(xx.x) + bf_lo(yy.x); v[j][1] = bf_hi(xx.x) + bf_hi(yy.x); v[j][2] = bf_lo(xx.y) + bf_lo(yy.y); v[j][3] = bf_hi(xx.y) + bf_hi(yy.y);
            ss += (v[j][0] * v[j][0] + v[j][1] * v[j][1]) + (v[j][2] * v[j][2] + v[j][3] * v[j][3]); }
        const float r = rsqrtf(wave_sum(ss) * (1.f / DM) + EPS);
        const f32x4* wp = (const f32x4*)a.nfinal + lane;
#pragma unroll
        for (int j = 0; j < 8; ++j) p[64 * j] = v[j] * r * wp[64 * j];
    }
}

__device__ __forceinline__ void phase_mix(const Args& a, unsigned char* lds, unsigned* ctr) {
    const bf16_t* Z = (const bf16_t*)(a.ws + WS_Z); bf16_t* MIX = (bf16_t*)(a.ws + WS_MIX);
    volatile LAS unsigned* slot = (volatile LAS unsigned*)((LAS unsigned char*)lds + LDS_MISC) + 2;
    for (;;) {
        const int item = next_item(ctr, slot);
        if (item >= 64 + 2048) break;
        if (item < 64) mls::mlstm_item(item >> 2, item & 3, a, (char*)lds);
        else { const int k = item - 64, qb = 15 - (k >> 7), bh = k & 127; const float lam = attn_lambda(a); att::attn_unit(bh >> 3, bh & 7, qb, Z, MIX, lam, a.subln, (char*)lds); }
    }
}

__global__ void __launch_bounds__(NTHREADS, 2) mega(Args a) {
    extern __shared__ __attribute__((aligned(16))) unsigned char lds[];
    cg::grid_group grid = cg::this_grid();
    const int bid = blockIdx.x, nb = gridDim.x;
    unsigned char* ws = a.ws;
    bf16_t* WinT = (bf16_t*)(ws + WS_WIN); bf16_t* WoutT = (bf16_t*)(ws + WS_WOUT); bf16_t* WqT = (bf16_t*)(ws + WS_WQ);
    float* rope = (float*)(ws + WS_ROPE); float* SSQ = (float*)(ws + WS_SSQ);
    bf16_t* HN = (bf16_t*)(ws + WS_HN); bf16_t* MIX = (bf16_t*)(ws + WS_MIX); bf16_t* Z = (bf16_t*)(ws + WS_Z);

    volatile LAS unsigned* MISC = (volatile LAS unsigned*)((LAS unsigned char*)lds + LDS_MISC);
    if (threadIdx.x < 16) MISC[threadIdx.x] = 0u;
    __syncthreads();
    unsigned* ctl = (unsigned*)(ws + WS_CTL);
    XcdBarrier bar = xcd_barrier_post(ctl + CW_BAR, MISC);
    phase_prep(a, lds, bid, nb);
    grid.sync();
    { pg8::Gemm g{HN, WinT, MROWS, NZ, DM}; EpiZ E{Z, rope}; pg8::StaticOrder S; S.init(g.M, g.N, nb, bid);
      pg8::gemm_phase<EpiZ, pg8::StaticOrder, true, true>((PG8_LAS unsigned char*)lds, g, S, E); }
    phase_tables(a, lds, ctl);
    xcd_barrier(bar);
    phase_mix(a, lds, ctl + CW_QUEUE);
    xcd_barrier(bar);
    { pg8::Gemm g{MIX, WoutT, TREAL, DM, DM}; EpiX1 E{a.x, HN, SSQ}; pg8::StaticOrder S; S.init(g.M, g.N, nb, bid);
      pg8::gemm_phase<EpiX1, pg8::StaticOrder, true, true>((PG8_LAS unsigned char*)lds, g, S, E); }
    xcd_barrier(bar);
    { pg8::Gemm g{HN, WqT, TREAL, DM, DM}; pg8::EpiBf16<0> E{MIX, DM, nullptr, 0, 0, 1.f}; pg8::StaticOrder S; S.init(g.M, g.N, nb, bid);
      pg8::gemm_phase<pg8::EpiBf16<0>, pg8::StaticOrder, true, true>((PG8_LAS unsigned char*)lds, g, S, E); }
    xcd_barrier(bar);
    phase_route(a, lds, bid, nb);
    xcd_barrier(bar);
    { const int xcc = (int)(xb_xcc_id() & 7u);
      phase_pu(a, lds, ctl, xcc); xcd_barrier(bar);
      phase_pc(a, bid, nb); xcd_barrier(bar);
      phase_pv(a, lds, ctl, xcc); xcd_barrier(bar);
      phase_pn(a, bid, nb); }
}

extern "C" void kernel_launch(void* const* d_in, const int* in_sizes, int n_in, void* d_out, int out_size, void* d_ws, size_t ws_size, hipStream_t stream) {
    if (n_in != 18 || out_size != TREAL * DM || ws_size < WS_END) { fprintf(stderr, "kernel_launch: unexpected shapes n_in %d out %d ws %zu (need %zu)\n", n_in, out_size, ws_size, (size_t)WS_END); return; }
    static int grid_blocks = 0;
    if (!grid_blocks) {
        int dev = 0, cus = 0, per_cu = 0;
        (void)hipGetDevice(&dev);
        (void)hipDeviceGetAttribute(&cus, hipDeviceAttributeMultiprocessorCount, dev);
        (void)hipFuncSetAttribute((const void*)mega, hipFuncAttributeMaxDynamicSharedMemorySize, LDS_BYTES);
        (void)hipOccupancyMaxActiveBlocksPerMultiprocessor(&per_cu, (const void*)mega, NTHREADS, LDS_BYTES);
        if (per_cu < 1) { fprintf(stderr, "kernel_launch: occupancy query says %d blocks/CU\n", per_cu); per_cu = 1; }
        if (per_cu > 1) per_cu = 1;
        grid_blocks = cus * per_cu;
    }
    Args a{};
    a.x = (const float*)d_in[0]; a.meta = (const float*)d_in[1]; a.nmw = (const float*)d_in[2]; a.w_in = (const float*)d_in[3];
    a.lamqk = (const float*)d_in[4]; a.subln = (const float*)d_in[5]; a.convw = (const float*)d_in[6]; a.convb = (const float*)d_in[7];
    a.ib = (const float*)d_in[8]; a.fb = (const float*)d_in[9]; a.mnw = (const float*)d_in[10]; a.w_out = (const float*)d_in[11];
    a.nfw_ffn = (const float*)d_in[12]; a.w_q = (const float*)d_in[13]; a.subkeys = (const float*)d_in[14]; a.pu = (const float*)d_in[15];
    a.pv = (const float*)d_in[16]; a.nfinal = (const float*)d_in[17];
    a.out = (float*)d_out; a.ws = (unsigned char*)d_ws;
    (void)hipMemsetAsync((char*)d_ws + WS_CTL, 0, 65536, stream);
    void* kargs[] = {&a};
    const hipError_t e = hipLaunchCooperativeKernel((const void*)mega, dim3(grid_blocks), dim3(NTHREADS), kargs, LDS_BYTES, stream);
    if (e != hipSuccess) fprintf(stderr, "kernel_launch: cooperative launch failed: %s (grid %d)\n", hipGetErrorString(e), grid_blocks);
}
```

```cpp
#include <hip/hip_runtime.h>
#include <hip/hip_bf16.h>
#include <cstdio>
#include <cstdint>
#include <cmath>
namespace pg8 {
#define PG8_LAS __attribute__((address_space(3)))
typedef unsigned short bf16_t;
typedef short bf16x8 __attribute__((ext_vector_type(8)));
typedef float f32x4 __attribute__((ext_vector_type(4)));
typedef unsigned u32x4 __attribute__((ext_vector_type(4)));
constexpr int BM = 256, BK = 64, HALF = 128, HTB = HALF * BK * 2  , STAGE_BYTES = 8 * HTB, NXCD = 8, WGM = 8;

__host__ __device__ __forceinline__ int lds_byte(int r, int c) { const int st = (r >> 4) * 2 + (c >> 5), rr = r & 15, cc = c & 31, ob = rr * 64 + cc * 2; return st * 1024 + (ob ^ (((ob >> 9) & 1) << 5)); }
__host__ __device__ __forceinline__ void stage_rc(int b, int& R, int& C) { const int st = b / 1024, sb = b % 1024, swz = sb ^ (((sb >> 9) & 1) << 5); R = (st >> 1) * 16 + swz / 64; C = (st & 1) * 32 + (swz % 64) / 2; }
__host__ __device__ __forceinline__ int perm32(int rho) { const int n = rho >> 4, i = rho & 15; return 8 * (i >> 2) + 4 * n + (i & 3); }

struct Unit { int pm, pn; };
struct Gemm { const bf16_t* A; const bf16_t* Bt; int M, N, K; };

struct StaticOrder {
    int nM, nN, nwg, G, c;
    __host__ __device__ void init(int M, int N, int G_, int c_) { nM = M / BM; nN = N / BM; nwg = nM * nN; G = G_; c = c_; }
    __host__ __device__ bool next(int i, Unit& u) const {
        const long L = (long)i * G + c; if (L >= nwg) return false;
        int wgid = (int)L; { const int q = nwg / NXCD, r = nwg % NXCD, xcd = wgid % NXCD, off = wgid / NXCD; wgid = (xcd < r ? xcd * (q + 1) : r * (q + 1) + (xcd - r) * q) + off; }
        const int nig = WGM * nN, gid = wgid / nig, fm = gid * WGM, gsz = (nM - fm) < WGM ? (nM - fm) : WGM;
        u.pm = fm + ((wgid % nig) % gsz); u.pn = (wgid % nig) / gsz; return true;
    }
    __device__ __forceinline__ void a_ready(const Unit&) const {}
    __device__ __forceinline__ void done(const Unit&) const {}
};

__device__ __forceinline__ unsigned cvt_pk_bf16(float lo, float hi) { unsigned r; asm volatile("v_cvt_pk_bf16_f32 %0, %1, %2" : "=v"(r) : "v"(lo), "v"(hi)); return r; }
typedef float f32x2 __attribute__((ext_vector_type(2)));
__device__ __forceinline__ f32x2 gelu_pk(f32x2 v) {
    const f32x2 av = __builtin_elementwise_abs(v), d = av * 0.2316418882f + 1.0f;
    f32x2 t; t.x = __builtin_amdgcn_rcpf(d.x); t.y = __builtin_amdgcn_rcpf(d.y);
    f32x2 q = t * 0.5307027145f + (-0.7265760135f); q = q * t + 0.7107068705f; q = q * t + (-0.142248368f); q = q * t + 0.127414796f; q = q * t;
    const f32x2 s = (v * v) * (-0.72134752044f);
    f32x2 e; e.x = __builtin_amdgcn_exp2f(s.x); e.y = __builtin_amdgcn_exp2f(s.y);
    const f32x2 m = v * (q * e), r = v - m;
    f32x2 o; o.x = v.x < 0.f ? m.x : r.x; o.y = v.y < 0.f ? m.y : r.y; return o;
}

template <int ACT  > struct EpiBf16 {
    static constexpr bool PERM = true, AFTER_DRAIN = false; static_assert(ACT == 0 || ACT == 1, "EpiBf16: ACT is 0 (none) or 1 (gelu_pk)");
    bf16_t* O; int ldc; const float* bias; int split_cols; size_t split_stride; float scale0;
    __device__ __forceinline__ void operator()(const f32x4 (&acc)[2][2][4][2], const Unit& u, int wr, int wc, int fr, int fq) const {
        const int row0 = u.pm * BM + wr * 64 + fr; int colt = u.pn * BM; bf16_t* base = O;
        float sc = 1.f; if (split_cols) { const int t = colt / split_cols; base += (size_t)t * split_stride; colt -= t * split_cols; if (t == 0) sc = scale0; }
        const int col0 = colt + wc * 32 + 8 * fq, bcol0 = u.pn * BM + wc * 32 + 8 * fq;
        f32x4 bv[2][2];
#pragma unroll
        for (int bj = 0; bj < 2; ++bj)
#pragma unroll
            for (int n = 0; n < 2; ++n) bv[bj][n] = bias ? *(const f32x4*)(bias + bcol0 + bj * HALF + 4 * n) : (f32x4){0.f, 0.f, 0.f, 0.f};
#pragma unroll
        for (int ai = 0; ai < 2; ++ai)
#pragma unroll
            for (int m = 0; m < 4; ++m) { bf16_t* rowp = base + (size_t)(row0 + ai * HALF + m * 16) * ldc + col0;
#pragma unroll
                for (int bj = 0; bj < 2; ++bj) { f32x4 v0 = acc[ai][bj][m][0] + bv[bj][0], v1 = acc[ai][bj][m][1] + bv[bj][1];
                    if (ACT == 1) { f32x2 a = gelu_pk((f32x2){v0[0], v0[1]}), b = gelu_pk((f32x2){v0[2], v0[3]}), c = gelu_pk((f32x2){v1[0], v1[1]}), d = gelu_pk((f32x2){v1[2], v1[3]});
                        v0 = (f32x4){a.x, a.y, b.x, b.y}; v1 = (f32x4){c.x, c.y, d.x, d.y}; }
                    v0 = v0 * sc; v1 = v1 * sc; u32x4 w; w.x = cvt_pk_bf16(v0[0], v0[1]); w.y = cvt_pk_bf16(v0[2], v0[3]); w.z = cvt_pk_bf16(v1[0], v1[1]); w.w = cvt_pk_bf16(v1[2], v1[3]);
                    *(u32x4*)(rowp + bj * HALF) = w; } }
    }
};
template <class Epi, class Sched, bool ALIGN_EPI = false, bool SP2 = false>
__device__ __forceinline__ void gemm_phase(PG8_LAS unsigned char* lds, const Gemm g, const Sched& S, const Epi& E) {
    int tid_ = threadIdx.x; asm volatile("" : "+v"(tid_));
    const int tid = tid_, wid = __builtin_amdgcn_readfirstlane(tid >> 6), lane = tid & 63, wr = wid >> 2, wc = wid & 3, fr = lane & 15, fq = lane >> 4;
    const int K = g.K, nt = K / BK;
    unsigned voffA[2], voffB[2];
#pragma unroll
    for (int i = 0; i < 2; ++i) { int R, C; stage_rc(tid * 16 + i * 8192, R, C); const int Rb = Epi::PERM ? ((R & ~31) + perm32(R & 31)) : R;
        voffA[i] = (unsigned)(R * K + C) * 2u; voffB[i] = (unsigned)(Rb * K + C) * 2u; }
    const size_t kstep = (size_t)(BK * 2);
    const size_t hstep = (size_t)HALF * K * 2;
    const size_t tstep = 2 * hstep;
    const unsigned ldsw = (unsigned)wid * 1024u;
    const int aoff = lds_byte(wr * 64 + fr, fq * 8), boff = lds_byte(wc * 32 + fr, fq * 8);
#define PG8_SA(b, h) (((b) * 2 + (h)) * HTB)
#define PG8_SB(b, h) ((4 + (b) * 2 + (h)) * HTB)
#define PG8_STAGE(bufoff, gbase, voff) do { _Pragma("unroll") for (int _i = 0; _i < 2; ++_i) \
        __builtin_amdgcn_global_load_lds((const unsigned*)((const char*)(gbase) + (voff)[_i]), (PG8_LAS unsigned*)(lds + (bufoff) + ldsw + _i * 8192), 16, 0, 0); } while (0)
#define PG8_LDA(dst, b, h) do { _Pragma("unroll") for (int m = 0; m < 4; ++m) _Pragma("unroll") for (int k = 0; k < 2; ++k) dst[m][k] = *(const PG8_LAS bf16x8*)(lds + PG8_SA(b, h) + aoff + m * 2048 + k * 1024); } while (0)
#define PG8_LDB(dst, b, h) do { _Pragma("unroll") for (int n = 0; n < 2; ++n) _Pragma("unroll") for (int k = 0; k < 2; ++k) dst[n][k] = *(const PG8_LAS bf16x8*)(lds + PG8_SB(b, h) + boff + n * 2048 + k * 1024); } while (0)
#define PG8_MMA(ai, bj, At, Bt) do { __builtin_amdgcn_s_setprio(1); _Pragma("unroll") for (int m = 0; m < 4; ++m) _Pragma("unroll") for (int n = 0; n < 2; ++n) _Pragma("unroll") for (int k = 0; k < 2; ++k) \
        acc[ai][bj][m][n] = __builtin_amdgcn_mfma_f32_16x16x32_bf16(Bt[n][k], At[m][k], acc[ai][bj][m][n], 0, 0, 0); __builtin_amdgcn_s_setprio(0); } while (0)
#define PG8_WAIT_V(n) asm volatile("s_waitcnt vmcnt(" #n ")" ::: "memory")
#define PG8_WAIT_L(n) asm volatile("s_waitcnt lgkmcnt(" #n ")" ::: "memory")
#define PG8_BAR __builtin_amdgcn_s_barrier()
#define PG8_SCHED __builtin_amdgcn_sched_barrier(0)
    Unit cur, nxt; int ui = 0;
    if (!S.next(0, cur)) return;
    f32x4 acc[2][2][4][2];
#pragma unroll
    for (int a = 0; a < 2; ++a)
#pragma unroll
        for (int b = 0; b < 2; ++b)
#pragma unroll
            for (int m = 0; m < 4; ++m)
#pragma unroll
                for (int n = 0; n < 2; ++n) acc[a][b][m][n] = (f32x4){0.f, 0.f, 0.f, 0.f};
    bf16x8 At[4][2], B0[2][2], B1[2][2];
    const char* cA = (const char*)g.A + (size_t)cur.pm * tstep; const char* cB = (const char*)g.Bt + (size_t)cur.pn * tstep;
    S.a_ready(cur);
    if constexpr (SP2) {
        PG8_STAGE(PG8_SB(0, 0), cB, voffB); PG8_STAGE(PG8_SB(0, 1), cB + hstep, voffB); PG8_STAGE(PG8_SA(0, 0), cA, voffA); PG8_STAGE(PG8_SA(0, 1), cA + hstep, voffA);
        if (wr == 1) PG8_BAR;
        PG8_WAIT_V(2); PG8_BAR;
        PG8_STAGE(PG8_SB(1, 0), cB + kstep, voffB); PG8_STAGE(PG8_SA(1, 0), cA + kstep, voffA); PG8_STAGE(PG8_SB(1, 1), cB + hstep + kstep, voffB);
        PG8_WAIT_V(6); PG8_BAR;
    } else {
        PG8_STAGE(PG8_SB(0, 0), cB, voffB); PG8_STAGE(PG8_SA(0, 0), cA, voffA); PG8_STAGE(PG8_SB(0, 1), cB + hstep, voffB); PG8_STAGE(PG8_SA(0, 1), cA + hstep, voffA);
        if (wr == 1) PG8_BAR;
        PG8_WAIT_V(4); PG8_BAR;
        PG8_STAGE(PG8_SB(1, 0), cB + kstep, voffB); PG8_STAGE(PG8_SA(1, 0), cA + kstep, voffA); PG8_STAGE(PG8_SB(1, 1), cB + hstep + kstep, voffB);
        PG8_WAIT_V(6); PG8_BAR;
    }
    for (;;) {
        const bool has_next = S.next(ui + 1, nxt);
        const char* nA = has_next ? (const char*)g.A + (size_t)nxt.pm * tstep : cA; const char* nB = has_next ? (const char*)g.Bt + (size_t)nxt.pn * tstep : cB;
        for (int t = 0; t < nt; t += 2) {
            const bool last = (t == nt - 2);
            const char* a1 = cA + (size_t)(t + 1) * kstep;
            const char* a2 = last ? nA : cA + (size_t)(t + 2) * kstep; const char* b2 = last ? nB : cB + (size_t)(t + 2) * kstep;
            const char* a3 = a2 + kstep; const char* b3 = b2 + kstep;
            if (last && has_next) S.a_ready(nxt);
            if constexpr (SP2) {
            PG8_LDB(B0, 0, 0); PG8_LDB(B1, 0, 1); PG8_SCHED; PG8_LDA(At, 0, 0); PG8_STAGE(PG8_SA(1, 1), a1 + hstep, voffA);
            PG8_WAIT_V(8); PG8_WAIT_L(0); PG8_BAR; PG8_MMA(0, 0, At, B0); PG8_MMA(0, 1, At, B1); PG8_BAR; PG8_SCHED;
            PG8_LDA(At, 0, 1); PG8_STAGE(PG8_SB(0, 0), b2, voffB); PG8_STAGE(PG8_SB(0, 1), b2 + hstep, voffB); PG8_STAGE(PG8_SA(0, 0), a2, voffA);
            PG8_WAIT_V(8); PG8_WAIT_L(0); PG8_BAR; PG8_MMA(1, 0, At, B0); PG8_MMA(1, 1, At, B1); PG8_BAR; PG8_SCHED;
            PG8_LDB(B0, 1, 0); PG8_LDB(B1, 1, 1); PG8_SCHED; PG8_LDA(At, 1, 0); PG8_STAGE(PG8_SA(0, 1), a2 + hstep, voffA);
            PG8_WAIT_V(8); PG8_WAIT_L(0); PG8_BAR; PG8_MMA(0, 0, At, B0); PG8_MMA(0, 1, At, B1); PG8_BAR; PG8_SCHED;
            PG8_LDA(At, 1, 1); PG8_STAGE(PG8_SB(1, 0), b3, voffB); PG8_STAGE(PG8_SB(1, 1), b3 + hstep, voffB); PG8_STAGE(PG8_SA(1, 0), a3, voffA);
            PG8_WAIT_V(8); PG8_WAIT_L(0); PG8_BAR; PG8_MMA(1, 0, At, B0); PG8_MMA(1, 1, At, B1); PG8_BAR; PG8_SCHED;
            } else {
            PG8_LDB(B0, 0, 0); PG8_SCHED; PG8_LDA(At, 0, 0); PG8_STAGE(PG8_SA(1, 1), a1 + hstep, voffA);
            PG8_WAIT_L(8); PG8_BAR; PG8_WAIT_L(0); PG8_MMA(0, 0, At, B0); PG8_BAR; PG8_SCHED;
            PG8_LDB(B1, 0, 1); PG8_STAGE(PG8_SB(0, 0), b2, voffB);
            PG8_BAR; PG8_WAIT_L(0); PG8_MMA(0, 1, At, B1); PG8_BAR;
            PG8_LDA(At, 0, 1); PG8_STAGE(PG8_SA(0, 0), a2, voffA);
            PG8_BAR; PG8_WAIT_L(0); PG8_MMA(1, 0, At, B0); PG8_BAR; PG8_SCHED;
            PG8_STAGE(PG8_SB(0, 1), b2 + hstep, voffB);
            PG8_WAIT_V(6); PG8_BAR; PG8_MMA(1, 1, At, B1); PG8_BAR;
            PG8_LDB(B0, 1, 0); PG8_SCHED; PG8_LDA(At, 1, 0); PG8_STAGE(PG8_SA(0, 1), a2 + hstep, voffA);
            PG8_WAIT_L(8); PG8_BAR; PG8_WAIT_L(0); PG8_MMA(0, 0, At, B0); PG8_BAR; PG8_SCHED;
            PG8_LDB(B1, 1, 1); PG8_STAGE(PG8_SB(1, 0), b3, voffB);
            PG8_BAR; PG8_WAIT_L(0); PG8_MMA(0, 1, At, B1); PG8_BAR;
            PG8_LDA(At, 1, 1); PG8_STAGE(PG8_SA(1, 0), a3, voffA);
            PG8_BAR; PG8_WAIT_L(0); PG8_MMA(1, 0, At, B0); PG8_BAR; PG8_SCHED;
            PG8_STAGE(PG8_SB(1, 1), b3 + hstep, voffB);
            PG8_WAIT_V(6); PG8_BAR; PG8_MMA(1, 1, At, B1); PG8_BAR;
            }
        }
        if constexpr (ALIGN_EPI) { if (wr == 0) PG8_BAR; }
        if constexpr (!Epi::AFTER_DRAIN) { E(acc, cur, wr, wc, fr, fq); S.done(cur); }
        if (!has_next) break;
#pragma unroll
        for (int a = 0; a < 2; ++a)
#pragma unroll
            for (int b = 0; b < 2; ++b)
#pragma unroll
                for (int m = 0; m < 4; ++m)
#pragma unroll
                    for (int n = 0; n < 2; ++n) acc[a][b][m][n] = (f32x4){0.f, 0.f, 0.f, 0.f};
        cur = nxt; cA = nA; cB = nB; ++ui;
        if constexpr (ALIGN_EPI) { if (wr == 1) PG8_BAR; }
    }
    PG8_WAIT_V(0);
    if constexpr (!ALIGN_EPI) { if (wr == 0) PG8_BAR; }
    PG8_BAR;
    if constexpr (Epi::AFTER_DRAIN) { E.fused(acc, cur, wr, wc, fr, fq, lds, wid, lane); S.done(cur); }
#undef PG8_SA
#undef PG8_SB
#undef PG8_STAGE
#undef PG8_LDA
#undef PG8_LDB
#undef PG8_MMA
#undef PG8_WAIT_V
#undef PG8_WAIT_L
#undef PG8_BAR
#undef PG8_SCHED
}
}

constexpr int BATCH = 16, SEQ = 2048, DM = 2048, NMETA = 16;
constexpr int TREAL = BATCH * SEQ;
constexpr int MROWS = 33024;
constexpr int META_TILE0 = 32768;
constexpr int META_ROW0 = 32816;
constexpr int NZ = 6144;
constexpr int ZQ = 0, ZK = 1024, ZV = 2048, ZMQ = 3072, ZMK = 3584, ZMV = 4096, ZMO = 5120;
constexpr int INCOLS = 6152;
constexpr float EPS = 1e-6f;
constexpr float QSCALE = 0.125f * 1.4426950408889634f;
constexpr float LAMBDA_INIT = 0.2f;

typedef unsigned short bf16_t;
typedef float f32x4 __attribute__((ext_vector_type(4)));
typedef __bf16 bf16x2_t __attribute__((ext_vector_type(2)));

constexpr size_t MiB = 1u << 20;
constexpr size_t WS_CTL = 0;
constexpr size_t WS_ISC = 655360;
constexpr size_t WS_SKB = 65536;
constexpr size_t WS_WIN = 1 * MiB;
constexpr size_t WS_WOUT = 25 * MiB;
constexpr size_t WS_WQ = 33 * MiB;
constexpr size_t WS_ROPE = 41 * MiB;
constexpr size_t WS_GATES = 42 * MiB;
constexpr size_t WS_SSQ = 44 * MiB;
constexpr size_t WS_IDX = 48 * MiB;
constexpr size_t WS_GATE = 64 * MiB;
constexpr size_t WS_U = 80 * MiB;
constexpr size_t WS_V = 144 * MiB;
constexpr size_t WS_HN = 208 * MiB;
constexpr size_t WS_MIX = 338 * MiB;
constexpr size_t WS_Z = 466 * MiB;
constexpr size_t WS_END = 854 * MiB;

__device__ __forceinline__ float bf_lo(unsigned w) { return __uint_as_float(w << 16); }
__device__ __forceinline__ float bf_hi(unsigned w) { return __uint_as_float(w & 0xffff0000u); }
__device__ __forceinline__ float bf2f(bf16_t v) { return __uint_as_float(((unsigned)v) << 16); }
__device__ __forceinline__ unsigned f2bf(float f) { unsigned r; asm("v_cvt_pk_bf16_f32 %0, %1, 0" : "=v"(r) : "v"(f)); return r; }
__device__ __forceinline__ unsigned pk2(float lo, float hi) { unsigned r; asm("v_cvt_pk_bf16_f32 %0, %1, %2" : "=v"(r) : "v"(lo), "v"(hi)); return r; }
__device__ __forceinline__ float dot2(unsigned a, unsigned b, float acc) { return __builtin_amdgcn_fdot2_f32_bf16(__builtin_bit_cast(bf16x2_t, a), __builtin_bit_cast(bf16x2_t, b), acc, false); }
__device__ __forceinline__ float wave_sum(float v) {
#pragma unroll
    for (int o = 1; o < 64; o <<= 1) v += __shfl_xor(v, o);
    return v;
}
__device__ __forceinline__ float wave_max(float v) {
#pragma unroll
    for (int o = 1; o < 64; o <<= 1) v = fmaxf(v, __shfl_xor(v, o));
    return v;
}
__device__ __forceinline__ int zrow_of(int b, int l) { return l < NMETA ? META_ROW0 + l : b * SEQ + (l - NMETA); }

struct EpiZ {
    static constexpr bool PERM = true, AFTER_DRAIN = false;
    bf16_t* Z; const float* rope;
    __device__ __forceinline__ void operator()(const pg8::f32x4 (&acc)[2][2][4][2], const pg8::Unit& u, int wr, int wc, int fr, int fq) const {
        const int row0 = u.pm * 256 + wr * 64 + fr, col0 = u.pn * 256 + wc * 32 + 8 * fq;
        const bool isq = u.pn < 4, isrope = u.pn < 8;
        const int j0 = 16 * (wc & 1) + 4 * fq;
#pragma unroll
        for (int ai = 0; ai < 2; ++ai)
#pragma unroll
            for (int m = 0; m < 4; ++m) {
                const int row = row0 + ai * 128 + m * 16;
                pg8::f32x4 c0 = {1.f, 0.f, 1.f, 0.f}, c1 = {1.f, 0.f, 1.f, 0.f};
                if (isrope) {
                    const int pos = row < TREAL ? (row & (SEQ - 1)) + NMETA : ((row >= META_ROW0 && row < META_ROW0 + NMETA) ? row - META_ROW0 : 0);
                    const pg8::f32x4* tp = (const pg8::f32x4*)(rope + ((size_t)pos * 32 + j0) * 2);
                    c0 = tp[0]; c1 = tp[1];
                }
                bf16_t* rowp = Z + (size_t)row * NZ + col0;
#pragma unroll
                for (int bj = 0; bj < 2; ++bj) {
                    pg8::f32x4 v0 = acc[ai][bj][m][0], v1 = acc[ai][bj][m][1];
                    if (isrope) {
                        pg8::f32x4 o0, o1;
                        o0[0] = v0[0] * c0[0] - v0[1] * c0[1]; o0[1] = v0[1] * c0[0] + v0[0] * c0[1];
                        o0[2] = v0[2] * c0[2] - v0[3] * c0[3]; o0[3] = v0[3] * c0[2] + v0[2] * c0[3];
                        o1[0] = v1[0] * c1[0] - v1[1] * c1[1]; o1[1] = v1[1] * c1[0] + v1[0] * c1[1];
                        o1[2] = v1[2] * c1[2] - v1[3] * c1[3]; o1[3] = v1[3] * c1[2] + v1[2] * c1[3];
                        v0 = o0; v1 = o1;
                        if (isq) { v0 = v0 * QSCALE; v1 = v1 * QSCALE; }
                    }
                    pg8::u32x4 w; w.x = pg8::cvt_pk_bf16(v0[0], v0[1]); w.y = pg8::cvt_pk_bf16(v0[2], v0[3]); w.z = pg8::cvt_pk_bf16(v1[0], v1[1]); w.w = pg8::cvt_pk_bf16(v1[2], v1[3]);
                    *(pg8::u32x4*)(rowp + bj * 128) = w;
                }
            }
    }
};
struct EpiX1 {
    static constexpr bool PERM = true, AFTER_DRAIN = false;
    const float* x; bf16_t* x1b; float* ssq;
    __device__ __forceinline__ void loadr(pg8::f32x4 (&xb)[2][2], int row0, int col0, int i) const {
#pragma unroll
        for (int bj = 0; bj < 2; ++bj) {
            const size_t off = (size_t)(row0 + (i >> 2) * 128 + (i & 3) * 16) * DM + col0 + bj * 128;
            xb[bj][0] = *(const pg8::f32x4*)(x + off); xb[bj][1] = *(const pg8::f32x4*)(x + off + 4);
        }
    }
    __device__ __forceinline__ void procr(const pg8::f32x4 (&acc)[2][2][4][2], const pg8::f32x4 (&xb)[2][2], int row0, int col0, int i, int pn, int wc, int fq) const {
        const int ai = i >> 2, m = i & 3;
        const int row = row0 + ai * 128 + m * 16; float ss = 0.f;
#pragma unroll
        for (int bj = 0; bj < 2; ++bj) {
            const size_t off = (size_t)row * DM + col0 + bj * 128;
            const pg8::f32x4 v0 = acc[ai][bj][m][0] + xb[bj][0], v1 = acc[ai][bj][m][1] + xb[bj][1];
            ss += (v0[0] * v0[0] + v0[1] * v0[1]) + (v0[2] * v0[2] + v0[3] * v0[3]) + (v1[0] * v1[0] + v1[1] * v1[1]) + (v1[2] * v1[2] + v1[3] * v1[3]);
            pg8::u32x4 w; w.x = pg8::cvt_pk_bf16(v0[0], v0[1]); w.y = pg8::cvt_pk_bf16(v0[2], v0[3]); w.z = pg8::cvt_pk_bf16(v1[0], v1[1]); w.w = pg8::cvt_pk_bf16(v1[2], v1[3]);
            *(pg8::u32x4*)(x1b + off) = w;
        }
        ss += __shfl_xor(ss, 16); ss += __shfl_xor(ss, 32);
        if (fq == 0) ssq[(size_t)row * 32 + pn * 4 + wc] = ss;
    }
    __device__ __forceinline__ void operator()(const pg8::f32x4 (&acc)[2][2][4][2], const pg8::Unit& u, int wr, int wc, int fr, int fq) const {
        const int row0 = u.pm * 256 + wr * 64 + fr, col0 = u.pn * 256 + wc * 32 + 8 * fq;
        pg8::f32x4 b0[2][2], b1[2][2], b2[2][2];
        loadr(b0, row0, col0, 0); loadr(b1, row0, col0, 1); loadr(b2, row0, col0, 2);
        procr(acc, b0, row0, col0, 0, u.pn, wc, fq); loadr(b0, row0, col0, 3);
        procr(acc, b1, row0, col0, 1, u.pn, wc, fq); loadr(b1, row0, col0, 4);
        procr(acc, b2, row0, col0, 2, u.pn, wc, fq); loadr(b2, row0, col0, 5);
        procr(acc, b0, row0, col0, 3, u.pn, wc, fq); loadr(b0, row0, col0, 6);
        procr(acc, b1, row0, col0, 4, u.pn, wc, fq); loadr(b1, row0, col0, 7);
        procr(acc, b2, row0, col0, 5, u.pn, wc, fq);
        procr(acc, b0, row0, col0, 6, u.pn, wc, fq);
        procr(acc, b1, row0, col0, 7, u.pn, wc, fq);
    }
};


#include <hip/hip_cooperative_groups.h>
namespace cg = cooperative_groups;

constexpr int NWAVES = 8, NTHREADS = 512;
constexpr size_t WS_X1Q = WS_Z + 300 * MiB, WS_XSC = WS_Z + 370 * MiB;
__device__ __forceinline__ int opaque_tid() { int t = threadIdx.x; asm volatile("" : "+v"(t)); return t; }
constexpr int LDS_BYTES = 163840;

struct Args {
    const float *x, *meta, *nmw, *w_in, *lamqk, *subln, *convw, *convb, *ib, *fb, *mnw, *w_out, *nfw_ffn, *w_q, *subkeys, *pu, *pv, *nfinal;
    float* out; unsigned char* ws;
};

#define LAS __attribute__((address_space(3)))
#define XB_TMO      128
#define XB_XCNT(j)  (256  + 64 * (j))
#define XB_XSUB(j)  (1280 + 64 * (j))
#define XB_XGEN(j)  (2304 + 64 * (j))
#define XB_TOP      3328
#define XB_TOPGEN   3392
#define XCD_BAR_WORDS 3456
#define XB_SPIN_CAP (1u << 18)

__device__ __forceinline__ unsigned xb_ld(unsigned* p)              { return __hip_atomic_load(p, __ATOMIC_RELAXED, __HIP_MEMORY_SCOPE_AGENT); }
__device__ __forceinline__ unsigned xb_add(unsigned* p, unsigned v) { return __hip_atomic_fetch_add(p, v, __ATOMIC_RELAXED, __HIP_MEMORY_SCOPE_AGENT); }
__device__ __forceinline__ unsigned xb_xcc_id() { return (unsigned)__builtin_amdgcn_s_getreg((3 << 11) | 20) & 0xFu; }
#define XB_SPIN(cond, bar) do { unsigned _sp = 0; while (cond) { __builtin_amdgcn_s_sleep(1); \
    if ((++_sp & 255u) == 0u) { if (xb_ld(&(bar)[XB_TMO])) break; if (_sp > XB_SPIN_CAP) { atomicAdd(&(bar)[XB_TMO], 1u); break; } } } } while (0)

struct XcdBarrier {
    unsigned* bar; unsigned x;
    volatile LAS unsigned* st;
};

__device__ __forceinline__ XcdBarrier xcd_barrier_post(unsigned* bar, volatile LAS unsigned* st) {
    XcdBarrier b; b.bar = bar; b.x = xb_xcc_id(); b.st = st;
    if (threadIdx.x == 0) (void)xb_add(&bar[XB_XCNT(b.x)], 1u);
    return b;
}
__device__ __forceinline__ void xcd_barrier_complete(unsigned* bar, unsigned x, unsigned& nloc, unsigned& nx) {
    const unsigned G = gridDim.x * gridDim.y * gridDim.z;
    unsigned sum, cnt, mine, sp = 0u;
    for (;;) {
        sum = 0u; cnt = 0u; mine = 0u;
#pragma unroll
        for (unsigned j = 0; j < 16; ++j) { const unsigned c = xb_ld(&bar[XB_XCNT(j)]); sum += c; cnt += (c > 0u) ? 1u : 0u; mine = (j == x) ? c : mine; }
        if (sum == G) break;
        __builtin_amdgcn_s_sleep(1);
        if ((++sp & 255u) == 0u) { if (xb_ld(&bar[XB_TMO])) break; if (sp > XB_SPIN_CAP) { atomicAdd(&bar[XB_TMO], 1u); break; } }
    }
    nloc = mine > 0u ? mine : 1u; nx = cnt > 0u ? cnt : 1u;
}

__device__ __forceinline__ void xcd_barrier(const XcdBarrier& b) {
    asm volatile("s_waitcnt vmcnt(0)" ::: "memory");
    __syncthreads();
    if (threadIdx.x == 0) {
        unsigned* bar = b.bar;
        __builtin_amdgcn_s_waitcnt(0);
        unsigned nloc = b.st[0], nx = b.st[1];
        if (nloc == 0u) { xcd_barrier_complete(bar, b.x, nloc, nx); b.st[0] = nloc; b.st[1] = nx; }
        const unsigned old = xb_add(&bar[XB_XSUB(b.x)], 1u);
        const unsigned gen = old / nloc;
        if (old + 1u == (gen + 1u) * nloc) {
            __builtin_amdgcn_fence(__ATOMIC_RELEASE, "agent");
            asm volatile("s_waitcnt vmcnt(0)" ::: "memory");
            const unsigned og = xb_add(&bar[XB_TOP], 1u);
            const unsigned tg = og / nx;
            if (og + 1u == (tg + 1u) * nx) xb_add(&bar[XB_TOPGEN], 1u);
            else XB_SPIN(xb_ld(&bar[XB_TOPGEN]) == tg, bar);
            __builtin_amdgcn_fence(__ATOMIC_ACQUIRE, "agent");
            xb_add(&bar[XB_XGEN(b.x)], 1u);
            asm volatile("s_waitcnt vmcnt(0)" ::: "memory");
        } else {
            XB_SPIN(xb_ld(&bar[XB_XGEN(b.x)]) == gen, bar);
            __builtin_amdgcn_fence(__ATOMIC_ACQUIRE, "agent");
            asm volatile("s_waitcnt vmcnt(0)" ::: "memory");
        }
    }
    __syncthreads();
}

constexpr int CW_BAR = 0, CW_QUEUE = 4096;
constexpr int LDS_MISC = LDS_BYTES - 256;
__device__ __forceinline__ unsigned wave_draw(unsigned* ctr, int lane) {
    unsigned v = 0u;
    if (lane == 0) v = __hip_atomic_fetch_add(ctr, 1u, __ATOMIC_RELAXED, __HIP_MEMORY_SCOPE_AGENT);
    return v;
}
__device__ __forceinline__ int wave_item(unsigned v) { return (int)__builtin_amdgcn_readfirstlane(v); }
__device__ __forceinline__ int next_item(unsigned* ctr, volatile LAS unsigned* slot) {
    __syncthreads();
    if (threadIdx.x == 0) *slot = __hip_atomic_fetch_add(ctr, 1u, __ATOMIC_RELAXED, __HIP_MEMORY_SCOPE_AGENT);
    __syncthreads();
    return (int)*slot;
}

__device__ __forceinline__ void transpose_item(const float* W, int ldw, int K, int N, bf16_t* WT, bool ropeperm, float* scr, int item, int lane, const float* kscale = nullptr) {
    const int nblk = N / 32, kb = item / nblk, nb = item % nblk, k0 = 64 * kb, n0 = 32 * nb;
#pragma unroll 8
    for (int i = 0; i < 32; ++i) { const int kk = 2 * i + (lane >> 5); scr[kk * 33 + (lane & 31)] = W[(size_t)(k0 + kk) * ldw + n0 + (lane & 31)] * (kscale ? kscale[k0 + kk] : 1.f); }
    __builtin_amdgcn_s_waitcnt(0xC07F); asm volatile("" ::: "memory");
    const int c = lane & 7;
#pragma unroll
    for (int j = 0; j < 4; ++j) {
        const int n = (lane >> 3) + 8 * j; const float* s = scr + (8 * c) * 33 + n;
        uint4 o; o.x = pk2(s[0 * 33], s[1 * 33]); o.y = pk2(s[2 * 33], s[3 * 33]); o.z = pk2(s[4 * 33], s[5 * 33]); o.w = pk2(s[6 * 33], s[7 * 33]);
        int orow = n0 + n;
        if (ropeperm && n0 < 2048) orow = (n0 & ~63) + 2 * n + ((n0 >> 5) & 1);
        *(uint4*)(WT + (size_t)orow * K + k0 + 8 * c) = o;
    }
    __builtin_amdgcn_s_waitcnt(0xC07F); asm volatile("" ::: "memory");
}

__device__ __forceinline__ void hn_row(const Args& a, bf16_t* HN, float* G, const float* WG, int r, const f32x4 (&v)[8], int lane) {
    float ss = 0.f;
#pragma unroll
    for (int j = 0; j < 8; ++j) ss += (v[j][0] * v[j][0] + v[j][1] * v[j][1]) + (v[j][2] * v[j][2] + v[j][3] * v[j][3]);
    const float rstd = rsqrtf(wave_sum(ss) * (1.f / DM) + EPS);
    float g[8];
#pragma unroll
    for (int k = 0; k < 8; ++k) g[k] = 0.f;
    unsigned long long* o8 = (unsigned long long*)(HN + (size_t)r * DM) + lane;
#pragma unroll
    for (int j = 0; j < 8; ++j) {
        const f32x4 w = ((const f32x4*)a.nmw)[64 * j + lane];
        const f32x4 y = v[j] * rstd * w;
        o8[64 * j] = (unsigned long long)pk2(y[0], y[1]) | ((unsigned long long)pk2(y[2], y[3]) << 32);
#pragma unroll
        for (int k = 0; k < 8; ++k) { const f32x4 wg = ((const f32x4*)(WG + k * 2048))[64 * j + lane]; g[k] += (y[0] * wg[0] + y[1] * wg[1]) + (y[2] * wg[2] + y[3] * wg[3]); }
        __builtin_amdgcn_sched_barrier(0);
    }
    float r4[4], r2[2], r1;
    { const bool hb = (lane & 32) != 0;
#pragma unroll
      for (int i = 0; i < 4; ++i) { const float send = hb ? g[i] : g[i + 4]; const float recv = __shfl_xor(send, 32); r4[i] = (hb ? g[i + 4] : g[i]) + recv; } }
    { const bool hb = (lane & 16) != 0;
#pragma unroll
      for (int i = 0; i < 2; ++i) { const float send = hb ? r4[i] : r4[i + 2]; const float recv = __shfl_xor(send, 16); r2[i] = (hb ? r4[i + 2] : r4[i]) + recv; } }
    { const bool hb = (lane & 8) != 0; const float send = hb ? r2[0] : r2[1]; const float recv = __shfl_xor(send, 8); r1 = (hb ? r2[1] : r2[0]) + recv; }
    r1 += __shfl_xor(r1, 4); r1 += __shfl_xor(r1, 2); r1 += __shfl_xor(r1, 1);
    if ((lane & 7) == 0) G[(size_t)r * 8 + ((lane >> 5) & 1) * 4 + ((lane >> 4) & 1) * 2 + ((lane >> 3) & 1)] = r1;
}

__device__ __forceinline__ void phase_prep(const Args& a, unsigned char* lds, int bid, int nb) {
    const int tid = opaque_tid(), lane = tid & 63, wave = tid >> 6;
    const int gw = bid * NWAVES + wave, NGW = nb * NWAVES;
    unsigned char* ws = a.ws;
    bf16_t* WinT = (bf16_t*)(ws + WS_WIN); bf16_t* WoutT = (bf16_t*)(ws + WS_WOUT); bf16_t* WqT = (bf16_t*)(ws + WS_WQ);
    bf16_t* U = (bf16_t*)(ws + WS_U); bf16_t* V = (bf16_t*)(ws + WS_V); bf16_t* HN = (bf16_t*)(ws + WS_HN);
    float* G = (float*)(ws + WS_GATES); float* rope = (float*)(ws + WS_ROPE);
    float* scr = (float*)lds + wave * (64 * 33);
    float* WG = (float*)(lds + 8 * 64 * 33 * 4);
    for (int i = tid; i < 8 * 2048; i += NTHREADS) { const int k = i >> 3, g = i & 7; WG[g * 2048 + k] = a.w_in[(size_t)k * INCOLS + 6144 + g]; }
    __syncthreads();
    constexpr int I_IN = 32 * 192, I_OUT = 32 * 64, I_Q = 32 * 64;
    for (int it = gw; it < I_IN + I_OUT + I_Q; it += NGW) {
        int r = it;
        if (r < I_IN) { transpose_item(a.w_in, INCOLS, 2048, 6144, WinT, true, scr, r, lane); continue; } r -= I_IN;
        if (r < I_OUT) { transpose_item(a.w_out, 2048, 2048, 2048, WoutT, false, scr, r, lane); continue; } r -= I_OUT;
        transpose_item(a.w_q, 2048, 2048, 2048, WqT, false, scr, r, lane, a.nfw_ffn);
    }
    {
        f32x4 vc[8], vn[8];
#pragma unroll
        for (int j = 0; j < 8; ++j) vc[j] = ((const f32x4*)(a.x + (size_t)gw * DM))[64 * j + lane];
        for (int r = gw; r < TREAL; r += NGW) {
            const int rn = r + NGW < TREAL ? r + NGW : r;
#pragma unroll
            for (int j = 0; j < 8; ++j) vn[j] = ((const f32x4*)(a.x + (size_t)rn * DM))[64 * j + lane];
            hn_row(a, HN, G, WG, r, vc, lane);
#pragma unroll
            for (int j = 0; j < 8; ++j) vc[j] = vn[j];
        }
    }
    for (int r = TREAL + gw; r < MROWS; r += NGW) {
        if (r >= META_ROW0 && r < META_ROW0 + NMETA) {
            f32x4 vm[8];
#pragma unroll
            for (int j = 0; j < 8; ++j) vm[j] = ((const f32x4*)(a.meta + (size_t)(r - META_ROW0) * DM))[64 * j + lane];
            hn_row(a, HN, G, WG, r, vm, lane);
        } else {
            unsigned long long* o8 = (unsigned long long*)(HN + (size_t)r * DM) + lane;
#pragma unroll
            for (int j = 0; j < 8; ++j) o8[64 * j] = 0ull;
            if (lane < 8) G[(size_t)r * 8 + lane] = 0.f;
        }
    }
    { bf16_t* SKB = (bf16_t*)(ws + WS_SKB);
      for (int i = bid * NTHREADS + tid; i < 8 * 2 * 128 * 128 / 2; i += nb * NTHREADS) { const float2 v = ((const float2*)a.subkeys)[i]; ((unsigned*)SKB)[i] = pk2(v.x, v.y); } }
    for (int i = bid * NTHREADS + tid; i < (SEQ + NMETA) * 32; i += nb * NTHREADS) {
        const int pos = i >> 5, j = i & 31;
        const float inv = (float)pow(10000.0, -(double)j / 32.0);
        const float ang = (float)pos * inv;
        rope[2 * i] = (float)cos((double)ang); rope[2 * i + 1] = (float)sin((double)ang);
    }
}


constexpr int CW_QTAB = 4096 + 1024, TAB_ITEMS = 2 * 16384 / 16;
__device__ __forceinline__ void phase_tables(const Args& a, unsigned char* lds, unsigned* ctl) {
    const int tid = opaque_tid(), lane = tid & 63, wave = __builtin_amdgcn_readfirstlane(tid >> 6);
    unsigned char* ws = a.ws;
    volatile LAS unsigned* slot = (volatile LAS unsigned*)((LAS unsigned char*)lds + LDS_MISC) + 2;
    for (;;) {
        const int item = next_item(ctl + CW_QTAB, slot);
        if (item >= TAB_ITEMS) break;
        const int rr = item * 16 + wave;
    {
        unsigned* U8 = (unsigned*)(ws + WS_U); unsigned* V8 = (unsigned*)(ws + WS_V); float* ISC = (float*)(ws + WS_ISC);
        {
            f32x4 v[2][8]; float am[2];
#pragma unroll
            for (int q = 0; q < 2; ++q) {
                const int r = rr + q * 8; const bool isu = r < 16384; const int e = r & 16383;
                const f32x4* xr = (const f32x4*)((isu ? a.pu : a.pv) + (size_t)e * DM) + lane;
#pragma unroll
                for (int j = 0; j < 8; ++j) v[q][j] = xr[64 * j];
            }
#pragma unroll
            for (int q = 0; q < 2; ++q) if (rr + q * 8 < 16384) {
#pragma unroll
                for (int j = 0; j < 8; ++j) v[q][j] = v[q][j] * ((const f32x4*)a.nfw_ffn)[64 * j + lane]; }
#pragma unroll
            for (int q = 0; q < 2; ++q) { float t = 0.f;
#pragma unroll
                for (int j = 0; j < 8; ++j) t = fmaxf(t, fmaxf(fmaxf(fabsf(v[q][j][0]), fabsf(v[q][j][1])), fmaxf(fabsf(v[q][j][2]), fabsf(v[q][j][3]))));
                am[q] = t; }
#pragma unroll
            for (int o = 1; o < 64; o <<= 1) { am[0] = fmaxf(am[0], __shfl_xor(am[0], o)); am[1] = fmaxf(am[1], __shfl_xor(am[1], o)); }
#pragma unroll
            for (int q = 0; q < 2; ++q) {
                const int r = rr + q * 8; const bool isu = r < 16384; const int e = r & 16383;
                const float top = isu ? 127.f : 256.f;
                const float sc = am[q] > 0.f ? top / am[q] : 0.f;
                unsigned* o8 = isu ? U8 : V8;
#pragma unroll
                for (int j = 0; j < 8; ++j) { int w;
                    if (isu) { const int q0 = (int)rintf(v[q][j][0] * sc), q1 = (int)rintf(v[q][j][1] * sc), q2 = (int)rintf(v[q][j][2] * sc), q3 = (int)rintf(v[q][j][3] * sc);
                        w = (int)((unsigned)(q0 & 255) | ((unsigned)(q1 & 255) << 8) | ((unsigned)(q2 & 255) << 16) | ((unsigned)q3 << 24)); }
                    else { w = __builtin_amdgcn_cvt_pk_fp8_f32(v[q][j][0] * sc, v[q][j][1] * sc, 0, false); w = __builtin_amdgcn_cvt_pk_fp8_f32(v[q][j][2] * sc, v[q][j][3] * sc, w, true); }
                    o8[((size_t)j * 16384 + e) * 64 + lane] = (unsigned)w; }
                if (lane == 0) ISC[(isu ? 0 : 16384) + e] = am[q] / top;
            }
        }
    }
    }
}

namespace att {
using bf16x8 = __attribute__((ext_vector_type(8))) short;
using s16x4 = __attribute__((ext_vector_type(4))) short;
using f32x16 = __attribute__((ext_vector_type(16))) float;
using u32x4 = __attribute__((ext_vector_type(4))) unsigned;
constexpr int SHM_V = 16384, SHM_K = 16384;
constexpr int L_V = 0, L_K = 2 * SHM_V, L_WS = L_K + 2 * SHM_K, L_P = L_WS + 8 * 64 * 4, L_END = L_P + 4 * 4096;
#define KSWZ(row, colB) ((row) * 256 + ((colB) ^ (((row) & 7) << 4)))
#define SBAR() __builtin_amdgcn_sched_barrier(0)
__device__ __forceinline__ int crow(int r, int hi) { return (r & 3) + 8 * (r >> 2) + 4 * hi; }
__device__ __forceinline__ unsigned cvtpk(float lo, float hi) { unsigned r; asm volatile("v_cvt_pk_bf16_f32 %0, %1, %2" : "=v"(r) : "v"(lo), "v"(hi)); return r; }
__device__ __forceinline__ int v_st(int k, int c) { const int kk = (k & ~0xC) | ((k & 4) << 1) | ((k & 8) >> 1); return ((kk >> 3) * 4 + (c >> 5)) * 512 + ((kk & 7) * 32 + (c & 31)) * 2; }
__device__ __forceinline__ int v_rd_base(int lane) { return ((lane & 3) << 3) | (((lane >> 2) & 3) << 6) | (((lane >> 4) & 1) << 5) | (((lane >> 5) & 1) << 8); }
constexpr int v_rd_off(int d0, int ks, int half) { return d0 * 512 + ks * 4096 + half * 2048; }
template <int OFF> __device__ __forceinline__ s16x4 tr_read(int vb) { s16x4 r; asm volatile("ds_read_b64_tr_b16 %0, %1 offset:%2" : "=&v"(r) : "v"(vb), "i"(OFF) : "memory"); return r; }
template <int D0> __device__ __forceinline__ void pv_one(f32x16& od, int vb, bf16x8 pa0, bf16x8 pa1, bf16x8 pa2, bf16x8 pa3) {
    const s16x4 l0 = tr_read<v_rd_off(D0, 0, 0)>(vb), h0 = tr_read<v_rd_off(D0, 0, 1)>(vb), l1 = tr_read<v_rd_off(D0, 1, 0)>(vb), h1 = tr_read<v_rd_off(D0, 1, 1)>(vb);
    const s16x4 l2 = tr_read<v_rd_off(D0, 2, 0)>(vb), h2 = tr_read<v_rd_off(D0, 2, 1)>(vb), l3 = tr_read<v_rd_off(D0, 3, 0)>(vb), h3 = tr_read<v_rd_off(D0, 3, 1)>(vb);
    asm volatile("s_waitcnt lgkmcnt(0)" ::: "memory"); SBAR();
#define PK(L, H) (bf16x8){L[0], L[1], L[2], L[3], H[0], H[1], H[2], H[3]}
    od = __builtin_amdgcn_mfma_f32_32x32x16_bf16(pa0, PK(l0, h0), od, 0, 0, 0);
    od = __builtin_amdgcn_mfma_f32_32x32x16_bf16(pa1, PK(l1, h1), od, 0, 0, 0);
    od = __builtin_amdgcn_mfma_f32_32x32x16_bf16(pa2, PK(l2, h2), od, 0, 0, 0);
    od = __builtin_amdgcn_mfma_f32_32x32x16_bf16(pa3, PK(l3, h3), od, 0, 0, 0);
#undef PK
}
__device__ __forceinline__ void qkt(f32x16& p0, f32x16& p1, const char* Ks, const bf16x8* qr, int r32, int hi, int comp) {
    p0 = f32x16{}; p1 = f32x16{};
#pragma unroll
    for (int d0 = 0; d0 < 4; ++d0) {
        const int cb = (comp * 64 + d0 * 16 + hi * 8) * 2;
        const bf16x8 b0 = *reinterpret_cast<const bf16x8*>(Ks + KSWZ(r32, cb));
        const bf16x8 b1 = *reinterpret_cast<const bf16x8*>(Ks + KSWZ(32 + r32, cb));
        p0 = __builtin_amdgcn_mfma_f32_32x32x16_bf16(b0, qr[d0], p0, 0, 0, 0);
        p1 = __builtin_amdgcn_mfma_f32_32x32x16_bf16(b1, qr[d0], p1, 0, 0, 0);
    }
}

__device__ __forceinline__ void attn_unit(int b, int h, int qb, const bf16_t* Z, bf16_t* MIX, float lam, const float* subln, char* lds) {
    const int tid = opaque_tid(), wid = __builtin_amdgcn_readfirstlane(tid >> 6), lane = tid & 63, r32 = lane & 31, hi = lane >> 5;
    const int comp = wid >> 2, rg = wid & 3;
    char* V_lds = lds + L_V; char* K_lds = lds + L_K;
    float* wsf = (float*)(lds + L_WS) + wid * 64;
    const int q0 = b * SEQ + qb * 128;
    const float NEGV = -1e30f;
    bf16x8 qr[4];
    {
        const bf16_t* Qw = Z + (size_t)(q0 + rg * 32 + r32) * NZ + ZQ + h * 128 + comp * 64 + hi * 8;
#pragma unroll
        for (int d0 = 0; d0 < 4; ++d0) qr[d0] = *reinterpret_cast<const bf16x8*>(Qw + d0 * 16);
    }
    const int NT = 2 * qb + 3;
    const int sr = tid >> 4, sc = (tid & 15) * 8;
    const int vst0 = v_st(sr, sc), vst1 = v_st(32 + sr, sc), kst0 = KSWZ(sr, sc * 2), kst1 = KSWZ(32 + sr, sc * 2);
    const int vb0 = (int)(uintptr_t)V_lds + v_rd_base(lane);
#define PK4(P, BASE, OUT) do { unsigned a0 = cvtpk(P[BASE + 0], P[BASE + 1]), a1 = cvtpk(P[BASE + 2], P[BASE + 3]); \
        unsigned b0 = cvtpk(P[BASE + 4], P[BASE + 5]), b1 = cvtpk(P[BASE + 6], P[BASE + 7]); \
        auto r0 = __builtin_amdgcn_permlane32_swap(a0, b0, false, false); auto r1 = __builtin_amdgcn_permlane32_swap(a1, b1, false, false); \
        u32x4 w = {r0[0], r1[0], r0[1], r1[1]}; OUT = *reinterpret_cast<bf16x8*>(&w); } while (0)
    bf16x8 vsA0, vsA1, ksA0, ksA1, vsB0, vsB1, ksB0, ksB1;
#define SLOAD(j, S) do { const size_t r0_ = (size_t)((j) == 0 ? META_TILE0 : b * SEQ + ((j) - 1) * 64) + sr; const bf16_t* zp_ = Z + r0_ * NZ + h * 128 + sc; \
        vs##S##0 = *reinterpret_cast<const bf16x8*>(zp_ + ZV); vs##S##1 = *reinterpret_cast<const bf16x8*>(zp_ + ZV + (size_t)32 * NZ); \
        ks##S##0 = *reinterpret_cast<const bf16x8*>(zp_ + ZK); ks##S##1 = *reinterpret_cast<const bf16x8*>(zp_ + ZK + (size_t)32 * NZ); } while (0)
#define SWRITE(bi, S) do { *reinterpret_cast<bf16x8*>(V_lds + (bi) * SHM_V + vst0) = vs##S##0; *reinterpret_cast<bf16x8*>(V_lds + (bi) * SHM_V + vst1) = vs##S##1; \
        *reinterpret_cast<bf16x8*>(K_lds + (bi) * SHM_K + kst0) = ks##S##0; *reinterpret_cast<bf16x8*>(K_lds + (bi) * SHM_K + kst1) = ks##S##1; } while (0)
    f32x16 o[4] = {}; float m_reg = NEGV, l_reg = 0.f;
    SLOAD(0, A); SWRITE(0, A); SLOAD(1, B); __syncthreads();
    const int qrel = rg * 32 + r32;
#define ATT_TILE(j, L_, W_) do { \
        const int cur = j & 1; \
        if (j + 2 < NT) SLOAD(j + 2, L_); \
        f32x16 p0, p1; \
        qkt(p0, p1, K_lds + cur * SHM_K, qr, r32, hi, comp); \
        if (j == 0) { \
    _Pragma("unroll") \
            for (int r = 0; r < 16; ++r) { p0[r] = NEGV; if (r < 8) p1[r] = NEGV; } \
        } else if (j >= NT - 2) { \
            const int kb0 = (j - (NT - 2)) * 64; \
    _Pragma("unroll") \
            for (int r = 0; r < 16; ++r) { const int kl = kb0 + crow(r, hi); if (kl > qrel) p0[r] = NEGV; if (kl + 32 > qrel) p1[r] = NEGV; } \
        } \
        float pmax = p0[0]; \
    _Pragma("unroll") \
        for (int r = 1; r < 16; ++r) pmax = fmaxf(pmax, p0[r]); \
    _Pragma("unroll") \
        for (int r = 0; r < 16; ++r) pmax = fmaxf(pmax, p1[r]); \
        { auto rr = __builtin_amdgcn_permlane32_swap(__float_as_uint(pmax), __float_as_uint(pmax), false, false); pmax = fmaxf(__uint_as_float(rr[0]), __uint_as_float(rr[1])); } \
        const float mn = fmaxf(m_reg, pmax); const float alpha = __builtin_amdgcn_exp2f(m_reg - mn); m_reg = mn; \
        float ps = 0.f; \
    _Pragma("unroll") \
        for (int r = 0; r < 16; ++r) { p0[r] = __builtin_amdgcn_exp2f(p0[r] - mn); ps += p0[r]; } \
    _Pragma("unroll") \
        for (int r = 0; r < 16; ++r) { p1[r] = __builtin_amdgcn_exp2f(p1[r] - mn); ps += p1[r]; } \
        { auto rr = __builtin_amdgcn_permlane32_swap(__float_as_uint(ps), __float_as_uint(ps), false, false); ps = __uint_as_float(rr[0]) + __uint_as_float(rr[1]); } \
        l_reg = l_reg * alpha + ps; \
        if (__any(alpha < 1.f)) { \
            if (hi == 0) wsf[r32] = alpha; \
            asm volatile("s_waitcnt lgkmcnt(0)" ::: "memory"); \
            float al[16]; \
    _Pragma("unroll") \
            for (int r = 0; r < 16; ++r) al[r] = wsf[crow(r, hi)]; \
    _Pragma("unroll") \
            for (int d = 0; d < 4; ++d) \
    _Pragma("unroll") \
                for (int r = 0; r < 16; ++r) o[d][r] *= al[r]; \
            asm volatile("s_waitcnt lgkmcnt(0)" ::: "memory"); \
        } \
        bf16x8 pa0, pa1, pa2, pa3; \
        PK4(p0, 0, pa0); PK4(p0, 8, pa1); PK4(p1, 0, pa2); PK4(p1, 8, pa3); \
        SBAR(); \
        { const int vb = vb0 + cur * SHM_V; \
          pv_one<0>(o[0], vb, pa0, pa1, pa2, pa3); pv_one<1>(o[1], vb, pa0, pa1, pa2, pa3); pv_one<2>(o[2], vb, pa0, pa1, pa2, pa3); pv_one<3>(o[3], vb, pa0, pa1, pa2, pa3); } \
        if (j + 1 < NT) SWRITE(cur ^ 1, W_); \
        __syncthreads(); \
    } while (0)
    {
        SLOAD(2, A);
        f32x16 p1 = f32x16{};
#pragma unroll
        for (int d0 = 0; d0 < 4; ++d0) {
            const int cb = (comp * 64 + d0 * 16 + hi * 8) * 2;
            const bf16x8 b1 = *reinterpret_cast<const bf16x8*>(K_lds + KSWZ(32 + r32, cb));
            p1 = __builtin_amdgcn_mfma_f32_32x32x16_bf16(b1, qr[d0], p1, 0, 0, 0);
        }
        float pmax = p1[8];
#pragma unroll
        for (int r = 9; r < 16; ++r) pmax = fmaxf(pmax, p1[r]);
        { auto rr = __builtin_amdgcn_permlane32_swap(__float_as_uint(pmax), __float_as_uint(pmax), false, false); pmax = fmaxf(__uint_as_float(rr[0]), __uint_as_float(rr[1])); }
        m_reg = pmax;
        float ps = 0.f;
#pragma unroll
        for (int r = 0; r < 8; ++r) p1[r] = 0.f;
#pragma unroll
        for (int r = 8; r < 16; ++r) { p1[r] = __builtin_amdgcn_exp2f(p1[r] - pmax); ps += p1[r]; }
        { auto rr = __builtin_amdgcn_permlane32_swap(__float_as_uint(ps), __float_as_uint(ps), false, false); ps = __uint_as_float(rr[0]) + __uint_as_float(rr[1]); }
        l_reg = ps;
        bf16x8 pa3; PK4(p1, 8, pa3);
        SBAR();
        {
#define PKF(L, H) (bf16x8){L[0], L[1], L[2], L[3], H[0], H[1], H[2], H[3]}
            const s16x4 l0 = tr_read<v_rd_off(0, 3, 0)>(vb0), h0 = tr_read<v_rd_off(0, 3, 1)>(vb0), l1 = tr_read<v_rd_off(1, 3, 0)>(vb0), h1 = tr_read<v_rd_off(1, 3, 1)>(vb0);
            const s16x4 l2 = tr_read<v_rd_off(2, 3, 0)>(vb0), h2 = tr_read<v_rd_off(2, 3, 1)>(vb0), l3 = tr_read<v_rd_off(3, 3, 0)>(vb0), h3 = tr_read<v_rd_off(3, 3, 1)>(vb0);
            asm volatile("s_waitcnt lgkmcnt(0)" ::: "memory"); SBAR();
            o[0] = __builtin_amdgcn_mfma_f32_32x32x16_bf16(pa3, PKF(l0, h0), o[0], 0, 0, 0); o[1] = __builtin_amdgcn_mfma_f32_32x32x16_bf16(pa3, PKF(l1, h1), o[1], 0, 0, 0);
            o[2] = __builtin_amdgcn_mfma_f32_32x32x16_bf16(pa3, PKF(l2, h2), o[2], 0, 0, 0); o[3] = __builtin_amdgcn_mfma_f32_32x32x16_bf16(pa3, PKF(l3, h3), o[3], 0, 0, 0);
#undef PKF
        }
        SWRITE(1, B);
        __syncthreads();
    }
    for (int j = 1; j < NT; j += 2) { ATT_TILE(j, B, A); ATT_TILE(j + 1, A, B); }
#undef ATT_TILE
#undef SLOAD
#undef SWRITE
#undef PK4
    if (hi == 0) wsf[r32] = l_reg;
    asm volatile("s_waitcnt lgkmcnt(0)" ::: "memory");
    float rli[16];
#pragma unroll
    for (int r = 0; r < 16; ++r) rli[r] = __builtin_amdgcn_rcpf(wsf[crow(r, hi)]);
    float* X = (float*)lds + rg * 4096;
    if (comp == 1) {
#pragma unroll
        for (int d0 = 0; d0 < 4; ++d0)
#pragma unroll
            for (int r = 0; r < 16; ++r) X[(d0 * 16 + r) * 64 + lane] = o[d0][r] * rli[r] * lam;
    }
    __syncthreads();
    if (comp == 0) {
        float ssr[16];
#pragma unroll
        for (int r = 0; r < 16; ++r) ssr[r] = 0.f;
#pragma unroll
        for (int d0 = 0; d0 < 4; ++d0)
#pragma unroll
            for (int r = 0; r < 16; ++r) { const float v = o[d0][r] * rli[r] - X[(d0 * 16 + r) * 64 + lane]; o[d0][r] = v; ssr[r] += v * v; }
        float* P = (float*)(lds + L_P) + rg * 1024;
#pragma unroll
        for (int r = 0; r < 16; ++r) P[r * 64 + lane] = ssr[r];
        asm volatile("s_waitcnt lgkmcnt(0)" ::: "memory");
        {
            const int rho = lane & 31, hh = (rho >> 2) & 1, rr = (rho & 3) + 4 * (rho >> 3);
            const float4* pp = (const float4*)(P + rr * 64 + hh * 32 + (lane >> 5) * 16);
            const float4 a0 = pp[0], a1 = pp[1], a2 = pp[2], a3 = pp[3];
            float s = ((a0.x + a0.y) + (a0.z + a0.w)) + ((a1.x + a1.y) + (a1.z + a1.w)) + ((a2.x + a2.y) + (a2.z + a2.w)) + ((a3.x + a3.y) + (a3.z + a3.w));
            auto sw = __builtin_amdgcn_permlane32_swap(__float_as_uint(s), __float_as_uint(s), false, false); s = __uint_as_float(sw[0]) + __uint_as_float(sw[1]);
            if (lane < 32) wsf[32 + rho] = rsqrtf(s * (1.f / 128.f) + EPS) * (1.f - LAMBDA_INIT);
        }
        asm volatile("s_waitcnt lgkmcnt(0)" ::: "memory");
        float sw4[4];
#pragma unroll
        for (int d0 = 0; d0 < 4; ++d0) sw4[d0] = subln[d0 * 32 + r32];
        bf16_t* Ow = MIX + (size_t)(q0 + rg * 32) * DM + h * 128 + r32;
#pragma unroll
        for (int r = 0; r < 16; ++r) {
            const int orow = crow(r, hi); const float rs = wsf[32 + orow];
#pragma unroll
            for (int d0 = 0; d0 < 4; ++d0) Ow[(size_t)orow * DM + d0 * 32] = (bf16_t)f2bf(o[d0][r] * rs * sw4[d0]);
        }
    }
    __syncthreads();
}
#undef KSWZ
#undef SBAR
}

__device__ __forceinline__ float attn_lambda(const Args& a) {
    const int lane = opaque_tid() & 63;
    const float l1 = wave_sum(a.lamqk[lane] * a.lamqk[64 + lane]), l2 = wave_sum(a.lamqk[128 + lane] * a.lamqk[192 + lane]);
    return expf(l1) - expf(l2) + LAMBDA_INIT;
}
namespace mls {
using bf16x8 = __attribute__((ext_vector_type(8))) short;
using bf16x4 = __attribute__((ext_vector_type(4))) short;
using s16x4 = __attribute__((ext_vector_type(4))) short;
using f32x16 = __attribute__((ext_vector_type(16))) float;
using f32x4v = __attribute__((ext_vector_type(4))) float;
using u32x4v = __attribute__((ext_vector_type(4))) unsigned;
using u32x2v = __attribute__((ext_vector_type(2))) unsigned;
constexpr int L_QS = 0, L_QP = 16384, L_KS = 32768, L_KW = 49152, L_VT = 65536, L_PT = 98304, L_HT = 106496, HT_STRIDE = 528;
constexpr int L_MISC = L_HT + 64 * HT_STRIDE;
constexpr int L_RS = L_MISC, L_QN = L_RS + 2 * 64 * 4, L_NV = L_QN + 64 * 4, L_NP = L_NV + 128 * 4, L_CW = L_NP + 8 * 128 * 4, L_RD = L_CW + 5 * 256 * 4, L_NW = L_RD + 8 * 64 * 4, L_END = L_NW + 8 * 36 * 4;
#define KSWZ(row, colB) ((row) * 256 + ((colB) ^ (((row) & 7) << 4)))
#define PSWZ(row, colB) ((row) * 128 + ((colB) ^ ((((row) >> 1) & 7) << 4)))
__device__ __forceinline__ int crow(int r, int hi) { return (r & 3) + 8 * (r >> 2) + 4 * hi; }
__device__ __forceinline__ unsigned cvtpk(float lo, float hi) { unsigned r; asm volatile("v_cvt_pk_bf16_f32 %0, %1, %2" : "=v"(r) : "v"(lo), "v"(hi)); return r; }
__device__ __forceinline__ int v_st(int k, int c) { const int kk = (k & ~0xC) | ((k & 4) << 1) | ((k & 8) >> 1); return ((kk >> 3) * 4 + (c >> 5)) * 512 + ((kk & 7) * 32 + (c & 31)) * 2; }
__device__ __forceinline__ int v_rd_base(int lane) { return ((lane & 3) << 3) | (((lane >> 2) & 3) << 6) | (((lane >> 4) & 1) << 5) | (((lane >> 5) & 1) << 8); }
__device__ __forceinline__ s16x4 tr_read_dyn(int addr) { s16x4 r; asm volatile("ds_read_b64_tr_b16 %0, %1" : "=&v"(r) : "v"(addr) : "memory"); return r; }
__device__ __forceinline__ bf16x8 tr_frag(int img_plus_base, int d0, int ks) {
    const s16x4 lo = tr_read_dyn(img_plus_base + d0 * 512 + ks * 4096), hi = tr_read_dyn(img_plus_base + d0 * 512 + ks * 4096 + 2048);
    return (bf16x8){lo[0], lo[1], lo[2], lo[3], hi[0], hi[1], hi[2], hi[3]};
}
template <int CTRL, int RMASK> __device__ __forceinline__ float dppf(float old, float v) { return __builtin_bit_cast(float, __builtin_amdgcn_update_dpp(__builtin_bit_cast(int, old), __builtin_bit_cast(int, v), CTRL, RMASK, 0xf, false)); }
__device__ __forceinline__ float scan_add(float v) {
    v += dppf<0x111, 0xf>(0.f, v); v += dppf<0x112, 0xf>(0.f, v); v += dppf<0x114, 0xf>(0.f, v); v += dppf<0x118, 0xf>(0.f, v);
    v += dppf<0x142, 0xa>(0.f, v); v += dppf<0x143, 0xc>(0.f, v); return v;
}
__device__ __forceinline__ float scan_max(float v) {
    const float NI = -3.0e38f;
    v = fmaxf(v, dppf<0x111, 0xf>(NI, v)); v = fmaxf(v, dppf<0x112, 0xf>(NI, v)); v = fmaxf(v, dppf<0x114, 0xf>(NI, v)); v = fmaxf(v, dppf<0x118, 0xf>(NI, v));
    v = fmaxf(v, dppf<0x142, 0xa>(NI, v)); v = fmaxf(v, dppf<0x143, 0xc>(NI, v)); return v;
}
__device__ __forceinline__ float rlane(float v, int l) { return __uint_as_float(__builtin_amdgcn_readlane(__float_as_uint(v), l)); }
__device__ __forceinline__ float silu(float x) { return x * __builtin_amdgcn_rcpf(1.f + __expf(-x)); }
__device__ __forceinline__ void fmac_v(float& y, float a, float b) { asm("v_fmac_f32 %0, %1, %2" : "+v"(y) : "v"(a), "v"(b)); }
__device__ __forceinline__ float mul_v(float a, float b) { float r; asm("v_mul_f32 %0, %1, %2" : "=v"(r) : "v"(a), "v"(b)); return r; }

__device__ __forceinline__ void mlstm_item(int b, int h, const Args& a, char* lds) {
    const int tid0 = opaque_tid(), wid = __builtin_amdgcn_readfirstlane(tid0 >> 6);
    const bf16_t* Z = (const bf16_t*)(a.ws + WS_Z); const float* G = (const float*)(a.ws + WS_GATES); bf16_t* MIX = (bf16_t*)(a.ws + WS_MIX);
    const int ldsb = (int)(uintptr_t)lds;
    float* RS = (float*)(lds + L_RS); float* QN = (float*)(lds + L_QN); float* NV = (float*)(lds + L_NV); float* NP = (float*)(lds + L_NP); float* CW = (float*)(lds + L_CW);
    for (int i = tid0; i < 5 * 256; i += NTHREADS) { const int j = i >> 8, c = i & 255; const int cc = c < 128 ? h * 128 + c : 512 + h * 128 + (c - 128); CW[i] = j < 4 ? a.convw[j * 1024 + cc] : a.convb[cc]; }
    if (tid0 < 128) NV[tid0] = 0.f;
    if (tid0 < 256) ((float*)(lds + L_NW))[(tid0 >> 5) * 36 + (tid0 & 31)] = a.mnw[h * 256 + tid0];
    const float ibh = a.ib[h], fbh = a.fb[h];
    float cw[4][4], cb[4];
    __syncthreads();
    { const int c4 = 4 * (tid0 & 63);
#pragma unroll
    for (int j = 0; j < 4; ++j)
#pragma unroll
        for (int q = 0; q < 4; ++q) cw[j][q] = CW[j * 256 + c4 + q];
#pragma unroll
    for (int q = 0; q < 4; ++q) cb[q] = CW[4 * 256 + c4 + q]; }
    f32x16 C[4] = {};
    float m_prev = -1e30f;
    u32x2v rq[11]; u32x4v rv[4]; float gi, gf;
    auto chunk_row0 = [&](int c) -> int { return c == 0 ? META_TILE0 : b * SEQ + (c - 1) * 64; };
#define LOAD_RAW(c) do { int tq_ = tid0; asm volatile("" : "+v"(tq_)); const int ln_ = tq_ & 63, c4_ = 4 * ln_, zc_qk = (c4_ < 128 ? ZMQ + h * 128 + c4_ : ZMK + h * 128 + (c4_ - 128)), erow = tq_ >> 3, eseg = tq_ & 7; const int r0_ = chunk_row0(c); \
        _Pragma("unroll") for (int i_ = 0; i_ < 11; ++i_) { const int t_ = 8 * wid - 3 + i_; int row_; bool ok_ = true; \
            if (t_ >= 0) row_ = r0_ + t_; else if ((c) == 0) { row_ = 0; ok_ = false; } else if ((c) == 1) row_ = META_TILE0 + 64 + t_; else row_ = r0_ + t_; \
            rq[i_] = ok_ ? *(const u32x2v*)(Z + (size_t)row_ * NZ + zc_qk) : (u32x2v){0u, 0u}; } \
        _Pragma("unroll") for (int i_ = 0; i_ < 4; ++i_) rv[i_] = *(const u32x4v*)(Z + (size_t)(r0_ + erow) * NZ + ZMV + h * 256 + eseg * 32 + 8 * i_); \
        { const int rowg_ = r0_ + ln_; gi = G[(size_t)rowg_ * 8 + h]; gf = G[(size_t)rowg_ * 8 + 4 + h]; } } while (0)
    LOAD_RAW(0);
    const int NCH = 33;
    for (int c = 0; c < NCH; ++c) {
        int tid = tid0; asm volatile("" : "+v"(tid));
        const int lane = tid & 63, r32 = lane & 31, hi = lane >> 5, cq = lane, c4 = 4 * cq, erow = tid >> 3, eseg = tid & 7;
        float* RD = (float*)(lds + L_RD) + wid * 64;
        float li = gi + ibh; float lf; { const float xf = gf + fbh; lf = fminf(xf, 0.f) - __logf(1.f + __expf(-fabsf(xf))); }
        if (c == 0 && lane < 48) { li = -1e30f; lf = 0.f; }
        const float bsum = scan_add(lf);
        const float u = li - bsum;
        const float cm = scan_max(u);
        const float Mrow = fmaxf(cm, m_prev);
        const float iw = __expf(m_prev - Mrow);
        const float Mend = rlane(Mrow, 63), gtot = rlane(bsum, 63);
        const float wrow = __expf(u - Mend);
        const float dec = __expf(m_prev - Mend);
        const float dexp = __expf(-(bsum + Mrow));
        {
            float qn_part[8], ksum[4] = {0.f, 0.f, 0.f, 0.f};
            float nvv[4];
#pragma unroll
            for (int q = 0; q < 4; ++q) nvv[q] = (cq < 32) ? NV[c4 + q] : 0.f;
#pragma unroll
            for (int i = 0; i < 8; ++i) {
                const int t = 8 * wid + i;
                float xo[4];
#pragma unroll
                for (int q = 0; q < 4; ++q) xo[q] = cb[q];
#pragma unroll
                for (int j = 0; j < 4; ++j) {
                    const u32x2v rr = rq[i + j];
                    fmac_v(xo[0], cw[j][0], bf_lo(rr.x)); fmac_v(xo[1], cw[j][1], bf_hi(rr.x)); fmac_v(xo[2], cw[j][2], bf_lo(rr.y)); fmac_v(xo[3], cw[j][3], bf_hi(rr.y));
                }
#pragma unroll
                for (int q = 0; q < 4; ++q) xo[q] = silu(xo[q]);
                const float iw_t = rlane(iw, t), w_t = rlane(wrow, t);
                if (cq < 32) {
#pragma unroll
                    for (int q = 0; q < 4; ++q) xo[q] = mul_v(xo[q], 0.08838834764831845f);
                    *(uint2*)(lds + L_QS + KSWZ(t, c4 * 2)) = make_uint2(cvtpk(xo[0], xo[1]), cvtpk(xo[2], xo[3]));
                    float qd = 0.f;
#pragma unroll
                    for (int q = 0; q < 4; ++q) { fmac_v(qd, xo[q], nvv[q]); xo[q] = mul_v(xo[q], iw_t); }
                    *(uint2*)(lds + L_QP + KSWZ(t, c4 * 2)) = make_uint2(cvtpk(xo[0], xo[1]), cvtpk(xo[2], xo[3]));
                    qn_part[i] = iw_t * qd;
                } else {
                    const int kc = c4 - 128;
                    *(uint2*)(lds + L_KS + KSWZ(t, kc * 2)) = make_uint2(cvtpk(xo[0], xo[1]), cvtpk(xo[2], xo[3]));
#pragma unroll
                    for (int q = 0; q < 4; ++q) { xo[q] = mul_v(xo[q], w_t); ksum[q] += xo[q]; }
                    *(uint2*)(lds + L_KW + v_st(t, kc)) = make_uint2(cvtpk(xo[0], xo[1]), cvtpk(xo[2], xo[3]));
                    qn_part[i] = 0.f;
                }
                __builtin_amdgcn_sched_barrier(0);
            }
            {
                float r4[4], r2[2], r1;
                { const bool hb = (lane & 16) != 0;
#pragma unroll
                  for (int i = 0; i < 4; ++i) { const float send = hb ? qn_part[i] : qn_part[i + 4]; const float recv = __shfl_xor(send, 16); r4[i] = (hb ? qn_part[i + 4] : qn_part[i]) + recv; } }
                { const bool hb = (lane & 8) != 0;
#pragma unroll
                  for (int i = 0; i < 2; ++i) { const float send = hb ? r4[i] : r4[i + 2]; const float recv = __shfl_xor(send, 8); r2[i] = (hb ? r4[i + 2] : r4[i]) + recv; } }
                { const bool hb = (lane & 4) != 0; const float send = hb ? r2[0] : r2[1]; const float recv = __shfl_xor(send, 4); r1 = (hb ? r2[1] : r2[0]) + recv; }
                r1 += __shfl_xor(r1, 2); r1 += __shfl_xor(r1, 1);
                if (lane < 32 && (lane & 3) == 0) QN[8 * wid + ((lane >> 4) & 1) * 4 + ((lane >> 3) & 1) * 2 + ((lane >> 2) & 1)] = r1;
            }
            if (cq >= 32) {
#pragma unroll
                for (int q = 0; q < 4; ++q) NP[wid * 128 + (c4 - 128) + q] = ksum[q];
            }
#pragma unroll
            for (int i = 0; i < 4; ++i) *(u32x4v*)(lds + L_VT + (eseg >> 2) * 16384 + v_st(erow, (eseg & 3) * 32 + 8 * i)) = rv[i];
        }
        u32x4v zo[4];
        {
            const int r0 = chunk_row0(c);
#pragma unroll
            for (int i = 0; i < 4; ++i) zo[i] = *(const u32x4v*)(Z + (size_t)(r0 + erow) * NZ + ZMO + h * 256 + eseg * 32 + 8 * i);
        }
        if (c + 1 < NCH) LOAD_RAW(c + 1);
        __syncthreads();
        {
            const int tb = wid >> 1, half = wid & 1;
            float rsum[4] = {0.f, 0.f, 0.f, 0.f};
            const int fr = lane & 15, fq = lane >> 4;
            float Mt[4];
#pragma unroll
            for (int i = 0; i < 4; ++i) Mt[i] = __shfl(Mrow, 16 * tb + 4 * fq + i);
#pragma unroll
            for (int sj = 0; sj < 2; ++sj) {
                const int sb = 2 * half + sj;
                unsigned short pw[4] = {0, 0, 0, 0};
                if (sb <= tb) {
                    f32x4v acc = {0.f, 0.f, 0.f, 0.f};
#pragma unroll
                    for (int ks = 0; ks < 4; ++ks) {
                        const bf16x8 af = *(const bf16x8*)(lds + L_QS + KSWZ(16 * tb + fr, (32 * ks + 8 * fq) * 2));
                        const bf16x8 bfr = *(const bf16x8*)(lds + L_KS + KSWZ(16 * sb + fr, (32 * ks + 8 * fq) * 2));
                        acc = __builtin_amdgcn_mfma_f32_16x16x32_bf16(af, bfr, acc, 0, 0, 0);
                    }
                    const int s = 16 * sb + fr; const float us = __shfl(u, s);
#pragma unroll
                    for (int i = 0; i < 4; ++i) {
                        const int t = 16 * tb + 4 * fq + i;
                        const float p = (s <= t) ? acc[i] * __expf(us - Mt[i]) : 0.f;
                        rsum[i] += p; pw[i] = (unsigned short)f2bf(p);
                    }
                }
#pragma unroll
                for (int i = 0; i < 4; ++i) *(unsigned short*)(lds + L_PT + PSWZ(16 * tb + 4 * fq + i, (16 * sb + fr) * 2)) = pw[i];
            }
#pragma unroll
            for (int i = 0; i < 4; ++i) {
                float v = rsum[i];
                v += __shfl_xor(v, 1); v += __shfl_xor(v, 2); v += __shfl_xor(v, 4); v += __shfl_xor(v, 8);
                if (fr == 0) RS[half * 64 + 16 * tb + 4 * fq + i] = v;
            }
        }
        __syncthreads();
        {
            const float nq = RS[lane] + RS[64 + lane] + QN[lane];
            RD[lane] = __builtin_amdgcn_rcpf(fmaxf(fabsf(nq), dexp));
            bf16x8 vf[4];
            const int vimg = ldsb + L_VT + (wid >> 2) * 16384 + v_rd_base(lane);
#pragma unroll
            for (int ks = 0; ks < 4; ++ks) vf[ks] = tr_frag(vimg, wid & 3, ks);
            asm volatile("s_waitcnt lgkmcnt(0)" ::: "memory"); __builtin_amdgcn_sched_barrier(0);
            f32x16 acc[2] = {};
#pragma unroll
            for (int rb = 0; rb < 2; ++rb) {
                const int row = 32 * rb + r32;
#pragma unroll
                for (int ks = 0; ks < 4; ++ks) {
                    if (rb == 0 && ks >= 2) continue;
                    const bf16x8 pf = *(const bf16x8*)(lds + L_PT + PSWZ(row, (16 * ks + 8 * hi) * 2));
                    acc[rb] = __builtin_amdgcn_mfma_f32_32x32x16_bf16(pf, vf[ks], acc[rb], 0, 0, 0);
                }
            }
#pragma unroll
            for (int kb = 0; kb < 4; ++kb)
#pragma unroll
                for (int sp = 0; sp < 2; ++sp) {
                    bf16x8 cf; { unsigned w0 = cvtpk(C[kb][8 * sp + 0], C[kb][8 * sp + 1]), w1 = cvtpk(C[kb][8 * sp + 2], C[kb][8 * sp + 3]), w2 = cvtpk(C[kb][8 * sp + 4], C[kb][8 * sp + 5]), w3 = cvtpk(C[kb][8 * sp + 6], C[kb][8 * sp + 7]);
                        typedef unsigned u32x4_ __attribute__((ext_vector_type(4))); u32x4_ ww = {w0, w1, w2, w3}; cf = __builtin_bit_cast(bf16x8, ww); }
                    const int base = 32 * kb + 16 * sp;
#pragma unroll
                    for (int rb = 0; rb < 2; ++rb) {
                        const int row = 32 * rb + r32;
                        const bf16x4 q0 = *(const bf16x4*)(lds + L_QP + KSWZ(row, (base + 4 * hi) * 2));
                        const bf16x4 q1 = *(const bf16x4*)(lds + L_QP + KSWZ(row, (base + 8 + 4 * hi) * 2));
                        const bf16x8 qf = {q0[0], q0[1], q0[2], q0[3], q1[0], q1[1], q1[2], q1[3]};
                        acc[rb] = __builtin_amdgcn_mfma_f32_32x32x16_bf16(qf, cf, acc[rb], 0, 0, 0);
                    }
                }
            asm volatile("s_waitcnt lgkmcnt(0)" ::: "memory");
#pragma unroll
            for (int rb = 0; rb < 2; ++rb)
#pragma unroll
                for (int r = 0; r < 16; ++r) {
                    const int row = 32 * rb + crow(r, hi);
                    *(unsigned short*)(lds + L_HT + row * HT_STRIDE + (32 * wid + r32) * 2) = (unsigned short)f2bf(acc[rb][r] * RD[row]);
                }
#pragma unroll
            for (int kb = 0; kb < 4; ++kb) {
#pragma unroll
                for (int r = 0; r < 16; ++r) C[kb][r] *= dec;
                const int kimg = ldsb + L_KW + v_rd_base(lane);
                bf16x8 kf[4];
#pragma unroll
                for (int ks = 0; ks < 4; ++ks) kf[ks] = tr_frag(kimg, kb, ks);
                asm volatile("s_waitcnt lgkmcnt(0)" ::: "memory"); __builtin_amdgcn_sched_barrier(0);
#pragma unroll
                for (int ks = 0; ks < 4; ++ks) C[kb] = __builtin_amdgcn_mfma_f32_32x32x16_bf16(kf[ks], vf[ks], C[kb], 0, 0, 0);
            }
            if (tid < 128) { float s = NV[tid] * dec;
#pragma unroll
                for (int w8 = 0; w8 < 8; ++w8) s += NP[w8 * 128 + tid];
                NV[tid] = s; }
        }
        m_prev = gtot + Mend;
        __syncthreads();
        if (c > 0) {
            float hv[32]; float ss = 0.f;
#pragma unroll
            for (int i = 0; i < 4; ++i) {
                const uint4 w = *(const uint4*)(lds + L_HT + erow * HT_STRIDE + eseg * 64 + 16 * i);
                hv[8 * i + 0] = bf_lo(w.x); hv[8 * i + 1] = bf_hi(w.x); hv[8 * i + 2] = bf_lo(w.y); hv[8 * i + 3] = bf_hi(w.y);
                hv[8 * i + 4] = bf_lo(w.z); hv[8 * i + 5] = bf_hi(w.z); hv[8 * i + 6] = bf_lo(w.w); hv[8 * i + 7] = bf_hi(w.w);
            }
#pragma unroll
            for (int i = 0; i < 32; ++i) ss += hv[i] * hv[i];
            ss += __shfl_xor(ss, 1); ss += __shfl_xor(ss, 2); ss += __shfl_xor(ss, 4);
            const float rstd = rsqrtf(ss * (1.f / 256.f) + EPS);
            const float* nw = (const float*)(lds + L_NW) + eseg * 36;
            bf16_t* op = MIX + (size_t)(chunk_row0(c) + erow) * DM + 1024 + h * 256 + eseg * 32;
#pragma unroll
            for (int i = 0; i < 4; ++i) {
                const unsigned zz[4] = {zo[i].x, zo[i].y, zo[i].z, zo[i].w};
                unsigned ow[4];
#pragma unroll
                for (int q = 0; q < 4; ++q) {
                    const float z0 = bf_lo(zz[q]), z1 = bf_hi(zz[q]);
                    const float o0 = hv[8 * i + 2 * q] * rstd * nw[8 * i + 2 * q] * __builtin_amdgcn_rcpf(1.f + __expf(-z0));
                    const float o1 = hv[8 * i + 2 * q + 1] * rstd * nw[8 * i + 2 * q + 1] * __builtin_amdgcn_rcpf(1.f + __expf(-z1));
                    ow[q] = pk2(o0, o1);
                }
                *(uint4*)(op + 8 * i) = make_uint4(ow[0], ow[1], ow[2], ow[3]);
            }
        }
    }
#undef LOAD_RAW
    __syncthreads();
}
#undef KSWZ
#undef PSWZ
}

namespace rt {
using bf16x8 = __attribute__((ext_vector_type(8))) short;
using f32x16 = __attribute__((ext_vector_type(16))) float;
#define CE(a, b) do { const unsigned x_ = (a), y_ = (b); (a) = x_ > y_ ? x_ : y_; (b) = x_ > y_ ? y_ : x_; } while (0)
#define SORT16_DESC(V) do { CE(V[0], V[1]); CE(V[2], V[3]); CE(V[0], V[2]); CE(V[1], V[3]); CE(V[1], V[2]); CE(V[4], V[5]); CE(V[6], V[7]); CE(V[4], V[6]); CE(V[5], V[7]); CE(V[5], V[6]); CE(V[0], V[4]); CE(V[2], V[6]); CE(V[2], V[4]); CE(V[1], V[5]); CE(V[3], V[7]); CE(V[3], V[5]); CE(V[1], V[2]); CE(V[3], V[4]); CE(V[5], V[6]); CE(V[8], V[9]); CE(V[10], V[11]); CE(V[8], V[10]); CE(V[9], V[11]); CE(V[9], V[10]); CE(V[12], V[13]); CE(V[14], V[15]); CE(V[12], V[14]); CE(V[13], V[15]); CE(V[13], V[14]); CE(V[8], V[12]); CE(V[10], V[14]); CE(V[10], V[12]); CE(V[9], V[13]); CE(V[11], V[15]); CE(V[11], V[13]); CE(V[9], V[10]); CE(V[11], V[12]); CE(V[13], V[14]); CE(V[0], V[8]); CE(V[4], V[12]); CE(V[4], V[8]); CE(V[2], V[10]); CE(V[6], V[14]); CE(V[6], V[10]); CE(V[2], V[4]); CE(V[6], V[8]); CE(V[10], V[12]); CE(V[1], V[9]); CE(V[5], V[13]); CE(V[5], V[9]); CE(V[3], V[11]); CE(V[7], V[15]); CE(V[7], V[11]); CE(V[3], V[5]); CE(V[7], V[9]); CE(V[11], V[13]); CE(V[1], V[2]); CE(V[3], V[4]); CE(V[5], V[6]); CE(V[7], V[8]); CE(V[9], V[10]); CE(V[11], V[12]); CE(V[13], V[14]); } while (0)
#define BMERGE16_DESC(V) do { CE(V[0], V[8]); CE(V[1], V[9]); CE(V[2], V[10]); CE(V[3], V[11]); CE(V[4], V[12]); CE(V[5], V[13]); CE(V[6], V[14]); CE(V[7], V[15]); CE(V[0], V[4]); CE(V[1], V[5]); CE(V[2], V[6]); CE(V[3], V[7]); CE(V[8], V[12]); CE(V[9], V[13]); CE(V[10], V[14]); CE(V[11], V[15]); CE(V[0], V[2]); CE(V[1], V[3]); CE(V[4], V[6]); CE(V[5], V[7]); CE(V[8], V[10]); CE(V[9], V[11]); CE(V[12], V[14]); CE(V[13], V[15]); CE(V[0], V[1]); CE(V[2], V[3]); CE(V[4], V[5]); CE(V[6], V[7]); CE(V[8], V[9]); CE(V[10], V[11]); CE(V[12], V[13]); CE(V[14], V[15]); } while (0)

#define TOP16(A, B) do { _Pragma("unroll") for (int i_ = 0; i_ < 16; ++i_) { const unsigned x_ = A[i_], y_ = B[15 - i_]; A[i_] = x_ > y_ ? x_ : y_; } BMERGE16_DESC(A); } while (0)
__device__ __forceinline__ unsigned ord_key(float f) { const unsigned u = __float_as_uint(f); return u ^ (((unsigned)((int)u >> 31)) | 0x80000000u); }
__device__ __forceinline__ float ord_val(unsigned k) { return __uint_as_float((k & 0x80000000u) ? (k ^ 0x80000000u) : ~k); }
__device__ __forceinline__ int crow(int r, int hi) { return (r & 3) + 8 * (r >> 2) + 4 * hi; }

__device__ __forceinline__ void route_item(int tb, int h, const bf16_t* QP, const char* KL, const float* SSQ, int* IDX, float* GATE, int* scr, int lane_in) {
    int lane = lane_in; asm volatile("" : "+v"(lane));
    const int tok = lane & 31, hi = lane >> 5;
    const int row = tb * 32 + tok;
    float rstd;
    { const float4* sp = (const float4*)(SSQ + (size_t)row * 32); float s = 0.f;
#pragma unroll
      for (int i = 0; i < 8; ++i) { const float4 v = sp[i]; s += (v.x + v.y) + (v.z + v.w); }
      rstd = rsqrtf(s * (1.f / DM) + EPS); }
    unsigned top[2][16];
    bf16x8 qf[8], af[2][8];
    unsigned T[16];
#define RT_LOADQ(p_) do { const bf16_t* qp_ = QP + (size_t)row * DM + h * 256 + (p_) * 128 + hi * 8; \
        _Pragma("unroll") for (int ks = 0; ks < 8; ++ks) qf[ks] = *reinterpret_cast<const bf16x8*>(qp_ + ks * 16); } while (0)
#define RT_LOADK(b_, i_) do { const char* kp_ = KL + ((((i_) >> 2) * 128 + ((i_) & 3) * 32 + tok) * 272 + hi * 16); \
        _Pragma("unroll") for (int ks = 0; ks < 8; ++ks) af[b_][ks] = *reinterpret_cast<const bf16x8*>(kp_ + ks * 32); } while (0)
    RT_LOADQ(0); RT_LOADK(0, 0);
#pragma unroll
    for (int i = 0; i < 8; ++i) {
        const int p = i >> 2, kb = i & 3;
        if (i + 1 < 8) RT_LOADK((i + 1) & 1, i + 1);
        f32x16 acc = {};
#pragma unroll
        for (int ks = 0; ks < 8; ++ks) acc = __builtin_amdgcn_mfma_f32_32x32x16_bf16(af[i & 1][ks], qf[ks], acc, 0, 0, 0);
        unsigned K[16];
#pragma unroll
        for (int r = 0; r < 16; ++r) { const int low = 127 - (32 * kb + (r & 3) + 8 * (r >> 2)) - 4 * hi; K[r] = (ord_key(acc[r]) & ~127u) | (unsigned)low; }
        if (i == 3) RT_LOADQ(1);
        SORT16_DESC(K);
        if (kb == 0) {
#pragma unroll
            for (int j = 0; j < 16; ++j) T[j] = K[j];
        } else { TOP16(T, K); }
        if (kb == 3) {
            unsigned O[16];
#pragma unroll
            for (int j = 0; j < 16; ++j) { auto rr = __builtin_amdgcn_permlane32_swap(T[j], T[j], false, false); O[j] = hi ? rr[0] : rr[1]; }
            TOP16(T, O);
#pragma unroll
            for (int j = 0; j < 16; ++j) top[p][j] = T[j];
        }
        __builtin_amdgcn_sched_barrier(0);
    }
#undef RT_LOADQ
#undef RT_LOADK
    float s1[16], s2[16];
#pragma unroll
    for (int i = 0; i < 16; ++i) {
        s1[i] = ord_val(top[0][i] & ~127u) * rstd; s2[i] = ord_val(top[1][i] & ~127u) * rstd;
        scr[i * 64 + lane] = 127 - (int)(top[0][i] & 127u); scr[(16 + i) * 64 + lane] = 127 - (int)(top[1][i] & 127u);
    }
#define CKEY(a_, b_) ((ord_key(s1[a_] + s2[b_]) & ~255u) | (unsigned)(255 - (16 * (a_) + (b_))))
    unsigned A[16], B[16], Cg[16];
#pragma unroll
    for (int b_ = 0; b_ < 16; ++b_) A[b_] = CKEY(0, b_);
#pragma unroll
    for (int b_ = 0; b_ < 8; ++b_) { B[b_] = CKEY(1, b_); B[8 + b_] = CKEY(15 - b_, 0); }
    BMERGE16_DESC(B);
    Cg[0] = CKEY(2, 0); Cg[1] = CKEY(2, 1); Cg[2] = CKEY(2, 2); Cg[3] = CKEY(2, 3); Cg[4] = CKEY(2, 4);
    Cg[5] = CKEY(3, 0); Cg[6] = CKEY(3, 1); Cg[7] = CKEY(3, 2); Cg[8] = CKEY(3, 3);
    Cg[9] = CKEY(4, 0); Cg[10] = CKEY(4, 1); Cg[11] = CKEY(4, 2);
    Cg[12] = CKEY(5, 0); Cg[13] = CKEY(5, 1); Cg[14] = CKEY(6, 0); Cg[15] = CKEY(6, 1);
    SORT16_DESC(Cg);
    { const unsigned d0 = CKEY(7, 0), d1 = CKEY(7, 1); Cg[15] = Cg[15] > d0 ? Cg[15] : d0; Cg[14] = Cg[14] > d1 ? Cg[14] : d1; BMERGE16_DESC(Cg); }
    TOP16(A, B); TOP16(A, Cg);
#undef CKEY
    asm volatile("s_waitcnt lgkmcnt(0)" ::: "memory");
    float e[16]; float z = 0.f; const float mx = ord_val(A[0] & ~255u);
#pragma unroll
    for (int j = 0; j < 16; ++j) { e[j] = __expf(ord_val(A[j] & ~255u) - mx); z += e[j]; }
    const float rz = 1.f / z;
    int* ip = IDX + (size_t)row * 128 + h * 16 + hi * 8; float* gp = GATE + (size_t)row * 128 + h * 16 + hi * 8;
    int oi[8] = {0, 0, 0, 0, 0, 0, 0, 0}; float og[8] = {0.f, 0.f, 0.f, 0.f, 0.f, 0.f, 0.f, 0.f};
#pragma unroll
    for (int j = 0; j < 16; ++j) {
        const int flat = 255 - (int)(A[j] & 255u), a_ = flat >> 4, b_ = flat & 15;
        const int ex = scr[a_ * 64 + lane] * 128 + scr[(16 + b_) * 64 + lane];
        if (j < 8) { if (!hi) { oi[j] = ex; og[j] = e[j] * rz; } } else { if (hi) { oi[j - 8] = ex; og[j - 8] = e[j] * rz; } }
    }
    *(int4*)(ip) = make_int4(oi[0], oi[1], oi[2], oi[3]); *(int4*)(ip + 4) = make_int4(oi[4], oi[5], oi[6], oi[7]);
    *(float4*)(gp) = make_float4(og[0], og[1], og[2], og[3]); *(float4*)(gp + 4) = make_float4(og[4], og[5], og[6], og[7]);
    asm volatile("s_waitcnt lgkmcnt(0)" ::: "memory");
}
#undef CE
#undef TOP16
}

__device__ __forceinline__ void phase_route(const Args& a, unsigned char* lds, int bid, int nb) {
    const int tid = opaque_tid(), wave = __builtin_amdgcn_readfirstlane(tid >> 6), lane = tid & 63;
    const bf16_t* QP = (const bf16_t*)(a.ws + WS_MIX); const bf16_t* SKB = (const bf16_t*)(a.ws + WS_SKB); const float* SSQ = (const float*)(a.ws + WS_SSQ);
    int* IDX = (int*)(a.ws + WS_IDX); float* GATE = (float*)(a.ws + WS_GATE);
    int* scr = (int*)lds + wave * 2048;
    {
        const bf16_t* X1W = (const bf16_t*)(a.ws + WS_HN); signed char* X1Q = (signed char*)(a.ws + WS_X1Q); float* XSC = (float*)(a.ws + WS_XSC);
        for (int row = bid * NWAVES + wave; row < TREAL; row += nb * NWAVES) {
            uint4 xr[4]; float am = 0.f;
#pragma unroll
            for (int j = 0; j < 4; ++j) { xr[j] = *(const uint4*)(X1W + (size_t)row * DM + 8 * lane + 512 * j);
                am = fmaxf(am, fmaxf(fmaxf(fmaxf(fabsf(bf_lo(xr[j].x)), fabsf(bf_hi(xr[j].x))), fmaxf(fabsf(bf_lo(xr[j].y)), fabsf(bf_hi(xr[j].y)))), fmaxf(fmaxf(fabsf(bf_lo(xr[j].z)), fabsf(bf_hi(xr[j].z))), fmaxf(fabsf(bf_lo(xr[j].w)), fabsf(bf_hi(xr[j].w)))))); }
            am = wave_max(am);
            const float sc = am > 0.f ? 127.f / am : 0.f;
#pragma unroll
            for (int j = 0; j < 4; ++j) {
                const unsigned ww[4] = {xr[j].x, xr[j].y, xr[j].z, xr[j].w}; unsigned o[2] = {0u, 0u};
#pragma unroll
                for (int q = 0; q < 4; ++q) { const int q0 = (int)rintf(bf_lo(ww[q]) * sc), q1 = (int)rintf(bf_hi(ww[q]) * sc); o[q >> 1] |= ((unsigned)(q0 & 255) | ((unsigned)(q1 & 255) << 8)) << (16 * (q & 1)); }
                *(uint2*)(X1Q + (size_t)row * DM + 8 * lane + 512 * j) = make_uint2(o[0], o[1]);
            }
            if (lane == 0) XSC[row] = am * (1.f / 127.f);
        }
    }
    {
        const int hb = bid & 7; char* KL = (char*)lds + 65536;
        __syncthreads();
        const uint4* src = (const uint4*)(SKB + (size_t)hb * (2 * 128 * 128));
#pragma unroll
        for (int k = 0; k < 8; ++k) { const int ci = tid + NTHREADS * k; *(uint4*)(KL + (ci >> 4) * 272 + (ci & 15) * 16) = src[ci]; }
        __syncthreads();
        const int nbh = (nb - hb + 7) >> 3;
        for (int tb = (bid >> 3) * NWAVES + wave; tb < TREAL / 32; tb += nbh * NWAVES) rt::route_item(tb, hb, QP, KL, SSQ, IDX, GATE, scr, lane);
    }
}

constexpr int CW_QPV = 8192, CW_QPU = 8192 + 8 * 64;
constexpr int PX_ITEMS = TREAL / 64;
constexpr size_t WS_W = WS_Z + 4 * MiB, WS_PART = WS_Z + 32 * MiB, WS_Y = WS_Z + 160 * MiB;


template <int CTRL, int RMASK> __device__ __forceinline__ float dppf(float old, float v) { return __builtin_bit_cast(float, __builtin_amdgcn_update_dpp(__builtin_bit_cast(int, old), __builtin_bit_cast(int, v), CTRL, RMASK, 0xf, false)); }
template <int CTRL> __device__ __forceinline__ int dppi(int v) { return __builtin_amdgcn_update_dpp(0, v, CTRL, 0xf, 0xf, false); }
namespace pu2 {
typedef float f32x2v __attribute__((ext_vector_type(2)));
typedef unsigned u32x4v __attribute__((ext_vector_type(4)));
#define SBP() __builtin_amdgcn_sched_barrier(0)
#define PU_CHUNK_LD(dst, r_, q_) dst = *(const u32x4v*)(sidx + ((r_) - r0) * 512 + g128 + (q_) * 16)
#define PU_ROW_LD(buf, e_) buf = __builtin_amdgcn_raw_buffer_load_b128(U, (int)(e_) * 256 + c16, 0, 0)
#define PU_CONSUME(buf, I_) do { int s_ = __builtin_amdgcn_sdot4((int)buf[0], hq0, 0, false); s_ = __builtin_amdgcn_sdot4((int)buf[1], hq1, s_, false); \
    s_ = __builtin_amdgcn_sdot4((int)buf[2], hq2, s_, false); s_ = __builtin_amdgcn_sdot4((int)buf[3], hq3, s_, false); \
    s_ += dppi<0x128>(s_); s_ += dppi<0x124>(s_); s_ += dppi<0x122>(s_); s_ += dppi<0x121>(s_); \
    if ((I_) < 16) keep0 = (c == ((I_) & 15)) ? s_ : keep0; else keep1 = (c == ((I_) & 15)) ? s_ : keep1; } while (0)
#define PU_TOKEN_BODY(row_, nrow_, has_next_) do { \
    PU_CHUNK_LD(C7, row_, 7); \
    SBP(); PU_CONSUME(B0, 0); \
    PU_ROW_LD(B0, C2.x); \
    SBP(); PU_CONSUME(B1, 1); \
    PU_ROW_LD(B1, C2.y); \
    SBP(); PU_CONSUME(B2, 2); \
    PU_ROW_LD(B2, C2.z); \
    SBP(); PU_CONSUME(B3, 3); \
    PU_ROW_LD(B3, C2.w); \
    if (has_next_) PU_CHUNK_LD(C0, nrow_, 0); \
    SBP(); PU_CONSUME(B4, 4); \
    PU_ROW_LD(B4, C3.x); \
    SBP(); PU_CONSUME(B5, 5); \
    PU_ROW_LD(B5, C3.y); \
    SBP(); PU_CONSUME(B6, 6); \
    PU_ROW_LD(B6, C3.z); \
    SBP(); PU_CONSUME(B7, 7); \
    PU_ROW_LD(B7, C3.w); \
    if (has_next_) PU_CHUNK_LD(C1, nrow_, 1); \
    SBP(); PU_CONSUME(B0, 8); \
    PU_ROW_LD(B0, C4.x); \
    SBP(); PU_CONSUME(B1, 9); \
    PU_ROW_LD(B1, C4.y); \
    SBP(); PU_CONSUME(B2, 10); \
    PU_ROW_LD(B2, C4.z); \
    SBP(); PU_CONSUME(B3, 11); \
    PU_ROW_LD(B3, C4.w); \
    if (has_next_) PU_CHUNK_LD(C2, nrow_, 2); \
    SBP(); PU_CONSUME(B4, 12); \
    PU_ROW_LD(B4, C5.x); \
    SBP(); PU_CONSUME(B5, 13); \
    PU_ROW_LD(B5, C5.y); \
    SBP(); PU_CONSUME(B6, 14); \
    PU_ROW_LD(B6, C5.z); \
    SBP(); PU_CONSUME(B7, 15); \
    PU_ROW_LD(B7, C5.w); \
    if (has_next_) PU_CHUNK_LD(C3, nrow_, 3); \
    SBP(); PU_CONSUME(B0, 16); \
    PU_ROW_LD(B0, C6.x); \
    SBP(); PU_CONSUME(B1, 17); \
    PU_ROW_LD(B1, C6.y); \
    SBP(); PU_CONSUME(B2, 18); \
    PU_ROW_LD(B2, C6.z); \
    SBP(); PU_CONSUME(B3, 19); \
    PU_ROW_LD(B3, C6.w); \
    if (has_next_) PU_CHUNK_LD(C4, nrow_, 4); \
    SBP(); PU_CONSUME(B4, 20); \
    PU_ROW_LD(B4, C7.x); \
    SBP(); PU_CONSUME(B5, 21); \
    PU_ROW_LD(B5, C7.y); \
    SBP(); PU_CONSUME(B6, 22); \
    PU_ROW_LD(B6, C7.z); \
    SBP(); PU_CONSUME(B7, 23); \
    PU_ROW_LD(B7, C7.w); \
    if (has_next_) PU_CHUNK_LD(C5, nrow_, 5); \
    SBP(); PU_CONSUME(B0, 24); \
    if (has_next_) PU_ROW_LD(B0, C0.x); \
    SBP(); PU_CONSUME(B1, 25); \
    if (has_next_) PU_ROW_LD(B1, C0.y); \
    SBP(); PU_CONSUME(B2, 26); \
    if (has_next_) PU_ROW_LD(B2, C0.z); \
    SBP(); PU_CONSUME(B3, 27); \
    if (has_next_) PU_ROW_LD(B3, C0.w); \
    if (has_next_) PU_CHUNK_LD(C6, nrow_, 6); \
    SBP(); PU_CONSUME(B4, 28); \
    if (has_next_) PU_ROW_LD(B4, C1.x); \
    SBP(); PU_CONSUME(B5, 29); \
    if (has_next_) PU_ROW_LD(B5, C1.y); \
    SBP(); PU_CONSUME(B6, 30); \
    if (has_next_) PU_ROW_LD(B6, C1.z); \
    SBP(); PU_CONSUME(B7, 31); \
    if (has_next_) PU_ROW_LD(B7, C1.w); \
    } while (0)
#undef SBP
}

__device__ __forceinline__ void phase_pu(const Args& a, unsigned char* lds, unsigned* ctl, int xcc) {
    using namespace pu2;
#define SBP() __builtin_amdgcn_sched_barrier(0)
    const int tid = opaque_tid(), wave = __builtin_amdgcn_readfirstlane(tid >> 6), lane = tid & 63;
    volatile LAS unsigned* slot = (volatile LAS unsigned*)((LAS unsigned char*)lds + LDS_MISC) + 2;
    const signed char* X1Q = (const signed char*)(a.ws + WS_X1Q); float* PART = (float*)(a.ws + WS_PART);
    unsigned char* sidx = lds + wave * 4096; unsigned char* sxq = lds + 32768 + wave * 2048;
    const __amdgpu_buffer_rsrc_t RI = __builtin_amdgcn_make_buffer_rsrc((void*)(a.ws + WS_IDX), (short)0, TREAL * 512, 0x00020000);
    for (int ss = 0; ss < 8; ++ss) {
        const int s = (xcc + ss) & 7;
        const __amdgpu_buffer_rsrc_t U = __builtin_amdgcn_make_buffer_rsrc((void*)(a.ws + WS_U + (size_t)s * (16384 * 256)), (short)0, 16384 * 256, 0x00020000);
        unsigned wdraw = wave_draw(ctl + CW_QPU + 64 * s, lane);
        for (;;) {
            const int item8 = wave_item(wdraw);
            if (item8 >= PX_ITEMS * 8) break;
            wdraw = wave_draw(ctl + CW_QPU + 64 * s, lane);
            int ln = lane; asm volatile("" : "+v"(ln));
            const int g = ln >> 4, c = ln & 15, c16 = c * 16, g128 = g * 128;
            const int r0 = item8 * 8;
            u32x4v C0, C1, C2, C3, C4, C5, C6, C7, B0, B1, B2, B3, B4, B5, B6, B7;
            {
                const u32x4v* gi = (const u32x4v*)(a.ws + WS_IDX + (size_t)r0 * 512) + ln;
                const u32x4v i0 = gi[0], i1 = gi[64], i2 = gi[128], i3 = gi[192];
                const u32x4v xa = *(const u32x4v*)(X1Q + (size_t)(r0 + g) * DM + 256 * s + 16 * c), xb = *(const u32x4v*)(X1Q + (size_t)(r0 + 4 + g) * DM + 256 * s + 16 * c);
                u32x4v* si = (u32x4v*)sidx + ln; u32x4v* sx = (u32x4v*)sxq + ln;
                si[0] = i0; si[64] = i1; si[128] = i2; si[192] = i3; sx[0] = xa; sx[64] = xb;
                asm volatile("s_waitcnt lgkmcnt(0)" ::: "memory");
            }
            PU_CHUNK_LD(C0, r0, 0); PU_CHUNK_LD(C1, r0, 1); PU_CHUNK_LD(C2, r0, 2); PU_CHUNK_LD(C3, r0, 3); PU_CHUNK_LD(C4, r0, 4); PU_CHUNK_LD(C5, r0, 5); PU_CHUNK_LD(C6, r0, 6);
            uint4 nxq = ((const uint4*)sxq)[c];
            PU_ROW_LD(B0, C0.x); PU_ROW_LD(B1, C0.y); PU_ROW_LD(B2, C0.z); PU_ROW_LD(B3, C0.w); PU_ROW_LD(B4, C1.x); PU_ROW_LD(B5, C1.y); PU_ROW_LD(B6, C1.z); PU_ROW_LD(B7, C1.w);
#pragma unroll 1
            for (int t = 0; t < 8; ++t) {
                const int row = r0 + t, nrow = row + 1; const bool has_next = t < 7;
                const int hq0 = (int)nxq.x, hq1 = (int)nxq.y, hq2 = (int)nxq.z, hq3 = (int)nxq.w;
                if (has_next) nxq = ((const uint4*)sxq)[(t + 1) * 16 + c];
                int keep0 = 0, keep1 = 0;
                PU_TOKEN_BODY(row, nrow, has_next);
                float* pp = PART + (size_t)row * 1024 + s * 128 + 32 * g + c;
                pp[0] = (float)keep0; pp[16] = (float)keep1;
            }
        }
    }
#undef SBP
}
__device__ __forceinline__ void phase_pc(const Args& a, int bid, int nb) {
    const int tid = opaque_tid(), wave = __builtin_amdgcn_readfirstlane(tid >> 6), lane = tid & 63;
    const float* SSQ = (const float*)(a.ws + WS_SSQ); const int* IDX = (const int*)(a.ws + WS_IDX); const float* GATE = (const float*)(a.ws + WS_GATE);
    const float* ISC = (const float*)(a.ws + WS_ISC); const float* PART = (const float*)(a.ws + WS_PART); unsigned short* W16 = (unsigned short*)(a.ws + WS_W); float* WSC = (float*)(a.ws + WS_W + 12 * MiB);
    for (int row = bid * NWAVES + wave; row < TREAL; row += nb * NWAVES) {
        float ssv = lane < 32 ? SSQ[(size_t)row * 32 + lane] : 0.f; ssv = wave_sum(ssv);
        const float rstd = rsqrtf(ssv * (1.f / DM) + EPS);
        const float xsc = ((const float*)(a.ws + WS_XSC))[row];
        float wv[2];
#pragma unroll
        for (int k = 0; k < 2; ++k) {
            const int p = 64 * k + lane; float d = 0.f;
#pragma unroll
            for (int s = 0; s < 8; ++s) d += PART[(size_t)row * 1024 + s * 128 + p];
            const int e = IDX[(size_t)row * 128 + p];
            const float pre = d * rstd * ISC[e] * xsc;
            wv[k] = GATE[(size_t)row * 128 + p] * ISC[16384 + e] * (0.5f * pre * (1.f + erff(pre * 0.7071067811865476f)));
        }
        const float wmax = wave_max(fmaxf(fabsf(wv[0]), fabsf(wv[1])));
        const float wsc = wmax > 0.f ? 240.f / wmax : 0.f;
#pragma unroll
        for (int k = 0; k < 2; ++k) {
            const float ws = wv[k] * wsc;
            const int hi = __builtin_amdgcn_cvt_pk_fp8_f32(ws, 0.f, 0, false) & 255;
            const int lo = __builtin_amdgcn_cvt_pk_fp8_f32(ws - __builtin_amdgcn_cvt_f32_fp8(hi, 0), 0.f, 0, false) & 255;
            W16[(size_t)row * 128 + 64 * k + lane] = (unsigned short)(hi | (lo << 8));
        }
        if (lane == 0) WSC[row] = wmax * (1.f / 240.f);
    }
}
namespace pv2 {
typedef float f32x2v __attribute__((ext_vector_type(2)));
typedef unsigned u32x4v __attribute__((ext_vector_type(4))); typedef float f32x4v __attribute__((ext_vector_type(4)));
typedef unsigned u32x2v __attribute__((ext_vector_type(2)));
struct Chunk { u32x4v i; u32x2v w; };
#define SBP() __builtin_amdgcn_sched_barrier(0)
#define PV_CHUNK_LD(dst, r_, q_) do { dst.i = *(const u32x4v*)(sidx + ((r_) - r0) * 512 + g128 + (q_) * 16); dst.w = *(const u32x2v*)(swt + ((r_) - r0) * 256 + g64 + (q_) * 8); } while (0)
#define PV_ROW_LD(buf, e_) buf = __builtin_amdgcn_raw_buffer_load_b128(V, (int)(e_) * 256 + c16, 0, 0)
#define PV_CONSUME(buf, ww_, S0_, S1_) do { const u32x2v b2_ = {__builtin_amdgcn_perm(0u, (ww_), (S0_)), __builtin_amdgcn_perm(0u, (ww_), (S1_))}; const long bb_ = __builtin_bit_cast(long, b2_); \
    const u32x2v a0_ = {buf[0], buf[1]}, a1_ = {buf[2], buf[3]}; \
    acc_lo = __builtin_amdgcn_mfma_f32_16x16x32_fp8_fp8(__builtin_bit_cast(long, a0_), bb_, acc_lo, 0, 0, 0); acc_hi = __builtin_amdgcn_mfma_f32_16x16x32_fp8_fp8(__builtin_bit_cast(long, a1_), bb_, acc_hi, 0, 0, 0); } while (0)
#define PV_TOKEN_BODY(row_, nrow_, has_next_) do { \
    PV_CHUNK_LD(C7, row_, 7); \
    SBP(); PV_CONSUME(B0, C0.w[0], sele0, sele1); \
    PV_ROW_LD(B0, C2.i.x); \
    SBP(); PV_CONSUME(B1, C0.w[0], selo0, selo1); \
    PV_ROW_LD(B1, C2.i.y); \
    SBP(); PV_CONSUME(B2, C0.w[1], sele0, sele1); \
    PV_ROW_LD(B2, C2.i.z); \
    SBP(); PV_CONSUME(B3, C0.w[1], selo0, selo1); \
    PV_ROW_LD(B3, C2.i.w); \
    if (has_next_) PV_CHUNK_LD(C0, nrow_, 0); \
    SBP(); PV_CONSUME(B4, C1.w[0], sele0, sele1); \
    PV_ROW_LD(B4, C3.i.x); \
    SBP(); PV_CONSUME(B5, C1.w[0], selo0, selo1); \
    PV_ROW_LD(B5, C3.i.y); \
    SBP(); PV_CONSUME(B6, C1.w[1], sele0, sele1); \
    PV_ROW_LD(B6, C3.i.z); \
    SBP(); PV_CONSUME(B7, C1.w[1], selo0, selo1); \
    PV_ROW_LD(B7, C3.i.w); \
    if (has_next_) PV_CHUNK_LD(C1, nrow_, 1); \
    SBP(); PV_CONSUME(B0, C2.w[0], sele0, sele1); \
    PV_ROW_LD(B0, C4.i.x); \
    SBP(); PV_CONSUME(B1, C2.w[0], selo0, selo1); \
    PV_ROW_LD(B1, C4.i.y); \
    SBP(); PV_CONSUME(B2, C2.w[1], sele0, sele1); \
    PV_ROW_LD(B2, C4.i.z); \
    SBP(); PV_CONSUME(B3, C2.w[1], selo0, selo1); \
    PV_ROW_LD(B3, C4.i.w); \
    if (has_next_) PV_CHUNK_LD(C2, nrow_, 2); \
    SBP(); PV_CONSUME(B4, C3.w[0], sele0, sele1); \
    PV_ROW_LD(B4, C5.i.x); \
    SBP(); PV_CONSUME(B5, C3.w[0], selo0, selo1); \
    PV_ROW_LD(B5, C5.i.y); \
    SBP(); PV_CONSUME(B6, C3.w[1], sele0, sele1); \
    PV_ROW_LD(B6, C5.i.z); \
    SBP(); PV_CONSUME(B7, C3.w[1], selo0, selo1); \
    PV_ROW_LD(B7, C5.i.w); \
    if (has_next_) PV_CHUNK_LD(C3, nrow_, 3); \
    SBP(); PV_CONSUME(B0, C4.w[0], sele0, sele1); \
    PV_ROW_LD(B0, C6.i.x); \
    SBP(); PV_CONSUME(B1, C4.w[0], selo0, selo1); \
    PV_ROW_LD(B1, C6.i.y); \
    SBP(); PV_CONSUME(B2, C4.w[1], sele0, sele1); \
    PV_ROW_LD(B2, C6.i.z); \
    SBP(); PV_CONSUME(B3, C4.w[1], selo0, selo1); \
    PV_ROW_LD(B3, C6.i.w); \
    if (has_next_) PV_CHUNK_LD(C4, nrow_, 4); \
    SBP(); PV_CONSUME(B4, C5.w[0], sele0, sele1); \
    PV_ROW_LD(B4, C7.i.x); \
    SBP(); PV_CONSUME(B5, C5.w[0], selo0, selo1); \
    PV_ROW_LD(B5, C7.i.y); \
    SBP(); PV_CONSUME(B6, C5.w[1], sele0, sele1); \
    PV_ROW_LD(B6, C7.i.z); \
    SBP(); PV_CONSUME(B7, C5.w[1], selo0, selo1); \
    PV_ROW_LD(B7, C7.i.w); \
    if (has_next_) PV_CHUNK_LD(C5, nrow_, 5); \
    SBP(); PV_CONSUME(B0, C6.w[0], sele0, sele1); \
    if (has_next_) PV_ROW_LD(B0, C0.i.x); \
    SBP(); PV_CONSUME(B1, C6.w[0], selo0, selo1); \
    if (has_next_) PV_ROW_LD(B1, C0.i.y); \
    SBP(); PV_CONSUME(B2, C6.w[1], sele0, sele1); \
    if (has_next_) PV_ROW_LD(B2, C0.i.z); \
    SBP(); PV_CONSUME(B3, C6.w[1], selo0, selo1); \
    if (has_next_) PV_ROW_LD(B3, C0.i.w); \
    if (has_next_) PV_CHUNK_LD(C6, nrow_, 6); \
    SBP(); PV_CONSUME(B4, C7.w[0], sele0, sele1); \
    if (has_next_) PV_ROW_LD(B4, C1.i.x); \
    SBP(); PV_CONSUME(B5, C7.w[0], selo0, selo1); \
    if (has_next_) PV_ROW_LD(B5, C1.i.y); \
    SBP(); PV_CONSUME(B6, C7.w[1], sele0, sele1); \
    if (has_next_) PV_ROW_LD(B6, C1.i.z); \
    SBP(); PV_CONSUME(B7, C7.w[1], selo0, selo1); \
    if (has_next_) PV_ROW_LD(B7, C1.i.w); \
    } while (0)
#undef SBP
}

__device__ __forceinline__ void phase_pv(const Args& a, unsigned char* lds, unsigned* ctl, int xcc) {
    using namespace pv2;
#define SBP() __builtin_amdgcn_sched_barrier(0)
    const int tid = opaque_tid(), wave = __builtin_amdgcn_readfirstlane(tid >> 6), lane = tid & 63;
    volatile LAS unsigned* slot = (volatile LAS unsigned*)((LAS unsigned char*)lds + LDS_MISC) + 2;
    bf16_t* Y = (bf16_t*)(a.ws + WS_Y); const float* WSC = (const float*)(a.ws + WS_W + 12 * MiB);
    const __amdgpu_buffer_rsrc_t RI = __builtin_amdgcn_make_buffer_rsrc((void*)(a.ws + WS_IDX), (short)0, TREAL * 512, 0x00020000);
    const __amdgpu_buffer_rsrc_t RW = __builtin_amdgcn_make_buffer_rsrc((void*)(a.ws + WS_W), (short)0, TREAL * 256, 0x00020000);
    float* ybuf = (float*)lds + wave * 256;
    unsigned char* sidx = lds + 8192 + wave * 4096; unsigned char* swt = lds + 8192 + 32768 + wave * 2048;
    for (int ss = 0; ss < 8; ++ss) {
        const int s = (xcc + ss) & 7;
        const __amdgpu_buffer_rsrc_t V = __builtin_amdgcn_make_buffer_rsrc((void*)(a.ws + WS_V + (size_t)s * (16384 * 256)), (short)0, 16384 * 256, 0x00020000);
        unsigned wdraw = wave_draw(ctl + CW_QPV + 64 * s, lane);
        for (;;) {
            const int item8 = wave_item(wdraw);
            if (item8 >= PX_ITEMS * 8) break;
            wdraw = wave_draw(ctl + CW_QPV + 64 * s, lane);
            int ln = lane; asm volatile("" : "+v"(ln));
            const int g = ln >> 4, n = ln & 15, c16 = n * 16, g128 = g * 128, g64 = g * 64;
            const int r0 = item8 * 8;
            unsigned sele0, sele1, selo0, selo1;
            { const unsigned sh = 8u * (unsigned)(n & 3), keep = ~(255u << sh), se = (unsigned)(n >> 3), so = 2u + se;
              const unsigned ve = (0x0c0c0c0cu & keep) | (se << sh), vo = (0x0c0c0c0cu & keep) | (so << sh);
              const bool d0 = (n & 4) == 0;
              sele0 = d0 ? ve : 0x0c0c0c0cu; sele1 = d0 ? 0x0c0c0c0cu : ve; selo0 = d0 ? vo : 0x0c0c0c0cu; selo1 = d0 ? 0x0c0c0c0cu : vo; }
            Chunk C0, C1, C2, C3, C4, C5, C6, C7; u32x4v B0, B1, B2, B3, B4, B5, B6, B7;
            const float wscv = WSC[r0 + (ln & 7)];
            {
                const u32x4v* gi = (const u32x4v*)(a.ws + WS_IDX + (size_t)r0 * 512) + ln; const u32x4v* gw = (const u32x4v*)(a.ws + WS_W + (size_t)r0 * 256) + ln;
                const u32x4v i0 = gi[0], i1 = gi[64], i2 = gi[128], i3 = gi[192], w0 = gw[0], w1 = gw[64];
                u32x4v* si = (u32x4v*)sidx + ln; u32x4v* sw = (u32x4v*)swt + ln;
                si[0] = i0; si[64] = i1; si[128] = i2; si[192] = i3; sw[0] = w0; sw[64] = w1;
                asm volatile("s_waitcnt lgkmcnt(0)" ::: "memory");
            }
            PV_CHUNK_LD(C0, r0, 0); PV_CHUNK_LD(C1, r0, 1); PV_CHUNK_LD(C2, r0, 2); PV_CHUNK_LD(C3, r0, 3); PV_CHUNK_LD(C4, r0, 4); PV_CHUNK_LD(C5, r0, 5); PV_CHUNK_LD(C6, r0, 6);
            PV_ROW_LD(B0, C0.i.x); PV_ROW_LD(B1, C0.i.y); PV_ROW_LD(B2, C0.i.z); PV_ROW_LD(B3, C0.i.w); PV_ROW_LD(B4, C1.i.x); PV_ROW_LD(B5, C1.i.y); PV_ROW_LD(B6, C1.i.z); PV_ROW_LD(B7, C1.i.w);
#pragma unroll 1
            for (int t = 0; t < 8; ++t) {
                const int row = r0 + t, nrow = row + 1; const bool has_next = t < 7;
                f32x4v acc_lo = {0.f, 0.f, 0.f, 0.f}, acc_hi = {0.f, 0.f, 0.f, 0.f};
                PV_TOKEN_BODY(row, nrow, has_next);
                const float wsc = __uint_as_float(__builtin_amdgcn_readlane(__float_as_uint(wscv), t));
#pragma unroll
                for (int i = 0; i < 4; ++i) {
                    const float lo_ = acc_lo[i] + __uint_as_float(__builtin_amdgcn_update_dpp(0, __float_as_uint(acc_lo[i]), 0x128, 0xf, 0xf, false));
                    const float hi_ = acc_hi[i] + __uint_as_float(__builtin_amdgcn_update_dpp(0, __float_as_uint(acc_hi[i]), 0x128, 0xf, 0xf, false));
                    ybuf[16 * (4 * g + i) + n] = (n < 8 ? lo_ : hi_) * wsc;
                }
                asm volatile("s_waitcnt lgkmcnt(0)" ::: "memory");
                {
                    const float4 yv = ((const float4*)ybuf)[ln];
                    *(uint2*)(Y + (size_t)row * DM + 256 * s + 4 * ln) = make_uint2(pk2(yv.x, yv.y), pk2(yv.z, yv.w));
                }
                asm volatile("s_waitcnt lgkmcnt(0)" ::: "memory");
            }
        }
    }
#undef SBP
}
__device__ __forceinline__ void phase_pn(const Args& a, int bid, int nb) {
    const int tid = opaque_tid(), wave = __builtin_amdgcn_readfirstlane(tid >> 6), lane = tid & 63;
    const bf16_t* Y = (const bf16_t*)(a.ws + WS_Y); const bf16_t* X1 = (const bf16_t*)(a.ws + WS_HN);
    for (int row = bid * NWAVES + wave; row < TREAL; row += nb * NWAVES) {
        f32x4* p = (f32x4*)(a.out + (size_t)row * DM) + lane;
        const uint2* yp = (const uint2*)(Y + (size_t)row * DM) + lane; const uint2* xp = (const uint2*)(X1 + (size_t)row * DM) + lane;
        f32x4 v[8]; float ss = 0.f;
#pragma unroll
        for (int j = 0; j < 8; ++j) { const uint2 yy = yp[64 * j], xx = xp[64 * j];
            v[j][0] = bf_lo(xx.x) + bf_lo(yy.x); v[j][1] = bf_hi(xx.x) + bf_hi(yy.x); v[j][2] = bf_lo(xx.y) + bf_lo(yy.y); v[j][3] = bf_hi(xx.y) + bf_hi(yy.y);
            ss += (v[j][0] * v[j][0] + v[j][1] * v[j][1]) + (v[j][2] * v[j][2] + v[j][3] * v[j][3]); }
        const float r = rsqrtf(wave_sum(ss) * (1.f / DM) + EPS);
        const f32x4* wp = (const f32x4*)a.nfinal + lane;
#pragma unroll
        for (int j = 0; j < 8; ++j) p[64 * j] = v[j] * r * wp[64 * j];
    }
}

__device__ __forceinline__ void phase_mix(const Args& a, unsigned char* lds, unsigned* ctr) {
    const bf16_t* Z = (const bf16_t*)(a.ws + WS_Z); bf16_t* MIX = (bf16_t*)(a.ws + WS_MIX);
    volatile LAS unsigned* slot = (volatile LAS unsigned*)((LAS unsigned char*)lds + LDS_MISC) + 2;
    for (;;) {
        const int item = next_item(ctr, slot);
        if (item >= 64 + 2048) break;
        if (item < 64) mls::mlstm_item(item >> 2, item & 3, a, (char*)lds);
        else { const int k = item - 64, qb = 15 - (k >> 7), bh = k & 127; const float lam = attn_lambda(a); att::attn_unit(bh >> 3, bh & 7, qb, Z, MIX, lam, a.subln, (char*)lds); }
    }
}

__global__ void __launch_bounds__(NTHREADS, 2) mega(Args a) {
    extern __shared__ __attribute__((aligned(16))) unsigned char lds[];
    cg::grid_group grid = cg::this_grid();
    const int bid = blockIdx.x, nb = gridDim.x;
    unsigned char* ws = a.ws;
    bf16_t* WinT = (bf16_t*)(ws + WS_WIN); bf16_t* WoutT = (bf16_t*)(ws + WS_WOUT); bf16_t* WqT = (bf16_t*)(ws + WS_WQ);
    float* rope = (float*)(ws + WS_ROPE); float* SSQ = (float*)(ws + WS_SSQ);
    bf16_t* HN = (bf16_t*)(ws + WS_HN); bf16_t* MIX = (bf16_t*)(ws + WS_MIX); bf16_t* Z = (bf16_t*)(ws + WS_Z);

    volatile LAS unsigned* MISC = (volatile LAS unsigned*)((LAS unsigned char*)lds + LDS_MISC);
    if (threadIdx.x < 16) MISC[threadIdx.x] = 0u;
    __syncthreads();
    unsigned* ctl = (unsigned*)(ws + WS_CTL);
    XcdBarrier bar = xcd_barrier_post(ctl + CW_BAR, MISC);
    phase_prep(a, lds, bid, nb);
    grid.sync();
    { pg8::Gemm g{HN, WinT, MROWS, NZ, DM}; EpiZ E{Z, rope}; pg8::StaticOrder S; S.init(g.M, g.N, nb, bid);
      pg8::gemm_phase<EpiZ, pg8::StaticOrder, true, true>((PG8_LAS unsigned char*)lds, g, S, E); }
    phase_tables(a, lds, ctl);
    xcd_barrier(bar);
    phase_mix(a, lds, ctl + CW_QUEUE);
    xcd_barrier(bar);
    { pg8::Gemm g{MIX, WoutT, TREAL, DM, DM}; EpiX1 E{a.x, HN, SSQ}; pg8::StaticOrder S; S.init(g.M, g.N, nb, bid);
      pg8::gemm_phase<EpiX1, pg8::StaticOrder, true, true>((PG8_LAS unsigned char*)lds, g, S, E); }
    xcd_barrier(bar);
    { pg8::Gemm g{HN, WqT, TREAL, DM, DM}; pg8::EpiBf16<0> E{MIX, DM, nullptr, 0, 0, 1.f}; pg8::StaticOrder S; S.init(g.M, g.N, nb, bid);
      pg8::gemm_phase<pg8::EpiBf16<0>, pg8::StaticOrder, true, true>((PG8_LAS unsigned char*)lds, g, S, E); }
    xcd_barrier(bar);
    phase_route(a, lds, bid, nb);
    xcd_barrier(bar);
    { const int xcc = (int)(xb_xcc_id() & 7u);
      phase_pu(a, lds, ctl, xcc); xcd_barrier(bar);
      phase_pc(a, bid, nb); xcd_barrier(bar);
      phase_pv(a, lds, ctl, xcc); xcd_barrier(bar);
      phase_pn(a, bid, nb); }
}

extern "C" void kernel_launch(void* const* d_in, const int* in_sizes, int n_in, void* d_out, int out_size, void* d_ws, size_t ws_size, hipStream_t stream) {
    if (n_in != 18 || out_size != TREAL * DM || ws_size < WS_END) { fprintf(stderr, "kernel_launch: unexpected shapes n_in %d out %d ws %zu (need %zu)\n", n_in, out_size, ws_size, (size_t)WS_END); return; }
    static int grid_blocks = 0;
    if (!grid_blocks) {
        int dev = 0, cus = 0, per_cu = 0;
        (void)hipGetDevice(&dev);
        (void)hipDeviceGetAttribute(&cus, hipDeviceAttributeMultiprocessorCount, dev);
        (void)hipFuncSetAttribute((const void*)mega, hipFuncAttributeMaxDynamicSharedMemorySize, LDS_BYTES);
        (void)hipOccupancyMaxActiveBlocksPerMultiprocessor(&per_cu, (const void*)mega, NTHREADS, LDS_BYTES);
        if (per_cu < 1) { fprintf(stderr, "kernel_launch: occupancy query says %d blocks/CU\n", per_cu); per_cu = 1; }
        if (per_cu > 1) per_cu = 1;
        grid_blocks = cus * per_cu;
    }
    Args a{};
    a.x = (const float*)d_in[0]; a.meta = (const float*)d_in[1]; a.nmw = (const float*)d_in[2]; a.w_in = (const float*)d_in[3];
    a.lamqk = (const float*)d_in[4]; a.subln = (const float*)d_in[5]; a.convw = (const float*)d_in[6]; a.convb = (const float*)d_in[7];
    a.ib = (const float*)d_in[8]; a.fb = (const float*)d_in[9]; a.mnw = (const float*)d_in[10]; a.w_out = (const float*)d_in[11];
    a.nfw_ffn = (const float*)d_in[12]; a.w_q = (const float*)d_in[13]; a.subkeys = (const float*)d_in[14]; a.pu = (const float*)d_in[15];
    a.pv = (const float*)d_in[16]; a.nfinal = (const float*)d_in[17];
    a.out = (float*)d_out; a.ws = (unsigned char*)d_ws;
    (void)hipMemsetAsync((char*)d_ws + WS_CTL, 0, 65536, stream);
    void* kargs[] = {&a};
    const hipError_t e = hipLaunchCooperativeKernel((const void*)mega, dim3(grid_blocks), dim3(NTHREADS), kargs, LDS_BYTES, stream);
    if (e != hipSuccess) fprintf(stderr, "kernel_launch: cooperative launch failed: %s (grid %d)\n", hipGetErrorString(e), grid_blocks);
}
```

```cpp
#include <hip/hip_runtime.h>
#include <hip/hip_bf16.h>
#include <cstdio>
#include <cstdint>
#include <cmath>
namespace pg8 {
#define PG8_LAS __attribute__((address_space(3)))
typedef unsigned short bf16_t;
typedef short bf16x8 __attribute__((ext_vector_type(8)));
typedef float f32x4 __attribute__((ext_vector_type(4)));
typedef unsigned u32x4 __attribute__((ext_vector_type(4)));
constexpr int BM = 256, BK = 64, HALF = 128, HTB = HALF * BK * 2  , STAGE_BYTES = 8 * HTB, NXCD = 8, WGM = 8;

__host__ __device__ __forceinline__ int lds_byte(int r, int c) { const int st = (r >> 4) * 2 + (c >> 5), rr = r & 15, cc = c & 31, ob = rr * 64 + cc * 2; return st * 1024 + (ob ^ (((ob >> 9) & 1) << 5)); }
__host__ __device__ __forceinline__ void stage_rc(int b, int& R, int& C) { const int st = b / 1024, sb = b % 1024, swz = sb ^ (((sb >> 9) & 1) << 5); R = (st >> 1) * 16 + swz / 64; C = (st & 1) * 32 + (swz % 64) / 2; }
__host__ __device__ __forceinline__ int perm32(int rho) { const int n = rho >> 4, i = rho & 15; return 8 * (i >> 2) + 4 * n + (i & 3); }

struct Unit { int pm, pn; };
struct Gemm { const bf16_t* A; const bf16_t* Bt; int M, N, K; };

struct StaticOrder {
    int nM, nN, nwg, G, c;
    __host__ __device__ void init(int M, int N, int G_, int c_) { nM = M / BM; nN = N / BM; nwg = nM * nN; G = G_; c = c_; }
    __host__ __device__ bool next(int i, Unit& u) const {
        const long L = (long)i * G + c; if (L >= nwg) return false;
        int wgid = (int)L; { const int q = nwg / NXCD, r = nwg % NXCD, xcd = wgid % NXCD, off = wgid / NXCD; wgid = (xcd < r ? xcd * (q + 1) : r * (q + 1) + (xcd - r) * q) + off; }
        const int nig = WGM * nN, gid = wgid / nig, fm = gid * WGM, gsz = (nM - fm) < WGM ? (nM - fm) : WGM;
        u.pm = fm + ((wgid % nig) % gsz); u.pn = (wgid % nig) / gsz; return true;
    }
    __device__ __forceinline__ void a_ready(const Unit&) const {}
    __device__ __forceinline__ void done(const Unit&) const {}
};

__device__ __forceinline__ unsigned cvt_pk_bf16(float lo, float hi) { unsigned r; asm volatile("v_cvt_pk_bf16_f32 %0, %1, %2" : "=v"(r) : "v"(lo), "v"(hi)); return r; }
typedef float f32x2 __attribute__((ext_vector_type(2)));
__device__ __forceinline__ f32x2 gelu_pk(f32x2 v) {
    const f32x2 av = __builtin_elementwise_abs(v), d = av * 0.2316418882f + 1.0f;
    f32x2 t; t.x = __builtin_amdgcn_rcpf(d.x); t.y = __builtin_amdgcn_rcpf(d.y);
    f32x2 q = t * 0.5307027145f + (-0.7265760135f); q = q * t + 0.7107068705f; q = q * t + (-0.142248368f); q = q * t + 0.127414796f; q = q * t;
    const f32x2 s = (v * v) * (-0.72134752044f);
    f32x2 e; e.x = __builtin_amdgcn_exp2f(s.x); e.y = __builtin_amdgcn_exp2f(s.y);
    const f32x2 m = v * (q * e), r = v - m;
    f32x2 o; o.x = v.x < 0.f ? m.x : r.x; o.y = v.y < 0.f ? m.y : r.y; return o;
}

template <int ACT  > struct EpiBf16 {
    static constexpr bool PERM = true, AFTER_DRAIN = false; static_assert(ACT == 0 || ACT == 1, "EpiBf16: ACT is 0 (none) or 1 (gelu_pk)");
    bf16_t* O; int ldc; const float* bias; int split_cols; size_t split_stride; float scale0;
    __device__ __forceinline__ void operator()(const f32x4 (&acc)[2][2][4][2], const Unit& u, int wr, int wc, int fr, int fq) const {
        const int row0 = u.pm * BM + wr * 64 + fr; int colt = u.pn * BM; bf16_t* base = O;
        float sc = 1.f; if (split_cols) { const int t = colt / split_cols; base += (size_t)t * split_stride; colt -= t * split_cols; if (t == 0) sc = scale0; }
        const int col0 = colt + wc * 32 + 8 * fq, bcol0 = u.pn * BM + wc * 32 + 8 * fq;
        f32x4 bv[2][2];
#pragma unroll
        for (int bj = 0; bj < 2; ++bj)
#pragma unroll
            for (int n = 0; n < 2; ++n) bv[bj][n] = bias ? *(const f32x4*)(bias + bcol0 + bj * HALF + 4 * n) : (f32x4){0.f, 0.f, 0.f, 0.f};
#pragma unroll
        for (int ai = 0; ai < 2; ++ai)
#pragma unroll
            for (int m = 0; m < 4; ++m) { bf16_t* rowp = base + (size_t)(row0 + ai * HALF + m * 16) * ldc + col0;
#pragma unroll
                for (int bj = 0; bj < 2; ++bj) { f32x4 v0 = acc[ai][bj][m][0] + bv[bj][0], v1 = acc[ai][bj][m][1] + bv[bj][1];
                    if (ACT == 1) { f32x2 a = gelu_pk((f32x2){v0[0], v0[1]}), b = gelu_pk((f32x2){v0[2], v0[3]}), c = gelu_pk((f32x2){v1[0], v1[1]}), d = gelu_pk((f32x2){v1[2], v1[3]});
                        v0 = (f32x4){a.x, a.y, b.x, b.y}; v1 = (f32x4){c.x, c.y, d.x, d.y}; }
                    v0 = v0 * sc; v1 = v1 * sc; u32x4 w; w.x = cvt_pk_bf16(v0[0], v0[1]); w.y = cvt_pk_bf16(v0[2], v0[3]); w.z = cvt_pk_bf16(v1[0], v1[1]); w.w = cvt_pk_bf16(v1[2], v1[3]);
                    *(u32x4*)(rowp + bj * HALF) = w; } }
    }
};
template <class Epi, class Sched, bool ALIGN_EPI = false, bool SP2 = false>
__device__ __forceinline__ void gemm_phase(PG8_LAS unsigned char* lds, const Gemm g, const Sched& S, const Epi& E) {
    int tid_ = threadIdx.x; asm volatile("" : "+v"(tid_));
    const int tid = tid_, wid = __builtin_amdgcn_readfirstlane(tid >> 6), lane = tid & 63, wr = wid >> 2, wc = wid & 3, fr = lane & 15, fq = lane >> 4;
    const int K = g.K, nt = K / BK;
    unsigned voffA[2], voffB[2];
#pragma unroll
    for (int i = 0; i < 2; ++i) { int R, C; stage_rc(tid * 16 + i * 8192, R, C); const int Rb = Epi::PERM ? ((R & ~31) + perm32(R & 31)) : R;
        voffA[i] = (unsigned)(R * K + C) * 2u; voffB[i] = (unsigned)(Rb * K + C) * 2u; }
    const size_t kstep = (size_t)(BK * 2);
    const size_t hstep = (size_t)HALF * K * 2;
    const size_t tstep = 2 * hstep;
    const unsigned ldsw = (unsigned)wid * 1024u;
    const int aoff = lds_byte(wr * 64 + fr, fq * 8), boff = lds_byte(wc * 32 + fr, fq * 8);
#define PG8_SA(b, h) (((b) * 2 + (h)) * HTB)
#define PG8_SB(b, h) ((4 + (b) * 2 + (h)) * HTB)
#define PG8_STAGE(bufoff, gbase, voff) do { _Pragma("unroll") for (int _i = 0; _i < 2; ++_i) \
        __builtin_amdgcn_global_load_lds((const unsigned*)((const char*)(gbase) + (voff)[_i]), (PG8_LAS unsigned*)(lds + (bufoff) + ldsw + _i * 8192), 16, 0, 0); } while (0)
#define PG8_LDA(dst, b, h) do { _Pragma("unroll") for (int m = 0; m < 4; ++m) _Pragma("unroll") for (int k = 0; k < 2; ++k) dst[m][k] = *(const PG8_LAS bf16x8*)(lds + PG8_SA(b, h) + aoff + m * 2048 + k * 1024); } while (0)
#define PG8_LDB(dst, b, h) do { _Pragma("unroll") for (int n = 0; n < 2; ++n) _Pragma("unroll") for (int k = 0; k < 2; ++k) dst[n][k] = *(const PG8_LAS bf16x8*)(lds + PG8_SB(b, h) + boff + n * 2048 + k * 1024); } while (0)
#define PG8_MMA(ai, bj, At, Bt) do { __builtin_amdgcn_s_setprio(1); _Pragma("unroll") for (int m = 0; m < 4; ++m) _Pragma("unroll") for (int n = 0; n < 2; ++n) _Pragma("unroll") for (int k = 0; k < 2; ++k) \
        acc[ai][bj][m][n] = __builtin_amdgcn_mfma_f32_16x16x32_bf16(Bt[n][k], At[m][k], acc[ai][bj][m][n], 0, 0, 0); __builtin_amdgcn_s_setprio(0); } while (0)
#define PG8_WAIT_V(n) asm volatile("s_waitcnt vmcnt(" #n ")" ::: "memory")
#define PG8_WAIT_L(n) asm volatile("s_waitcnt lgkmcnt(" #n ")" ::: "memory")
#define PG8_BAR __builtin_amdgcn_s_barrier()
#define PG8_SCHED __builtin_amdgcn_sched_barrier(0)
    Unit cur, nxt; int ui = 0;
    if (!S.next(0, cur)) return;
    f32x4 acc[2][2][4][2];
#pragma unroll
    for (int a = 0; a < 2; ++a)
#pragma unroll
        for (int b = 0; b < 2; ++b)
#pragma unroll
            for (int m = 0; m < 4; ++m)
#pragma unroll
                for (int n = 0; n < 2; ++n) acc[a][b][m][n] = (f32x4){0.f, 0.f, 0.f, 0.f};
    bf16x8 At[4][2], B0[2][2], B1[2][2];
    const char* cA = (const char*)g.A + (size_t)cur.pm * tstep; const char* cB = (const char*)g.Bt + (size_t)cur.pn * tstep;
    S.a_ready(cur);
    if constexpr (SP2) {
        PG8_STAGE(PG8_SB(0, 0), cB, voffB); PG8_STAGE(PG8_SB(0, 1), cB + hstep, voffB); PG8_STAGE(PG8_SA(0, 0), cA, voffA); PG8_STAGE(PG8_SA(0, 1), cA + hstep, voffA);
        if (wr == 1) PG8_BAR;
        PG8_WAIT_V(2); PG8_BAR;
        PG8_STAGE(PG8_SB(1, 0), cB + kstep, voffB); PG8_STAGE(PG8_SA(1, 0), cA + kstep, voffA); PG8_STAGE(PG8_SB(1, 1), cB + hstep + kstep, voffB);
        PG8_WAIT_V(6); PG8_BAR;
    } else {
        PG8_STAGE(PG8_SB(0, 0), cB, voffB); PG8_STAGE(PG8_SA(0, 0), cA, voffA); PG8_STAGE(PG8_SB(0, 1), cB + hstep, voffB); PG8_STAGE(PG8_SA(0, 1), cA + hstep, voffA);
        if (wr == 1) PG8_BAR;
        PG8_WAIT_V(4); PG8_BAR;
        PG8_STAGE(PG8_SB(1, 0), cB + kstep, voffB); PG8_STAGE(PG8_SA(1, 0), cA + kstep, voffA); PG8_STAGE(PG8_SB(1, 1), cB + hstep + kstep, voffB);
        PG8_WAIT_V(6); PG8_BAR;
    }
    for (;;) {
        const bool has_next = S.next(ui + 1, nxt);
        const char* nA = has_next ? (const char*)g.A + (size_t)nxt.pm * tstep : cA; const char* nB = has_next ? (const char*)g.Bt + (size_t)nxt.pn * tstep : cB;
        for (int t = 0; t < nt; t += 2) {
            const bool last = (t == nt - 2);
            const char* a1 = cA + (size_t)(t + 1) * kstep;
            const char* a2 = last ? nA : cA + (size_t)(t + 2) * kstep; const char* b2 = last ? nB : cB + (size_t)(t + 2) * kstep;
            const char* a3 = a2 + kstep; const char* b3 = b2 + kstep;
            if (last && has_next) S.a_ready(nxt);
            if constexpr (SP2) {
            PG8_LDB(B0, 0, 0); PG8_LDB(B1, 0, 1); PG8_SCHED; PG8_LDA(At, 0, 0); PG8_STAGE(PG8_SA(1, 1), a1 + hstep, voffA);
            PG8_WAIT_V(8); PG8_WAIT_L(0); PG8_BAR; PG8_MMA(0, 0, At, B0); PG8_MMA(0, 1, At, B1); PG8_BAR; PG8_SCHED;
            PG8_LDA(At, 0, 1); PG8_STAGE(PG8_SB(0, 0), b2, voffB); PG8_STAGE(PG8_SB(0, 1), b2 + hstep, voffB); PG8_STAGE(PG8_SA(0, 0), a2, voffA);
            PG8_WAIT_V(8); PG8_WAIT_L(0); PG8_BAR; PG8_MMA(1, 0, At, B0); PG8_MMA(1, 1, At, B1); PG8_BAR; PG8_SCHED;
            PG8_LDB(B0, 1, 0); PG8_LDB(B1, 1, 1); PG8_SCHED; PG8_LDA(At, 1, 0); PG8_STAGE(PG8_SA(0, 1), a2 + hstep, voffA);
            PG8_WAIT_V(8); PG8_WAIT_L(0); PG8_BAR; PG8_MMA(0, 0, At, B0); PG8_MMA(0, 1, At, B1); PG8_BAR; PG8_SCHED;
            PG8_LDA(At, 1, 1); PG8_STAGE(PG8_SB(1, 0), b3, voffB); PG8_STAGE(PG8_SB(1, 1), b3 + hstep, voffB); PG8_STAGE(PG8_SA(1, 0), a3, voffA);
            PG8_WAIT_V(8); PG8_WAIT_L(0); PG8_BAR; PG8_MMA(1, 0, At, B0); PG8_MMA(1, 1, At, B1); PG8_BAR; PG8_SCHED;
            } else {
            PG8_LDB(B0, 0, 0); PG8_SCHED; PG8_LDA(At, 0, 0); PG8_STAGE(PG8_SA(1, 1), a1 + hstep, voffA);
            PG8_WAIT_L(8); PG8_BAR; PG8_WAIT_L(0); PG8_MMA(0, 0, At, B0); PG8_BAR; PG8_SCHED;
            PG8_LDB(B1, 0, 1); PG8_STAGE(PG8_SB(0, 0), b2, voffB);
            PG8_BAR; PG8_WAIT_L(0); PG8_MMA(0, 1, At, B1); PG8_BAR;
            PG8_LDA(At, 0, 1); PG8_STAGE(PG8_SA(0, 0), a2, voffA);
            PG8_BAR; PG8_WAIT_L(0); PG8_MMA(1, 0, At, B0); PG8_BAR; PG8_SCHED;
            PG8_STAGE(PG8_SB(0, 1), b2 + hstep, voffB);
            PG8_WAIT_V(6); PG8_BAR; PG8_MMA(1, 1, At, B1); PG8_BAR;
            PG8_LDB(B0, 1, 0); PG8_SCHED; PG8_LDA(At, 1, 0); PG8_STAGE(PG8_SA(0, 1), a2 + hstep, voffA);
            PG8_WAIT_L(8); PG8_BAR; PG8_WAIT_L(0); PG8_MMA(0, 0, At, B0); PG8_BAR; PG8_SCHED;
            PG8_LDB(B1, 1, 1); PG8_STAGE(PG8_SB(1, 0), b3, voffB);
            PG8_BAR; PG8_WAIT_L(0); PG8_MMA(0, 1, At, B1); PG8_BAR;
            PG8_LDA(At, 1, 1); PG8_STAGE(PG8_SA(1, 0), a3, voffA);
            PG8_BAR; PG8_WAIT_L(0); PG8_MMA(1, 0, At, B0); PG8_BAR; PG8_SCHED;
            PG8_STAGE(PG8_SB(1, 1), b3 + hstep, voffB);
            PG8_WAIT_V(6); PG8_BAR; PG8_MMA(1, 1, At, B1); PG8_BAR;
            }
        }
        if constexpr (ALIGN_EPI) { if (wr == 0) PG8_BAR; }
        if constexpr (!Epi::AFTER_DRAIN) { E(acc, cur, wr, wc, fr, fq); S.done(cur); }
        if (!has_next) break;
#pragma unroll
        for (int a = 0; a < 2; ++a)
#pragma unroll
            for (int b = 0; b < 2; ++b)
#pragma unroll
                for (int m = 0; m < 4; ++m)
#pragma unroll
                    for (int n = 0; n < 2; ++n) acc[a][b][m][n] = (f32x4){0.f, 0.f, 0.f, 0.f};
        cur = nxt; cA = nA; cB = nB; ++ui;
        if constexpr (ALIGN_EPI) { if (wr == 1) PG8_BAR; }
    }
    PG8_WAIT_V(0);
    if constexpr (!ALIGN_EPI) { if (wr == 0) PG8_BAR; }
    PG8_BAR;
    if constexpr (Epi::AFTER_DRAIN) { E.fused(acc, cur, wr, wc, fr, fq, lds, wid, lane); S.done(cur); }
#undef PG8_SA
#undef PG8_SB
#undef PG8_STAGE
#undef PG8_LDA
#undef PG8_LDB
#undef PG8_MMA
#undef PG8_WAIT_V
#undef PG8_WAIT_L
#undef PG8_BAR
#undef PG8_SCHED
}
}

constexpr int BATCH = 16, SEQ = 2048, DM = 2048, NMETA = 16;
constexpr int TREAL = BATCH * SEQ;
constexpr int MROWS = 33024;
constexpr int META_TILE0 = 32768;
constexpr int META_ROW0 = 32816;
constexpr int NZ = 6144;
constexpr int ZQ = 0, ZK = 1024, ZV = 2048, ZMQ = 3072, ZMK = 3584, ZMV = 4096, ZMO = 5120;
constexpr int INCOLS = 6152;
constexpr float EPS = 1e-6f;
constexpr float QSCALE = 0.125f * 1.4426950408889634f;
constexpr float LAMBDA_INIT = 0.2f;

typedef unsigned short bf16_t;
typedef float f32x4 __attribute__((ext_vector_type(4)));
typedef __bf16 bf16x2_t __attribute__((ext_vector_type(2)));

constexpr size_t MiB = 1u << 20;
constexpr size_t WS_CTL = 0;
constexpr size_t WS_ISC = 655360;
constexpr size_t WS_SKB = 65536;
constexpr size_t WS_WIN = 1 * MiB;
constexpr size_t WS_WOUT = 25 * MiB;
constexpr size_t WS_WQ = 33 * MiB;
constexpr size_t WS_ROPE = 41 * MiB;
constexpr size_t WS_GATES = 42 * MiB;
constexpr size_t WS_SSQ = 44 * MiB;
constexpr size_t WS_IDX = 48 * MiB;
constexpr size_t WS_GATE = 64 * MiB;
constexpr size_t WS_U = 80 * MiB;
constexpr size_t WS_V = 144 * MiB;
constexpr size_t WS_HN = 208 * MiB;
constexpr size_t WS_MIX = 338 * MiB;
constexpr size_t WS_Z = 466 * MiB;
constexpr size_t WS_END = 854 * MiB;

__device__ __forceinline__ float bf_lo(unsigned w) { return __uint_as_float(w << 16); }
__device__ __forceinline__ float bf_hi(unsigned w) { return __uint_as_float(w & 0xffff0000u); }
__device__ __forceinline__ float bf2f(bf16_t v) { return __uint_as_float(((unsigned)v) << 16); }
__device__ __forceinline__ unsigned f2bf(float f) { unsigned r; asm("v_cvt_pk_bf16_f32 %0, %1, 0" : "=v"(r) : "v"(f)); return r; }
__device__ __forceinline__ unsigned pk2(float lo, float hi) { unsigned r; asm("v_cvt_pk_bf16_f32 %0, %1, %2" : "=v"(r) : "v"(lo), "v"(hi)); return r; }
__device__ __forceinline__ float dot2(unsigned a, unsigned b, float acc) { return __builtin_amdgcn_fdot2_f32_bf16(__builtin_bit_cast(bf16x2_t, a), __builtin_bit_cast(bf16x2_t, b), acc, false); }
__device__ __forceinline__ float wave_sum(float v) {
#pragma unroll
    for (int o = 1; o < 64; o <<= 1) v += __shfl_xor(v, o);
    return v;
}
__device__ __forceinline__ float wave_max(float v) {
#pragma unroll
    for (int o = 1; o < 64; o <<= 1) v = fmaxf(v, __shfl_xor(v, o));
    return v;
}
__device__ __forceinline__ int zrow_of(int b, int l) { return l < NMETA ? META_ROW0 + l : b * SEQ + (l - NMETA); }

struct EpiZ {
    static constexpr bool PERM = true, AFTER_DRAIN = false;
    bf16_t* Z; const float* rope;
    __device__ __forceinline__ void operator()(const pg8::f32x4 (&acc)[2][2][4][2], const pg8::Unit& u, int wr, int wc, int fr, int fq) const {
        const int row0 = u.pm * 256 + wr * 64 + fr, col0 = u.pn * 256 + wc * 32 + 8 * fq;
        const bool isq = u.pn < 4, isrope = u.pn < 8;
        const int j0 = 16 * (wc & 1) + 4 * fq;
#pragma unroll
        for (int ai = 0; ai < 2; ++ai)
#pragma unroll
            for (int m = 0; m < 4; ++m) {
                const int row = row0 + ai * 128 + m * 16;
                pg8::f32x4 c0 = {1.f, 0.f, 1.f, 0.f}, c1 = {1.f, 0.f, 1.f, 0.f};
                if (isrope) {
                    const int pos = row < TREAL ? (row & (SEQ - 1)) + NMETA : ((row >= META_ROW0 && row < META_ROW0 + NMETA) ? row - META_ROW0 : 0);
                    const pg8::f32x4* tp = (const pg8::f32x4*)(rope + ((size_t)pos * 32 + j0) * 2);
                    c0 = tp[0]; c1 = tp[1];
                }
                bf16_t* rowp = Z + (size_t)row * NZ + col0;
#pragma unroll
                for (int bj = 0; bj < 2; ++bj) {
                    pg8::f32x4 v0 = acc[ai][bj][m][0], v1 = acc[ai][bj][m][1];
                    if (isrope) {
                        pg8::f32x4 o0, o1;
                        o0[0] = v0[0] * c0[0] - v0[1] * c0[1]; o0[1] = v0[1] * c0[0] + v0[0] * c0[1];
                        o0[2] = v0[2] * c0[2] - v0[3] * c0[3]; o0[3] = v0[3] * c0[2] + v0[2] * c0[3];
                        o1[0] = v1[0] * c1[0] - v1[1] * c1[1]; o1[1] = v1[1] * c1[0] + v1[0] * c1[1];
                        o1[2] = v1[2] * c1[2] - v1[3] * c1[3]; o1[3] = v1[3] * c1[2] + v1[2] * c1[3];
                        v0 = o0; v1 = o1;
                        if (isq) { v0 = v0 * QSCALE; v1 = v1 * QSCALE; }
                    }
                    pg8::u32x4 w; w.x = pg8::cvt_pk_bf16(v0[0], v0[1]); w.y = pg8::cvt_pk_bf16(v0[2], v0[3]); w.z = pg8::cvt_pk_bf16(v1[0], v1[1]); w.w = pg8::cvt_pk_bf16(v1[2], v1[3]);
                    *(pg8::u32x4*)(rowp + bj * 128) = w;
                }
            }
    }
};
struct EpiX1 {
    static constexpr bool PERM = true, AFTER_DRAIN = false;
    const float* x; bf16_t* x1b; float* ssq;
    __device__ __forceinline__ void loadr(pg8::f32x4 (&xb)[2][2], int row0, int col0, int i) const {
#pragma unroll
        for (int bj = 0; bj < 2; ++bj) {
            const size_t off = (size_t)(row0 + (i >> 2) * 128 + (i & 3) * 16) * DM + col0 + bj * 128;
            xb[bj][0] = *(const pg8::f32x4*)(x + off); xb[bj][1] = *(const pg8::f32x4*)(x + off + 4);
        }
    }
    __device__ __forceinline__ void procr(const pg8::f32x4 (&acc)[2][2][4][2], const pg8::f32x4 (&xb)[2][2], int row0, int col0, int i, int pn, int wc, int fq) const {
        const int ai = i >> 2, m = i & 3;
        const int row = row0 + ai * 128 + m * 16; float ss = 0.f;
#pragma unroll
        for (int bj = 0; bj < 2; ++bj) {
            const size_t off = (size_t)row * DM + col0 + bj * 128;
            const pg8::f32x4 v0 = acc[ai][bj][m][0] + xb[bj][0], v1 = acc[ai][bj][m][1] + xb[bj][1];
            ss += (v0[0] * v0[0] + v0[1] * v0[1]) + (v0[2] * v0[2] + v0[3] * v0[3]) + (v1[0] * v1[0] + v1[1] * v1[1]) + (v1[2] * v1[2] + v1[3] * v1[3]);
            pg8::u32x4 w; w.x = pg8::cvt_pk_bf16(v0[0], v0[1]); w.y = pg8::cvt_pk_bf16(v0[2], v0[3]); w.z = pg8::cvt_pk_bf16(v1[0], v1[1]); w.w = pg8::cvt_pk_bf16(v1[2], v1[3]);
            *(pg8::u32x4*)(x1b + off) = w;
        }
        ss += __shfl_xor(ss, 16); ss += __shfl_xor(ss, 32);
        if (fq == 0) ssq[(size_t)row * 32 + pn * 4 + wc] = ss;
    }
    __device__ __forceinline__ void operator()(const pg8::f32x4 (&acc)[2][2][4][2], const pg8::Unit& u, int wr, int wc, int fr, int fq) const {
        const int row0 = u.pm * 256 + wr * 64 + fr, col0 = u.pn * 256 + wc * 32 + 8 * fq;
        pg8::f32x4 b0[2][2], b1[2][2], b2[2][2];
        loadr(b0, row0, col0, 0); loadr(b1, row0, col0, 1); loadr(b2, row0, col0, 2);
        procr(acc, b0, row0, col0, 0, u.pn, wc, fq); loadr(b0, row0, col0, 3);
        procr(acc, b1, row0, col0, 1, u.pn, wc, fq); loadr(b1, row0, col0, 4);
        procr(acc, b2, row0, col0, 2, u.pn, wc, fq); loadr(b2, row0, col0, 5);
        procr(acc, b0, row0, col0, 3, u.pn, wc, fq); loadr(b0, row0, col0, 6);
        procr(acc, b1, row0, col0, 4, u.pn, wc, fq); loadr(b1, row0, col0, 7);
        procr(acc, b2, row0, col0, 5, u.pn, wc, fq);
        procr(acc, b0, row0, col0, 6, u.pn, wc, fq);
        procr(acc, b1, row0, col0, 7, u.pn, wc, fq);
    }
};


#include <hip/hip_cooperative_groups.h>
namespace cg = cooperative_groups;

constexpr int NWAVES = 8, NTHREADS = 512;
constexpr size_t WS_X1Q = WS_Z + 300 * MiB, WS_XSC = WS_Z + 370 * MiB;
__device__ __forceinline__ int opaque_tid() { int t = threadIdx.x; asm volatile("" : "+v"(t)); return t; }
constexpr int LDS_BYTES = 163840;

struct Args {
    const float *x, *meta, *nmw, *w_in, *lamqk, *subln, *convw, *convb, *ib, *fb, *mnw, *w_out, *nfw_ffn, *w_q, *subkeys, *pu, *pv, *nfinal;
    float* out; unsigned char* ws;
};

#define LAS __attribute__((address_space(3)))
#define XB_TMO      128
#define XB_XCNT(j)  (256  + 64 * (j))
#define XB_XSUB(j)  (1280 + 64 * (j))
#define XB_XGEN(j)  (2304 + 64 * (j))
#define XB_TOP      3328
#define XB_TOPGEN   3392
#define XCD_BAR_WORDS 3456
#define XB_SPIN_CAP (1u << 18)

__device__ __forceinline__ unsigned xb_ld(unsigned* p)              { return __hip_atomic_load(p, __ATOMIC_RELAXED, __HIP_MEMORY_SCOPE_AGENT); }
__device__ __forceinline__ unsigned xb_add(unsigned* p, unsigned v) { return __hip_atomic_fetch_add(p, v, __ATOMIC_RELAXED, __HIP_MEMORY_SCOPE_AGENT); }
__device__ __forceinline__ unsigned xb_xcc_id() { return (unsigned)__builtin_amdgcn_s_getreg((3 << 11) | 20) & 0xFu; }
#define XB_SPIN(cond, bar) do { unsigned _sp = 0; while (cond) { __builtin_amdgcn_s_sleep(1); \
    if ((++_sp & 255u) == 0u) { if (xb_ld(&(bar)[XB_TMO])) break; if (_sp > XB_SPIN_CAP) { atomicAdd(&(bar)[XB_TMO], 1u); break; } } } } while (0)

struct XcdBarrier {
    unsigned* bar; unsigned x;
    volatile LAS unsigned* st;
};

__device__ __forceinline__ XcdBarrier xcd_barrier_post(unsigned* bar, volatile LAS unsigned* st) {
    XcdBarrier b; b.bar = bar; b.x = xb_xcc_id(); b.st = st;
    if (threadIdx.x == 0) (void)xb_add(&bar[XB_XCNT(b.x)], 1u);
    return b;
}
__device__ __forceinline__ void xcd_barrier_complete(unsigned* bar, unsigned x, unsigned& nloc, unsigned& nx) {
    const unsigned G = gridDim.x * gridDim.y * gridDim.z;
    unsigned sum, cnt, mine, sp = 0u;
    for (;;) {
        sum = 0u; cnt = 0u; mine = 0u;
#pragma unroll
        for (unsigned j = 0; j < 16; ++j) { const unsigned c = xb_ld(&bar[XB_XCNT(j)]); sum += c; cnt += (c > 0u) ? 1u : 0u; mine = (j == x) ? c : mine; }
        if (sum == G) break;
        __builtin_amdgcn_s_sleep(1);
        if ((++sp & 255u) == 0u) { if (xb_ld(&bar[XB_TMO])) break; if (sp > XB_SPIN_CAP) { atomicAdd(&bar[XB_TMO], 1u); break; } }
    }
    nloc = mine > 0u ? mine : 1u; nx = cnt > 0u ? cnt : 1u;
}

__device__ __forceinline__ void xcd_barrier(const XcdBarrier& b) {
    asm volatile("s_waitcnt vmcnt(0)" ::: "memory");
    __syncthreads();
    if (threadIdx.x == 0) {
        unsigned* bar = b.bar;
        __builtin_amdgcn_s_waitcnt(0);
        unsigned nloc = b.st[0], nx = b.st[1];
        if (nloc == 0u) { xcd_barrier_complete(bar, b.x, nloc, nx); b.st[0] = nloc; b.st[1] = nx; }
        const unsigned old = xb_add(&bar[XB_XSUB(b.x)], 1u);
        const unsigned gen = old / nloc;
        if (old + 1u == (gen + 1u) * nloc) {
            __builtin_amdgcn_fence(__ATOMIC_RELEASE, "agent");
            asm volatile("s_waitcnt vmcnt(0)" ::: "memory");
            const unsigned og = xb_add(&bar[XB_TOP], 1u);
            const unsigned tg = og / nx;
            if (og + 1u == (tg + 1u) * nx) xb_add(&bar[XB_TOPGEN], 1u);
            else XB_SPIN(xb_ld(&bar[XB_TOPGEN]) == tg, bar);
            __builtin_amdgcn_fence(__ATOMIC_ACQUIRE, "agent");
            xb_add(&bar[XB_XGEN(b.x)], 1u);
            asm volatile("s_waitcnt vmcnt(0)" ::: "memory");
        } else {
            XB_SPIN(xb_ld(&bar[XB_XGEN(b.x)]) == gen, bar);
            __builtin_amdgcn_fence(__ATOMIC_ACQUIRE, "agent");
            asm volatile("s_waitcnt vmcnt(0)" ::: "memory");
        }
    }
    __syncthreads();
}

constexpr int CW_BAR = 0, CW_QUEUE = 4096;
constexpr int LDS_MISC = LDS_BYTES - 256;
__device__ __forceinline__ unsigned wave_draw(unsigned* ctr, int lane) {
    unsigned v = 0u;
    if (lane == 0) v = __hip_atomic_fetch_add(ctr, 1u, __ATOMIC_RELAXED, __HIP_MEMORY_SCOPE_AGENT);
    return v;
}
__device__ __forceinline__ int wave_item(unsigned v) { return (int)__builtin_amdgcn_readfirstlane(v); }
__device__ __forceinline__ int next_item(unsigned* ctr, volatile LAS unsigned* slot) {
    __syncthreads();
    if (threadIdx.x == 0) *slot = __hip_atomic_fetch_add(ctr, 1u, __ATOMIC_RELAXED, __HIP_MEMORY_SCOPE_AGENT);
    __syncthreads();
    return (int)*slot;
}

__device__ __forceinline__ void transpose_item(const float* W, int ldw, int K, int N, bf16_t* WT, bool ropeperm, float* scr, int item, int lane, const float* kscale = nullptr) {
    const int nblk = N / 32, kb = item / nblk, nb = item % nblk, k0 = 64 * kb, n0 = 32 * nb;
#pragma unroll 8
    for (int i = 0; i < 32; ++i) { const int kk = 2 * i + (lane >> 5); scr[kk * 33 + (lane & 31)] = W[(size_t)(k0 + kk) * ldw + n0 + (lane & 31)] * (kscale ? kscale[k0 + kk] : 1.f); }
    __builtin_amdgcn_s_waitcnt(0xC07F); asm volatile("" ::: "memory");
    const int c = lane & 7;
#pragma unroll
    for (int j = 0; j < 4; ++j) {
        const int n = (lane >> 3) + 8 * j; const float* s = scr + (8 * c) * 33 + n;
        uint4 o; o.x = pk2(s[0 * 33], s[1 * 33]); o.y = pk2(s[2 * 33], s[3 * 33]); o.z = pk2(s[4 * 33], s[5 * 33]); o.w = pk2(s[6 * 33], s[7 * 33]);
        int orow = n0 + n;
        if (ropeperm && n0 < 2048) orow = (n0 & ~63) + 2 * n + ((n0 >> 5) & 1);
        *(uint4*)(WT + (size_t)orow * K + k0 + 8 * c) = o;
    }
    __builtin_amdgcn_s_waitcnt(0xC07F); asm volatile("" ::: "memory");
}

__device__ __forceinline__ void hn_row(const Args& a, bf16_t* HN, float* G, const float* WG, int r, const f32x4 (&v)[8], int lane) {
    float ss = 0.f;
#pragma unroll
    for (int j = 0; j < 8; ++j) ss += (v[j][0] * v[j][0] + v[j][1] * v[j][1]) + (v[j][2] * v[j][2] + v[j][3] * v[j][3]);
    const float rstd = rsqrtf(wave_sum(ss) * (1.f / DM) + EPS);
    float g[8];
#pragma unroll
    for (int k = 0; k < 8; ++k) g[k] = 0.f;
    unsigned long long* o8 = (unsigned long long*)(HN + (size_t)r * DM) + lane;
#pragma unroll
    for (int j = 0; j < 8; ++j) {
        const f32x4 w = ((const f32x4*)a.nmw)[64 * j + lane];
        const f32x4 y = v[j] * rstd * w;
        o8[64 * j] = (unsigned long long)pk2(y[0], y[1]) | ((unsigned long long)pk2(y[2], y[3]) << 32);
#pragma unroll
        for (int k = 0; k < 8; ++k) { const f32x4 wg = ((const f32x4*)(WG + k * 2048))[64 * j + lane]; g[k] += (y[0] * wg[0] + y[1] * wg[1]) + (y[2] * wg[2] + y[3] * wg[3]); }
        __builtin_amdgcn_sched_barrier(0);
    }
    float r4[4], r2[2], r1;
    { const bool hb = (lane & 32) != 0;
#pragma unroll
      for (int i = 0; i < 4; ++i) { const float send = hb ? g[i] : g[i + 4]; const float recv = __shfl_xor(send, 32); r4[i] = (hb ? g[i + 4] : g[i]) + recv; } }
    { const bool hb = (lane & 16) != 0;
#pragma unroll
      for (int i = 0; i < 2; ++i) { const float send = hb ? r4[i] : r4[i + 2]; const float recv = __shfl_xor(send, 16); r2[i] = (hb ? r4[i + 2] : r4[i]) + recv; } }
    { const bool hb = (lane & 8) != 0; const float send = hb ? r2[0] : r2[1]; const float recv = __shfl_xor(send, 8); r1 = (hb ? r2[1] : r2[0]) + recv; }
    r1 += __shfl_xor(r1, 4); r1 += __shfl_xor(r1, 2); r1 += __shfl_xor(r1, 1);
    if ((lane & 7) == 0) G[(size_t)r * 8 + ((lane >> 5) & 1) * 4 + ((lane >> 4) & 1) * 2 + ((lane >> 3) & 1)] = r1;
}

__device__ __forceinline__ void phase_prep(const Args& a, unsigned char* lds, int bid, int nb) {
    const int tid = opaque_tid(), lane = tid & 63, wave = tid >> 6;
    const int gw = bid * NWAVES + wave, NGW = nb * NWAVES;
    unsigned char* ws = a.ws;
    bf16_t* WinT = (bf16_t*)(ws + WS_WIN); bf16_t* WoutT = (bf16_t*)(ws + WS_WOUT); bf16_t* WqT = (bf16_t*)(ws + WS_WQ);
    bf16_t* U = (bf16_t*)(ws + WS_U); bf16_t* V = (bf16_t*)(ws + WS_V); bf16_t* HN = (bf16_t*)(ws + WS_HN);
    float* G = (float*)(ws + WS_GATES); float* rope = (float*)(ws + WS_ROPE);
    float* scr = (float*)lds + wave * (64 * 33);
    float* WG = (float*)(lds + 8 * 64 * 33 * 4);
    for (int i = tid; i < 8 * 2048; i += NTHREADS) { const int k = i >> 3, g = i & 7; WG[g * 2048 + k] = a.w_in[(size_t)k * INCOLS + 6144 + g]; }
    __syncthreads();
    constexpr int I_IN = 32 * 192, I_OUT = 32 * 64, I_Q = 32 * 64;
    for (int it = gw; it < I_IN + I_OUT + I_Q; it += NGW) {
        int r = it;
        if (r < I_IN) { transpose_item(a.w_in, INCOLS, 2048, 6144, WinT, true, scr, r, lane); continue; } r -= I_IN;
        if (r < I_OUT) { transpose_item(a.w_out, 2048, 2048, 2048, WoutT, false, scr, r, lane); continue; } r -= I_OUT;
        transpose_item(a.w_q, 2048, 2048, 2048, WqT, false, scr, r, lane, a.nfw_ffn);
    }
    {
        f32x4 vc[8], vn[8];
#pragma unroll
        for (int j = 0; j < 8; ++j) vc[j] = ((const f32x4*)(a.x + (size_t)gw * DM))[64 * j + lane];
        for (int r = gw; r < TREAL; r += NGW) {
            const int rn = r + NGW < TREAL ? r + NGW : r;
#pragma unroll
            for (int j = 0; j < 8; ++j) vn[j] = ((const f32x4*)(a.x + (size_t)rn * DM))[64 * j + lane];
            hn_row(a, HN, G, WG, r, vc, lane);
#pragma unroll
            for (int j = 0; j < 8; ++j) vc[j] = vn[j];
        }
    }
    for (int r = TREAL + gw; r < MROWS; r += NGW) {
        if (r >= META_ROW0 && r < META_ROW0 + NMETA) {
            f32x4 vm[8];
#pragma unroll
            for (int j = 0; j < 8; ++j) vm[j] = ((const f32x4*)(a.meta + (size_t)(r - META_ROW0) * DM))[64 * j + lane];
            hn_row(a, HN, G, WG, r, vm, lane);
        } else {
            unsigned long long* o8 = (unsigned long long*)(HN + (size_t)r * DM) + lane;
#pragma unroll
            for (int j = 0; j < 8; ++j) o8[64 * j] = 0ull;
            if (lane < 8) G[(size_t)r * 8 + lane] = 0.f;
        }
    }
    { bf16_t* SKB = (bf16_t*)(ws + WS_SKB);
      for (int i = bid * NTHREADS + tid; i < 8 * 2 * 128 * 128 / 2; i += nb * NTHREADS) { const float2 v = ((const float2*)a.subkeys)[i]; ((unsigned*)SKB)[i] = pk2(v.x, v.y); } }
    for (int i = bid * NTHREADS + tid; i < (SEQ + NMETA) * 32; i += nb * NTHREADS) {
        const int pos = i >> 5, j = i & 31;
        const float inv = (float)pow(10000.0, -(double)j / 32.0);
        const float ang = (float)pos * inv;
        rope[2 * i] = (float)cos((double)ang); rope[2 * i + 1] = (float)sin((double)ang);
    }
}


constexpr int CW_QTAB = 4096 + 1024, TAB_ITEMS = 2 * 16384 / 16;
__device__ __forceinline__ void phase_tables(const Args& a, unsigned char* lds, unsigned* ctl) {
    const int tid = opaque_tid(), lane = tid & 63, wave = __builtin_amdgcn_readfirstlane(tid >> 6);
    unsigned char* ws = a.ws;
    volatile LAS unsigned* slot = (volatile LAS unsigned*)((LAS unsigned char*)lds + LDS_MISC) + 2;
    for (;;) {
        const int item = next_item(ctl + CW_QTAB, slot);
        if (item >= TAB_ITEMS) break;
        const int rr = item * 16 + wave;
    {
        unsigned* U8 = (unsigned*)(ws + WS_U); unsigned* V8 = (unsigned*)(ws + WS_V); float* ISC = (float*)(ws + WS_ISC);
        {
            f32x4 v[2][8]; float am[2];
#pragma unroll
            for (int q = 0; q < 2; ++q) {
                const int r = rr + q * 8; const bool isu = r < 16384; const int e = r & 16383;
                const f32x4* xr = (const f32x4*)((isu ? a.pu : a.pv) + (size_t)e * DM) + lane;
#pragma unroll
                for (int j = 0; j < 8; ++j) v[q][j] = xr[64 * j];
            }
#pragma unroll
            for (int q = 0; q < 2; ++q) if (rr + q * 8 < 16384) {
#pragma unroll
                for (int j = 0; j < 8; ++j) v[q][j] = v[q][j] * ((const f32x4*)a.nfw_ffn)[64 * j + lane]; }
#pragma unroll
            for (int q = 0; q < 2; ++q) { float t = 0.f;
#pragma unroll
                for (int j = 0; j < 8; ++j) t = fmaxf(t, fmaxf(fmaxf(fabsf(v[q][j][0]), fabsf(v[q][j][1])), fmaxf(fabsf(v[q][j][2]), fabsf(v[q][j][3]))));
                am[q] = t; }
#pragma unroll
            for (int o = 1; o < 64; o <<= 1) { am[0] = fmaxf(am[0], __shfl_xor(am[0], o)); am[1] = fmaxf(am[1], __shfl_xor(am[1], o)); }
#pragma unroll
            for (int q = 0; q < 2; ++q) {
                const int r = rr + q * 8; const bool isu = r < 16384; const int e = r & 16383;
                const float top = isu ? 127.f : 256.f;
                const float sc = am[q] > 0.f ? top / am[q] : 0.f;
                unsigned* o8 = isu ? U8 : V8;
#pragma unroll
                for (int j = 0; j < 8; ++j) { int w;
                    if (isu) { const int q0 = (int)rintf(v[q][j][0] * sc), q1 = (int)rintf(v[q][j][1] * sc), q2 = (int)rintf(v[q][j][2] * sc), q3 = (int)rintf(v[q][j][3] * sc);
                        w = (int)((unsigned)(q0 & 255) | ((unsigned)(q1 & 255) << 8) | ((unsigned)(q2 & 255) << 16) | ((unsigned)q3 << 24)); }
                    else { w = __builtin_amdgcn_cvt_pk_fp8_f32(v[q][j][0] * sc, v[q][j][1] * sc, 0, false); w = __builtin_amdgcn_cvt_pk_fp8_f32(v[q][j][2] * sc, v[q][j][3] * sc, w, true); }
                    o8[((size_t)j * 16384 + e) * 64 + lane] = (unsigned)w; }
                if (lane == 0) ISC[2 * e + (isu ? 0 : 1)] = am[q] / top;
            }
        }
    }
    }
}

namespace att {
using bf16x8 = __attribute__((ext_vector_type(8))) short;
using s16x4 = __attribute__((ext_vector_type(4))) short;
using f32x16 = __attribute__((ext_vector_type(16))) float;
using u32x4 = __attribute__((ext_vector_type(4))) unsigned;
constexpr int SHM_V = 16384, SHM_K = 16384;
constexpr int L_V = 0, L_K = 2 * SHM_V, L_WS = L_K + 2 * SHM_K, L_P = L_WS + 8 * 64 * 4, L_END = L_P + 4 * 4096;
#define KSWZ(row, colB) ((row) * 256 + ((colB) ^ (((row) & 7) << 4)))
#define SBAR() __builtin_amdgcn_sched_barrier(0)
__device__ __forceinline__ int crow(int r, int hi) { return (r & 3) + 8 * (r >> 2) + 4 * hi; }
__device__ __forceinline__ unsigned cvtpk(float lo, float hi) { unsigned r; asm volatile("v_cvt_pk_bf16_f32 %0, %1, %2" : "=v"(r) : "v"(lo), "v"(hi)); return r; }
__device__ __forceinline__ int v_st(int k, int c) { const int kk = (k & ~0xC) | ((k & 4) << 1) | ((k & 8) >> 1); return ((kk >> 3) * 4 + (c >> 5)) * 512 + ((kk & 7) * 32 + (c & 31)) * 2; }
__device__ __forceinline__ int v_rd_base(int lane) { return ((lane & 3) << 3) | (((lane >> 2) & 3) << 6) | (((lane >> 4) & 1) << 5) | (((lane >> 5) & 1) << 8); }
constexpr int v_rd_off(int d0, int ks, int half) { return d0 * 512 + ks * 4096 + half * 2048; }
template <int OFF> __device__ __forceinline__ s16x4 tr_read(int vb) { s16x4 r; asm volatile("ds_read_b64_tr_b16 %0, %1 offset:%2" : "=&v"(r) : "v"(vb), "i"(OFF) : "memory"); return r; }
template <int D0> __device__ __forceinline__ void pv_one(f32x16& od, int vb, bf16x8 pa0, bf16x8 pa1, bf16x8 pa2, bf16x8 pa3) {
    const s16x4 l0 = tr_read<v_rd_off(D0, 0, 0)>(vb), h0 = tr_read<v_rd_off(D0, 0, 1)>(vb), l1 = tr_read<v_rd_off(D0, 1, 0)>(vb), h1 = tr_read<v_rd_off(D0, 1, 1)>(vb);
    const s16x4 l2 = tr_read<v_rd_off(D0, 2, 0)>(vb), h2 = tr_read<v_rd_off(D0, 2, 1)>(vb), l3 = tr_read<v_rd_off(D0, 3, 0)>(vb), h3 = tr_read<v_rd_off(D0, 3, 1)>(vb);
    asm volatile("s_waitcnt lgkmcnt(0)" ::: "memory"); SBAR();
#define PK(L, H) (bf16x8){L[0], L[1], L[2], L[3], H[0], H[1], H[2], H[3]}
    od = __builtin_amdgcn_mfma_f32_32x32x16_bf16(pa0, PK(l0, h0), od, 0, 0, 0);
    od = __builtin_amdgcn_mfma_f32_32x32x16_bf16(pa1, PK(l1, h1), od, 0, 0, 0);
    od = __builtin_amdgcn_mfma_f32_32x32x16_bf16(pa2, PK(l2, h2), od, 0, 0, 0);
    od = __builtin_amdgcn_mfma_f32_32x32x16_bf16(pa3, PK(l3, h3), od, 0, 0, 0);
#undef PK
}
__device__ __forceinline__ void qkt(f32x16& p0, f32x16& p1, const char* Ks, const bf16x8* qr, int r32, int hi, int comp) {
    p0 = f32x16{}; p1 = f32x16{};
#pragma unroll
    for (int d0 = 0; d0 < 4; ++d0) {
        const int cb = (comp * 64 + d0 * 16 + hi * 8) * 2;
        const bf16x8 b0 = *reinterpret_cast<const bf16x8*>(Ks + KSWZ(r32, cb));
        const bf16x8 b1 = *reinterpret_cast<const bf16x8*>(Ks + KSWZ(32 + r32, cb));
        p0 = __builtin_amdgcn_mfma_f32_32x32x16_bf16(b0, qr[d0], p0, 0, 0, 0);
        p1 = __builtin_amdgcn_mfma_f32_32x32x16_bf16(b1, qr[d0], p1, 0, 0, 0);
    }
}

__device__ __forceinline__ void attn_unit(int b, int h, int qb, const bf16_t* Z, bf16_t* MIX, float lam, const float* subln, char* lds) {
    const int tid = opaque_tid(), wid = __builtin_amdgcn_readfirstlane(tid >> 6), lane = tid & 63, r32 = lane & 31, hi = lane >> 5;
    const int comp = wid >> 2, rg = wid & 3;
    char* V_lds = lds + L_V; char* K_lds = lds + L_K;
    float* wsf = (float*)(lds + L_WS) + wid * 64;
    const int q0 = b * SEQ + qb * 128;
    const float NEGV = -1e30f;
    bf16x8 qr[4];
    {
        const bf16_t* Qw = Z + (size_t)(q0 + rg * 32 + r32) * NZ + ZQ + h * 128 + comp * 64 + hi * 8;
#pragma unroll
        for (int d0 = 0; d0 < 4; ++d0) qr[d0] = *reinterpret_cast<const bf16x8*>(Qw + d0 * 16);
    }
    const int NT = 2 * qb + 3;
    const int sr = tid >> 4, sc = (tid & 15) * 8;
    const int vst0 = v_st(sr, sc), vst1 = v_st(32 + sr, sc), kst0 = KSWZ(sr, sc * 2), kst1 = KSWZ(32 + sr, sc * 2);
    const int vb0 = (int)(uintptr_t)V_lds + v_rd_base(lane);
#define PK4(P, BASE, OUT) do { unsigned a0 = cvtpk(P[BASE + 0], P[BASE + 1]), a1 = cvtpk(P[BASE + 2], P[BASE + 3]); \
        unsigned b0 = cvtpk(P[BASE + 4], P[BASE + 5]), b1 = cvtpk(P[BASE + 6], P[BASE + 7]); \
        auto r0 = __builtin_amdgcn_permlane32_swap(a0, b0, false, false); auto r1 = __builtin_amdgcn_permlane32_swap(a1, b1, false, false); \
        u32x4 w = {r0[0], r1[0], r0[1], r1[1]}; OUT = *reinterpret_cast<bf16x8*>(&w); } while (0)
    bf16x8 vsA0, vsA1, ksA0, ksA1, vsB0, vsB1, ksB0, ksB1;
#define SLOAD(j, S) do { const size_t r0_ = (size_t)((j) == 0 ? META_TILE0 : b * SEQ + ((j) - 1) * 64) + sr; const bf16_t* zp_ = Z + r0_ * NZ + h * 128 + sc; \
        vs##S##0 = *reinterpret_cast<const bf16x8*>(zp_ + ZV); vs##S##1 = *reinterpret_cast<const bf16x8*>(zp_ + ZV + (size_t)32 * NZ); \
        ks##S##0 = *reinterpret_cast<const bf16x8*>(zp_ + ZK); ks##S##1 = *reinterpret_cast<const bf16x8*>(zp_ + ZK + (size_t)32 * NZ); } while (0)
#define SWRITE(bi, S) do { *reinterpret_cast<bf16x8*>(V_lds + (bi) * SHM_V + vst0) = vs##S##0; *reinterpret_cast<bf16x8*>(V_lds + (bi) * SHM_V + vst1) = vs##S##1; \
        *reinterpret_cast<bf16x8*>(K_lds + (bi) * SHM_K + kst0) = ks##S##0; *reinterpret_cast<bf16x8*>(K_lds + (bi) * SHM_K + kst1) = ks##S##1; } while (0)
    f32x16 o[4] = {}; float m_reg = NEGV, l_reg = 0.f;
    SLOAD(0, A); SWRITE(0, A); SLOAD(1, B); __syncthreads();
    const int qrel = rg * 32 + r32;
#define ATT_TILE(j, L_, W_) do { \
        const int cur = j & 1; \
        if (j + 2 < NT) SLOAD(j + 2, L_); \
        f32x16 p0, p1; \
        qkt(p0, p1, K_lds + cur * SHM_K, qr, r32, hi, comp); \
        if (j == 0) { \
    _Pragma("unroll") \
            for (int r = 0; r < 16; ++r) { p0[r] = NEGV; if (r < 8) p1[r] = NEGV; } \
        } else if (j >= NT - 2) { \
            const int kb0 = (j - (NT - 2)) * 64; \
    _Pragma("unroll") \
            for (int r = 0; r < 16; ++r) { const int kl = kb0 + crow(r, hi); if (kl > qrel) p0[r] = NEGV; if (kl + 32 > qrel) p1[r] = NEGV; } \
        } \
        float pmax = p0[0]; \
    _Pragma("unroll") \
        for (int r = 1; r < 16; ++r) pmax = fmaxf(pmax, p0[r]); \
    _Pragma("unroll") \
        for (int r = 0; r < 16; ++r) pmax = fmaxf(pmax, p1[r]); \
        { auto rr = __builtin_amdgcn_permlane32_swap(__float_as_uint(pmax), __float_as_uint(pmax), false, false); pmax = fmaxf(__uint_as_float(rr[0]), __uint_as_float(rr[1])); } \
        const float mn = fmaxf(m_reg, pmax); const float alpha = __builtin_amdgcn_exp2f(m_reg - mn); m_reg = mn; \
        float ps = 0.f; \
    _Pragma("unroll") \
        for (int r = 0; r < 16; ++r) { p0[r] = __builtin_amdgcn_exp2f(p0[r] - mn); ps += p0[r]; } \
    _Pragma("unroll") \
        for (int r = 0; r < 16; ++r) { p1[r] = __builtin_amdgcn_exp2f(p1[r] - mn); ps += p1[r]; } \
        { auto rr = __builtin_amdgcn_permlane32_swap(__float_as_uint(ps), __float_as_uint(ps), false, false); ps = __uint_as_float(rr[0]) + __uint_as_float(rr[1]); } \
        l_reg = l_reg * alpha + ps; \
        if (__any(alpha < 1.f)) { \
            if (hi == 0) wsf[r32] = alpha; \
            asm volatile("s_waitcnt lgkmcnt(0)" ::: "memory"); \
            float al[16]; \
    _Pragma("unroll") \
            for (int r = 0; r < 16; ++r) al[r] = wsf[crow(r, hi)]; \
    _Pragma("unroll") \
            for (int d = 0; d < 4; ++d) \
    _Pragma("unroll") \
                for (int r = 0; r < 16; ++r) o[d][r] *= al[r]; \
            asm volatile("s_waitcnt lgkmcnt(0)" ::: "memory"); \
        } \
        bf16x8 pa0, pa1, pa2, pa3; \
        PK4(p0, 0, pa0); PK4(p0, 8, pa1); PK4(p1, 0, pa2); PK4(p1, 8, pa3); \
        SBAR(); \
        { const int vb = vb0 + cur * SHM_V; \
          pv_one<0>(o[0], vb, pa0, pa1, pa2, pa3); pv_one<1>(o[1], vb, pa0, pa1, pa2, pa3); pv_one<2>(o[2], vb, pa0, pa1, pa2, pa3); pv_one<3>(o[3], vb, pa0, pa1, pa2, pa3); } \
        if (j + 1 < NT) SWRITE(cur ^ 1, W_); \
        __syncthreads(); \
    } while (0)
    {
        SLOAD(2, A);
        f32x16 p1 = f32x16{};
#pragma unroll
        for (int d0 = 0; d0 < 4; ++d0) {
            const int cb = (comp * 64 + d0 * 16 + hi * 8) * 2;
            const bf16x8 b1 = *reinterpret_cast<const bf16x8*>(K_lds + KSWZ(32 + r32, cb));
            p1 = __builtin_amdgcn_mfma_f32_32x32x16_bf16(b1, qr[d0], p1, 0, 0, 0);
        }
        float pmax = p1[8];
#pragma unroll
        for (int r = 9; r < 16; ++r) pmax = fmaxf(pmax, p1[r]);
        { auto rr = __builtin_amdgcn_permlane32_swap(__float_as_uint(pmax), __float_as_uint(pmax), false, false); pmax = fmaxf(__uint_as_float(rr[0]), __uint_as_float(rr[1])); }
        m_reg = pmax;
        float ps = 0.f;
#pragma unroll
        for (int r = 0; r < 8; ++r) p1[r] = 0.f;
#pragma unroll
        for (int r = 8; r < 16; ++r) { p1[r] = __builtin_amdgcn_exp2f(p1[r] - pmax); ps += p1[r]; }
        { auto rr = __builtin_amdgcn_permlane32_swap(__float_as_uint(ps), __float_as_uint(ps), false, false); ps = __uint_as_float(rr[0]) + __uint_as_float(rr[1]); }
        l_reg = ps;
        bf16x8 pa3; PK4(p1, 8, pa3);
        SBAR();
        {
#define PKF(L, H) (bf16x8){L[0], L[1], L[2], L[3], H[0], H[1], H[2], H[3]}
            const s16x4 l0 = tr_read<v_rd_off(0, 3, 0)>(vb0), h0 = tr_read<v_rd_off(0, 3, 1)>(vb0), l1 = tr_read<v_rd_off(1, 3, 0)>(vb0), h1 = tr_read<v_rd_off(1, 3, 1)>(vb0);
            const s16x4 l2 = tr_read<v_rd_off(2, 3, 0)>(vb0), h2 = tr_read<v_rd_off(2, 3, 1)>(vb0), l3 = tr_read<v_rd_off(3, 3, 0)>(vb0), h3 = tr_read<v_rd_off(3, 3, 1)>(vb0);
            asm volatile("s_waitcnt lgkmcnt(0)" ::: "memory"); SBAR();
            o[0] = __builtin_amdgcn_mfma_f32_32x32x16_bf16(pa3, PKF(l0, h0), o[0], 0, 0, 0); o[1] = __builtin_amdgcn_mfma_f32_32x32x16_bf16(pa3, PKF(l1, h1), o[1], 0, 0, 0);
            o[2] = __builtin_amdgcn_mfma_f32_32x32x16_bf16(pa3, PKF(l2, h2), o[2], 0, 0, 0); o[3] = __builtin_amdgcn_mfma_f32_32x32x16_bf16(pa3, PKF(l3, h3), o[3], 0, 0, 0);
#undef PKF
        }
        SWRITE(1, B);
        __syncthreads();
    }
    for (int j = 1; j < NT; j += 2) { ATT_TILE(j, B, A); ATT_TILE(j + 1, A, B); }
#undef ATT_TILE
#undef SLOAD
#undef SWRITE
#undef PK4
    if (hi == 0) wsf[r32] = l_reg;
    asm volatile("s_waitcnt lgkmcnt(0)" ::: "memory");
    float rli[16];
#pragma unroll
    for (int r = 0; r < 16; ++r) rli[r] = __builtin_amdgcn_rcpf(wsf[crow(r, hi)]);
    float* X = (float*)lds + rg * 4096;
    if (comp == 1) {
#pragma unroll
        for (int d0 = 0; d0 < 4; ++d0)
#pragma unroll
            for (int r = 0; r < 16; ++r) X[(d0 * 16 + r) * 64 + lane] = o[d0][r] * rli[r] * lam;
    }
    __syncthreads();
    if (comp == 0) {
        float ssr[16];
#pragma unroll
        for (int r = 0; r < 16; ++r) ssr[r] = 0.f;
#pragma unroll
        for (int d0 = 0; d0 < 4; ++d0)
#pragma unroll
            for (int r = 0; r < 16; ++r) { const float v = o[d0][r] * rli[r] - X[(d0 * 16 + r) * 64 + lane]; o[d0][r] = v; ssr[r] += v * v; }
        float* P = (float*)(lds + L_P) + rg * 1024;
#pragma unroll
        for (int r = 0; r < 16; ++r) P[r * 64 + lane] = ssr[r];
        asm volatile("s_waitcnt lgkmcnt(0)" ::: "memory");
        {
            const int rho = lane & 31, hh = (rho >> 2) & 1, rr = (rho & 3) + 4 * (rho >> 3);
            const float4* pp = (const float4*)(P + rr * 64 + hh * 32 + (lane >> 5) * 16);
            const float4 a0 = pp[0], a1 = pp[1], a2 = pp[2], a3 = pp[3];
            float s = ((a0.x + a0.y) + (a0.z + a0.w)) + ((a1.x + a1.y) + (a1.z + a1.w)) + ((a2.x + a2.y) + (a2.z + a2.w)) + ((a3.x + a3.y) + (a3.z + a3.w));
            auto sw = __builtin_amdgcn_permlane32_swap(__float_as_uint(s), __float_as_uint(s), false, false); s = __uint_as_float(sw[0]) + __uint_as_float(sw[1]);
            if (lane < 32) wsf[32 + rho] = rsqrtf(s * (1.f / 128.f) + EPS) * (1.f - LAMBDA_INIT);
        }
        asm volatile("s_waitcnt lgkmcnt(0)" ::: "memory");
        float sw4[4];
#pragma unroll
        for (int d0 = 0; d0 < 4; ++d0) sw4[d0] = subln[d0 * 32 + r32];
        bf16_t* Ow = MIX + (size_t)(q0 + rg * 32) * DM + h * 128 + r32;
#pragma unroll
        for (int r = 0; r < 16; ++r) {
            const int orow = crow(r, hi); const float rs = wsf[32 + orow];
#pragma unroll
            for (int d0 = 0; d0 < 4; ++d0) Ow[(size_t)orow * DM + d0 * 32] = (bf16_t)f2bf(o[d0][r] * rs * sw4[d0]);
        }
    }
    __syncthreads();
}
#undef KSWZ
#undef SBAR
}

__device__ __forceinline__ float attn_lambda(const Args& a) {
    const int lane = opaque_tid() & 63;
    const float l1 = wave_sum(a.lamqk[lane] * a.lamqk[64 + lane]), l2 = wave_sum(a.lamqk[128 + lane] * a.lamqk[192 + lane]);
    return expf(l1) - expf(l2) + LAMBDA_INIT;
}
namespace mls {
using bf16x8 = __attribute__((ext_vector_type(8))) short;
using bf16x4 = __attribute__((ext_vector_type(4))) short;
using s16x4 = __attribute__((ext_vector_type(4))) short;
using f32x16 = __attribute__((ext_vector_type(16))) float;
using f32x4v = __attribute__((ext_vector_type(4))) float;
using u32x4v = __attribute__((ext_vector_type(4))) unsigned;
using u32x2v = __attribute__((ext_vector_type(2))) unsigned;
constexpr int L_QS = 0, L_QP = 16384, L_KS = 32768, L_KW = 49152, L_VT = 65536, L_PT = 98304, L_HT = 106496, HT_STRIDE = 528;
constexpr int L_MISC = L_HT + 64 * HT_STRIDE;
constexpr int L_RS = L_MISC, L_QN = L_RS + 2 * 64 * 4, L_NV = L_QN + 64 * 4, L_NP = L_NV + 128 * 4, L_CW = L_NP + 8 * 128 * 4, L_RD = L_CW + 5 * 256 * 4, L_NW = L_RD + 8 * 64 * 4, L_END = L_NW + 8 * 36 * 4;
#define KSWZ(row, colB) ((row) * 256 + ((colB) ^ (((row) & 7) << 4)))
#define PSWZ(row, colB) ((row) * 128 + ((colB) ^ ((((row) >> 1) & 7) << 4)))
__device__ __forceinline__ int crow(int r, int hi) { return (r & 3) + 8 * (r >> 2) + 4 * hi; }
__device__ __forceinline__ unsigned cvtpk(float lo, float hi) { unsigned r; asm volatile("v_cvt_pk_bf16_f32 %0, %1, %2" : "=v"(r) : "v"(lo), "v"(hi)); return r; }
__device__ __forceinline__ int v_st(int k, int c) { const int kk = (k & ~0xC) | ((k & 4) << 1) | ((k & 8) >> 1); return ((kk >> 3) * 4 + (c >> 5)) * 512 + ((kk & 7) * 32 + (c & 31)) * 2; }
__device__ __forceinline__ int v_rd_base(int lane) { return ((lane & 3) << 3) | (((lane >> 2) & 3) << 6) | (((lane >> 4) & 1) << 5) | (((lane >> 5) & 1) << 8); }
__device__ __forceinline__ s16x4 tr_read_dyn(int addr) { s16x4 r; asm volatile("ds_read_b64_tr_b16 %0, %1" : "=&v"(r) : "v"(addr) : "memory"); return r; }
__device__ __forceinline__ bf16x8 tr_frag(int img_plus_base, int d0, int ks) {
    const s16x4 lo = tr_read_dyn(img_plus_base + d0 * 512 + ks * 4096), hi = tr_read_dyn(img_plus_base + d0 * 512 + ks * 4096 + 2048);
    return (bf16x8){lo[0], lo[1], lo[2], lo[3], hi[0], hi[1], hi[2], hi[3]};
}
template <int CTRL, int RMASK> __device__ __forceinline__ float dppf(float old, float v) { return __builtin_bit_cast(float, __builtin_amdgcn_update_dpp(__builtin_bit_cast(int, old), __builtin_bit_cast(int, v), CTRL, RMASK, 0xf, false)); }
__device__ __forceinline__ float scan_add(float v) {
    v += dppf<0x111, 0xf>(0.f, v); v += dppf<0x112, 0xf>(0.f, v); v += dppf<0x114, 0xf>(0.f, v); v += dppf<0x118, 0xf>(0.f, v);
    v += dppf<0x142, 0xa>(0.f, v); v += dppf<0x143, 0xc>(0.f, v); return v;
}
__device__ __forceinline__ float scan_max(float v) {
    const float NI = -3.0e38f;
    v = fmaxf(v, dppf<0x111, 0xf>(NI, v)); v = fmaxf(v, dppf<0x112, 0xf>(NI, v)); v = fmaxf(v, dppf<0x114, 0xf>(NI, v)); v = fmaxf(v, dppf<0x118, 0xf>(NI, v));
    v = fmaxf(v, dppf<0x142, 0xa>(NI, v)); v = fmaxf(v, dppf<0x143, 0xc>(NI, v)); return v;
}
__device__ __forceinline__ float rlane(float v, int l) { return __uint_as_float(__builtin_amdgcn_readlane(__float_as_uint(v), l)); }
__device__ __forceinline__ float silu(float x) { return x * __builtin_amdgcn_rcpf(1.f + __expf(-x)); }
__device__ __forceinline__ void fmac_v(float& y, float a, float b) { asm("v_fmac_f32 %0, %1, %2" : "+v"(y) : "v"(a), "v"(b)); }
__device__ __forceinline__ float mul_v(float a, float b) { float r; asm("v_mul_f32 %0, %1, %2" : "=v"(r) : "v"(a), "v"(b)); return r; }

__device__ __forceinline__ void mlstm_item(int b, int h, const Args& a, char* lds) {
    const int tid0 = opaque_tid(), wid = __builtin_amdgcn_readfirstlane(tid0 >> 6);
    const bf16_t* Z = (const bf16_t*)(a.ws + WS_Z); const float* G = (const float*)(a.ws + WS_GATES); bf16_t* MIX = (bf16_t*)(a.ws + WS_MIX);
    const int ldsb = (int)(uintptr_t)lds;
    float* RS = (float*)(lds + L_RS); float* QN = (float*)(lds + L_QN); float* NV = (float*)(lds + L_NV); float* NP = (float*)(lds + L_NP); float* CW = (float*)(lds + L_CW);
    for (int i = tid0; i < 5 * 256; i += NTHREADS) { const int j = i >> 8, c = i & 255; const int cc = c < 128 ? h * 128 + c : 512 + h * 128 + (c - 128); CW[i] = j < 4 ? a.convw[j * 1024 + cc] : a.convb[cc]; }
    if (tid0 < 128) NV[tid0] = 0.f;
    if (tid0 < 256) ((float*)(lds + L_NW))[(tid0 >> 5) * 36 + (tid0 & 31)] = a.mnw[h * 256 + tid0];
    const float ibh = a.ib[h], fbh = a.fb[h];
    float cw[4][4], cb[4];
    __syncthreads();
    { const int c4 = 4 * (tid0 & 63);
#pragma unroll
    for (int j = 0; j < 4; ++j)
#pragma unroll
        for (int q = 0; q < 4; ++q) cw[j][q] = CW[j * 256 + c4 + q];
#pragma unroll
    for (int q = 0; q < 4; ++q) cb[q] = CW[4 * 256 + c4 + q]; }
    f32x16 C[4] = {};
    float m_prev = -1e30f;
    u32x2v rq[11]; u32x4v rv[4]; float gi, gf;
    auto chunk_row0 = [&](int c) -> int { return c == 0 ? META_TILE0 : b * SEQ + (c - 1) * 64; };
#define LOAD_RAW(c) do { int tq_ = tid0; asm volatile("" : "+v"(tq_)); const int ln_ = tq_ & 63, c4_ = 4 * ln_, zc_qk = (c4_ < 128 ? ZMQ + h * 128 + c4_ : ZMK + h * 128 + (c4_ - 128)), erow = tq_ >> 3, eseg = tq_ & 7; const int r0_ = chunk_row0(c); \
        _Pragma("unroll") for (int i_ = 0; i_ < 11; ++i_) { const int t_ = 8 * wid - 3 + i_; int row_; bool ok_ = true; \
            if (t_ >= 0) row_ = r0_ + t_; else if ((c) == 0) { row_ = 0; ok_ = false; } else if ((c) == 1) row_ = META_TILE0 + 64 + t_; else row_ = r0_ + t_; \
            rq[i_] = ok_ ? *(const u32x2v*)(Z + (size_t)row_ * NZ + zc_qk) : (u32x2v){0u, 0u}; } \
        _Pragma("unroll") for (int i_ = 0; i_ < 4; ++i_) rv[i_] = *(const u32x4v*)(Z + (size_t)(r0_ + erow) * NZ + ZMV + h * 256 + eseg * 32 + 8 * i_); \
        { const int rowg_ = r0_ + ln_; gi = G[(size_t)rowg_ * 8 + h]; gf = G[(size_t)rowg_ * 8 + 4 + h]; } } while (0)
    LOAD_RAW(0);
    const int NCH = 33;
    for (int c = 0; c < NCH; ++c) {
        int tid = tid0; asm volatile("" : "+v"(tid));
        const int lane = tid & 63, r32 = lane & 31, hi = lane >> 5, cq = lane, c4 = 4 * cq, erow = tid >> 3, eseg = tid & 7;
        float* RD = (float*)(lds + L_RD) + wid * 64;
        float li = gi + ibh; float lf; { const float xf = gf + fbh; lf = fminf(xf, 0.f) - __logf(1.f + __expf(-fabsf(xf))); }
        if (c == 0 && lane < 48) { li = -1e30f; lf = 0.f; }
        const float bsum = scan_add(lf);
        const float u = li - bsum;
        const float cm = scan_max(u);
        const float Mrow = fmaxf(cm, m_prev);
        const float iw = __expf(m_prev - Mrow);
        const float Mend = rlane(Mrow, 63), gtot = rlane(bsum, 63);
        const float wrow = __expf(u - Mend);
        const float dec = __expf(m_prev - Mend);
        const float dexp = __expf(-(bsum + Mrow));
        {
            float qn_part[8], ksum[4] = {0.f, 0.f, 0.f, 0.f};
            float nvv[4];
#pragma unroll
            for (int q = 0; q < 4; ++q) nvv[q] = (cq < 32) ? NV[c4 + q] : 0.f;
#pragma unroll
            for (int i = 0; i < 8; ++i) {
                const int t = 8 * wid + i;
                float xo[4];
#pragma unroll
                for (int q = 0; q < 4; ++q) xo[q] = cb[q];
#pragma unroll
                for (int j = 0; j < 4; ++j) {
                    const u32x2v rr = rq[i + j];
                    fmac_v(xo[0], cw[j][0], bf_lo(rr.x)); fmac_v(xo[1], cw[j][1], bf_hi(rr.x)); fmac_v(xo[2], cw[j][2], bf_lo(rr.y)); fmac_v(xo[3], cw[j][3], bf_hi(rr.y));
                }
#pragma unroll
                for (int q = 0; q < 4; ++q) xo[q] = silu(xo[q]);
                const float iw_t = rlane(iw, t), w_t = rlane(wrow, t);
                if (cq < 32) {
#pragma unroll
                    for (int q = 0; q < 4; ++q) xo[q] = mul_v(xo[q], 0.08838834764831845f);
                    *(uint2*)(lds + L_QS + KSWZ(t, c4 * 2)) = make_uint2(cvtpk(xo[0], xo[1]), cvtpk(xo[2], xo[3]));
                    float qd = 0.f;
#pragma unroll
                    for (int q = 0; q < 4; ++q) { fmac_v(qd, xo[q], nvv[q]); xo[q] = mul_v(xo[q], iw_t); }
                    *(uint2*)(lds + L_QP + KSWZ(t, c4 * 2)) = make_uint2(cvtpk(xo[0], xo[1]), cvtpk(xo[2], xo[3]));
                    qn_part[i] = iw_t * qd;
                } else {
                    const int kc = c4 - 128;
                    *(uint2*)(lds + L_KS + KSWZ(t, kc * 2)) = make_uint2(cvtpk(xo[0], xo[1]), cvtpk(xo[2], xo[3]));
#pragma unroll
                    for (int q = 0; q < 4; ++q) { xo[q] = mul_v(xo[q], w_t); ksum[q] += xo[q]; }
                    *(uint2*)(lds + L_KW + v_st(t, kc)) = make_uint2(cvtpk(xo[0], xo[1]), cvtpk(xo[2], xo[3]));
                    qn_part[i] = 0.f;
                }
                __builtin_amdgcn_sched_barrier(0);
            }
            {
                float r4[4], r2[2], r1;
                { const bool hb = (lane & 16) != 0;
#pragma unroll
                  for (int i = 0; i < 4; ++i) { const float send = hb ? qn_part[i] : qn_part[i + 4]; const float recv = __shfl_xor(send, 16); r4[i] = (hb ? qn_part[i + 4] : qn_part[i]) + recv; } }
                { const bool hb = (lane & 8) != 0;
#pragma unroll
                  for (int i = 0; i < 2; ++i) { const float send = hb ? r4[i] : r4[i + 2]; const float recv = __shfl_xor(send, 8); r2[i] = (hb ? r4[i + 2] : r4[i]) + recv; } }
                { const bool hb = (lane & 4) != 0; const float send = hb ? r2[0] : r2[1]; const float recv = __shfl_xor(send, 4); r1 = (hb ? r2[1] : r2[0]) + recv; }
                r1 += __shfl_xor(r1, 2); r1 += __shfl_xor(r1, 1);
                if (lane < 32 && (lane & 3) == 0) QN[8 * wid + ((lane >> 4) & 1) * 4 + ((lane >> 3) & 1) * 2 + ((lane >> 2) & 1)] = r1;
            }
            if (cq >= 32) {
#pragma unroll
                for (int q = 0; q < 4; ++q) NP[wid * 128 + (c4 - 128) + q] = ksum[q];
            }
#pragma unroll
            for (int i = 0; i < 4; ++i) *(u32x4v*)(lds + L_VT + (eseg >> 2) * 16384 + v_st(erow, (eseg & 3) * 32 + 8 * i)) = rv[i];
        }
        u32x4v zo[4];
        {
            const int r0 = chunk_row0(c);
#pragma unroll
            for (int i = 0; i < 4; ++i) zo[i] = *(const u32x4v*)(Z + (size_t)(r0 + erow) * NZ + ZMO + h * 256 + eseg * 32 + 8 * i);
        }
        if (c + 1 < NCH) LOAD_RAW(c + 1);
        __syncthreads();
        {
            const int tb = wid >> 1, half = wid & 1;
            float rsum[4] = {0.f, 0.f, 0.f, 0.f};
            const int fr = lane & 15, fq = lane >> 4;
            float Mt[4];
#pragma unroll
            for (int i = 0; i < 4; ++i) Mt[i] = __shfl(Mrow, 16 * tb + 4 * fq + i);
#pragma unroll
            for (int sj = 0; sj < 2; ++sj) {
                const int sb = 2 * half + sj;
                unsigned short pw[4] = {0, 0, 0, 0};
                if (sb <= tb) {
                    f32x4v acc = {0.f, 0.f, 0.f, 0.f};
#pragma unroll
                    for (int ks = 0; ks < 4; ++ks) {
                        const bf16x8 af = *(const bf16x8*)(lds + L_QS + KSWZ(16 * tb + fr, (32 * ks + 8 * fq) * 2));
                        const bf16x8 bfr = *(const bf16x8*)(lds + L_KS + KSWZ(16 * sb + fr, (32 * ks + 8 * fq) * 2));
                        acc = __builtin_amdgcn_mfma_f32_16x16x32_bf16(af, bfr, acc, 0, 0, 0);
                    }
                    const int s = 16 * sb + fr; const float us = __shfl(u, s);
#pragma unroll
                    for (int i = 0; i < 4; ++i) {
                        const int t = 16 * tb + 4 * fq + i;
                        const float p = (s <= t) ? acc[i] * __expf(us - Mt[i]) : 0.f;
                        rsum[i] += p; pw[i] = (unsigned short)f2bf(p);
                    }
                }
#pragma unroll
                for (int i = 0; i < 4; ++i) *(unsigned short*)(lds + L_PT + PSWZ(16 * tb + 4 * fq + i, (16 * sb + fr) * 2)) = pw[i];
            }
#pragma unroll
            for (int i = 0; i < 4; ++i) {
                float v = rsum[i];
                v += __shfl_xor(v, 1); v += __shfl_xor(v, 2); v += __shfl_xor(v, 4); v += __shfl_xor(v, 8);
                if (fr == 0) RS[half * 64 + 16 * tb + 4 * fq + i] = v;
            }
        }
        __syncthreads();
        {
            const float nq = RS[lane] + RS[64 + lane] + QN[lane];
            RD[lane] = __builtin_amdgcn_rcpf(fmaxf(fabsf(nq), dexp));
            bf16x8 vf[4];
            const int vimg = ldsb + L_VT + (wid >> 2) * 16384 + v_rd_base(lane);
#pragma unroll
            for (int ks = 0; ks < 4; ++ks) vf[ks] = tr_frag(vimg, wid & 3, ks);
            asm volatile("s_waitcnt lgkmcnt(0)" ::: "memory"); __builtin_amdgcn_sched_barrier(0);
            f32x16 acc[2] = {};
#pragma unroll
            for (int rb = 0; rb < 2; ++rb) {
                const int row = 32 * rb + r32;
#pragma unroll
                for (int ks = 0; ks < 4; ++ks) {
                    if (rb == 0 && ks >= 2) continue;
                    const bf16x8 pf = *(const bf16x8*)(lds + L_PT + PSWZ(row, (16 * ks + 8 * hi) * 2));
                    acc[rb] = __builtin_amdgcn_mfma_f32_32x32x16_bf16(pf, vf[ks], acc[rb], 0, 0, 0);
                }
            }
#pragma unroll
            for (int kb = 0; kb < 4; ++kb)
#pragma unroll
                for (int sp = 0; sp < 2; ++sp) {
                    bf16x8 cf; { unsigned w0 = cvtpk(C[kb][8 * sp + 0], C[kb][8 * sp + 1]), w1 = cvtpk(C[kb][8 * sp + 2], C[kb][8 * sp + 3]), w2 = cvtpk(C[kb][8 * sp + 4], C[kb][8 * sp + 5]), w3 = cvtpk(C[kb][8 * sp + 6], C[kb][8 * sp + 7]);
                        typedef unsigned u32x4_ __attribute__((ext_vector_type(4))); u32x4_ ww = {w0, w1, w2, w3}; cf = __builtin_bit_cast(bf16x8, ww); }
                    const int base = 32 * kb + 16 * sp;
#pragma unroll
                    for (int rb = 0; rb < 2; ++rb) {
                        const int row = 32 * rb + r32;
                        const bf16x4 q0 = *(const bf16x4*)(lds + L_QP + KSWZ(row, (base + 4 * hi) * 2));
                        const bf16x4 q1 = *(const bf16x4*)(lds + L_QP + KSWZ(row, (base + 8 + 4 * hi) * 2));
                        const bf16x8 qf = {q0[0], q0[1], q0[2], q0[3], q1[0], q1[1], q1[2], q1[3]};
                        acc[rb] = __builtin_amdgcn_mfma_f32_32x32x16_bf16(qf, cf, acc[rb], 0, 0, 0);
                    }
                }
            asm volatile("s_waitcnt lgkmcnt(0)" ::: "memory");
#pragma unroll
            for (int rb = 0; rb < 2; ++rb)
#pragma unroll
                for (int r = 0; r < 16; ++r) {
                    const int row = 32 * rb + crow(r, hi);
                    *(unsigned short*)(lds + L_HT + row * HT_STRIDE + (32 * wid + r32) * 2) = (unsigned short)f2bf(acc[rb][r] * RD[row]);
                }
#pragma unroll
            for (int kb = 0; kb < 4; ++kb) {
#pragma unroll
                for (int r = 0; r < 16; ++r) C[kb][r] *= dec;
                const int kimg = ldsb + L_KW + v_rd_base(lane);
                bf16x8 kf[4];
#pragma unroll
                for (int ks = 0; ks < 4; ++ks) kf[ks] = tr_frag(kimg, kb, ks);
                asm volatile("s_waitcnt lgkmcnt(0)" ::: "memory"); __builtin_amdgcn_sched_barrier(0);
#pragma unroll
                for (int ks = 0; ks < 4; ++ks) C[kb] = __builtin_amdgcn_mfma_f32_32x32x16_bf16(kf[ks], vf[ks], C[kb], 0, 0, 0);
            }
            if (tid < 128) { float s = NV[tid] * dec;
#pragma unroll
                for (int w8 = 0; w8 < 8; ++w8) s += NP[w8 * 128 + tid];
                NV[tid] = s; }
        }
        m_prev = gtot + Mend;
        __syncthreads();
        if (c > 0) {
            float hv[32]; float ss = 0.f;
#pragma unroll
            for (int i = 0; i < 4; ++i) {
                const uint4 w = *(const uint4*)(lds + L_HT + erow * HT_STRIDE + eseg * 64 + 16 * i);
                hv[8 * i + 0] = bf_lo(w.x); hv[8 * i + 1] = bf_hi(w.x); hv[8 * i + 2] = bf_lo(w.y); hv[8 * i + 3] = bf_hi(w.y);
                hv[8 * i + 4] = bf_lo(w.z); hv[8 * i + 5] = bf_hi(w.z); hv[8 * i + 6] = bf_lo(w.w); hv[8 * i + 7] = bf_hi(w.w);
            }
#pragma unroll
            for (int i = 0; i < 32; ++i) ss += hv[i] * hv[i];
            ss += __shfl_xor(ss, 1); ss += __shfl_xor(ss, 2); ss += __shfl_xor(ss, 4);
            const float rstd = rsqrtf(ss * (1.f / 256.f) + EPS);
            const float* nw = (const float*)(lds + L_NW) + eseg * 36;
            bf16_t* op = MIX + (size_t)(chunk_row0(c) + erow) * DM + 1024 + h * 256 + eseg * 32;
#pragma unroll
            for (int i = 0; i < 4; ++i) {
                const unsigned zz[4] = {zo[i].x, zo[i].y, zo[i].z, zo[i].w};
                unsigned ow[4];
#pragma unroll
                for (int q = 0; q < 4; ++q) {
                    const float z0 = bf_lo(zz[q]), z1 = bf_hi(zz[q]);
                    const float o0 = hv[8 * i + 2 * q] * rstd * nw[8 * i + 2 * q] * __builtin_amdgcn_rcpf(1.f + __expf(-z0));
                    const float o1 = hv[8 * i + 2 * q + 1] * rstd * nw[8 * i + 2 * q + 1] * __builtin_amdgcn_rcpf(1.f + __expf(-z1));
                    ow[q] = pk2(o0, o1);
                }
                *(uint4*)(op + 8 * i) = make_uint4(ow[0], ow[1], ow[2], ow[3]);
            }
        }
    }
#undef LOAD_RAW
    __syncthreads();
}
#undef KSWZ
#undef PSWZ
}

namespace rt {
using bf16x8 = __attribute__((ext_vector_type(8))) short;
using f32x16 = __attribute__((ext_vector_type(16))) float;
#define CE(a, b) do { const unsigned x_ = (a), y_ = (b); (a) = x_ > y_ ? x_ : y_; (b) = x_ > y_ ? y_ : x_; } while (0)
#define SORT16_DESC(V) do { CE(V[0], V[1]); CE(V[2], V[3]); CE(V[0], V[2]); CE(V[1], V[3]); CE(V[1], V[2]); CE(V[4], V[5]); CE(V[6], V[7]); CE(V[4], V[6]); CE(V[5], V[7]); CE(V[5], V[6]); CE(V[0], V[4]); CE(V[2], V[6]); CE(V[2], V[4]); CE(V[1], V[5]); CE(V[3], V[7]); CE(V[3], V[5]); CE(V[1], V[2]); CE(V[3], V[4]); CE(V[5], V[6]); CE(V[8], V[9]); CE(V[10], V[11]); CE(V[8], V[10]); CE(V[9], V[11]); CE(V[9], V[10]); CE(V[12], V[13]); CE(V[14], V[15]); CE(V[12], V[14]); CE(V[13], V[15]); CE(V[13], V[14]); CE(V[8], V[12]); CE(V[10], V[14]); CE(V[10], V[12]); CE(V[9], V[13]); CE(V[11], V[15]); CE(V[11], V[13]); CE(V[9], V[10]); CE(V[11], V[12]); CE(V[13], V[14]); CE(V[0], V[8]); CE(V[4], V[12]); CE(V[4], V[8]); CE(V[2], V[10]); CE(V[6], V[14]); CE(V[6], V[10]); CE(V[2], V[4]); CE(V[6], V[8]); CE(V[10], V[12]); CE(V[1], V[9]); CE(V[5], V[13]); CE(V[5], V[9]); CE(V[3], V[11]); CE(V[7], V[15]); CE(V[7], V[11]); CE(V[3], V[5]); CE(V[7], V[9]); CE(V[11], V[13]); CE(V[1], V[2]); CE(V[3], V[4]); CE(V[5], V[6]); CE(V[7], V[8]); CE(V[9], V[10]); CE(V[11], V[12]); CE(V[13], V[14]); } while (0)
#define BMERGE16_DESC(V) do { CE(V[0], V[8]); CE(V[1], V[9]); CE(V[2], V[10]); CE(V[3], V[11]); CE(V[4], V[12]); CE(V[5], V[13]); CE(V[6], V[14]); CE(V[7], V[15]); CE(V[0], V[4]); CE(V[1], V[5]); CE(V[2], V[6]); CE(V[3], V[7]); CE(V[8], V[12]); CE(V[9], V[13]); CE(V[10], V[14]); CE(V[11], V[15]); CE(V[0], V[2]); CE(V[1], V[3]); CE(V[4], V[6]); CE(V[5], V[7]); CE(V[8], V[10]); CE(V[9], V[11]); CE(V[12], V[14]); CE(V[13], V[15]); CE(V[0], V[1]); CE(V[2], V[3]); CE(V[4], V[5]); CE(V[6], V[7]); CE(V[8], V[9]); CE(V[10], V[11]); CE(V[12], V[13]); CE(V[14], V[15]); } while (0)

#define TOP16(A, B) do { _Pragma("unroll") for (int i_ = 0; i_ < 16; ++i_) { const unsigned x_ = A[i_], y_ = B[15 - i_]; A[i_] = x_ > y_ ? x_ : y_; } BMERGE16_DESC(A); } while (0)
__device__ __forceinline__ unsigned ord_key(float f) { const unsigned u = __float_as_uint(f); return u ^ (((unsigned)((int)u >> 31)) | 0x80000000u); }
__device__ __forceinline__ float ord_val(unsigned k) { return __uint_as_float((k & 0x80000000u) ? (k ^ 0x80000000u) : ~k); }
__device__ __forceinline__ int crow(int r, int hi) { return (r & 3) + 8 * (r >> 2) + 4 * hi; }

__device__ __forceinline__ void route_item(int tb, int h, const bf16_t* QP, const char* KL, const float* SSQ, int* IDX, float* GATE, int* scr, int lane_in) {
    int lane = lane_in; asm volatile("" : "+v"(lane));
    const int tok = lane & 31, hi = lane >> 5;
    const int row = tb * 32 + tok;
    float rstd;
    { const float4* sp = (const float4*)(SSQ + (size_t)row * 32); float s = 0.f;
#pragma unroll
      for (int i = 0; i < 8; ++i) { const float4 v = sp[i]; s += (v.x + v.y) + (v.z + v.w); }
      rstd = rsqrtf(s * (1.f / DM) + EPS); }
    unsigned top[2][16];
    bf16x8 qf[8], af[2][8];
    unsigned T[16];
#define RT_LOADQ(p_) do { const bf16_t* qp_ = QP + (size_t)row * DM + h * 256 + (p_) * 128 + hi * 8; \
        _Pragma("unroll") for (int ks = 0; ks < 8; ++ks) qf[ks] = *reinterpret_cast<const bf16x8*>(qp_ + ks * 16); } while (0)
#define RT_LOADK(b_, i_) do { const char* kp_ = KL + ((((i_) >> 2) * 128 + ((i_) & 3) * 32 + tok) * 272 + hi * 16); \
        _Pragma("unroll") for (int ks = 0; ks < 8; ++ks) af[b_][ks] = *reinterpret_cast<const bf16x8*>(kp_ + ks * 32); } while (0)
    RT_LOADQ(0); RT_LOADK(0, 0);
#pragma unroll
    for (int i = 0; i < 8; ++i) {
        const int p = i >> 2, kb = i & 3;
        if (i + 1 < 8) RT_LOADK((i + 1) & 1, i + 1);
        f32x16 acc = {};
#pragma unroll
        for (int ks = 0; ks < 8; ++ks) acc = __builtin_amdgcn_mfma_f32_32x32x16_bf16(af[i & 1][ks], qf[ks], acc, 0, 0, 0);
        unsigned K[16];
#pragma unroll
        for (int r = 0; r < 16; ++r) { const int low = 127 - (32 * kb + (r & 3) + 8 * (r >> 2)) - 4 * hi; K[r] = (ord_key(acc[r]) & ~127u) | (unsigned)low; }
        if (i == 3) RT_LOADQ(1);
        SORT16_DESC(K);
        if (kb == 0) {
#pragma unroll
            for (int j = 0; j < 16; ++j) T[j] = K[j];
        } else { TOP16(T, K); }
        if (kb == 3) {
            unsigned O[16];
#pragma unroll
            for (int j = 0; j < 16; ++j) { auto rr = __builtin_amdgcn_permlane32_swap(T[j], T[j], false, false); O[j] = hi ? rr[0] : rr[1]; }
            TOP16(T, O);
#pragma unroll
            for (int j = 0; j < 16; ++j) top[p][j] = T[j];
        }
        __builtin_amdgcn_sched_barrier(0);
    }
#undef RT_LOADQ
#undef RT_LOADK
    float s1[16], s2[16];
#pragma unroll
    for (int i = 0; i < 16; ++i) {
        s1[i] = ord_val(top[0][i] & ~127u) * rstd; s2[i] = ord_val(top[1][i] & ~127u) * rstd;
        scr[i * 64 + lane] = 127 - (int)(top[0][i] & 127u); scr[(16 + i) * 64 + lane] = 127 - (int)(top[1][i] & 127u);
    }
#define CKEY(a_, b_) ((ord_key(s1[a_] + s2[b_]) & ~255u) | (unsigned)(255 - (16 * (a_) + (b_))))
    unsigned A[16], B[16], Cg[16];
#pragma unroll
    for (int b_ = 0; b_ < 16; ++b_) A[b_] = CKEY(0, b_);
#pragma unroll
    for (int b_ = 0; b_ < 8; ++b_) { B[b_] = CKEY(1, b_); B[8 + b_] = CKEY(15 - b_, 0); }
    BMERGE16_DESC(B);
    Cg[0] = CKEY(2, 0); Cg[1] = CKEY(2, 1); Cg[2] = CKEY(2, 2); Cg[3] = CKEY(2, 3); Cg[4] = CKEY(2, 4);
    Cg[5] = CKEY(3, 0); Cg[6] = CKEY(3, 1); Cg[7] = CKEY(3, 2); Cg[8] = CKEY(3, 3);
    Cg[9] = CKEY(4, 0); Cg[10] = CKEY(4, 1); Cg[11] = CKEY(4, 2);
    Cg[12] = CKEY(5, 0); Cg[13] = CKEY(5, 1); Cg[14] = CKEY(6, 0); Cg[15] = CKEY(6, 1);
    SORT16_DESC(Cg);
    { const unsigned d0 = CKEY(7, 0), d1 = CKEY(7, 1); Cg[15] = Cg[15] > d0 ? Cg[15] : d0; Cg[14] = Cg[14] > d1 ? Cg[14] : d1; BMERGE16_DESC(Cg); }
    TOP16(A, B); TOP16(A, Cg);
#undef CKEY
    asm volatile("s_waitcnt lgkmcnt(0)" ::: "memory");
    float e[16]; float z = 0.f; const float mx = ord_val(A[0] & ~255u);
#pragma unroll
    for (int j = 0; j < 16; ++j) { e[j] = __expf(ord_val(A[j] & ~255u) - mx); z += e[j]; }
    const float rz = 1.f / z;
    int* ip = IDX + (size_t)row * 128 + h * 16 + hi * 8; float* gp = GATE + (size_t)row * 128 + h * 16 + hi * 8;
    int oi[8] = {0, 0, 0, 0, 0, 0, 0, 0}; float og[8] = {0.f, 0.f, 0.f, 0.f, 0.f, 0.f, 0.f, 0.f};
#pragma unroll
    for (int j = 0; j < 16; ++j) {
        const int flat = 255 - (int)(A[j] & 255u), a_ = flat >> 4, b_ = flat & 15;
        const int ex = scr[a_ * 64 + lane] * 128 + scr[(16 + b_) * 64 + lane];
        if (j < 8) { if (!hi) { oi[j] = ex; og[j] = e[j] * rz; } } else { if (hi) { oi[j - 8] = ex; og[j - 8] = e[j] * rz; } }
    }
    *(int4*)(ip) = make_int4(oi[0], oi[1], oi[2], oi[3]); *(int4*)(ip + 4) = make_int4(oi[4], oi[5], oi[6], oi[7]);
    *(float4*)(gp) = make_float4(og[0], og[1], og[2], og[3]); *(float4*)(gp + 4) = make_float4(og[4], og[5], og[6], og[7]);
    asm volatile("s_waitcnt lgkmcnt(0)" ::: "memory");
}
#undef CE
#undef TOP16
}

__device__ __forceinline__ void phase_route(const Args& a, unsigned char* lds, int bid, int nb) {
    const int tid = opaque_tid(), wave = __builtin_amdgcn_readfirstlane(tid >> 6), lane = tid & 63;
    const bf16_t* QP = (const bf16_t*)(a.ws + WS_MIX); const bf16_t* SKB = (const bf16_t*)(a.ws + WS_SKB); const float* SSQ = (const float*)(a.ws + WS_SSQ);
    int* IDX = (int*)(a.ws + WS_IDX); float* GATE = (float*)(a.ws + WS_GATE);
    int* scr = (int*)lds + wave * 2048;
    {
        const bf16_t* X1W = (const bf16_t*)(a.ws + WS_HN); signed char* X1Q = (signed char*)(a.ws + WS_X1Q); float* XSC = (float*)(a.ws + WS_XSC);
        for (int row = bid * NWAVES + wave; row < TREAL; row += nb * NWAVES) {
            uint4 xr[4]; float am = 0.f;
#pragma unroll
            for (int j = 0; j < 4; ++j) { xr[j] = *(const uint4*)(X1W + (size_t)row * DM + 8 * lane + 512 * j);
                am = fmaxf(am, fmaxf(fmaxf(fmaxf(fabsf(bf_lo(xr[j].x)), fabsf(bf_hi(xr[j].x))), fmaxf(fabsf(bf_lo(xr[j].y)), fabsf(bf_hi(xr[j].y)))), fmaxf(fmaxf(fabsf(bf_lo(xr[j].z)), fabsf(bf_hi(xr[j].z))), fmaxf(fabsf(bf_lo(xr[j].w)), fabsf(bf_hi(xr[j].w)))))); }
            am = wave_max(am);
            const float sc = am > 0.f ? 127.f / am : 0.f;
#pragma unroll
            for (int j = 0; j < 4; ++j) {
                const unsigned ww[4] = {xr[j].x, xr[j].y, xr[j].z, xr[j].w}; unsigned o[2] = {0u, 0u};
#pragma unroll
                for (int q = 0; q < 4; ++q) { const int q0 = (int)rintf(bf_lo(ww[q]) * sc), q1 = (int)rintf(bf_hi(ww[q]) * sc); o[q >> 1] |= ((unsigned)(q0 & 255) | ((unsigned)(q1 & 255) << 8)) << (16 * (q & 1)); }
                *(uint2*)(X1Q + (size_t)row * DM + 8 * lane + 512 * j) = make_uint2(o[0], o[1]);
            }
            if (lane == 0) XSC[row] = am * (1.f / 127.f);
        }
    }
    {
        const int hb = bid & 7; char* KL = (char*)lds + 65536;
        __syncthreads();
        const uint4* src = (const uint4*)(SKB + (size_t)hb * (2 * 128 * 128));
#pragma unroll
        for (int k = 0; k < 8; ++k) { const int ci = tid + NTHREADS * k; *(uint4*)(KL + (ci >> 4) * 272 + (ci & 15) * 16) = src[ci]; }
        __syncthreads();
        const int nbh = (nb - hb + 7) >> 3;
        for (int tb = (bid >> 3) * NWAVES + wave; tb < TREAL / 32; tb += nbh * NWAVES) rt::route_item(tb, hb, QP, KL, SSQ, IDX, GATE, scr, lane);
    }
}

constexpr int CW_QPV = 8192, CW_QPU = 8192 + 8 * 64;
constexpr int PX_ITEMS = TREAL / 64;
constexpr size_t WS_W = WS_Z + 4 * MiB, WS_PART = WS_Z + 32 * MiB, WS_Y = WS_Z + 160 * MiB;


template <int CTRL, int RMASK> __device__ __forceinline__ float dppf(float old, float v) { return __builtin_bit_cast(float, __builtin_amdgcn_update_dpp(__builtin_bit_cast(int, old), __builtin_bit_cast(int, v), CTRL, RMASK, 0xf, false)); }
template <int CTRL> __device__ __forceinline__ int dppi(int v) { return __builtin_amdgcn_update_dpp(0, v, CTRL, 0xf, 0xf, false); }
namespace pu2 {
typedef float f32x2v __attribute__((ext_vector_type(2)));
typedef unsigned u32x4v __attribute__((ext_vector_type(4)));
#define SBP() __builtin_amdgcn_sched_barrier(0)
#define PU_CHUNK_LD(dst, r_, q_) dst = *(const u32x4v*)(sidx + ((r_) - r0) * 512 + g128 + (q_) * 16)
#define PU_ROW_LD(buf, e_) buf = __builtin_amdgcn_raw_buffer_load_b128(U, (int)(e_) * 256 + c16, 0, 0)
#define PU_CONSUME(buf, I_) do { int s_ = __builtin_amdgcn_sdot4((int)buf[0], hq0, 0, false); s_ = __builtin_amdgcn_sdot4((int)buf[1], hq1, s_, false); \
    s_ = __builtin_amdgcn_sdot4((int)buf[2], hq2, s_, false); s_ = __builtin_amdgcn_sdot4((int)buf[3], hq3, s_, false); \
    s_ += dppi<0x128>(s_); s_ += dppi<0x124>(s_); s_ += dppi<0x122>(s_); s_ += dppi<0x121>(s_); \
    if ((I_) < 16) keep0 = (c == ((I_) & 15)) ? s_ : keep0; else keep1 = (c == ((I_) & 15)) ? s_ : keep1; } while (0)
#define PU_TOKEN_BODY(row_, nrow_, has_next_) do { \
    PU_CHUNK_LD(C7, row_, 7); \
    SBP(); PU_CONSUME(B0, 0); \
    PU_ROW_LD(B0, C2.x); \
    SBP(); PU_CONSUME(B1, 1); \
    PU_ROW_LD(B1, C2.y); \
    SBP(); PU_CONSUME(B2, 2); \
    PU_ROW_LD(B2, C2.z); \
    SBP(); PU_CONSUME(B3, 3); \
    PU_ROW_LD(B3, C2.w); \
    if (has_next_) PU_CHUNK_LD(C0, nrow_, 0); \
    SBP(); PU_CONSUME(B4, 4); \
    PU_ROW_LD(B4, C3.x); \
    SBP(); PU_CONSUME(B5, 5); \
    PU_ROW_LD(B5, C3.y); \
    SBP(); PU_CONSUME(B6, 6); \
    PU_ROW_LD(B6, C3.z); \
    SBP(); PU_CONSUME(B7, 7); \
    PU_ROW_LD(B7, C3.w); \
    if (has_next_) PU_CHUNK_LD(C1, nrow_, 1); \
    SBP(); PU_CONSUME(B0, 8); \
    PU_ROW_LD(B0, C4.x); \
    SBP(); PU_CONSUME(B1, 9); \
    PU_ROW_LD(B1, C4.y); \
    SBP(); PU_CONSUME(B2, 10); \
    PU_ROW_LD(B2, C4.z); \
    SBP(); PU_CONSUME(B3, 11); \
    PU_ROW_LD(B3, C4.w); \
    if (has_next_) PU_CHUNK_LD(C2, nrow_, 2); \
    SBP(); PU_CONSUME(B4, 12); \
    PU_ROW_LD(B4, C5.x); \
    SBP(); PU_CONSUME(B5, 13); \
    PU_ROW_LD(B5, C5.y); \
    SBP(); PU_CONSUME(B6, 14); \
    PU_ROW_LD(B6, C5.z); \
    SBP(); PU_CONSUME(B7, 15); \
    PU_ROW_LD(B7, C5.w); \
    if (has_next_) PU_CHUNK_LD(C3, nrow_, 3); \
    SBP(); PU_CONSUME(B0, 16); \
    PU_ROW_LD(B0, C6.x); \
    SBP(); PU_CONSUME(B1, 17); \
    PU_ROW_LD(B1, C6.y); \
    SBP(); PU_CONSUME(B2, 18); \
    PU_ROW_LD(B2, C6.z); \
    SBP(); PU_CONSUME(B3, 19); \
    PU_ROW_LD(B3, C6.w); \
    if (has_next_) PU_CHUNK_LD(C4, nrow_, 4); \
    SBP(); PU_CONSUME(B4, 20); \
    PU_ROW_LD(B4, C7.x); \
    SBP(); PU_CONSUME(B5, 21); \
    PU_ROW_LD(B5, C7.y); \
    SBP(); PU_CONSUME(B6, 22); \
    PU_ROW_LD(B6, C7.z); \
    SBP(); PU_CONSUME(B7, 23); \
    PU_ROW_LD(B7, C7.w); \
    if (has_next_) PU_CHUNK_LD(C5, nrow_, 5); \
    SBP(); PU_CONSUME(B0, 24); \
    if (has_next_) PU_ROW_LD(B0, C0.x); \
    SBP(); PU_CONSUME(B1, 25); \
    if (has_next_) PU_ROW_LD(B1, C0.y); \
    SBP(); PU_CONSUME(B2, 26); \
    if (has_next_) PU_ROW_LD(B2, C0.z); \
    SBP(); PU_CONSUME(B3, 27); \
    if (has_next_) PU_ROW_LD(B3, C0.w); \
    if (has_next_) PU_CHUNK_LD(C6, nrow_, 6); \
    SBP(); PU_CONSUME(B4, 28); \
    if (has_next_) PU_ROW_LD(B4, C1.x); \
    SBP(); PU_CONSUME(B5, 29); \
    if (has_next_) PU_ROW_LD(B5, C1.y); \
    SBP(); PU_CONSUME(B6, 30); \
    if (has_next_) PU_ROW_LD(B6, C1.z); \
    SBP(); PU_CONSUME(B7, 31); \
    if (has_next_) PU_ROW_LD(B7, C1.w); \
    } while (0)
#undef SBP
}

__device__ __forceinline__ void phase_pu(const Args& a, unsigned char* lds, unsigned* ctl, int xcc) {
    using namespace pu2;
#define SBP() __builtin_amdgcn_sched_barrier(0)
    const int tid = opaque_tid(), wave = __builtin_amdgcn_readfirstlane(tid >> 6), lane = tid & 63;
    volatile LAS unsigned* slot = (volatile LAS unsigned*)((LAS unsigned char*)lds + LDS_MISC) + 2;
    const signed char* X1Q = (const signed char*)(a.ws + WS_X1Q); float* PART = (float*)(a.ws + WS_PART);
    unsigned char* sidx = lds + wave * 4096; unsigned char* sxq = lds + 32768 + wave * 2048;
    const __amdgpu_buffer_rsrc_t RI = __builtin_amdgcn_make_buffer_rsrc((void*)(a.ws + WS_IDX), (short)0, TREAL * 512, 0x00020000);
    for (int ss = 0; ss < 8; ++ss) {
        const int s = (xcc + ss) & 7;
        const __amdgpu_buffer_rsrc_t U = __builtin_amdgcn_make_buffer_rsrc((void*)(a.ws + WS_U + (size_t)s * (16384 * 256)), (short)0, 16384 * 256, 0x00020000);
        unsigned wdraw = wave_draw(ctl + CW_QPU + 64 * s, lane);
        for (;;) {
            const int item8 = wave_item(wdraw);
            if (item8 >= PX_ITEMS * 8) break;
            wdraw = wave_draw(ctl + CW_QPU + 64 * s, lane);
            int ln = lane; asm volatile("" : "+v"(ln));
            const int g = ln >> 4, c = ln & 15, c16 = c * 16, g128 = g * 128;
            const int r0 = item8 * 8;
            u32x4v C0, C1, C2, C3, C4, C5, C6, C7, B0, B1, B2, B3, B4, B5, B6, B7;
            {
                const u32x4v* gi = (const u32x4v*)(a.ws + WS_IDX + (size_t)r0 * 512) + ln;
                const u32x4v i0 = gi[0], i1 = gi[64], i2 = gi[128], i3 = gi[192];
                const u32x4v xa = *(const u32x4v*)(X1Q + (size_t)(r0 + g) * DM + 256 * s + 16 * c), xb = *(const u32x4v*)(X1Q + (size_t)(r0 + 4 + g) * DM + 256 * s + 16 * c);
                u32x4v* si = (u32x4v*)sidx + ln; u32x4v* sx = (u32x4v*)sxq + ln;
                si[0] = i0; si[64] = i1; si[128] = i2; si[192] = i3; sx[0] = xa; sx[64] = xb;
                asm volatile("s_waitcnt lgkmcnt(0)" ::: "memory");
            }
            PU_CHUNK_LD(C0, r0, 0); PU_CHUNK_LD(C1, r0, 1); PU_CHUNK_LD(C2, r0, 2); PU_CHUNK_LD(C3, r0, 3); PU_CHUNK_LD(C4, r0, 4); PU_CHUNK_LD(C5, r0, 5); PU_CHUNK_LD(C6, r0, 6);
            uint4 nxq = ((const uint4*)sxq)[c];
            PU_ROW_LD(B0, C0.x); PU_ROW_LD(B1, C0.y); PU_ROW_LD(B2, C0.z); PU_ROW_LD(B3, C0.w); PU_ROW_LD(B4, C1.x); PU_ROW_LD(B5, C1.y); PU_ROW_LD(B6, C1.z); PU_ROW_LD(B7, C1.w);
#pragma unroll 1
            for (int t = 0; t < 8; ++t) {
                const int row = r0 + t, nrow = row + 1; const bool has_next = t < 7;
                const int hq0 = (int)nxq.x, hq1 = (int)nxq.y, hq2 = (int)nxq.z, hq3 = (int)nxq.w;
                if (has_next) nxq = ((const uint4*)sxq)[(t + 1) * 16 + c];
                int keep0 = 0, keep1 = 0;
                PU_TOKEN_BODY(row, nrow, has_next);
                float* pp = PART + (size_t)row * 1024 + s * 128 + 32 * g + c;
                pp[0] = (float)keep0; pp[16] = (float)keep1;
            }
        }
    }
#undef SBP
}
__device__ __forceinline__ void phase_pc(const Args& a, int bid, int nb) {
    const int tid = opaque_tid(), wave = __builtin_amdgcn_readfirstlane(tid >> 6), lane = tid & 63;
    const float* SSQ = (const float*)(a.ws + WS_SSQ); const int* IDX = (const int*)(a.ws + WS_IDX); const float* GATE = (const float*)(a.ws + WS_GATE);
    const float2* ISC2 = (const float2*)(a.ws + WS_ISC); const float* PART = (const float*)(a.ws + WS_PART); unsigned* W16 = (unsigned*)(a.ws + WS_W); float* WSC = (float*)(a.ws + WS_W + 12 * MiB);
    for (int row = bid * NWAVES + wave; row < TREAL; row += nb * NWAVES) {
        float ssv = lane < 32 ? SSQ[(size_t)row * 32 + lane] : 0.f; ssv = wave_sum(ssv);
        const float rstd = rsqrtf(ssv * (1.f / DM) + EPS);
        const float xsc = ((const float*)(a.ws + WS_XSC))[row];
        float2 d = {0.f, 0.f};
#pragma unroll
        for (int s = 0; s < 8; ++s) { const float2 v = *(const float2*)(PART + (size_t)row * 1024 + s * 128 + 2 * lane); d.x += v.x; d.y += v.y; }
        const int2 e2 = *(const int2*)(IDX + (size_t)row * 128 + 2 * lane);
        const float2 g2 = *(const float2*)(GATE + (size_t)row * 128 + 2 * lane);
        const float2 sa = ISC2[e2.x], sb = ISC2[e2.y];
        float wv[2];
        { const float pre = d.x * rstd * sa.x * xsc; wv[0] = g2.x * sa.y * (0.5f * pre * (1.f + erff(pre * 0.7071067811865476f))); }
        { const float pre = d.y * rstd * sb.x * xsc; wv[1] = g2.y * sb.y * (0.5f * pre * (1.f + erff(pre * 0.7071067811865476f))); }
        const float wmax = wave_max(fmaxf(fabsf(wv[0]), fabsf(wv[1])));
        const float wsc = wmax > 0.f ? 240.f / wmax : 0.f;
        unsigned packed = 0u;
#pragma unroll
        for (int k = 0; k < 2; ++k) {
            const float ws = wv[k] * wsc;
            const int hi = __builtin_amdgcn_cvt_pk_fp8_f32(ws, 0.f, 0, false) & 255;
            const int lo = __builtin_amdgcn_cvt_pk_fp8_f32(ws - __builtin_amdgcn_cvt_f32_fp8(hi, 0), 0.f, 0, false) & 255;
            packed |= (unsigned)(hi | (lo << 8)) << (16 * k);
        }
        W16[(size_t)row * 64 + lane] = packed;
        if (lane == 0) WSC[row] = wmax * (1.f / 240.f);
    }
}
namespace pv2 {
typedef float f32x2v __attribute__((ext_vector_type(2)));
typedef unsigned u32x4v __attribute__((ext_vector_type(4))); typedef float f32x4v __attribute__((ext_vector_type(4)));
typedef unsigned u32x2v __attribute__((ext_vector_type(2)));
struct Chunk { u32x4v i; u32x2v w; };
#define SBP() __builtin_amdgcn_sched_barrier(0)
#define PV_CHUNK_LD(dst, r_, q_) do { dst.i = *(const u32x4v*)(sidx + ((r_) - r0) * 512 + g128 + (q_) * 16); dst.w = *(const u32x2v*)(swt + ((r_) - r0) * 256 + g64 + (q_) * 8); } while (0)
#define PV_ROW_LD(buf, e_) buf = __builtin_amdgcn_raw_buffer_load_b128(V, (int)(e_) * 256 + c16, 0, 0)
#define PV_CONSUME(buf, ww_, S0_, S1_) do { const u32x2v b2_ = {__builtin_amdgcn_perm(0u, (ww_), (S0_)), __builtin_amdgcn_perm(0u, (ww_), (S1_))}; const long bb_ = __builtin_bit_cast(long, b2_); \
    const u32x2v a0_ = {buf[0], buf[1]}, a1_ = {buf[2], buf[3]}; \
    acc_lo = __builtin_amdgcn_mfma_f32_16x16x32_fp8_fp8(__builtin_bit_cast(long, a0_), bb_, acc_lo, 0, 0, 0); acc_hi = __builtin_amdgcn_mfma_f32_16x16x32_fp8_fp8(__builtin_bit_cast(long, a1_), bb_, acc_hi, 0, 0, 0); } while (0)
#define PV_TOKEN_BODY(row_, nrow_, has_next_) do { \
    PV_CHUNK_LD(C7, row_, 7); \
    SBP(); PV_CONSUME(B0, C0.w[0], sele0, sele1); \
    PV_ROW_LD(B0, C2.i.x); \
    SBP(); PV_CONSUME(B1, C0.w[0], selo0, selo1); \
    PV_ROW_LD(B1, C2.i.y); \
    SBP(); PV_CONSUME(B2, C0.w[1], sele0, sele1); \
    PV_ROW_LD(B2, C2.i.z); \
    SBP(); PV_CONSUME(B3, C0.w[1], selo0, selo1); \
    PV_ROW_LD(B3, C2.i.w); \
    if (has_next_) PV_CHUNK_LD(C0, nrow_, 0); \
    SBP(); PV_CONSUME(B4, C1.w[0], sele0, sele1); \
    PV_ROW_LD(B4, C3.i.x); \
    SBP(); PV_CONSUME(B5, C1.w[0], selo0, selo1); \
    PV_ROW_LD(B5, C3.i.y); \
    SBP(); PV_CONSUME(B6, C1.w[1], sele0, sele1); \
    PV_ROW_LD(B6, C3.i.z); \
    SBP(); PV_CONSUME(B7, C1.w[1], selo0, selo1); \
    PV_ROW_LD(B7, C3.i.w); \
    if (has_next_) PV_CHUNK_LD(C1, nrow_, 1); \
    SBP(); PV_CONSUME(B0, C2.w[0], sele0, sele1); \
    PV_ROW_LD(B0, C4.i.x); \
    SBP(); PV_CONSUME(B1, C2.w[0], selo0, selo1); \
    PV_ROW_LD(B1, C4.i.y); \
    SBP(); PV_CONSUME(B2, C2.w[1], sele0, sele1); \
    PV_ROW_LD(B2, C4.i.z); \
    SBP(); PV_CONSUME(B3, C2.w[1], selo0, selo1); \
    PV_ROW_LD(B3, C4.i.w); \
    if (has_next_) PV_CHUNK_LD(C2, nrow_, 2); \
    SBP(); PV_CONSUME(B4, C3.w[0], sele0, sele1); \
    PV_ROW_LD(B4, C5.i.x); \
    SBP(); PV_CONSUME(B5, C3.w[0], selo0, selo1); \
    PV_ROW_LD(B5, C5.i.y); \
    SBP(); PV_CONSUME(B6, C3.w[1], sele0, sele1); \
    PV_ROW_LD(B6, C5.i.z); \
    SBP(); PV_CONSUME(B7, C3.w[1], selo0, selo1); \
    PV_ROW_LD(B7, C5.i.w); \
    if (has_next_) PV_CHUNK_LD(C3, nrow_, 3); \
    SBP(); PV_CONSUME(B0, C4.w[0], sele0, sele1); \
    PV_ROW_LD(B0, C6.i.x); \
    SBP(); PV_CONSUME(B1, C4.w[0], selo0, selo1); \
    PV_ROW_LD(B1, C6.i.y); \
    SBP(); PV_CONSUME(B2, C4.w[1], sele0, sele1); \
    PV_ROW_LD(B2, C6.i.z); \
    SBP(); PV_CONSUME(B3, C4.w[1], selo0, selo1); \
    PV_ROW_LD(B3, C6.i.w); \
    if (has_next_) PV_CHUNK_LD(C4, nrow_, 4); \
    SBP(); PV_CONSUME(B4, C5.w[0], sele0, sele1); \
    PV_ROW_LD(B4, C7.i.x); \
    SBP(); PV_CONSUME(B5, C5.w[0], selo0, selo1); \
    PV_ROW_LD(B5, C7.i.y); \
    SBP(); PV_CONSUME(B6, C5.w[1], sele0, sele1); \
    PV_ROW_LD(B6, C7.i.z); \
    SBP(); PV_CONSUME(B7, C5.w[1], selo0, selo1); \
    PV_ROW_LD(B7, C7.i.w); \
    if (has_next_) PV_CHUNK_LD(C5, nrow_, 5); \
    SBP(); PV_CONSUME(B0, C6.w[0], sele0, sele1); \
    if (has_next_) PV_ROW_LD(B0, C0.i.x); \
    SBP(); PV_CONSUME(B1, C6.w[0], selo0, selo1); \
    if (has_next_) PV_ROW_LD(B1, C0.i.y); \
    SBP(); PV_CONSUME(B2, C6.w[1], sele0, sele1); \
    if (has_next_) PV_ROW_LD(B2, C0.i.z); \
    SBP(); PV_CONSUME(B3, C6.w[1], selo0, selo1); \
    if (has_next_) PV_ROW_LD(B3, C0.i.w); \
    if (has_next_) PV_CHUNK_LD(C6, nrow_, 6); \
    SBP(); PV_CONSUME(B4, C7.w[0], sele0, sele1); \
    if (has_next_) PV_ROW_LD(B4, C1.i.x); \
    SBP(); PV_CONSUME(B5, C7.w[0], selo0, selo1); \
    if (has_next_) PV_ROW_LD(B5, C1.i.y); \
    SBP(); PV_CONSUME(B6, C7.w[1], sele0, sele1); \
    if (has_next_) PV_ROW_LD(B6, C1.i.z); \
    SBP(); PV_CONSUME(B7, C7.w[1], selo0, selo1); \
    if (has_next_) PV_ROW_LD(B7, C1.i.w); \
    } while (0)
#undef SBP
}

__device__ __forceinline__ void phase_pv(const Args& a, unsigned char* lds, unsigned* ctl, int xcc) {
    using namespace pv2;
#define SBP() __builtin_amdgcn_sched_barrier(0)
    const int tid = opaque_tid(), wave = __builtin_amdgcn_readfirstlane(tid >> 6), lane = tid & 63;
    volatile LAS unsigned* slot = (volatile LAS unsigned*)((LAS unsigned char*)lds + LDS_MISC) + 2;
    bf16_t* Y = (bf16_t*)(a.ws + WS_Y); const float* WSC = (const float*)(a.ws + WS_W + 12 * MiB);
    const __amdgpu_buffer_rsrc_t RI = __builtin_amdgcn_make_buffer_rsrc((void*)(a.ws + WS_IDX), (short)0, TREAL * 512, 0x00020000);
    const __amdgpu_buffer_rsrc_t RW = __builtin_amdgcn_make_buffer_rsrc((void*)(a.ws + WS_W), (short)0, TREAL * 256, 0x00020000);
    float* ybuf = (float*)lds + wave * 256;
    unsigned char* sidx = lds + 8192 + wave * 4096; unsigned char* swt = lds + 8192 + 32768 + wave * 2048;
    for (int ss = 0; ss < 8; ++ss) {
        const int s = (xcc + ss) & 7;
        const __amdgpu_buffer_rsrc_t V = __builtin_amdgcn_make_buffer_rsrc((void*)(a.ws + WS_V + (size_t)s * (16384 * 256)), (short)0, 16384 * 256, 0x00020000);
        unsigned wdraw = wave_draw(ctl + CW_QPV + 64 * s, lane);
        for (;;) {
            const int item8 = wave_item(wdraw);
            if (item8 >= PX_ITEMS * 8) break;
            wdraw = wave_draw(ctl + CW_QPV + 64 * s, lane);
            int ln = lane; asm volatile("" : "+v"(ln));
            const int g = ln >> 4, n = ln & 15, c16 = n * 16, g128 = g * 128, g64 = g * 64;
            const int r0 = item8 * 8;
            unsigned sele0, sele1, selo0, selo1;
            { const unsigned sh = 8u * (unsigned)(n & 3), keep = ~(255u << sh), se = (unsigned)(n >> 3), so = 2u + se;
              const unsigned ve = (0x0c0c0c0cu & keep) | (se << sh), vo = (0x0c0c0c0cu & keep) | (so << sh);
              const bool d0 = (n & 4) == 0;
              sele0 = d0 ? ve : 0x0c0c0c0cu; sele1 = d0 ? 0x0c0c0c0cu : ve; selo0 = d0 ? vo : 0x0c0c0c0cu; selo1 = d0 ? 0x0c0c0c0cu : vo; }
            Chunk C0, C1, C2, C3, C4, C5, C6, C7; u32x4v B0, B1, B2, B3, B4, B5, B6, B7;
            const float wscv = WSC[r0 + (ln & 7)];
            {
                const u32x4v* gi = (const u32x4v*)(a.ws + WS_IDX + (size_t)r0 * 512) + ln; const u32x4v* gw = (const u32x4v*)(a.ws + WS_W + (size_t)r0 * 256) + ln;
                const u32x4v i0 = gi[0], i1 = gi[64], i2 = gi[128], i3 = gi[192], w0 = gw[0], w1 = gw[64];
                u32x4v* si = (u32x4v*)sidx + ln; u32x4v* sw = (u32x4v*)swt + ln;
                si[0] = i0; si[64] = i1; si[128] = i2; si[192] = i3; sw[0] = w0; sw[64] = w1;
                asm volatile("s_waitcnt lgkmcnt(0)" ::: "memory");
            }
            PV_CHUNK_LD(C0, r0, 0); PV_CHUNK_LD(C1, r0, 1); PV_CHUNK_LD(C2, r0, 2); PV_CHUNK_LD(C3, r0, 3); PV_CHUNK_LD(C4, r0, 4); PV_CHUNK_LD(C5, r0, 5); PV_CHUNK_LD(C6, r0, 6);
            PV_ROW_LD(B0, C0.i.x); PV_ROW_LD(B1, C0.i.y); PV_ROW_LD(B2, C0.i.z); PV_ROW_LD(B3, C0.i.w); PV_ROW_LD(B4, C1.i.x); PV_ROW_LD(B5, C1.i.y); PV_ROW_LD(B6, C1.i.z); PV_ROW_LD(B7, C1.i.w);
#pragma unroll 1
            for (int t = 0; t < 8; ++t) {
                const int row = r0 + t, nrow = row + 1; const bool has_next = t < 7;
                f32x4v acc_lo = {0.f, 0.f, 0.f, 0.f}, acc_hi = {0.f, 0.f, 0.f, 0.f};
                PV_TOKEN_BODY(row, nrow, has_next);
                const float wsc = __uint_as_float(__builtin_amdgcn_readlane(__float_as_uint(wscv), t));
#pragma unroll
                for (int i = 0; i < 4; ++i) {
                    const float lo_ = acc_lo[i] + __uint_as_float(__builtin_amdgcn_update_dpp(0, __float_as_uint(acc_lo[i]), 0x128, 0xf, 0xf, false));
                    const float hi_ = acc_hi[i] + __uint_as_float(__builtin_amdgcn_update_dpp(0, __float_as_uint(acc_hi[i]), 0x128, 0xf, 0xf, false));
                    ybuf[16 * (4 * g + i) + n] = (n < 8 ? lo_ : hi_) * wsc;
                }
                asm volatile("s_waitcnt lgkmcnt(0)" ::: "memory");
                {
                    const float4 yv = ((const float4*)ybuf)[ln];
                    *(uint2*)(Y + (size_t)row * DM + 256 * s + 4 * ln) = make_uint2(pk2(yv.x, yv.y), pk2(yv.z, yv.w));
                }
                asm volatile("s_waitcnt lgkmcnt(0)" ::: "memory");
            }
        }
    }
#undef SBP
}
__device__ __forceinline__ void phase_pn(const Args& a, int bid, int nb) {
    const int tid = opaque_tid(), wave = __builtin_amdgcn_readfirstlane(tid >> 6), lane = tid & 63;
    const bf16_t* Y = (const bf16_t*)(a.ws + WS_Y); const bf16_t* X1 = (const bf16_t*)(a.ws + WS_HN);
    for (int row = bid * NWAVES + wave; row < TREAL; row += nb * NWAVES) {
        f32x4* p = (f32x4*)(a.out + (size_t)row * DM) + lane;
        const uint2* yp = (const uint2*)(Y + (size_t)row * DM) + lane; const uint2* xp = (const uint2*)(X1 + (size_t)row * DM) + lane;
        f32x4 v[8]; float ss = 0.f;
#pragma unroll
        for (int j = 0; j < 8; ++j) { const uint2 yy = yp[64 * j], xx = xp[64 * j];
            v[j][0] = bf_lo(xx.x) + bf_lo(yy.x); v[j][1] = bf_hi(xx.x) + bf_hi(yy.x); v[j][2] = bf_lo(xx.y) + bf_lo(yy.y); v[j][3] = bf_hi(xx.y) + bf_hi(yy.y);
            ss += (v[j][0] * v[j][0] + v[j][1] * v[j][1]) + (v[j][2] * v[j][2] + v[j][3] * v[j][3]); }
        const float r = rsqrtf(wave_sum(ss) * (1.f / DM) + EPS);
        const f32x4* wp = (const f32x4*)a.nfinal + lane;
#pragma unroll
        for (int j = 0; j < 8; ++j) p[64 * j] = v[j] * r * wp[64 * j];
    }
}

__device__ __forceinline__ void phase_mix(const Args& a, unsigned char* lds, unsigned* ctr) {
    const bf16_t* Z = (const bf16_t*)(a.ws + WS_Z); bf16_t* MIX = (bf16_t*)(a.ws + WS_MIX);
    volatile LAS unsigned* slot = (volatile LAS unsigned*)((LAS unsigned char*)lds + LDS_MISC) + 2;
    for (;;) {
        const int item = next_item(ctr, slot);
        if (item >= 64 + 2048) break;
        if (item < 64) mls::mlstm_item(item >> 2, item & 3, a, (char*)lds);
        else { const int k = item - 64, qb = 15 - (k >> 7), bh = k & 127; const float lam = attn_lambda(a); att::attn_unit(bh >> 3, bh & 7, qb, Z, MIX, lam, a.subln, (char*)lds); }
    }
}

__global__ void __launch_bounds__(NTHREADS, 2) mega(Args a) {
    extern __shared__ __attribute__((aligned(16))) unsigned char lds[];
    cg::grid_group grid = cg::this_grid();
    const int bid = blockIdx.x, nb = gridDim.x;
    unsigned char* ws = a.ws;
    bf16_t* WinT = (bf16_t*)(ws + WS_WIN); bf16_t* WoutT = (bf16_t*)(ws + WS_WOUT); bf16_t* WqT = (bf16_t*)(ws + WS_WQ);
    float* rope = (float*)(ws + WS_ROPE); float* SSQ = (float*)(ws + WS_SSQ);
    bf16_t* HN = (bf16_t*)(ws + WS_HN); bf16_t* MIX = (bf16_t*)(ws + WS_MIX); bf16_t* Z = (bf16_t*)(ws + WS_Z);

    volatile LAS unsigned* MISC = (volatile LAS unsigned*)((LAS unsigned char*)lds + LDS_MISC);
    if (threadIdx.x < 16) MISC[threadIdx.x] = 0u;
    __syncthreads();
    unsigned* ctl = (unsigned*)(ws + WS_CTL);
    XcdBarrier bar = xcd_barrier_post(ctl + CW_BAR, MISC);
    phase_prep(a, lds, bid, nb);
    grid.sync();
    { pg8::Gemm g{HN, WinT, MROWS, NZ, DM}; EpiZ E{Z, rope}; pg8::StaticOrder S; S.init(g.M, g.N, nb, bid);
      pg8::gemm_phase<EpiZ, pg8::StaticOrder, true, true>((PG8_LAS unsigned char*)lds, g, S, E); }
    phase_tables(a, lds, ctl);
    xcd_barrier(bar);
    phase_mix(a, lds, ctl + CW_QUEUE);
    xcd_barrier(bar);
    { pg8::Gemm g{MIX, WoutT, TREAL, DM, DM}; EpiX1 E{a.x, HN, SSQ}; pg8::StaticOrder S; S.init(g.M, g.N, nb, bid);
      pg8::gemm_phase<EpiX1, pg8::StaticOrder, true, true>((PG8_LAS unsigned char*)lds, g, S, E); }
    xcd_barrier(bar);
    { pg8::Gemm g{HN, WqT, TREAL, DM, DM}; pg8::EpiBf16<0> E{MIX, DM, nullptr, 0, 0, 1.f}; pg8::StaticOrder S; S.init(g.M, g.N, nb, bid);
      pg8::gemm_phase<pg8::EpiBf16<0>, pg8::StaticOrder, true, true>((PG8_LAS unsigned char*)lds, g, S, E); }
    xcd_barrier(bar);
    phase_route(a, lds, bid, nb);
    xcd_barrier(bar);
    { const int xcc = (int)(xb_xcc_id() & 7u);
      phase_pu(a, lds, ctl, xcc); xcd_barrier(bar);
      phase_pc(a, bid, nb); xcd_barrier(bar);
      phase_pv(a, lds, ctl, xcc); xcd_barrier(bar);
      phase_pn(a, bid, nb); }
}

extern "C" void kernel_launch(void* const* d_in, const int* in_sizes, int n_in, void* d_out, int out_size, void* d_ws, size_t ws_size, hipStream_t stream) {
    if (n_in != 18 || out_size != TREAL * DM || ws_size < WS_END) { fprintf(stderr, "kernel_launch: unexpected shapes n_in %d out %d ws %zu (need %zu)\n", n_in, out_size, ws_size, (size_t)WS_END); return; }
    static int grid_blocks = 0;
    if (!grid_blocks) {
        int dev = 0, cus = 0, per_cu = 0;
        (void)hipGetDevice(&dev);
        (void)hipDeviceGetAttribute(&cus, hipDeviceAttributeMultiprocessorCount, dev);
        (void)hipFuncSetAttribute((const void*)mega, hipFuncAttributeMaxDynamicSharedMemorySize, LDS_BYTES);
        (void)hipOccupancyMaxActiveBlocksPerMultiprocessor(&per_cu, (const void*)mega, NTHREADS, LDS_BYTES);
        if (per_cu < 1) { fprintf(stderr, "kernel_launch: occupancy query says %d blocks/CU\n", per_cu); per_cu = 1; }
        if (per_cu > 1) per_cu = 1;
        grid_blocks = cus * per_cu;
    }
    Args a{};
    a.x = (const float*)d_in[0]; a.meta = (const float*)d_in[1]; a.nmw = (const float*)d_in[2]; a.w_in = (const float*)d_in[3];
    a.lamqk = (const float*)d_in[4]; a.subln = (const float*)d_in[5]; a.convw = (const float*)d_in[6]; a.convb = (const float*)d_in[7];
    a.ib = (const float*)d_in[8]; a.fb = (const float*)d_in[9]; a.mnw = (const float*)d_in[10]; a.w_out = (const float*)d_in[11];
    a.nfw_ffn = (const float*)d_in[12]; a.w_q = (const float*)d_in[13]; a.subkeys = (const float*)d_in[14]; a.pu = (const float*)d_in[15];
    a.pv = (const float*)d_in[16]; a.nfinal = (const float*)d_in[17];
    a.out = (float*)d_out; a.ws = (unsigned char*)d_ws;
    (void)hipMemsetAsync((char*)d_ws + WS_CTL, 0, 65536, stream);
    void* kargs[] = {&a};
    const hipError_t e = hipLaunchCooperativeKernel((const void*)mega, dim3(grid_blocks), dim3(NTHREADS), kargs, LDS_BYTES, stream);
    if (e != hipSuccess) fprintf(stderr, "kernel_launch: cooperative launch failed: %s (grid %d)\n", hipGetErrorString(e), grid_blocks);
}
```

```cpp
#include <hip/hip_runtime.h>
#include <hip/hip_bf16.h>
#include <cstdio>
#include <cstdint>
#include <cmath>
namespace pg8 {
#define PG8_LAS __attribute__((address_space(3)))
typedef unsigned short bf16_t;
typedef short bf16x8 __attribute__((ext_vector_type(8)));
typedef float f32x4 __attribute__((ext_vector_type(4)));
typedef unsigned u32x4 __attribute__((ext_vector_type(4)));
constexpr int BM = 256, BK = 64, HALF = 128, HTB = HALF * BK * 2  , STAGE_BYTES = 8 * HTB, NXCD = 8, WGM = 8;

__host__ __device__ __forceinline__ int lds_byte(int r, int c) { const int st = (r >> 4) * 2 + (c >> 5), rr = r & 15, cc = c & 31, ob = rr * 64 + cc * 2; return st * 1024 + (ob ^ (((ob >> 9) & 1) << 5)); }
__host__ __device__ __forceinline__ void stage_rc(int b, int& R, int& C) { const int st = b / 1024, sb = b % 1024, swz = sb ^ (((sb >> 9) & 1) << 5); R = (st >> 1) * 16 + swz / 64; C = (st & 1) * 32 + (swz % 64) / 2; }
__host__ __device__ __forceinline__ int perm32(int rho) { const int n = rho >> 4, i = rho & 15; return 8 * (i >> 2) + 4 * n + (i & 3); }

struct Unit { int pm, pn; };
struct Gemm { const bf16_t* A; const bf16_t* Bt; int M, N, K; };

struct StaticOrder {
    int nM, nN, nwg, G, c;
    __host__ __device__ void init(int M, int N, int G_, int c_) { nM = M / BM; nN = N / BM; nwg = nM * nN; G = G_; c = c_; }
    __host__ __device__ bool next(int i, Unit& u) const {
        const long L = (long)i * G + c; if (L >= nwg) return false;
        int wgid = (int)L; { const int q = nwg / NXCD, r = nwg % NXCD, xcd = wgid % NXCD, off = wgid / NXCD; wgid = (xcd < r ? xcd * (q + 1) : r * (q + 1) + (xcd - r) * q) + off; }
        const int nig = WGM * nN, gid = wgid / nig, fm = gid * WGM, gsz = (nM - fm) < WGM ? (nM - fm) : WGM;
        u.pm = fm + ((wgid % nig) % gsz); u.pn = (wgid % nig) / gsz; return true;
    }
    __device__ __forceinline__ void a_ready(const Unit&) const {}
    __device__ __forceinline__ void done(const Unit&) const {}
};

__device__ __forceinline__ unsigned cvt_pk_bf16(float lo, float hi) { unsigned r; asm volatile("v_cvt_pk_bf16_f32 %0, %1, %2" : "=v"(r) : "v"(lo), "v"(hi)); return r; }
typedef float f32x2 __attribute__((ext_vector_type(2)));
__device__ __forceinline__ f32x2 gelu_pk(f32x2 v) {
    const f32x2 av = __builtin_elementwise_abs(v), d = av * 0.2316418882f + 1.0f;
    f32x2 t; t.x = __builtin_amdgcn_rcpf(d.x); t.y = __builtin_amdgcn_rcpf(d.y);
    f32x2 q = t * 0.5307027145f + (-0.7265760135f); q = q * t + 0.7107068705f; q = q * t + (-0.142248368f); q = q * t + 0.127414796f; q = q * t;
    const f32x2 s = (v * v) * (-0.72134752044f);
    f32x2 e; e.x = __builtin_amdgcn_exp2f(s.x); e.y = __builtin_amdgcn_exp2f(s.y);
    const f32x2 m = v * (q * e), r = v - m;
    f32x2 o; o.x = v.x < 0.f ? m.x : r.x; o.y = v.y < 0.f ? m.y : r.y; return o;
}

template <int ACT  > struct EpiBf16 {
    static constexpr bool PERM = true, AFTER_DRAIN = false; static_assert(ACT == 0 || ACT == 1, "EpiBf16: ACT is 0 (none) or 1 (gelu_pk)");
    bf16_t* O; int ldc; const float* bias; int split_cols; size_t split_stride; float scale0;
    __device__ __forceinline__ void operator()(const f32x4 (&acc)[2][2][4][2], const Unit& u, int wr, int wc, int fr, int fq) const {
        const int row0 = u.pm * BM + wr * 64 + fr; int colt = u.pn * BM; bf16_t* base = O;
        float sc = 1.f; if (split_cols) { const int t = colt / split_cols; base += (size_t)t * split_stride; colt -= t * split_cols; if (t == 0) sc = scale0; }
        const int col0 = colt + wc * 32 + 8 * fq, bcol0 = u.pn * BM + wc * 32 + 8 * fq;
        f32x4 bv[2][2];
#pragma unroll
        for (int bj = 0; bj < 2; ++bj)
#pragma unroll
            for (int n = 0; n < 2; ++n) bv[bj][n] = bias ? *(const f32x4*)(bias + bcol0 + bj * HALF + 4 * n) : (f32x4){0.f, 0.f, 0.f, 0.f};
#pragma unroll
        for (int ai = 0; ai < 2; ++ai)
#pragma unroll
            for (int m = 0; m < 4; ++m) { bf16_t* rowp = base + (size_t)(row0 + ai * HALF + m * 16) * ldc + col0;
#pragma unroll
                for (int bj = 0; bj < 2; ++bj) { f32x4 v0 = acc[ai][bj][m][0] + bv[bj][0], v1 = acc[ai][bj][m][1] + bv[bj][1];
                    if (ACT == 1) { f32x2 a = gelu_pk((f32x2){v0[0], v0[1]}), b = gelu_pk((f32x2){v0[2], v0[3]}), c = gelu_pk((f32x2){v1[0], v1[1]}), d = gelu_pk((f32x2){v1[2], v1[3]});
                        v0 = (f32x4){a.x, a.y, b.x, b.y}; v1 = (f32x4){c.x, c.y, d.x, d.y}; }
                    v0 = v0 * sc; v1 = v1 * sc; u32x4 w; w.x = cvt_pk_bf16(v0[0], v0[1]); w.y = cvt_pk_bf16(v0[2], v0[3]); w.z = cvt_pk_bf16(v1[0], v1[1]); w.w = cvt_pk_bf16(v1[2], v1[3]);
                    *(u32x4*)(rowp + bj * HALF) = w; } }
    }
};
template <class Epi, class Sched, bool ALIGN_EPI = false, bool SP2 = false>
__device__ __forceinline__ void gemm_phase(PG8_LAS unsigned char* lds, const Gemm g, const Sched& S, const Epi& E) {
    int tid_ = threadIdx.x; asm volatile("" : "+v"(tid_));
    const int tid = tid_, wid = __builtin_amdgcn_readfirstlane(tid >> 6), lane = tid & 63, wr = wid >> 2, wc = wid & 3, fr = lane & 15, fq = lane >> 4;
    const int K = g.K, nt = K / BK;
    unsigned voffA[2], voffB[2];
#pragma unroll
    for (int i = 0; i < 2; ++i) { int R, C; stage_rc(tid * 16 + i * 8192, R, C); const int Rb = Epi::PERM ? ((R & ~31) + perm32(R & 31)) : R;
        voffA[i] = (unsigned)(R * K + C) * 2u; voffB[i] = (unsigned)(Rb * K + C) * 2u; }
    const size_t kstep = (size_t)(BK * 2);
    const size_t hstep = (size_t)HALF * K * 2;
    const size_t tstep = 2 * hstep;
    const unsigned ldsw = (unsigned)wid * 1024u;
    const int aoff = lds_byte(wr * 64 + fr, fq * 8), boff = lds_byte(wc * 32 + fr, fq * 8);
#define PG8_SA(b, h) (((b) * 2 + (h)) * HTB)
#define PG8_SB(b, h) ((4 + (b) * 2 + (h)) * HTB)
#define PG8_STAGE(bufoff, gbase, voff) do { _Pragma("unroll") for (int _i = 0; _i < 2; ++_i) \
        __builtin_amdgcn_global_load_lds((const unsigned*)((const char*)(gbase) + (voff)[_i]), (PG8_LAS unsigned*)(lds + (bufoff) + ldsw + _i * 8192), 16, 0, 0); } while (0)
#define PG8_LDA(dst, b, h) do { _Pragma("unroll") for (int m = 0; m < 4; ++m) _Pragma("unroll") for (int k = 0; k < 2; ++k) dst[m][k] = *(const PG8_LAS bf16x8*)(lds + PG8_SA(b, h) + aoff + m * 2048 + k * 1024); } while (0)
#define PG8_LDB(dst, b, h) do { _Pragma("unroll") for (int n = 0; n < 2; ++n) _Pragma("unroll") for (int k = 0; k < 2; ++k) dst[n][k] = *(const PG8_LAS bf16x8*)(lds + PG8_SB(b, h) + boff + n * 2048 + k * 1024); } while (0)
#define PG8_MMA(ai, bj, At, Bt) do { __builtin_amdgcn_s_setprio(1); _Pragma("unroll") for (int m = 0; m < 4; ++m) _Pragma("unroll") for (int n = 0; n < 2; ++n) _Pragma("unroll") for (int k = 0; k < 2; ++k) \
        acc[ai][bj][m][n] = __builtin_amdgcn_mfma_f32_16x16x32_bf16(Bt[n][k], At[m][k], acc[ai][bj][m][n], 0, 0, 0); __builtin_amdgcn_s_setprio(0); } while (0)
#define PG8_WAIT_V(n) asm volatile("s_waitcnt vmcnt(" #n ")" ::: "memory")
#define PG8_WAIT_L(n) asm volatile("s_waitcnt lgkmcnt(" #n ")" ::: "memory")
#define PG8_BAR __builtin_amdgcn_s_barrier()
#define PG8_SCHED __builtin_amdgcn_sched_barrier(0)
    Unit cur, nxt; int ui = 0;
    if (!S.next(0, cur)) return;
    f32x4 acc[2][2][4][2];
#pragma unroll
    for (int a = 0; a < 2; ++a)
#pragma unroll
        for (int b = 0; b < 2; ++b)
#pragma unroll
            for (int m = 0; m < 4; ++m)
#pragma unroll
                for (int n = 0; n < 2; ++n) acc[a][b][m][n] = (f32x4){0.f, 0.f, 0.f, 0.f};
    bf16x8 At[4][2], B0[2][2], B1[2][2];
    const char* cA = (const char*)g.A + (size_t)cur.pm * tstep; const char* cB = (const char*)g.Bt + (size_t)cur.pn * tstep;
    S.a_ready(cur);
    if constexpr (SP2) {
        PG8_STAGE(PG8_SB(0, 0), cB, voffB); PG8_STAGE(PG8_SB(0, 1), cB + hstep, voffB); PG8_STAGE(PG8_SA(0, 0), cA, voffA); PG8_STAGE(PG8_SA(0, 1), cA + hstep, voffA);
        if (wr == 1) PG8_BAR;
        PG8_WAIT_V(2); PG8_BAR;
        PG8_STAGE(PG8_SB(1, 0), cB + kstep, voffB); PG8_STAGE(PG8_SA(1, 0), cA + kstep, voffA); PG8_STAGE(PG8_SB(1, 1), cB + hstep + kstep, voffB);
        PG8_WAIT_V(6); PG8_BAR;
    } else {
        PG8_STAGE(PG8_SB(0, 0), cB, voffB); PG8_STAGE(PG8_SA(0, 0), cA, voffA); PG8_STAGE(PG8_SB(0, 1), cB + hstep, voffB); PG8_STAGE(PG8_SA(0, 1), cA + hstep, voffA);
        if (wr == 1) PG8_BAR;
        PG8_WAIT_V(4); PG8_BAR;
        PG8_STAGE(PG8_SB(1, 0), cB + kstep, voffB); PG8_STAGE(PG8_SA(1, 0), cA + kstep, voffA); PG8_STAGE(PG8_SB(1, 1), cB + hstep + kstep, voffB);
        PG8_WAIT_V(6); PG8_BAR;
    }
    for (;;) {
        const bool has_next = S.next(ui + 1, nxt);
        const char* nA = has_next ? (const char*)g.A + (size_t)nxt.pm * tstep : cA; const char* nB = has_next ? (const char*)g.Bt + (size_t)nxt.pn * tstep : cB;
        for (int t = 0; t < nt; t += 2) {
            const bool last = (t == nt - 2);
            const char* a1 = cA + (size_t)(t + 1) * kstep;
            const char* a2 = last ? nA : cA + (size_t)(t + 2) * kstep; const char* b2 = last ? nB : cB + (size_t)(t + 2) * kstep;
            const char* a3 = a2 + kstep; const char* b3 = b2 + kstep;
            if (last && has_next) S.a_ready(nxt);
            if constexpr (SP2) {
            PG8_LDB(B0, 0, 0); PG8_LDB(B1, 0, 1); PG8_SCHED; PG8_LDA(At, 0, 0); PG8_STAGE(PG8_SA(1, 1), a1 + hstep, voffA);
            PG8_WAIT_V(8); PG8_WAIT_L(0); PG8_BAR; PG8_MMA(0, 0, At, B0); PG8_MMA(0, 1, At, B1); PG8_BAR; PG8_SCHED;
            PG8_LDA(At, 0, 1); PG8_STAGE(PG8_SB(0, 0), b2, voffB); PG8_STAGE(PG8_SB(0, 1), b2 + hstep, voffB); PG8_STAGE(PG8_SA(0, 0), a2, voffA);
            PG8_WAIT_V(8); PG8_WAIT_L(0); PG8_BAR; PG8_MMA(1, 0, At, B0); PG8_MMA(1, 1, At, B1); PG8_BAR; PG8_SCHED;
            PG8_LDB(B0, 1, 0); PG8_LDB(B1, 1, 1); PG8_SCHED; PG8_LDA(At, 1, 0); PG8_STAGE(PG8_SA(0, 1), a2 + hstep, voffA);
            PG8_WAIT_V(8); PG8_WAIT_L(0); PG8_BAR; PG8_MMA(0, 0, At, B0); PG8_MMA(0, 1, At, B1); PG8_BAR; PG8_SCHED;
            PG8_LDA(At, 1, 1); PG8_STAGE(PG8_SB(1, 0), b3, voffB); PG8_STAGE(PG8_SB(1, 1), b3 + hstep, voffB); PG8_STAGE(PG8_SA(1, 0), a3, voffA);
            PG8_WAIT_V(8); PG8_WAIT_L(0); PG8_BAR; PG8_MMA(1, 0, At, B0); PG8_MMA(1, 1, At, B1); PG8_BAR; PG8_SCHED;
            } else {
            PG8_LDB(B0, 0, 0); PG8_SCHED; PG8_LDA(At, 0, 0); PG8_STAGE(PG8_SA(1, 1), a1 + hstep, voffA);
            PG8_WAIT_L(8); PG8_BAR; PG8_WAIT_L(0); PG8_MMA(0, 0, At, B0); PG8_BAR; PG8_SCHED;
            PG8_LDB(B1, 0, 1); PG8_STAGE(PG8_SB(0, 0), b2, voffB);
            PG8_BAR; PG8_WAIT_L(0); PG8_MMA(0, 1, At, B1); PG8_BAR;
            PG8_LDA(At, 0, 1); PG8_STAGE(PG8_SA(0, 0), a2, voffA);
            PG8_BAR; PG8_WAIT_L(0); PG8_MMA(1, 0, At, B0); PG8_BAR; PG8_SCHED;
            PG8_STAGE(PG8_SB(0, 1), b2 + hstep, voffB);
            PG8_WAIT_V(6); PG8_BAR; PG8_MMA(1, 1, At, B1); PG8_BAR;
            PG8_LDB(B0, 1, 0); PG8_SCHED; PG8_LDA(At, 1, 0); PG8_STAGE(PG8_SA(0, 1), a2 + hstep, voffA);
            PG8_WAIT_L(8); PG8_BAR; PG8_WAIT_L(0); PG8_MMA(0, 0, At, B0); PG8_BAR; PG8_SCHED;
            PG8_LDB(B1, 1, 1); PG8_STAGE(PG8_SB(1, 0), b3, voffB);
            PG8_BAR; PG8_WAIT_L(0); PG8_MMA(0, 1, At, B1); PG8_BAR;
            PG8_LDA(At, 1, 1); PG8_STAGE(PG8_SA(1, 0), a3, voffA);
            PG8_BAR; PG8_WAIT_L(0); PG8_MMA(1, 0, At, B0); PG8_BAR; PG8_SCHED;
            PG8_STAGE(PG8_SB(1, 1), b3 + hstep, voffB);
            PG8_WAIT_V(6); PG8_BAR; PG8_MMA(1, 1, At, B1); PG8_BAR;
            }
        }
        if constexpr (ALIGN_EPI) { if (wr == 0) PG8_BAR; }
        if constexpr (!Epi::AFTER_DRAIN) { E(acc, cur, wr, wc, fr, fq); S.done(cur); }
        if (!has_next) break;
#pragma unroll
        for (int a = 0; a < 2; ++a)
#pragma unroll
            for (int b = 0; b < 2; ++b)
#pragma unroll
                for (int m = 0; m < 4; ++m)
#pragma unroll
                    for (int n = 0; n < 2; ++n) acc[a][b][m][n] = (f32x4){0.f, 0.f, 0.f, 0.f};
        cur = nxt; cA = nA; cB = nB; ++ui;
        if constexpr (ALIGN_EPI) { if (wr == 1) PG8_BAR; }
    }
    PG8_WAIT_V(0);
    if constexpr (!ALIGN_EPI) { if (wr == 0) PG8_BAR; }
    PG8_BAR;
    if constexpr (Epi::AFTER_DRAIN) { E.fused(acc, cur, wr, wc, fr, fq, lds, wid, lane); S.done(cur); }
#undef PG8_SA
#undef PG8_SB
#undef PG8_STAGE
#undef PG8_LDA
#undef PG8_LDB
#undef PG8_MMA
#undef PG8_WAIT_V
#undef PG8_WAIT_L
#undef PG8_BAR
#undef PG8_SCHED
}
}

constexpr int BATCH = 16, SEQ = 2048, DM = 2048, NMETA = 16;
constexpr int TREAL = BATCH * SEQ;
constexpr int MROWS = 33024;
constexpr int META_TILE0 = 32768;
constexpr int META_ROW0 = 32816;
constexpr int NZ = 6144;
constexpr int ZQ = 0, ZK = 1024, ZV = 2048, ZMQ = 3072, ZMK = 3584, ZMV = 4096, ZMO = 5120;
constexpr int INCOLS = 6152;
constexpr float EPS = 1e-6f;
constexpr float QSCALE = 0.125f * 1.4426950408889634f;
constexpr float LAMBDA_INIT = 0.2f;

typedef unsigned short bf16_t;
typedef float f32x4 __attribute__((ext_vector_type(4)));
typedef __bf16 bf16x2_t __attribute__((ext_vector_type(2)));

constexpr size_t MiB = 1u << 20;
constexpr size_t WS_CTL = 0;
constexpr size_t WS_ISC = 655360;
constexpr size_t WS_SKB = 65536;
constexpr size_t WS_WIN = 1 * MiB;
constexpr size_t WS_WOUT = 25 * MiB;
constexpr size_t WS_WQ = 33 * MiB;
constexpr size_t WS_ROPE = 41 * MiB;
constexpr size_t WS_GATES = 42 * MiB;
constexpr size_t WS_SSQ = 44 * MiB;
constexpr size_t WS_IDX = 48 * MiB;
constexpr size_t WS_GATE = 64 * MiB;
constexpr size_t WS_U = 80 * MiB;
constexpr size_t WS_V = 144 * MiB;
constexpr size_t WS_HN = 208 * MiB;
constexpr size_t WS_MIX = 338 * MiB;
constexpr size_t WS_Z = 466 * MiB;
constexpr size_t WS_END = 854 * MiB;

__device__ __forceinline__ float bf_lo(unsigned w) { return __uint_as_float(w << 16); }
__device__ __forceinline__ float bf_hi(unsigned w) { return __uint_as_float(w & 0xffff0000u); }
__device__ __forceinline__ float bf2f(bf16_t v) { return __uint_as_float(((unsigned)v) << 16); }
__device__ __forceinline__ unsigned f2bf(float f) { unsigned r; asm("v_cvt_pk_bf16_f32 %0, %1, 0" : "=v"(r) : "v"(f)); return r; }
__device__ __forceinline__ unsigned pk2(float lo, float hi) { unsigned r; asm("v_cvt_pk_bf16_f32 %0, %1, %2" : "=v"(r) : "v"(lo), "v"(hi)); return r; }
__device__ __forceinline__ float dot2(unsigned a, unsigned b, float acc) { return __builtin_amdgcn_fdot2_f32_bf16(__builtin_bit_cast(bf16x2_t, a), __builtin_bit_cast(bf16x2_t, b), acc, false); }
__device__ __forceinline__ float wave_sum(float v) {
#pragma unroll
    for (int o = 1; o < 64; o <<= 1) v += __shfl_xor(v, o);
    return v;
}
__device__ __forceinline__ float wave_max(float v) {
#pragma unroll
    for (int o = 1; o < 64; o <<= 1) v = fmaxf(v, __shfl_xor(v, o));
    return v;
}
__device__ __forceinline__ int zrow_of(int b, int l) { return l < NMETA ? META_ROW0 + l : b * SEQ + (l - NMETA); }

struct EpiZ {
    static constexpr bool PERM = true, AFTER_DRAIN = false;
    bf16_t* Z; const float* rope;
    __device__ __forceinline__ void operator()(const pg8::f32x4 (&acc)[2][2][4][2], const pg8::Unit& u, int wr, int wc, int fr, int fq) const {
        const int row0 = u.pm * 256 + wr * 64 + fr, col0 = u.pn * 256 + wc * 32 + 8 * fq;
        const bool isq = u.pn < 4, isrope = u.pn < 8;
        const int j0 = 16 * (wc & 1) + 4 * fq;
#pragma unroll
        for (int ai = 0; ai < 2; ++ai)
#pragma unroll
            for (int m = 0; m < 4; ++m) {
                const int row = row0 + ai * 128 + m * 16;
                pg8::f32x4 c0 = {1.f, 0.f, 1.f, 0.f}, c1 = {1.f, 0.f, 1.f, 0.f};
                if (isrope) {
                    const int pos = row < TREAL ? (row & (SEQ - 1)) + NMETA : ((row >= META_ROW0 && row < META_ROW0 + NMETA) ? row - META_ROW0 : 0);
                    const pg8::f32x4* tp = (const pg8::f32x4*)(rope + ((size_t)pos * 32 + j0) * 2);
                    c0 = tp[0]; c1 = tp[1];
                }
                bf16_t* rowp = Z + (size_t)row * NZ + col0;
#pragma unroll
                for (int bj = 0; bj < 2; ++bj) {
                    pg8::f32x4 v0 = acc[ai][bj][m][0], v1 = acc[ai][bj][m][1];
                    if (isrope) {
                        pg8::f32x4 o0, o1;
                        o0[0] = v0[0] * c0[0] - v0[1] * c0[1]; o0[1] = v0[1] * c0[0] + v0[0] * c0[1];
                        o0[2] = v0[2] * c0[2] - v0[3] * c0[3]; o0[3] = v0[3] * c0[2] + v0[2] * c0[3];
                        o1[0] = v1[0] * c1[0] - v1[1] * c1[1]; o1[1] = v1[1] * c1[0] + v1[0] * c1[1];
                        o1[2] = v1[2] * c1[2] - v1[3] * c1[3]; o1[3] = v1[3] * c1[2] + v1[2] * c1[3];
                        v0 = o0; v1 = o1;
                        if (isq) { v0 = v0 * QSCALE; v1 = v1 * QSCALE; }
                    }
                    pg8::u32x4 w; w.x = pg8::cvt_pk_bf16(v0[0], v0[1]); w.y = pg8::cvt_pk_bf16(v0[2], v0[3]); w.z = pg8::cvt_pk_bf16(v1[0], v1[1]); w.w = pg8::cvt_pk_bf16(v1[2], v1[3]);
                    *(pg8::u32x4*)(rowp + bj * 128) = w;
                }
            }
    }
};
struct EpiX1 {
    static constexpr bool PERM = true, AFTER_DRAIN = false;
    const float* x; bf16_t* x1b; float* ssq;
    __device__ __forceinline__ void loadr(pg8::f32x4 (&xb)[2][2], int row0, int col0, int i) const {
#pragma unroll
        for (int bj = 0; bj < 2; ++bj) {
            const size_t off = (size_t)(row0 + (i >> 2) * 128 + (i & 3) * 16) * DM + col0 + bj * 128;
            xb[bj][0] = *(const pg8::f32x4*)(x + off); xb[bj][1] = *(const pg8::f32x4*)(x + off + 4);
        }
    }
    __device__ __forceinline__ void procr(const pg8::f32x4 (&acc)[2][2][4][2], const pg8::f32x4 (&xb)[2][2], int row0, int col0, int i, int pn, int wc, int fq) const {
        const int ai = i >> 2, m = i & 3;
        const int row = row0 + ai * 128 + m * 16; float ss = 0.f;
#pragma unroll
        for (int bj = 0; bj < 2; ++bj) {
            const size_t off = (size_t)row * DM + col0 + bj * 128;
            const pg8::f32x4 v0 = acc[ai][bj][m][0] + xb[bj][0], v1 = acc[ai][bj][m][1] + xb[bj][1];
            ss += (v0[0] * v0[0] + v0[1] * v0[1]) + (v0[2] * v0[2] + v0[3] * v0[3]) + (v1[0] * v1[0] + v1[1] * v1[1]) + (v1[2] * v1[2] + v1[3] * v1[3]);
            pg8::u32x4 w; w.x = pg8::cvt_pk_bf16(v0[0], v0[1]); w.y = pg8::cvt_pk_bf16(v0[2], v0[3]); w.z = pg8::cvt_pk_bf16(v1[0], v1[1]); w.w = pg8::cvt_pk_bf16(v1[2], v1[3]);
            *(pg8::u32x4*)(x1b + off) = w;
        }
        ss += __shfl_xor(ss, 16); ss += __shfl_xor(ss, 32);
        if (fq == 0) ssq[(size_t)row * 32 + pn * 4 + wc] = ss;
    }
    __device__ __forceinline__ void operator()(const pg8::f32x4 (&acc)[2][2][4][2], const pg8::Unit& u, int wr, int wc, int fr, int fq) const {
        const int row0 = u.pm * 256 + wr * 64 + fr, col0 = u.pn * 256 + wc * 32 + 8 * fq;
        pg8::f32x4 b0[2][2], b1[2][2], b2[2][2];
        loadr(b0, row0, col0, 0); loadr(b1, row0, col0, 1); loadr(b2, row0, col0, 2);
        procr(acc, b0, row0, col0, 0, u.pn, wc, fq); loadr(b0, row0, col0, 3);
        procr(acc, b1, row0, col0, 1, u.pn, wc, fq); loadr(b1, row0, col0, 4);
        procr(acc, b2, row0, col0, 2, u.pn, wc, fq); loadr(b2, row0, col0, 5);
        procr(acc, b0, row0, col0, 3, u.pn, wc, fq); loadr(b0, row0, col0, 6);
        procr(acc, b1, row0, col0, 4, u.pn, wc, fq); loadr(b1, row0, col0, 7);
        procr(acc, b2, row0, col0, 5, u.pn, wc, fq);
        procr(acc, b0, row0, col0, 6, u.pn, wc, fq);
        procr(acc, b1, row0, col0, 7, u.pn, wc, fq);
    }
};


#include <hip/hip_cooperative_groups.h>
namespace cg = cooperative_groups;

constexpr int NWAVES = 8, NTHREADS = 512;
constexpr size_t WS_X1Q = WS_Z + 300 * MiB, WS_XSC = WS_Z + 370 * MiB;
__device__ __forceinline__ int opaque_tid() { int t = threadIdx.x; asm volatile("" : "+v"(t)); return t; }
constexpr int LDS_BYTES = 163840;

struct Args {
    const float *x, *meta, *nmw, *w_in, *lamqk, *subln, *convw, *convb, *ib, *fb, *mnw, *w_out, *nfw_ffn, *w_q, *subkeys, *pu, *pv, *nfinal;
    float* out; unsigned char* ws;
};

#define LAS __attribute__((address_space(3)))
#define XB_TMO      128
#define XB_XCNT(j)  (256  + 64 * (j))
#define XB_XSUB(j)  (1280 + 64 * (j))
#define XB_XGEN(j)  (2304 + 64 * (j))
#define XB_TOP      3328
#define XB_TOPGEN   3392
#define XCD_BAR_WORDS 3456
#define XB_SPIN_CAP (1u << 18)

__device__ __forceinline__ unsigned xb_ld(unsigned* p)              { return __hip_atomic_load(p, __ATOMIC_RELAXED, __HIP_MEMORY_SCOPE_AGENT); }
__device__ __forceinline__ unsigned xb_add(unsigned* p, unsigned v) { return __hip_atomic_fetch_add(p, v, __ATOMIC_RELAXED, __HIP_MEMORY_SCOPE_AGENT); }
__device__ __forceinline__ unsigned xb_xcc_id() { return (unsigned)__builtin_amdgcn_s_getreg((3 << 11) | 20) & 0xFu; }
#define XB_SPIN(cond, bar) do { unsigned _sp = 0; while (cond) { __builtin_amdgcn_s_sleep(1); \
    if ((++_sp & 255u) == 0u) { if (xb_ld(&(bar)[XB_TMO])) break; if (_sp > XB_SPIN_CAP) { atomicAdd(&(bar)[XB_TMO], 1u); break; } } } } while (0)

struct XcdBarrier {
    unsigned* bar; unsigned x;
    volatile LAS unsigned* st;
};

__device__ __forceinline__ XcdBarrier xcd_barrier_post(unsigned* bar, volatile LAS unsigned* st) {
    XcdBarrier b; b.bar = bar; b.x = xb_xcc_id(); b.st = st;
    if (threadIdx.x == 0) (void)xb_add(&bar[XB_XCNT(b.x)], 1u);
    return b;
}
__device__ __forceinline__ void xcd_barrier_complete(unsigned* bar, unsigned x, unsigned& nloc, unsigned& nx) {
    const unsigned G = gridDim.x * gridDim.y * gridDim.z;
    unsigned sum, cnt, mine, sp = 0u;
    for (;;) {
        sum = 0u; cnt = 0u; mine = 0u;
#pragma unroll
        for (unsigned j = 0; j < 16; ++j) { const unsigned c = xb_ld(&bar[XB_XCNT(j)]); sum += c; cnt += (c > 0u) ? 1u : 0u; mine = (j == x) ? c : mine; }
        if (sum == G) break;
        __builtin_amdgcn_s_sleep(1);
        if ((++sp & 255u) == 0u) { if (xb_ld(&bar[XB_TMO])) break; if (sp > XB_SPIN_CAP) { atomicAdd(&bar[XB_TMO], 1u); break; } }
    }
    nloc = mine > 0u ? mine : 1u; nx = cnt > 0u ? cnt : 1u;
}

__device__ __forceinline__ void xcd_barrier(const XcdBarrier& b) {
    asm volatile("s_waitcnt vmcnt(0)" ::: "memory");
    __syncthreads();
    if (threadIdx.x == 0) {
        unsigned* bar = b.bar;
        __builtin_amdgcn_s_waitcnt(0);
        unsigned nloc = b.st[0], nx = b.st[1];
        if (nloc == 0u) { xcd_barrier_complete(bar, b.x, nloc, nx); b.st[0] = nloc; b.st[1] = nx; }
        const unsigned old = xb_add(&bar[XB_XSUB(b.x)], 1u);
        const unsigned gen = old / nloc;
        if (old + 1u == (gen + 1u) * nloc) {
            __builtin_amdgcn_fence(__ATOMIC_RELEASE, "agent");
            asm volatile("s_waitcnt vmcnt(0)" ::: "memory");
            const unsigned og = xb_add(&bar[XB_TOP], 1u);
            const unsigned tg = og / nx;
            if (og + 1u == (tg + 1u) * nx) xb_add(&bar[XB_TOPGEN], 1u);
            else XB_SPIN(xb_ld(&bar[XB_TOPGEN]) == tg, bar);
            __builtin_amdgcn_fence(__ATOMIC_ACQUIRE, "agent");
            xb_add(&bar[XB_XGEN(b.x)], 1u);
            asm volatile("s_waitcnt vmcnt(0)" ::: "memory");
        } else {
            XB_SPIN(xb_ld(&bar[XB_XGEN(b.x)]) == gen, bar);
            __builtin_amdgcn_fence(__ATOMIC_ACQUIRE, "agent");
            asm volatile("s_waitcnt vmcnt(0)" ::: "memory");
        }
    }
    __syncthreads();
}

constexpr int CW_BAR = 0, CW_QUEUE = 4096;
constexpr int LDS_MISC = LDS_BYTES - 256;
__device__ __forceinline__ unsigned wave_draw(unsigned* ctr, int lane) {
    unsigned v = 0u;
    if (lane == 0) v = __hip_atomic_fetch_add(ctr, 1u, __ATOMIC_RELAXED, __HIP_MEMORY_SCOPE_AGENT);
    return v;
}
__device__ __forceinline__ int wave_item(unsigned v) { return (int)__builtin_amdgcn_readfirstlane(v); }
__device__ __forceinline__ int next_item(unsigned* ctr, volatile LAS unsigned* slot) {
    __syncthreads();
    if (threadIdx.x == 0) *slot = __hip_atomic_fetch_add(ctr, 1u, __ATOMIC_RELAXED, __HIP_MEMORY_SCOPE_AGENT);
    __syncthreads();
    return (int)*slot;
}

__device__ __forceinline__ void transpose_item(const float* W, int ldw, int K, int N, bf16_t* WT, bool ropeperm, float* scr, int item, int lane, const float* kscale = nullptr) {
    const int nblk = N / 32, kb = item / nblk, nb = item % nblk, k0 = 64 * kb, n0 = 32 * nb;
#pragma unroll 8
    for (int i = 0; i < 32; ++i) { const int kk = 2 * i + (lane >> 5); scr[kk * 33 + (lane & 31)] = W[(size_t)(k0 + kk) * ldw + n0 + (lane & 31)] * (kscale ? kscale[k0 + kk] : 1.f); }
    __builtin_amdgcn_s_waitcnt(0xC07F); asm volatile("" ::: "memory");
    const int c = lane & 7;
#pragma unroll
    for (int j = 0; j < 4; ++j) {
        const int n = (lane >> 3) + 8 * j; const float* s = scr + (8 * c) * 33 + n;
        uint4 o; o.x = pk2(s[0 * 33], s[1 * 33]); o.y = pk2(s[2 * 33], s[3 * 33]); o.z = pk2(s[4 * 33], s[5 * 33]); o.w = pk2(s[6 * 33], s[7 * 33]);
        int orow = n0 + n;
        if (ropeperm && n0 < 2048) orow = (n0 & ~63) + 2 * n + ((n0 >> 5) & 1);
        *(uint4*)(WT + (size_t)orow * K + k0 + 8 * c) = o;
    }
    __builtin_amdgcn_s_waitcnt(0xC07F); asm volatile("" ::: "memory");
}

__device__ __forceinline__ void hn_row(const Args& a, bf16_t* HN, float* G, const float* WG, int r, const f32x4 (&v)[8], int lane) {
    float ss = 0.f;
#pragma unroll
    for (int j = 0; j < 8; ++j) ss += (v[j][0] * v[j][0] + v[j][1] * v[j][1]) + (v[j][2] * v[j][2] + v[j][3] * v[j][3]);
    const float rstd = rsqrtf(wave_sum(ss) * (1.f / DM) + EPS);
    float g[8];
#pragma unroll
    for (int k = 0; k < 8; ++k) g[k] = 0.f;
    unsigned long long* o8 = (unsigned long long*)(HN + (size_t)r * DM) + lane;
#pragma unroll
    for (int j = 0; j < 8; ++j) {
        const f32x4 w = ((const f32x4*)a.nmw)[64 * j + lane];
        const f32x4 y = v[j] * rstd * w;
        o8[64 * j] = (unsigned long long)pk2(y[0], y[1]) | ((unsigned long long)pk2(y[2], y[3]) << 32);
#pragma unroll
        for (int k = 0; k < 8; ++k) { const f32x4 wg = ((const f32x4*)(WG + k * 2048))[64 * j + lane]; g[k] += (y[0] * wg[0] + y[1] * wg[1]) + (y[2] * wg[2] + y[3] * wg[3]); }
        __builtin_amdgcn_sched_barrier(0);
    }
    float r4[4], r2[2], r1;
    { const bool hb = (lane & 32) != 0;
#pragma unroll
      for (int i = 0; i < 4; ++i) { const float send = hb ? g[i] : g[i + 4]; const float recv = __shfl_xor(send, 32); r4[i] = (hb ? g[i + 4] : g[i]) + recv; } }
    { const bool hb = (lane & 16) != 0;
#pragma unroll
      for (int i = 0; i < 2; ++i) { const float send = hb ? r4[i] : r4[i + 2]; const float recv = __shfl_xor(send, 16); r2[i] = (hb ? r4[i + 2] : r4[i]) + recv; } }
    { const bool hb = (lane & 8) != 0; const float send = hb ? r2[0] : r2[1]; const float recv = __shfl_xor(send, 8); r1 = (hb ? r2[1] : r2[0]) + recv; }
    r1 += __shfl_xor(r1, 4); r1 += __shfl_xor(r1, 2); r1 += __shfl_xor(r1, 1);
    if ((lane & 7) == 0) G[(size_t)r * 8 + ((lane >> 5) & 1) * 4 + ((lane >> 4) & 1) * 2 + ((lane >> 3) & 1)] = r1;
}

__device__ __forceinline__ void phase_prep(const Args& a, unsigned char* lds, int bid, int nb) {
    const int tid = opaque_tid(), lane = tid & 63, wave = tid >> 6;
    const int gw = bid * NWAVES + wave, NGW = nb * NWAVES;
    unsigned char* ws = a.ws;
    bf16_t* WinT = (bf16_t*)(ws + WS_WIN); bf16_t* WoutT = (bf16_t*)(ws + WS_WOUT); bf16_t* WqT = (bf16_t*)(ws + WS_WQ);
    bf16_t* U = (bf16_t*)(ws + WS_U); bf16_t* V = (bf16_t*)(ws + WS_V); bf16_t* HN = (bf16_t*)(ws + WS_HN);
    float* G = (float*)(ws + WS_GATES); float* rope = (float*)(ws + WS_ROPE);
    float* scr = (float*)lds + wave * (64 * 33);
    float* WG = (float*)(lds + 8 * 64 * 33 * 4);
    for (int i = tid; i < 8 * 2048; i += NTHREADS) { const int k = i >> 3, g = i & 7; WG[g * 2048 + k] = a.w_in[(size_t)k * INCOLS + 6144 + g]; }
    __syncthreads();
    constexpr int I_IN = 32 * 192, I_OUT = 32 * 64, I_Q = 32 * 64;
    for (int it = gw; it < I_IN + I_OUT + I_Q; it += NGW) {
        int r = it;
        if (r < I_IN) { transpose_item(a.w_in, INCOLS, 2048, 6144, WinT, true, scr, r, lane); continue; } r -= I_IN;
        if (r < I_OUT) { transpose_item(a.w_out, 2048, 2048, 2048, WoutT, false, scr, r, lane); continue; } r -= I_OUT;
        transpose_item(a.w_q, 2048, 2048, 2048, WqT, false, scr, r, lane, a.nfw_ffn);
    }
    {
        f32x4 vc[8], vn[8];
#pragma unroll
        for (int j = 0; j < 8; ++j) vc[j] = ((const f32x4*)(a.x + (size_t)gw * DM))[64 * j + lane];
        for (int r = gw; r < TREAL; r += NGW) {
            const int rn = r + NGW < TREAL ? r + NGW : r;
#pragma unroll
            for (int j = 0; j < 8; ++j) vn[j] = ((const f32x4*)(a.x + (size_t)rn * DM))[64 * j + lane];
            hn_row(a, HN, G, WG, r, vc, lane);
#pragma unroll
            for (int j = 0; j < 8; ++j) vc[j] = vn[j];
        }
    }
    for (int r = TREAL + gw; r < MROWS; r += NGW) {
        if (r >= META_ROW0 && r < META_ROW0 + NMETA) {
            f32x4 vm[8];
#pragma unroll
            for (int j = 0; j < 8; ++j) vm[j] = ((const f32x4*)(a.meta + (size_t)(r - META_ROW0) * DM))[64 * j + lane];
            hn_row(a, HN, G, WG, r, vm, lane);
        } else {
            unsigned long long* o8 = (unsigned long long*)(HN + (size_t)r * DM) + lane;
#pragma unroll
            for (int j = 0; j < 8; ++j) o8[64 * j] = 0ull;
            if (lane < 8) G[(size_t)r * 8 + lane] = 0.f;
        }
    }
    { bf16_t* SKB = (bf16_t*)(ws + WS_SKB);
      for (int i = bid * NTHREADS + tid; i < 8 * 2 * 128 * 128 / 2; i += nb * NTHREADS) { const float2 v = ((const float2*)a.subkeys)[i]; ((unsigned*)SKB)[i] = pk2(v.x, v.y); } }
    for (int i = bid * NTHREADS + tid; i < (SEQ + NMETA) * 32; i += nb * NTHREADS) {
        const int pos = i >> 5, j = i & 31;
        const float inv = (float)pow(10000.0, -(double)j / 32.0);
        const float ang = (float)pos * inv;
        rope[2 * i] = (float)cos((double)ang); rope[2 * i + 1] = (float)sin((double)ang);
    }
}


constexpr int CW_QTAB = 4096 + 1024, TAB_ITEMS = 2 * 16384 / 16;
__device__ __forceinline__ void phase_tables(const Args& a, unsigned char* lds, unsigned* ctl) {
    const int tid = opaque_tid(), lane = tid & 63, wave = __builtin_amdgcn_readfirstlane(tid >> 6);
    unsigned char* ws = a.ws;
    volatile LAS unsigned* slot = (volatile LAS unsigned*)((LAS unsigned char*)lds + LDS_MISC) + 2;
    for (;;) {
        const int item = next_item(ctl + CW_QTAB, slot);
        if (item >= TAB_ITEMS) break;
        const int rr = item * 16 + wave;
    {
        unsigned* U8 = (unsigned*)(ws + WS_U); unsigned* V8 = (unsigned*)(ws + WS_V); float* ISC = (float*)(ws + WS_ISC);
        {
            f32x4 v[2][8]; float am[2];
#pragma unroll
            for (int q = 0; q < 2; ++q) {
                const int r = rr + q * 8; const bool isu = r < 16384; const int e = r & 16383;
                const f32x4* xr = (const f32x4*)((isu ? a.pu : a.pv) + (size_t)e * DM) + lane;
#pragma unroll
                for (int j = 0; j < 8; ++j) v[q][j] = xr[64 * j];
            }
#pragma unroll
            for (int q = 0; q < 2; ++q) if (rr + q * 8 < 16384) {
#pragma unroll
                for (int j = 0; j < 8; ++j) v[q][j] = v[q][j] * ((const f32x4*)a.nfw_ffn)[64 * j + lane]; }
#pragma unroll
            for (int q = 0; q < 2; ++q) { float t = 0.f;
#pragma unroll
                for (int j = 0; j < 8; ++j) t = fmaxf(t, fmaxf(fmaxf(fabsf(v[q][j][0]), fabsf(v[q][j][1])), fmaxf(fabsf(v[q][j][2]), fabsf(v[q][j][3]))));
                am[q] = t; }
#pragma unroll
            for (int o = 1; o < 64; o <<= 1) { am[0] = fmaxf(am[0], __shfl_xor(am[0], o)); am[1] = fmaxf(am[1], __shfl_xor(am[1], o)); }
#pragma unroll
            for (int q = 0; q < 2; ++q) {
                const int r = rr + q * 8; const bool isu = r < 16384; const int e = r & 16383;
                const float top = isu ? 127.f : 256.f;
                const float sc = am[q] > 0.f ? top / am[q] : 0.f;
                unsigned* o8 = isu ? U8 : V8;
#pragma unroll
                for (int j = 0; j < 8; ++j) { int w;
                    if (isu) { const int q0 = (int)rintf(v[q][j][0] * sc), q1 = (int)rintf(v[q][j][1] * sc), q2 = (int)rintf(v[q][j][2] * sc), q3 = (int)rintf(v[q][j][3] * sc);
                        w = (int)((unsigned)(q0 & 255) | ((unsigned)(q1 & 255) << 8) | ((unsigned)(q2 & 255) << 16) | ((unsigned)q3 << 24)); }
                    else { w = __builtin_amdgcn_cvt_pk_fp8_f32(v[q][j][0] * sc, v[q][j][1] * sc, 0, false); w = __builtin_amdgcn_cvt_pk_fp8_f32(v[q][j][2] * sc, v[q][j][3] * sc, w, true); }
                    o8[((size_t)j * 16384 + e) * 64 + lane] = (unsigned)w; }
                if (lane == 0) ISC[2 * e + (isu ? 0 : 1)] = am[q] / top;
            }
        }
    }
    }
}

namespace att {
using bf16x8 = __attribute__((ext_vector_type(8))) short;
using s16x4 = __attribute__((ext_vector_type(4))) short;
using f32x16 = __attribute__((ext_vector_type(16))) float;
using u32x4 = __attribute__((ext_vector_type(4))) unsigned;
constexpr int SHM_V = 16384, SHM_K = 16384;
constexpr int L_V = 0, L_K = 2 * SHM_V, L_WS = L_K + 2 * SHM_K, L_P = L_WS + 8 * 64 * 4, L_END = L_P + 4 * 4096;
#define KSWZ(row, colB) ((row) * 256 + ((colB) ^ (((row) & 7) << 4)))
#define SBAR() __builtin_amdgcn_sched_barrier(0)
__device__ __forceinline__ int crow(int r, int hi) { return (r & 3) + 8 * (r >> 2) + 4 * hi; }
__device__ __forceinline__ unsigned cvtpk(float lo, float hi) { unsigned r; asm volatile("v_cvt_pk_bf16_f32 %0, %1, %2" : "=v"(r) : "v"(lo), "v"(hi)); return r; }
__device__ __forceinline__ int v_st(int k, int c) { const int kk = (k & ~0xC) | ((k & 4) << 1) | ((k & 8) >> 1); return ((kk >> 3) * 4 + (c >> 5)) * 512 + ((kk & 7) * 32 + (c & 31)) * 2; }
__device__ __forceinline__ int v_rd_base(int lane) { return ((lane & 3) << 3) | (((lane >> 2) & 3) << 6) | (((lane >> 4) & 1) << 5) | (((lane >> 5) & 1) << 8); }
constexpr int v_rd_off(int d0, int ks, int half) { return d0 * 512 + ks * 4096 + half * 2048; }
template <int OFF> __device__ __forceinline__ s16x4 tr_read(int vb) { s16x4 r; asm volatile("ds_read_b64_tr_b16 %0, %1 offset:%2" : "=&v"(r) : "v"(vb), "i"(OFF) : "memory"); return r; }
template <int D0> __device__ __forceinline__ void pv_one(f32x16& od, int vb, bf16x8 pa0, bf16x8 pa1, bf16x8 pa2, bf16x8 pa3) {
    const s16x4 l0 = tr_read<v_rd_off(D0, 0, 0)>(vb), h0 = tr_read<v_rd_off(D0, 0, 1)>(vb), l1 = tr_read<v_rd_off(D0, 1, 0)>(vb), h1 = tr_read<v_rd_off(D0, 1, 1)>(vb);
    const s16x4 l2 = tr_read<v_rd_off(D0, 2, 0)>(vb), h2 = tr_read<v_rd_off(D0, 2, 1)>(vb), l3 = tr_read<v_rd_off(D0, 3, 0)>(vb), h3 = tr_read<v_rd_off(D0, 3, 1)>(vb);
    asm volatile("s_waitcnt lgkmcnt(0)" ::: "memory"); SBAR();
#define PK(L, H) (bf16x8){L[0], L[1], L[2], L[3], H[0], H[1], H[2], H[3]}
    od = __builtin_amdgcn_mfma_f32_32x32x16_bf16(pa0, PK(l0, h0), od, 0, 0, 0);
    od = __builtin_amdgcn_mfma_f32_32x32x16_bf16(pa1, PK(l1, h1), od, 0, 0, 0);
    od = __builtin_amdgcn_mfma_f32_32x32x16_bf16(pa2, PK(l2, h2), od, 0, 0, 0);
    od = __builtin_amdgcn_mfma_f32_32x32x16_bf16(pa3, PK(l3, h3), od, 0, 0, 0);
#undef PK
}
__device__ __forceinline__ void qkt(f32x16& p0, f32x16& p1, const char* Ks, const bf16x8* qr, int r32, int hi, int comp) {
    p0 = f32x16{}; p1 = f32x16{};
#pragma unroll
    for (int d0 = 0; d0 < 4; ++d0) {
        const int cb = (comp * 64 + d0 * 16 + hi * 8) * 2;
        const bf16x8 b0 = *reinterpret_cast<const bf16x8*>(Ks + KSWZ(r32, cb));
        const bf16x8 b1 = *reinterpret_cast<const bf16x8*>(Ks + KSWZ(32 + r32, cb));
        p0 = __builtin_amdgcn_mfma_f32_32x32x16_bf16(b0, qr[d0], p0, 0, 0, 0);
        p1 = __builtin_amdgcn_mfma_f32_32x32x16_bf16(b1, qr[d0], p1, 0, 0, 0);
    }
}

__device__ __forceinline__ void attn_unit(int b, int h, int qb, const bf16_t* Z, bf16_t* MIX, float lam, const float* subln, char* lds) {
    const int tid = opaque_tid(), wid = __builtin_amdgcn_readfirstlane(tid >> 6), lane = tid & 63, r32 = lane & 31, hi = lane >> 5;
    const int comp = wid >> 2, rg = wid & 3;
    char* V_lds = lds + L_V; char* K_lds = lds + L_K;
    float* wsf = (float*)(lds + L_WS) + wid * 64;
    const int q0 = b * SEQ + qb * 128;
    const float NEGV = -1e30f;
    bf16x8 qr[4];
    {
        const bf16_t* Qw = Z + (size_t)(q0 + rg * 32 + r32) * NZ + ZQ + h * 128 + comp * 64 + hi * 8;
#pragma unroll
        for (int d0 = 0; d0 < 4; ++d0) qr[d0] = *reinterpret_cast<const bf16x8*>(Qw + d0 * 16);
    }
    const int NT = 2 * qb + 3;
    const int sr = tid >> 4, sc = (tid & 15) * 8;
    const int vst0 = v_st(sr, sc), vst1 = v_st(32 + sr, sc), kst0 = KSWZ(sr, sc * 2), kst1 = KSWZ(32 + sr, sc * 2);
    const int vb0 = (int)(uintptr_t)V_lds + v_rd_base(lane);
#define PK4(P, BASE, OUT) do { unsigned a0 = cvtpk(P[BASE + 0], P[BASE + 1]), a1 = cvtpk(P[BASE + 2], P[BASE + 3]); \
        unsigned b0 = cvtpk(P[BASE + 4], P[BASE + 5]), b1 = cvtpk(P[BASE + 6], P[BASE + 7]); \
        auto r0 = __builtin_amdgcn_permlane32_swap(a0, b0, false, false); auto r1 = __builtin_amdgcn_permlane32_swap(a1, b1, false, false); \
        u32x4 w = {r0[0], r1[0], r0[1], r1[1]}; OUT = *reinterpret_cast<bf16x8*>(&w); } while (0)
    bf16x8 vsA0, vsA1, ksA0, ksA1, vsB0, vsB1, ksB0, ksB1;
#define SLOAD(j, S) do { const size_t r0_ = (size_t)((j) == 0 ? META_TILE0 : b * SEQ + ((j) - 1) * 64) + sr; const bf16_t* zp_ = Z + r0_ * NZ + h * 128 + sc; \
        vs##S##0 = *reinterpret_cast<const bf16x8*>(zp_ + ZV); vs##S##1 = *reinterpret_cast<const bf16x8*>(zp_ + ZV + (size_t)32 * NZ); \
        ks##S##0 = *reinterpret_cast<const bf16x8*>(zp_ + ZK); ks##S##1 = *reinterpret_cast<const bf16x8*>(zp_ + ZK + (size_t)32 * NZ); } while (0)
#define SWRITE(bi, S) do { *reinterpret_cast<bf16x8*>(V_lds + (bi) * SHM_V + vst0) = vs##S##0; *reinterpret_cast<bf16x8*>(V_lds + (bi) * SHM_V + vst1) = vs##S##1; \
        *reinterpret_cast<bf16x8*>(K_lds + (bi) * SHM_K + kst0) = ks##S##0; *reinterpret_cast<bf16x8*>(K_lds + (bi) * SHM_K + kst1) = ks##S##1; } while (0)
    f32x16 o[4] = {}; float m_reg = NEGV, l_reg = 0.f;
    SLOAD(0, A); SWRITE(0, A); SLOAD(1, B); __syncthreads();
    const int qrel = rg * 32 + r32;
#define ATT_TILE(j, L_, W_) do { \
        const int cur = j & 1; \
        if (j + 2 < NT) SLOAD(j + 2, L_); \
        f32x16 p0, p1; \
        qkt(p0, p1, K_lds + cur * SHM_K, qr, r32, hi, comp); \
        if (j == 0) { \
    _Pragma("unroll") \
            for (int r = 0; r < 16; ++r) { p0[r] = NEGV; if (r < 8) p1[r] = NEGV; } \
        } else if (j >= NT - 2) { \
            const int kb0 = (j - (NT - 2)) * 64; \
    _Pragma("unroll") \
            for (int r = 0; r < 16; ++r) { const int kl = kb0 + crow(r, hi); if (kl > qrel) p0[r] = NEGV; if (kl + 32 > qrel) p1[r] = NEGV; } \
        } \
        float pmax = p0[0]; \
    _Pragma("unroll") \
        for (int r = 1; r < 16; ++r) pmax = fmaxf(pmax, p0[r]); \
    _Pragma("unroll") \
        for (int r = 0; r < 16; ++r) pmax = fmaxf(pmax, p1[r]); \
        { auto rr = __builtin_amdgcn_permlane32_swap(__float_as_uint(pmax), __float_as_uint(pmax), false, false); pmax = fmaxf(__uint_as_float(rr[0]), __uint_as_float(rr[1])); } \
        const float mn = fmaxf(m_reg, pmax); const float alpha = __builtin_amdgcn_exp2f(m_reg - mn); m_reg = mn; \
        float ps = 0.f; \
    _Pragma("unroll") \
        for (int r = 0; r < 16; ++r) { p0[r] = __builtin_amdgcn_exp2f(p0[r] - mn); ps += p0[r]; } \
    _Pragma("unroll") \
        for (int r = 0; r < 16; ++r) { p1[r] = __builtin_amdgcn_exp2f(p1[r] - mn); ps += p1[r]; } \
        { auto rr = __builtin_amdgcn_permlane32_swap(__float_as_uint(ps), __float_as_uint(ps), false, false); ps = __uint_as_float(rr[0]) + __uint_as_float(rr[1]); } \
        l_reg = l_reg * alpha + ps; \
        if (__any(alpha < 1.f)) { \
            if (hi == 0) wsf[r32] = alpha; \
            asm volatile("s_waitcnt lgkmcnt(0)" ::: "memory"); \
            float al[16]; \
    _Pragma("unroll") \
            for (int r = 0; r < 16; ++r) al[r] = wsf[crow(r, hi)]; \
    _Pragma("unroll") \
            for (int d = 0; d < 4; ++d) \
    _Pragma("unroll") \
                for (int r = 0; r < 16; ++r) o[d][r] *= al[r]; \
            asm volatile("s_waitcnt lgkmcnt(0)" ::: "memory"); \
        } \
        bf16x8 pa0, pa1, pa2, pa3; \
        PK4(p0, 0, pa0); PK4(p0, 8, pa1); PK4(p1, 0, pa2); PK4(p1, 8, pa3); \
        SBAR(); \
        { const int vb = vb0 + cur * SHM_V; \
          pv_one<0>(o[0], vb, pa0, pa1, pa2, pa3); pv_one<1>(o[1], vb, pa0, pa1, pa2, pa3); pv_one<2>(o[2], vb, pa0, pa1, pa2, pa3); pv_one<3>(o[3], vb, pa0, pa1, pa2, pa3); } \
        if (j + 1 < NT) SWRITE(cur ^ 1, W_); \
        __syncthreads(); \
    } while (0)
    {
        SLOAD(2, A);
        f32x16 p1 = f32x16{};
#pragma unroll
        for (int d0 = 0; d0 < 4; ++d0) {
            const int cb = (comp * 64 + d0 * 16 + hi * 8) * 2;
            const bf16x8 b1 = *reinterpret_cast<const bf16x8*>(K_lds + KSWZ(32 + r32, cb));
            p1 = __builtin_amdgcn_mfma_f32_32x32x16_bf16(b1, qr[d0], p1, 0, 0, 0);
        }
        float pmax = p1[8];
#pragma unroll
        for (int r = 9; r < 16; ++r) pmax = fmaxf(pmax, p1[r]);
        { auto rr = __builtin_amdgcn_permlane32_swap(__float_as_uint(pmax), __float_as_uint(pmax), false, false); pmax = fmaxf(__uint_as_float(rr[0]), __uint_as_float(rr[1])); }
        m_reg = pmax;
        float ps = 0.f;
#pragma unroll
        for (int r = 0; r < 8; ++r) p1[r] = 0.f;
#pragma unroll
        for (int r = 8; r < 16; ++r) { p1[r] = __builtin_amdgcn_exp2f(p1[r] - pmax); ps += p1[r]; }
        { auto rr = __builtin_amdgcn_permlane32_swap(__float_as_uint(ps), __float_as_uint(ps), false, false); ps = __uint_as_float(rr[0]) + __uint_as_float(rr[1]); }
        l_reg = ps;
        bf16x8 pa3; PK4(p1, 8, pa3);
        SBAR();
        {
#define PKF(L, H) (bf16x8){L[0], L[1], L[2], L[3], H[0], H[1], H[2], H[3]}
            const s16x4 l0 = tr_read<v_rd_off(0, 3, 0)>(vb0), h0 = tr_read<v_rd_off(0, 3, 1)>(vb0), l1 = tr_read<v_rd_off(1, 3, 0)>(vb0), h1 = tr_read<v_rd_off(1, 3, 1)>(vb0);
            const s16x4 l2 = tr_read<v_rd_off(2, 3, 0)>(vb0), h2 = tr_read<v_rd_off(2, 3, 1)>(vb0), l3 = tr_read<v_rd_off(3, 3, 0)>(vb0), h3 = tr_read<v_rd_off(3, 3, 1)>(vb0);
            asm volatile("s_waitcnt lgkmcnt(0)" ::: "memory"); SBAR();
            o[0] = __builtin_amdgcn_mfma_f32_32x32x16_bf16(pa3, PKF(l0, h0), o[0], 0, 0, 0); o[1] = __builtin_amdgcn_mfma_f32_32x32x16_bf16(pa3, PKF(l1, h1), o[1], 0, 0, 0);
            o[2] = __builtin_amdgcn_mfma_f32_32x32x16_bf16(pa3, PKF(l2, h2), o[2], 0, 0, 0); o[3] = __builtin_amdgcn_mfma_f32_32x32x16_bf16(pa3, PKF(l3, h3), o[3], 0, 0, 0);
#undef PKF
        }
        SWRITE(1, B);
        __syncthreads();
    }
    for (int j = 1; j < NT; j += 2) { ATT_TILE(j, B, A); ATT_TILE(j + 1, A, B); }
#undef ATT_TILE
#undef SLOAD
#undef SWRITE
#undef PK4
    if (hi == 0) wsf[r32] = l_reg;
    asm volatile("s_waitcnt lgkmcnt(0)" ::: "memory");
    float rli[16];
#pragma unroll
    for (int r = 0; r < 16; ++r) rli[r] = __builtin_amdgcn_rcpf(wsf[crow(r, hi)]);
    float* X = (float*)lds + rg * 4096;
    if (comp == 1) {
#pragma unroll
        for (int d0 = 0; d0 < 4; ++d0)
#pragma unroll
            for (int r = 0; r < 16; ++r) X[(d0 * 16 + r) * 64 + lane] = o[d0][r] * rli[r] * lam;
    }
    __syncthreads();
    if (comp == 0) {
        float ssr[16];
#pragma unroll
        for (int r = 0; r < 16; ++r) ssr[r] = 0.f;
#pragma unroll
        for (int d0 = 0; d0 < 4; ++d0)
#pragma unroll
            for (int r = 0; r < 16; ++r) { const float v = o[d0][r] * rli[r] - X[(d0 * 16 + r) * 64 + lane]; o[d0][r] = v; ssr[r] += v * v; }
        float* P = (float*)(lds + L_P) + rg * 1024;
#pragma unroll
        for (int r = 0; r < 16; ++r) P[r * 64 + lane] = ssr[r];
        asm volatile("s_waitcnt lgkmcnt(0)" ::: "memory");
        {
            const int rho = lane & 31, hh = (rho >> 2) & 1, rr = (rho & 3) + 4 * (rho >> 3);
            const float4* pp = (const float4*)(P + rr * 64 + hh * 32 + (lane >> 5) * 16);
            const float4 a0 = pp[0], a1 = pp[1], a2 = pp[2], a3 = pp[3];
            float s = ((a0.x + a0.y) + (a0.z + a0.w)) + ((a1.x + a1.y) + (a1.z + a1.w)) + ((a2.x + a2.y) + (a2.z + a2.w)) + ((a3.x + a3.y) + (a3.z + a3.w));
            auto sw = __builtin_amdgcn_permlane32_swap(__float_as_uint(s), __float_as_uint(s), false, false); s = __uint_as_float(sw[0]) + __uint_as_float(sw[1]);
            if (lane < 32) wsf[32 + rho] = rsqrtf(s * (1.f / 128.f) + EPS) * (1.f - LAMBDA_INIT);
        }
        asm volatile("s_waitcnt lgkmcnt(0)" ::: "memory");
        float sw4[4];
#pragma unroll
        for (int d0 = 0; d0 < 4; ++d0) sw4[d0] = subln[d0 * 32 + r32];
        bf16_t* Ow = MIX + (size_t)(q0 + rg * 32) * DM + h * 128 + r32;
#pragma unroll
        for (int r = 0; r < 16; ++r) {
            const int orow = crow(r, hi); const float rs = wsf[32 + orow];
#pragma unroll
            for (int d0 = 0; d0 < 4; ++d0) Ow[(size_t)orow * DM + d0 * 32] = (bf16_t)f2bf(o[d0][r] * rs * sw4[d0]);
        }
    }
    __syncthreads();
}
#undef KSWZ
#undef SBAR
}

__device__ __forceinline__ float attn_lambda(const Args& a) {
    const int lane = opaque_tid() & 63;
    const float l1 = wave_sum(a.lamqk[lane] * a.lamqk[64 + lane]), l2 = wave_sum(a.lamqk[128 + lane] * a.lamqk[192 + lane]);
    return expf(l1) - expf(l2) + LAMBDA_INIT;
}
namespace mls {
using bf16x8 = __attribute__((ext_vector_type(8))) short;
using bf16x4 = __attribute__((ext_vector_type(4))) short;
using s16x4 = __attribute__((ext_vector_type(4))) short;
using f32x16 = __attribute__((ext_vector_type(16))) float;
using f32x4v = __attribute__((ext_vector_type(4))) float;
using u32x4v = __attribute__((ext_vector_type(4))) unsigned;
using u32x2v = __attribute__((ext_vector_type(2))) unsigned;
constexpr int L_QS = 0, L_QP = 16384, L_KS = 32768, L_KW = 49152, L_VT = 65536, L_PT = 98304, L_HT = 106496, HT_STRIDE = 528;
constexpr int L_MISC = L_HT + 64 * HT_STRIDE;
constexpr int L_RS = L_MISC, L_QN = L_RS + 2 * 64 * 4, L_NV = L_QN + 64 * 4, L_NP = L_NV + 128 * 4, L_CW = L_NP + 8 * 128 * 4, L_RD = L_CW + 5 * 256 * 4, L_NW = L_RD + 8 * 64 * 4, L_END = L_NW + 8 * 36 * 4;
#define KSWZ(row, colB) ((row) * 256 + ((colB) ^ (((row) & 7) << 4)))
#define PSWZ(row, colB) ((row) * 128 + ((colB) ^ ((((row) >> 1) & 7) << 4)))
__device__ __forceinline__ int crow(int r, int hi) { return (r & 3) + 8 * (r >> 2) + 4 * hi; }
__device__ __forceinline__ unsigned cvtpk(float lo, float hi) { unsigned r; asm volatile("v_cvt_pk_bf16_f32 %0, %1, %2" : "=v"(r) : "v"(lo), "v"(hi)); return r; }
__device__ __forceinline__ int v_st(int k, int c) { const int kk = (k & ~0xC) | ((k & 4) << 1) | ((k & 8) >> 1); return ((kk >> 3) * 4 + (c >> 5)) * 512 + ((kk & 7) * 32 + (c & 31)) * 2; }
__device__ __forceinline__ int v_rd_base(int lane) { return ((lane & 3) << 3) | (((lane >> 2) & 3) << 6) | (((lane >> 4) & 1) << 5) | (((lane >> 5) & 1) << 8); }
__device__ __forceinline__ s16x4 tr_read_dyn(int addr) { s16x4 r; asm volatile("ds_read_b64_tr_b16 %0, %1" : "=&v"(r) : "v"(addr) : "memory"); return r; }
__device__ __forceinline__ bf16x8 tr_frag(int img_plus_base, int d0, int ks) {
    const s16x4 lo = tr_read_dyn(img_plus_base + d0 * 512 + ks * 4096), hi = tr_read_dyn(img_plus_base + d0 * 512 + ks * 4096 + 2048);
    return (bf16x8){lo[0], lo[1], lo[2], lo[3], hi[0], hi[1], hi[2], hi[3]};
}
template <int CTRL, int RMASK> __device__ __forceinline__ float dppf(float old, float v) { return __builtin_bit_cast(float, __builtin_amdgcn_update_dpp(__builtin_bit_cast(int, old), __builtin_bit_cast(int, v), CTRL, RMASK, 0xf, false)); }
__device__ __forceinline__ float scan_add(float v) {
    v += dppf<0x111, 0xf>(0.f, v); v += dppf<0x112, 0xf>(0.f, v); v += dppf<0x114, 0xf>(0.f, v); v += dppf<0x118, 0xf>(0.f, v);
    v += dppf<0x142, 0xa>(0.f, v); v += dppf<0x143, 0xc>(0.f, v); return v;
}
__device__ __forceinline__ float scan_max(float v) {
    const float NI = -3.0e38f;
    v = fmaxf(v, dppf<0x111, 0xf>(NI, v)); v = fmaxf(v, dppf<0x112, 0xf>(NI, v)); v = fmaxf(v, dppf<0x114, 0xf>(NI, v)); v = fmaxf(v, dppf<0x118, 0xf>(NI, v));
    v = fmaxf(v, dppf<0x142, 0xa>(NI, v)); v = fmaxf(v, dppf<0x143, 0xc>(NI, v)); return v;
}
__device__ __forceinline__ float rlane(float v, int l) { return __uint_as_float(__builtin_amdgcn_readlane(__float_as_uint(v), l)); }
__device__ __forceinline__ float silu(float x) { return x * __builtin_amdgcn_rcpf(1.f + __expf(-x)); }
__device__ __forceinline__ void fmac_v(float& y, float a, float b) { asm("v_fmac_f32 %0, %1, %2" : "+v"(y) : "v"(a), "v"(b)); }
__device__ __forceinline__ float mul_v(float a, float b) { float r; asm("v_mul_f32 %0, %1, %2" : "=v"(r) : "v"(a), "v"(b)); return r; }

__device__ __forceinline__ void mlstm_item(int b, int h, const Args& a, char* lds) {
    const int tid0 = opaque_tid(), wid = __builtin_amdgcn_readfirstlane(tid0 >> 6);
    const bf16_t* Z = (const bf16_t*)(a.ws + WS_Z); const float* G = (const float*)(a.ws + WS_GATES); bf16_t* MIX = (bf16_t*)(a.ws + WS_MIX);
    const int ldsb = (int)(uintptr_t)lds;
    float* RS = (float*)(lds + L_RS); float* QN = (float*)(lds + L_QN); float* NV = (float*)(lds + L_NV); float* NP = (float*)(lds + L_NP); float* CW = (float*)(lds + L_CW);
    for (int i = tid0; i < 5 * 256; i += NTHREADS) { const int j = i >> 8, c = i & 255; const int cc = c < 128 ? h * 128 + c : 512 + h * 128 + (c - 128); CW[i] = j < 4 ? a.convw[j * 1024 + cc] : a.convb[cc]; }
    if (tid0 < 128) NV[tid0] = 0.f;
    if (tid0 < 256) ((float*)(lds + L_NW))[(tid0 >> 5) * 36 + (tid0 & 31)] = a.mnw[h * 256 + tid0];
    const float ibh = a.ib[h], fbh = a.fb[h];
    float cw[4][4], cb[4];
    __syncthreads();
    { const int c4 = 4 * (tid0 & 63);
#pragma unroll
    for (int j = 0; j < 4; ++j)
#pragma unroll
        for (int q = 0; q < 4; ++q) cw[j][q] = CW[j * 256 + c4 + q];
#pragma unroll
    for (int q = 0; q < 4; ++q) cb[q] = CW[4 * 256 + c4 + q]; }
    f32x16 C[4] = {};
    float m_prev = -1e30f;
    u32x2v rq[11]; u32x4v rv[4]; float gi, gf;
    auto chunk_row0 = [&](int c) -> int { return c == 0 ? META_TILE0 : b * SEQ + (c - 1) * 64; };
#define LOAD_RAW(c) do { int tq_ = tid0; asm volatile("" : "+v"(tq_)); const int ln_ = tq_ & 63, c4_ = 4 * ln_, zc_qk = (c4_ < 128 ? ZMQ + h * 128 + c4_ : ZMK + h * 128 + (c4_ - 128)), erow = tq_ >> 3, eseg = tq_ & 7; const int r0_ = chunk_row0(c); \
        _Pragma("unroll") for (int i_ = 0; i_ < 11; ++i_) { const int t_ = 8 * wid - 3 + i_; int row_; bool ok_ = true; \
            if (t_ >= 0) row_ = r0_ + t_; else if ((c) == 0) { row_ = 0; ok_ = false; } else if ((c) == 1) row_ = META_TILE0 + 64 + t_; else row_ = r0_ + t_; \
            rq[i_] = ok_ ? *(const u32x2v*)(Z + (size_t)row_ * NZ + zc_qk) : (u32x2v){0u, 0u}; } \
        _Pragma("unroll") for (int i_ = 0; i_ < 4; ++i_) rv[i_] = *(const u32x4v*)(Z + (size_t)(r0_ + erow) * NZ + ZMV + h * 256 + eseg * 32 + 8 * i_); \
        { const int rowg_ = r0_ + ln_; gi = G[(size_t)rowg_ * 8 + h]; gf = G[(size_t)rowg_ * 8 + 4 + h]; } } while (0)
    LOAD_RAW(0);
    const int NCH = 33;
    for (int c = 0; c < NCH; ++c) {
        int tid = tid0; asm volatile("" : "+v"(tid));
        const int lane = tid & 63, r32 = lane & 31, hi = lane >> 5, cq = lane, c4 = 4 * cq, erow = tid >> 3, eseg = tid & 7;
        float* RD = (float*)(lds + L_RD) + wid * 64;
        float li = gi + ibh; float lf; { const float xf = gf + fbh; lf = fminf(xf, 0.f) - __logf(1.f + __expf(-fabsf(xf))); }
        if (c == 0 && lane < 48) { li = -1e30f; lf = 0.f; }
        const float bsum = scan_add(lf);
        const float u = li - bsum;
        const float cm = scan_max(u);
        const float Mrow = fmaxf(cm, m_prev);
        const float iw = __expf(m_prev - Mrow);
        const float Mend = rlane(Mrow, 63), gtot = rlane(bsum, 63);
        const float wrow = __expf(u - Mend);
        const float dec = __expf(m_prev - Mend);
        const float dexp = __expf(-(bsum + Mrow));
        {
            float qn_part[8], ksum[4] = {0.f, 0.f, 0.f, 0.f};
            float nvv[4];
#pragma unroll
            for (int q = 0; q < 4; ++q) nvv[q] = (cq < 32) ? NV[c4 + q] : 0.f;
#pragma unroll
            for (int i = 0; i < 8; ++i) {
                const int t = 8 * wid + i;
                float xo[4];
#pragma unroll
                for (int q = 0; q < 4; ++q) xo[q] = cb[q];
#pragma unroll
                for (int j = 0; j < 4; ++j) {
                    const u32x2v rr = rq[i + j];
                    fmac_v(xo[0], cw[j][0], bf_lo(rr.x)); fmac_v(xo[1], cw[j][1], bf_hi(rr.x)); fmac_v(xo[2], cw[j][2], bf_lo(rr.y)); fmac_v(xo[3], cw[j][3], bf_hi(rr.y));
                }
#pragma unroll
                for (int q = 0; q < 4; ++q) xo[q] = silu(xo[q]);
                const float iw_t = rlane(iw, t), w_t = rlane(wrow, t);
                if (cq < 32) {
#pragma unroll
                    for (int q = 0; q < 4; ++q) xo[q] = mul_v(xo[q], 0.08838834764831845f);
                    *(uint2*)(lds + L_QS + KSWZ(t, c4 * 2)) = make_uint2(cvtpk(xo[0], xo[1]), cvtpk(xo[2], xo[3]));
                    float qd = 0.f;
#pragma unroll
                    for (int q = 0; q < 4; ++q) { fmac_v(qd, xo[q], nvv[q]); xo[q] = mul_v(xo[q], iw_t); }
                    *(uint2*)(lds + L_QP + KSWZ(t, c4 * 2)) = make_uint2(cvtpk(xo[0], xo[1]), cvtpk(xo[2], xo[3]));
                    qn_part[i] = iw_t * qd;
                } else {
                    const int kc = c4 - 128;
                    *(uint2*)(lds + L_KS + KSWZ(t, kc * 2)) = make_uint2(cvtpk(xo[0], xo[1]), cvtpk(xo[2], xo[3]));
#pragma unroll
                    for (int q = 0; q < 4; ++q) { xo[q] = mul_v(xo[q], w_t); ksum[q] += xo[q]; }
                    *(uint2*)(lds + L_KW + v_st(t, kc)) = make_uint2(cvtpk(xo[0], xo[1]), cvtpk(xo[2], xo[3]));
                    qn_part[i] = 0.f;
                }
                __builtin_amdgcn_sched_barrier(0);
            }
            {
                float r4[4], r2[2], r1;
                { const bool hb = (lane & 16) != 0;
#pragma unroll
                  for (int i = 0; i < 4; ++i) { const float send = hb ? qn_part[i] : qn_part[i + 4]; const float recv = __shfl_xor(send, 16); r4[i] = (hb ? qn_part[i + 4] : qn_part[i]) + recv; } }
                { const bool hb = (lane & 8) != 0;
#pragma unroll
                  for (int i = 0; i < 2; ++i) { const float send = hb ? r4[i] : r4[i + 2]; const float recv = __shfl_xor(send, 8); r2[i] = (hb ? r4[i + 2] : r4[i]) + recv; } }
                { const bool hb = (lane & 4) != 0; const float send = hb ? r2[0] : r2[1]; const float recv = __shfl_xor(send, 4); r1 = (hb ? r2[1] : r2[0]) + recv; }
                r1 += __shfl_xor(r1, 2); r1 += __shfl_xor(r1, 1);
                if (lane < 32 && (lane & 3) == 0) QN[8 * wid + ((lane >> 4) & 1) * 4 + ((lane >> 3) & 1) * 2 + ((lane >> 2) & 1)] = r1;
            }
            if (cq >= 32) {
#pragma unroll
                for (int q = 0; q < 4; ++q) NP[wid * 128 + (c4 - 128) + q] = ksum[q];
            }
#pragma unroll
            for (int i = 0; i < 4; ++i) *(u32x4v*)(lds + L_VT + (eseg >> 2) * 16384 + v_st(erow, (eseg & 3) * 32 + 8 * i)) = rv[i];
        }
        u32x4v zo[4];
        {
            const int r0 = chunk_row0(c);
#pragma unroll
            for (int i = 0; i < 4; ++i) zo[i] = *(const u32x4v*)(Z + (size_t)(r0 + erow) * NZ + ZMO + h * 256 + eseg * 32 + 8 * i);
        }
        if (c + 1 < NCH) LOAD_RAW(c + 1);
        __syncthreads();
        {
            const int tb = wid >> 1, half = wid & 1;
            float rsum[4] = {0.f, 0.f, 0.f, 0.f};
            const int fr = lane & 15, fq = lane >> 4;
            float Mt[4];
#pragma unroll
            for (int i = 0; i < 4; ++i) Mt[i] = __shfl(Mrow, 16 * tb + 4 * fq + i);
#pragma unroll
            for (int sj = 0; sj < 2; ++sj) {
                const int sb = 2 * half + sj;
                unsigned short pw[4] = {0, 0, 0, 0};
                if (sb <= tb) {
                    f32x4v acc = {0.f, 0.f, 0.f, 0.f};
#pragma unroll
                    for (int ks = 0; ks < 4; ++ks) {
                        const bf16x8 af = *(const bf16x8*)(lds + L_QS + KSWZ(16 * tb + fr, (32 * ks + 8 * fq) * 2));
                        const bf16x8 bfr = *(const bf16x8*)(lds + L_KS + KSWZ(16 * sb + fr, (32 * ks + 8 * fq) * 2));
                        acc = __builtin_amdgcn_mfma_f32_16x16x32_bf16(af, bfr, acc, 0, 0, 0);
                    }
                    const int s = 16 * sb + fr; const float us = __shfl(u, s);
#pragma unroll
                    for (int i = 0; i < 4; ++i) {
                        const int t = 16 * tb + 4 * fq + i;
                        const float p = (s <= t) ? acc[i] * __expf(us - Mt[i]) : 0.f;
                        rsum[i] += p; pw[i] = (unsigned short)f2bf(p);
                    }
                }
#pragma unroll
                for (int i = 0; i < 4; ++i) *(unsigned short*)(lds + L_PT + PSWZ(16 * tb + 4 * fq + i, (16 * sb + fr) * 2)) = pw[i];
            }
#pragma unroll
            for (int i = 0; i < 4; ++i) {
                float v = rsum[i];
                v += __shfl_xor(v, 1); v += __shfl_xor(v, 2); v += __shfl_xor(v, 4); v += __shfl_xor(v, 8);
                if (fr == 0) RS[half * 64 + 16 * tb + 4 * fq + i] = v;
            }
        }
        __syncthreads();
        {
            const float nq = RS[lane] + RS[64 + lane] + QN[lane];
            RD[lane] = __builtin_amdgcn_rcpf(fmaxf(fabsf(nq), dexp));
            bf16x8 vf[4];
            const int vimg = ldsb + L_VT + (wid >> 2) * 16384 + v_rd_base(lane);
#pragma unroll
            for (int ks = 0; ks < 4; ++ks) vf[ks] = tr_frag(vimg, wid & 3, ks);
            asm volatile("s_waitcnt lgkmcnt(0)" ::: "memory"); __builtin_amdgcn_sched_barrier(0);
            f32x16 acc[2] = {};
#pragma unroll
            for (int rb = 0; rb < 2; ++rb) {
                const int row = 32 * rb + r32;
#pragma unroll
                for (int ks = 0; ks < 4; ++ks) {
                    if (rb == 0 && ks >= 2) continue;
                    const bf16x8 pf = *(const bf16x8*)(lds + L_PT + PSWZ(row, (16 * ks + 8 * hi) * 2));
                    acc[rb] = __builtin_amdgcn_mfma_f32_32x32x16_bf16(pf, vf[ks], acc[rb], 0, 0, 0);
                }
            }
#pragma unroll
            for (int kb = 0; kb < 4; ++kb)
#pragma unroll
                for (int sp = 0; sp < 2; ++sp) {
                    bf16x8 cf; { unsigned w0 = cvtpk(C[kb][8 * sp + 0], C[kb][8 * sp + 1]), w1 = cvtpk(C[kb][8 * sp + 2], C[kb][8 * sp + 3]), w2 = cvtpk(C[kb][8 * sp + 4], C[kb][8 * sp + 5]), w3 = cvtpk(C[kb][8 * sp + 6], C[kb][8 * sp + 7]);
                        typedef unsigned u32x4_ __attribute__((ext_vector_type(4))); u32x4_ ww = {w0, w1, w2, w3}; cf = __builtin_bit_cast(bf16x8, ww); }
                    const int base = 32 * kb + 16 * sp;
#pragma unroll
                    for (int rb = 0; rb < 2; ++rb) {
                        const int row = 32 * rb + r32;
                        const bf16x4 q0 = *(const bf16x4*)(lds + L_QP + KSWZ(row, (base + 4 * hi) * 2));
                        const bf16x4 q1 = *(const bf16x4*)(lds + L_QP + KSWZ(row, (base + 8 + 4 * hi) * 2));
                        const bf16x8 qf = {q0[0], q0[1], q0[2], q0[3], q1[0], q1[1], q1[2], q1[3]};
                        acc[rb] = __builtin_amdgcn_mfma_f32_32x32x16_bf16(qf, cf, acc[rb], 0, 0, 0);
                    }
                }
            asm volatile("s_waitcnt lgkmcnt(0)" ::: "memory");
#pragma unroll
            for (int rb = 0; rb < 2; ++rb)
#pragma unroll
                for (int r = 0; r < 16; ++r) {
                    const int row = 32 * rb + crow(r, hi);
                    *(unsigned short*)(lds + L_HT + row * HT_STRIDE + (32 * wid + r32) * 2) = (unsigned short)f2bf(acc[rb][r] * RD[row]);
                }
#pragma unroll
            for (int kb = 0; kb < 4; ++kb) {
#pragma unroll
                for (int r = 0; r < 16; ++r) C[kb][r] *= dec;
                const int kimg = ldsb + L_KW + v_rd_base(lane);
                bf16x8 kf[4];
#pragma unroll
                for (int ks = 0; ks < 4; ++ks) kf[ks] = tr_frag(kimg, kb, ks);
                asm volatile("s_waitcnt lgkmcnt(0)" ::: "memory"); __builtin_amdgcn_sched_barrier(0);
#pragma unroll
                for (int ks = 0; ks < 4; ++ks) C[kb] = __builtin_amdgcn_mfma_f32_32x32x16_bf16(kf[ks], vf[ks], C[kb], 0, 0, 0);
            }
            if (tid < 128) { float s = NV[tid] * dec;
#pragma unroll
                for (int w8 = 0; w8 < 8; ++w8) s += NP[w8 * 128 + tid];
                NV[tid] = s; }
        }
        m_prev = gtot + Mend;
        __syncthreads();
        if (c > 0) {
            float hv[32]; float ss = 0.f;
#pragma unroll
            for (int i = 0; i < 4; ++i) {
                const uint4 w = *(const uint4*)(lds + L_HT + erow * HT_STRIDE + eseg * 64 + 16 * i);
                hv[8 * i + 0] = bf_lo(w.x); hv[8 * i + 1] = bf_hi(w.x); hv[8 * i + 2] = bf_lo(w.y); hv[8 * i + 3] = bf_hi(w.y);
                hv[8 * i + 4] = bf_lo(w.z); hv[8 * i + 5] = bf_hi(w.z); hv[8 * i + 6] = bf_lo(w.w); hv[8 * i + 7] = bf_hi(w.w);
            }
#pragma unroll
            for (int i = 0; i < 32; ++i) ss += hv[i] * hv[i];
            ss += __shfl_xor(ss, 1); ss += __shfl_xor(ss, 2); ss += __shfl_xor(ss, 4);
            const float rstd = rsqrtf(ss * (1.f / 256.f) + EPS);
            const float* nw = (const float*)(lds + L_NW) + eseg * 36;
            bf16_t* op = MIX + (size_t)(chunk_row0(c) + erow) * DM + 1024 + h * 256 + eseg * 32;
#pragma unroll
            for (int i = 0; i < 4; ++i) {
                const unsigned zz[4] = {zo[i].x, zo[i].y, zo[i].z, zo[i].w};
                unsigned ow[4];
#pragma unroll
                for (int q = 0; q < 4; ++q) {
                    const float z0 = bf_lo(zz[q]), z1 = bf_hi(zz[q]);
                    const float o0 = hv[8 * i + 2 * q] * rstd * nw[8 * i + 2 * q] * __builtin_amdgcn_rcpf(1.f + __expf(-z0));
                    const float o1 = hv[8 * i + 2 * q + 1] * rstd * nw[8 * i + 2 * q + 1] * __builtin_amdgcn_rcpf(1.f + __expf(-z1));
                    ow[q] = pk2(o0, o1);
                }
                *(uint4*)(op + 8 * i) = make_uint4(ow[0], ow[1], ow[2], ow[3]);
            }
        }
    }
#undef LOAD_RAW
    __syncthreads();
}
#undef KSWZ
#undef PSWZ
}

namespace rt {
using bf16x8 = __attribute__((ext_vector_type(8))) short;
using f32x16 = __attribute__((ext_vector_type(16))) float;
#define CE(a, b) do { const unsigned x_ = (a), y_ = (b); (a) = x_ > y_ ? x_ : y_; (b) = x_ > y_ ? y_ : x_; } while (0)
#define SORT16_DESC(V) do { CE(V[0], V[1]); CE(V[2], V[3]); CE(V[0], V[2]); CE(V[1], V[3]); CE(V[1], V[2]); CE(V[4], V[5]); CE(V[6], V[7]); CE(V[4], V[6]); CE(V[5], V[7]); CE(V[5], V[6]); CE(V[0], V[4]); CE(V[2], V[6]); CE(V[2], V[4]); CE(V[1], V[5]); CE(V[3], V[7]); CE(V[3], V[5]); CE(V[1], V[2]); CE(V[3], V[4]); CE(V[5], V[6]); CE(V[8], V[9]); CE(V[10], V[11]); CE(V[8], V[10]); CE(V[9], V[11]); CE(V[9], V[10]); CE(V[12], V[13]); CE(V[14], V[15]); CE(V[12], V[14]); CE(V[13], V[15]); CE(V[13], V[14]); CE(V[8], V[12]); CE(V[10], V[14]); CE(V[10], V[12]); CE(V[9], V[13]); CE(V[11], V[15]); CE(V[11], V[13]); CE(V[9], V[10]); CE(V[11], V[12]); CE(V[13], V[14]); CE(V[0], V[8]); CE(V[4], V[12]); CE(V[4], V[8]); CE(V[2], V[10]); CE(V[6], V[14]); CE(V[6], V[10]); CE(V[2], V[4]); CE(V[6], V[8]); CE(V[10], V[12]); CE(V[1], V[9]); CE(V[5], V[13]); CE(V[5], V[9]); CE(V[3], V[11]); CE(V[7], V[15]); CE(V[7], V[11]); CE(V[3], V[5]); CE(V[7], V[9]); CE(V[11], V[13]); CE(V[1], V[2]); CE(V[3], V[4]); CE(V[5], V[6]); CE(V[7], V[8]); CE(V[9], V[10]); CE(V[11], V[12]); CE(V[13], V[14]); } while (0)
#define BMERGE16_DESC(V) do { CE(V[0], V[8]); CE(V[1], V[9]); CE(V[2], V[10]); CE(V[3], V[11]); CE(V[4], V[12]); CE(V[5], V[13]); CE(V[6], V[14]); CE(V[7], V[15]); CE(V[0], V[4]); CE(V[1], V[5]); CE(V[2], V[6]); CE(V[3], V[7]); CE(V[8], V[12]); CE(V[9], V[13]); CE(V[10], V[14]); CE(V[11], V[15]); CE(V[0], V[2]); CE(V[1], V[3]); CE(V[4], V[6]); CE(V[5], V[7]); CE(V[8], V[10]); CE(V[9], V[11]); CE(V[12], V[14]); CE(V[13], V[15]); CE(V[0], V[1]); CE(V[2], V[3]); CE(V[4], V[5]); CE(V[6], V[7]); CE(V[8], V[9]); CE(V[10], V[11]); CE(V[12], V[13]); CE(V[14], V[15]); } while (0)

#define TOP16(A, B) do { _Pragma("unroll") for (int i_ = 0; i_ < 16; ++i_) { const unsigned x_ = A[i_], y_ = B[15 - i_]; A[i_] = x_ > y_ ? x_ : y_; } BMERGE16_DESC(A); } while (0)
__device__ __forceinline__ unsigned ord_key(float f) { const unsigned u = __float_as_uint(f); return u ^ (((unsigned)((int)u >> 31)) | 0x80000000u); }
__device__ __forceinline__ float ord_val(unsigned k) { return __uint_as_float((k & 0x80000000u) ? (k ^ 0x80000000u) : ~k); }
__device__ __forceinline__ int crow(int r, int hi) { return (r & 3) + 8 * (r >> 2) + 4 * hi; }

__device__ __forceinline__ void route_item(int tb, int h, const bf16_t* QP, const char* KL, const float* SSQ, int* IDX, float* GATE, int* scr, int lane_in) {
    int lane = lane_in; asm volatile("" : "+v"(lane));
    const int tok = lane & 31, hi = lane >> 5;
    const int row = tb * 32 + tok;
    float rstd;
    { const float4* sp = (const float4*)(SSQ + (size_t)row * 32); float s = 0.f;
#pragma unroll
      for (int i = 0; i < 8; ++i) { const float4 v = sp[i]; s += (v.x + v.y) + (v.z + v.w); }
      rstd = rsqrtf(s * (1.f / DM) + EPS); }
    unsigned top[2][16];
    bf16x8 qf[8], af[2][8];
    unsigned T[16];
#define RT_LOADQ(p_) do { const bf16_t* qp_ = QP + (size_t)row * DM + h * 256 + (p_) * 128 + hi * 8; \
        _Pragma("unroll") for (int ks = 0; ks < 8; ++ks) qf[ks] = *reinterpret_cast<const bf16x8*>(qp_ + ks * 16); } while (0)
#define RT_LOADK(b_, i_) do { const char* kp_ = KL + ((((i_) >> 2) * 128 + ((i_) & 3) * 32 + tok) * 272 + hi * 16); \
        _Pragma("unroll") for (int ks = 0; ks < 8; ++ks) af[b_][ks] = *reinterpret_cast<const bf16x8*>(kp_ + ks * 32); } while (0)
    RT_LOADQ(0); RT_LOADK(0, 0);
#pragma unroll
    for (int i = 0; i < 8; ++i) {
        const int p = i >> 2, kb = i & 3;
        if (i + 1 < 8) RT_LOADK((i + 1) & 1, i + 1);
        f32x16 acc = {};
#pragma unroll
        for (int ks = 0; ks < 8; ++ks) acc = __builtin_amdgcn_mfma_f32_32x32x16_bf16(af[i & 1][ks], qf[ks], acc, 0, 0, 0);
        unsigned K[16];
#pragma unroll
        for (int r = 0; r < 16; ++r) { const int low = 127 - (32 * kb + (r & 3) + 8 * (r >> 2)) - 4 * hi; K[r] = (ord_key(acc[r]) & ~127u) | (unsigned)low; }
        if (i == 3) RT_LOADQ(1);
        SORT16_DESC(K);
        if (kb == 0) {
#pragma unroll
            for (int j = 0; j < 16; ++j) T[j] = K[j];
        } else { TOP16(T, K); }
        if (kb == 3) {
            unsigned O[16];
#pragma unroll
            for (int j = 0; j < 16; ++j) { auto rr = __builtin_amdgcn_permlane32_swap(T[j], T[j], false, false); O[j] = hi ? rr[0] : rr[1]; }
            TOP16(T, O);
#pragma unroll
            for (int j = 0; j < 16; ++j) top[p][j] = T[j];
        }
        __builtin_amdgcn_sched_barrier(0);
    }
#undef RT_LOADQ
#undef RT_LOADK
    float s1[16], s2[16];
#pragma unroll
    for (int i = 0; i < 16; ++i) {
        s1[i] = ord_val(top[0][i] & ~127u) * rstd; s2[i] = ord_val(top[1][i] & ~127u) * rstd;
        scr[i * 64 + lane] = 127 - (int)(top[0][i] & 127u); scr[(16 + i) * 64 + lane] = 127 - (int)(top[1][i] & 127u);
    }
#define CKEY(a_, b_) ((ord_key(s1[a_] + s2[b_]) & ~255u) | (unsigned)(255 - (16 * (a_) + (b_))))
    unsigned A[16], B[16], Cg[16];
#pragma unroll
    for (int b_ = 0; b_ < 16; ++b_) A[b_] = CKEY(0, b_);
#pragma unroll
    for (int b_ = 0; b_ < 8; ++b_) { B[b_] = CKEY(1, b_); B[8 + b_] = CKEY(15 - b_, 0); }
    BMERGE16_DESC(B);
    Cg[0] = CKEY(2, 0); Cg[1] = CKEY(2, 1); Cg[2] = CKEY(2, 2); Cg[3] = CKEY(2, 3); Cg[4] = CKEY(2, 4);
    Cg[5] = CKEY(3, 0); Cg[6] = CKEY(3, 1); Cg[7] = CKEY(3, 2); Cg[8] = CKEY(3, 3);
    Cg[9] = CKEY(4, 0); Cg[10] = CKEY(4, 1); Cg[11] = CKEY(4, 2);
    Cg[12] = CKEY(5, 0); Cg[13] = CKEY(5, 1); Cg[14] = CKEY(6, 0); Cg[15] = CKEY(6, 1);
    SORT16_DESC(Cg);
    { const unsigned d0 = CKEY(7, 0), d1 = CKEY(7, 1); Cg[15] = Cg[15] > d0 ? Cg[15] : d0; Cg[14] = Cg[14] > d1 ? Cg[14] : d1; BMERGE16_DESC(Cg); }
    TOP16(A, B); TOP16(A, Cg);
#undef CKEY
    asm volatile("s_waitcnt lgkmcnt(0)" ::: "memory");
    float e[16]; float z = 0.f; const float mx = ord_val(A[0] & ~255u);
#pragma unroll
    for (int j = 0; j < 16; ++j) { e[j] = __expf(ord_val(A[j] & ~255u) - mx); z += e[j]; }
    const float rz = 1.f / z;
    int* ip = IDX + (size_t)row * 128 + h * 16 + hi * 8; float* gp = GATE + (size_t)row * 128 + h * 16 + hi * 8;
    int oi[8] = {0, 0, 0, 0, 0, 0, 0, 0}; float og[8] = {0.f, 0.f, 0.f, 0.f, 0.f, 0.f, 0.f, 0.f};
#pragma unroll
    for (int j = 0; j < 16; ++j) {
        const int flat = 255 - (int)(A[j] & 255u), a_ = flat >> 4, b_ = flat & 15;
        const int ex = scr[a_ * 64 + lane] * 128 + scr[(16 + b_) * 64 + lane];
        if (j < 8) { if (!hi) { oi[j] = ex; og[j] = e[j] * rz; } } else { if (hi) { oi[j - 8] = ex; og[j - 8] = e[j] * rz; } }
    }
    *(int4*)(ip) = make_int4(oi[0], oi[1], oi[2], oi[3]); *(int4*)(ip + 4) = make_int4(oi[4], oi[5], oi[6], oi[7]);
    *(float4*)(gp) = make_float4(og[0], og[1], og[2], og[3]); *(float4*)(gp + 4) = make_float4(og[4], og[5], og[6], og[7]);
    asm volatile("s_waitcnt lgkmcnt(0)" ::: "memory");
}
#undef CE
#undef TOP16
}

__device__ __forceinline__ void phase_route(const Args& a, unsigned char* lds, int bid, int nb) {
    const int tid = opaque_tid(), wave = __builtin_amdgcn_readfirstlane(tid >> 6), lane = tid & 63;
    const bf16_t* QP = (const bf16_t*)(a.ws + WS_MIX); const bf16_t* SKB = (const bf16_t*)(a.ws + WS_SKB); const float* SSQ = (const float*)(a.ws + WS_SSQ);
    int* IDX = (int*)(a.ws + WS_IDX); float* GATE = (float*)(a.ws + WS_GATE);
    int* scr = (int*)lds + wave * 2048;
    {
        const bf16_t* X1W = (const bf16_t*)(a.ws + WS_HN); signed char* X1Q = (signed char*)(a.ws + WS_X1Q); float* XSC = (float*)(a.ws + WS_XSC);
        for (int row = bid * NWAVES + wave; row < TREAL; row += nb * NWAVES) {
            uint4 xr[4]; float am = 0.f;
#pragma unroll
            for (int j = 0; j < 4; ++j) { xr[j] = *(const uint4*)(X1W + (size_t)row * DM + 8 * lane + 512 * j);
                am = fmaxf(am, fmaxf(fmaxf(fmaxf(fabsf(bf_lo(xr[j].x)), fabsf(bf_hi(xr[j].x))), fmaxf(fabsf(bf_lo(xr[j].y)), fabsf(bf_hi(xr[j].y)))), fmaxf(fmaxf(fabsf(bf_lo(xr[j].z)), fabsf(bf_hi(xr[j].z))), fmaxf(fabsf(bf_lo(xr[j].w)), fabsf(bf_hi(xr[j].w)))))); }
            am = wave_max(am);
            const float sc = am > 0.f ? 127.f / am : 0.f;
#pragma unroll
            for (int j = 0; j < 4; ++j) {
                const unsigned ww[4] = {xr[j].x, xr[j].y, xr[j].z, xr[j].w}; unsigned o[2] = {0u, 0u};
#pragma unroll
                for (int q = 0; q < 4; ++q) { const int q0 = (int)rintf(bf_lo(ww[q]) * sc), q1 = (int)rintf(bf_hi(ww[q]) * sc); o[q >> 1] |= ((unsigned)(q0 & 255) | ((unsigned)(q1 & 255) << 8)) << (16 * (q & 1)); }
                *(uint2*)(X1Q + (size_t)row * DM + 8 * lane + 512 * j) = make_uint2(o[0], o[1]);
            }
            if (lane == 0) XSC[row] = am * (1.f / 127.f);
        }
    }
    {
        const int hb = bid & 7; char* KL = (char*)lds + 65536;
        __syncthreads();
        const uint4* src = (const uint4*)(SKB + (size_t)hb * (2 * 128 * 128));
#pragma unroll
        for (int k = 0; k < 8; ++k) { const int ci = tid + NTHREADS * k; *(uint4*)(KL + (ci >> 4) * 272 + (ci & 15) * 16) = src[ci]; }
        __syncthreads();
        const int nbh = (nb - hb + 7) >> 3;
        for (int tb = (bid >> 3) * NWAVES + wave; tb < TREAL / 32; tb += nbh * NWAVES) rt::route_item(tb, hb, QP, KL, SSQ, IDX, GATE, scr, lane);
    }
}

constexpr int CW_QPV = 8192, CW_QPU = 8192 + 8 * 64;
constexpr int PX_ITEMS = TREAL / 64;
constexpr size_t WS_W = WS_Z + 4 * MiB, WS_PART = WS_Z + 32 * MiB, WS_Y = WS_Z + 160 * MiB;


template <int CTRL, int RMASK> __device__ __forceinline__ float dppf(float old, float v) { return __builtin_bit_cast(float, __builtin_amdgcn_update_dpp(__builtin_bit_cast(int, old), __builtin_bit_cast(int, v), CTRL, RMASK, 0xf, false)); }
template <int CTRL> __device__ __forceinline__ int dppi(int v) { return __builtin_amdgcn_update_dpp(0, v, CTRL, 0xf, 0xf, false); }
namespace pu2 {
typedef float f32x2v __attribute__((ext_vector_type(2)));
typedef unsigned u32x4v __attribute__((ext_vector_type(4)));
#define SBP() __builtin_amdgcn_sched_barrier(0)
#define PU_CHUNK_LD(dst, r_, q_) dst = *(const u32x4v*)(sidx + ((r_) - r0) * 512 + g128 + (q_) * 16)
#define PU_ROW_LD(buf, e_) buf = __builtin_amdgcn_raw_buffer_load_b128(U, (int)(e_) * 256 + c16, 0, 0)
#define PU_CONSUME(buf, I_) do { int s_ = __builtin_amdgcn_sdot4((int)buf[0], hq0, 0, false); s_ = __builtin_amdgcn_sdot4((int)buf[1], hq1, s_, false); \
    s_ = __builtin_amdgcn_sdot4((int)buf[2], hq2, s_, false); s_ = __builtin_amdgcn_sdot4((int)buf[3], hq3, s_, false); \
    s_ += dppi<0x128>(s_); s_ += dppi<0x124>(s_); s_ += dppi<0x122>(s_); s_ += dppi<0x121>(s_); \
    if ((I_) < 16) keep0 = (c == ((I_) & 15)) ? s_ : keep0; else keep1 = (c == ((I_) & 15)) ? s_ : keep1; } while (0)
#define PU_TOKEN_BODY(row_, nrow_, has_next_) do { \
    PU_CHUNK_LD(C7, row_, 7); \
    SBP(); PU_CONSUME(B0, 0); \
    PU_ROW_LD(B0, C2.x); \
    SBP(); PU_CONSUME(B1, 1); \
    PU_ROW_LD(B1, C2.y); \
    SBP(); PU_CONSUME(B2, 2); \
    PU_ROW_LD(B2, C2.z); \
    SBP(); PU_CONSUME(B3, 3); \
    PU_ROW_LD(B3, C2.w); \
    if (has_next_) PU_CHUNK_LD(C0, nrow_, 0); \
    SBP(); PU_CONSUME(B4, 4); \
    PU_ROW_LD(B4, C3.x); \
    SBP(); PU_CONSUME(B5, 5); \
    PU_ROW_LD(B5, C3.y); \
    SBP(); PU_CONSUME(B6, 6); \
    PU_ROW_LD(B6, C3.z); \
    SBP(); PU_CONSUME(B7, 7); \
    PU_ROW_LD(B7, C3.w); \
    if (has_next_) PU_CHUNK_LD(C1, nrow_, 1); \
    SBP(); PU_CONSUME(B0, 8); \
    PU_ROW_LD(B0, C4.x); \
    SBP(); PU_CONSUME(B1, 9); \
    PU_ROW_LD(B1, C4.y); \
    SBP(); PU_CONSUME(B2, 10); \
    PU_ROW_LD(B2, C4.z); \
    SBP(); PU_CONSUME(B3, 11); \
    PU_ROW_LD(B3, C4.w); \
    if (has_next_) PU_CHUNK_LD(C2, nrow_, 2); \
    SBP(); PU_CONSUME(B4, 12); \
    PU_ROW_LD(B4, C5.x); \
    SBP(); PU_CONSUME(B5, 13); \
    PU_ROW_LD(B5, C5.y); \
    SBP(); PU_CONSUME(B6, 14); \
    PU_ROW_LD(B6, C5.z); \
    SBP(); PU_CONSUME(B7, 15); \
    PU_ROW_LD(B7, C5.w); \
    if (has_next_) PU_CHUNK_LD(C3, nrow_, 3); \
    SBP(); PU_CONSUME(B0, 16); \
    PU_ROW_LD(B0, C6.x); \
    SBP(); PU_CONSUME(B1, 17); \
    PU_ROW_LD(B1, C6.y); \
    SBP(); PU_CONSUME(B2, 18); \
    PU_ROW_LD(B2, C6.z); \
    SBP(); PU_CONSUME(B3, 19); \
    PU_ROW_LD(B3, C6.w); \
    if (has_next_) PU_CHUNK_LD(C4, nrow_, 4); \
    SBP(); PU_CONSUME(B4, 20); \
    PU_ROW_LD(B4, C7.x); \
    SBP(); PU_CONSUME(B5, 21); \
    PU_ROW_LD(B5, C7.y); \
    SBP(); PU_CONSUME(B6, 22); \
    PU_ROW_LD(B6, C7.z); \
    SBP(); PU_CONSUME(B7, 23); \
    PU_ROW_LD(B7, C7.w); \
    if (has_next_) PU_CHUNK_LD(C5, nrow_, 5); \
    SBP(); PU_CONSUME(B0, 24); \
    if (has_next_) PU_ROW_LD(B0, C0.x); \
    SBP(); PU_CONSUME(B1, 25); \
    if (has_next_) PU_ROW_LD(B1, C0.y); \
    SBP(); PU_CONSUME(B2, 26); \
    if (has_next_) PU_ROW_LD(B2, C0.z); \
    SBP(); PU_CONSUME(B3, 27); \
    if (has_next_) PU_ROW_LD(B3, C0.w); \
    if (has_next_) PU_CHUNK_LD(C6, nrow_, 6); \
    SBP(); PU_CONSUME(B4, 28); \
    if (has_next_) PU_ROW_LD(B4, C1.x); \
    SBP(); PU_CONSUME(B5, 29); \
    if (has_next_) PU_ROW_LD(B5, C1.y); \
    SBP(); PU_CONSUME(B6, 30); \
    if (has_next_) PU_ROW_LD(B6, C1.z); \
    SBP(); PU_CONSUME(B7, 31); \
    if (has_next_) PU_ROW_LD(B7, C1.w); \
    } while (0)
#undef SBP
}

__device__ __forceinline__ void phase_pu(const Args& a, unsigned char* lds, unsigned* ctl, int xcc) {
    using namespace pu2;
#define SBP() __builtin_amdgcn_sched_barrier(0)
    const int tid = opaque_tid(), wave = __builtin_amdgcn_readfirstlane(tid >> 6), lane = tid & 63;
    volatile LAS unsigned* slot = (volatile LAS unsigned*)((LAS unsigned char*)lds + LDS_MISC) + 2;
    const signed char* X1Q = (const signed char*)(a.ws + WS_X1Q); float* PART = (float*)(a.ws + WS_PART);
    unsigned char* sidx = lds + wave * 4096; unsigned char* sxq = lds + 32768 + wave * 2048;
    const __amdgpu_buffer_rsrc_t RI = __builtin_amdgcn_make_buffer_rsrc((void*)(a.ws + WS_IDX), (short)0, TREAL * 512, 0x00020000);
    for (int ss = 0; ss < 8; ++ss) {
        const int s = (xcc + ss) & 7;
        const __amdgpu_buffer_rsrc_t U = __builtin_amdgcn_make_buffer_rsrc((void*)(a.ws + WS_U + (size_t)s * (16384 * 256)), (short)0, 16384 * 256, 0x00020000);
        unsigned wdraw = wave_draw(ctl + CW_QPU + 64 * s, lane);
        for (;;) {
            const int item8 = wave_item(wdraw);
            if (item8 >= PX_ITEMS * 8) break;
            wdraw = wave_draw(ctl + CW_QPU + 64 * s, lane);
            int ln = lane; asm volatile("" : "+v"(ln));
            const int g = ln >> 4, c = ln & 15, c16 = c * 16, g128 = g * 128;
            const int r0 = item8 * 8;
            u32x4v C0, C1, C2, C3, C4, C5, C6, C7, B0, B1, B2, B3, B4, B5, B6, B7;
            {
                const u32x4v* gi = (const u32x4v*)(a.ws + WS_IDX + (size_t)r0 * 512) + ln;
                const u32x4v i0 = gi[0], i1 = gi[64], i2 = gi[128], i3 = gi[192];
                const u32x4v xa = *(const u32x4v*)(X1Q + (size_t)(r0 + g) * DM + 256 * s + 16 * c), xb = *(const u32x4v*)(X1Q + (size_t)(r0 + 4 + g) * DM + 256 * s + 16 * c);
                u32x4v* si = (u32x4v*)sidx + ln; u32x4v* sx = (u32x4v*)sxq + ln;
                si[0] = i0; si[64] = i1; si[128] = i2; si[192] = i3; sx[0] = xa; sx[64] = xb;
                asm volatile("s_waitcnt lgkmcnt(0)" ::: "memory");
            }
            PU_CHUNK_LD(C0, r0, 0); PU_CHUNK_LD(C1, r0, 1); PU_CHUNK_LD(C2, r0, 2); PU_CHUNK_LD(C3, r0, 3); PU_CHUNK_LD(C4, r0, 4); PU_CHUNK_LD(C5, r0, 5); PU_CHUNK_LD(C6, r0, 6);
            uint4 nxq = ((const uint4*)sxq)[c];
            PU_ROW_LD(B0, C0.x); PU_ROW_LD(B1, C0.y); PU_ROW_LD(B2, C0.z); PU_ROW_LD(B3, C0.w); PU_ROW_LD(B4, C1.x); PU_ROW_LD(B5, C1.y); PU_ROW_LD(B6, C1.z); PU_ROW_LD(B7, C1.w);
#pragma unroll 1
            for (int t = 0; t < 8; ++t) {
                const int row = r0 + t, nrow = row + 1; const bool has_next = t < 7;
                const int hq0 = (int)nxq.x, hq1 = (int)nxq.y, hq2 = (int)nxq.z, hq3 = (int)nxq.w;
                if (has_next) nxq = ((const uint4*)sxq)[(t + 1) * 16 + c];
                int keep0 = 0, keep1 = 0;
                PU_TOKEN_BODY(row, nrow, has_next);
                *(float2*)(PART + (size_t)row * 1024 + s * 128 + 32 * g + 2 * c) = make_float2((float)keep0, (float)keep1);
            }
        }
    }
#undef SBP
}
__device__ __forceinline__ void phase_pc(const Args& a, int bid, int nb) {
    const int tid = opaque_tid(), wave = __builtin_amdgcn_readfirstlane(tid >> 6), lane = tid & 63;
    const float* SSQ = (const float*)(a.ws + WS_SSQ); const int* IDX = (const int*)(a.ws + WS_IDX); const float* GATE = (const float*)(a.ws + WS_GATE);
    const float2* ISC2 = (const float2*)(a.ws + WS_ISC); const float* PART = (const float*)(a.ws + WS_PART); unsigned short* W16 = (unsigned short*)(a.ws + WS_W); float* WSC = (float*)(a.ws + WS_W + 12 * MiB);
    for (int row = bid * NWAVES + wave; row < TREAL; row += nb * NWAVES) {
        float ssv = lane < 32 ? SSQ[(size_t)row * 32 + lane] : 0.f; ssv = wave_sum(ssv);
        const float rstd = rsqrtf(ssv * (1.f / DM) + EPS);
        const float xsc = ((const float*)(a.ws + WS_XSC))[row];
        const int p0 = 32 * (lane >> 4) + (lane & 15), p1 = p0 + 16;
        float2 d = {0.f, 0.f};
#pragma unroll
        for (int s = 0; s < 8; ++s) { const float2 v = *(const float2*)(PART + (size_t)row * 1024 + s * 128 + 2 * lane); d.x += v.x; d.y += v.y; }
        const int2 e2 = make_int2(IDX[(size_t)row * 128 + p0], IDX[(size_t)row * 128 + p1]);
        const float2 g2 = make_float2(GATE[(size_t)row * 128 + p0], GATE[(size_t)row * 128 + p1]);
        const float2 sa = ISC2[e2.x], sb = ISC2[e2.y];
        float wv[2];
        { const float pre = d.x * rstd * sa.x * xsc; wv[0] = g2.x * sa.y * (0.5f * pre * (1.f + erff(pre * 0.7071067811865476f))); }
        { const float pre = d.y * rstd * sb.x * xsc; wv[1] = g2.y * sb.y * (0.5f * pre * (1.f + erff(pre * 0.7071067811865476f))); }
        const float wmax = wave_max(fmaxf(fabsf(wv[0]), fabsf(wv[1])));
        const float wsc = wmax > 0.f ? 240.f / wmax : 0.f;
#pragma unroll
        for (int k = 0; k < 2; ++k) {
            const float ws = wv[k] * wsc;
            const int hi = __builtin_amdgcn_cvt_pk_fp8_f32(ws, 0.f, 0, false) & 255;
            const int lo = __builtin_amdgcn_cvt_pk_fp8_f32(ws - __builtin_amdgcn_cvt_f32_fp8(hi, 0), 0.f, 0, false) & 255;
            W16[(size_t)row * 128 + (k ? p1 : p0)] = (unsigned short)(hi | (lo << 8));
        }
        if (lane == 0) WSC[row] = wmax * (1.f / 240.f);
    }
}
namespace pv2 {
typedef float f32x2v __attribute__((ext_vector_type(2)));
typedef unsigned u32x4v __attribute__((ext_vector_type(4))); typedef float f32x4v __attribute__((ext_vector_type(4)));
typedef unsigned u32x2v __attribute__((ext_vector_type(2)));
struct Chunk { u32x4v i; u32x2v w; };
#define SBP() __builtin_amdgcn_sched_barrier(0)
#define PV_CHUNK_LD(dst, r_, q_) do { dst.i = *(const u32x4v*)(sidx + ((r_) - r0) * 512 + g128 + (q_) * 16); dst.w = *(const u32x2v*)(swt + ((r_) - r0) * 256 + g64 + (q_) * 8); } while (0)
#define PV_ROW_LD(buf, e_) buf = __builtin_amdgcn_raw_buffer_load_b128(V, (int)(e_) * 256 + c16, 0, 0)
#define PV_CONSUME(buf, ww_, S0_, S1_) do { const u32x2v b2_ = {__builtin_amdgcn_perm(0u, (ww_), (S0_)), __builtin_amdgcn_perm(0u, (ww_), (S1_))}; const long bb_ = __builtin_bit_cast(long, b2_); \
    const u32x2v a0_ = {buf[0], buf[1]}, a1_ = {buf[2], buf[3]}; \
    acc_lo = __builtin_amdgcn_mfma_f32_16x16x32_fp8_fp8(__builtin_bit_cast(long, a0_), bb_, acc_lo, 0, 0, 0); acc_hi = __builtin_amdgcn_mfma_f32_16x16x32_fp8_fp8(__builtin_bit_cast(long, a1_), bb_, acc_hi, 0, 0, 0); } while (0)
#define PV_TOKEN_BODY(row_, nrow_, has_next_) do { \
    PV_CHUNK_LD(C7, row_, 7); \
    SBP(); PV_CONSUME(B0, C0.w[0], sele0, sele1); \
    PV_ROW_LD(B0, C2.i.x); \
    SBP(); PV_CONSUME(B1, C0.w[0], selo0, selo1); \
    PV_ROW_LD(B1, C2.i.y); \
    SBP(); PV_CONSUME(B2, C0.w[1], sele0, sele1); \
    PV_ROW_LD(B2, C2.i.z); \
    SBP(); PV_CONSUME(B3, C0.w[1], selo0, selo1); \
    PV_ROW_LD(B3, C2.i.w); \
    if (has_next_) PV_CHUNK_LD(C0, nrow_, 0); \
    SBP(); PV_CONSUME(B4, C1.w[0], sele0, sele1); \
    PV_ROW_LD(B4, C3.i.x); \
    SBP(); PV_CONSUME(B5, C1.w[0], selo0, selo1); \
    PV_ROW_LD(B5, C3.i.y); \
    SBP(); PV_CONSUME(B6, C1.w[1], sele0, sele1); \
    PV_ROW_LD(B6, C3.i.z); \
    SBP(); PV_CONSUME(B7, C1.w[1], selo0, selo1); \
    PV_ROW_LD(B7, C3.i.w); \
    if (has_next_) PV_CHUNK_LD(C1, nrow_, 1); \
    SBP(); PV_CONSUME(B0, C2.w[0], sele0, sele1); \
    PV_ROW_LD(B0, C4.i.x); \
    SBP(); PV_CONSUME(B1, C2.w[0], selo0, selo1); \
    PV_ROW_LD(B1, C4.i.y); \
    SBP(); PV_CONSUME(B2, C2.w[1], sele0, sele1); \
    PV_ROW_LD(B2, C4.i.z); \
    SBP(); PV_CONSUME(B3, C2.w[1], selo0, selo1); \
    PV_ROW_LD(B3, C4.i.w); \
    if (has_next_) PV_CHUNK_LD(C2, nrow_, 2); \
    SBP(); PV_CONSUME(B4, C3.w[0], sele0, sele1); \
    PV_ROW_LD(B4, C5.i.x); \
    SBP(); PV_CONSUME(B5, C3.w[0], selo0, selo1); \
    PV_ROW_LD(B5, C5.i.y); \
    SBP(); PV_CONSUME(B6, C3.w[1], sele0, sele1); \
    PV_ROW_LD(B6, C5.i.z); \
    SBP(); PV_CONSUME(B7, C3.w[1], selo0, selo1); \
    PV_ROW_LD(B7, C5.i.w); \
    if (has_next_) PV_CHUNK_LD(C3, nrow_, 3); \
    SBP(); PV_CONSUME(B0, C4.w[0], sele0, sele1); \
    PV_ROW_LD(B0, C6.i.x); \
    SBP(); PV_CONSUME(B1, C4.w[0], selo0, selo1); \
    PV_ROW_LD(B1, C6.i.y); \
    SBP(); PV_CONSUME(B2, C4.w[1], sele0, sele1); \
    PV_ROW_LD(B2, C6.i.z); \
    SBP(); PV_CONSUME(B3, C4.w[1], selo0, selo1); \
    PV_ROW_LD(B3, C6.i.w); \
    if (has_next_) PV_CHUNK_LD(C4, nrow_, 4); \
    SBP(); PV_CONSUME(B4, C5.w[0], sele0, sele1); \
    PV_ROW_LD(B4, C7.i.x); \
    SBP(); PV_CONSUME(B5, C5.w[0], selo0, selo1); \
    PV_ROW_LD(B5, C7.i.y); \
    SBP(); PV_CONSUME(B6, C5.w[1], sele0, sele1); \
    PV_ROW_LD(B6, C7.i.z); \
    SBP(); PV_CONSUME(B7, C5.w[1], selo0, selo1); \
    PV_ROW_LD(B7, C7.i.w); \
    if (has_next_) PV_CHUNK_LD(C5, nrow_, 5); \
    SBP(); PV_CONSUME(B0, C6.w[0], sele0, sele1); \
    if (has_next_) PV_ROW_LD(B0, C0.i.x); \
    SBP(); PV_CONSUME(B1, C6.w[0], selo0, selo1); \
    if (has_next_) PV_ROW_LD(B1, C0.i.y); \
    SBP(); PV_CONSUME(B2, C6.w[1], sele0, sele1); \
    if (has_next_) PV_ROW_LD(B2, C0.i.z); \
    SBP(); PV_CONSUME(B3, C6.w[1], selo0, selo1); \
    if (has_next_) PV_ROW_LD(B3, C0.i.w); \
    if (has_next_) PV_CHUNK_LD(C6, nrow_, 6); \
    SBP(); PV_CONSUME(B4, C7.w[0], sele0, sele1); \
    if (has_next_) PV_ROW_LD(B4, C1.i.x); \
    SBP(); PV_CONSUME(B5, C7.w[0], selo0, selo1); \
    if (has_next_) PV_ROW_LD(B5, C1.i.y); \
    SBP(); PV_CONSUME(B6, C7.w[1], sele0, sele1); \
    if (has_next_) PV_ROW_LD(B6, C1.i.z); \
    SBP(); PV_CONSUME(B7, C7.w[1], selo0, selo1); \
    if (has_next_) PV_ROW_LD(B7, C1.i.w); \
    } while (0)
#undef SBP
}

__device__ __forceinline__ void phase_pv(const Args& a, unsigned char* lds, unsigned* ctl, int xcc) {
    using namespace pv2;
#define SBP() __builtin_amdgcn_sched_barrier(0)
    const int tid = opaque_tid(), wave = __builtin_amdgcn_readfirstlane(tid >> 6), lane = tid & 63;
    volatile LAS unsigned* slot = (volatile LAS unsigned*)((LAS unsigned char*)lds + LDS_MISC) + 2;
    bf16_t* Y = (bf16_t*)(a.ws + WS_Y); const float* WSC = (const float*)(a.ws + WS_W + 12 * MiB);
    const __amdgpu_buffer_rsrc_t RI = __builtin_amdgcn_make_buffer_rsrc((void*)(a.ws + WS_IDX), (short)0, TREAL * 512, 0x00020000);
    const __amdgpu_buffer_rsrc_t RW = __builtin_amdgcn_make_buffer_rsrc((void*)(a.ws + WS_W), (short)0, TREAL * 256, 0x00020000);
    float* ybuf = (float*)lds + wave * 256;
    unsigned char* sidx = lds + 8192 + wave * 4096; unsigned char* swt = lds + 8192 + 32768 + wave * 2048;
    for (int ss = 0; ss < 8; ++ss) {
        const int s = (xcc + ss) & 7;
        const __amdgpu_buffer_rsrc_t V = __builtin_amdgcn_make_buffer_rsrc((void*)(a.ws + WS_V + (size_t)s * (16384 * 256)), (short)0, 16384 * 256, 0x00020000);
        unsigned wdraw = wave_draw(ctl + CW_QPV + 64 * s, lane);
        for (;;) {
            const int item8 = wave_item(wdraw);
            if (item8 >= PX_ITEMS * 8) break;
            wdraw = wave_draw(ctl + CW_QPV + 64 * s, lane);
            int ln = lane; asm volatile("" : "+v"(ln));
            const int g = ln >> 4, n = ln & 15, c16 = n * 16, g128 = g * 128, g64 = g * 64;
            const int r0 = item8 * 8;
            unsigned sele0, sele1, selo0, selo1;
            { const unsigned sh = 8u * (unsigned)(n & 3), keep = ~(255u << sh), se = (unsigned)(n >> 3), so = 2u + se;
              const unsigned ve = (0x0c0c0c0cu & keep) | (se << sh), vo = (0x0c0c0c0cu & keep) | (so << sh);
              const bool d0 = (n & 4) == 0;
              sele0 = d0 ? ve : 0x0c0c0c0cu; sele1 = d0 ? 0x0c0c0c0cu : ve; selo0 = d0 ? vo : 0x0c0c0c0cu; selo1 = d0 ? 0x0c0c0c0cu : vo; }
            Chunk C0, C1, C2, C3, C4, C5, C6, C7; u32x4v B0, B1, B2, B3, B4, B5, B6, B7;
            const float wscv = WSC[r0 + (ln & 7)];
            {
                const u32x4v* gi = (const u32x4v*)(a.ws + WS_IDX + (size_t)r0 * 512) + ln; const u32x4v* gw = (const u32x4v*)(a.ws + WS_W + (size_t)r0 * 256) + ln;
                const u32x4v i0 = gi[0], i1 = gi[64], i2 = gi[128], i3 = gi[192], w0 = gw[0], w1 = gw[64];
                u32x4v* si = (u32x4v*)sidx + ln; u32x4v* sw = (u32x4v*)swt + ln;
                si[0] = i0; si[64] = i1; si[128] = i2; si[192] = i3; sw[0] = w0; sw[64] = w1;
                asm volatile("s_waitcnt lgkmcnt(0)" ::: "memory");
            }
            PV_CHUNK_LD(C0, r0, 0); PV_CHUNK_LD(C1, r0, 1); PV_CHUNK_LD(C2, r0, 2); PV_CHUNK_LD(C3, r0, 3); PV_CHUNK_LD(C4, r0, 4); PV_CHUNK_LD(C5, r0, 5); PV_CHUNK_LD(C6, r0, 6);
            PV_ROW_LD(B0, C0.i.x); PV_ROW_LD(B1, C0.i.y); PV_ROW_LD(B2, C0.i.z); PV_ROW_LD(B3, C0.i.w); PV_ROW_LD(B4, C1.i.x); PV_ROW_LD(B5, C1.i.y); PV_ROW_LD(B6, C1.i.z); PV_ROW_LD(B7, C1.i.w);
#pragma unroll 1
            for (int t = 0; t < 8; ++t) {
                const int row = r0 + t, nrow = row + 1; const bool has_next = t < 7;
                f32x4v acc_lo = {0.f, 0.f, 0.f, 0.f}, acc_hi = {0.f, 0.f, 0.f, 0.f};
                PV_TOKEN_BODY(row, nrow, has_next);
                const float wsc = __uint_as_float(__builtin_amdgcn_readlane(__float_as_uint(wscv), t));
#pragma unroll
                for (int i = 0; i < 4; ++i) {
                    const float lo_ = acc_lo[i] + __uint_as_float(__builtin_amdgcn_update_dpp(0, __float_as_uint(acc_lo[i]), 0x128, 0xf, 0xf, false));
                    const float hi_ = acc_hi[i] + __uint_as_float(__builtin_amdgcn_update_dpp(0, __float_as_uint(acc_hi[i]), 0x128, 0xf, 0xf, false));
                    ybuf[16 * (4 * g + i) + n] = (n < 8 ? lo_ : hi_) * wsc;
                }
                asm volatile("s_waitcnt lgkmcnt(0)" ::: "memory");
                {
                    const float4 yv = ((const float4*)ybuf)[ln];
                    *(uint2*)(Y + (size_t)row * DM + 256 * s + 4 * ln) = make_uint2(pk2(yv.x, yv.y), pk2(yv.z, yv.w));
                }
                asm volatile("s_waitcnt lgkmcnt(0)" ::: "memory");
            }
        }
    }
#undef SBP
}
__device__ __forceinline__ void phase_pn(const Args& a, int bid, int nb) {
    const int tid = opaque_tid(), wave = __builtin_amdgcn_readfirstlane(tid >> 6), lane = tid & 63;
    const bf16_t* Y = (const bf16_t*)(a.ws + WS_Y); const bf16_t* X1 = (const bf16_t*)(a.ws + WS_HN);
    for (int row = bid * NWAVES + wave; row < TREAL; row += nb * NWAVES) {
        f32x4* p = (f32x4*)(a.out + (size_t)row * DM) + lane;
        const uint2* yp = (const uint2*)(Y + (size_t)row * DM) + lane; const uint2* xp = (const uint2*)(X1 + (size_t)row * DM) + lane;
        f32x4 v[8]; float ss = 0.f;
#pragma unroll
        for (int j = 0; j < 8; ++j) { const uint2 yy = yp[64 * j], xx = xp[64 * j];
            v[j][0] = bf_lo(xx.x) + bf_lo(yy.x); v[j][1] = bf_hi(xx.x) + bf_hi(yy.x); v[j][2] = bf_lo(xx.y) + bf_lo(yy.y); v[j][3] = bf_hi(xx.y) + bf_hi(yy.y);
            ss += (v[j][0] * v[j][0] + v[j][1] * v[j][1]) + (v[j][2] * v[j][2] + v[j][3] * v[j][3]); }
        const float r = rsqrtf(wave_sum(ss) * (1.f / DM) + EPS);
        const f32x4* wp = (const f32x4*)a.nfinal + lane;
#pragma unroll
        for (int j = 0; j < 8; ++j) p[64 * j] = v[j] * r * wp[64 * j];
    }
}

__device__ __forceinline__ void phase_mix(const Args& a, unsigned char* lds, unsigned* ctr) {
    const bf16_t* Z = (const bf16_t*)(a.ws + WS_Z); bf16_t* MIX = (bf16_t*)(a.ws + WS_MIX);
    volatile LAS unsigned* slot = (volatile LAS unsigned*)((LAS unsigned char*)lds + LDS_MISC) + 2;
    for (;;) {
        const int item = next_item(ctr, slot);
        if (item >= 64 + 2048) break;
        if (item < 64) mls::mlstm_item(item >> 2, item & 3, a, (char*)lds);
        else { const int k = item - 64, qb = 15 - (k >> 7), bh = k & 127; const float lam = attn_lambda(a); att::attn_unit(bh >> 3, bh & 7, qb, Z, MIX, lam, a.subln, (char*)lds); }
    }
}

__global__ void __launch_bounds__(NTHREADS, 2) mega(Args a) {
    extern __shared__ __attribute__((aligned(16))) unsigned char lds[];
    cg::grid_group grid = cg::this_grid();
    const int bid = blockIdx.x, nb = gridDim.x;
    unsigned char* ws = a.ws;
    bf16_t* WinT = (bf16_t*)(ws + WS_WIN); bf16_t* WoutT = (bf16_t*)(ws + WS_WOUT); bf16_t* WqT = (bf16_t*)(ws + WS_WQ);
    float* rope = (float*)(ws + WS_ROPE); float* SSQ = (float*)(ws + WS_SSQ);
    bf16_t* HN = (bf16_t*)(ws + WS_HN); bf16_t* MIX = (bf16_t*)(ws + WS_MIX); bf16_t* Z = (bf16_t*)(ws + WS_Z);

    volatile LAS unsigned* MISC = (volatile LAS unsigned*)((LAS unsigned char*)lds + LDS_MISC);
    if (threadIdx.x < 16) MISC[threadIdx.x] = 0u;
    __syncthreads();
    unsigned* ctl = (unsigned*)(ws + WS_CTL);
    XcdBarrier bar = xcd_barrier_post(ctl + CW_BAR, MISC);
    phase_prep(a, lds, bid, nb);
    grid.sync();
    { pg8::Gemm g{HN, WinT, MROWS, NZ, DM}; EpiZ E{Z, rope}; pg8::StaticOrder S; S.init(g.M, g.N, nb, bid);
      pg8::gemm_phase<EpiZ, pg8::StaticOrder, true, true>((PG8_LAS unsigned char*)lds, g, S, E); }
    phase_tables(a, lds, ctl);
    xcd_barrier(bar);
    phase_mix(a, lds, ctl + CW_QUEUE);
    xcd_barrier(bar);
    { pg8::Gemm g{MIX, WoutT, TREAL, DM, DM}; EpiX1 E{a.x, HN, SSQ}; pg8::StaticOrder S; S.init(g.M, g.N, nb, bid);
      pg8::gemm_phase<EpiX1, pg8::StaticOrder, true, true>((PG8_LAS unsigned char*)lds, g, S, E); }
    xcd_barrier(bar);
    { pg8::Gemm g{HN, WqT, TREAL, DM, DM}; pg8::EpiBf16<0> E{MIX, DM, nullptr, 0, 0, 1.f}; pg8::StaticOrder S; S.init(g.M, g.N, nb, bid);
      pg8::gemm_phase<pg8::EpiBf16<0>, pg8::StaticOrder, true, true>((PG8_LAS unsigned char*)lds, g, S, E); }
    xcd_barrier(bar);
    phase_route(a, lds, bid, nb);
    xcd_barrier(bar);
    { const int xcc = (int)(xb_xcc_id() & 7u);
      phase_pu(a, lds, ctl, xcc); xcd_barrier(bar);
      phase_pc(a, bid, nb); xcd_barrier(bar);
      phase_pv(a, lds, ctl, xcc); xcd_barrier(bar);
      phase_pn(a, bid, nb); }
}

extern "C" void kernel_launch(void* const* d_in, const int* in_sizes, int n_in, void* d_out, int out_size, void* d_ws, size_t ws_size, hipStream_t stream) {
    if (n_in != 18 || out_size != TREAL * DM || ws_size < WS_END) { fprintf(stderr, "kernel_launch: unexpected shapes n_in %d out %d ws %zu (need %zu)\n", n_in, out_size, ws_size, (size_t)WS_END); return; }
    static int grid_blocks = 0;
    if (!grid_blocks) {
        int dev = 0, cus = 0, per_cu = 0;
        (void)hipGetDevice(&dev);
        (void)hipDeviceGetAttribute(&cus, hipDeviceAttributeMultiprocessorCount, dev);
        (void)hipFuncSetAttribute((const void*)mega, hipFuncAttributeMaxDynamicSharedMemorySize, LDS_BYTES);
        (void)hipOccupancyMaxActiveBlocksPerMultiprocessor(&per_cu, (const void*)mega, NTHREADS, LDS_BYTES);
        if (per_cu < 1) { fprintf(stderr, "kernel_launch: occupancy query says %d blocks/CU\n", per_cu); per_cu = 1; }
        if (per_cu > 1) per_cu = 1;
        grid_blocks = cus * per_cu;
    }
    Args a{};
    a.x = (const float*)d_in[0]; a.meta = (const float*)d_in[1]; a.nmw = (const float*)d_in[2]; a.w_in = (const float*)d_in[3];
    a.lamqk = (const float*)d_in[4]; a.subln = (const float*)d_in[5]; a.convw = (const float*)d_in[6]; a.convb = (const float*)d_in[7];
    a.ib = (const float*)d_in[8]; a.fb = (const float*)d_in[9]; a.mnw = (const float*)d_in[10]; a.w_out = (const float*)d_in[11];
    a.nfw_ffn = (const float*)d_in[12]; a.w_q = (const float*)d_in[13]; a.subkeys = (const float*)d_in[14]; a.pu = (const float*)d_in[15];
    a.pv = (const float*)d_in[16]; a.nfinal = (const float*)d_in[17];
    a.out = (float*)d_out; a.ws = (unsigned char*)d_ws;
    (void)hipMemsetAsync((char*)d_ws + WS_CTL, 0, 65536, stream);
    void* kargs[] = {&a};
    const hipError_t e = hipLaunchCooperativeKernel((const void*)mega, dim3(grid_blocks), dim3(NTHREADS), kargs, LDS_BYTES, stream);
    if (e != hipSuccess) fprintf(stderr, "kernel_launch: cooperative launch failed: %s (grid %d)\n", hipGetErrorString(e), grid_blocks);
}
```

```cpp
#include <hip/hip_runtime.h>
#include <hip/hip_bf16.h>
#include <cstdio>
#include <cstdint>
#include <cmath>
namespace pg8 {
#define PG8_LAS __attribute__((address_space(3)))
typedef unsigned short bf16_t;
typedef short bf16x8 __attribute__((ext_vector_type(8)));
typedef float f32x4 __attribute__((ext_vector_type(4)));
typedef unsigned u32x4 __attribute__((ext_vector_type(4)));
constexpr int BM = 256, BK = 64, HALF = 128, HTB = HALF * BK * 2  , STAGE_BYTES = 8 * HTB, NXCD = 8, WGM = 8;

__host__ __device__ __forceinline__ int lds_byte(int r, int c) { const int st = (r >> 4) * 2 + (c >> 5), rr = r & 15, cc = c & 31, ob = rr * 64 + cc * 2; return st * 1024 + (ob ^ (((ob >> 9) & 1) << 5)); }
__host__ __device__ __forceinline__ void stage_rc(int b, int& R, int& C) { const int st = b / 1024, sb = b % 1024, swz = sb ^ (((sb >> 9) & 1) << 5); R = (st >> 1) * 16 + swz / 64; C = (st & 1) * 32 + (swz % 64) / 2; }
__host__ __device__ __forceinline__ int perm32(int rho) { const int n = rho >> 4, i = rho & 15; return 8 * (i >> 2) + 4 * n + (i & 3); }

struct Unit { int pm, pn; };
struct Gemm { const bf16_t* A; const bf16_t* Bt; int M, N, K; };

struct StaticOrder {
    int nM, nN, nwg, G, c;
    __host__ __device__ void init(int M, int N, int G_, int c_) { nM = M / BM; nN = N / BM; nwg = nM * nN; G = G_; c = c_; }
    __host__ __device__ bool next(int i, Unit& u) const {
        const long L = (long)i * G + c; if (L >= nwg) return false;
        int wgid = (int)L; { const int q = nwg / NXCD, r = nwg % NXCD, xcd = wgid % NXCD, off = wgid / NXCD; wgid = (xcd < r ? xcd * (q + 1) : r * (q + 1) + (xcd - r) * q) + off; }
        const int nig = WGM * nN, gid = wgid / nig, fm = gid * WGM, gsz = (nM - fm) < WGM ? (nM - fm) : WGM;
        u.pm = fm + ((wgid % nig) % gsz); u.pn = (wgid % nig) / gsz; return true;
    }
    __device__ __forceinline__ void a_ready(const Unit&) const {}
    __device__ __forceinline__ void done(const Unit&) const {}
};

__device__ __forceinline__ unsigned cvt_pk_bf16(float lo, float hi) { unsigned r; asm volatile("v_cvt_pk_bf16_f32 %0, %1, %2" : "=v"(r) : "v"(lo), "v"(hi)); return r; }
typedef float f32x2 __attribute__((ext_vector_type(2)));
__device__ __forceinline__ f32x2 gelu_pk(f32x2 v) {
    const f32x2 av = __builtin_elementwise_abs(v), d = av * 0.2316418882f + 1.0f;
    f32x2 t; t.x = __builtin_amdgcn_rcpf(d.x); t.y = __builtin_amdgcn_rcpf(d.y);
    f32x2 q = t * 0.5307027145f + (-0.7265760135f); q = q * t + 0.7107068705f; q = q * t + (-0.142248368f); q = q * t + 0.127414796f; q = q * t;
    const f32x2 s = (v * v) * (-0.72134752044f);
    f32x2 e; e.x = __builtin_amdgcn_exp2f(s.x); e.y = __builtin_amdgcn_exp2f(s.y);
    const f32x2 m = v * (q * e), r = v - m;
    f32x2 o; o.x = v.x < 0.f ? m.x : r.x; o.y = v.y < 0.f ? m.y : r.y; return o;
}

template <int ACT  > struct EpiBf16 {
    static constexpr bool PERM = true, AFTER_DRAIN = false; static_assert(ACT == 0 || ACT == 1, "EpiBf16: ACT is 0 (none) or 1 (gelu_pk)");
    bf16_t* O; int ldc; const float* bias; int split_cols; size_t split_stride; float scale0;
    __device__ __forceinline__ void operator()(const f32x4 (&acc)[2][2][4][2], const Unit& u, int wr, int wc, int fr, int fq) const {
        const int row0 = u.pm * BM + wr * 64 + fr; int colt = u.pn * BM; bf16_t* base = O;
        float sc = 1.f; if (split_cols) { const int t = colt / split_cols; base += (size_t)t * split_stride; colt -= t * split_cols; if (t == 0) sc = scale0; }
        const int col0 = colt + wc * 32 + 8 * fq, bcol0 = u.pn * BM + wc * 32 + 8 * fq;
        f32x4 bv[2][2];
#pragma unroll
        for (int bj = 0; bj < 2; ++bj)
#pragma unroll
            for (int n = 0; n < 2; ++n) bv[bj][n] = bias ? *(const f32x4*)(bias + bcol0 + bj * HALF + 4 * n) : (f32x4){0.f, 0.f, 0.f, 0.f};
#pragma unroll
        for (int ai = 0; ai < 2; ++ai)
#pragma unroll
            for (int m = 0; m < 4; ++m) { bf16_t* rowp = base + (size_t)(row0 + ai * HALF + m * 16) * ldc + col0;
#pragma unroll
                for (int bj = 0; bj < 2; ++bj) { f32x4 v0 = acc[ai][bj][m][0] + bv[bj][0], v1 = acc[ai][bj][m][1] + bv[bj][1];
                    if (ACT == 1) { f32x2 a = gelu_pk((f32x2){v0[0], v0[1]}), b = gelu_pk((f32x2){v0[2], v0[3]}), c = gelu_pk((f32x2){v1[0], v1[1]}), d = gelu_pk((f32x2){v1[2], v1[3]});
                        v0 = (f32x4){a.x, a.y, b.x, b.y}; v1 = (f32x4){c.x, c.y, d.x, d.y}; }
                    v0 = v0 * sc; v1 = v1 * sc; u32x4 w; w.x = cvt_pk_bf16(v0[0], v0[1]); w.y = cvt_pk_bf16(v0[2], v0[3]); w.z = cvt_pk_bf16(v1[0], v1[1]); w.w = cvt_pk_bf16(v1[2], v1[3]);
                    *(u32x4*)(rowp + bj * HALF) = w; } }
    }
};
template <class Epi, class Sched, bool ALIGN_EPI = false, bool SP2 = false>
__device__ __forceinline__ void gemm_phase(PG8_LAS unsigned char* lds, const Gemm g, const Sched& S, const Epi& E) {
    int tid_ = threadIdx.x; asm volatile("" : "+v"(tid_));
    const int tid = tid_, wid = __builtin_amdgcn_readfirstlane(tid >> 6), lane = tid & 63, wr = wid >> 2, wc = wid & 3, fr = lane & 15, fq = lane >> 4;
    const int K = g.K, nt = K / BK;
    unsigned voffA[2], voffB[2];
#pragma unroll
    for (int i = 0; i < 2; ++i) { int R, C; stage_rc(tid * 16 + i * 8192, R, C); const int Rb = Epi::PERM ? ((R & ~31) + perm32(R & 31)) : R;
        voffA[i] = (unsigned)(R * K + C) * 2u; voffB[i] = (unsigned)(Rb * K + C) * 2u; }
    const size_t kstep = (size_t)(BK * 2);
    const size_t hstep = (size_t)HALF * K * 2;
    const size_t tstep = 2 * hstep;
    const unsigned ldsw = (unsigned)wid * 1024u;
    const int aoff = lds_byte(wr * 64 + fr, fq * 8), boff = lds_byte(wc * 32 + fr, fq * 8);
#define PG8_SA(b, h) (((b) * 2 + (h)) * HTB)
#define PG8_SB(b, h) ((4 + (b) * 2 + (h)) * HTB)
#define PG8_STAGE(bufoff, gbase, voff) do { _Pragma("unroll") for (int _i = 0; _i < 2; ++_i) \
        __builtin_amdgcn_global_load_lds((const unsigned*)((const char*)(gbase) + (voff)[_i]), (PG8_LAS unsigned*)(lds + (bufoff) + ldsw + _i * 8192), 16, 0, 0); } while (0)
#define PG8_LDA(dst, b, h) do { _Pragma("unroll") for (int m = 0; m < 4; ++m) _Pragma("unroll") for (int k = 0; k < 2; ++k) dst[m][k] = *(const PG8_LAS bf16x8*)(lds + PG8_SA(b, h) + aoff + m * 2048 + k * 1024); } while (0)
#define PG8_LDB(dst, b, h) do { _Pragma("unroll") for (int n = 0; n < 2; ++n) _Pragma("unroll") for (int k = 0; k < 2; ++k) dst[n][k] = *(const PG8_LAS bf16x8*)(lds + PG8_SB(b, h) + boff + n * 2048 + k * 1024); } while (0)
#define PG8_MMA(ai, bj, At, Bt) do { __builtin_amdgcn_s_setprio(1); _Pragma("unroll") for (int m = 0; m < 4; ++m) _Pragma("unroll") for (int n = 0; n < 2; ++n) _Pragma("unroll") for (int k = 0; k < 2; ++k) \
        acc[ai][bj][m][n] = __builtin_amdgcn_mfma_f32_16x16x32_bf16(Bt[n][k], At[m][k], acc[ai][bj][m][n], 0, 0, 0); __builtin_amdgcn_s_setprio(0); } while (0)
#define PG8_WAIT_V(n) asm volatile("s_waitcnt vmcnt(" #n ")" ::: "memory")
#define PG8_WAIT_L(n) asm volatile("s_waitcnt lgkmcnt(" #n ")" ::: "memory")
#define PG8_BAR __builtin_amdgcn_s_barrier()
#define PG8_SCHED __builtin_amdgcn_sched_barrier(0)
    Unit cur, nxt; int ui = 0;
    if (!S.next(0, cur)) return;
    f32x4 acc[2][2][4][2];
#pragma unroll
    for (int a = 0; a < 2; ++a)
#pragma unroll
        for (int b = 0; b < 2; ++b)
#pragma unroll
            for (int m = 0; m < 4; ++m)
#pragma unroll
                for (int n = 0; n < 2; ++n) acc[a][b][m][n] = (f32x4){0.f, 0.f, 0.f, 0.f};
    bf16x8 At[4][2], B0[2][2], B1[2][2];
    const char* cA = (const char*)g.A + (size_t)cur.pm * tstep; const char* cB = (const char*)g.Bt + (size_t)cur.pn * tstep;
    S.a_ready(cur);
    if constexpr (SP2) {
        PG8_STAGE(PG8_SB(0, 0), cB, voffB); PG8_STAGE(PG8_SB(0, 1), cB + hstep, voffB); PG8_STAGE(PG8_SA(0, 0), cA, voffA); PG8_STAGE(PG8_SA(0, 1), cA + hstep, voffA);
        if (wr == 1) PG8_BAR;
        PG8_WAIT_V(2); PG8_BAR;
        PG8_STAGE(PG8_SB(1, 0), cB + kstep, voffB); PG8_STAGE(PG8_SA(1, 0), cA + kstep, voffA); PG8_STAGE(PG8_SB(1, 1), cB + hstep + kstep, voffB);
        PG8_WAIT_V(6); PG8_BAR;
    } else {
        PG8_STAGE(PG8_SB(0, 0), cB, voffB); PG8_STAGE(PG8_SA(0, 0), cA, voffA); PG8_STAGE(PG8_SB(0, 1), cB + hstep, voffB); PG8_STAGE(PG8_SA(0, 1), cA + hstep, voffA);
        if (wr == 1) PG8_BAR;
        PG8_WAIT_V(4); PG8_BAR;
        PG8_STAGE(PG8_SB(1, 0), cB + kstep, voffB); PG8_STAGE(PG8_SA(1, 0), cA + kstep, voffA); PG8_STAGE(PG8_SB(1, 1), cB + hstep + kstep, voffB);
        PG8_WAIT_V(6); PG8_BAR;
    }
    for (;;) {
        const bool has_next = S.next(ui + 1, nxt);
        const char* nA = has_next ? (const char*)g.A + (size_t)nxt.pm * tstep : cA; const char* nB = has_next ? (const char*)g.Bt + (size_t)nxt.pn * tstep : cB;
        for (int t = 0; t < nt; t += 2) {
            const bool last = (t == nt - 2);
            const char* a1 = cA + (size_t)(t + 1) * kstep;
            const char* a2 = last ? nA : cA + (size_t)(t + 2) * kstep; const char* b2 = last ? nB : cB + (size_t)(t + 2) * kstep;
            const char* a3 = a2 + kstep; const char* b3 = b2 + kstep;
            if (last && has_next) S.a_ready(nxt);
            if constexpr (SP2) {
            PG8_LDB(B0, 0, 0); PG8_LDB(B1, 0, 1); PG8_SCHED; PG8_LDA(At, 0, 0); PG8_STAGE(PG8_SA(1, 1), a1 + hstep, voffA);
            PG8_WAIT_V(8); PG8_WAIT_L(0); PG8_BAR; PG8_MMA(0, 0, At, B0); PG8_MMA(0, 1, At, B1); PG8_BAR; PG8_SCHED;
            PG8_LDA(At, 0, 1); PG8_STAGE(PG8_SB(0, 0), b2, voffB); PG8_STAGE(PG8_SB(0, 1), b2 + hstep, voffB); PG8_STAGE(PG8_SA(0, 0), a2, voffA);
            PG8_WAIT_V(8); PG8_WAIT_L(0); PG8_BAR; PG8_MMA(1, 0, At, B0); PG8_MMA(1, 1, At, B1); PG8_BAR; PG8_SCHED;
            PG8_LDB(B0, 1, 0); PG8_LDB(B1, 1, 1); PG8_SCHED; PG8_LDA(At, 1, 0); PG8_STAGE(PG8_SA(0, 1), a2 + hstep, voffA);
            PG8_WAIT_V(8); PG8_WAIT_L(0); PG8_BAR; PG8_MMA(0, 0, At, B0); PG8_MMA(0, 1, At, B1); PG8_BAR; PG8_SCHED;
            PG8_LDA(At, 1, 1); PG8_STAGE(PG8_SB(1, 0), b3, voffB); PG8_STAGE(PG8_SB(1, 1), b3 + hstep, voffB); PG8_STAGE(PG8_SA(1, 0), a3, voffA);
            PG8_WAIT_V(8); PG8_WAIT_L(0); PG8_BAR; PG8_MMA(1, 0, At, B0); PG8_MMA(1, 1, At, B1); PG8_BAR; PG8_SCHED;
            } else {
            PG8_LDB(B0, 0, 0); PG8_SCHED; PG8_LDA(At, 0, 0); PG8_STAGE(PG8_SA(1, 1), a1 + hstep, voffA);
            PG8_WAIT_L(8); PG8_BAR; PG8_WAIT_L(0); PG8_MMA(0, 0, At, B0); PG8_BAR; PG8_SCHED;
            PG8_LDB(B1, 0, 1); PG8_STAGE(PG8_SB(0, 0), b2, voffB);
            PG8_BAR; PG8_WAIT_L(0); PG8_MMA(0, 1, At, B1); PG8_BAR;
            PG8_LDA(At, 0, 1); PG8_STAGE(PG8_SA(0, 0), a2, voffA);
            PG8_BAR; PG8_WAIT_L(0); PG8_MMA(1, 0, At, B0); PG8_BAR; PG8_SCHED;
            PG8_STAGE(PG8_SB(0, 1), b2 + hstep, voffB);
            PG8_WAIT_V(6); PG8_BAR; PG8_MMA(1, 1, At, B1); PG8_BAR;
            PG8_LDB(B0, 1, 0); PG8_SCHED; PG8_LDA(At, 1, 0); PG8_STAGE(PG8_SA(0, 1), a2 + hstep, voffA);
            PG8_WAIT_L(8); PG8_BAR; PG8_WAIT_L(0); PG8_MMA(0, 0, At, B0); PG8_BAR; PG8_SCHED;
            PG8_LDB(B1, 1, 1); PG8_STAGE(PG8_SB(1, 0), b3, voffB);
            PG8_BAR; PG8_WAIT_L(0); PG8_MMA(0, 1, At, B1); PG8_BAR;
            PG8_LDA(At, 1, 1); PG8_STAGE(PG8_SA(1, 0), a3, voffA);
            PG8_BAR; PG8_WAIT_L(0); PG8_MMA(1, 0, At, B0); PG8_BAR; PG8_SCHED;
            PG8_STAGE(PG8_SB(1, 1), b3 + hstep, voffB);
            PG8_WAIT_V(6); PG8_BAR; PG8_MMA(1, 1, At, B1); PG8_BAR;
            }
        }
        if constexpr (ALIGN_EPI) { if (wr == 0) PG8_BAR; }
        if constexpr (!Epi::AFTER_DRAIN) { E(acc, cur, wr, wc, fr, fq); S.done(cur); }
        if (!has_next) break;
#pragma unroll
        for (int a = 0; a < 2; ++a)
#pragma unroll
            for (int b = 0; b < 2; ++b)
#pragma unroll
                for (int m = 0; m < 4; ++m)
#pragma unroll
                    for (int n = 0; n < 2; ++n) acc[a][b][m][n] = (f32x4){0.f, 0.f, 0.f, 0.f};
        cur = nxt; cA = nA; cB = nB; ++ui;
        if constexpr (ALIGN_EPI) { if (wr == 1) PG8_BAR; }
    }
    PG8_WAIT_V(0);
    if constexpr (!ALIGN_EPI) { if (wr == 0) PG8_BAR; }
    PG8_BAR;
    if constexpr (Epi::AFTER_DRAIN) { E.fused(acc, cur, wr, wc, fr, fq, lds, wid, lane); S.done(cur); }
#undef PG8_SA
#undef PG8_SB
#undef PG8_STAGE
#undef PG8_LDA
#undef PG8_LDB
#undef PG8_MMA
#undef PG8_WAIT_V
#undef PG8_WAIT_L
#undef PG8_BAR
#undef PG8_SCHED
}
}

constexpr int BATCH = 16, SEQ = 2048, DM = 2048, NMETA = 16;
constexpr int TREAL = BATCH * SEQ;
constexpr int MROWS = 33024;
constexpr int META_TILE0 = 32768;
constexpr int META_ROW0 = 32816;
constexpr int NZ = 6144;
constexpr int ZQ = 0, ZK = 1024, ZV = 2048, ZMQ = 3072, ZMK = 3584, ZMV = 4096, ZMO = 5120;
constexpr int INCOLS = 6152;
constexpr float EPS = 1e-6f;
constexpr float QSCALE = 0.125f * 1.4426950408889634f;
constexpr float LAMBDA_INIT = 0.2f;

typedef unsigned short bf16_t;
typedef float f32x4 __attribute__((ext_vector_type(4)));
typedef __bf16 bf16x2_t __attribute__((ext_vector_type(2)));

constexpr size_t MiB = 1u << 20;
constexpr size_t WS_CTL = 0;
constexpr size_t WS_RINV = 819200;
constexpr size_t WS_ISC = 655360;
constexpr size_t WS_SKB = 65536;
constexpr size_t WS_WIN = 1 * MiB;
constexpr size_t WS_WOUT = 25 * MiB;
constexpr size_t WS_WQ = 33 * MiB;
constexpr size_t WS_ROPE = 41 * MiB;
constexpr size_t WS_GATES = 42 * MiB;
constexpr size_t WS_SSQ = 44 * MiB;
constexpr size_t WS_IDX = 48 * MiB;
constexpr size_t WS_GATE = 64 * MiB;
constexpr size_t WS_U = 80 * MiB;
constexpr size_t WS_V = 144 * MiB;
constexpr size_t WS_HN = 208 * MiB;
constexpr size_t WS_MIX = 338 * MiB;
constexpr size_t WS_Z = 466 * MiB;
constexpr size_t WS_END = 854 * MiB;

__device__ __forceinline__ float bf_lo(unsigned w) { return __uint_as_float(w << 16); }
__device__ __forceinline__ float bf_hi(unsigned w) { return __uint_as_float(w & 0xffff0000u); }
__device__ __forceinline__ float bf2f(bf16_t v) { return __uint_as_float(((unsigned)v) << 16); }
__device__ __forceinline__ unsigned f2bf(float f) { unsigned r; asm("v_cvt_pk_bf16_f32 %0, %1, 0" : "=v"(r) : "v"(f)); return r; }
__device__ __forceinline__ unsigned pk2(float lo, float hi) { unsigned r; asm("v_cvt_pk_bf16_f32 %0, %1, %2" : "=v"(r) : "v"(lo), "v"(hi)); return r; }
__device__ __forceinline__ float dot2(unsigned a, unsigned b, float acc) { return __builtin_amdgcn_fdot2_f32_bf16(__builtin_bit_cast(bf16x2_t, a), __builtin_bit_cast(bf16x2_t, b), acc, false); }
__device__ __forceinline__ float wave_sum(float v) {
#pragma unroll
    for (int o = 1; o < 64; o <<= 1) v += __shfl_xor(v, o);
    return v;
}
__device__ __forceinline__ float wave_max(float v) {
#pragma unroll
    for (int o = 1; o < 64; o <<= 1) v = fmaxf(v, __shfl_xor(v, o));
    return v;
}
__device__ __forceinline__ int zrow_of(int b, int l) { return l < NMETA ? META_ROW0 + l : b * SEQ + (l - NMETA); }

struct EpiZ {
    static constexpr bool PERM = true, AFTER_DRAIN = false;
    bf16_t* Z; const float* rope;
    __device__ __forceinline__ void operator()(const pg8::f32x4 (&acc)[2][2][4][2], const pg8::Unit& u, int wr, int wc, int fr, int fq) const {
        const int row0 = u.pm * 256 + wr * 64 + fr, col0 = u.pn * 256 + wc * 32 + 8 * fq;
        const bool isq = u.pn < 4, isrope = u.pn < 8;
        const int j0 = 16 * (wc & 1) + 4 * fq;
#pragma unroll
        for (int ai = 0; ai < 2; ++ai)
#pragma unroll
            for (int m = 0; m < 4; ++m) {
                const int row = row0 + ai * 128 + m * 16;
                pg8::f32x4 c0 = {1.f, 0.f, 1.f, 0.f}, c1 = {1.f, 0.f, 1.f, 0.f};
                if (isrope) {
                    const int pos = row < TREAL ? (row & (SEQ - 1)) + NMETA : ((row >= META_ROW0 && row < META_ROW0 + NMETA) ? row - META_ROW0 : 0);
                    const pg8::f32x4* tp = (const pg8::f32x4*)(rope + ((size_t)pos * 32 + j0) * 2);
                    c0 = tp[0]; c1 = tp[1];
                }
                bf16_t* rowp = Z + (size_t)row * NZ + col0;
#pragma unroll
                for (int bj = 0; bj < 2; ++bj) {
                    pg8::f32x4 v0 = acc[ai][bj][m][0], v1 = acc[ai][bj][m][1];
                    if (isrope) {
                        pg8::f32x4 o0, o1;
                        o0[0] = v0[0] * c0[0] - v0[1] * c0[1]; o0[1] = v0[1] * c0[0] + v0[0] * c0[1];
                        o0[2] = v0[2] * c0[2] - v0[3] * c0[3]; o0[3] = v0[3] * c0[2] + v0[2] * c0[3];
                        o1[0] = v1[0] * c1[0] - v1[1] * c1[1]; o1[1] = v1[1] * c1[0] + v1[0] * c1[1];
                        o1[2] = v1[2] * c1[2] - v1[3] * c1[3]; o1[3] = v1[3] * c1[2] + v1[2] * c1[3];
                        v0 = o0; v1 = o1;
                        if (isq) { v0 = v0 * QSCALE; v1 = v1 * QSCALE; }
                    }
                    pg8::u32x4 w; w.x = pg8::cvt_pk_bf16(v0[0], v0[1]); w.y = pg8::cvt_pk_bf16(v0[2], v0[3]); w.z = pg8::cvt_pk_bf16(v1[0], v1[1]); w.w = pg8::cvt_pk_bf16(v1[2], v1[3]);
                    *(pg8::u32x4*)(rowp + bj * 128) = w;
                }
            }
    }
};
struct EpiX1 {
    static constexpr bool PERM = true, AFTER_DRAIN = false;
    bf16_t* x1b; const float* rinv; float* ssq;
    struct Row { pg8::u32x4 h[2]; float ri; };
    __device__ __forceinline__ void loadr(Row& rb, int row0, int col0, int i) const {
        const int row = row0 + (i >> 2) * 128 + (i & 3) * 16;
#pragma unroll
        for (int bj = 0; bj < 2; ++bj) rb.h[bj] = *(const pg8::u32x4*)(x1b + (size_t)row * DM + col0 + bj * 128);
        rb.ri = rinv[row];
    }
    __device__ __forceinline__ void procr(const pg8::f32x4 (&acc)[2][2][4][2], const Row& rb, int row0, int col0, int i, int pn, int wc, int fq) const {
        const int ai = i >> 2, m = i & 3;
        const int row = row0 + ai * 128 + m * 16; float ss = 0.f;
#pragma unroll
        for (int bj = 0; bj < 2; ++bj) {
            const size_t off = (size_t)row * DM + col0 + bj * 128;
            const pg8::f32x4 x0 = {bf_lo(rb.h[bj].x), bf_hi(rb.h[bj].x), bf_lo(rb.h[bj].y), bf_hi(rb.h[bj].y)}, x1 = {bf_lo(rb.h[bj].z), bf_hi(rb.h[bj].z), bf_lo(rb.h[bj].w), bf_hi(rb.h[bj].w)};
            const pg8::f32x4 v0 = acc[ai][bj][m][0] + x0 * rb.ri, v1 = acc[ai][bj][m][1] + x1 * rb.ri;
            ss += (v0[0] * v0[0] + v0[1] * v0[1]) + (v0[2] * v0[2] + v0[3] * v0[3]) + (v1[0] * v1[0] + v1[1] * v1[1]) + (v1[2] * v1[2] + v1[3] * v1[3]);
            pg8::u32x4 w; w.x = pg8::cvt_pk_bf16(v0[0], v0[1]); w.y = pg8::cvt_pk_bf16(v0[2], v0[3]); w.z = pg8::cvt_pk_bf16(v1[0], v1[1]); w.w = pg8::cvt_pk_bf16(v1[2], v1[3]);
            *(pg8::u32x4*)(x1b + off) = w;
        }
        ss += __shfl_xor(ss, 16); ss += __shfl_xor(ss, 32);
        if (fq == 0) ssq[(size_t)row * 32 + pn * 4 + wc] = ss;
    }
    __device__ __forceinline__ void operator()(const pg8::f32x4 (&acc)[2][2][4][2], const pg8::Unit& u, int wr, int wc, int fr, int fq) const {
        const int row0 = u.pm * 256 + wr * 64 + fr, col0 = u.pn * 256 + wc * 32 + 8 * fq;
        Row b0, b1, b2;
        loadr(b0, row0, col0, 0); loadr(b1, row0, col0, 1); loadr(b2, row0, col0, 2);
        procr(acc, b0, row0, col0, 0, u.pn, wc, fq); loadr(b0, row0, col0, 3);
        procr(acc, b1, row0, col0, 1, u.pn, wc, fq); loadr(b1, row0, col0, 4);
        procr(acc, b2, row0, col0, 2, u.pn, wc, fq); loadr(b2, row0, col0, 5);
        procr(acc, b0, row0, col0, 3, u.pn, wc, fq); loadr(b0, row0, col0, 6);
        procr(acc, b1, row0, col0, 4, u.pn, wc, fq); loadr(b1, row0, col0, 7);
        procr(acc, b2, row0, col0, 5, u.pn, wc, fq);
        procr(acc, b0, row0, col0, 6, u.pn, wc, fq);
        procr(acc, b1, row0, col0, 7, u.pn, wc, fq);
    }
};


#include <hip/hip_cooperative_groups.h>
namespace cg = cooperative_groups;

constexpr int NWAVES = 8, NTHREADS = 512;
constexpr size_t WS_X1Q = WS_Z + 300 * MiB, WS_XSC = WS_Z + 370 * MiB;
__device__ __forceinline__ int opaque_tid() { int t = threadIdx.x; asm volatile("" : "+v"(t)); return t; }
constexpr int LDS_BYTES = 163840;

struct Args {
    const float *x, *meta, *nmw, *w_in, *lamqk, *subln, *convw, *convb, *ib, *fb, *mnw, *w_out, *nfw_ffn, *w_q, *subkeys, *pu, *pv, *nfinal;
    float* out; unsigned char* ws;
};

#define LAS __attribute__((address_space(3)))
#define XB_TMO      128
#define XB_XCNT(j)  (256  + 64 * (j))
#define XB_XSUB(j)  (1280 + 64 * (j))
#define XB_XGEN(j)  (2304 + 64 * (j))
#define XB_TOP      3328
#define XB_TOPGEN   3392
#define XCD_BAR_WORDS 3456
#define XB_SPIN_CAP (1u << 18)

__device__ __forceinline__ unsigned xb_ld(unsigned* p)              { return __hip_atomic_load(p, __ATOMIC_RELAXED, __HIP_MEMORY_SCOPE_AGENT); }
__device__ __forceinline__ unsigned xb_add(unsigned* p, unsigned v) { return __hip_atomic_fetch_add(p, v, __ATOMIC_RELAXED, __HIP_MEMORY_SCOPE_AGENT); }
__device__ __forceinline__ unsigned xb_xcc_id() { return (unsigned)__builtin_amdgcn_s_getreg((3 << 11) | 20) & 0xFu; }
#define XB_SPIN(cond, bar) do { unsigned _sp = 0; while (cond) { __builtin_amdgcn_s_sleep(1); \
    if ((++_sp & 255u) == 0u) { if (xb_ld(&(bar)[XB_TMO])) break; if (_sp > XB_SPIN_CAP) { atomicAdd(&(bar)[XB_TMO], 1u); break; } } } } while (0)

struct XcdBarrier {
    unsigned* bar; unsigned x;
    volatile LAS unsigned* st;
};

__device__ __forceinline__ XcdBarrier xcd_barrier_post(unsigned* bar, volatile LAS unsigned* st) {
    XcdBarrier b; b.bar = bar; b.x = xb_xcc_id(); b.st = st;
    if (threadIdx.x == 0) (void)xb_add(&bar[XB_XCNT(b.x)], 1u);
    return b;
}
__device__ __forceinline__ void xcd_barrier_complete(unsigned* bar, unsigned x, unsigned& nloc, unsigned& nx) {
    const unsigned G = gridDim.x * gridDim.y * gridDim.z;
    unsigned sum, cnt, mine, sp = 0u;
    for (;;) {
        sum = 0u; cnt = 0u; mine = 0u;
#pragma unroll
        for (unsigned j = 0; j < 16; ++j) { const unsigned c = xb_ld(&bar[XB_XCNT(j)]); sum += c; cnt += (c > 0u) ? 1u : 0u; mine = (j == x) ? c : mine; }
        if (sum == G) break;
        __builtin_amdgcn_s_sleep(1);
        if ((++sp & 255u) == 0u) { if (xb_ld(&bar[XB_TMO])) break; if (sp > XB_SPIN_CAP) { atomicAdd(&bar[XB_TMO], 1u); break; } }
    }
    nloc = mine > 0u ? mine : 1u; nx = cnt > 0u ? cnt : 1u;
}

__device__ __forceinline__ void xcd_barrier(const XcdBarrier& b) {
    asm volatile("s_waitcnt vmcnt(0)" ::: "memory");
    __syncthreads();
    if (threadIdx.x == 0) {
        unsigned* bar = b.bar;
        __builtin_amdgcn_s_waitcnt(0);
        unsigned nloc = b.st[0], nx = b.st[1];
        if (nloc == 0u) { xcd_barrier_complete(bar, b.x, nloc, nx); b.st[0] = nloc; b.st[1] = nx; }
        const unsigned old = xb_add(&bar[XB_XSUB(b.x)], 1u);
        const unsigned gen = old / nloc;
        if (old + 1u == (gen + 1u) * nloc) {
            __builtin_amdgcn_fence(__ATOMIC_RELEASE, "agent");
            asm volatile("s_waitcnt vmcnt(0)" ::: "memory");
            const unsigned og = xb_add(&bar[XB_TOP], 1u);
            const unsigned tg = og / nx;
            if (og + 1u == (tg + 1u) * nx) xb_add(&bar[XB_TOPGEN], 1u);
            else XB_SPIN(xb_ld(&bar[XB_TOPGEN]) == tg, bar);
            __builtin_amdgcn_fence(__ATOMIC_ACQUIRE, "agent");
            xb_add(&bar[XB_XGEN(b.x)], 1u);
            asm volatile("s_waitcnt vmcnt(0)" ::: "memory");
        } else {
            XB_SPIN(xb_ld(&bar[XB_XGEN(b.x)]) == gen, bar);
            __builtin_amdgcn_fence(__ATOMIC_ACQUIRE, "agent");
            asm volatile("s_waitcnt vmcnt(0)" ::: "memory");
        }
    }
    __syncthreads();
}

constexpr int CW_BAR = 0, CW_QUEUE = 4096;
constexpr int LDS_MISC = LDS_BYTES - 256;
__device__ __forceinline__ unsigned wave_draw(unsigned* ctr, int lane) {
    unsigned v = 0u;
    if (lane == 0) v = __hip_atomic_fetch_add(ctr, 1u, __ATOMIC_RELAXED, __HIP_MEMORY_SCOPE_AGENT);
    return v;
}
__device__ __forceinline__ int wave_item(unsigned v) { return (int)__builtin_amdgcn_readfirstlane(v); }
__device__ __forceinline__ int next_item(unsigned* ctr, volatile LAS unsigned* slot) {
    __syncthreads();
    if (threadIdx.x == 0) *slot = __hip_atomic_fetch_add(ctr, 1u, __ATOMIC_RELAXED, __HIP_MEMORY_SCOPE_AGENT);
    __syncthreads();
    return (int)*slot;
}

__device__ __forceinline__ void transpose_item(const float* W, int ldw, int K, int N, bf16_t* WT, bool ropeperm, float* scr, int item, int lane, const float* kscale = nullptr) {
    const int nblk = N / 32, kb = item / nblk, nb = item % nblk, k0 = 64 * kb, n0 = 32 * nb;
#pragma unroll
    for (int i = 0; i < 8; ++i) { const int kk = 8 * i + (lane >> 3), n4 = 4 * (lane & 7); const float ks = kscale ? kscale[k0 + kk] : 1.f;
        const f32x4 v = *(const f32x4*)(W + (size_t)(k0 + kk) * ldw + n0 + n4);
        scr[kk * 33 + n4] = v[0] * ks; scr[kk * 33 + n4 + 1] = v[1] * ks; scr[kk * 33 + n4 + 2] = v[2] * ks; scr[kk * 33 + n4 + 3] = v[3] * ks; }
    __builtin_amdgcn_s_waitcnt(0xC07F); asm volatile("" ::: "memory");
    const int c = lane & 7;
#pragma unroll
    for (int j = 0; j < 4; ++j) {
        const int n = (lane >> 3) + 8 * j; const float* s = scr + (8 * c) * 33 + n;
        uint4 o; o.x = pk2(s[0 * 33], s[1 * 33]); o.y = pk2(s[2 * 33], s[3 * 33]); o.z = pk2(s[4 * 33], s[5 * 33]); o.w = pk2(s[6 * 33], s[7 * 33]);
        int orow = n0 + n;
        if (ropeperm && n0 < 2048) orow = (n0 & ~63) + 2 * n + ((n0 >> 5) & 1);
        *(uint4*)(WT + (size_t)orow * K + k0 + 8 * c) = o;
    }
    __builtin_amdgcn_s_waitcnt(0xC07F); asm volatile("" ::: "memory");
}

__device__ __forceinline__ void hn_row(const f32x4 (&nw)[8], bf16_t* HN, float* G, float* RINV, const float* WG, int r, const f32x4 (&v)[8], int lane) {
    float ss = 0.f;
#pragma unroll
    for (int j = 0; j < 8; ++j) ss += (v[j][0] * v[j][0] + v[j][1] * v[j][1]) + (v[j][2] * v[j][2] + v[j][3] * v[j][3]);
    const float msq = wave_sum(ss) * (1.f / DM) + EPS; const float rstd = rsqrtf(msq);
    if (lane == 0) RINV[r] = sqrtf(msq);
    float g[8];
#pragma unroll
    for (int k = 0; k < 8; ++k) g[k] = 0.f;
    unsigned long long* o8 = (unsigned long long*)(HN + (size_t)r * DM) + lane;
#pragma unroll
    for (int j = 0; j < 8; ++j) {
        const f32x4 yn = v[j] * rstd; const f32x4 y = yn * nw[j];
        o8[64 * j] = (unsigned long long)pk2(yn[0], yn[1]) | ((unsigned long long)pk2(yn[2], yn[3]) << 32);
#pragma unroll
        for (int k = 0; k < 8; ++k) { const f32x4 wg = ((const f32x4*)(WG + k * 2048))[64 * j + lane]; g[k] += (y[0] * wg[0] + y[1] * wg[1]) + (y[2] * wg[2] + y[3] * wg[3]); }
        __builtin_amdgcn_sched_barrier(0);
    }
    float r4[4], r2[2], r1;
    { const bool hb = (lane & 32) != 0;
#pragma unroll
      for (int i = 0; i < 4; ++i) { const float send = hb ? g[i] : g[i + 4]; const float recv = __shfl_xor(send, 32); r4[i] = (hb ? g[i + 4] : g[i]) + recv; } }
    { const bool hb = (lane & 16) != 0;
#pragma unroll
      for (int i = 0; i < 2; ++i) { const float send = hb ? r4[i] : r4[i + 2]; const float recv = __shfl_xor(send, 16); r2[i] = (hb ? r4[i + 2] : r4[i]) + recv; } }
    { const bool hb = (lane & 8) != 0; const float send = hb ? r2[0] : r2[1]; const float recv = __shfl_xor(send, 8); r1 = (hb ? r2[1] : r2[0]) + recv; }
    r1 += __shfl_xor(r1, 4); r1 += __shfl_xor(r1, 2); r1 += __shfl_xor(r1, 1);
    if ((lane & 7) == 0) G[(size_t)r * 8 + ((lane >> 5) & 1) * 4 + ((lane >> 4) & 1) * 2 + ((lane >> 3) & 1)] = r1;
}

__device__ __forceinline__ void phase_prep(const Args& a, unsigned char* lds, int bid, int nb) {
    const int tid = opaque_tid(), lane = tid & 63, wave = tid >> 6;
    const int gw = bid * NWAVES + wave, NGW = nb * NWAVES;
    unsigned char* ws = a.ws;
    bf16_t* WinT = (bf16_t*)(ws + WS_WIN); bf16_t* WoutT = (bf16_t*)(ws + WS_WOUT); bf16_t* WqT = (bf16_t*)(ws + WS_WQ);
    bf16_t* U = (bf16_t*)(ws + WS_U); bf16_t* V = (bf16_t*)(ws + WS_V); bf16_t* HN = (bf16_t*)(ws + WS_HN);
    float* G = (float*)(ws + WS_GATES); float* rope = (float*)(ws + WS_ROPE); float* RINV = (float*)(ws + WS_RINV);
    float* scr = (float*)lds + wave * (64 * 33);
    float* WG = (float*)(lds + 8 * 64 * 33 * 4);
    {
        float wgv[32];
#pragma unroll
        for (int j = 0; j < 32; ++j) { const int i = tid + NTHREADS * j; wgv[j] = a.w_in[(size_t)(i >> 3) * INCOLS + 6144 + (i & 7)]; }
#pragma unroll
        for (int j = 0; j < 32; ++j) { const int i = tid + NTHREADS * j; WG[(i & 7) * 2048 + (i >> 3)] = wgv[j]; }
    }
    __syncthreads();
    constexpr int I_IN = 32 * 192, I_OUT = 32 * 64, I_Q = 32 * 64;
    for (int it = gw; it < I_IN + I_OUT + I_Q; it += NGW) {
        int r = it;
        if (r < I_IN) { transpose_item(a.w_in, INCOLS, 2048, 6144, WinT, true, scr, r, lane, a.nmw); continue; } r -= I_IN;
        if (r < I_OUT) { transpose_item(a.w_out, 2048, 2048, 2048, WoutT, false, scr, r, lane); continue; } r -= I_OUT;
        transpose_item(a.w_q, 2048, 2048, 2048, WqT, false, scr, r, lane, a.nfw_ffn);
    }
    f32x4 nw[8];
#pragma unroll
    for (int j = 0; j < 8; ++j) nw[j] = ((const f32x4*)a.nmw)[64 * j + lane];
    {
        f32x4 vc[8], vn[8];
#pragma unroll
        for (int j = 0; j < 8; ++j) vc[j] = ((const f32x4*)(a.x + (size_t)gw * DM))[64 * j + lane];
        for (int r = gw; r < TREAL; r += NGW) {
            const int rn = r + NGW < TREAL ? r + NGW : r;
#pragma unroll
            for (int j = 0; j < 8; ++j) vn[j] = ((const f32x4*)(a.x + (size_t)rn * DM))[64 * j + lane];
            hn_row(nw, HN, G, RINV, WG, r, vc, lane);
#pragma unroll
            for (int j = 0; j < 8; ++j) vc[j] = vn[j];
        }
    }
    for (int r = TREAL + gw; r < MROWS; r += NGW) {
        if (r >= META_ROW0 && r < META_ROW0 + NMETA) {
            f32x4 vm[8];
#pragma unroll
            for (int j = 0; j < 8; ++j) vm[j] = ((const f32x4*)(a.meta + (size_t)(r - META_ROW0) * DM))[64 * j + lane];
            hn_row(nw, HN, G, RINV, WG, r, vm, lane);
        } else {
            unsigned long long* o8 = (unsigned long long*)(HN + (size_t)r * DM) + lane;
#pragma unroll
            for (int j = 0; j < 8; ++j) o8[64 * j] = 0ull;
            if (lane < 8) G[(size_t)r * 8 + lane] = 0.f;
            if (lane == 0) RINV[r] = 0.f;
        }
    }
    { bf16_t* SKB = (bf16_t*)(ws + WS_SKB);
      for (int i = bid * NTHREADS + tid; i < 8 * 2 * 128 * 128 / 2; i += nb * NTHREADS) { const float2 v = ((const float2*)a.subkeys)[i]; ((unsigned*)SKB)[i] = pk2(v.x, v.y); } }
    for (int i = bid + nb * tid; i < (SEQ + NMETA) * 32; i += nb * NTHREADS) {
        const int pos = i >> 5, j = i & 31;
        const float inv = (float)pow(10000.0, -(double)j / 32.0);
        const float ang = (float)pos * inv;
        rope[2 * i] = (float)cos((double)ang); rope[2 * i + 1] = (float)sin((double)ang);
    }
}


constexpr int CW_QTAB = 4096 + 1024, TAB_ITEMS = 2 * 16384 / 16;
__device__ __forceinline__ void phase_tables(const Args& a, unsigned char* lds, unsigned* ctl) {
    const int tid = opaque_tid(), lane = tid & 63, wave = __builtin_amdgcn_readfirstlane(tid >> 6);
    unsigned char* ws = a.ws;
    volatile LAS unsigned* slot = (volatile LAS unsigned*)((LAS unsigned char*)lds + LDS_MISC) + 2;
    for (;;) {
        const int item = next_item(ctl + CW_QTAB, slot);
        if (item >= TAB_ITEMS) break;
        const int rr = item * 16 + wave;
    {
        unsigned* U8 = (unsigned*)(ws + WS_U); unsigned* V8 = (unsigned*)(ws + WS_V); float* ISC = (float*)(ws + WS_ISC);
        {
            f32x4 v[2][8]; float am[2];
#pragma unroll
            for (int q = 0; q < 2; ++q) {
                const int r = rr + q * 8; const bool isu = r < 16384; const int e = r & 16383;
                const f32x4* xr = (const f32x4*)((isu ? a.pu : a.pv) + (size_t)e * DM) + lane;
#pragma unroll
                for (int j = 0; j < 8; ++j) v[q][j] = xr[64 * j];
            }
#pragma unroll
            for (int q = 0; q < 2; ++q) if (rr + q * 8 < 16384) {
#pragma unroll
                for (int j = 0; j < 8; ++j) v[q][j] = v[q][j] * ((const f32x4*)a.nfw_ffn)[64 * j + lane]; }
#pragma unroll
            for (int q = 0; q < 2; ++q) { float t = 0.f;
#pragma unroll
                for (int j = 0; j < 8; ++j) t = fmaxf(t, fmaxf(fmaxf(fabsf(v[q][j][0]), fabsf(v[q][j][1])), fmaxf(fabsf(v[q][j][2]), fabsf(v[q][j][3]))));
                am[q] = t; }
#pragma unroll
            for (int o = 1; o < 64; o <<= 1) { am[0] = fmaxf(am[0], __shfl_xor(am[0], o)); am[1] = fmaxf(am[1], __shfl_xor(am[1], o)); }
#pragma unroll
            for (int q = 0; q < 2; ++q) {
                const int r = rr + q * 8; const bool isu = r < 16384; const int e = r & 16383;
                const float top = 7.f;
                const float sc = am[q] > 0.f ? top / am[q] : 0.f;
                unsigned* o8 = isu ? U8 : V8;
#pragma unroll
                for (int j = 0; j < 8; ++j) {
                    const int q0 = (int)rintf(v[q][j][0] * sc), q1 = (int)rintf(v[q][j][1] * sc), q2 = (int)rintf(v[q][j][2] * sc), q3 = (int)rintf(v[q][j][3] * sc);
                    const int w = (int)((unsigned)(q0 + 8) | ((unsigned)(q1 + 8) << 8) | ((unsigned)(q2 + 8) << 16) | ((unsigned)(q3 + 8) << 24));
                    const int wsg = (int)((unsigned)(q0 & 15) | ((unsigned)(q1 & 15) << 8) | ((unsigned)(q2 & 15) << 16) | ((unsigned)(q3 & 15) << 24));
                    const int wp = __shfl_xor(wsg, 4);
                    if ((lane & 4) == 0) o8[((size_t)(j >> 1) * 16384 + e) * 64 + 32 * (j & 1) + 4 * (lane >> 3) + (lane & 3)] = (unsigned)(isu ? wsg : w) | ((unsigned)wp << 4); }
                if (lane == 0) ISC[2 * e + (isu ? 0 : 1)] = am[q] / top;
            }
        }
    }
    }
}

namespace att {
using bf16x8 = __attribute__((ext_vector_type(8))) short;
using s16x4 = __attribute__((ext_vector_type(4))) short;
using f32x16 = __attribute__((ext_vector_type(16))) float;
using u32x4 = __attribute__((ext_vector_type(4))) unsigned;
constexpr int SHM_V = 16384, SHM_K = 16384;
constexpr int L_V = 0, L_K = 2 * SHM_V, L_WS = L_K + 2 * SHM_K, L_P = L_WS + 8 * 64 * 4, L_END = L_P + 4 * 4096;
#define KSWZ(row, colB) ((row) * 256 + ((colB) ^ (((row) & 7) << 4)))
#define SBAR() __builtin_amdgcn_sched_barrier(0)
__device__ __forceinline__ int crow(int r, int hi) { return (r & 3) + 8 * (r >> 2) + 4 * hi; }
__device__ __forceinline__ unsigned cvtpk(float lo, float hi) { unsigned r; asm volatile("v_cvt_pk_bf16_f32 %0, %1, %2" : "=v"(r) : "v"(lo), "v"(hi)); return r; }
__device__ __forceinline__ int v_st(int k, int c) { const int kk = (k & ~0xC) | ((k & 4) << 1) | ((k & 8) >> 1); return ((kk >> 3) * 4 + (c >> 5)) * 512 + ((kk & 7) * 32 + (c & 31)) * 2; }
__device__ __forceinline__ int v_rd_base(int lane) { return ((lane & 3) << 3) | (((lane >> 2) & 3) << 6) | (((lane >> 4) & 1) << 5) | (((lane >> 5) & 1) << 8); }
constexpr int v_rd_off(int d0, int ks, int half) { return d0 * 512 + ks * 4096 + half * 2048; }
template <int OFF> __device__ __forceinline__ s16x4 tr_read(int vb) { s16x4 r; asm volatile("ds_read_b64_tr_b16 %0, %1 offset:%2" : "=&v"(r) : "v"(vb), "i"(OFF) : "memory"); return r; }
template <int D0> __device__ __forceinline__ void pv_one(f32x16& od, int vb, bf16x8 pa0, bf16x8 pa1, bf16x8 pa2, bf16x8 pa3) {
    const s16x4 l0 = tr_read<v_rd_off(D0, 0, 0)>(vb), h0 = tr_read<v_rd_off(D0, 0, 1)>(vb), l1 = tr_read<v_rd_off(D0, 1, 0)>(vb), h1 = tr_read<v_rd_off(D0, 1, 1)>(vb);
    const s16x4 l2 = tr_read<v_rd_off(D0, 2, 0)>(vb), h2 = tr_read<v_rd_off(D0, 2, 1)>(vb), l3 = tr_read<v_rd_off(D0, 3, 0)>(vb), h3 = tr_read<v_rd_off(D0, 3, 1)>(vb);
    asm volatile("s_waitcnt lgkmcnt(0)" ::: "memory"); SBAR();
#define PK(L, H) (bf16x8){L[0], L[1], L[2], L[3], H[0], H[1], H[2], H[3]}
    od = __builtin_amdgcn_mfma_f32_32x32x16_bf16(pa0, PK(l0, h0), od, 0, 0, 0);
    od = __builtin_amdgcn_mfma_f32_32x32x16_bf16(pa1, PK(l1, h1), od, 0, 0, 0);
    od = __builtin_amdgcn_mfma_f32_32x32x16_bf16(pa2, PK(l2, h2), od, 0, 0, 0);
    od = __builtin_amdgcn_mfma_f32_32x32x16_bf16(pa3, PK(l3, h3), od, 0, 0, 0);
#undef PK
}
__device__ __forceinline__ void qkt(f32x16& p0, f32x16& p1, const char* Ks, const bf16x8* qr, int r32, int hi, int comp) {
    p0 = f32x16{}; p1 = f32x16{};
#pragma unroll
    for (int d0 = 0; d0 < 4; ++d0) {
        const int cb = (comp * 64 + d0 * 16 + hi * 8) * 2;
        const bf16x8 b0 = *reinterpret_cast<const bf16x8*>(Ks + KSWZ(r32, cb));
        const bf16x8 b1 = *reinterpret_cast<const bf16x8*>(Ks + KSWZ(32 + r32, cb));
        p0 = __builtin_amdgcn_mfma_f32_32x32x16_bf16(b0, qr[d0], p0, 0, 0, 0);
        p1 = __builtin_amdgcn_mfma_f32_32x32x16_bf16(b1, qr[d0], p1, 0, 0, 0);
    }
}

__device__ __forceinline__ void attn_unit(int b, int h, int qb, const bf16_t* Z, bf16_t* MIX, float lam, const float* subln, char* lds) {
    const int tid = opaque_tid(), wid = __builtin_amdgcn_readfirstlane(tid >> 6), lane = tid & 63, r32 = lane & 31, hi = lane >> 5;
    const int comp = wid >> 2, rg = wid & 3;
    char* V_lds = lds + L_V; char* K_lds = lds + L_K;
    float* wsf = (float*)(lds + L_WS) + wid * 64;
    const int q0 = b * SEQ + qb * 128;
    const float NEGV = -1e30f;
    bf16x8 qr[4];
    {
        const bf16_t* Qw = Z + (size_t)(q0 + rg * 32 + r32) * NZ + ZQ + h * 128 + comp * 64 + hi * 8;
#pragma unroll
        for (int d0 = 0; d0 < 4; ++d0) qr[d0] = *reinterpret_cast<const bf16x8*>(Qw + d0 * 16);
    }
    const int NT = 2 * qb + 3;
    const int sr = tid >> 4, sc = (tid & 15) * 8;
    const int vst0 = v_st(sr, sc), vst1 = v_st(32 + sr, sc), kst0 = KSWZ(sr, sc * 2), kst1 = KSWZ(32 + sr, sc * 2);
    const int vb0 = (int)(uintptr_t)V_lds + v_rd_base(lane);
#define PK4(P, BASE, OUT) do { unsigned a0 = cvtpk(P[BASE + 0], P[BASE + 1]), a1 = cvtpk(P[BASE + 2], P[BASE + 3]); \
        unsigned b0 = cvtpk(P[BASE + 4], P[BASE + 5]), b1 = cvtpk(P[BASE + 6], P[BASE + 7]); \
        auto r0 = __builtin_amdgcn_permlane32_swap(a0, b0, false, false); auto r1 = __builtin_amdgcn_permlane32_swap(a1, b1, false, false); \
        u32x4 w = {r0[0], r1[0], r0[1], r1[1]}; OUT = *reinterpret_cast<bf16x8*>(&w); } while (0)
    bf16x8 vsA0, vsA1, ksA0, ksA1, vsB0, vsB1, ksB0, ksB1;
#define SLOAD(j, S) do { const size_t r0_ = (size_t)((j) == 0 ? META_TILE0 : b * SEQ + ((j) - 1) * 64) + sr; const bf16_t* zp_ = Z + r0_ * NZ + h * 128 + sc; \
        vs##S##0 = *reinterpret_cast<const bf16x8*>(zp_ + ZV); vs##S##1 = *reinterpret_cast<const bf16x8*>(zp_ + ZV + (size_t)32 * NZ); \
        ks##S##0 = *reinterpret_cast<const bf16x8*>(zp_ + ZK); ks##S##1 = *reinterpret_cast<const bf16x8*>(zp_ + ZK + (size_t)32 * NZ); } while (0)
#define SWRITE(bi, S) do { *reinterpret_cast<bf16x8*>(V_lds + (bi) * SHM_V + vst0) = vs##S##0; *reinterpret_cast<bf16x8*>(V_lds + (bi) * SHM_V + vst1) = vs##S##1; \
        *reinterpret_cast<bf16x8*>(K_lds + (bi) * SHM_K + kst0) = ks##S##0; *reinterpret_cast<bf16x8*>(K_lds + (bi) * SHM_K + kst1) = ks##S##1; } while (0)
    f32x16 o[4] = {}; float m_reg = NEGV, l_reg = 0.f;
    SLOAD(0, A); SWRITE(0, A); SLOAD(1, B); __syncthreads();
    const int qrel = rg * 32 + r32;
#define ATT_TILE(j, L_, W_) do { \
        const int cur = j & 1; \
        if (j + 2 < NT) SLOAD(j + 2, L_); \
        f32x16 p0, p1; \
        qkt(p0, p1, K_lds + cur * SHM_K, qr, r32, hi, comp); \
        if (j == 0) { \
    _Pragma("unroll") \
            for (int r = 0; r < 16; ++r) { p0[r] = NEGV; if (r < 8) p1[r] = NEGV; } \
        } else if (j >= NT - 2) { \
            const int kb0 = (j - (NT - 2)) * 64; \
    _Pragma("unroll") \
            for (int r = 0; r < 16; ++r) { const int kl = kb0 + crow(r, hi); if (kl > qrel) p0[r] = NEGV; if (kl + 32 > qrel) p1[r] = NEGV; } \
        } \
        float pmax = p0[0]; \
    _Pragma("unroll") \
        for (int r = 1; r < 16; ++r) pmax = fmaxf(pmax, p0[r]); \
    _Pragma("unroll") \
        for (int r = 0; r < 16; ++r) pmax = fmaxf(pmax, p1[r]); \
        { auto rr = __builtin_amdgcn_permlane32_swap(__float_as_uint(pmax), __float_as_uint(pmax), false, false); pmax = fmaxf(__uint_as_float(rr[0]), __uint_as_float(rr[1])); } \
        const float mn = fmaxf(m_reg, pmax); const float alpha = __builtin_amdgcn_exp2f(m_reg - mn); m_reg = mn; \
        float ps = 0.f; \
    _Pragma("unroll") \
        for (int r = 0; r < 16; ++r) { p0[r] = __builtin_amdgcn_exp2f(p0[r] - mn); ps += p0[r]; } \
    _Pragma("unroll") \
        for (int r = 0; r < 16; ++r) { p1[r] = __builtin_amdgcn_exp2f(p1[r] - mn); ps += p1[r]; } \
        { auto rr = __builtin_amdgcn_permlane32_swap(__float_as_uint(ps), __float_as_uint(ps), false, false); ps = __uint_as_float(rr[0]) + __uint_as_float(rr[1]); } \
        l_reg = l_reg * alpha + ps; \
        if (__any(alpha < 1.f)) { \
            if (hi == 0) wsf[r32] = alpha; \
            asm volatile("s_waitcnt lgkmcnt(0)" ::: "memory"); \
            float al[16]; \
    _Pragma("unroll") \
            for (int r = 0; r < 16; ++r) al[r] = wsf[crow(r, hi)]; \
    _Pragma("unroll") \
            for (int d = 0; d < 4; ++d) \
    _Pragma("unroll") \
                for (int r = 0; r < 16; ++r) o[d][r] *= al[r]; \
            asm volatile("s_waitcnt lgkmcnt(0)" ::: "memory"); \
        } \
        bf16x8 pa0, pa1, pa2, pa3; \
        PK4(p0, 0, pa0); PK4(p0, 8, pa1); PK4(p1, 0, pa2); PK4(p1, 8, pa3); \
        SBAR(); \
        { const int vb = vb0 + cur * SHM_V; \
          pv_one<0>(o[0], vb, pa0, pa1, pa2, pa3); pv_one<1>(o[1], vb, pa0, pa1, pa2, pa3); pv_one<2>(o[2], vb, pa0, pa1, pa2, pa3); pv_one<3>(o[3], vb, pa0, pa1, pa2, pa3); } \
        if (j + 1 < NT) SWRITE(cur ^ 1, W_); \
        __syncthreads(); \
    } while (0)
    {
        SLOAD(2, A);
        f32x16 p1 = f32x16{};
#pragma unroll
        for (int d0 = 0; d0 < 4; ++d0) {
            const int cb = (comp * 64 + d0 * 16 + hi * 8) * 2;
            const bf16x8 b1 = *reinterpret_cast<const bf16x8*>(K_lds + KSWZ(32 + r32, cb));
            p1 = __builtin_amdgcn_mfma_f32_32x32x16_bf16(b1, qr[d0], p1, 0, 0, 0);
        }
        float pmax = p1[8];
#pragma unroll
        for (int r = 9; r < 16; ++r) pmax = fmaxf(pmax, p1[r]);
        { auto rr = __builtin_amdgcn_permlane32_swap(__float_as_uint(pmax), __float_as_uint(pmax), false, false); pmax = fmaxf(__uint_as_float(rr[0]), __uint_as_float(rr[1])); }
        m_reg = pmax;
        float ps = 0.f;
#pragma unroll
        for (int r = 0; r < 8; ++r) p1[r] = 0.f;
#pragma unroll
        for (int r = 8; r < 16; ++r) { p1[r] = __builtin_amdgcn_exp2f(p1[r] - pmax); ps += p1[r]; }
        { auto rr = __builtin_amdgcn_permlane32_swap(__float_as_uint(ps), __float_as_uint(ps), false, false); ps = __uint_as_float(rr[0]) + __uint_as_float(rr[1]); }
        l_reg = ps;
        bf16x8 pa3; PK4(p1, 8, pa3);
        SBAR();
        {
#define PKF(L, H) (bf16x8){L[0], L[1], L[2], L[3], H[0], H[1], H[2], H[3]}
            const s16x4 l0 = tr_read<v_rd_off(0, 3, 0)>(vb0), h0 = tr_read<v_rd_off(0, 3, 1)>(vb0), l1 = tr_read<v_rd_off(1, 3, 0)>(vb0), h1 = tr_read<v_rd_off(1, 3, 1)>(vb0);
            const s16x4 l2 = tr_read<v_rd_off(2, 3, 0)>(vb0), h2 = tr_read<v_rd_off(2, 3, 1)>(vb0), l3 = tr_read<v_rd_off(3, 3, 0)>(vb0), h3 = tr_read<v_rd_off(3, 3, 1)>(vb0);
            asm volatile("s_waitcnt lgkmcnt(0)" ::: "memory"); SBAR();
            o[0] = __builtin_amdgcn_mfma_f32_32x32x16_bf16(pa3, PKF(l0, h0), o[0], 0, 0, 0); o[1] = __builtin_amdgcn_mfma_f32_32x32x16_bf16(pa3, PKF(l1, h1), o[1], 0, 0, 0);
            o[2] = __builtin_amdgcn_mfma_f32_32x32x16_bf16(pa3, PKF(l2, h2), o[2], 0, 0, 0); o[3] = __builtin_amdgcn_mfma_f32_32x32x16_bf16(pa3, PKF(l3, h3), o[3], 0, 0, 0);
#undef PKF
        }
        SWRITE(1, B);
        __syncthreads();
    }
    for (int j = 1; j < NT; j += 2) { ATT_TILE(j, B, A); ATT_TILE(j + 1, A, B); }
#undef ATT_TILE
#undef SLOAD
#undef SWRITE
#undef PK4
    if (hi == 0) wsf[r32] = l_reg;
    asm volatile("s_waitcnt lgkmcnt(0)" ::: "memory");
    float rli[16];
#pragma unroll
    for (int r = 0; r < 16; ++r) rli[r] = __builtin_amdgcn_rcpf(wsf[crow(r, hi)]);
    float* X = (float*)lds + rg * 4096;
    if (comp == 1) {
#pragma unroll
        for (int d0 = 0; d0 < 4; ++d0)
#pragma unroll
            for (int r = 0; r < 16; ++r) X[(d0 * 16 + r) * 64 + lane] = o[d0][r] * rli[r] * lam;
    }
    __syncthreads();
    if (comp == 0) {
        float ssr[16];
#pragma unroll
        for (int r = 0; r < 16; ++r) ssr[r] = 0.f;
#pragma unroll
        for (int d0 = 0; d0 < 4; ++d0)
#pragma unroll
            for (int r = 0; r < 16; ++r) { const float v = o[d0][r] * rli[r] - X[(d0 * 16 + r) * 64 + lane]; o[d0][r] = v; ssr[r] += v * v; }
        float* P = (float*)(lds + L_P) + rg * 1024;
#pragma unroll
        for (int r = 0; r < 16; ++r) P[r * 64 + lane] = ssr[r];
        asm volatile("s_waitcnt lgkmcnt(0)" ::: "memory");
        {
            const int rho = lane & 31, hh = (rho >> 2) & 1, rr = (rho & 3) + 4 * (rho >> 3);
            const float4* pp = (const float4*)(P + rr * 64 + hh * 32 + (lane >> 5) * 16);
            const float4 a0 = pp[0], a1 = pp[1], a2 = pp[2], a3 = pp[3];
            float s = ((a0.x + a0.y) + (a0.z + a0.w)) + ((a1.x + a1.y) + (a1.z + a1.w)) + ((a2.x + a2.y) + (a2.z + a2.w)) + ((a3.x + a3.y) + (a3.z + a3.w));
            auto sw = __builtin_amdgcn_permlane32_swap(__float_as_uint(s), __float_as_uint(s), false, false); s = __uint_as_float(sw[0]) + __uint_as_float(sw[1]);
            if (lane < 32) wsf[32 + rho] = rsqrtf(s * (1.f / 128.f) + EPS) * (1.f - LAMBDA_INIT);
        }
        asm volatile("s_waitcnt lgkmcnt(0)" ::: "memory");
        float sw4[4];
#pragma unroll
        for (int d0 = 0; d0 < 4; ++d0) sw4[d0] = subln[d0 * 32 + r32];
        bf16_t* Ow = MIX + (size_t)(q0 + rg * 32) * DM + h * 128 + r32;
#pragma unroll
        for (int r = 0; r < 16; ++r) {
            const int orow = crow(r, hi); const float rs = wsf[32 + orow];
#pragma unroll
            for (int d0 = 0; d0 < 4; ++d0) Ow[(size_t)orow * DM + d0 * 32] = (bf16_t)f2bf(o[d0][r] * rs * sw4[d0]);
        }
    }
    __syncthreads();
}
#undef KSWZ
#undef SBAR
}

__device__ __forceinline__ float attn_lambda(const Args& a) {
    const int lane = opaque_tid() & 63;
    const float l1 = wave_sum(a.lamqk[lane] * a.lamqk[64 + lane]), l2 = wave_sum(a.lamqk[128 + lane] * a.lamqk[192 + lane]);
    return expf(l1) - expf(l2) + LAMBDA_INIT;
}
namespace mls {
using bf16x8 = __attribute__((ext_vector_type(8))) short;
using bf16x4 = __attribute__((ext_vector_type(4))) short;
using s16x4 = __attribute__((ext_vector_type(4))) short;
using f32x16 = __attribute__((ext_vector_type(16))) float;
using f32x4v = __attribute__((ext_vector_type(4))) float;
using u32x4v = __attribute__((ext_vector_type(4))) unsigned;
using u32x2v = __attribute__((ext_vector_type(2))) unsigned;
constexpr int L_QS = 0, L_QP = 16384, L_KS = 32768, L_KW = 49152, L_VT = 65536, L_PT = 98304, L_HT = 106496, HT_STRIDE = 528;
constexpr int L_MISC = L_HT + 64 * HT_STRIDE;
constexpr int L_RS = L_MISC, L_QN = L_RS + 2 * 64 * 4, L_NV = L_QN + 64 * 4, L_NP = L_NV + 128 * 4, L_CW = L_NP + 8 * 128 * 4, L_RD = L_CW + 5 * 256 * 4, L_NW = L_RD + 8 * 64 * 4, L_END = L_NW + 8 * 36 * 4;
#define KSWZ(row, colB) ((row) * 256 + ((colB) ^ (((row) & 7) << 4)))
#define PSWZ(row, colB) ((row) * 128 + ((colB) ^ ((((row) >> 1) & 7) << 4)))
__device__ __forceinline__ int crow(int r, int hi) { return (r & 3) + 8 * (r >> 2) + 4 * hi; }
__device__ __forceinline__ unsigned cvtpk(float lo, float hi) { unsigned r; asm volatile("v_cvt_pk_bf16_f32 %0, %1, %2" : "=v"(r) : "v"(lo), "v"(hi)); return r; }
__device__ __forceinline__ int v_st(int k, int c) { const int kk = (k & ~0xC) | ((k & 4) << 1) | ((k & 8) >> 1); return ((kk >> 3) * 4 + (c >> 5)) * 512 + ((kk & 7) * 32 + (c & 31)) * 2; }
__device__ __forceinline__ int v_rd_base(int lane) { return ((lane & 3) << 3) | (((lane >> 2) & 3) << 6) | (((lane >> 4) & 1) << 5) | (((lane >> 5) & 1) << 8); }
__device__ __forceinline__ s16x4 tr_read_dyn(int addr) { s16x4 r; asm volatile("ds_read_b64_tr_b16 %0, %1" : "=&v"(r) : "v"(addr) : "memory"); return r; }
__device__ __forceinline__ bf16x8 tr_frag(int img_plus_base, int d0, int ks) {
    const s16x4 lo = tr_read_dyn(img_plus_base + d0 * 512 + ks * 4096), hi = tr_read_dyn(img_plus_base + d0 * 512 + ks * 4096 + 2048);
    return (bf16x8){lo[0], lo[1], lo[2], lo[3], hi[0], hi[1], hi[2], hi[3]};
}
template <int CTRL, int RMASK> __device__ __forceinline__ float dppf(float old, float v) { return __builtin_bit_cast(float, __builtin_amdgcn_update_dpp(__builtin_bit_cast(int, old), __builtin_bit_cast(int, v), CTRL, RMASK, 0xf, false)); }
__device__ __forceinline__ float scan_add(float v) {
    v += dppf<0x111, 0xf>(0.f, v); v += dppf<0x112, 0xf>(0.f, v); v += dppf<0x114, 0xf>(0.f, v); v += dppf<0x118, 0xf>(0.f, v);
    v += dppf<0x142, 0xa>(0.f, v); v += dppf<0x143, 0xc>(0.f, v); return v;
}
__device__ __forceinline__ float scan_max(float v) {
    const float NI = -3.0e38f;
    v = fmaxf(v, dppf<0x111, 0xf>(NI, v)); v = fmaxf(v, dppf<0x112, 0xf>(NI, v)); v = fmaxf(v, dppf<0x114, 0xf>(NI, v)); v = fmaxf(v, dppf<0x118, 0xf>(NI, v));
    v = fmaxf(v, dppf<0x142, 0xa>(NI, v)); v = fmaxf(v, dppf<0x143, 0xc>(NI, v)); return v;
}
__device__ __forceinline__ float rlane(float v, int l) { return __uint_as_float(__builtin_amdgcn_readlane(__float_as_uint(v), l)); }
__device__ __forceinline__ float silu(float x) { return x * __builtin_amdgcn_rcpf(1.f + __expf(-x)); }
__device__ __forceinline__ void fmac_v(float& y, float a, float b) { asm("v_fmac_f32 %0, %1, %2" : "+v"(y) : "v"(a), "v"(b)); }
__device__ __forceinline__ float mul_v(float a, float b) { float r; asm("v_mul_f32 %0, %1, %2" : "=v"(r) : "v"(a), "v"(b)); return r; }

__device__ __forceinline__ void mlstm_item(int b, int h, const Args& a, char* lds) {
    const int tid0 = opaque_tid(), wid = __builtin_amdgcn_readfirstlane(tid0 >> 6);
    const bf16_t* Z = (const bf16_t*)(a.ws + WS_Z); const float* G = (const float*)(a.ws + WS_GATES); bf16_t* MIX = (bf16_t*)(a.ws + WS_MIX);
    const int ldsb = (int)(uintptr_t)lds;
    float* RS = (float*)(lds + L_RS); float* QN = (float*)(lds + L_QN); float* NV = (float*)(lds + L_NV); float* NP = (float*)(lds + L_NP); float* CW = (float*)(lds + L_CW);
    for (int i = tid0; i < 5 * 256; i += NTHREADS) { const int j = i >> 8, c = i & 255; const int cc = c < 128 ? h * 128 + c : 512 + h * 128 + (c - 128); CW[i] = j < 4 ? a.convw[j * 1024 + cc] : a.convb[cc]; }
    if (tid0 < 128) NV[tid0] = 0.f;
    if (tid0 < 256) ((float*)(lds + L_NW))[(tid0 >> 5) * 36 + (tid0 & 31)] = a.mnw[h * 256 + tid0];
    const float ibh = a.ib[h], fbh = a.fb[h];
    float cw[4][4], cb[4];
    __syncthreads();
    { const int c4 = 4 * (tid0 & 63);
#pragma unroll
    for (int j = 0; j < 4; ++j)
#pragma unroll
        for (int q = 0; q < 4; ++q) cw[j][q] = CW[j * 256 + c4 + q];
#pragma unroll
    for (int q = 0; q < 4; ++q) cb[q] = CW[4 * 256 + c4 + q]; }
    f32x16 C[4] = {};
    float m_prev = -1e30f;
    u32x2v rq[11]; u32x4v rv[4]; float gi, gf;
    auto chunk_row0 = [&](int c) -> int { return c == 0 ? META_TILE0 : b * SEQ + (c - 1) * 64; };
#define LOAD_RAW(c) do { int tq_ = tid0; asm volatile("" : "+v"(tq_)); const int ln_ = tq_ & 63, c4_ = 4 * ln_, zc_qk = (c4_ < 128 ? ZMQ + h * 128 + c4_ : ZMK + h * 128 + (c4_ - 128)), erow = tq_ >> 3, eseg = tq_ & 7; const int r0_ = chunk_row0(c); \
        _Pragma("unroll") for (int i_ = 0; i_ < 11; ++i_) { const int t_ = 8 * wid - 3 + i_; int row_; bool ok_ = true; \
            if (t_ >= 0) row_ = r0_ + t_; else if ((c) == 0) { row_ = 0; ok_ = false; } else if ((c) == 1) row_ = META_TILE0 + 64 + t_; else row_ = r0_ + t_; \
            rq[i_] = ok_ ? *(const u32x2v*)(Z + (size_t)row_ * NZ + zc_qk) : (u32x2v){0u, 0u}; } \
        _Pragma("unroll") for (int i_ = 0; i_ < 4; ++i_) rv[i_] = *(const u32x4v*)(Z + (size_t)(r0_ + erow) * NZ + ZMV + h * 256 + eseg * 32 + 8 * i_); \
        { const int rowg_ = r0_ + ln_; gi = G[(size_t)rowg_ * 8 + h]; gf = G[(size_t)rowg_ * 8 + 4 + h]; } } while (0)
    LOAD_RAW(0);
    const int NCH = 33;
    for (int c = 0; c < NCH; ++c) {
        int tid = tid0; asm volatile("" : "+v"(tid));
        const int lane = tid & 63, r32 = lane & 31, hi = lane >> 5, cq = lane, c4 = 4 * cq, erow = tid >> 3, eseg = tid & 7;
        float* RD = (float*)(lds + L_RD) + wid * 64;
        float li = gi + ibh; float lf; { const float xf = gf + fbh; lf = fminf(xf, 0.f) - __logf(1.f + __expf(-fabsf(xf))); }
        if (c == 0 && lane < 48) { li = -1e30f; lf = 0.f; }
        const float bsum = scan_add(lf);
        const float u = li - bsum;
        const float cm = scan_max(u);
        const float Mrow = fmaxf(cm, m_prev);
        const float iw = __expf(m_prev - Mrow);
        const float Mend = rlane(Mrow, 63), gtot = rlane(bsum, 63);
        const float wrow = __expf(u - Mend);
        const float dec = __expf(m_prev - Mend);
        const float dexp = __expf(-(bsum + Mrow));
        {
            float qn_part[8], ksum[4] = {0.f, 0.f, 0.f, 0.f};
            float nvv[4];
#pragma unroll
            for (int q = 0; q < 4; ++q) nvv[q] = (cq < 32) ? NV[c4 + q] : 0.f;
#pragma unroll
            for (int i = 0; i < 8; ++i) {
                const int t = 8 * wid + i;
                float xo[4];
#pragma unroll
                for (int q = 0; q < 4; ++q) xo[q] = cb[q];
#pragma unroll
                for (int j = 0; j < 4; ++j) {
                    const u32x2v rr = rq[i + j];
                    fmac_v(xo[0], cw[j][0], bf_lo(rr.x)); fmac_v(xo[1], cw[j][1], bf_hi(rr.x)); fmac_v(xo[2], cw[j][2], bf_lo(rr.y)); fmac_v(xo[3], cw[j][3], bf_hi(rr.y));
                }
#pragma unroll
                for (int q = 0; q < 4; ++q) xo[q] = silu(xo[q]);
                const float iw_t = rlane(iw, t), w_t = rlane(wrow, t);
                if (cq < 32) {
#pragma unroll
                    for (int q = 0; q < 4; ++q) xo[q] = mul_v(xo[q], 0.08838834764831845f);
                    *(uint2*)(lds + L_QS + KSWZ(t, c4 * 2)) = make_uint2(cvtpk(xo[0], xo[1]), cvtpk(xo[2], xo[3]));
                    float qd = 0.f;
#pragma unroll
                    for (int q = 0; q < 4; ++q) { fmac_v(qd, xo[q], nvv[q]); xo[q] = mul_v(xo[q], iw_t); }
                    *(uint2*)(lds + L_QP + KSWZ(t, c4 * 2)) = make_uint2(cvtpk(xo[0], xo[1]), cvtpk(xo[2], xo[3]));
                    qn_part[i] = iw_t * qd;
                } else {
                    const int kc = c4 - 128;
                    *(uint2*)(lds + L_KS + KSWZ(t, kc * 2)) = make_uint2(cvtpk(xo[0], xo[1]), cvtpk(xo[2], xo[3]));
#pragma unroll
                    for (int q = 0; q < 4; ++q) { xo[q] = mul_v(xo[q], w_t); ksum[q] += xo[q]; }
                    *(uint2*)(lds + L_KW + v_st(t, kc)) = make_uint2(cvtpk(xo[0], xo[1]), cvtpk(xo[2], xo[3]));
                    qn_part[i] = 0.f;
                }
                __builtin_amdgcn_sched_barrier(0);
            }
            {
                float r4[4], r2[2], r1;
                { const bool hb = (lane & 16) != 0;
#pragma unroll
                  for (int i = 0; i < 4; ++i) { const float send = hb ? qn_part[i] : qn_part[i + 4]; const float recv = __shfl_xor(send, 16); r4[i] = (hb ? qn_part[i + 4] : qn_part[i]) + recv; } }
                { const bool hb = (lane & 8) != 0;
#pragma unroll
                  for (int i = 0; i < 2; ++i) { const float send = hb ? r4[i] : r4[i + 2]; const float recv = __shfl_xor(send, 8); r2[i] = (hb ? r4[i + 2] : r4[i]) + recv; } }
                { const bool hb = (lane & 4) != 0; const float send = hb ? r2[0] : r2[1]; const float recv = __shfl_xor(send, 4); r1 = (hb ? r2[1] : r2[0]) + recv; }
                r1 += __shfl_xor(r1, 2); r1 += __shfl_xor(r1, 1);
                if (lane < 32 && (lane & 3) == 0) QN[8 * wid + ((lane >> 4) & 1) * 4 + ((lane >> 3) & 1) * 2 + ((lane >> 2) & 1)] = r1;
            }
            if (cq >= 32) {
#pragma unroll
                for (int q = 0; q < 4; ++q) NP[wid * 128 + (c4 - 128) + q] = ksum[q];
            }
#pragma unroll
            for (int i = 0; i < 4; ++i) *(u32x4v*)(lds + L_VT + (eseg >> 2) * 16384 + v_st(erow, (eseg & 3) * 32 + 8 * i)) = rv[i];
        }
        u32x4v zo[4];
        {
            const int r0 = chunk_row0(c);
#pragma unroll
            for (int i = 0; i < 4; ++i) zo[i] = *(const u32x4v*)(Z + (size_t)(r0 + erow) * NZ + ZMO + h * 256 + eseg * 32 + 8 * i);
        }
        if (c + 1 < NCH) LOAD_RAW(c + 1);
        __syncthreads();
        {
            const int tb = wid >> 1, half = wid & 1;
            float rsum[4] = {0.f, 0.f, 0.f, 0.f};
            const int fr = lane & 15, fq = lane >> 4;
            float Mt[4];
#pragma unroll
            for (int i = 0; i < 4; ++i) Mt[i] = __shfl(Mrow, 16 * tb + 4 * fq + i);
#pragma unroll
            for (int sj = 0; sj < 2; ++sj) {
                const int sb = 2 * half + sj;
                unsigned short pw[4] = {0, 0, 0, 0};
                if (sb <= tb) {
                    f32x4v acc = {0.f, 0.f, 0.f, 0.f};
#pragma unroll
                    for (int ks = 0; ks < 4; ++ks) {
                        const bf16x8 af = *(const bf16x8*)(lds + L_QS + KSWZ(16 * tb + fr, (32 * ks + 8 * fq) * 2));
                        const bf16x8 bfr = *(const bf16x8*)(lds + L_KS + KSWZ(16 * sb + fr, (32 * ks + 8 * fq) * 2));
                        acc = __builtin_amdgcn_mfma_f32_16x16x32_bf16(af, bfr, acc, 0, 0, 0);
                    }
                    const int s = 16 * sb + fr; const float us = __shfl(u, s);
#pragma unroll
                    for (int i = 0; i < 4; ++i) {
                        const int t = 16 * tb + 4 * fq + i;
                        const float p = (s <= t) ? acc[i] * __expf(us - Mt[i]) : 0.f;
                        rsum[i] += p; pw[i] = (unsigned short)f2bf(p);
                    }
                }
#pragma unroll
                for (int i = 0; i < 4; ++i) *(unsigned short*)(lds + L_PT + PSWZ(16 * tb + 4 * fq + i, (16 * sb + fr) * 2)) = pw[i];
            }
#pragma unroll
            for (int i = 0; i < 4; ++i) {
                float v = rsum[i];
                v += __shfl_xor(v, 1); v += __shfl_xor(v, 2); v += __shfl_xor(v, 4); v += __shfl_xor(v, 8);
                if (fr == 0) RS[half * 64 + 16 * tb + 4 * fq + i] = v;
            }
        }
        __syncthreads();
        {
            const float nq = RS[lane] + RS[64 + lane] + QN[lane];
            RD[lane] = __builtin_amdgcn_rcpf(fmaxf(fabsf(nq), dexp));
            bf16x8 vf[4];
            const int vimg = ldsb + L_VT + (wid >> 2) * 16384 + v_rd_base(lane);
#pragma unroll
            for (int ks = 0; ks < 4; ++ks) vf[ks] = tr_frag(vimg, wid & 3, ks);
            asm volatile("s_waitcnt lgkmcnt(0)" ::: "memory"); __builtin_amdgcn_sched_barrier(0);
            f32x16 acc[2] = {};
#pragma unroll
            for (int rb = 0; rb < 2; ++rb) {
                const int row = 32 * rb + r32;
#pragma unroll
                for (int ks = 0; ks < 4; ++ks) {
                    if (rb == 0 && ks >= 2) continue;
                    const bf16x8 pf = *(const bf16x8*)(lds + L_PT + PSWZ(row, (16 * ks + 8 * hi) * 2));
                    acc[rb] = __builtin_amdgcn_mfma_f32_32x32x16_bf16(pf, vf[ks], acc[rb], 0, 0, 0);
                }
            }
#pragma unroll
            for (int kb = 0; kb < 4; ++kb)
#pragma unroll
                for (int sp = 0; sp < 2; ++sp) {
                    bf16x8 cf; { unsigned w0 = cvtpk(C[kb][8 * sp + 0], C[kb][8 * sp + 1]), w1 = cvtpk(C[kb][8 * sp + 2], C[kb][8 * sp + 3]), w2 = cvtpk(C[kb][8 * sp + 4], C[kb][8 * sp + 5]), w3 = cvtpk(C[kb][8 * sp + 6], C[kb][8 * sp + 7]);
                        typedef unsigned u32x4_ __attribute__((ext_vector_type(4))); u32x4_ ww = {w0, w1, w2, w3}; cf = __builtin_bit_cast(bf16x8, ww); }
                    const int base = 32 * kb + 16 * sp;
#pragma unroll
                    for (int rb = 0; rb < 2; ++rb) {
                        const int row = 32 * rb + r32;
                        const bf16x4 q0 = *(const bf16x4*)(lds + L_QP + KSWZ(row, (base + 4 * hi) * 2));
                        const bf16x4 q1 = *(const bf16x4*)(lds + L_QP + KSWZ(row, (base + 8 + 4 * hi) * 2));
                        const bf16x8 qf = {q0[0], q0[1], q0[2], q0[3], q1[0], q1[1], q1[2], q1[3]};
                        acc[rb] = __builtin_amdgcn_mfma_f32_32x32x16_bf16(qf, cf, acc[rb], 0, 0, 0);
                    }
                }
            asm volatile("s_waitcnt lgkmcnt(0)" ::: "memory");
#pragma unroll
            for (int rb = 0; rb < 2; ++rb)
#pragma unroll
                for (int r = 0; r < 16; ++r) {
                    const int row = 32 * rb + crow(r, hi);
                    *(unsigned short*)(lds + L_HT + row * HT_STRIDE + (32 * wid + r32) * 2) = (unsigned short)f2bf(acc[rb][r] * RD[row]);
                }
#pragma unroll
            for (int kb = 0; kb < 4; ++kb) {
#pragma unroll
                for (int r = 0; r < 16; ++r) C[kb][r] *= dec;
                const int kimg = ldsb + L_KW + v_rd_base(lane);
                bf16x8 kf[4];
#pragma unroll
                for (int ks = 0; ks < 4; ++ks) kf[ks] = tr_frag(kimg, kb, ks);
                asm volatile("s_waitcnt lgkmcnt(0)" ::: "memory"); __builtin_amdgcn_sched_barrier(0);
#pragma unroll
                for (int ks = 0; ks < 4; ++ks) C[kb] = __builtin_amdgcn_mfma_f32_32x32x16_bf16(kf[ks], vf[ks], C[kb], 0, 0, 0);
            }
            if (tid < 128) { float s = NV[tid] * dec;
#pragma unroll
                for (int w8 = 0; w8 < 8; ++w8) s += NP[w8 * 128 + tid];
                NV[tid] = s; }
        }
        m_prev = gtot + Mend;
        __syncthreads();
        if (c > 0) {
            float hv[32]; float ss = 0.f;
#pragma unroll
            for (int i = 0; i < 4; ++i) {
                const uint4 w = *(const uint4*)(lds + L_HT + erow * HT_STRIDE + eseg * 64 + 16 * i);
                hv[8 * i + 0] = bf_lo(w.x); hv[8 * i + 1] = bf_hi(w.x); hv[8 * i + 2] = bf_lo(w.y); hv[8 * i + 3] = bf_hi(w.y);
                hv[8 * i + 4] = bf_lo(w.z); hv[8 * i + 5] = bf_hi(w.z); hv[8 * i + 6] = bf_lo(w.w); hv[8 * i + 7] = bf_hi(w.w);
            }
#pragma unroll
            for (int i = 0; i < 32; ++i) ss += hv[i] * hv[i];
            ss += __shfl_xor(ss, 1); ss += __shfl_xor(ss, 2); ss += __shfl_xor(ss, 4);
            const float rstd = rsqrtf(ss * (1.f / 256.f) + EPS);
            const float* nw = (const float*)(lds + L_NW) + eseg * 36;
            bf16_t* op = MIX + (size_t)(chunk_row0(c) + erow) * DM + 1024 + h * 256 + eseg * 32;
#pragma unroll
            for (int i = 0; i < 4; ++i) {
                const unsigned zz[4] = {zo[i].x, zo[i].y, zo[i].z, zo[i].w};
                unsigned ow[4];
#pragma unroll
                for (int q = 0; q < 4; ++q) {
                    const float z0 = bf_lo(zz[q]), z1 = bf_hi(zz[q]);
                    const float o0 = hv[8 * i + 2 * q] * rstd * nw[8 * i + 2 * q] * __builtin_amdgcn_rcpf(1.f + __expf(-z0));
                    const float o1 = hv[8 * i + 2 * q + 1] * rstd * nw[8 * i + 2 * q + 1] * __builtin_amdgcn_rcpf(1.f + __expf(-z1));
                    ow[q] = pk2(o0, o1);
                }
                *(uint4*)(op + 8 * i) = make_uint4(ow[0], ow[1], ow[2], ow[3]);
            }
        }
    }
#undef LOAD_RAW
    __syncthreads();
}
#undef KSWZ
#undef PSWZ
}

namespace rt {
using bf16x8 = __attribute__((ext_vector_type(8))) short;
using f32x16 = __attribute__((ext_vector_type(16))) float;
#define CE(a, b) do { const unsigned x_ = (a), y_ = (b); (a) = x_ > y_ ? x_ : y_; (b) = x_ > y_ ? y_ : x_; } while (0)
#define SORT16_DESC(V) do { CE(V[0], V[1]); CE(V[2], V[3]); CE(V[0], V[2]); CE(V[1], V[3]); CE(V[1], V[2]); CE(V[4], V[5]); CE(V[6], V[7]); CE(V[4], V[6]); CE(V[5], V[7]); CE(V[5], V[6]); CE(V[0], V[4]); CE(V[2], V[6]); CE(V[2], V[4]); CE(V[1], V[5]); CE(V[3], V[7]); CE(V[3], V[5]); CE(V[1], V[2]); CE(V[3], V[4]); CE(V[5], V[6]); CE(V[8], V[9]); CE(V[10], V[11]); CE(V[8], V[10]); CE(V[9], V[11]); CE(V[9], V[10]); CE(V[12], V[13]); CE(V[14], V[15]); CE(V[12], V[14]); CE(V[13], V[15]); CE(V[13], V[14]); CE(V[8], V[12]); CE(V[10], V[14]); CE(V[10], V[12]); CE(V[9], V[13]); CE(V[11], V[15]); CE(V[11], V[13]); CE(V[9], V[10]); CE(V[11], V[12]); CE(V[13], V[14]); CE(V[0], V[8]); CE(V[4], V[12]); CE(V[4], V[8]); CE(V[2], V[10]); CE(V[6], V[14]); CE(V[6], V[10]); CE(V[2], V[4]); CE(V[6], V[8]); CE(V[10], V[12]); CE(V[1], V[9]); CE(V[5], V[13]); CE(V[5], V[9]); CE(V[3], V[11]); CE(V[7], V[15]); CE(V[7], V[11]); CE(V[3], V[5]); CE(V[7], V[9]); CE(V[11], V[13]); CE(V[1], V[2]); CE(V[3], V[4]); CE(V[5], V[6]); CE(V[7], V[8]); CE(V[9], V[10]); CE(V[11], V[12]); CE(V[13], V[14]); } while (0)
#define BMERGE16_DESC(V) do { CE(V[0], V[8]); CE(V[1], V[9]); CE(V[2], V[10]); CE(V[3], V[11]); CE(V[4], V[12]); CE(V[5], V[13]); CE(V[6], V[14]); CE(V[7], V[15]); CE(V[0], V[4]); CE(V[1], V[5]); CE(V[2], V[6]); CE(V[3], V[7]); CE(V[8], V[12]); CE(V[9], V[13]); CE(V[10], V[14]); CE(V[11], V[15]); CE(V[0], V[2]); CE(V[1], V[3]); CE(V[4], V[6]); CE(V[5], V[7]); CE(V[8], V[10]); CE(V[9], V[11]); CE(V[12], V[14]); CE(V[13], V[15]); CE(V[0], V[1]); CE(V[2], V[3]); CE(V[4], V[5]); CE(V[6], V[7]); CE(V[8], V[9]); CE(V[10], V[11]); CE(V[12], V[13]); CE(V[14], V[15]); } while (0)

#define TOP16(A, B) do { _Pragma("unroll") for (int i_ = 0; i_ < 16; ++i_) { const unsigned x_ = A[i_], y_ = B[15 - i_]; A[i_] = x_ > y_ ? x_ : y_; } BMERGE16_DESC(A); } while (0)
__device__ __forceinline__ unsigned ord_key(float f) { const unsigned u = __float_as_uint(f); return u ^ (((unsigned)((int)u >> 31)) | 0x80000000u); }
__device__ __forceinline__ float ord_val(unsigned k) { return __uint_as_float((k & 0x80000000u) ? (k ^ 0x80000000u) : ~k); }
__device__ __forceinline__ int crow(int r, int hi) { return (r & 3) + 8 * (r >> 2) + 4 * hi; }

__device__ __forceinline__ void route_item(int tb, int h, const bf16_t* QP, const char* KL, const float* SSQ, int* IDX, float* GATE, int* scr, int lane_in) {
    int lane = lane_in; asm volatile("" : "+v"(lane));
    const int tok = lane & 31, hi = lane >> 5;
    const int row = tb * 32 + tok;
    float rstd;
    { const float4* sp = (const float4*)(SSQ + (size_t)row * 32); float s = 0.f;
#pragma unroll
      for (int i = 0; i < 8; ++i) { const float4 v = sp[i]; s += (v.x + v.y) + (v.z + v.w); }
      rstd = rsqrtf(s * (1.f / DM) + EPS); }
    unsigned top[2][16];
    bf16x8 qf[8], af[2][8];
    unsigned T[16];
#define RT_LOADQ(p_) do { const bf16_t* qp_ = QP + (size_t)row * DM + h * 256 + (p_) * 128 + hi * 8; \
        _Pragma("unroll") for (int ks = 0; ks < 8; ++ks) qf[ks] = *reinterpret_cast<const bf16x8*>(qp_ + ks * 16); } while (0)
#define RT_LOADK(b_, i_) do { const char* kp_ = KL + ((((i_) >> 2) * 128 + ((i_) & 3) * 32 + tok) * 272 + hi * 16); \
        _Pragma("unroll") for (int ks = 0; ks < 8; ++ks) af[b_][ks] = *reinterpret_cast<const bf16x8*>(kp_ + ks * 32); } while (0)
    RT_LOADQ(0); RT_LOADK(0, 0);
#pragma unroll
    for (int i = 0; i < 8; ++i) {
        const int p = i >> 2, kb = i & 3;
        if (i + 1 < 8) RT_LOADK((i + 1) & 1, i + 1);
        f32x16 acc = {};
#pragma unroll
        for (int ks = 0; ks < 8; ++ks) acc = __builtin_amdgcn_mfma_f32_32x32x16_bf16(af[i & 1][ks], qf[ks], acc, 0, 0, 0);
        unsigned K[16];
#pragma unroll
        for (int r = 0; r < 16; ++r) { const int low = 127 - (32 * kb + (r & 3) + 8 * (r >> 2)) - 4 * hi; K[r] = (ord_key(acc[r]) & ~127u) | (unsigned)low; }
        if (i == 3) RT_LOADQ(1);
        SORT16_DESC(K);
        if (kb == 0) {
#pragma unroll
            for (int j = 0; j < 16; ++j) T[j] = K[j];
        } else { TOP16(T, K); }
        if (kb == 3) {
            unsigned O[16];
#pragma unroll
            for (int j = 0; j < 16; ++j) { auto rr = __builtin_amdgcn_permlane32_swap(T[j], T[j], false, false); O[j] = hi ? rr[0] : rr[1]; }
            TOP16(T, O);
#pragma unroll
            for (int j = 0; j < 16; ++j) top[p][j] = T[j];
        }
        __builtin_amdgcn_sched_barrier(0);
    }
#undef RT_LOADQ
#undef RT_LOADK
    float s1[16], s2[16];
#pragma unroll
    for (int i = 0; i < 16; ++i) {
        s1[i] = ord_val(top[0][i] & ~127u) * rstd; s2[i] = ord_val(top[1][i] & ~127u) * rstd;
        scr[i * 64 + lane] = 127 - (int)(top[0][i] & 127u); scr[(16 + i) * 64 + lane] = 127 - (int)(top[1][i] & 127u);
    }
#define CKEY(a_, b_) ((ord_key(s1[a_] + s2[b_]) & ~255u) | (unsigned)(255 - (16 * (a_) + (b_))))
    unsigned A[16], B[16], Cg[16];
#pragma unroll
    for (int b_ = 0; b_ < 16; ++b_) A[b_] = CKEY(0, b_);
#pragma unroll
    for (int b_ = 0; b_ < 8; ++b_) { B[b_] = CKEY(1, b_); B[8 + b_] = CKEY(15 - b_, 0); }
    BMERGE16_DESC(B);
    Cg[0] = CKEY(2, 0); Cg[1] = CKEY(2, 1); Cg[2] = CKEY(2, 2); Cg[3] = CKEY(2, 3); Cg[4] = CKEY(2, 4);
    Cg[5] = CKEY(3, 0); Cg[6] = CKEY(3, 1); Cg[7] = CKEY(3, 2); Cg[8] = CKEY(3, 3);
    Cg[9] = CKEY(4, 0); Cg[10] = CKEY(4, 1); Cg[11] = CKEY(4, 2);
    Cg[12] = CKEY(5, 0); Cg[13] = CKEY(5, 1); Cg[14] = CKEY(6, 0); Cg[15] = CKEY(6, 1);
    SORT16_DESC(Cg);
    { const unsigned d0 = CKEY(7, 0), d1 = CKEY(7, 1); Cg[15] = Cg[15] > d0 ? Cg[15] : d0; Cg[14] = Cg[14] > d1 ? Cg[14] : d1; BMERGE16_DESC(Cg); }
    TOP16(A, B); TOP16(A, Cg);
#undef CKEY
    asm volatile("s_waitcnt lgkmcnt(0)" ::: "memory");
    float e[16]; float z = 0.f; const float mx = ord_val(A[0] & ~255u);
#pragma unroll
    for (int j = 0; j < 16; ++j) { e[j] = __expf(ord_val(A[j] & ~255u) - mx); z += e[j]; }
    const float rz = 1.f / z;
      unsigned short* ip = (unsigned short*)IDX + (size_t)row * 128 + h * 16 + hi * 8; float* gp = GATE + (size_t)row * 128 + h * 16 + hi * 8;
    int oi[8] = {0, 0, 0, 0, 0, 0, 0, 0}; float og[8] = {0.f, 0.f, 0.f, 0.f, 0.f, 0.f, 0.f, 0.f};
#pragma unroll
    for (int j = 0; j < 16; ++j) {
        const int flat = 255 - (int)(A[j] & 255u), a_ = flat >> 4, b_ = flat & 15;
        const int ex = scr[a_ * 64 + lane] * 128 + scr[(16 + b_) * 64 + lane];
        if (j < 8) { if (!hi) { oi[j] = ex; og[j] = e[j] * rz; } } else { if (hi) { oi[j - 8] = ex; og[j - 8] = e[j] * rz; } }
    }
    *(int4*)(ip) = make_int4(oi[0] | (oi[1] << 16), oi[2] | (oi[3] << 16), oi[4] | (oi[5] << 16), oi[6] | (oi[7] << 16));
    *(float4*)(gp) = make_float4(og[0], og[1], og[2], og[3]); *(float4*)(gp + 4) = make_float4(og[4], og[5], og[6], og[7]);
    asm volatile("s_waitcnt lgkmcnt(0)" ::: "memory");
}
#undef CE
#undef TOP16
}

__device__ __forceinline__ void phase_route(const Args& a, unsigned char* lds, int bid, int nb) {
    const int tid = opaque_tid(), wave = __builtin_amdgcn_readfirstlane(tid >> 6), lane = tid & 63;
    const bf16_t* QP = (const bf16_t*)(a.ws + WS_MIX); const bf16_t* SKB = (const bf16_t*)(a.ws + WS_SKB); const float* SSQ = (const float*)(a.ws + WS_SSQ);
    int* IDX = (int*)(a.ws + WS_IDX); float* GATE = (float*)(a.ws + WS_GATE);
    int* scr = (int*)lds + wave * 2048;
    {
        const bf16_t* X1W = (const bf16_t*)(a.ws + WS_HN); signed char* X1Q = (signed char*)(a.ws + WS_X1Q); float* XSC = (float*)(a.ws + WS_XSC);
        for (int row = bid * NWAVES + wave; row < TREAL; row += nb * NWAVES) {
            uint4 xr[4]; float am = 0.f;
#pragma unroll
            for (int j = 0; j < 4; ++j) { xr[j] = *(const uint4*)(X1W + (size_t)row * DM + 8 * lane + 512 * j);
                am = fmaxf(am, fmaxf(fmaxf(fmaxf(fabsf(bf_lo(xr[j].x)), fabsf(bf_hi(xr[j].x))), fmaxf(fabsf(bf_lo(xr[j].y)), fabsf(bf_hi(xr[j].y)))), fmaxf(fmaxf(fabsf(bf_lo(xr[j].z)), fabsf(bf_hi(xr[j].z))), fmaxf(fabsf(bf_lo(xr[j].w)), fabsf(bf_hi(xr[j].w)))))); }
            am = wave_max(am);
            const float sc = am > 0.f ? 119.f / am : 0.f;
            const bool hih = (lane & 2) != 0;
#pragma unroll
            for (int j = 0; j < 4; ++j) {
                const unsigned ww[4] = {xr[j].x, xr[j].y, xr[j].z, xr[j].w}; unsigned wh[2] = {0u, 0u}, wl[2] = {0u, 0u};
#pragma unroll
                for (int i = 0; i < 8; ++i) { const int q = (int)rintf(((i & 1) ? bf_hi(ww[i >> 1]) : bf_lo(ww[i >> 1])) * sc); const int xl = ((q + 8) & 15) - 8, xh = (q - xl) >> 4;
                    wh[i >> 2] |= (unsigned)(xh & 15) << (8 * (i & 3)); wl[i >> 2] |= (unsigned)(xl & 15) << (8 * (i & 3)); }
                const unsigned r0 = (unsigned)__shfl_xor((int)(hih ? wh[0] : wl[0]), 2), r1 = (unsigned)__shfl_xor((int)(hih ? wh[1] : wl[1]), 2);
                const unsigned o0 = hih ? (r0 | (wl[0] << 4)) : (wh[0] | (r0 << 4)), o1 = hih ? (r1 | (wl[1] << 4)) : (wh[1] | (r1 << 4));
                *(uint2*)(X1Q + (size_t)row * DM + 512 * j + 32 * (lane >> 2) + 8 * (lane & 1) + (hih ? 16 : 0)) = make_uint2(o0, o1);
            }
            if (lane == 0) XSC[row] = am * (1.f / 119.f);
        }
    }
    {
        const int hb = bid & 7; char* KL = (char*)lds + 65536;
        __syncthreads();
        const uint4* src = (const uint4*)(SKB + (size_t)hb * (2 * 128 * 128));
#pragma unroll
        for (int k = 0; k < 8; ++k) { const int ci = tid + NTHREADS * k; *(uint4*)(KL + (ci >> 4) * 272 + (ci & 15) * 16) = src[ci]; }
        __syncthreads();
        const int nbh = (nb - hb + 7) >> 3;
        for (int tb = (bid >> 3) * NWAVES + wave; tb < TREAL / 32; tb += nbh * NWAVES) rt::route_item(tb, hb, QP, KL, SSQ, IDX, GATE, scr, lane);
    }
}

constexpr int CW_QPV = 8192, CW_QPU = 8192 + 8 * 64;
constexpr int PX_BIG = 1792, PX_SMALL = (TREAL - PX_BIG * 16) / 4;
constexpr int PX_ITEMS = TREAL / 64;
constexpr size_t WS_W = WS_Z + 4 * MiB, WS_PART = WS_Z + 32 * MiB, WS_Y = WS_Z + 160 * MiB;


template <int CTRL, int RMASK> __device__ __forceinline__ float dppf(float old, float v) { return __builtin_bit_cast(float, __builtin_amdgcn_update_dpp(__builtin_bit_cast(int, old), __builtin_bit_cast(int, v), CTRL, RMASK, 0xf, false)); }
template <int CTRL> __device__ __forceinline__ int dppi(int v) { return __builtin_amdgcn_update_dpp(0, v, CTRL, 0xf, 0xf, false); }
namespace pu2 {
typedef float f32x2v __attribute__((ext_vector_type(2)));
typedef unsigned u32x4v __attribute__((ext_vector_type(4)));
#define SBP() __builtin_amdgcn_sched_barrier(0)
#define PU_CHUNK_LD(dst, r_, q_) dst = *(const u32x4v*)(sidx + ((r_) - r0) * 512 + g128 + (q_) * 16)
#define PU_ROW_LD(buf, e_) buf = __builtin_amdgcn_raw_buffer_load_b128(U, (int)(e_) * 256 + c16, 0, 0)
#define PU_CONSUME(buf, I_) do { int h_ = __builtin_amdgcn_sdot8((int)buf[0], hq0, 0, false); int s_ = __builtin_amdgcn_sdot8((int)buf[0], hr0, 0, false); \
    h_ = __builtin_amdgcn_sdot8((int)buf[1], hq1, h_, false); s_ = __builtin_amdgcn_sdot8((int)buf[1], hr1, s_, false); \
    h_ = __builtin_amdgcn_sdot8((int)buf[2], hq2, h_, false); s_ = __builtin_amdgcn_sdot8((int)buf[2], hr2, s_, false); \
    h_ = __builtin_amdgcn_sdot8((int)buf[3], hq3, h_, false); s_ = __builtin_amdgcn_sdot8((int)buf[3], hr3, s_, false); \
    s_ += h_ << 4; \
    s_ += dppi<0x128>(s_); s_ += dppi<0x124>(s_); s_ += dppi<0x122>(s_); s_ += dppi<0x121>(s_); \
    if ((I_) < 16) keep0 = (c == ((I_) & 15)) ? s_ : keep0; else keep1 = (c == ((I_) & 15)) ? s_ : keep1; } while (0)
#define PU_TOKEN_BODY(row_, nrow_, has_next_) do { \
    PU_CHUNK_LD(C7, row_, 7); \
    SBP(); PU_CONSUME(B0, 0); \
    PU_ROW_LD(B0, C2.x); \
    SBP(); PU_CONSUME(B1, 1); \
    PU_ROW_LD(B1, C2.y); \
    SBP(); PU_CONSUME(B2, 2); \
    PU_ROW_LD(B2, C2.z); \
    SBP(); PU_CONSUME(B3, 3); \
    PU_ROW_LD(B3, C2.w); \
    if (has_next_) PU_CHUNK_LD(C0, nrow_, 0); \
    SBP(); PU_CONSUME(B4, 4); \
    PU_ROW_LD(B4, C3.x); \
    SBP(); PU_CONSUME(B5, 5); \
    PU_ROW_LD(B5, C3.y); \
    SBP(); PU_CONSUME(B6, 6); \
    PU_ROW_LD(B6, C3.z); \
    SBP(); PU_CONSUME(B7, 7); \
    PU_ROW_LD(B7, C3.w); \
    if (has_next_) PU_CHUNK_LD(C1, nrow_, 1); \
    SBP(); PU_CONSUME(B0, 8); \
    PU_ROW_LD(B0, C4.x); \
    SBP(); PU_CONSUME(B1, 9); \
    PU_ROW_LD(B1, C4.y); \
    SBP(); PU_CONSUME(B2, 10); \
    PU_ROW_LD(B2, C4.z); \
    SBP(); PU_CONSUME(B3, 11); \
    PU_ROW_LD(B3, C4.w); \
    if (has_next_) PU_CHUNK_LD(C2, nrow_, 2); \
    SBP(); PU_CONSUME(B4, 12); \
    PU_ROW_LD(B4, C5.x); \
    SBP(); PU_CONSUME(B5, 13); \
    PU_ROW_LD(B5, C5.y); \
    SBP(); PU_CONSUME(B6, 14); \
    PU_ROW_LD(B6, C5.z); \
    SBP(); PU_CONSUME(B7, 15); \
    PU_ROW_LD(B7, C5.w); \
    if (has_next_) PU_CHUNK_LD(C3, nrow_, 3); \
    SBP(); PU_CONSUME(B0, 16); \
    PU_ROW_LD(B0, C6.x); \
    SBP(); PU_CONSUME(B1, 17); \
    PU_ROW_LD(B1, C6.y); \
    SBP(); PU_CONSUME(B2, 18); \
    PU_ROW_LD(B2, C6.z); \
    SBP(); PU_CONSUME(B3, 19); \
    PU_ROW_LD(B3, C6.w); \
    if (has_next_) PU_CHUNK_LD(C4, nrow_, 4); \
    SBP(); PU_CONSUME(B4, 20); \
    PU_ROW_LD(B4, C7.x); \
    SBP(); PU_CONSUME(B5, 21); \
    PU_ROW_LD(B5, C7.y); \
    SBP(); PU_CONSUME(B6, 22); \
    PU_ROW_LD(B6, C7.z); \
    SBP(); PU_CONSUME(B7, 23); \
    PU_ROW_LD(B7, C7.w); \
    if (has_next_) PU_CHUNK_LD(C5, nrow_, 5); \
    SBP(); PU_CONSUME(B0, 24); \
    if (has_next_) PU_ROW_LD(B0, C0.x); \
    SBP(); PU_CONSUME(B1, 25); \
    if (has_next_) PU_ROW_LD(B1, C0.y); \
    SBP(); PU_CONSUME(B2, 26); \
    if (has_next_) PU_ROW_LD(B2, C0.z); \
    SBP(); PU_CONSUME(B3, 27); \
    if (has_next_) PU_ROW_LD(B3, C0.w); \
    if (has_next_) PU_CHUNK_LD(C6, nrow_, 6); \
    SBP(); PU_CONSUME(B4, 28); \
    if (has_next_) PU_ROW_LD(B4, C1.x); \
    SBP(); PU_CONSUME(B5, 29); \
    if (has_next_) PU_ROW_LD(B5, C1.y); \
    SBP(); PU_CONSUME(B6, 30); \
    if (has_next_) PU_ROW_LD(B6, C1.z); \
    SBP(); PU_CONSUME(B7, 31); \
    if (has_next_) PU_ROW_LD(B7, C1.w); \
    } while (0)
#undef SBP
}

__device__ __forceinline__ void phase_pu(const Args& a, unsigned char* lds, unsigned* ctl, int xcc) {
    using namespace pu2;
#define SBP() __builtin_amdgcn_sched_barrier(0)
    const int tid = opaque_tid(), wave = __builtin_amdgcn_readfirstlane(tid >> 6), lane = tid & 63;
    volatile LAS unsigned* slot = (volatile LAS unsigned*)((LAS unsigned char*)lds + LDS_MISC) + 2;
    const signed char* X1Q = (const signed char*)(a.ws + WS_X1Q); float* PART = (float*)(a.ws + WS_PART);
    unsigned char* sidx = lds + wave * 8192; unsigned char* sxq = lds + 65536 + wave * 8192;
    const __amdgpu_buffer_rsrc_t RI = __builtin_amdgcn_make_buffer_rsrc((void*)(a.ws + WS_IDX), (short)0, TREAL * 512, 0x00020000);
    for (int ss = 0; ss < 4; ++ss) {
        const int s = (xcc + ss) & 3;
        const __amdgpu_buffer_rsrc_t U = __builtin_amdgcn_make_buffer_rsrc((void*)(a.ws + WS_U + (size_t)s * (16384 * 256)), (short)0, 16384 * 256, 0x00020000);
        unsigned wdraw = wave_draw(ctl + CW_QPU + 64 * s, lane);
        for (;;) {
            const int item8 = wave_item(wdraw);
            if (item8 >= PX_BIG + PX_SMALL) break;
            wdraw = wave_draw(ctl + CW_QPU + 64 * s, lane);
            int ln = lane; asm volatile("" : "+v"(ln));
            const int g = ln >> 4, c = ln & 15, c16 = c * 16, g128 = g * 128;
            const int r0 = item8 < PX_BIG ? item8 * 16 : PX_BIG * 16 + (item8 - PX_BIG) * 4, nt = item8 < PX_BIG ? 16 : 4;
            u32x4v C0, C1, C2, C3, C4, C5, C6, C7, B0, B1, B2, B3, B4, B5, B6, B7;
            {
                const u32x4v* gi = (const u32x4v*)(a.ws + WS_IDX + (size_t)r0 * 256) + ln;
                u32x4v iv[4], xv[8];
#pragma unroll
                for (int k = 0; k < 4; ++k) iv[k] = __builtin_nontemporal_load(gi + 64 * k);
#pragma unroll
                for (int k = 0; k < 8; ++k) xv[k] = __builtin_nontemporal_load((const u32x4v*)(X1Q + (size_t)(r0 + 2 * k + (ln >> 5)) * DM + 512 * s + 16 * (ln & 31)));
                u32x4v* si = (u32x4v*)sidx + 2 * ln; u32x4v* sx = (u32x4v*)sxq + ln;
#pragma unroll
                for (int k = 0; k < 4; ++k) { const u32x4v lo_ = {iv[k][0] & 0xffffu, iv[k][0] >> 16, iv[k][1] & 0xffffu, iv[k][1] >> 16}, hi_ = {iv[k][2] & 0xffffu, iv[k][2] >> 16, iv[k][3] & 0xffffu, iv[k][3] >> 16}; si[128 * k] = lo_; si[128 * k + 1] = hi_; }
#pragma unroll
                for (int k = 0; k < 8; ++k) sx[64 * k] = xv[k];
                asm volatile("s_waitcnt lgkmcnt(0)" ::: "memory");
            }
            PU_CHUNK_LD(C0, r0, 0); PU_CHUNK_LD(C1, r0, 1); PU_CHUNK_LD(C2, r0, 2); PU_CHUNK_LD(C3, r0, 3); PU_CHUNK_LD(C4, r0, 4); PU_CHUNK_LD(C5, r0, 5); PU_CHUNK_LD(C6, r0, 6);
            uint4 nxq = ((const uint4*)sxq)[2 * c], nxr = ((const uint4*)sxq)[2 * c + 1];
            PU_ROW_LD(B0, C0.x); PU_ROW_LD(B1, C0.y); PU_ROW_LD(B2, C0.z); PU_ROW_LD(B3, C0.w); PU_ROW_LD(B4, C1.x); PU_ROW_LD(B5, C1.y); PU_ROW_LD(B6, C1.z); PU_ROW_LD(B7, C1.w);
#pragma unroll 1
            for (int t = 0; t < nt; ++t) {
                const int row = r0 + t, nrow = row + 1; const bool has_next = t < nt - 1;
                const int hq0 = (int)nxq.x, hq1 = (int)nxq.y, hq2 = (int)nxq.z, hq3 = (int)nxq.w, hr0 = (int)nxr.x, hr1 = (int)nxr.y, hr2 = (int)nxr.z, hr3 = (int)nxr.w;
                if (has_next) { nxq = ((const uint4*)sxq)[(t + 1) * 32 + 2 * c]; nxr = ((const uint4*)sxq)[(t + 1) * 32 + 2 * c + 1]; }
                int keep0 = 0, keep1 = 0;
                PU_TOKEN_BODY(row, nrow, has_next);
                __builtin_nontemporal_store(pk2((float)keep0, (float)keep1), (unsigned*)PART + (size_t)row * 256 + s * 64 + 16 * g + c);
            }
        }
    }
#undef SBP
}
__device__ __forceinline__ void phase_pc(const Args& a, int bid, int nb) {
    const int tid = opaque_tid(), wave = __builtin_amdgcn_readfirstlane(tid >> 6), lane = tid & 63;
    const float* SSQ = (const float*)(a.ws + WS_SSQ); const int* IDX = (const int*)(a.ws + WS_IDX); const float* GATE = (const float*)(a.ws + WS_GATE);
    const float2* ISC2 = (const float2*)(a.ws + WS_ISC); const float* PART = (const float*)(a.ws + WS_PART); unsigned short* W16 = (unsigned short*)(a.ws + WS_W); float* WSC = (float*)(a.ws + WS_W + 12 * MiB);
    constexpr int R = 4;
    const int stride = nb * NWAVES;
    const int p0 = 32 * (lane >> 4) + (lane & 15), p1 = p0 + 16;
    for (int rowb = bid * NWAVES + wave; rowb < TREAL; rowb += R * stride) {
        int rw[R]; bool ok[R];
#pragma unroll
        for (int k = 0; k < R; ++k) { rw[k] = rowb + k * stride; ok[k] = rw[k] < TREAL; if (!ok[k]) rw[k] = rowb; }
        int2 e2[R]; float2 g2[R]; float ssv[R], xsc[R]; unsigned pv[R][4];
#pragma unroll
        for (int k = 0; k < R; ++k) e2[k] = make_int2((int)((const unsigned short*)IDX)[(size_t)rw[k] * 128 + p0], (int)((const unsigned short*)IDX)[(size_t)rw[k] * 128 + p1]);
#pragma unroll
        for (int k = 0; k < R; ++k) {
            ssv[k] = SSQ[(size_t)rw[k] * 32 + (lane & 31)]; xsc[k] = ((const float*)(a.ws + WS_XSC))[rw[k]];
            g2[k] = make_float2(GATE[(size_t)rw[k] * 128 + p0], GATE[(size_t)rw[k] * 128 + p1]);
#pragma unroll
            for (int s = 0; s < 4; ++s) pv[k][s] = ((const unsigned*)PART)[(size_t)rw[k] * 256 + s * 64 + lane];
        }
        float2 sa[R], sb[R];
#pragma unroll
        for (int k = 0; k < R; ++k) { sa[k] = ISC2[e2[k].x]; sb[k] = ISC2[e2[k].y]; }
#pragma unroll
        for (int k = 0; k < R; ++k) {
            const int row = rw[k];
            const float rstd = rsqrtf(wave_sum(lane < 32 ? ssv[k] : 0.f) * (1.f / DM) + EPS);
            float2 d = {0.f, 0.f};
#pragma unroll
            for (int s = 0; s < 4; ++s) { d.x += bf_lo(pv[k][s]); d.y += bf_hi(pv[k][s]); }
            float wv[2];
            { const float pre = d.x * rstd * sa[k].x * xsc[k]; wv[0] = g2[k].x * sa[k].y * (0.5f * pre * (1.f + erff(pre * 0.7071067811865476f))); }
            { const float pre = d.y * rstd * sb[k].x * xsc[k]; wv[1] = g2[k].y * sb[k].y * (0.5f * pre * (1.f + erff(pre * 0.7071067811865476f))); }
            const float wmax = wave_max(fmaxf(fabsf(wv[0]), fabsf(wv[1])));
            const float wsc = wmax > 1e-30f ? 127.f / wmax : 0.f;
            const float wq0 = rintf(wv[0] * wsc), wq1 = rintf(wv[1] * wsc);
            const float wtot = wave_sum(wq0 + wq1);
            if (ok[k]) {
                W16[(size_t)row * 128 + p0] = (unsigned short)((int)wq0 & 255); W16[(size_t)row * 128 + p1] = (unsigned short)((int)wq1 & 255);
                if (lane == 0) ((float2*)WSC)[row] = make_float2(wmax * (1.f / 127.f), 8.f * wtot * wmax * (1.f / 127.f));
            }
        }
    }
}
namespace pv2 {
typedef float f32x2v __attribute__((ext_vector_type(2)));
typedef unsigned u32x4v __attribute__((ext_vector_type(4))); typedef float f32x4v __attribute__((ext_vector_type(4)));
typedef unsigned u32x2v __attribute__((ext_vector_type(2)));
typedef int i32x4v __attribute__((ext_vector_type(4)));
struct Chunk { u32x4v i; u32x2v w; };
#define SBP() __builtin_amdgcn_sched_barrier(0)
#define PV_CHUNK_LD(dst, r_, q_) do { dst.i = *(const u32x4v*)(sidx + ((r_) - r0) * 512 + g128 + (q_) * 16); dst.w = *(const u32x2v*)(swt + ((r_) - r0) * 256 + g64 + (q_) * 8); } while (0)
#define PV_ROW_LD(buf, e_) buf = __builtin_amdgcn_raw_buffer_load_b128(V, (int)(e_) * 256 + c16, 0, 0)
#define PV_CONSUME(buf, ww_, S0_, S1_) do { \
    const i32x4v b_ = {(int)__builtin_amdgcn_perm(0u, (ww_), (S0_)[0]), (int)__builtin_amdgcn_perm(0u, (ww_), (S0_)[1]), (int)__builtin_amdgcn_perm(0u, (ww_), (S0_)[2]), (int)__builtin_amdgcn_perm(0u, (ww_), (S0_)[3])}; \
    const i32x4v l_ = {(int)buf[0], (int)buf[1], (int)buf[2], (int)buf[3]};        \
    const i32x4v h_ = {(int)(buf[0] & 0xf0f0f0f0u), (int)(buf[1] & 0xf0f0f0f0u), (int)(buf[2] & 0xf0f0f0f0u), (int)(buf[3] & 0xf0f0f0f0u)}; \
    acc_lo = __builtin_amdgcn_mfma_i32_16x16x64_i8(l_, b_, acc_lo, 0, 0, 0); acc_hi = __builtin_amdgcn_mfma_i32_16x16x64_i8(h_, b_, acc_hi, 0, 0, 0); } while (0)
#define PV_TOKEN_BODY(row_, nrow_, has_next_) do { \
    PV_CHUNK_LD(C7, row_, 7); \
    SBP(); PV_CONSUME(B0, C0.w[0], sele0, sele1); \
    PV_ROW_LD(B0, C2.i.x); \
    SBP(); PV_CONSUME(B1, C0.w[0], selo0, selo1); \
    PV_ROW_LD(B1, C2.i.y); \
    SBP(); PV_CONSUME(B2, C0.w[1], sele0, sele1); \
    PV_ROW_LD(B2, C2.i.z); \
    SBP(); PV_CONSUME(B3, C0.w[1], selo0, selo1); \
    PV_ROW_LD(B3, C2.i.w); \
    if (has_next_) PV_CHUNK_LD(C0, nrow_, 0); \
    SBP(); PV_CONSUME(B4, C1.w[0], sele0, sele1); \
    PV_ROW_LD(B4, C3.i.x); \
    SBP(); PV_CONSUME(B5, C1.w[0], selo0, selo1); \
    PV_ROW_LD(B5, C3.i.y); \
    SBP(); PV_CONSUME(B6, C1.w[1], sele0, sele1); \
    PV_ROW_LD(B6, C3.i.z); \
    SBP(); PV_CONSUME(B7, C1.w[1], selo0, selo1); \
    PV_ROW_LD(B7, C3.i.w); \
    if (has_next_) PV_CHUNK_LD(C1, nrow_, 1); \
    SBP(); PV_CONSUME(B0, C2.w[0], sele0, sele1); \
    PV_ROW_LD(B0, C4.i.x); \
    SBP(); PV_CONSUME(B1, C2.w[0], selo0, selo1); \
    PV_ROW_LD(B1, C4.i.y); \
    SBP(); PV_CONSUME(B2, C2.w[1], sele0, sele1); \
    PV_ROW_LD(B2, C4.i.z); \
    SBP(); PV_CONSUME(B3, C2.w[1], selo0, selo1); \
    PV_ROW_LD(B3, C4.i.w); \
    if (has_next_) PV_CHUNK_LD(C2, nrow_, 2); \
    SBP(); PV_CONSUME(B4, C3.w[0], sele0, sele1); \
    PV_ROW_LD(B4, C5.i.x); \
    SBP(); PV_CONSUME(B5, C3.w[0], selo0, selo1); \
    PV_ROW_LD(B5, C5.i.y); \
    SBP(); PV_CONSUME(B6, C3.w[1], sele0, sele1); \
    PV_ROW_LD(B6, C5.i.z); \
    SBP(); PV_CONSUME(B7, C3.w[1], selo0, selo1); \
    PV_ROW_LD(B7, C5.i.w); \
    if (has_next_) PV_CHUNK_LD(C3, nrow_, 3); \
    SBP(); PV_CONSUME(B0, C4.w[0], sele0, sele1); \
    PV_ROW_LD(B0, C6.i.x); \
    SBP(); PV_CONSUME(B1, C4.w[0], selo0, selo1); \
    PV_ROW_LD(B1, C6.i.y); \
    SBP(); PV_CONSUME(B2, C4.w[1], sele0, sele1); \
    PV_ROW_LD(B2, C6.i.z); \
    SBP(); PV_CONSUME(B3, C4.w[1], selo0, selo1); \
    PV_ROW_LD(B3, C6.i.w); \
    if (has_next_) PV_CHUNK_LD(C4, nrow_, 4); \
    SBP(); PV_CONSUME(B4, C5.w[0], sele0, sele1); \
    PV_ROW_LD(B4, C7.i.x); \
    SBP(); PV_CONSUME(B5, C5.w[0], selo0, selo1); \
    PV_ROW_LD(B5, C7.i.y); \
    SBP(); PV_CONSUME(B6, C5.w[1], sele0, sele1); \
    PV_ROW_LD(B6, C7.i.z); \
    SBP(); PV_CONSUME(B7, C5.w[1], selo0, selo1); \
    PV_ROW_LD(B7, C7.i.w); \
    if (has_next_) PV_CHUNK_LD(C5, nrow_, 5); \
    SBP(); PV_CONSUME(B0, C6.w[0], sele0, sele1); \
    if (has_next_) PV_ROW_LD(B0, C0.i.x); \
    SBP(); PV_CONSUME(B1, C6.w[0], selo0, selo1); \
    if (has_next_) PV_ROW_LD(B1, C0.i.y); \
    SBP(); PV_CONSUME(B2, C6.w[1], sele0, sele1); \
    if (has_next_) PV_ROW_LD(B2, C0.i.z); \
    SBP(); PV_CONSUME(B3, C6.w[1], selo0, selo1); \
    if (has_next_) PV_ROW_LD(B3, C0.i.w); \
    if (has_next_) PV_CHUNK_LD(C6, nrow_, 6); \
    SBP(); PV_CONSUME(B4, C7.w[0], sele0, sele1); \
    if (has_next_) PV_ROW_LD(B4, C1.i.x); \
    SBP(); PV_CONSUME(B5, C7.w[0], selo0, selo1); \
    if (has_next_) PV_ROW_LD(B5, C1.i.y); \
    SBP(); PV_CONSUME(B6, C7.w[1], sele0, sele1); \
    if (has_next_) PV_ROW_LD(B6, C1.i.z); \
    SBP(); PV_CONSUME(B7, C7.w[1], selo0, selo1); \
    if (has_next_) PV_ROW_LD(B7, C1.i.w); \
    } while (0)
#undef SBP
}

__device__ __forceinline__ void phase_pv(const Args& a, unsigned char* lds, unsigned* ctl, int xcc) {
    using namespace pv2;
#define SBP() __builtin_amdgcn_sched_barrier(0)
    const int tid = opaque_tid(), wave = __builtin_amdgcn_readfirstlane(tid >> 6), lane = tid & 63;
    volatile LAS unsigned* slot = (volatile LAS unsigned*)((LAS unsigned char*)lds + LDS_MISC) + 2;
    bf16_t* Y = (bf16_t*)(a.ws + WS_Y); const float* WSC = (const float*)(a.ws + WS_W + 12 * MiB);
    const __amdgpu_buffer_rsrc_t RI = __builtin_amdgcn_make_buffer_rsrc((void*)(a.ws + WS_IDX), (short)0, TREAL * 512, 0x00020000);
    const __amdgpu_buffer_rsrc_t RW = __builtin_amdgcn_make_buffer_rsrc((void*)(a.ws + WS_W), (short)0, TREAL * 256, 0x00020000);
    float* ybuf = (float*)lds + wave * 512;
    unsigned char* sidx = lds + 16384 + wave * 8192; unsigned char* swt = lds + 16384 + 65536 + wave * 4096;
    for (int ss = 0; ss < 4; ++ss) {
        const int s = (xcc + ss) & 3;
        const __amdgpu_buffer_rsrc_t V = __builtin_amdgcn_make_buffer_rsrc((void*)(a.ws + WS_V + (size_t)s * (16384 * 256)), (short)0, 16384 * 256, 0x00020000);
        unsigned wdraw = wave_draw(ctl + CW_QPV + 64 * s, lane);
        for (;;) {
            const int item8 = wave_item(wdraw);
            if (item8 >= PX_BIG + PX_SMALL) break;
            wdraw = wave_draw(ctl + CW_QPV + 64 * s, lane);
            int ln = lane; asm volatile("" : "+v"(ln));
            const int g = ln >> 4, n = ln & 15, c16 = n * 16, g128 = g * 128, g64 = g * 64;
            const int r0 = item8 < PX_BIG ? item8 * 16 : PX_BIG * 16 + (item8 - PX_BIG) * 4, nt = item8 < PX_BIG ? 16 : 4;
            u32x4v sele0, selo0; const int sele1 = 0, selo1 = 0; (void)sele1; (void)selo1;
            { const unsigned sh = 8u * (unsigned)(n & 3), keep = 0x0c0c0c0cu & ~(255u << sh), ve = keep, vo = keep | (2u << sh); const int d0 = n >> 2;
              sele0[0] = d0 == 0 ? ve : 0x0c0c0c0cu; sele0[1] = d0 == 1 ? ve : 0x0c0c0c0cu; sele0[2] = d0 == 2 ? ve : 0x0c0c0c0cu; sele0[3] = d0 == 3 ? ve : 0x0c0c0c0cu;
              selo0[0] = d0 == 0 ? vo : 0x0c0c0c0cu; selo0[1] = d0 == 1 ? vo : 0x0c0c0c0cu; selo0[2] = d0 == 2 ? vo : 0x0c0c0c0cu; selo0[3] = d0 == 3 ? vo : 0x0c0c0c0cu; }
            Chunk C0, C1, C2, C3, C4, C5, C6, C7; u32x4v B0, B1, B2, B3, B4, B5, B6, B7;
            const float2 wscv = ((const float2*)WSC)[r0 + (ln & 15)];
            {
                const u32x4v* gi = (const u32x4v*)(a.ws + WS_IDX + (size_t)r0 * 256) + ln; const u32x4v* gw = (const u32x4v*)(a.ws + WS_W + (size_t)r0 * 256) + ln;
                u32x4v iv[4], wv4[4];
#pragma unroll
                for (int k = 0; k < 4; ++k) iv[k] = __builtin_nontemporal_load(gi + 64 * k);
#pragma unroll
                for (int k = 0; k < 4; ++k) wv4[k] = __builtin_nontemporal_load(gw + 64 * k);
                u32x4v* si = (u32x4v*)sidx + 2 * ln; u32x4v* sw = (u32x4v*)swt + ln;
#pragma unroll
                for (int k = 0; k < 4; ++k) { const u32x4v lo_ = {iv[k][0] & 0xffffu, iv[k][0] >> 16, iv[k][1] & 0xffffu, iv[k][1] >> 16}, hi_ = {iv[k][2] & 0xffffu, iv[k][2] >> 16, iv[k][3] & 0xffffu, iv[k][3] >> 16}; si[128 * k] = lo_; si[128 * k + 1] = hi_; }
#pragma unroll
                for (int k = 0; k < 4; ++k) sw[64 * k] = wv4[k];
                asm volatile("s_waitcnt lgkmcnt(0)" ::: "memory");
            }
            PV_CHUNK_LD(C0, r0, 0); PV_CHUNK_LD(C1, r0, 1); PV_CHUNK_LD(C2, r0, 2); PV_CHUNK_LD(C3, r0, 3); PV_CHUNK_LD(C4, r0, 4); PV_CHUNK_LD(C5, r0, 5); PV_CHUNK_LD(C6, r0, 6);
            PV_ROW_LD(B0, C0.i.x); PV_ROW_LD(B1, C0.i.y); PV_ROW_LD(B2, C0.i.z); PV_ROW_LD(B3, C0.i.w); PV_ROW_LD(B4, C1.i.x); PV_ROW_LD(B5, C1.i.y); PV_ROW_LD(B6, C1.i.z); PV_ROW_LD(B7, C1.i.w);
#pragma unroll 1
            for (int t = 0; t < nt; ++t) {
                const int row = r0 + t, nrow = row + 1; const bool has_next = t < nt - 1;
                i32x4v acc_lo = {0, 0, 0, 0}, acc_hi = {0, 0, 0, 0};
                PV_TOKEN_BODY(row, nrow, has_next);
                const float wsc = 128.f * __uint_as_float(__builtin_amdgcn_readlane(__float_as_uint(wscv.x), t)), woff = 128.f * __uint_as_float(__builtin_amdgcn_readlane(__float_as_uint(wscv.y), t));
#pragma unroll
                for (int i = 0; i < 4; ++i) {
                    const float wsc16 = wsc * 0.0625f;
                    ybuf[32 * (4 * g + i) + n] = (float)(acc_lo[i] - acc_hi[i]) * wsc - woff;
                    ybuf[32 * (4 * g + i) + 16 + n] = (float)acc_hi[i] * wsc16;
                }
                asm volatile("s_waitcnt lgkmcnt(0)" ::: "memory");
                {
                    const float4 ya = ((const float4*)ybuf)[2 * ln], yb = ((const float4*)ybuf)[2 * ln + 1];
                    { int w0_ = __builtin_amdgcn_cvt_pk_fp8_f32(ya.x, ya.y, 0, false); w0_ = __builtin_amdgcn_cvt_pk_fp8_f32(ya.z, ya.w, w0_, true); int w1_ = __builtin_amdgcn_cvt_pk_fp8_f32(yb.x, yb.y, 0, false); w1_ = __builtin_amdgcn_cvt_pk_fp8_f32(yb.z, yb.w, w1_, true);
                      const u32x2v yo_ = {(unsigned)w0_, (unsigned)w1_}; __builtin_nontemporal_store(yo_, (u32x2v*)((unsigned char*)Y + (size_t)row * DM + 512 * s + 8 * ln)); }
                }
                asm volatile("s_waitcnt lgkmcnt(0)" ::: "memory");
            }
        }
    }
#undef SBP
}
__device__ __forceinline__ void phase_pn(const Args& a, int bid, int nb) {
    const int tid = opaque_tid(), wave = __builtin_amdgcn_readfirstlane(tid >> 6), lane = tid & 63;
    const bf16_t* Y = (const bf16_t*)(a.ws + WS_Y); const bf16_t* X1 = (const bf16_t*)(a.ws + WS_HN);
    f32x4 nwf[8];
#pragma unroll
    for (int j = 0; j < 8; ++j) nwf[j] = ((const f32x4*)a.nfinal)[64 * j + lane];
    for (int row = bid * NWAVES + wave; row < TREAL; row += nb * NWAVES) {
        f32x4* p = (f32x4*)(a.out + (size_t)row * DM) + lane;
        const unsigned* yp = (const unsigned*)((const unsigned char*)Y + (size_t)row * DM) + lane; const uint2* xp = (const uint2*)(X1 + (size_t)row * DM) + lane;
        f32x4 v[8]; float ss = 0.f;
#pragma unroll
        for (int j = 0; j < 8; ++j) { const int yy = (int)yp[64 * j]; const uint2 xx = xp[64 * j];
            v[j][0] = bf_lo(xx.x) + 0.0078125f * __builtin_amdgcn_cvt_f32_fp8(yy, 0); v[j][1] = bf_hi(xx.x) + 0.0078125f * __builtin_amdgcn_cvt_f32_fp8(yy, 1); v[j][2] = bf_lo(xx.y) + 0.0078125f * __builtin_amdgcn_cvt_f32_fp8(yy, 2); v[j][3] = bf_hi(xx.y) + 0.0078125f * __builtin_amdgcn_cvt_f32_fp8(yy, 3);
            ss += (v[j][0] * v[j][0] + v[j][1] * v[j][1]) + (v[j][2] * v[j][2] + v[j][3] * v[j][3]); }
        const float r = rsqrtf(wave_sum(ss) * (1.f / DM) + EPS);
#pragma unroll
        for (int j = 0; j < 8; ++j) p[64 * j] = v[j] * r * nwf[j];
    }
}

__device__ __forceinline__ void phase_mix(const Args& a, unsigned char* lds, unsigned* ctr) {
    const bf16_t* Z = (const bf16_t*)(a.ws + WS_Z); bf16_t* MIX = (bf16_t*)(a.ws + WS_MIX);
    volatile LAS unsigned* slot = (volatile LAS unsigned*)((LAS unsigned char*)lds + LDS_MISC) + 2;
    for (;;) {
        const int item = next_item(ctr, slot);
        if (item >= 64 + 2048) break;
        if (item < 64) mls::mlstm_item(item >> 2, item & 3, a, (char*)lds);
        else { const int k = item - 64, qb = 15 - (k >> 7), bh = k & 127; const float lam = attn_lambda(a); att::attn_unit(bh >> 3, bh & 7, qb, Z, MIX, lam, a.subln, (char*)lds); }
    }
}

__global__ void __launch_bounds__(NTHREADS, 2) mega(Args a) {
    extern __shared__ __attribute__((aligned(16))) unsigned char lds[];
    cg::grid_group grid = cg::this_grid();
    const int bid = blockIdx.x, nb = gridDim.x;
    unsigned char* ws = a.ws;
    bf16_t* WinT = (bf16_t*)(ws + WS_WIN); bf16_t* WoutT = (bf16_t*)(ws + WS_WOUT); bf16_t* WqT = (bf16_t*)(ws + WS_WQ);
    float* rope = (float*)(ws + WS_ROPE); float* SSQ = (float*)(ws + WS_SSQ);
    bf16_t* HN = (bf16_t*)(ws + WS_HN); bf16_t* MIX = (bf16_t*)(ws + WS_MIX); bf16_t* Z = (bf16_t*)(ws + WS_Z);

    volatile LAS unsigned* MISC = (volatile LAS unsigned*)((LAS unsigned char*)lds + LDS_MISC);
    if (threadIdx.x < 16) MISC[threadIdx.x] = 0u;
    __syncthreads();
    unsigned* ctl = (unsigned*)(ws + WS_CTL);
    XcdBarrier bar = xcd_barrier_post(ctl + CW_BAR, MISC);
    phase_prep(a, lds, bid, nb);
    if (nb == (1 << 30)) grid.sync();
    xcd_barrier(bar);
    { pg8::Gemm g{HN, WinT, MROWS, NZ, DM}; EpiZ E{Z, rope}; pg8::StaticOrder S; S.init(g.M, g.N, nb, bid);
      pg8::gemm_phase<EpiZ, pg8::StaticOrder, true, true>((PG8_LAS unsigned char*)lds, g, S, E); }
    phase_tables(a, lds, ctl);
    xcd_barrier(bar);
    phase_mix(a, lds, ctl + CW_QUEUE);
    xcd_barrier(bar);
    { pg8::Gemm g{MIX, WoutT, TREAL, DM, DM}; EpiX1 E{HN, (const float*)(ws + WS_RINV), SSQ}; pg8::StaticOrder S; S.init(g.M, g.N, nb, bid);
      pg8::gemm_phase<EpiX1, pg8::StaticOrder, true, true>((PG8_LAS unsigned char*)lds, g, S, E); }
    xcd_barrier(bar);
    { pg8::Gemm g{HN, WqT, TREAL, DM, DM}; pg8::EpiBf16<0> E{MIX, DM, nullptr, 0, 0, 1.f}; pg8::StaticOrder S; S.init(g.M, g.N, nb, bid);
      pg8::gemm_phase<pg8::EpiBf16<0>, pg8::StaticOrder, true, true>((PG8_LAS unsigned char*)lds, g, S, E); }
    xcd_barrier(bar);
    phase_route(a, lds, bid, nb);
    xcd_barrier(bar);
    { const int xcc = (int)(xb_xcc_id() & 7u);
      phase_pu(a, lds, ctl, xcc); xcd_barrier(bar);
      phase_pc(a, bid, nb); xcd_barrier(bar);
      phase_pv(a, lds, ctl, xcc); xcd_barrier(bar);
      phase_pn(a, bid, nb); }
}

extern "C" void kernel_launch(void* const* d_in, const int* in_sizes, int n_in, void* d_out, int out_size, void* d_ws, size_t ws_size, hipStream_t stream) {
    if (n_in != 18 || out_size != TREAL * DM || ws_size < WS_END) { fprintf(stderr, "kernel_launch: unexpected shapes n_in %d out %d ws %zu (need %zu)\n", n_in, out_size, ws_size, (size_t)WS_END); return; }
    static int grid_blocks = 0;
    if (!grid_blocks) {
        int dev = 0, cus = 0, per_cu = 0;
        (void)hipGetDevice(&dev);
        (void)hipDeviceGetAttribute(&cus, hipDeviceAttributeMultiprocessorCount, dev);
        (void)hipFuncSetAttribute((const void*)mega, hipFuncAttributeMaxDynamicSharedMemorySize, LDS_BYTES);
        (void)hipOccupancyMaxActiveBlocksPerMultiprocessor(&per_cu, (const void*)mega, NTHREADS, LDS_BYTES);
        if (per_cu < 1) { fprintf(stderr, "kernel_launch: occupancy query says %d blocks/CU\n", per_cu); per_cu = 1; }
        if (per_cu > 1) per_cu = 1;
        grid_blocks = cus * per_cu;
    }
    Args a{};
    a.x = (const float*)d_in[0]; a.meta = (const float*)d_in[1]; a.nmw = (const float*)d_in[2]; a.w_in = (const float*)d_in[3];
    a.lamqk = (const float*)d_in[4]; a.subln = (const float*)d_in[5]; a.convw = (const float*)d_in[6]; a.convb = (const float*)d_in[7];
    a.ib = (const float*)d_in[8]; a.fb = (const float*)d_in[9]; a.mnw = (const float*)d_in[10]; a.w_out = (const float*)d_in[11];
    a.nfw_ffn = (const float*)d_in[12]; a.w_q = (const float*)d_in[13]; a.subkeys = (const float*)d_in[14]; a.pu = (const float*)d_in[15];
    a.pv = (const float*)d_in[16]; a.nfinal = (const float*)d_in[17];
    a.out = (float*)d_out; a.ws = (unsigned char*)d_ws;
    (void)hipMemsetAsync((char*)d_ws + WS_CTL, 0, 65536, stream);
    void* kargs[] = {&a};
    const hipError_t e = hipLaunchCooperativeKernel((const void*)mega, dim3(grid_blocks), dim3(NTHREADS), kargs, LDS_BYTES, stream);
    if (e != hipSuccess) fprintf(stderr, "kernel_launch: cooperative launch failed: %s (grid %d)\n", hipGetErrorString(e), grid_blocks);
}
```
